# Optimizing an MI355X kernel written in HIP

```python
import functools
import jax, jax.numpy as jnp
from jax import lax
import numpy as np

D_MODEL = 1024
BATCH = 2
SEQ = 8192
DEPTH = 2
DEC_BATCH = 128
DEC_SEQ = 4
PAST_LEN = 16384
PAGE_SIZE = 128

HEAD_DIM = 64
MIX_WIDTH = D_MODEL
MEM_HEADS = 4
MEM_WIDTH = MEM_HEADS * HEAD_DIM
MAIN_WIDTH = MIX_WIDTH - MEM_WIDTH
RWKV_HEADS = MAIN_WIDTH // HEAD_DIM
DECAY_LORA = 64
AAA_LORA = 64
GATE_LORA = 128
RWKV_COLS = 3 * MAIN_WIDTH + DECAY_LORA + AAA_LORA + GATE_LORA
A_IN_COLS = RWKV_COLS + MEM_WIDTH
SWA_Q_HEADS = MAIN_WIDTH // HEAD_DIM
SWA_KV_HEADS = 4
SWA_GROUP = SWA_Q_HEADS // SWA_KV_HEADS
KV_WIDTH = SWA_KV_HEADS * HEAD_DIM
WINDOW = 128
BLOCK = 128
N_MEM = 256
D_FF = 4 * D_MODEL
N_A = DEPTH // 2
N_B = DEPTH - N_A
ROPE_THETA = 10000.0
NORM_EPS = 1e-6
LNX_EPS = 6.4e-4
L2_EPS = 1e-12
ATTN_SCALE = HEAD_DIM ** -0.5

kernel_name = "yoco_rwkv7_swa_sink_mem_step"


def rms_norm(x, g):
    xf = x.astype(jnp.float32)
    y = xf * lax.rsqrt(jnp.mean(xf * xf, axis=-1, keepdims=True) + NORM_EPS)
    return (y * g.astype(jnp.float32)).astype(x.dtype)


def rope(x, pos):
    half = HEAD_DIM // 2
    freqs = jnp.power(ROPE_THETA, -jnp.arange(half, dtype=jnp.float32) / half)
    ang = pos.astype(jnp.float32)[:, None] * freqs[None, :]
    cos, sin = jnp.cos(ang)[:, None, :], jnp.sin(ang)[:, None, :]
    xf = x.astype(jnp.float32)
    x1, x2 = xf[..., :half], xf[..., half:]
    return jnp.concatenate([x1 * cos - x2 * sin, x2 * cos + x1 * sin], axis=-1).astype(x.dtype)


def wkv_scan(r, w, k, v, a, b, S0):
    def step(S, inp):
        r_t, w_t, k_t, v_t, a_t, b_t = inp
        sa = jnp.einsum('bhij,bhj->bhi', S, a_t)
        S = S * w_t[:, :, None, :] + sa[..., None] * b_t[:, :, None, :] + v_t[..., None] * k_t[:, :, None, :]
        return S, jnp.einsum('bhij,bhj->bhi', S, r_t)
    xs = tuple(jnp.moveaxis(t, 1, 0) for t in (r, w, k, v, a, b))
    S, ys = lax.scan(step, S0, xs)
    return jnp.moveaxis(ys, 0, 1), S


def rwkv_time_mix(p, shift_prev, wkv_prev, mu, w_w2, w0, w_a2, a0, w_g2, k_k, k_a, r_k, lnx_w, lnx_b):
    B, T, _ = p.shape
    f32 = jnp.float32
    pf = p.astype(f32)
    prev = jnp.concatenate([shift_prev.astype(f32)[:, None], pf[:, :-1]], axis=1)
    ps = pf + (prev - pf) * mu.astype(f32)
    i1, i2, i3 = MAIN_WIDTH, 2 * MAIN_WIDTH, 3 * MAIN_WIDTH
    i4, i5 = i3 + DECAY_LORA, i3 + DECAY_LORA + AAA_LORA
    r, k, v, wd, ad, gd = jnp.split(ps, [i1, i2, i3, i4, i5], axis=-1)
    w_log = -jax.nn.softplus(-(w0.astype(f32) + jnp.tanh(wd) @ w_w2.astype(f32))) - 0.5
    decay = jnp.exp(-jnp.exp(w_log))
    a = jax.nn.sigmoid(a0.astype(f32) + ad @ w_a2.astype(f32))
    g = jax.nn.sigmoid(gd) @ w_g2.astype(f32)
    hs = lambda t: t.reshape(B, T, RWKV_HEADS, HEAD_DIM)
    kk = hs(k * k_k.astype(f32))
    kk = kk / jnp.maximum(jnp.linalg.norm(kk, axis=-1, keepdims=True), L2_EPS)
    k = k * (1.0 + (a - 1.0) * k_a.astype(f32))
    r_h, k_h, v_h, a_h = hs(r), hs(k), hs(v), hs(a)
    y, wkv = wkv_scan(r_h, hs(decay), k_h, v_h, -kk, kk * a_h, wkv_prev.astype(f32))
    mean = jnp.mean(y, axis=-1, keepdims=True)
    var = jnp.mean(jnp.square(y - mean), axis=-1, keepdims=True)
    y = ((y - mean) * lax.rsqrt(var + LNX_EPS)).reshape(B, T, MAIN_WIDTH) * lnx_w.astype(f32) + lnx_b.astype(f32)
    bonus = jnp.sum(r_h * k_h * r_k.astype(f32), axis=-1, keepdims=True) * v_h
    out = (y + bonus.reshape(B, T, MAIN_WIDTH)) * g
    return out.astype(p.dtype), p[:, -1], wkv.astype(wkv_prev.dtype)


def memory_kv(mem, g_norm, w_kv, g_knorm):
    B, M, _ = mem.shape
    kv = rms_norm(mem, g_norm) @ w_kv
    k = rms_norm(kv[..., :MEM_WIDTH].reshape(B, M, MEM_HEADS, HEAD_DIM), g_knorm)
    v = kv[..., MEM_WIDTH:].reshape(B, M, MEM_HEADS, HEAD_DIM)
    return k, v


def memory_attention(q, g_qnorm, mem_k, mem_v):
    B, T, _ = q.shape
    qh = rms_norm(q.reshape(B, T, MEM_HEADS, HEAD_DIM), g_qnorm)
    s = jnp.einsum('bthd,bmhd->bhtm', qh, mem_k, preferred_element_type=jnp.float32) * ATTN_SCALE
    p = jax.nn.softmax(s, axis=-1).astype(mem_v.dtype)
    return jnp.einsum('bhtm,bmhd->bthd', p, mem_v).reshape(B, T, MEM_WIDTH)


def sink_attention(q, k, v, mask, sinks):
    s = jnp.einsum('...qhgd,...khd->...hgqk', q, k, preferred_element_type=jnp.float32) * ATTN_SCALE
    s = jnp.where(mask[..., None, None, :, :], s, -jnp.inf)
    sink = sinks.astype(jnp.float32).reshape(SWA_KV_HEADS, SWA_GROUP, 1, 1)
    m = jnp.maximum(jnp.max(s, axis=-1, keepdims=True), sink)
    p = jnp.exp(s - m)
    p = p / (jnp.sum(p, axis=-1, keepdims=True) + jnp.exp(sink - m))
    return jnp.einsum('...hgqk,...khd->...qhgd', p.astype(v.dtype), v)


def swa_prompt_context(k, v):
    B, T = k.shape[:2]
    nb = T // BLOCK
    def band(t):
        tr = jnp.concatenate([jnp.zeros_like(t[:, :BLOCK]), t], axis=1)
        tr = tr.reshape(B, nb + 1, BLOCK, SWA_KV_HEADS, HEAD_DIM)
        return jnp.concatenate([tr[:, :-1], tr[:, 1:]], axis=2)
    kb, vb = band(k), band(v)
    blk = jnp.arange(nb)[:, None] * BLOCK
    qpos = blk + jnp.arange(BLOCK)[None, :]
    kpos = blk - BLOCK + jnp.arange(2 * BLOCK)[None, :]
    rel = qpos[:, :, None] - kpos[:, None, :]
    mask = (rel >= 0) & (rel < WINDOW) & (kpos[:, None, :] >= 0)
    def attend(q, sinks):
        qb = q.reshape(B, nb, BLOCK, SWA_KV_HEADS, SWA_GROUP, HEAD_DIM)
        return sink_attention(qb, kb, vb, mask, sinks).reshape(B, T, MAIN_WIDTH)
    win = min(WINDOW, T)
    return attend, k[:, T - win:], v[:, T - win:]


def swa_sample_context(k, v, k_buf, v_buf):
    B, T = k.shape[:2]
    W = k_buf.shape[1]
    kc = jnp.concatenate([k_buf.astype(k.dtype), k], axis=1)
    vc = jnp.concatenate([v_buf.astype(v.dtype), v], axis=1)
    qpos = PAST_LEN + jnp.arange(T)
    kpos = PAST_LEN - W + jnp.arange(W + T)
    rel = qpos[:, None] - kpos[None, :]
    mask = (rel >= 0) & (rel < WINDOW)
    def attend(q, sinks):
        qh = q.reshape(B, T, SWA_KV_HEADS, SWA_GROUP, HEAD_DIM)
        return sink_attention(qh, kc, vc, mask, sinks).reshape(B, T, MAIN_WIDTH)
    return attend, kc[:, T:], vc[:, T:]


def trunk(x, pos, mem_k, mem_v, shift0, wkv0, make_swa, *, norm_mix, norm_mlp, w_out, w_up, w_down,
          mem_qnorm, w_in_a, shift_mu, w_w2, w0, w_a2, a0, w_g2, k_k, k_a, r_k, lnx_w, lnx_b,
          w_in_b, swa_qnorm, sinks, kv_norm, w_kv, swa_knorm):
    B, T, _ = x.shape
    h = x
    new_shift, new_wkv = [], []
    attend = k_state = v_state = None
    for l in range(DEPTH):
        hn = rms_norm(h, norm_mix[l])
        if l < N_A:
            proj = hn @ w_in_a[l]
            main, sh, st = rwkv_time_mix(proj[..., :RWKV_COLS], shift0[l], wkv0[l], shift_mu[l], w_w2[l],
                                         w0[l], w_a2[l], a0[l], w_g2[l], k_k[l], k_a[l], r_k[l],
                                         lnx_w[l], lnx_b[l])
            new_shift.append(sh)
            new_wkv.append(st)
            q_mem = proj[..., RWKV_COLS:]
        else:
            j = l - N_A
            proj = hn @ w_in_b[j]
            q = rms_norm(proj[..., :MAIN_WIDTH].reshape(B, T, SWA_Q_HEADS, HEAD_DIM), swa_qnorm[j])
            main = attend(rope(q, pos), sinks[j])
            q_mem = proj[..., MAIN_WIDTH:]
        mem_o = memory_attention(q_mem, mem_qnorm[l], mem_k[l], mem_v[l])
        h = h + jnp.concatenate([main, mem_o], axis=-1) @ w_out[l]
        hn = rms_norm(h, norm_mlp[l])
        h = h + jnp.square(jax.nn.relu(hn @ w_up[l])) @ w_down[l]
        if l == N_A - 1:
            kv = rms_norm(h, kv_norm) @ w_kv
            k_sh = rope(rms_norm(kv[..., :KV_WIDTH].reshape(B, T, SWA_KV_HEADS, HEAD_DIM), swa_knorm), pos)
            v_sh = kv[..., KV_WIDTH:].reshape(B, T, SWA_KV_HEADS, HEAD_DIM)
            attend, k_state, v_state = make_swa(k_sh, v_sh)
    return h, jnp.stack(new_shift), jnp.stack(new_wkv), k_state, v_state


def setup_inputs(seed: int = 0) -> dict:
    key = jax.random.key(seed)
    ks = iter(jax.random.split(key, 48))
    def nrm(shape, scale=1.0):
        return jax.random.normal(next(ks), shape, jnp.float32) * scale
    def gain(shape):
        return 1.0 + nrm(shape, 0.05)
    def unif(shape, lo, hi):
        return jax.random.uniform(next(ks), shape, jnp.float32, lo, hi)
    win = min(WINDOW, PAST_LEN)
    return {
        "x_prompt": nrm((BATCH, SEQ, D_MODEL)),
        "x_sample": nrm((DEC_BATCH, DEC_SEQ, D_MODEL)),
        "state_rwkv_shift": nrm((N_A, DEC_BATCH, RWKV_COLS)),
        "state_rwkv_wkv": nrm((N_A, DEC_BATCH, RWKV_HEADS, HEAD_DIM, HEAD_DIM), 0.5),
        "cache_swa_k": nrm((DEC_BATCH, win, SWA_KV_HEADS, HEAD_DIM)),
        "cache_swa_v": nrm((DEC_BATCH, win, SWA_KV_HEADS, HEAD_DIM)),
        "cache_mem_k": nrm((DEPTH, DEC_BATCH, N_MEM, MEM_HEADS, HEAD_DIM)),
        "cache_mem_v": nrm((DEPTH, DEC_BATCH, N_MEM, MEM_HEADS, HEAD_DIM)),
        "mem_prompt": nrm((BATCH, N_MEM, D_MODEL)),
        "norm_mix": gain((DEPTH, D_MODEL)),
        "norm_mlp": gain((DEPTH, D_MODEL)),
        "w_out": nrm((DEPTH, MIX_WIDTH, D_MODEL), MIX_WIDTH ** -0.5),
        "w_up": nrm((DEPTH, D_MODEL, D_FF), D_MODEL ** -0.5),
        "w_down": nrm((DEPTH, D_FF, D_MODEL), D_FF ** -0.5),
        "mem_norm": gain((DEPTH, D_MODEL)),
        "w_mem_kv": nrm((DEPTH, D_MODEL, 2 * MEM_WIDTH), D_MODEL ** -0.5),
        "mem_qnorm": gain((DEPTH, HEAD_DIM)),
        "mem_knorm": gain((DEPTH, HEAD_DIM)),
        "w_in_a": nrm((N_A, D_MODEL, A_IN_COLS), D_MODEL ** -0.5),
        "shift_mu": unif((N_A, RWKV_COLS), 0.0, 1.0),
        "w_w2": nrm((N_A, DECAY_LORA, MAIN_WIDTH), 0.1),
        "w0": unif((N_A, MAIN_WIDTH), -6.5, -1.5),
        "w_a2": nrm((N_A, AAA_LORA, MAIN_WIDTH), AAA_LORA ** -0.5),
        "a0": nrm((N_A, MAIN_WIDTH), 0.1),
        "w_g2": nrm((N_A, GATE_LORA, MAIN_WIDTH), GATE_LORA ** -0.5),
        "k_k": 0.85 + nrm((N_A, MAIN_WIDTH), 0.05),
        "k_a": gain((N_A, MAIN_WIDTH)),
        "r_k": nrm((N_A, RWKV_HEADS, HEAD_DIM), 0.1),
        "lnx_w": gain((N_A, MAIN_WIDTH)),
        "lnx_b": nrm((N_A, MAIN_WIDTH), 0.02),
        "w_in_b": nrm((N_B, D_MODEL, MIX_WIDTH), D_MODEL ** -0.5),
        "swa_qnorm": gain((N_B, HEAD_DIM)),
        "sinks": nrm((N_B, SWA_Q_HEADS)),
        "kv_norm": gain((D_MODEL,)),
        "w_kv": nrm((D_MODEL, 2 * KV_WIDTH), D_MODEL ** -0.5),
        "swa_knorm": gain((HEAD_DIM,)),
    }


def reference(x_prompt, x_sample, state_rwkv_shift, state_rwkv_wkv, cache_swa_k, cache_swa_v,
              cache_mem_k, cache_mem_v, mem_prompt,
              norm_mix, norm_mlp, w_out, w_up, w_down, mem_norm, w_mem_kv, mem_qnorm, mem_knorm,
              w_in_a, shift_mu, w_w2, w0, w_a2, a0, w_g2, k_k, k_a, r_k, lnx_w, lnx_b,
              w_in_b, swa_qnorm, sinks, kv_norm, w_kv, swa_knorm):
    run = functools.partial(
        trunk, norm_mix=norm_mix, norm_mlp=norm_mlp, w_out=w_out, w_up=w_up, w_down=w_down,
        mem_qnorm=mem_qnorm, w_in_a=w_in_a, shift_mu=shift_mu, w_w2=w_w2, w0=w0, w_a2=w_a2, a0=a0,
        w_g2=w_g2, k_k=k_k, k_a=k_a, r_k=r_k, lnx_w=lnx_w, lnx_b=lnx_b, w_in_b=w_in_b,
        swa_qnorm=swa_qnorm, sinks=sinks, kv_norm=kv_norm, w_kv=w_kv, swa_knorm=swa_knorm)

    B, T, _ = x_prompt.shape
    mem_kv_p = [memory_kv(mem_prompt, mem_norm[l], w_mem_kv[l], mem_knorm[l]) for l in range(DEPTH)]
    p_mem_k = jnp.stack([kv[0] for kv in mem_kv_p])
    p_mem_v = jnp.stack([kv[1] for kv in mem_kv_p])
    shift0 = jnp.zeros((N_A, B, RWKV_COLS), x_prompt.dtype)
    wkv0 = jnp.zeros((N_A, B, RWKV_HEADS, HEAD_DIM, HEAD_DIM), x_prompt.dtype)
    y_prompt, p_shift, p_wkv, p_swa_k, p_swa_v = run(
        x_prompt, jnp.arange(T), p_mem_k, p_mem_v, shift0, wkv0, swa_prompt_context)

    Ts = x_sample.shape[1]
    sample_ctx = functools.partial(swa_sample_context, k_buf=cache_swa_k, v_buf=cache_swa_v)
    y_sample, s_shift, s_wkv, s_swa_k, s_swa_v = run(
        x_sample, PAST_LEN + jnp.arange(Ts), cache_mem_k, cache_mem_v, state_rwkv_shift, state_rwkv_wkv,
        sample_ctx)

    return (y_prompt, y_sample, p_shift, p_wkv, p_swa_k, p_swa_v, p_mem_k, p_mem_v,
            s_shift, s_wkv, s_swa_k, s_swa_v)
```

```cpp
#include <hip/hip_runtime.h>
#include <cstdio>
#include <cstdint>
namespace pg8 {
#define PG8_LAS __attribute__((address_space(3)))
typedef unsigned short bf16_t;
typedef short bf16x8 __attribute__((ext_vector_type(8)));
typedef float f32x4 __attribute__((ext_vector_type(4)));
typedef unsigned u32x4 __attribute__((ext_vector_type(4)));
constexpr int BM = 256, BK = 64, HALF = 128, HTB = HALF * BK * 2  , STAGE_BYTES = 8 * HTB, NXCD = 8, WGM = 8;

__host__ __device__ __forceinline__ int lds_byte(int r, int c) { const int st = (r >> 4) * 2 + (c >> 5), rr = r & 15, cc = c & 31, ob = rr * 64 + cc * 2; return st * 1024 + (ob ^ (((ob >> 9) & 1) << 5)); }
__host__ __device__ __forceinline__ void stage_rc(int b, int& R, int& C) { const int st = b / 1024, sb = b % 1024, swz = sb ^ (((sb >> 9) & 1) << 5); R = (st >> 1) * 16 + swz / 64; C = (st & 1) * 32 + (swz % 64) / 2; }
__host__ __device__ __forceinline__ int perm32(int rho) { const int n = rho >> 4, i = rho & 15; return 8 * (i >> 2) + 4 * n + (i & 3); }

struct Unit { int pm, pn; };
struct Gemm { const bf16_t* A; const bf16_t* Bt; int M, N, K; };

struct StaticOrder {
    int nM, nN, nwg, G, c;
    __host__ __device__ void init(int M, int N, int G_, int c_) { nM = M / BM; nN = N / BM; nwg = nM * nN; G = G_; c = c_; }
    __host__ __device__ bool next(int i, Unit& u) const {
        const long L = (long)i * G + c; if (L >= nwg) return false;
        int wgid = (int)L; { const int q = nwg / NXCD, r = nwg % NXCD, xcd = wgid % NXCD, off = wgid / NXCD; wgid = (xcd < r ? xcd * (q + 1) : r * (q + 1) + (xcd - r) * q) + off; }
        const int nig = WGM * nN, gid = wgid / nig, fm = gid * WGM, gsz = (nM - fm) < WGM ? (nM - fm) : WGM;
        u.pm = fm + ((wgid % nig) % gsz); u.pn = (wgid % nig) / gsz; return true;
    }
    __device__ __forceinline__ void a_ready(const Unit&) const {}
    __device__ __forceinline__ void done(const Unit&) const {}
};


typedef float f32x2_t __attribute__((ext_vector_type(2))); typedef __bf16 bf16x2_t __attribute__((ext_vector_type(2)));
__device__ __forceinline__ unsigned cvt_pk_bf16(float lo, float hi) { f32x2_t v = {lo, hi}; bf16x2_t b = __builtin_convertvector(v, bf16x2_t); return __builtin_bit_cast(unsigned, b); }
__device__ __forceinline__ u32x4 pack8(f32x4 v0, f32x4 v1) { u32x4 w; w.x = cvt_pk_bf16(v0[0], v0[1]); w.y = cvt_pk_bf16(v0[2], v0[3]); w.z = cvt_pk_bf16(v1[0], v1[1]); w.w = cvt_pk_bf16(v1[2], v1[3]); return w; }
__device__ __forceinline__ float hsum4(f32x4 a) { return (a[0] + a[1]) + (a[2] + a[3]); }
__device__ __forceinline__ float row_rstd(const float* ssq, int row) {
    const f32x4* p = (const f32x4*)(ssq + (size_t)row * 16);
    const f32x4 a = p[0], b = p[1], c = p[2], d = p[3];
    const float s = (hsum4(a) + hsum4(b)) + (hsum4(c) + hsum4(d));
    return rsqrtf(s * (1.0f / 1024.0f) + 1e-6f);
}
template <int ACT> struct EpiScaleBf16 {
    static constexpr bool PERM = true, AFTER_DRAIN = false;
    bf16_t* O; int ldc; const float* ssq;
    __device__ __forceinline__ void operator()(const f32x4 (&acc)[2][2][4][2], const Unit& u, int wr, int wc, int fr_, int fq_) const {
        int fr = fr_, fq = fq_; asm volatile("" : "+v"(fr), "+v"(fq));
        const int row0 = u.pm * BM + wr * 64 + fr, col0 = u.pn * BM + wc * 32 + 8 * fq;
#pragma unroll
        for (int ai = 0; ai < 2; ++ai)
#pragma unroll
            for (int m = 0; m < 4; ++m) { const int row = row0 + ai * HALF + m * 16; const float rs = row_rstd(ssq, row); bf16_t* rowp = O + (size_t)row * ldc + col0;
#pragma unroll
                for (int bj = 0; bj < 2; ++bj) { f32x4 v0 = acc[ai][bj][m][0] * rs, v1 = acc[ai][bj][m][1] * rs;
                    if (ACT == 1) {
#pragma unroll
                        for (int e = 0; e < 4; ++e) { const float a = fmaxf(v0[e], 0.f), b = fmaxf(v1[e], 0.f); v0[e] = a * a; v1[e] = b * b; } }
                    *(u32x4*)(rowp + bj * HALF) = pack8(v0, v1); } }
    }
};
struct EpiResid {
    static constexpr bool PERM = true, AFTER_DRAIN = false;
    const float* base; const float* base2; int split; float* out; bf16_t* hb; float* ssq_out;
    __device__ __forceinline__ void operator()(const f32x4 (&acc)[2][2][4][2], const Unit& u, int wr, int wc, int fr_, int fq_) const {
        int fr = fr_, fq = fq_; asm volatile("" : "+v"(fr), "+v"(fq));
        const int row0 = u.pm * BM + wr * 64 + fr, col0 = u.pn * BM + wc * 32 + 8 * fq;
#pragma unroll
        for (int ai = 0; ai < 2; ++ai)
#pragma unroll
            for (int m = 0; m < 4; ++m) { const int row = row0 + ai * HALF + m * 16;
                const float* bp = (row < split ? base + (size_t)row * 1024 : base2 + (size_t)(row - split) * 1024) + col0;
                float* op = out + (size_t)row * 1024 + col0; float ss = 0.f;
#pragma unroll
                for (int bj = 0; bj < 2; ++bj) { const f32x4 b0 = *(const f32x4*)(bp + bj * HALF), b1 = *(const f32x4*)(bp + bj * HALF + 4);
                    const f32x4 h0 = b0 + acc[ai][bj][m][0], h1 = b1 + acc[ai][bj][m][1];
                    *(f32x4*)(op + bj * HALF) = h0; *(f32x4*)(op + bj * HALF + 4) = h1;
                    if (hb) *(u32x4*)(hb + (size_t)row * 1024 + col0 + bj * HALF) = pack8(h0, h1);
                    ss += hsum4(h0 * h0) + hsum4(h1 * h1); }
                if (ssq_out) { ss += __shfl_xor(ss, 16); ss += __shfl_xor(ss, 32); if (fq == 0) ssq_out[(size_t)row * 16 + u.pn * 4 + wc] = ss; }
                if (m & 1) asm volatile("" ::: "memory"); }
    }
};
template <class Epi, class Sched, bool ALIGN_EPI = false, bool SP2 = false>
__device__ __forceinline__ void gemm_phase(PG8_LAS unsigned char* lds, const Gemm g, const Sched& S, const Epi& E, int wid_in, int lane_in) {
    const int wid = wid_in, lane = lane_in, tid = wid * 64 + lane, wr = wid >> 2, wc = wid & 3, fr = lane & 15, fq = lane >> 4;
    const int K = g.K, nt = K / BK;
    unsigned voffA[2], voffB[2];
#pragma unroll
    for (int i = 0; i < 2; ++i) { int R, C; stage_rc(tid * 16 + i * 8192, R, C); const int Rb = Epi::PERM ? ((R & ~31) + perm32(R & 31)) : R;
        voffA[i] = (unsigned)(R * K + C) * 2u; voffB[i] = (unsigned)(Rb * K + C) * 2u; }
    const size_t kstep = (size_t)(BK * 2);
    const size_t hstep = (size_t)HALF * K * 2;
    const size_t tstep = 2 * hstep;
    const unsigned ldsw = (unsigned)wid * 1024u;
    const int aoff = lds_byte(wr * 64 + fr, fq * 8), boff = lds_byte(wc * 32 + fr, fq * 8);
#define PG8_SA(b, h) (((b) * 2 + (h)) * HTB)
#define PG8_SB(b, h) ((4 + (b) * 2 + (h)) * HTB)
#define PG8_STAGE(bufoff, gbase, voff) do { _Pragma("unroll") for (int _i = 0; _i < 2; ++_i) \
        __builtin_amdgcn_global_load_lds((const unsigned*)((const char*)(gbase) + (voff)[_i]), (PG8_LAS unsigned*)(lds + (bufoff) + ldsw + _i * 8192), 16, 0, 0); } while (0)
#define PG8_LDA(dst, b, h) do { _Pragma("unroll") for (int m = 0; m < 4; ++m) _Pragma("unroll") for (int k = 0; k < 2; ++k) dst[m][k] = *(const PG8_LAS bf16x8*)(lds + PG8_SA(b, h) + aoff + m * 2048 + k * 1024); } while (0)
#define PG8_LDB(dst, b, h) do { _Pragma("unroll") for (int n = 0; n < 2; ++n) _Pragma("unroll") for (int k = 0; k < 2; ++k) dst[n][k] = *(const PG8_LAS bf16x8*)(lds + PG8_SB(b, h) + boff + n * 2048 + k * 1024); } while (0)
#define PG8_MMA(ai, bj, At, Bt) do { __builtin_amdgcn_s_setprio(1); _Pragma("unroll") for (int m = 0; m < 4; ++m) _Pragma("unroll") for (int n = 0; n < 2; ++n) _Pragma("unroll") for (int k = 0; k < 2; ++k) \
        acc[ai][bj][m][n] = __builtin_amdgcn_mfma_f32_16x16x32_bf16(Bt[n][k], At[m][k], acc[ai][bj][m][n], 0, 0, 0); __builtin_amdgcn_s_setprio(0); } while (0)
#define PG8_WAIT_V(n) asm volatile("s_waitcnt vmcnt(" #n ")" ::: "memory")
#define PG8_WAIT_L(n) asm volatile("s_waitcnt lgkmcnt(" #n ")" ::: "memory")
#define PG8_BAR __builtin_amdgcn_s_barrier()
#define PG8_SCHED __builtin_amdgcn_sched_barrier(0)
    Unit cur, nxt; int ui = 0;
    if (!S.next(0, cur)) return;
    f32x4 acc[2][2][4][2];
#pragma unroll
    for (int a = 0; a < 2; ++a)
#pragma unroll
        for (int b = 0; b < 2; ++b)
#pragma unroll
            for (int m = 0; m < 4; ++m)
#pragma unroll
                for (int n = 0; n < 2; ++n) acc[a][b][m][n] = (f32x4){0.f, 0.f, 0.f, 0.f};
    bf16x8 At[4][2], B0[2][2], B1[2][2];
    const char* cA = (const char*)g.A + (size_t)cur.pm * tstep; const char* cB = (const char*)g.Bt + (size_t)cur.pn * tstep;
    S.a_ready(cur);
    if constexpr (SP2) {
        PG8_STAGE(PG8_SB(0, 0), cB, voffB); PG8_STAGE(PG8_SB(0, 1), cB + hstep, voffB); PG8_STAGE(PG8_SA(0, 0), cA, voffA); PG8_STAGE(PG8_SA(0, 1), cA + hstep, voffA);
        if (wr == 1) PG8_BAR;
        PG8_WAIT_V(2); PG8_BAR;
        PG8_STAGE(PG8_SB(1, 0), cB + kstep, voffB); PG8_STAGE(PG8_SA(1, 0), cA + kstep, voffA); PG8_STAGE(PG8_SB(1, 1), cB + hstep + kstep, voffB);
        PG8_WAIT_V(6); PG8_BAR;
    } else {
        PG8_STAGE(PG8_SB(0, 0), cB, voffB); PG8_STAGE(PG8_SA(0, 0), cA, voffA); PG8_STAGE(PG8_SB(0, 1), cB + hstep, voffB); PG8_STAGE(PG8_SA(0, 1), cA + hstep, voffA);
        if (wr == 1) PG8_BAR;
        PG8_WAIT_V(4); PG8_BAR;
        PG8_STAGE(PG8_SB(1, 0), cB + kstep, voffB); PG8_STAGE(PG8_SA(1, 0), cA + kstep, voffA); PG8_STAGE(PG8_SB(1, 1), cB + hstep + kstep, voffB);
        PG8_WAIT_V(6); PG8_BAR;
    }
    for (;;) {
        const bool has_next = S.next(ui + 1, nxt);
        const char* nA = has_next ? (const char*)g.A + (size_t)nxt.pm * tstep : cA; const char* nB = has_next ? (const char*)g.Bt + (size_t)nxt.pn * tstep : cB;
        for (int t = 0; t < nt; t += 2) {
            const bool last = (t == nt - 2);
            const char* a1 = cA + (size_t)(t + 1) * kstep;
            const char* a2 = last ? nA : cA + (size_t)(t + 2) * kstep; const char* b2 = last ? nB : cB + (size_t)(t + 2) * kstep;
            const char* a3 = a2 + kstep; const char* b3 = b2 + kstep;
            if (last && has_next) S.a_ready(nxt);
            if constexpr (SP2) {
            PG8_LDB(B0, 0, 0); PG8_LDB(B1, 0, 1); PG8_SCHED; PG8_LDA(At, 0, 0); PG8_STAGE(PG8_SA(1, 1), a1 + hstep, voffA);
            PG8_WAIT_V(8); PG8_WAIT_L(0); PG8_BAR; PG8_MMA(0, 0, At, B0); PG8_MMA(0, 1, At, B1); PG8_BAR; PG8_SCHED;
            PG8_LDA(At, 0, 1); PG8_STAGE(PG8_SB(0, 0), b2, voffB); PG8_STAGE(PG8_SB(0, 1), b2 + hstep, voffB); PG8_STAGE(PG8_SA(0, 0), a2, voffA);
            PG8_WAIT_V(8); PG8_WAIT_L(0); PG8_BAR; PG8_MMA(1, 0, At, B0); PG8_MMA(1, 1, At, B1); PG8_BAR; PG8_SCHED;
            PG8_LDB(B0, 1, 0); PG8_LDB(B1, 1, 1); PG8_SCHED; PG8_LDA(At, 1, 0); PG8_STAGE(PG8_SA(0, 1), a2 + hstep, voffA);
            PG8_WAIT_V(8); PG8_WAIT_L(0); PG8_BAR; PG8_MMA(0, 0, At, B0); PG8_MMA(0, 1, At, B1); PG8_BAR; PG8_SCHED;
            PG8_LDA(At, 1, 1); PG8_STAGE(PG8_SB(1, 0), b3, voffB); PG8_STAGE(PG8_SB(1, 1), b3 + hstep, voffB); PG8_STAGE(PG8_SA(1, 0), a3, voffA);
            PG8_WAIT_V(8); PG8_WAIT_L(0); PG8_BAR; PG8_MMA(1, 0, At, B0); PG8_MMA(1, 1, At, B1); PG8_BAR; PG8_SCHED;
            } else {
            PG8_LDB(B0, 0, 0); PG8_SCHED; PG8_LDA(At, 0, 0); PG8_STAGE(PG8_SA(1, 1), a1 + hstep, voffA);
            PG8_WAIT_L(8); PG8_BAR; PG8_WAIT_L(0); PG8_MMA(0, 0, At, B0); PG8_BAR; PG8_SCHED;
            PG8_LDB(B1, 0, 1); PG8_STAGE(PG8_SB(0, 0), b2, voffB);
            PG8_BAR; PG8_WAIT_L(0); PG8_MMA(0, 1, At, B1); PG8_BAR;
            PG8_LDA(At, 0, 1); PG8_STAGE(PG8_SA(0, 0), a2, voffA);
            PG8_BAR; PG8_WAIT_L(0); PG8_MMA(1, 0, At, B0); PG8_BAR; PG8_SCHED;
            PG8_STAGE(PG8_SB(0, 1), b2 + hstep, voffB);
            PG8_WAIT_V(6); PG8_BAR; PG8_MMA(1, 1, At, B1); PG8_BAR;
            PG8_LDB(B0, 1, 0); PG8_SCHED; PG8_LDA(At, 1, 0); PG8_STAGE(PG8_SA(0, 1), a2 + hstep, voffA);
            PG8_WAIT_L(8); PG8_BAR; PG8_WAIT_L(0); PG8_MMA(0, 0, At, B0); PG8_BAR; PG8_SCHED;
            PG8_LDB(B1, 1, 1); PG8_STAGE(PG8_SB(1, 0), b3, voffB);
            PG8_BAR; PG8_WAIT_L(0); PG8_MMA(0, 1, At, B1); PG8_BAR;
            PG8_LDA(At, 1, 1); PG8_STAGE(PG8_SA(1, 0), a3, voffA);
            PG8_BAR; PG8_WAIT_L(0); PG8_MMA(1, 0, At, B0); PG8_BAR; PG8_SCHED;
            PG8_STAGE(PG8_SB(1, 1), b3 + hstep, voffB);
            PG8_WAIT_V(6); PG8_BAR; PG8_MMA(1, 1, At, B1); PG8_BAR;
            }
        }
        if constexpr (ALIGN_EPI) { if (wr == 0) PG8_BAR; }
        if constexpr (!Epi::AFTER_DRAIN) { E(acc, cur, wr, wc, fr, fq); S.done(cur); }
        if (!has_next) break;
#pragma unroll
        for (int a = 0; a < 2; ++a)
#pragma unroll
            for (int b = 0; b < 2; ++b)
#pragma unroll
                for (int m = 0; m < 4; ++m)
#pragma unroll
                    for (int n = 0; n < 2; ++n) acc[a][b][m][n] = (f32x4){0.f, 0.f, 0.f, 0.f};
        cur = nxt; cA = nA; cB = nB; ++ui;
        if constexpr (ALIGN_EPI) { if (wr == 1) PG8_BAR; }
    }
    PG8_WAIT_V(0);
    if constexpr (!ALIGN_EPI) { if (wr == 0) PG8_BAR; }
    PG8_BAR;
    if constexpr (Epi::AFTER_DRAIN) { E.fused(acc, cur, wr, wc, fr, fq, lds, wid, lane); S.done(cur); }
#undef PG8_SA
#undef PG8_SB
#undef PG8_STAGE
#undef PG8_LDA
#undef PG8_LDB
#undef PG8_MMA
#undef PG8_WAIT_V
#undef PG8_WAIT_L
#undef PG8_BAR
#undef PG8_SCHED
}
}

constexpr int NWAVES = 8;
#ifndef MK_ONE_LAUNCH
#define MK_ONE_LAUNCH 1
#endif
constexpr int DM = 1024, RP = 16384  , RS = 512  , R = RP + RS, T = 8192, NB = 2, SB = 128, ST = 4;
constexpr int NCOLA = 2816, RWKV_COLS = 2560, NH = 12, HD = 64, FF = 4096, NCOLB = 1536, NMEM = 256;
constexpr int NCHUNK = RP / 64  , NUNIT = NCHUNK * NH  ;
constexpr float C2Q = 0.125f * 1.4426950408889634f;
constexpr float LOG2E = 1.4426950408889634f;
enum { I_XP = 0, I_XS, I_SSHIFT, I_SWKV, I_CSK, I_CSV, I_CMK, I_CMV, I_MEMP, I_NMIX, I_NMLP, I_WOUT, I_WUP, I_WDN, I_MNORM, I_WMKV, I_MQN, I_MKN,
       I_WINA, I_MU, I_WW2, I_W0, I_WA2, I_A0, I_WG2, I_KK, I_KA, I_RK, I_LNW, I_LNB, I_WINB, I_QN, I_SINKS, I_KVN, I_WKV, I_KN, N_IN };
constexpr size_t O_Y = 0, O_PSHIFT = (size_t)R * DM, O_PWKV = O_PSHIFT + 2 * RWKV_COLS, O_PSK = O_PWKV + 2 * 12 * 4096, O_PSV = O_PSK + 2 * 128 * 256,
                 O_PMK = O_PSV + 2 * 128 * 256, O_PMV = O_PMK + 2 * 2 * 256 * 256, O_SSHIFT = O_PMV + 2 * 2 * 256 * 256, O_SWKV = O_SSHIFT + (size_t)SB * RWKV_COLS,
                 O_SSK = O_SWKV + (size_t)SB * 12 * 4096, O_SSV = O_SSK + (size_t)SB * 128 * 256, O_END = O_SSV + (size_t)SB * 128 * 256;
constexpr size_t al256(size_t x) { return (x + 255) & ~(size_t)255; }
constexpr size_t WS_CTL = 0, CTL_ZERO_BYTES = 1u << 20;
constexpr size_t WS_WA = CTL_ZERO_BYTES;
constexpr size_t WS_WOUT = WS_WA + (size_t)NCOLA * DM * 2;
constexpr size_t WS_WUP = WS_WOUT + (size_t)2 * DM * DM * 2;
constexpr size_t WS_WDN = WS_WUP + (size_t)2 * FF * DM * 2;
constexpr size_t WS_WB = WS_WDN + (size_t)2 * FF * DM * 2;
constexpr size_t WS_WM = WS_WB + (size_t)NCOLB * DM * 2;
constexpr size_t WS_WW2 = WS_WM + (size_t)DM * DM * 2;
constexpr size_t WS_WA2 = WS_WW2 + (size_t)768 * 64 * 2;
constexpr size_t WS_WG2 = WS_WA2 + (size_t)768 * 64 * 2;
constexpr size_t WS_ROPE = WS_WG2 + (size_t)768 * 128 * 2;
constexpr size_t WS_SSQ = al256(WS_ROPE + (size_t)8196 * 64 * 4);
constexpr size_t WS_SSQM = WS_SSQ + (size_t)R * 16 * 4;
constexpr size_t WS_MB = WS_SSQM + (size_t)512 * 16 * 4;
constexpr size_t WS_MK = WS_MB + (size_t)512 * DM * 2;
constexpr size_t WS_MVT = WS_MK + (size_t)2 * 2 * 4 * 256 * 64 * 2;
constexpr size_t WS_HB = WS_MVT + (size_t)2 * 2 * 4 * 256 * 64 * 2;
constexpr size_t WS_MIX = WS_HB + (size_t)R * DM * 2;
constexpr size_t WS_BIG = WS_MIX + (size_t)R * DM * 2;
constexpr size_t WS_PROJ = WS_BIG;
constexpr size_t WS_REC = WS_PROJ + (size_t)R * NCOLA * 2;
constexpr size_t REC_BYTES = 5 * 8192;
constexpr size_t WS_END0 = WS_REC + (size_t)NUNIT * REC_BYTES;
constexpr size_t WS_H = WS_BIG;
constexpr size_t WS_END1 = WS_H + (size_t)R * FF * 2;
constexpr size_t WS_Q1 = WS_BIG;
constexpr size_t WS_K1 = WS_Q1 + (size_t)R * DM * 2;
constexpr size_t WS_V1 = WS_K1 + (size_t)R * 256 * 2;
constexpr size_t WS_VT1 = WS_V1 + (size_t)R * 256 * 2;
constexpr size_t WS_END = WS_END0 > WS_END1 ? WS_END0 : WS_END1;
static_assert(WS_VT1 + (size_t)2 * 4 * 64 * 8192 * 2 <= WS_END, "ws map");
constexpr int CW_BAR = 4096;
constexpr int RING_OFF = 0, RING_BYTES = 131072, PREP_HALF = 73728, LDSCTL_OFF = 147456, MISC_OFF = LDSCTL_OFF + 320, WTOT_OFF = LDSCTL_OFF + 1024, LDS_BYTES = LDSCTL_OFF + 4096;

#define GAS __attribute__((address_space(1)))
#define LAS __attribute__((address_space(3)))
typedef unsigned short bf16;
typedef unsigned v4u __attribute__((ext_vector_type(4)));
typedef unsigned v2u __attribute__((ext_vector_type(2)));
typedef float f32x4 __attribute__((ext_vector_type(4)));
typedef float f32x16 __attribute__((ext_vector_type(16)));
typedef short bf16x8 __attribute__((ext_vector_type(8)));
typedef short bf16x4 __attribute__((ext_vector_type(4)));
typedef GAS unsigned gu32;
#define RLX_AGENT __ATOMIC_RELAXED, __HIP_MEMORY_SCOPE_AGENT
#define LDS_WAIT() asm volatile("s_waitcnt lgkmcnt(0)" ::: "memory")
#define VM_WAIT() asm volatile("s_waitcnt vmcnt(0)" ::: "memory")
using pg8::cvt_pk_bf16;
__device__ __forceinline__ int mk_lane() { int l; asm volatile("v_mbcnt_lo_u32_b32 %0, -1, 0\n\tv_mbcnt_hi_u32_b32 %0, -1, %0" : "=v"(l)); return l; }
__device__ __forceinline__ float bf2f(unsigned v) { return __uint_as_float(v << 16); }
__device__ __forceinline__ float bflo(unsigned w) { return __uint_as_float(w << 16); }
__device__ __forceinline__ float bfhi(unsigned w) { return __uint_as_float(w & 0xffff0000u); }
__device__ __forceinline__ bf16 f2bf(float f) { return (bf16)(cvt_pk_bf16(f, 0.f) & 0xffffu); }
__device__ __forceinline__ v2u pack4(f32x4 v) { v2u w; w.x = cvt_pk_bf16(v[0], v[1]); w.y = cvt_pk_bf16(v[2], v[3]); return w; }
__device__ __forceinline__ f32x4 unpack4(v2u w) { return (f32x4){bflo(w.x), bfhi(w.x), bflo(w.y), bfhi(w.y)}; }
__device__ __forceinline__ f32x4 mfma16(bf16x8 a, bf16x8 b, f32x4 c) { return __builtin_amdgcn_mfma_f32_16x16x32_bf16(a, b, c, 0, 0, 0); }
__device__ __forceinline__ f32x16 mfma32(bf16x8 a, bf16x8 b, f32x16 c) { return __builtin_amdgcn_mfma_f32_32x32x16_bf16(a, b, c, 0, 0, 0); }
__device__ __forceinline__ float wave_sum(float v) {
#pragma unroll
    for (int o = 1; o < 64; o <<= 1) v += __shfl_xor(v, o);
    return v;
}
__device__ __forceinline__ float wave_max(float v) {
#pragma unroll
    for (int o = 1; o < 64; o <<= 1) v = fmaxf(v, __shfl_xor(v, o));
    return v;
}
__device__ __forceinline__ float sum16(float v) {
#pragma unroll
    for (int o = 1; o < 16; o <<= 1) v += __shfl_xor(v, o);
    return v;
}
__device__ __forceinline__ float fsigmoid(float x) { return 1.0f / (1.0f + __expf(-x)); }
__device__ __forceinline__ float ftanh(float x) { const float e = __expf(2.0f * x); return 1.0f - 2.0f / (e + 1.0f); }
namespace pg8 {
__device__ __forceinline__ void head_norm(f32x4 (&x)[2][2], const float* gain, int fq) {
    float ss = 0.f;
#pragma unroll
    for (int bj = 0; bj < 2; ++bj)
#pragma unroll
        for (int n = 0; n < 2; ++n) ss += hsum4(x[bj][n] * x[bj][n]);
    ss += __shfl_xor(ss, 16); ss += __shfl_xor(ss, 32);
    const float rs = rsqrtf(ss * (1.0f / 64.0f) + 1e-6f);
#pragma unroll
    for (int bj = 0; bj < 2; ++bj)
#pragma unroll
        for (int n = 0; n < 2; ++n) { const f32x4 g = *(const f32x4*)(gain + 32 * bj + 8 * fq + 4 * n); x[bj][n] = x[bj][n] * rs * g; }
}
__device__ __forceinline__ void head_rope(f32x4 (&x)[2][2], const float* cs  , int fq) {
#pragma unroll
    for (int n = 0; n < 2; ++n) { const f32x4 t0 = *(const f32x4*)(cs + 2 * (8 * fq + 4 * n)), t1 = *(const f32x4*)(cs + 2 * (8 * fq + 4 * n) + 4);
        const f32x4 cc = {t0[0], t0[2], t1[0], t1[2]}, sn = {t0[1], t0[3], t1[1], t1[3]};
        const f32x4 x1 = x[0][n], x2 = x[1][n]; x[0][n] = x1 * cc - x2 * sn; x[1][n] = x2 * cc + x1 * sn; }
}
struct EpiL1 {
    static constexpr bool PERM = true, AFTER_DRAIN = false;
    unsigned char* ws; float* outp; const float* g_q; const float* g_mq; const float* g_k;
    __device__ __forceinline__ void operator()(const f32x4 (&acc)[2][2][4][2], const Unit& u, int wr, int wc, int fr_, int fq_) const {
        int fr = fr_, fq = fq_; asm volatile("" : "+v"(fr), "+v"(fq));
        const float* ssq = (const float*)(ws + WS_SSQ); const float* rope = (const float*)(ws + WS_ROPE); const float c2 = C2Q;
        bf16_t* Q1 = (bf16_t*)(ws + WS_Q1); bf16_t* K1 = (bf16_t*)(ws + WS_K1); bf16_t* V1 = (bf16_t*)(ws + WS_V1); bf16_t* VT1 = (bf16_t*)(ws + WS_VT1);
        float* p_k = outp + O_PSK; float* p_v = outp + O_PSV; float* s_k = outp + O_SSK; float* s_v = outp + O_SSV;
        const int H = u.pn * 4 + wc, row0 = u.pm * BM + wr * 64 + fr;
#pragma unroll
        for (int ai = 0; ai < 2; ++ai)
#pragma unroll
            for (int m = 0; m < 4; ++m) { const int row = row0 + ai * HALF + m * 16; const float rs = row_rstd(ssq, row);
                const int pidx = row < 16384 ? (row & 8191) : 8192 + ((row - 16384) & 3);
                f32x4 x[2][2];
#pragma unroll
                for (int bj = 0; bj < 2; ++bj)
#pragma unroll
                    for (int n = 0; n < 2; ++n) x[bj][n] = acc[ai][bj][m][n] * rs;
                if (H < 16) {
                    head_norm(x, H < 12 ? g_q : g_mq, fq);
                    if (H < 12) head_rope(x, rope + (size_t)pidx * 64, fq);
#pragma unroll
                    for (int bj = 0; bj < 2; ++bj) *(u32x4*)(Q1 + (size_t)row * 1024 + H * 64 + 32 * bj + 8 * fq) = pack8(x[bj][0] * c2, x[bj][1] * c2);
                } else {
                    const int kh = (H - 16) & 3; const bool isk = H < 20;
                    if (isk) { head_norm(x, g_k, fq); head_rope(x, rope + (size_t)pidx * 64, fq); }
                    bf16_t* dst = isk ? K1 : V1;
#pragma unroll
                    for (int bj = 0; bj < 2; ++bj) *(u32x4*)(dst + (size_t)row * 256 + kh * 64 + 32 * bj + 8 * fq) = pack8(x[bj][0], x[bj][1]);
                    if (!isk && row < 16384) {
                        const int b = row >> 13, t = row & 8191;
#pragma unroll
                        for (int bj = 0; bj < 2; ++bj)
#pragma unroll
                            for (int n = 0; n < 2; ++n)
#pragma unroll
                                for (int e = 0; e < 4; ++e) { const int d = 32 * bj + 8 * fq + 4 * n + e; VT1[((size_t)(b * 4 + kh) * 64 + d) * 8192 + t] = (bf16_t)(cvt_pk_bf16(x[bj][n][e], 0.f) & 0xffffu); } }
                    float* o = nullptr;
                    if (row < 16384) { const int b = row >> 13, t = row & 8191; if (t >= 8064) o = (isk ? p_k : p_v) + ((size_t)(b * 128 + (t - 8064)) * 4 + kh) * 64; }
                    else { const int b = (row - 16384) >> 2, i = (row - 16384) & 3; o = (isk ? s_k : s_v) + ((size_t)(b * 128 + 124 + i) * 4 + kh) * 64; }
                    if (o) {
#pragma unroll
                        for (int bj = 0; bj < 2; ++bj) { *(f32x4*)(o + 32 * bj + 8 * fq) = x[bj][0]; *(f32x4*)(o + 32 * bj + 8 * fq + 4) = x[bj][1]; } }
                }
                asm volatile("" ::: "memory");
            }
    }
};
struct EpiMemKV {
    static constexpr bool PERM = true, AFTER_DRAIN = false;
    unsigned char* ws; float* outp; const float* g_k  ;
    __device__ __forceinline__ void operator()(const f32x4 (&acc)[2][2][4][2], const Unit& u, int wr, int wc, int fr_, int fq_) const {
        int fr = fr_, fq = fq_; asm volatile("" : "+v"(fr), "+v"(fq));
        const float* ssq = (const float*)(ws + WS_SSQM); float* p_k = outp + O_PMK; float* p_v = outp + O_PMV; bf16_t* MK = (bf16_t*)(ws + WS_MK)  ; bf16_t* MVT = (bf16_t*)(ws + WS_MVT)  ;
        const int H = u.pn * 4 + wc, l = H >> 3, isv = (H >> 2) & 1, hh = H & 3, row0 = u.pm * BM + wr * 64 + fr;
#pragma unroll
        for (int ai = 0; ai < 2; ++ai)
#pragma unroll
            for (int m = 0; m < 4; ++m) { const int row = row0 + ai * HALF + m * 16; const float rs = row_rstd(ssq, row); const int b = row >> 8, mm = row & 255;
                f32x4 x[2][2];
#pragma unroll
                for (int bj = 0; bj < 2; ++bj)
#pragma unroll
                    for (int n = 0; n < 2; ++n) x[bj][n] = acc[ai][bj][m][n] * rs;
                if (!isv) head_norm(x, g_k + l * 64, fq);
                float* o = (isv ? p_v : p_k) + ((((size_t)l * 2 + b) * 256 + mm) * 4 + hh) * 64;
#pragma unroll
                for (int bj = 0; bj < 2; ++bj) { *(f32x4*)(o + 32 * bj + 8 * fq) = x[bj][0]; *(f32x4*)(o + 32 * bj + 8 * fq + 4) = x[bj][1]; }
                if (!isv) {
#pragma unroll
                    for (int bj = 0; bj < 2; ++bj) *(u32x4*)(MK + ((((size_t)l * 2 + b) * 4 + hh) * 256 + mm) * 64 + 32 * bj + 8 * fq) = pack8(x[bj][0], x[bj][1]);
                } else {
#pragma unroll
                    for (int bj = 0; bj < 2; ++bj)
#pragma unroll
                        for (int n = 0; n < 2; ++n)
#pragma unroll
                            for (int e = 0; e < 4; ++e) { const int d = 32 * bj + 8 * fq + 4 * n + e; MVT[((((size_t)l * 2 + b) * 4 + hh) * 64 + d) * 256 + mm] = (bf16_t)(cvt_pk_bf16(x[bj][n][e], 0.f) & 0xffffu); }
                }
                asm volatile("" ::: "memory");
            }
    }
};
}
#define XB_TMO      128
#define XB_XCNT(j)  (256  + 64 * (j))
#define XB_XSUB(j)  (1280 + 64 * (j))
#define XB_XGEN(j)  (2304 + 64 * (j))
#define XB_TOP      3328
#define XB_TOPGEN   3392
#define XCD_BAR_WORDS 3456
#define XB_SPIN_CAP (1u << 18)

__device__ __forceinline__ unsigned xb_ld(unsigned* p)              { return __hip_atomic_load(p, __ATOMIC_RELAXED, __HIP_MEMORY_SCOPE_AGENT); }
__device__ __forceinline__ unsigned xb_add(unsigned* p, unsigned v) { return __hip_atomic_fetch_add(p, v, __ATOMIC_RELAXED, __HIP_MEMORY_SCOPE_AGENT); }
__device__ __forceinline__ unsigned xb_xcc_id() { return (unsigned)__builtin_amdgcn_s_getreg((3 << 11) | 20) & 0xFu; }
#define XB_SPIN(cond, bar) do { unsigned _sp = 0; while (cond) { __builtin_amdgcn_s_sleep(1); \
    if ((++_sp & 255u) == 0u) { if (xb_ld(&(bar)[XB_TMO])) break; if (_sp > XB_SPIN_CAP) { atomicAdd(&(bar)[XB_TMO], 1u); break; } } } } while (0)

struct XcdBarrier {
    bool wave0;
    unsigned* bar; unsigned x;
    volatile LAS unsigned* st;
};

__device__ __forceinline__ XcdBarrier xcd_barrier_post(unsigned* bar, volatile LAS unsigned* st, bool wave0) {
    XcdBarrier b; b.wave0 = wave0; b.bar = bar; b.x = xb_xcc_id(); b.st = st;
    if (wave0 && mk_lane() == 0) (void)xb_add(&bar[XB_XCNT(b.x)], 1u);
    return b;
}
__device__ __forceinline__ void xcd_barrier_complete(unsigned* bar, unsigned x, unsigned& nloc, unsigned& nx) {
    const unsigned G = gridDim.x * gridDim.y * gridDim.z;
    unsigned sum, cnt, mine, sp = 0u;
    for (;;) {
        sum = 0u; cnt = 0u; mine = 0u;
#pragma unroll
        for (unsigned j = 0; j < 16; ++j) { const unsigned c = xb_ld(&bar[XB_XCNT(j)]); sum += c; cnt += (c > 0u) ? 1u : 0u; mine = (j == x) ? c : mine; }
        if (sum == G) break;
        __builtin_amdgcn_s_sleep(1);
        if ((++sp & 255u) == 0u) { if (xb_ld(&bar[XB_TMO])) break; if (sp > XB_SPIN_CAP) { atomicAdd(&bar[XB_TMO], 1u); break; } }
    }
    nloc = mine > 0u ? mine : 1u; nx = cnt > 0u ? cnt : 1u;
}

__device__ __forceinline__ void xcd_barrier(const XcdBarrier& b) {
    asm volatile("s_waitcnt vmcnt(0)" ::: "memory");
    __syncthreads();
    if (b.wave0 && mk_lane() == 0) {
        unsigned* bar = b.bar;
        __builtin_amdgcn_s_waitcnt(0);
        unsigned nloc = b.st[0], nx = b.st[1];
        if (nloc == 0u) { xcd_barrier_complete(bar, b.x, nloc, nx); b.st[0] = nloc; b.st[1] = nx; }
        const unsigned old = xb_add(&bar[XB_XSUB(b.x)], 1u);
        const unsigned gen = old / nloc;
        if (old + 1u == (gen + 1u) * nloc) {
            __builtin_amdgcn_fence(__ATOMIC_RELEASE, "agent");
            asm volatile("s_waitcnt vmcnt(0)" ::: "memory");
            const unsigned og = xb_add(&bar[XB_TOP], 1u);
            const unsigned tg = og / nx;
            if (og + 1u == (tg + 1u) * nx) xb_add(&bar[XB_TOPGEN], 1u);
            else XB_SPIN(xb_ld(&bar[XB_TOPGEN]) == tg, bar);
            __builtin_amdgcn_fence(__ATOMIC_ACQUIRE, "agent");
            xb_add(&bar[XB_XGEN(b.x)], 1u);
            asm volatile("s_waitcnt vmcnt(0)" ::: "memory");
        } else {
            XB_SPIN(xb_ld(&bar[XB_XGEN(b.x)]) == gen, bar);
            __builtin_amdgcn_fence(__ATOMIC_ACQUIRE, "agent");
            asm volatile("s_waitcnt vmcnt(0)" ::: "memory");
        }
    }
    __syncthreads();
}

struct Args { const float* in[N_IN]; float* out; unsigned char* ws; int ph_lo, ph_hi; };
struct Frame {
    LAS unsigned char* lds; unsigned char* lds_g;
    gu32* ctl;
    int tid, lane, wave, vcu, G;
    const float* const* in; float* out; unsigned char* ws;
};
__host__ __device__ __forceinline__ int wsig_inv(int nl) { return 128 * ((nl >> 5) & 1) + 32 * (nl >> 6) + (nl & 31); }

__device__ __forceinline__ void p0_transpose_item(const float* W, int K, int N, bf16* WT, int row_off, bool sig, const float* gain, LAS float* scr, int item, int lane) {
    const int nblk = N / 32, kb = item / nblk, nb = item % nblk, k0 = 64 * kb, n0 = 32 * nb;
#pragma unroll 8
    for (int i = 0; i < 32; ++i) { const int kk = 2 * i + (lane >> 5); float v = W[(size_t)(k0 + kk) * N + n0 + (lane & 31)]; if (gain) v *= gain[k0 + kk]; scr[kk * 33 + (lane & 31)] = v; }
    LDS_WAIT(); asm volatile("" ::: "memory");
    const int c = lane & 7;
    int nbase = row_off + n0; if (sig) { const int ng = row_off + n0; nbase = (ng & ~255) + wsig_inv(ng & 255); }
#pragma unroll
    for (int j = 0; j < 4; ++j) { const int n = (lane >> 3) + 8 * j; const LAS float* s = scr + (8 * c) * 33 + n;
        v4u o; o.x = cvt_pk_bf16(s[0 * 33], s[1 * 33]); o.y = cvt_pk_bf16(s[2 * 33], s[3 * 33]); o.z = cvt_pk_bf16(s[4 * 33], s[5 * 33]); o.w = cvt_pk_bf16(s[6 * 33], s[7 * 33]);
        *(GAS v4u*)(WT + (size_t)(nbase + n) * K + k0 + 8 * c) = o; }
    LDS_WAIT(); asm volatile("" ::: "memory");
}
__device__ __forceinline__ void row_to_bf16_ssq(const float* xrow, bf16* orow, float* ssqrow, int lane) {
    const GAS f32x4* xr = (const GAS f32x4*)xrow + lane;
    f32x4 v[4]; float s = 0.f;
#pragma unroll
    for (int j = 0; j < 4; ++j) { v[j] = xr[64 * j]; s += (v[j].x * v[j].x + v[j].y * v[j].y) + (v[j].z * v[j].z + v[j].w * v[j].w); }
    s = wave_sum(s);
    GAS v2u* o8 = (GAS v2u*)orow + lane;
#pragma unroll
    for (int j = 0; j < 4; ++j) o8[64 * j] = pack4(v[j]);
    if (lane < 16) ssqrow[lane] = lane == 0 ? s : 0.f;
}
__device__ __forceinline__ void p0_prologue(Frame& F) {
    LAS float* scr = (LAS float*)(F.lds + RING_OFF + F.wave * 16384);
    const int gw = F.vcu * NWAVES + F.wave, NGW = F.G * NWAVES;
    unsigned char* ws = F.ws;
    int it = gw;
#define P0_JOB(Wp, K_, N_, WTp, roff, sg, gn) { const int ni = ((K_) / 64) * ((N_) / 32); for (; it < ni; it += NGW) p0_transpose_item((Wp), (K_), (N_), (WTp), (roff), (sg), (gn), scr, it, F.lane); it -= ni; }
    P0_JOB(F.in[I_WINA], DM, NCOLA, (bf16*)(ws + WS_WA), 0, false, F.in[I_NMIX]);
    P0_JOB(F.in[I_WOUT], DM, DM, (bf16*)(ws + WS_WOUT), 0, false, nullptr);
    P0_JOB(F.in[I_WOUT] + (size_t)DM * DM, DM, DM, (bf16*)(ws + WS_WOUT) + (size_t)DM * DM, 0, false, nullptr);
    P0_JOB(F.in[I_WUP], DM, FF, (bf16*)(ws + WS_WUP), 0, false, F.in[I_NMLP]);
    P0_JOB(F.in[I_WUP] + (size_t)DM * FF, DM, FF, (bf16*)(ws + WS_WUP) + (size_t)DM * FF, 0, false, F.in[I_NMLP] + DM);
    P0_JOB(F.in[I_WDN], FF, DM, (bf16*)(ws + WS_WDN), 0, false, nullptr);
    P0_JOB(F.in[I_WDN] + (size_t)DM * FF, FF, DM, (bf16*)(ws + WS_WDN) + (size_t)DM * FF, 0, false, nullptr);
    P0_JOB(F.in[I_WINB], DM, DM, (bf16*)(ws + WS_WB), 0, true, F.in[I_NMIX] + DM);
    P0_JOB(F.in[I_WKV], DM, 512, (bf16*)(ws + WS_WB), 1024, true, F.in[I_KVN]);
    P0_JOB(F.in[I_WMKV], DM, 512, (bf16*)(ws + WS_WM), 0, true, F.in[I_MNORM]);
    P0_JOB(F.in[I_WMKV] + (size_t)DM * 512, DM, 512, (bf16*)(ws + WS_WM), 512, true, F.in[I_MNORM] + DM);
    P0_JOB(F.in[I_WW2], 64, 768, (bf16*)(ws + WS_WW2), 0, false, nullptr);
    P0_JOB(F.in[I_WA2], 64, 768, (bf16*)(ws + WS_WA2), 0, false, nullptr);
    P0_JOB(F.in[I_WG2], 128, 768, (bf16*)(ws + WS_WG2), 0, false, nullptr);
#undef P0_JOB
    for (int m = gw; m < R; m += NGW) { const float* xr = m < RP ? F.in[I_XP] + (size_t)m * DM : F.in[I_XS] + (size_t)(m - RP) * DM;
        row_to_bf16_ssq(xr, (bf16*)(ws + WS_HB) + (size_t)m * DM, (float*)(ws + WS_SSQ) + (size_t)m * 16, F.lane); }
    for (int m = gw; m < 512; m += NGW) row_to_bf16_ssq(F.in[I_MEMP] + (size_t)m * DM, (bf16*)(ws + WS_MB) + (size_t)m * DM, (float*)(ws + WS_SSQM) + (size_t)m * 16, F.lane);
    { const int gt = F.vcu * NWAVES * 64 + F.tid, NGT = F.G * NWAVES * 64; float* rt = (float*)(ws + WS_ROPE);
      for (int i = gt; i < 8196 * 32; i += NGT) { const int p = i >> 5, f = i & 31; const float pos = (float)(p < 8192 ? p : 16384 + (p - 8192));
          double fq_ = 1.0; for (int k = 0; k < f; ++k) fq_ *= 0.74989420933245582730; const float ang = pos * (float)fq_; const double rev = (double)ang * 0.15915494309189535; const float fr = (float)(rev - floor(rev));
          rt[2 * i] = __builtin_amdgcn_cosf(fr); rt[2 * i + 1] = __builtin_amdgcn_sinf(fr); } }
    { const int gt = F.vcu * NWAVES * 64 + F.tid, NGT = F.G * NWAVES * 64; const int per = 124 * 256 / 4;
      for (int i = gt; i < SB * per; i += NGT) { const int b = i / per, r = i % per;
          ((GAS f32x4*)(F.out + O_SSK + (size_t)b * 128 * 256))[r] = ((const GAS f32x4*)(F.in[I_CSK] + (size_t)b * 128 * 256 + 4 * 256))[r];
          ((GAS f32x4*)(F.out + O_SSV + (size_t)b * 128 * 256))[r] = ((const GAS f32x4*)(F.in[I_CSV] + (size_t)b * 128 * 256 + 4 * 256))[r]; } }
}

constexpr int LSTR = 144, SLOT = 64 * LSTR;
constexpr int REC_PT = 0, REC_QS = 8192, REC_RY = 16384, REC_YL = 24576, REC_BV = 32768;
__device__ __forceinline__ bf16x8 lfrag(const LAS unsigned char* m, int row, int k) { return *(const LAS bf16x8*)(m + row * LSTR + k * 2); }
__device__ __forceinline__ void mm_strip(f32x4 (&acc)[4], const LAS unsigned char* X, const LAS unsigned char* Y, int w, int c, int g) {
#pragma unroll
    for (int ks = 0; ks < 2; ++ks) { const bf16x8 a = lfrag(X, 16 * w + c, 32 * ks + 8 * g);
#pragma unroll
        for (int n = 0; n < 4; ++n) acc[n] = mfma16(a, lfrag(Y, 16 * n + c, 32 * ks + 8 * g), acc[n]); }
}
__device__ __forceinline__ void mm_strip2(f32x4 (&acc0)[4], f32x4 (&acc1)[4], const LAS unsigned char* X, const LAS unsigned char* Y0, const LAS unsigned char* Y1, int w, int c, int g) {
#pragma unroll
    for (int ks = 0; ks < 2; ++ks) { const bf16x8 a = lfrag(X, 16 * w + c, 32 * ks + 8 * g);
#pragma unroll
        for (int n = 0; n < 4; ++n) { acc0[n] = mfma16(a, lfrag(Y0, 16 * n + c, 32 * ks + 8 * g), acc0[n]); acc1[n] = mfma16(a, lfrag(Y1, 16 * n + c, 32 * ks + 8 * g), acc1[n]); } }
}
__device__ __forceinline__ void zero4(f32x4 (&a)[4]) {
#pragma unroll
    for (int n = 0; n < 4; ++n) a[n] = (f32x4){0.f, 0.f, 0.f, 0.f};
}
__device__ __forceinline__ void st_T(LAS unsigned char* dest, const f32x4 (&acc)[4], int w, int c, int g) {
#pragma unroll
    for (int n = 0; n < 4; ++n) *(LAS v2u*)(dest + (16 * n + c) * LSTR + (16 * w + 4 * g) * 2) = pack4(acc[n]);
}
__device__ __forceinline__ void st_T_global(unsigned char* dest  , const f32x4 (&acc)[4], int w, int c, int g) {
#pragma unroll
    for (int n = 0; n < 4; ++n) *(GAS v2u*)(dest + (16 * n + c) * 128 + (16 * w + 4 * g) * 2) = pack4(acc[n]);
}
__device__ __forceinline__ void load_shift8(const bf16* cur, const bf16* prv, const float* mu, float (&o)[8]) {
    const v4u cw = *(const GAS v4u*)cur; v4u pw = {0u, 0u, 0u, 0u}; if (prv) pw = *(const GAS v4u*)prv;
    const f32x4 m0 = *(const GAS f32x4*)mu, m1 = *(const GAS f32x4*)(mu + 4);
    const float cf[8] = {bflo(cw.x), bfhi(cw.x), bflo(cw.y), bfhi(cw.y), bflo(cw.z), bfhi(cw.z), bflo(cw.w), bfhi(cw.w)};
    const float pf[8] = {bflo(pw.x), bfhi(pw.x), bflo(pw.y), bfhi(pw.y), bflo(pw.z), bfhi(pw.z), bflo(pw.w), bfhi(pw.w)};
    const float mf[8] = {m0[0], m0[1], m0[2], m0[3], m1[0], m1[1], m1[2], m1[3]};
#pragma unroll
    for (int i = 0; i < 8; ++i) o[i] = cf[i] + (pf[i] - cf[i]) * mf[i];
}
__device__ __forceinline__ bf16x8 pack_frag(const float (&v)[8]) {
    v4u w; w.x = cvt_pk_bf16(v[0], v[1]); w.y = cvt_pk_bf16(v[2], v[3]); w.z = cvt_pk_bf16(v[4], v[5]); w.w = cvt_pk_bf16(v[6], v[7]); return __builtin_bit_cast(bf16x8, w);
}

__device__ __forceinline__ void rwkv_prep_unit(Frame& F, int unit, LAS unsigned char* hb, LAS float* wtot) {
    int w_ = F.wave & 3, lane_ = F.lane; asm volatile("" : "+s"(w_), "+v"(lane_));
    const int w = w_, lane = lane_, g = lane >> 4, c = lane & 15;
    const int chunk = unit / NH, h = unit % NH, row0 = chunk * 64; const bool first = (chunk & 127) == 0;
    const bf16* proj = (const bf16*)(F.ws + WS_PROJ);
    unsigned char* rec = F.ws + WS_REC + (size_t)unit * REC_BYTES;
    LAS unsigned char* const s0 = hb, * const s1 = hb + SLOT, * const s2 = hb + 2 * SLOT, * const s3 = hb + 3 * SLOT, * const s4 = hb + 4 * SLOT, * const s5 = hb + 5 * SLOT, * const s6 = hb + 6 * SLOT, * const s7 = hb + 7 * SLOT;
    f32x4 dw[4], da[4]; zero4(dw); zero4(da);
    {
        const int t = 16 * w + c; const bf16* cr = proj + (size_t)(row0 + t) * NCOLA; const bf16* pr = (first && t == 0) ? nullptr : cr - NCOLA;
        const bf16* Ww2 = (const bf16*)(F.ws + WS_WW2); const bf16* Wa2 = (const bf16*)(F.ws + WS_WA2);
#pragma unroll
        for (int ks = 0; ks < 2; ++ks) { const int l0 = 32 * ks + 8 * g; float x[8];
            load_shift8(cr + 2304 + l0, pr ? pr + 2304 + l0 : nullptr, F.in[I_MU] + 2304 + l0, x);
#pragma unroll
            for (int i = 0; i < 8; ++i) x[i] = ftanh(x[i]);
            const bf16x8 aw = pack_frag(x);
            load_shift8(cr + 2368 + l0, pr ? pr + 2368 + l0 : nullptr, F.in[I_MU] + 2368 + l0, x);
            const bf16x8 aa = pack_frag(x);
#pragma unroll
            for (int n = 0; n < 4; ++n) { const size_t wo = (size_t)(h * 64 + 16 * n + c) * 64 + l0;
                dw[n] = mfma16(aw, *(const GAS bf16x8*)(Ww2 + wo), dw[n]); da[n] = mfma16(aa, *(const GAS bf16x8*)(Wa2 + wo), da[n]); } }
    }
    f32x4 rt[4], kh[4], lw[4], at_[4], bt_[4], kt_[4], bh_[4], vv[4]; float gam[4]; float bon[4] = {0.f, 0.f, 0.f, 0.f}; float ssk[4] = {0.f, 0.f, 0.f, 0.f};
    f32x4 kkr[4], aa_[4], kp[4], rr[4];
    {
        float mur[4], muk[4], muv[4], w0[4], a0[4], kkc[4], kac[4], rkc[4];
#pragma unroll
        for (int n = 0; n < 4; ++n) { const int col = h * 64 + 16 * n + c; mur[n] = F.in[I_MU][col]; muk[n] = F.in[I_MU][768 + col]; muv[n] = F.in[I_MU][1536 + col];
            w0[n] = F.in[I_W0][col]; a0[n] = F.in[I_A0][col]; kkc[n] = F.in[I_KK][col]; kac[n] = F.in[I_KA][col]; rkc[n] = F.in[I_RK][col]; }
#pragma unroll
        for (int reg = 0; reg < 4; ++reg) { const int t = 16 * w + 4 * g + reg; const bool hp = !(first && t == 0);
            const GAS bf16* cr = (const GAS bf16*)(proj + (size_t)(row0 + t) * NCOLA + h * 64 + c); const GAS bf16* pr = hp ? cr - NCOLA : cr;
#pragma unroll
            for (int n = 0; n < 4; ++n) {
                const float r0 = bf2f(cr[16 * n]), k0 = bf2f(cr[16 * n + 768]), v0 = bf2f(cr[16 * n + 1536]);
                float r1 = bf2f(pr[16 * n]), k1 = bf2f(pr[16 * n + 768]), v1 = bf2f(pr[16 * n + 1536]);
                if (!hp) { r1 = 0.f; k1 = 0.f; v1 = 0.f; }
                const float r = r0 + (r1 - r0) * mur[n], k = k0 + (k1 - k0) * muk[n], v = v0 + (v1 - v0) * muv[n];
                const float y = -(w0[n] + dw[n][reg]);
                const float sp = fmaxf(y, 0.f) + __logf(1.0f + __expf(-fabsf(y)));
                lw[n][reg] = -__expf(-sp - 0.5f);
                const float a = fsigmoid(a0[n] + da[n][reg]);
                aa_[n][reg] = a; kkr[n][reg] = k * kkc[n]; kp[n][reg] = k * (1.0f + (a - 1.0f) * kac[n]); rr[n][reg] = r; vv[n][reg] = v;
                ssk[reg] += kkr[n][reg] * kkr[n][reg]; bon[reg] += r * kp[n][reg] * rkc[n]; }
            asm volatile("" ::: "memory"); }
    }
#pragma unroll
    for (int reg = 0; reg < 4; ++reg) { ssk[reg] = sum16(ssk[reg]); bon[reg] = sum16(bon[reg]); ssk[reg] = 1.0f / fmaxf(sqrtf(ssk[reg]), 1e-12f); }
    f32x4 Lc[4];
#pragma unroll
    for (int n = 0; n < 4; ++n) { f32x4 inc; inc[0] = lw[n][0]; inc[1] = inc[0] + lw[n][1]; inc[2] = inc[1] + lw[n][2]; inc[3] = inc[2] + lw[n][3];
        const float tot = inc[3]; const float t1 = __shfl(tot, (lane - 16) & 63), t2 = __shfl(tot, (lane - 32) & 63), t3 = __shfl(tot, (lane - 48) & 63);
        const float pre = (g >= 1 ? t1 : 0.f) + (g >= 2 ? t2 : 0.f) + (g >= 3 ? t3 : 0.f);
        Lc[n] = inc + pre; if (g == 3) wtot[w * 64 + 16 * n + c] = pre + tot; }
    __syncthreads();
#pragma unroll
    for (int n = 0; n < 4; ++n) { const int j = 16 * n + c; const float t0 = wtot[j], t1 = wtot[64 + j], t2 = wtot[128 + j], t3 = wtot[192 + j];
        const float base = (w >= 1 ? t0 : 0.f) + (w >= 2 ? t1 : 0.f) + (w >= 3 ? t2 : 0.f); const float LC = (t0 + t1) + (t2 + t3);
        gam[n] = __expf(LC);
#pragma unroll
        for (int reg = 0; reg < 4; ++reg) { const float L = Lc[n][reg] + base; const float eL = __expf(L), eLi = __expf(-L), eP = __expf(L - lw[n][reg]), eC = __expf(LC - L);
            const float kk = kkr[n][reg] * ssk[reg], bsc = kk * aa_[n][reg];
            at_[n][reg] = -kk * eP; rt[n][reg] = rr[n][reg] * eL; bt_[n][reg] = bsc * eLi; kt_[n][reg] = kp[n][reg] * eLi; bh_[n][reg] = bsc * eC; kh[n][reg] = kp[n][reg] * eC;
            const int t = 16 * w + 4 * g + reg;
            *(LAS bf16*)(s0 + t * LSTR + j * 2) = f2bf(at_[n][reg]); *(LAS bf16*)(s1 + t * LSTR + j * 2) = f2bf(bt_[n][reg]);
            *(LAS bf16*)(s2 + t * LSTR + j * 2) = f2bf(kt_[n][reg]); *(LAS bf16*)(s3 + t * LSTR + j * 2) = f2bf(rt[n][reg]); }
        *(LAS v2u*)(s4 + j * LSTR + (16 * w + 4 * g) * 2) = pack4(at_[n]); *(LAS v2u*)(s5 + j * LSTR + (16 * w + 4 * g) * 2) = pack4(bh_[n]); *(LAS v2u*)(s6 + j * LSTR + (16 * w + 4 * g) * 2) = pack4(vv[n]);
        f32x4 bv;
#pragma unroll
        for (int reg = 0; reg < 4; ++reg) bv[reg] = bon[reg] * vv[n][reg];
        *(GAS v2u*)(rec + REC_BV + j * 128 + (16 * w + 4 * g) * 2) = pack4(bv); }
    __syncthreads();
    f32x4 aN[4], aMk[4], aMbr[4], aMkr[4]; zero4(aN); zero4(aMk); zero4(aMbr); zero4(aMkr);
    mm_strip2(aN, aMk, s0, s1, s2, w, c, g);
    mm_strip(aMbr, s1, s3, w, c, g); mm_strip(aMkr, s2, s3, w, c, g);
#pragma unroll
    for (int n = 0; n < 4; ++n)
#pragma unroll
        for (int reg = 0; reg < 4; ++reg) { const int row = 16 * w + 4 * g + reg, col = 16 * n + c;
            if (!(col < row)) { aN[n][reg] = 0.f; aMk[n][reg] = 0.f; } if (!(row <= col)) { aMbr[n][reg] = 0.f; aMkr[n][reg] = 0.f; } }
    __syncthreads();
    LAS float* Nf = (LAS float*)s0;
#pragma unroll
    for (int n = 0; n < 4; ++n)
#pragma unroll
        for (int reg = 0; reg < 4; ++reg) Nf[(16 * w + 4 * g + reg) * 64 + 16 * n + c] = aN[n][reg];
    st_T(s2, aMk, w, c, g);
    st_T(s3, aMbr, w, c, g);
    __syncthreads();
    if (w == 0) {
        float col[64];
#pragma unroll
        for (int t = 0; t < 64; ++t) col[t] = 0.f;
#pragma unroll
        for (int t = 0; t < 64; ++t) { float pv[4] = {(t == lane) ? 1.0f : 0.0f, 0.f, 0.f, 0.f};
#pragma unroll
            for (int u4 = 0; u4 < (t + 3) / 4; ++u4) { const f32x4 nv = *(const LAS f32x4*)(Nf + t * 64 + 4 * u4);
#pragma unroll
                for (int e = 0; e < 4; ++e) if (4 * u4 + e < t) pv[e] = fmaf(nv[e], col[4 * u4 + e], pv[e]); }
            const float val = (pv[0] + pv[1]) + (pv[2] + pv[3]);
            col[t] = val; *(LAS bf16*)(s7 + t * LSTR + lane * 2) = f2bf(val); }
    }
    __syncthreads();
    { f32x4 aW[4], aNk[4]; zero4(aW); zero4(aNk); mm_strip2(aW, aNk, s7, s4, s2, w, c, g); st_T(s0, aW, w, c, g); st_T(s1, aNk, w, c, g); }
    __syncthreads();
    { f32x4 aP[4]; zero4(aP); mm_strip(aP, s0, s5, w, c, g);
#pragma unroll
      for (int n = 0; n < 4; ++n)
#pragma unroll
          for (int reg = 0; reg < 4; ++reg) if (n == w && c == 4 * g + reg) aP[n][reg] += gam[n];
      st_T_global(rec + REC_PT, aP, w, c, g); }
    { f32x4 aZq[4], aZy[4]; zero4(aZq); zero4(aZy); mm_strip2(aZq, aZy, s1, s5, s3, w, c, g);
#pragma unroll
      for (int n = 0; n < 4; ++n) { aZq[n] += kh[n]; aZy[n] += aMkr[n]; }
      f32x4 aRy[4]; zero4(aRy); mm_strip(aRy, s3, s0, w, c, g);
#pragma unroll
      for (int n = 0; n < 4; ++n)
#pragma unroll
          for (int reg = 0; reg < 4; ++reg) *(GAS bf16*)(rec + REC_RY + (16 * w + 4 * g + reg) * 128 + (16 * n + c) * 2) = f2bf(aRy[n][reg] + rt[n][reg]);
      st_T(s4, aZq, w, c, g);
      st_T(s7, aZy, w, c, g); }
    __syncthreads();
    { f32x4 aQ[4], aY[4]; zero4(aQ); zero4(aY); mm_strip(aQ, s4, s6, w, c, g); mm_strip(aY, s7, s6, w, c, g);
      st_T_global(rec + REC_QS, aQ, w, c, g); st_T_global(rec + REC_YL, aY, w, c, g); }
}

__device__ __forceinline__ float rdlane(float v, int l) { return __int_as_float(__builtin_amdgcn_readlane(__float_as_int(v), l)); }
__device__ __forceinline__ void rwkv_sample_task(Frame& F, int task) {
    int lane_ = F.lane; asm volatile("" : "+v"(lane_)); const int lane = lane_;
    const int b = task / NH, h = task % NH, col = h * 64 + lane;
    const bf16* proj = (const bf16*)(F.ws + WS_PROJ);
    const float* sh = F.in[I_SSHIFT] + (size_t)b * RWKV_COLS;
    const float* mu = F.in[I_MU];
    float S[64];
    { const GAS f32x4* sp = (const GAS f32x4*)(F.in[I_SWKV] + (((size_t)b * NH + h) * 64 + lane) * 64);
#pragma unroll
      for (int q = 0; q < 16; ++q) { const f32x4 v = sp[q]; S[4 * q] = v[0]; S[4 * q + 1] = v[1]; S[4 * q + 2] = v[2]; S[4 * q + 3] = v[3]; } }
    const float w0 = F.in[I_W0][col], a0 = F.in[I_A0][col], kkc = F.in[I_KK][col], kac = F.in[I_KA][col], rkc = F.in[I_RK][col], lnw = F.in[I_LNW][col], lnb = F.in[I_LNB][col];
#pragma unroll 1
    for (int i = 0; i < ST; ++i) {
        const int row = RP + b * ST + i; const bf16* cr = proj + (size_t)row * NCOLA;
#define SHIFTED(cc) ({ const float p_ = bf2f(cr[(cc)]); const float q_ = (i == 0) ? sh[(cc)] : bf2f(cr[(cc) - NCOLA]); p_ + (q_ - p_) * mu[(cc)]; })
        const float r = SHIFTED(col), k = SHIFTED(768 + col), v = SHIFTED(1536 + col);
        const float twd = ftanh(SHIFTED(2304 + lane)), ad = SHIFTED(2368 + lane), gd0 = fsigmoid(SHIFTED(2432 + lane)), gd1 = fsigmoid(SHIFTED(2496 + lane));
#undef SHIFTED
        float dw = 0.f, da = 0.f, gg = 0.f;
        const GAS float* W2 = (const GAS float*)(F.in[I_WW2] + col); const GAS float* A2 = (const GAS float*)(F.in[I_WA2] + col); const GAS float* G2 = (const GAS float*)(F.in[I_WG2] + col);
#pragma unroll 4
        for (int l = 0; l < 64; ++l) { dw = fmaf(rdlane(twd, l), W2[0], dw); da = fmaf(rdlane(ad, l), A2[0], da);
            gg = fmaf(rdlane(gd0, l), G2[0], gg); gg = fmaf(rdlane(gd1, l), G2[64 * 768], gg); W2 += 768; A2 += 768; G2 += 768; }
        const float y0 = -(w0 + dw); const float sp = fmaxf(y0, 0.f) + __logf(1.0f + __expf(-fabsf(y0)));
        const float wdec = __expf(-__expf(-sp - 0.5f));
        const float a = fsigmoid(a0 + da);
        const float kkr = k * kkc; const float nrm = fmaxf(sqrtf(wave_sum(kkr * kkr)), 1e-12f); const float kk = kkr / nrm;
        const float kp = k * (1.0f + (a - 1.0f) * kac);
        const float asc = -kk, bsc = kk * a;
        const float bonus = wave_sum(r * kp * rkc);
        float sa = 0.f;
#pragma unroll
        for (int j = 0; j < 64; ++j) sa = fmaf(S[j], rdlane(asc, j), sa);
        const float vi = v;
        float y = 0.f;
#pragma unroll
        for (int j = 0; j < 64; ++j) { const float wj = rdlane(wdec, j), bj = rdlane(bsc, j), kj = rdlane(kp, j), rj = rdlane(r, j);
            S[j] = fmaf(S[j], wj, fmaf(sa, bj, vi * kj)); y = fmaf(S[j], rj, y); }
        const float mean = wave_sum(y) * (1.0f / 64.0f); const float dy = y - mean; const float var = wave_sum(dy * dy) * (1.0f / 64.0f);
        const float o = (dy * rsqrtf(var + 6.4e-4f) * lnw + lnb + bonus * vi) * gg;
        ((bf16*)(F.ws + WS_MIX))[(size_t)row * DM + col] = f2bf(o);
    }
    { GAS f32x4* sp = (GAS f32x4*)(F.out + O_SWKV + (((size_t)b * NH + h) * 64 + lane) * 64);
#pragma unroll
      for (int q = 0; q < 16; ++q) sp[q] = (f32x4){S[4 * q], S[4 * q + 1], S[4 * q + 2], S[4 * q + 3]}; }
    if (h == 0) { const bf16* lr = proj + (size_t)(RP + b * ST + ST - 1) * NCOLA; float* o = F.out + O_SSHIFT + (size_t)b * RWKV_COLS;
        for (int q = lane; q < RWKV_COLS; q += 64) o[q] = bf2f(lr[q]); }
}

__device__ __forceinline__ void rwkv_scan_chain(Frame& F, int bh, int w) {
    const int lane = F.lane, g = lane >> 4, c = lane & 15; const int b = bh / NH, h = bh % NH;
    f32x4 acc[4]; zero4(acc);
    const int vrow = 16 * w + c;
    auto recp = [&](int cc) -> unsigned char* { return F.ws + WS_REC + (size_t)((b * 128 + cc) * NH + h) * REC_BYTES; };
    v2u pa[4][2][2], qa[4];
    { unsigned char* rp = recp(0);
#pragma unroll
      for (int mt = 0; mt < 4; ++mt) { qa[mt] = *(const GAS v2u*)(rp + REC_QS + vrow * 128 + (16 * mt + 4 * g) * 2);
#pragma unroll
          for (int ks = 0; ks < 2; ++ks) { pa[mt][ks][0] = *(const GAS v2u*)(rp + REC_PT + (16 * mt + c) * 128 + (32 * ks + 4 * g) * 2); pa[mt][ks][1] = *(const GAS v2u*)(rp + REC_PT + (16 * mt + c) * 128 + (32 * ks + 16 + 4 * g) * 2); } } }
    for (int cc = 0; cc < 128; ++cc) {
        unsigned char* rp = recp(cc);
        v2u sb[4];
#pragma unroll
        for (int mt = 0; mt < 4; ++mt) sb[mt] = pack4(acc[mt]);
        f32x4 nacc[4];
#pragma unroll
        for (int mt = 0; mt < 4; ++mt) nacc[mt] = unpack4(qa[mt]);
        VM_WAIT();
#pragma unroll
        for (int mt = 0; mt < 4; ++mt) *(GAS v2u*)(rp + REC_QS + vrow * 128 + (16 * mt + 4 * g) * 2) = sb[mt];
        bf16x8 bf[2];
#pragma unroll
        for (int ks = 0; ks < 2; ++ks) { v4u t; t.x = sb[2 * ks].x; t.y = sb[2 * ks].y; t.z = sb[2 * ks + 1].x; t.w = sb[2 * ks + 1].y; bf[ks] = __builtin_bit_cast(bf16x8, t); }
        bf16x8 af[4][2];
#pragma unroll
        for (int mt = 0; mt < 4; ++mt)
#pragma unroll
            for (int ks = 0; ks < 2; ++ks) { v4u t; t.x = pa[mt][ks][0].x; t.y = pa[mt][ks][0].y; t.z = pa[mt][ks][1].x; t.w = pa[mt][ks][1].y; af[mt][ks] = __builtin_bit_cast(bf16x8, t); }
        if (cc + 1 < 128) { unsigned char* rn = recp(cc + 1);
#pragma unroll
            for (int mt = 0; mt < 4; ++mt) { qa[mt] = *(const GAS v2u*)(rn + REC_QS + vrow * 128 + (16 * mt + 4 * g) * 2);
#pragma unroll
                for (int ks = 0; ks < 2; ++ks) { pa[mt][ks][0] = *(const GAS v2u*)(rn + REC_PT + (16 * mt + c) * 128 + (32 * ks + 4 * g) * 2); pa[mt][ks][1] = *(const GAS v2u*)(rn + REC_PT + (16 * mt + c) * 128 + (32 * ks + 16 + 4 * g) * 2); } } }
#pragma unroll
        for (int mt = 0; mt < 4; ++mt) { nacc[mt] = mfma16(af[mt][0], bf[0], nacc[mt]); nacc[mt] = mfma16(af[mt][1], bf[1], nacc[mt]); acc[mt] = nacc[mt]; }
    }
    float* o = F.out + O_PWKV + (((size_t)b * NH + h) * 64 + vrow) * 64;
#pragma unroll
    for (int mt = 0; mt < 4; ++mt) *(GAS f32x4*)(o + 16 * mt + 4 * g) = acc[mt];
}

__device__ __forceinline__ void rwkv_yout_item(Frame& F, int item) {
    const int lane = F.lane, g = lane >> 4, c = lane & 15; const int unit = item >> 2, w = item & 3;
    const int chunk = unit / NH, h = unit % NH, row0 = chunk * 64; const bool first = (chunk & 127) == 0;
    const unsigned char* rec = F.ws + WS_REC + (size_t)unit * REC_BYTES;
    const bf16* proj = (const bf16*)(F.ws + WS_PROJ);
    f32x4 y[4], gt[4]; zero4(gt);
#pragma unroll
    for (int n = 0; n < 4; ++n) y[n] = unpack4(*(const GAS v2u*)(rec + REC_YL + (16 * n + c) * 128 + (16 * w + 4 * g) * 2));
#pragma unroll
    for (int ks = 0; ks < 2; ++ks) { const bf16x8 a = *(const GAS bf16x8*)(rec + REC_RY + (16 * w + c) * 128 + (32 * ks + 8 * g) * 2);
#pragma unroll
        for (int n = 0; n < 4; ++n) y[n] = mfma16(a, *(const GAS bf16x8*)(rec + REC_QS + (16 * n + c) * 128 + (32 * ks + 8 * g) * 2), y[n]); }
    { const int t = 16 * w + c; const bf16* cr = proj + (size_t)(row0 + t) * NCOLA; const bf16* pr = (first && t == 0) ? nullptr : cr - NCOLA; const bf16* Wg2 = (const bf16*)(F.ws + WS_WG2);
#pragma unroll
      for (int ks = 0; ks < 4; ++ks) { const int l0 = 32 * ks + 8 * g; float x[8]; load_shift8(cr + 2432 + l0, pr ? pr + 2432 + l0 : nullptr, F.in[I_MU] + 2432 + l0, x);
#pragma unroll
          for (int i = 0; i < 8; ++i) x[i] = fsigmoid(x[i]);
          const bf16x8 ag = pack_frag(x);
#pragma unroll
          for (int n = 0; n < 4; ++n) gt[n] = mfma16(ag, *(const GAS bf16x8*)(Wg2 + (size_t)(h * 64 + 16 * n + c) * 128 + l0), gt[n]); } }
    float mean[4], rstd[4];
#pragma unroll
    for (int reg = 0; reg < 4; ++reg) { float s = (y[0][reg] + y[1][reg]) + (y[2][reg] + y[3][reg]); s = sum16(s); mean[reg] = s * (1.0f / 64.0f);
        float q = 0.f;
#pragma unroll
        for (int n = 0; n < 4; ++n) { const float d = y[n][reg] - mean[reg]; q += d * d; }
        q = sum16(q); rstd[reg] = rsqrtf(q * (1.0f / 64.0f) + 6.4e-4f); }
    bf16* mix = (bf16*)(F.ws + WS_MIX);
#pragma unroll
    for (int n = 0; n < 4; ++n) { const int col = h * 64 + 16 * n + c; const float lnw = F.in[I_LNW][col], lnb = F.in[I_LNB][col];
        const f32x4 bv = unpack4(*(const GAS v2u*)(rec + REC_BV + (16 * n + c) * 128 + (16 * w + 4 * g) * 2));
#pragma unroll
        for (int reg = 0; reg < 4; ++reg) { const float o = ((y[n][reg] - mean[reg]) * rstd[reg] * lnw + lnb + bv[reg]) * gt[n][reg];
            mix[(size_t)(row0 + 16 * w + 4 * g + reg) * DM + col] = f2bf(o); } }
}

__device__ __forceinline__ int crow32(int r, int hi) { return (r & 3) + 8 * (r >> 2) + 4 * hi; }
template <bool MASKED>
__device__ __forceinline__ void flash32(const bf16x8 (&qf)[4], const bf16* Kp, int kstr, const bf16* VTp, int vstr, int kb_lo, int nblk, int qpos, float m0, float l0,
                                        f32x16& o0, f32x16& o1, float& lsum, int lane) {
    const int r32 = lane & 31, hh = lane >> 5;
    float m = m0, l = hh == 0 ? l0 : 0.f;
#pragma unroll
    for (int r = 0; r < 16; ++r) { o0[r] = 0.f; o1[r] = 0.f; }
    for (int blk = 0; blk < nblk; ++blk) { const int kb = kb_lo + 32 * blk;
        f32x16 s;
#pragma unroll
        for (int r = 0; r < 16; ++r) s[r] = 0.f;
#pragma unroll
        for (int ks = 0; ks < 4; ++ks) s = mfma32(*(const GAS bf16x8*)(Kp + (size_t)(kb + r32) * kstr + 16 * ks + 8 * hh), qf[ks], s);
        if (MASKED) {
#pragma unroll
            for (int r = 0; r < 16; ++r) { const int rel = qpos - (kb + crow32(r, hh)); if (rel < 0 || rel >= 128) s[r] = -1e30f; } }
        float bm = s[0];
#pragma unroll
        for (int r = 1; r < 16; ++r) bm = fmaxf(bm, s[r]);
        bm = fmaxf(bm, __shfl_xor(bm, 32));
        const float mn = fmaxf(m, bm), alpha = __builtin_amdgcn_exp2f(m - mn); m = mn;
        float ps = 0.f;
#pragma unroll
        for (int r = 0; r < 16; ++r) { s[r] = __builtin_amdgcn_exp2f(s[r] - mn); ps += s[r]; }
        l = l * alpha + ps;
#pragma unroll
        for (int r = 0; r < 16; ++r) { o0[r] *= alpha; o1[r] *= alpha; }
#pragma unroll
        for (int s2 = 0; s2 < 2; ++s2) {
            v4u pw; pw.x = cvt_pk_bf16(s[8 * s2], s[8 * s2 + 1]); pw.y = cvt_pk_bf16(s[8 * s2 + 2], s[8 * s2 + 3]); pw.z = cvt_pk_bf16(s[8 * s2 + 4], s[8 * s2 + 5]); pw.w = cvt_pk_bf16(s[8 * s2 + 6], s[8 * s2 + 7]);
            const bf16x8 pb = __builtin_bit_cast(bf16x8, pw);
#pragma unroll
            for (int dt = 0; dt < 2; ++dt) { const bf16* vp = VTp + (size_t)(32 * dt + r32) * vstr + kb + 16 * s2 + 4 * hh;
                const v2u a0 = *(const GAS v2u*)vp, a1 = *(const GAS v2u*)(vp + 8); v4u aw; aw.x = a0.x; aw.y = a0.y; aw.z = a1.x; aw.w = a1.y;
                if (dt == 0) o0 = mfma32(__builtin_bit_cast(bf16x8, aw), pb, o0); else o1 = mfma32(__builtin_bit_cast(bf16x8, aw), pb, o1); } }
    }
    lsum = l + __shfl_xor(l, 32);
}
__device__ __forceinline__ void flash_store(bf16* dst  , int rstride, const f32x16& o0, const f32x16& o1, float lsum, int lane) {
    const int r32 = lane & 31, hh = lane >> 5; const float inv = 1.0f / lsum; bf16* p = dst + (size_t)r32 * rstride + 4 * hh;
#pragma unroll
    for (int k = 0; k < 4; ++k) { *(GAS v2u*)(p + 8 * k) = pack4((f32x4){o0[4 * k] * inv, o0[4 * k + 1] * inv, o0[4 * k + 2] * inv, o0[4 * k + 3] * inv});
        *(GAS v2u*)(p + 32 + 8 * k) = pack4((f32x4){o1[4 * k] * inv, o1[4 * k + 1] * inv, o1[4 * k + 2] * inv, o1[4 * k + 3] * inv}); }
}
__device__ __forceinline__ void memattn_prompt_task(Frame& F, int layer, int task) {
    const int lane = F.lane, r32 = lane & 31, hh = lane >> 5; const int hm = task & 3, qt = task >> 2;
    const int row = qt * 32 + r32, b = (qt * 32) >> 13;
    bf16x8 qf[4];
    if (layer == 0) { const bf16* qp = (const bf16*)(F.ws + WS_PROJ) + (size_t)row * NCOLA + RWKV_COLS + hm * 64; const float* gn = F.in[I_MQN];
        float x[4][8]; float ss = 0.f;
#pragma unroll
        for (int ks = 0; ks < 4; ++ks) { const v4u w = *(const GAS v4u*)(qp + 16 * ks + 8 * hh); const unsigned ww[4] = {w.x, w.y, w.z, w.w};
#pragma unroll
            for (int i = 0; i < 4; ++i) { x[ks][2 * i] = bflo(ww[i]); x[ks][2 * i + 1] = bfhi(ww[i]); ss += x[ks][2 * i] * x[ks][2 * i] + x[ks][2 * i + 1] * x[ks][2 * i + 1]; } }
        ss += __shfl_xor(ss, 32); const float rs = rsqrtf(ss * (1.0f / 64.0f) + 1e-6f) * C2Q;
#pragma unroll
        for (int ks = 0; ks < 4; ++ks) {
#pragma unroll
            for (int i = 0; i < 8; ++i) x[ks][i] *= rs * gn[16 * ks + 8 * hh + i];
            qf[ks] = pack_frag(x[ks]); }
    } else { const bf16* qp = (const bf16*)(F.ws + WS_Q1) + (size_t)row * DM + 768 + hm * 64;
#pragma unroll
        for (int ks = 0; ks < 4; ++ks) qf[ks] = *(const GAS bf16x8*)(qp + 16 * ks + 8 * hh); }
    const bf16* Kp = (const bf16*)(F.ws + WS_MK) + (size_t)((layer * 2 + b) * 4 + hm) * 256 * 64;
    const bf16* VTp = (const bf16*)(F.ws + WS_MVT) + (size_t)((layer * 2 + b) * 4 + hm) * 64 * 256;
    f32x16 o0, o1; float ls;
    flash32<false>(qf, Kp, 64, VTp, 256, 0, 8, 0, -1e30f, 0.f, o0, o1, ls, lane);
    flash_store((bf16*)(F.ws + WS_MIX) + (size_t)(qt * 32) * DM + 768 + hm * 64, DM, o0, o1, ls, lane);
}
__device__ __forceinline__ void swa_prompt_task(Frame& F, int task) {
    const int lane = F.lane, r32 = lane & 31, hh = lane >> 5; const int hq = task % NH, qt = task / NH;
    const int b = qt >> 8, tq = (qt & 255) * 32, row = qt * 32 + r32, kvh = hq / 3;
    const bf16* qp = (const bf16*)(F.ws + WS_Q1) + (size_t)row * DM + hq * 64;
    bf16x8 qf[4];
#pragma unroll
    for (int ks = 0; ks < 4; ++ks) qf[ks] = *(const GAS bf16x8*)(qp + 16 * ks + 8 * hh);
    const bf16* Kp = (const bf16*)(F.ws + WS_K1) + (size_t)(b * T) * 256 + kvh * 64;
    const bf16* VTp = (const bf16*)(F.ws + WS_VT1) + (size_t)(b * 4 + kvh) * 64 * T;
    const int kb_lo = tq >= 128 ? tq - 128 : 0, nblk = (tq - kb_lo) / 32 + 1;
    const float sink = F.in[I_SINKS][hq] * LOG2E;
    f32x16 o0, o1; float ls;
    flash32<true>(qf, Kp, 256, VTp, T, kb_lo, nblk, tq + r32, sink, 1.0f, o0, o1, ls, lane);
    flash_store((bf16*)(F.ws + WS_MIX) + (size_t)(qt * 32) * DM + hq * 64, DM, o0, o1, ls, lane);
}
template <int NQ, bool WINDOW>
__device__ __forceinline__ void small_attn(const LAS float* ql, LAS float* sc, int NKP, const float* k1, const float* v1, int kst1, int nk1, const bf16* k2, const bf16* v2, int kst2, int nk2,
                                           const float* sinkg  , bf16* out0, int ostride_q, int lane) {
    const int sub = lane >> 4, dq = lane & 15, nk = nk1 + nk2;
    f32x4 qv[NQ];
#pragma unroll
    for (int qi = 0; qi < NQ; ++qi) qv[qi] = *(const LAS f32x4*)(ql + qi * 64 + 4 * dq);
    for (int kg = 0; kg < nk; kg += 4) { const int key = kg + sub; f32x4 kv;
        if (key < nk1) kv = *(const GAS f32x4*)(k1 + (size_t)key * kst1 + 4 * dq); else kv = unpack4(*(const GAS v2u*)(k2 + (size_t)(key - nk1) * kst2 + 4 * dq));
#pragma unroll
        for (int qi = 0; qi < NQ; ++qi) { const f32x4 p = qv[qi] * kv; const float s = sum16((p[0] + p[1]) + (p[2] + p[3])); if (dq == 0) sc[qi * NKP + key] = s; } }
    LDS_WAIT(); asm volatile("" ::: "memory");
#pragma unroll
    for (int qi = 0; qi < NQ; ++qi) { float sv[5]; const float sk_ = sinkg ? sinkg[qi >> 2] * LOG2E : -1e30f; float mx = sk_;
#pragma unroll
        for (int t = 0; t < 5; ++t) { const int key = lane + 64 * t; float s = -1e30f; if (key < nk) { s = sc[qi * NKP + key]; if (WINDOW) { const int i = qi & 3; if (key < i + 1 || key > 128 + i) s = -1e30f; } } sv[t] = s; mx = fmaxf(mx, s); }
        mx = wave_max(mx); float sum = 0.f;
#pragma unroll
        for (int t = 0; t < 5; ++t) { sv[t] = __builtin_amdgcn_exp2f(sv[t] - mx); sum += sv[t]; }
        sum = wave_sum(sum) + (sinkg ? __builtin_amdgcn_exp2f(sk_ - mx) : 0.f); const float inv = 1.0f / sum;
#pragma unroll
        for (int t = 0; t < 5; ++t) { const int key = lane + 64 * t; if (key < nk) sc[qi * NKP + key] = sv[t] * inv; } }
    LDS_WAIT(); asm volatile("" ::: "memory");
    f32x4 acc[NQ];
#pragma unroll
    for (int qi = 0; qi < NQ; ++qi) acc[qi] = (f32x4){0.f, 0.f, 0.f, 0.f};
    for (int kg = 0; kg < nk; kg += 4) { const int key = kg + sub; f32x4 vv;
        if (key < nk1) vv = *(const GAS f32x4*)(v1 + (size_t)key * kst1 + 4 * dq); else vv = unpack4(*(const GAS v2u*)(v2 + (size_t)(key - nk1) * kst2 + 4 * dq));
#pragma unroll
        for (int qi = 0; qi < NQ; ++qi) acc[qi] += vv * sc[qi * NKP + key]; }
#pragma unroll
    for (int qi = 0; qi < NQ; ++qi) { f32x4 a = acc[qi];
#pragma unroll
        for (int e = 0; e < 4; ++e) { a[e] += __shfl_xor(a[e], 16); a[e] += __shfl_xor(a[e], 32); }
        if (sub == 0) *(GAS v2u*)(out0 + (size_t)(qi & 3) * ostride_q + (qi >> 2) * 64 + 4 * dq) = pack4(a); }
    LDS_WAIT(); asm volatile("" ::: "memory");
}
__device__ __forceinline__ void memattn_sample_task(Frame& F, int layer, int task, LAS float* wl  ) {
    const int lane = F.lane, b = task >> 2, hm = task & 3; LAS float* ql = wl; LAS float* sc = wl + 12 * 64;
#pragma unroll
    for (int i = 0; i < 4; ++i) { const int row = RP + b * ST + i; float x;
        if (layer == 0) { x = bf2f(((const bf16*)(F.ws + WS_PROJ))[(size_t)row * NCOLA + RWKV_COLS + hm * 64 + lane]); const float ss = wave_sum(x * x); x *= rsqrtf(ss * (1.0f / 64.0f) + 1e-6f) * C2Q * F.in[I_MQN][lane]; }
        else x = bf2f(((const bf16*)(F.ws + WS_Q1))[(size_t)row * DM + 768 + hm * 64 + lane]);
        ql[i * 64 + lane] = x; }
    LDS_WAIT(); asm volatile("" ::: "memory");
    const float* k1 = F.in[I_CMK] + (((size_t)layer * SB + b) * NMEM * 4 + hm) * 64; const float* v1 = F.in[I_CMV] + (((size_t)layer * SB + b) * NMEM * 4 + hm) * 64;
    small_attn<4, false>(ql, sc, 264, k1, v1, 256, 256, nullptr, nullptr, 0, 0, nullptr, (bf16*)(F.ws + WS_MIX) + (size_t)(RP + b * ST) * DM + 768 + hm * 64, DM, lane);
}
__device__ __forceinline__ void swa_sample_task(Frame& F, int task, LAS float* wl) {
    const int lane = F.lane, b = task >> 2, kvh = task & 3; LAS float* ql = wl; LAS float* sc = wl + 12 * 64;
#pragma unroll
    for (int qi = 0; qi < 12; ++qi) { const int i = qi & 3, gq = qi >> 2, hq = kvh * 3 + gq; const int row = RP + b * ST + i;
        ql[qi * 64 + lane] = bf2f(((const bf16*)(F.ws + WS_Q1))[(size_t)row * DM + hq * 64 + lane]); }
    LDS_WAIT(); asm volatile("" ::: "memory");
    const float* k1 = F.in[I_CSK] + ((size_t)b * 128 * 4 + kvh) * 64; const float* v1 = F.in[I_CSV] + ((size_t)b * 128 * 4 + kvh) * 64;
    const bf16* k2 = (const bf16*)(F.ws + WS_K1) + (size_t)(RP + b * ST) * 256 + kvh * 64; const bf16* v2 = (const bf16*)(F.ws + WS_V1) + (size_t)(RP + b * ST) * 256 + kvh * 64;
    small_attn<12, true>(ql, sc, 136, k1, v1, 256, 128, k2, v2, 256, 4, F.in[I_SINKS] + kvh * 3, (bf16*)(F.ws + WS_MIX) + (size_t)(RP + b * ST) * DM + kvh * 3 * 64, DM, lane);
}

constexpr int N_PHASES = 13;
template <int PM> __global__ void __launch_bounds__(NWAVES * 64, 2) yoco_fwd(Args args) {
    extern __shared__ __attribute__((aligned(16))) unsigned char lds[];
    Frame F;
    F.lds = (LAS unsigned char*)lds; F.lds_g = lds;
    F.wave = __builtin_amdgcn_readfirstlane((int)threadIdx.x >> 6); F.lane = mk_lane(); F.tid = F.wave * 64 + F.lane;
    F.G = gridDim.x; { const int bx = blockIdx.x; F.vcu = (F.G % 8 == 0) ? (bx % 8) * (F.G / 8) + bx / 8 : bx; }
    F.in = args.in; F.out = args.out; F.ws = args.ws; F.ctl = (gu32*)(args.ws + WS_CTL);
    for (int u = F.tid; u < (LDS_BYTES - LDSCTL_OFF) / 4; u += NWAVES * 64) ((LAS unsigned*)(F.lds + LDSCTL_OFF))[u] = 0u;
    __syncthreads();
    const int lo = args.ph_lo, hi = args.ph_hi;
    XcdBarrier bar; bar.wave0 = F.wave == 0; bar.bar = (unsigned*)(F.ctl + CW_BAR); bar.x = 0; bar.st = nullptr;
    if (hi - lo > 1) bar = xcd_barrier_post((unsigned*)(F.ctl + CW_BAR), (volatile LAS unsigned*)(F.lds + MISC_OFF) + 8, F.wave == 0);
#define IN(k) (((PM >> (k)) & 1) && lo <= (k) && (k) < hi)
#define SEAM(k) do { if (IN(k) && IN((k) + 1)) xcd_barrier(bar); } while (0)
    const int gw = F.vcu * NWAVES + F.wave, NGW = F.G * NWAVES;
#define SSQ ((float*)(F.ws + WS_SSQ))
#define HB ((bf16*)(F.ws + WS_HB))
#define MIX ((bf16*)(F.ws + WS_MIX))
#define HH ((bf16*)(F.ws + WS_H))
#define PHASE_BEGIN() do { int z_ = 0; unsigned char* ws_ = args.ws; float* out_ = args.out; asm volatile("" : "+s"(z_), "+s"(ws_), "+s"(out_)); F.in = args.in + z_; F.ws = ws_; F.out = out_; \
                           F.lane = mk_lane(); F.tid = F.wave * 64 + F.lane; } while (0)

    if (IN(0)) { PHASE_BEGIN(); p0_prologue(F); } SEAM(0);

    if (IN(1)) { PHASE_BEGIN();
        { pg8::Gemm g{HB, (const bf16*)(F.ws + WS_WA), R, NCOLA, DM}; pg8::StaticOrder S; S.init(R, NCOLA, F.G, (int)blockIdx.x);
          pg8::EpiScaleBf16<0> E{(bf16*)(F.ws + WS_PROJ), NCOLA, SSQ};
          pg8::gemm_phase<pg8::EpiScaleBf16<0>, pg8::StaticOrder, true, true>(F.lds + RING_OFF, g, S, E, F.wave, F.lane); }
#ifndef NO_MEMKV
        { pg8::Gemm g{(const bf16*)(F.ws + WS_MB), (const bf16*)(F.ws + WS_WM), 512, 1024, DM}; pg8::StaticOrder S; S.init(512, 1024, F.G, (int)blockIdx.x);
          pg8::EpiMemKV E{F.ws, F.out, F.in[I_MKN]};
          pg8::gemm_phase<pg8::EpiMemKV, pg8::StaticOrder, true, true>(F.lds + RING_OFF, g, S, E, F.wave, F.lane); }
#endif
    } SEAM(1);

    if (IN(2)) { PHASE_BEGIN();
        const int half = F.wave >> 2;
        LAS unsigned char* hb = F.lds + half * PREP_HALF; LAS float* wtot = (LAS float*)(F.lds + WTOT_OFF + half * 1024);
#ifndef NO_PREP
        for (int pi = F.vcu; pi < NUNIT / 2; pi += F.G) rwkv_prep_unit(F, 2 * pi + half, hb, wtot);
#endif
        for (int t = gw; t < SB * NH + 2; t += NGW) {
#ifndef NO_SAMPLE
            if (t < SB * NH) rwkv_sample_task(F, t);
#else
            if (t < SB * NH) {}
#endif
            else { const int b = t - SB * NH; const bf16* lr = (const bf16*)(F.ws + WS_PROJ) + (size_t)(b * T + T - 1) * NCOLA; float* o = F.out + O_PSHIFT + (size_t)b * RWKV_COLS;
                for (int q = F.lane; q < RWKV_COLS; q += 64) o[q] = bf2f(lr[q]); } }
    } SEAM(2);

    if (IN(3)) { PHASE_BEGIN();
        const int nscan = NB * NH;
        if (F.vcu < nscan) { if (F.wave < 4) rwkv_scan_chain(F, F.vcu, F.wave); }
        else { const int ow = (F.vcu - nscan) * NWAVES + F.wave, NOW = (F.G - nscan) * NWAVES; LAS float* wl = (LAS float*)(F.lds + F.wave * 12288);
            for (int t = ow; t < 2048 + 512; t += NOW) { if (t < 2048) memattn_prompt_task(F, 0, t); else memattn_sample_task(F, 0, t - 2048, wl); } }
    } SEAM(3);

    if (IN(4)) { PHASE_BEGIN(); for (int it = gw; it < NUNIT * 4; it += NGW) rwkv_yout_item(F, it); } SEAM(4);

    if (IN(5)) { PHASE_BEGIN(); pg8::Gemm g{MIX, (const bf16*)(F.ws + WS_WOUT), R, DM, DM}; pg8::StaticOrder S; S.init(R, DM, F.G, (int)blockIdx.x);
        pg8::EpiResid E{F.in[I_XP], F.in[I_XS], RP, F.out + O_Y, HB, SSQ};
        pg8::gemm_phase<pg8::EpiResid, pg8::StaticOrder, true, true>(F.lds + RING_OFF, g, S, E, F.wave, F.lane); } SEAM(5);
    if (IN(6)) { PHASE_BEGIN(); pg8::Gemm g{HB, (const bf16*)(F.ws + WS_WUP), R, FF, DM}; pg8::StaticOrder S; S.init(R, FF, F.G, (int)blockIdx.x);
        pg8::EpiScaleBf16<1> E{HH, FF, SSQ};
        pg8::gemm_phase<pg8::EpiScaleBf16<1>, pg8::StaticOrder, true, true>(F.lds + RING_OFF, g, S, E, F.wave, F.lane); } SEAM(6);
    if (IN(7)) { PHASE_BEGIN(); pg8::Gemm g{HH, (const bf16*)(F.ws + WS_WDN), R, DM, FF}; pg8::StaticOrder S; S.init(R, DM, F.G, (int)blockIdx.x);
        pg8::EpiResid E{F.out + O_Y, F.out + O_Y + (size_t)RP * DM, RP, F.out + O_Y, HB, SSQ};
        pg8::gemm_phase<pg8::EpiResid, pg8::StaticOrder, true, true>(F.lds + RING_OFF, g, S, E, F.wave, F.lane); } SEAM(7);

    if (IN(8)) { PHASE_BEGIN(); pg8::Gemm g{HB, (const bf16*)(F.ws + WS_WB), R, NCOLB, DM}; pg8::StaticOrder S; S.init(R, NCOLB, F.G, (int)blockIdx.x);
        pg8::EpiL1 E{F.ws, F.out, F.in[I_QN], F.in[I_MQN] + 64, F.in[I_KN]};
        pg8::gemm_phase<pg8::EpiL1, pg8::StaticOrder, true, true>(F.lds + RING_OFF, g, S, E, F.wave, F.lane); } SEAM(8);

    if (IN(9)) { PHASE_BEGIN(); LAS float* wl = (LAS float*)(F.lds + F.wave * 12288);
        for (int t = gw; t < 6144 + 2048 + 512 + 512; t += NGW) {
            if (t < 6144) swa_prompt_task(F, t); else if (t < 8192) memattn_prompt_task(F, 1, t - 6144);
            else if (t < 8704) swa_sample_task(F, t - 8192, wl); else memattn_sample_task(F, 1, t - 8704, wl); }
    } SEAM(9);

    if (IN(10)) { PHASE_BEGIN(); pg8::Gemm g{MIX, (const bf16*)(F.ws + WS_WOUT) + (size_t)DM * DM, R, DM, DM}; pg8::StaticOrder S; S.init(R, DM, F.G, (int)blockIdx.x);
        pg8::EpiResid E{F.out + O_Y, F.out + O_Y + (size_t)RP * DM, RP, F.out + O_Y, HB, SSQ};
        pg8::gemm_phase<pg8::EpiResid, pg8::StaticOrder, true, true>(F.lds + RING_OFF, g, S, E, F.wave, F.lane); } SEAM(10);
    if (IN(11)) { PHASE_BEGIN(); pg8::Gemm g{HB, (const bf16*)(F.ws + WS_WUP) + (size_t)DM * FF, R, FF, DM}; pg8::StaticOrder S; S.init(R, FF, F.G, (int)blockIdx.x);
        pg8::EpiScaleBf16<1> E{HH, FF, SSQ};
        pg8::gemm_phase<pg8::EpiScaleBf16<1>, pg8::StaticOrder, true, true>(F.lds + RING_OFF, g, S, E, F.wave, F.lane); } SEAM(11);
    if (IN(12)) { PHASE_BEGIN(); pg8::Gemm g{HH, (const bf16*)(F.ws + WS_WDN) + (size_t)DM * FF, R, DM, FF}; pg8::StaticOrder S; S.init(R, DM, F.G, (int)blockIdx.x);
        pg8::EpiResid E{F.out + O_Y, F.out + O_Y + (size_t)RP * DM, RP, F.out + O_Y, nullptr, nullptr};
        pg8::gemm_phase<pg8::EpiResid, pg8::StaticOrder, true, true>(F.lds + RING_OFF, g, S, E, F.wave, F.lane); }
#undef IN
#undef SEAM
#undef SSQ
#undef HB
#undef MIX
#undef HH
#undef PHASE_BEGIN
}

template <int PM> static void launch_pm(int grid, hipStream_t stream, const Args& a) { hipLaunchKernelGGL(yoco_fwd<PM>, dim3(grid), dim3(NWAVES * 64), LDS_BYTES, stream, a); }
template <int PM> static bool set_lds() { return hipFuncSetAttribute((const void*)yoco_fwd<PM>, hipFuncAttributeMaxDynamicSharedMemorySize, LDS_BYTES) == hipSuccess; }
extern "C" void kernel_launch(void* const* d_in, const int* in_sizes, int n_in, void* d_out, int out_size, void* d_ws, size_t ws_size, hipStream_t stream) {
    static int grid = 0;
    if (grid == 0) {
        if (n_in != N_IN || (size_t)out_size != O_END || ws_size < WS_END) { fprintf(stderr, "kernel_launch: unexpected shapes (n_in %d, out %d, ws %zu < %zu)\n", n_in, out_size, ws_size, (size_t)WS_END); grid = -1; return; }
        int dev = 0, cus = 0;
        if (hipGetDevice(&dev) != hipSuccess || hipDeviceGetAttribute(&cus, hipDeviceAttributeMultiprocessorCount, dev) != hipSuccess) { grid = -1; return; }
        bool ok = true;
#if MK_ONE_LAUNCH
        ok = set_lds<0x1fff>();
#else
        ok = set_lds<1>() && set_lds<2>() && set_lds<4>() && set_lds<8>() && set_lds<16>() && set_lds<32>() && set_lds<64>() && set_lds<128>() && set_lds<256>() && set_lds<512>() && set_lds<1024>() && set_lds<2048>() && set_lds<4096>();
#endif
        if (!ok) { grid = -1; return; }
        (void)hipGetLastError();
        grid = cus;
    }
    if (grid < 0) return;
    (void)hipMemsetAsync((char*)d_ws + WS_CTL, 0, CTL_ZERO_BYTES, stream);
    Args a{};
    for (int i = 0; i < N_IN; ++i) a.in[i] = (const float*)d_in[i];
    a.out = (float*)d_out; a.ws = (unsigned char*)d_ws;
#if MK_ONE_LAUNCH
    a.ph_lo = 0; a.ph_hi = N_PHASES; launch_pm<0x1fff>(grid, stream, a);
#else
#define LP(p) a.ph_lo = (p); a.ph_hi = (p) + 1; launch_pm<(1 << (p))>(grid, stream, a);
    LP(0) LP(1) LP(2) LP(3) LP(4) LP(5) LP(6) LP(7) LP(8) LP(9) LP(10) LP(11) LP(12)
#undef LP
#endif
}
```

```cpp
#include <hip/hip_runtime.h>
#include <cstdio>
#include <cstdint>
namespace pg8 {
#define PG8_LAS __attribute__((address_space(3)))
typedef unsigned short bf16_t;
typedef short bf16x8 __attribute__((ext_vector_type(8)));
typedef float f32x4 __attribute__((ext_vector_type(4)));
typedef unsigned u32x4 __attribute__((ext_vector_type(4)));
constexpr int BM = 256, BK = 64, HALF = 128, HTB = HALF * BK * 2  , STAGE_BYTES = 8 * HTB, NXCD = 8, WGM = 8;

__host__ __device__ __forceinline__ int lds_byte(int r, int c) { const int st = (r >> 4) * 2 + (c >> 5), rr = r & 15, cc = c & 31, ob = rr * 64 + cc * 2; return st * 1024 + (ob ^ (((ob >> 9) & 1) << 5)); }
__host__ __device__ __forceinline__ void stage_rc(int b, int& R, int& C) { const int st = b / 1024, sb = b % 1024, swz = sb ^ (((sb >> 9) & 1) << 5); R = (st >> 1) * 16 + swz / 64; C = (st & 1) * 32 + (swz % 64) / 2; }
__host__ __device__ __forceinline__ int perm32(int rho) { const int n = rho >> 4, i = rho & 15; return 8 * (i >> 2) + 4 * n + (i & 3); }

struct Unit { int pm, pn; };
struct Gemm { const bf16_t* A; const bf16_t* Bt; int M, N, K; };

struct StaticOrder {
    int nM, nN, nwg, G, c;
    __host__ __device__ void init(int M, int N, int G_, int c_) { nM = M / BM; nN = N / BM; nwg = nM * nN; G = G_; c = c_; }
    __host__ __device__ bool next(int i, Unit& u) const {
        const long L = (long)i * G + c; if (L >= nwg) return false;
        int wgid = (int)L; { const int q = nwg / NXCD, r = nwg % NXCD, xcd = wgid % NXCD, off = wgid / NXCD; wgid = (xcd < r ? xcd * (q + 1) : r * (q + 1) + (xcd - r) * q) + off; }
        const int nig = WGM * nN, gid = wgid / nig, fm = gid * WGM, gsz = (nM - fm) < WGM ? (nM - fm) : WGM;
        u.pm = fm + ((wgid % nig) % gsz); u.pn = (wgid % nig) / gsz; return true;
    }
    __device__ __forceinline__ void a_ready(const Unit&) const {}
    __device__ __forceinline__ void done(const Unit&) const {}
};


typedef float f32x2_t __attribute__((ext_vector_type(2))); typedef __bf16 bf16x2_t __attribute__((ext_vector_type(2)));
__device__ __forceinline__ unsigned cvt_pk_bf16(float lo, float hi) { f32x2_t v = {lo, hi}; bf16x2_t b = __builtin_convertvector(v, bf16x2_t); return __builtin_bit_cast(unsigned, b); }
__device__ __forceinline__ u32x4 pack8(f32x4 v0, f32x4 v1) { u32x4 w; w.x = cvt_pk_bf16(v0[0], v0[1]); w.y = cvt_pk_bf16(v0[2], v0[3]); w.z = cvt_pk_bf16(v1[0], v1[1]); w.w = cvt_pk_bf16(v1[2], v1[3]); return w; }

template <int M> __device__ __forceinline__ float swz_xor(float v) { return __int_as_float(__builtin_amdgcn_ds_swizzle(__float_as_int(v), (M << 10) | 0x1f)); }
__device__ __forceinline__ float add_x32(float v) { auto r = __builtin_amdgcn_permlane32_swap(__float_as_uint(v), __float_as_uint(v), false, false); return __uint_as_float(r[0]) + __uint_as_float(r[1]); }
__device__ __forceinline__ float max_x32(float v) { auto r = __builtin_amdgcn_permlane32_swap(__float_as_uint(v), __float_as_uint(v), false, false); return fmaxf(__uint_as_float(r[0]), __uint_as_float(r[1])); }
__device__ __forceinline__ float add_x16(float v) { return v + swz_xor<16>(v); }
__device__ __forceinline__ float hsum4(f32x4 a) { return (a[0] + a[1]) + (a[2] + a[3]); }
__device__ __forceinline__ float row_rstd(const float* ssq, int row) {
    const f32x4* p = (const f32x4*)(ssq + (size_t)row * 16);
    const f32x4 a = p[0], b = p[1], c = p[2], d = p[3];
    const float s = (hsum4(a) + hsum4(b)) + (hsum4(c) + hsum4(d));
    return rsqrtf(s * (1.0f / 1024.0f) + 1e-6f);
}
template <int ACT> struct EpiScaleBf16 {
    static constexpr bool PERM = true, AFTER_DRAIN = false;
    bf16_t* O; int ldc; const float* ssq;
    __device__ __forceinline__ void operator()(const f32x4 (&acc)[2][2][4][2], const Unit& u, int wr, int wc, int fr_, int fq_) const {
        int fr = fr_, fq = fq_; asm volatile("" : "+v"(fr), "+v"(fq));
        const int row0 = u.pm * BM + wr * 64 + fr, col0 = u.pn * BM + wc * 32 + 8 * fq;
#pragma unroll
        for (int ai = 0; ai < 2; ++ai)
#pragma unroll
            for (int m = 0; m < 4; ++m) { const int row = row0 + ai * HALF + m * 16; const float rs = row_rstd(ssq, row); bf16_t* rowp = O + (size_t)row * ldc + col0;
#pragma unroll
                for (int bj = 0; bj < 2; ++bj) { f32x4 v0 = acc[ai][bj][m][0] * rs, v1 = acc[ai][bj][m][1] * rs;
                    if (ACT == 1) {
#pragma unroll
                        for (int e = 0; e < 4; ++e) { const float a = fmaxf(v0[e], 0.f), b = fmaxf(v1[e], 0.f); v0[e] = a * a; v1[e] = b * b; } }
                    *(u32x4*)(rowp + bj * HALF) = pack8(v0, v1); } }
    }
};
struct EpiResid {
    static constexpr bool PERM = true, AFTER_DRAIN = false;
    const float* base; const float* base2; int split; float* out; bf16_t* hb; float* ssq_out;
    __device__ __forceinline__ void operator()(const f32x4 (&acc)[2][2][4][2], const Unit& u, int wr, int wc, int fr_, int fq_) const {
        int fr = fr_, fq = fq_; asm volatile("" : "+v"(fr), "+v"(fq));
        const int row0 = u.pm * BM + wr * 64 + fr, col0 = u.pn * BM + wc * 32 + 8 * fq;
#pragma unroll
        for (int ai = 0; ai < 2; ++ai)
#pragma unroll
            for (int m = 0; m < 4; ++m) { const int row = row0 + ai * HALF + m * 16;
                const float* bp = (row < split ? base + (size_t)row * 1024 : base2 + (size_t)(row - split) * 1024) + col0;
                float* op = out + (size_t)row * 1024 + col0; float ss = 0.f;
#pragma unroll
                for (int bj = 0; bj < 2; ++bj) { const f32x4 b0 = *(const f32x4*)(bp + bj * HALF), b1 = *(const f32x4*)(bp + bj * HALF + 4);
                    const f32x4 h0 = b0 + acc[ai][bj][m][0], h1 = b1 + acc[ai][bj][m][1];
                    *(f32x4*)(op + bj * HALF) = h0; *(f32x4*)(op + bj * HALF + 4) = h1;
                    if (hb) *(u32x4*)(hb + (size_t)row * 1024 + col0 + bj * HALF) = pack8(h0, h1);
                    ss += hsum4(h0 * h0) + hsum4(h1 * h1); }
                if (ssq_out) { ss = add_x16(ss); ss = add_x32(ss); if (fq == 0) ssq_out[(size_t)row * 16 + u.pn * 4 + wc] = ss; }
                if (m & 1) asm volatile("" ::: "memory"); }
    }
};
template <class Epi, class Sched, bool ALIGN_EPI = false, bool SP2 = false>
__device__ __forceinline__ void gemm_phase(PG8_LAS unsigned char* lds, const Gemm g, const Sched& S, const Epi& E, int wid_in, int lane_in) {
    const int wid = wid_in, lane = lane_in, tid = wid * 64 + lane, wr = wid >> 2, wc = wid & 3, fr = lane & 15, fq = lane >> 4;
    const int K = g.K, nt = K / BK;
    unsigned voffA[2], voffB[2];
#pragma unroll
    for (int i = 0; i < 2; ++i) { int R, C; stage_rc(tid * 16 + i * 8192, R, C); const int Rb = Epi::PERM ? ((R & ~31) + perm32(R & 31)) : R;
        voffA[i] = (unsigned)(R * K + C) * 2u; voffB[i] = (unsigned)(Rb * K + C) * 2u; }
    const size_t kstep = (size_t)(BK * 2);
    const size_t hstep = (size_t)HALF * K * 2;
    const size_t tstep = 2 * hstep;
    const unsigned ldsw = (unsigned)wid * 1024u;
    const int aoff = lds_byte(wr * 64 + fr, fq * 8), boff = lds_byte(wc * 32 + fr, fq * 8);
#define PG8_SA(b, h) (((b) * 2 + (h)) * HTB)
#define PG8_SB(b, h) ((4 + (b) * 2 + (h)) * HTB)
#define PG8_STAGE(bufoff, gbase, voff) do { _Pragma("unroll") for (int _i = 0; _i < 2; ++_i) \
        __builtin_amdgcn_global_load_lds((const unsigned*)((const char*)(gbase) + (voff)[_i]), (PG8_LAS unsigned*)(lds + (bufoff) + ldsw + _i * 8192), 16, 0, 0); } while (0)
#define PG8_LDA(dst, b, h) do { _Pragma("unroll") for (int m = 0; m < 4; ++m) _Pragma("unroll") for (int k = 0; k < 2; ++k) dst[m][k] = *(const PG8_LAS bf16x8*)(lds + PG8_SA(b, h) + aoff + m * 2048 + k * 1024); } while (0)
#define PG8_LDB(dst, b, h) do { _Pragma("unroll") for (int n = 0; n < 2; ++n) _Pragma("unroll") for (int k = 0; k < 2; ++k) dst[n][k] = *(const PG8_LAS bf16x8*)(lds + PG8_SB(b, h) + boff + n * 2048 + k * 1024); } while (0)
#define PG8_MMA(ai, bj, At, Bt) do { __builtin_amdgcn_s_setprio(1); _Pragma("unroll") for (int m = 0; m < 4; ++m) _Pragma("unroll") for (int n = 0; n < 2; ++n) _Pragma("unroll") for (int k = 0; k < 2; ++k) \
        acc[ai][bj][m][n] = __builtin_amdgcn_mfma_f32_16x16x32_bf16(Bt[n][k], At[m][k], acc[ai][bj][m][n], 0, 0, 0); __builtin_amdgcn_s_setprio(0); } while (0)
#define PG8_WAIT_V(n) asm volatile("s_waitcnt vmcnt(" #n ")" ::: "memory")
#define PG8_WAIT_L(n) asm volatile("s_waitcnt lgkmcnt(" #n ")" ::: "memory")
#define PG8_BAR __builtin_amdgcn_s_barrier()
#define PG8_SCHED __builtin_amdgcn_sched_barrier(0)
    Unit cur, nxt; int ui = 0;
    if (!S.next(0, cur)) return;
    f32x4 acc[2][2][4][2];
#pragma unroll
    for (int a = 0; a < 2; ++a)
#pragma unroll
        for (int b = 0; b < 2; ++b)
#pragma unroll
            for (int m = 0; m < 4; ++m)
#pragma unroll
                for (int n = 0; n < 2; ++n) acc[a][b][m][n] = (f32x4){0.f, 0.f, 0.f, 0.f};
    bf16x8 At[4][2], B0[2][2], B1[2][2];
    const char* cA = (const char*)g.A + (size_t)cur.pm * tstep; const char* cB = (const char*)g.Bt + (size_t)cur.pn * tstep;
    S.a_ready(cur);
    if constexpr (SP2) {
        PG8_STAGE(PG8_SB(0, 0), cB, voffB); PG8_STAGE(PG8_SB(0, 1), cB + hstep, voffB); PG8_STAGE(PG8_SA(0, 0), cA, voffA); PG8_STAGE(PG8_SA(0, 1), cA + hstep, voffA);
        if (wr == 1) PG8_BAR;
        PG8_WAIT_V(2); PG8_BAR;
        PG8_STAGE(PG8_SB(1, 0), cB + kstep, voffB); PG8_STAGE(PG8_SA(1, 0), cA + kstep, voffA); PG8_STAGE(PG8_SB(1, 1), cB + hstep + kstep, voffB);
        PG8_WAIT_V(6); PG8_BAR;
    } else {
        PG8_STAGE(PG8_SB(0, 0), cB, voffB); PG8_STAGE(PG8_SA(0, 0), cA, voffA); PG8_STAGE(PG8_SB(0, 1), cB + hstep, voffB); PG8_STAGE(PG8_SA(0, 1), cA + hstep, voffA);
        if (wr == 1) PG8_BAR;
        PG8_WAIT_V(4); PG8_BAR;
        PG8_STAGE(PG8_SB(1, 0), cB + kstep, voffB); PG8_STAGE(PG8_SA(1, 0), cA + kstep, voffA); PG8_STAGE(PG8_SB(1, 1), cB + hstep + kstep, voffB);
        PG8_WAIT_V(6); PG8_BAR;
    }
    for (;;) {
        const bool has_next = S.next(ui + 1, nxt);
        const char* nA = has_next ? (const char*)g.A + (size_t)nxt.pm * tstep : cA; const char* nB = has_next ? (const char*)g.Bt + (size_t)nxt.pn * tstep : cB;
        for (int t = 0; t < nt; t += 2) {
            const bool last = (t == nt - 2);
            const char* a1 = cA + (size_t)(t + 1) * kstep;
            const char* a2 = last ? nA : cA + (size_t)(t + 2) * kstep; const char* b2 = last ? nB : cB + (size_t)(t + 2) * kstep;
            const char* a3 = a2 + kstep; const char* b3 = b2 + kstep;
            if (last && has_next) S.a_ready(nxt);
            if constexpr (SP2) {
            PG8_LDB(B0, 0, 0); PG8_LDB(B1, 0, 1); PG8_SCHED; PG8_LDA(At, 0, 0); PG8_STAGE(PG8_SA(1, 1), a1 + hstep, voffA);
            PG8_WAIT_V(8); PG8_WAIT_L(0); PG8_BAR; PG8_MMA(0, 0, At, B0); PG8_MMA(0, 1, At, B1); PG8_BAR; PG8_SCHED;
            PG8_LDA(At, 0, 1); PG8_STAGE(PG8_SB(0, 0), b2, voffB); PG8_STAGE(PG8_SB(0, 1), b2 + hstep, voffB); PG8_STAGE(PG8_SA(0, 0), a2, voffA);
            PG8_WAIT_V(8); PG8_WAIT_L(0); PG8_BAR; PG8_MMA(1, 0, At, B0); PG8_MMA(1, 1, At, B1); PG8_BAR; PG8_SCHED;
            PG8_LDB(B0, 1, 0); PG8_LDB(B1, 1, 1); PG8_SCHED; PG8_LDA(At, 1, 0); PG8_STAGE(PG8_SA(0, 1), a2 + hstep, voffA);
            PG8_WAIT_V(8); PG8_WAIT_L(0); PG8_BAR; PG8_MMA(0, 0, At, B0); PG8_MMA(0, 1, At, B1); PG8_BAR; PG8_SCHED;
            PG8_LDA(At, 1, 1); PG8_STAGE(PG8_SB(1, 0), b3, voffB); PG8_STAGE(PG8_SB(1, 1), b3 + hstep, voffB); PG8_STAGE(PG8_SA(1, 0), a3, voffA);
            PG8_WAIT_V(8); PG8_WAIT_L(0); PG8_BAR; PG8_MMA(1, 0, At, B0); PG8_MMA(1, 1, At, B1); PG8_BAR; PG8_SCHED;
            } else {
            PG8_LDB(B0, 0, 0); PG8_SCHED; PG8_LDA(At, 0, 0); PG8_STAGE(PG8_SA(1, 1), a1 + hstep, voffA);
            PG8_WAIT_L(8); PG8_BAR; PG8_WAIT_L(0); PG8_MMA(0, 0, At, B0); PG8_BAR; PG8_SCHED;
            PG8_LDB(B1, 0, 1); PG8_STAGE(PG8_SB(0, 0), b2, voffB);
            PG8_BAR; PG8_WAIT_L(0); PG8_MMA(0, 1, At, B1); PG8_BAR;
            PG8_LDA(At, 0, 1); PG8_STAGE(PG8_SA(0, 0), a2, voffA);
            PG8_BAR; PG8_WAIT_L(0); PG8_MMA(1, 0, At, B0); PG8_BAR; PG8_SCHED;
            PG8_STAGE(PG8_SB(0, 1), b2 + hstep, voffB);
            PG8_WAIT_V(6); PG8_BAR; PG8_MMA(1, 1, At, B1); PG8_BAR;
            PG8_LDB(B0, 1, 0); PG8_SCHED; PG8_LDA(At, 1, 0); PG8_STAGE(PG8_SA(0, 1), a2 + hstep, voffA);
            PG8_WAIT_L(8); PG8_BAR; PG8_WAIT_L(0); PG8_MMA(0, 0, At, B0); PG8_BAR; PG8_SCHED;
            PG8_LDB(B1, 1, 1); PG8_STAGE(PG8_SB(1, 0), b3, voffB);
            PG8_BAR; PG8_WAIT_L(0); PG8_MMA(0, 1, At, B1); PG8_BAR;
            PG8_LDA(At, 1, 1); PG8_STAGE(PG8_SA(1, 0), a3, voffA);
            PG8_BAR; PG8_WAIT_L(0); PG8_MMA(1, 0, At, B0); PG8_BAR; PG8_SCHED;
            PG8_STAGE(PG8_SB(1, 1), b3 + hstep, voffB);
            PG8_WAIT_V(6); PG8_BAR; PG8_MMA(1, 1, At, B1); PG8_BAR;
            }
        }
        if constexpr (ALIGN_EPI) { if (wr == 0) PG8_BAR; }
        if constexpr (!Epi::AFTER_DRAIN) { E(acc, cur, wr, wc, fr, fq); S.done(cur); }
        if (!has_next) break;
#pragma unroll
        for (int a = 0; a < 2; ++a)
#pragma unroll
            for (int b = 0; b < 2; ++b)
#pragma unroll
                for (int m = 0; m < 4; ++m)
#pragma unroll
                    for (int n = 0; n < 2; ++n) acc[a][b][m][n] = (f32x4){0.f, 0.f, 0.f, 0.f};
        cur = nxt; cA = nA; cB = nB; ++ui;
        if constexpr (ALIGN_EPI) { if (wr == 1) PG8_BAR; }
    }
    PG8_WAIT_V(0);
    if constexpr (!ALIGN_EPI) { if (wr == 0) PG8_BAR; }
    PG8_BAR;
    if constexpr (Epi::AFTER_DRAIN) { E.fused(acc, cur, wr, wc, fr, fq, lds, wid, lane); S.done(cur); }
#undef PG8_SA
#undef PG8_SB
#undef PG8_STAGE
#undef PG8_LDA
#undef PG8_LDB
#undef PG8_MMA
#undef PG8_WAIT_V
#undef PG8_WAIT_L
#undef PG8_BAR
#undef PG8_SCHED
}
}

constexpr int NWAVES = 8;
#ifndef MK_ONE_LAUNCH
#define MK_ONE_LAUNCH 1
#endif
constexpr int DM = 1024, RP = 16384  , RS = 512  , R = RP + RS, T = 8192, NB = 2, SB = 128, ST = 4;
constexpr int NCOLA = 2816, RWKV_COLS = 2560, NH = 12, HD = 64, FF = 4096, NCOLB = 1536, NMEM = 256;
constexpr int NCHUNK = RP / 64  , NUNIT = NCHUNK * NH  ;
constexpr float C2Q = 0.125f * 1.4426950408889634f;
constexpr float LOG2E = 1.4426950408889634f;
enum { I_XP = 0, I_XS, I_SSHIFT, I_SWKV, I_CSK, I_CSV, I_CMK, I_CMV, I_MEMP, I_NMIX, I_NMLP, I_WOUT, I_WUP, I_WDN, I_MNORM, I_WMKV, I_MQN, I_MKN,
       I_WINA, I_MU, I_WW2, I_W0, I_WA2, I_A0, I_WG2, I_KK, I_KA, I_RK, I_LNW, I_LNB, I_WINB, I_QN, I_SINKS, I_KVN, I_WKV, I_KN, N_IN };
constexpr size_t O_Y = 0, O_PSHIFT = (size_t)R * DM, O_PWKV = O_PSHIFT + 2 * RWKV_COLS, O_PSK = O_PWKV + 2 * 12 * 4096, O_PSV = O_PSK + 2 * 128 * 256,
                 O_PMK = O_PSV + 2 * 128 * 256, O_PMV = O_PMK + 2 * 2 * 256 * 256, O_SSHIFT = O_PMV + 2 * 2 * 256 * 256, O_SWKV = O_SSHIFT + (size_t)SB * RWKV_COLS,
                 O_SSK = O_SWKV + (size_t)SB * 12 * 4096, O_SSV = O_SSK + (size_t)SB * 128 * 256, O_END = O_SSV + (size_t)SB * 128 * 256;
constexpr size_t al256(size_t x) { return (x + 255) & ~(size_t)255; }
constexpr size_t WS_CTL = 0, CTL_ZERO_BYTES = 1u << 20;
constexpr size_t WS_WA = CTL_ZERO_BYTES;
constexpr size_t WS_WOUT = WS_WA + (size_t)NCOLA * DM * 2;
constexpr size_t WS_WUP = WS_WOUT + (size_t)2 * DM * DM * 2;
constexpr size_t WS_WDN = WS_WUP + (size_t)2 * FF * DM * 2;
constexpr size_t WS_WB = WS_WDN + (size_t)2 * FF * DM * 2;
constexpr size_t WS_WM = WS_WB + (size_t)NCOLB * DM * 2;
constexpr size_t WS_WW2 = WS_WM + (size_t)DM * DM * 2;
constexpr size_t WS_WA2 = WS_WW2 + (size_t)768 * 64 * 2;
constexpr size_t WS_WG2 = WS_WA2 + (size_t)768 * 64 * 2;
constexpr size_t WS_ROPE = WS_WG2 + (size_t)768 * 128 * 2;
constexpr size_t WS_SSQ = al256(WS_ROPE + (size_t)8196 * 64 * 4);
constexpr size_t WS_SSQM = WS_SSQ + (size_t)R * 16 * 4;
constexpr size_t WS_MB = WS_SSQM + (size_t)512 * 16 * 4;
constexpr size_t WS_MK = WS_MB + (size_t)512 * DM * 2;
constexpr size_t WS_MVT = WS_MK + (size_t)2 * 2 * 4 * 256 * 64 * 2;
constexpr size_t WS_HB = WS_MVT + (size_t)2 * 2 * 4 * 256 * 64 * 2;
constexpr size_t WS_MIX = WS_HB + (size_t)R * DM * 2;
constexpr size_t WS_BIG = WS_MIX + (size_t)R * DM * 2;
constexpr size_t WS_PROJ = WS_BIG;
constexpr size_t WS_REC = WS_PROJ + (size_t)R * NCOLA * 2;
constexpr size_t REC_BYTES = 5 * 8192;
constexpr size_t WS_END0 = WS_REC + (size_t)NUNIT * REC_BYTES;
constexpr size_t WS_H = WS_BIG;
constexpr size_t WS_END1 = WS_H + (size_t)R * FF * 2;
constexpr size_t WS_Q1 = WS_BIG;
constexpr size_t WS_K1 = WS_Q1 + (size_t)R * DM * 2;
constexpr size_t WS_V1 = WS_K1 + (size_t)R * 256 * 2;
constexpr size_t WS_VT1 = WS_V1 + (size_t)R * 256 * 2;
constexpr size_t WS_END = WS_END0 > WS_END1 ? WS_END0 : WS_END1;
static_assert(WS_VT1 + (size_t)2 * 4 * 64 * 8192 * 2 <= WS_END, "ws map");
constexpr int CW_BAR = 4096;
constexpr int RING_OFF = 0, RING_BYTES = 131072, PREP_HALF = 73728, LDSCTL_OFF = 147456, MISC_OFF = LDSCTL_OFF + 320, WTOT_OFF = LDSCTL_OFF + 1024, LDS_BYTES = LDSCTL_OFF + 4096;

#define GAS __attribute__((address_space(1)))
#define LAS __attribute__((address_space(3)))
typedef unsigned short bf16;
typedef unsigned v4u __attribute__((ext_vector_type(4)));
typedef unsigned v2u __attribute__((ext_vector_type(2)));
typedef float f32x4 __attribute__((ext_vector_type(4)));
typedef float f32x16 __attribute__((ext_vector_type(16)));
typedef short bf16x8 __attribute__((ext_vector_type(8)));
typedef short bf16x4 __attribute__((ext_vector_type(4)));
typedef GAS unsigned gu32;
#define RLX_AGENT __ATOMIC_RELAXED, __HIP_MEMORY_SCOPE_AGENT
#define LDS_WAIT() asm volatile("s_waitcnt lgkmcnt(0)" ::: "memory")
#define VM_WAIT() asm volatile("s_waitcnt vmcnt(0)" ::: "memory")
using pg8::cvt_pk_bf16;
__device__ __forceinline__ int mk_lane() { int l; asm volatile("v_mbcnt_lo_u32_b32 %0, -1, 0\n\tv_mbcnt_hi_u32_b32 %0, -1, %0" : "=v"(l)); return l; }
__device__ __forceinline__ float bf2f(unsigned v) { return __uint_as_float(v << 16); }
__device__ __forceinline__ float bflo(unsigned w) { return __uint_as_float(w << 16); }
__device__ __forceinline__ float bfhi(unsigned w) { return __uint_as_float(w & 0xffff0000u); }
__device__ __forceinline__ bf16 f2bf(float f) { return (bf16)(cvt_pk_bf16(f, 0.f) & 0xffffu); }
__device__ __forceinline__ v2u pack4(f32x4 v) { v2u w; w.x = cvt_pk_bf16(v[0], v[1]); w.y = cvt_pk_bf16(v[2], v[3]); return w; }
__device__ __forceinline__ f32x4 unpack4(v2u w) { return (f32x4){bflo(w.x), bfhi(w.x), bflo(w.y), bfhi(w.y)}; }
__device__ __forceinline__ f32x4 mfma16(bf16x8 a, bf16x8 b, f32x4 c) { return __builtin_amdgcn_mfma_f32_16x16x32_bf16(a, b, c, 0, 0, 0); }
__device__ __forceinline__ f32x16 mfma32(bf16x8 a, bf16x8 b, f32x16 c) { return __builtin_amdgcn_mfma_f32_32x32x16_bf16(a, b, c, 0, 0, 0); }
using pg8::swz_xor; using pg8::add_x32; using pg8::max_x32; using pg8::add_x16;
__device__ __forceinline__ float sum16(float v) { v += swz_xor<1>(v); v += swz_xor<2>(v); v += swz_xor<4>(v); v += swz_xor<8>(v); return v; }
__device__ __forceinline__ float wave_sum(float v) { v = sum16(v); v = add_x16(v); return add_x32(v); }
__device__ __forceinline__ float wave_max(float v) { v = fmaxf(v, swz_xor<1>(v)); v = fmaxf(v, swz_xor<2>(v)); v = fmaxf(v, swz_xor<4>(v)); v = fmaxf(v, swz_xor<8>(v)); v = fmaxf(v, swz_xor<16>(v)); return max_x32(v); }
__device__ __forceinline__ float fsigmoid(float x) { return 1.0f / (1.0f + __expf(-x)); }
__device__ __forceinline__ float ftanh(float x) { const float e = __expf(2.0f * x); return 1.0f - 2.0f / (e + 1.0f); }
namespace pg8 {
__device__ __forceinline__ void head_norm(f32x4 (&x)[2][2], const float* gain, int fq) {
    float ss = 0.f;
#pragma unroll
    for (int bj = 0; bj < 2; ++bj)
#pragma unroll
        for (int n = 0; n < 2; ++n) ss += hsum4(x[bj][n] * x[bj][n]);
    ss = add_x16(ss); ss = add_x32(ss);
    const float rs = rsqrtf(ss * (1.0f / 64.0f) + 1e-6f);
#pragma unroll
    for (int bj = 0; bj < 2; ++bj)
#pragma unroll
        for (int n = 0; n < 2; ++n) { const f32x4 g = *(const f32x4*)(gain + 32 * bj + 8 * fq + 4 * n); x[bj][n] = x[bj][n] * rs * g; }
}
__device__ __forceinline__ void head_rope(f32x4 (&x)[2][2], const float* cs  , int fq) {
#pragma unroll
    for (int n = 0; n < 2; ++n) { const f32x4 t0 = *(const f32x4*)(cs + 2 * (8 * fq + 4 * n)), t1 = *(const f32x4*)(cs + 2 * (8 * fq + 4 * n) + 4);
        const f32x4 cc = {t0[0], t0[2], t1[0], t1[2]}, sn = {t0[1], t0[3], t1[1], t1[3]};
        const f32x4 x1 = x[0][n], x2 = x[1][n]; x[0][n] = x1 * cc - x2 * sn; x[1][n] = x2 * cc + x1 * sn; }
}
struct EpiL1 {
    static constexpr bool PERM = true, AFTER_DRAIN = false;
    unsigned char* ws; float* outp; const float* g_q; const float* g_mq; const float* g_k;
    __device__ __forceinline__ void operator()(const f32x4 (&acc)[2][2][4][2], const Unit& u, int wr, int wc, int fr_, int fq_) const {
        int fr = fr_, fq = fq_; asm volatile("" : "+v"(fr), "+v"(fq));
        const float* ssq = (const float*)(ws + WS_SSQ); const float* rope = (const float*)(ws + WS_ROPE); const float c2 = C2Q;
        bf16_t* Q1 = (bf16_t*)(ws + WS_Q1); bf16_t* K1 = (bf16_t*)(ws + WS_K1); bf16_t* V1 = (bf16_t*)(ws + WS_V1); bf16_t* VT1 = (bf16_t*)(ws + WS_VT1);
        float* p_k = outp + O_PSK; float* p_v = outp + O_PSV; float* s_k = outp + O_SSK; float* s_v = outp + O_SSV;
        const int H = u.pn * 4 + wc, row0 = u.pm * BM + wr * 64 + fr;
#pragma unroll
        for (int ai = 0; ai < 2; ++ai)
#pragma unroll
            for (int m = 0; m < 4; ++m) { const int row = row0 + ai * HALF + m * 16; const float rs = row_rstd(ssq, row);
                const int pidx = row < 16384 ? (row & 8191) : 8192 + ((row - 16384) & 3);
                f32x4 x[2][2];
#pragma unroll
                for (int bj = 0; bj < 2; ++bj)
#pragma unroll
                    for (int n = 0; n < 2; ++n) x[bj][n] = acc[ai][bj][m][n] * rs;
                if (H < 16) {
                    head_norm(x, H < 12 ? g_q : g_mq, fq);
                    if (H < 12) head_rope(x, rope + (size_t)pidx * 64, fq);
#pragma unroll
                    for (int bj = 0; bj < 2; ++bj) *(u32x4*)(Q1 + (size_t)row * 1024 + H * 64 + 32 * bj + 8 * fq) = pack8(x[bj][0] * c2, x[bj][1] * c2);
                } else {
                    const int kh = (H - 16) & 3; const bool isk = H < 20;
                    if (isk) { head_norm(x, g_k, fq); head_rope(x, rope + (size_t)pidx * 64, fq); }
                    bf16_t* dst = isk ? K1 : V1;
#pragma unroll
                    for (int bj = 0; bj < 2; ++bj) *(u32x4*)(dst + (size_t)row * 256 + kh * 64 + 32 * bj + 8 * fq) = pack8(x[bj][0], x[bj][1]);
                    if (!isk && row < 16384) {
                        const int b = row >> 13, t = row & 8191;
#pragma unroll
                        for (int bj = 0; bj < 2; ++bj)
#pragma unroll
                            for (int n = 0; n < 2; ++n)
#pragma unroll
                                for (int e = 0; e < 4; ++e) { const int d = 32 * bj + 8 * fq + 4 * n + e; VT1[((size_t)(b * 4 + kh) * 64 + d) * 8192 + t] = (bf16_t)(cvt_pk_bf16(x[bj][n][e], 0.f) & 0xffffu); } }
                    float* o = nullptr;
                    if (row < 16384) { const int b = row >> 13, t = row & 8191; if (t >= 8064) o = (isk ? p_k : p_v) + ((size_t)(b * 128 + (t - 8064)) * 4 + kh) * 64; }
                    else { const int b = (row - 16384) >> 2, i = (row - 16384) & 3; o = (isk ? s_k : s_v) + ((size_t)(b * 128 + 124 + i) * 4 + kh) * 64; }
                    if (o) {
#pragma unroll
                        for (int bj = 0; bj < 2; ++bj) { *(f32x4*)(o + 32 * bj + 8 * fq) = x[bj][0]; *(f32x4*)(o + 32 * bj + 8 * fq + 4) = x[bj][1]; } }
                }
                asm volatile("" ::: "memory");
            }
    }
};
struct EpiMemKV {
    static constexpr bool PERM = true, AFTER_DRAIN = false;
    unsigned char* ws; float* outp; const float* g_k  ;
    __device__ __forceinline__ void operator()(const f32x4 (&acc)[2][2][4][2], const Unit& u, int wr, int wc, int fr_, int fq_) const {
        int fr = fr_, fq = fq_; asm volatile("" : "+v"(fr), "+v"(fq));
        const float* ssq = (const float*)(ws + WS_SSQM); float* p_k = outp + O_PMK; float* p_v = outp + O_PMV; bf16_t* MK = (bf16_t*)(ws + WS_MK)  ; bf16_t* MVT = (bf16_t*)(ws + WS_MVT)  ;
        const int H = u.pn * 4 + wc, l = H >> 3, isv = (H >> 2) & 1, hh = H & 3, row0 = u.pm * BM + wr * 64 + fr;
#pragma unroll
        for (int ai = 0; ai < 2; ++ai)
#pragma unroll
            for (int m = 0; m < 4; ++m) { const int row = row0 + ai * HALF + m * 16; const float rs = row_rstd(ssq, row); const int b = row >> 8, mm = row & 255;
                f32x4 x[2][2];
#pragma unroll
                for (int bj = 0; bj < 2; ++bj)
#pragma unroll
                    for (int n = 0; n < 2; ++n) x[bj][n] = acc[ai][bj][m][n] * rs;
                if (!isv) head_norm(x, g_k + l * 64, fq);
                float* o = (isv ? p_v : p_k) + ((((size_t)l * 2 + b) * 256 + mm) * 4 + hh) * 64;
#pragma unroll
                for (int bj = 0; bj < 2; ++bj) { *(f32x4*)(o + 32 * bj + 8 * fq) = x[bj][0]; *(f32x4*)(o + 32 * bj + 8 * fq + 4) = x[bj][1]; }
                if (!isv) {
#pragma unroll
                    for (int bj = 0; bj < 2; ++bj) *(u32x4*)(MK + ((((size_t)l * 2 + b) * 4 + hh) * 256 + mm) * 64 + 32 * bj + 8 * fq) = pack8(x[bj][0], x[bj][1]);
                } else {
#pragma unroll
                    for (int bj = 0; bj < 2; ++bj)
#pragma unroll
                        for (int n = 0; n < 2; ++n)
#pragma unroll
                            for (int e = 0; e < 4; ++e) { const int d = 32 * bj + 8 * fq + 4 * n + e; MVT[((((size_t)l * 2 + b) * 4 + hh) * 64 + d) * 256 + mm] = (bf16_t)(cvt_pk_bf16(x[bj][n][e], 0.f) & 0xffffu); }
                }
                asm volatile("" ::: "memory");
            }
    }
};
}
#define XB_TMO      128
#define XB_XCNT(j)  (256  + 64 * (j))
#define XB_XSUB(j)  (1280 + 64 * (j))
#define XB_XGEN(j)  (2304 + 64 * (j))
#define XB_TOP      3328
#define XB_TOPGEN   3392
#define XCD_BAR_WORDS 3456
#define XB_SPIN_CAP (1u << 18)

__device__ __forceinline__ unsigned xb_ld(unsigned* p)              { return __hip_atomic_load(p, __ATOMIC_RELAXED, __HIP_MEMORY_SCOPE_AGENT); }
__device__ __forceinline__ unsigned xb_add(unsigned* p, unsigned v) { return __hip_atomic_fetch_add(p, v, __ATOMIC_RELAXED, __HIP_MEMORY_SCOPE_AGENT); }
__device__ __forceinline__ unsigned xb_xcc_id() { return (unsigned)__builtin_amdgcn_s_getreg((3 << 11) | 20) & 0xFu; }
#define XB_SPIN(cond, bar) do { unsigned _sp = 0; while (cond) { __builtin_amdgcn_s_sleep(1); \
    if ((++_sp & 255u) == 0u) { if (xb_ld(&(bar)[XB_TMO])) break; if (_sp > XB_SPIN_CAP) { atomicAdd(&(bar)[XB_TMO], 1u); break; } } } } while (0)

struct XcdBarrier {
    bool wave0;
    unsigned* bar; unsigned x;
    volatile LAS unsigned* st;
};

__device__ __forceinline__ XcdBarrier xcd_barrier_post(unsigned* bar, volatile LAS unsigned* st, bool wave0) {
    XcdBarrier b; b.wave0 = wave0; b.bar = bar; b.x = xb_xcc_id(); b.st = st;
    if (wave0 && mk_lane() == 0) (void)xb_add(&bar[XB_XCNT(b.x)], 1u);
    return b;
}
__device__ __forceinline__ void xcd_barrier_complete(unsigned* bar, unsigned x, unsigned& nloc, unsigned& nx) {
    const unsigned G = gridDim.x * gridDim.y * gridDim.z;
    unsigned sum, cnt, mine, sp = 0u;
    for (;;) {
        sum = 0u; cnt = 0u; mine = 0u;
#pragma unroll
        for (unsigned j = 0; j < 16; ++j) { const unsigned c = xb_ld(&bar[XB_XCNT(j)]); sum += c; cnt += (c > 0u) ? 1u : 0u; mine = (j == x) ? c : mine; }
        if (sum == G) break;
        __builtin_amdgcn_s_sleep(1);
        if ((++sp & 255u) == 0u) { if (xb_ld(&bar[XB_TMO])) break; if (sp > XB_SPIN_CAP) { atomicAdd(&bar[XB_TMO], 1u); break; } }
    }
    nloc = mine > 0u ? mine : 1u; nx = cnt > 0u ? cnt : 1u;
}

__device__ __forceinline__ void xcd_barrier(const XcdBarrier& b) {
    asm volatile("s_waitcnt vmcnt(0)" ::: "memory");
    __syncthreads();
    if (b.wave0 && mk_lane() == 0) {
        unsigned* bar = b.bar;
        __builtin_amdgcn_s_waitcnt(0);
        unsigned nloc = b.st[0], nx = b.st[1];
        if (nloc == 0u) { xcd_barrier_complete(bar, b.x, nloc, nx); b.st[0] = nloc; b.st[1] = nx; }
        const unsigned old = xb_add(&bar[XB_XSUB(b.x)], 1u);
        const unsigned gen = old / nloc;
        if (old + 1u == (gen + 1u) * nloc) {
            __builtin_amdgcn_fence(__ATOMIC_RELEASE, "agent");
            asm volatile("s_waitcnt vmcnt(0)" ::: "memory");
            const unsigned og = xb_add(&bar[XB_TOP], 1u);
            const unsigned tg = og / nx;
            if (og + 1u == (tg + 1u) * nx) xb_add(&bar[XB_TOPGEN], 1u);
            else XB_SPIN(xb_ld(&bar[XB_TOPGEN]) == tg, bar);
            __builtin_amdgcn_fence(__ATOMIC_ACQUIRE, "agent");
            xb_add(&bar[XB_XGEN(b.x)], 1u);
            asm volatile("s_waitcnt vmcnt(0)" ::: "memory");
        } else {
            XB_SPIN(xb_ld(&bar[XB_XGEN(b.x)]) == gen, bar);
            __builtin_amdgcn_fence(__ATOMIC_ACQUIRE, "agent");
            asm volatile("s_waitcnt vmcnt(0)" ::: "memory");
        }
    }
    __syncthreads();
}

struct Args { const float* in[N_IN]; float* out; unsigned char* ws; int ph_lo, ph_hi; };
struct Frame {
    LAS unsigned char* lds; unsigned char* lds_g;
    gu32* ctl;
    int tid, lane, wave, vcu, G;
    const float* const* in; float* out; unsigned char* ws;
};
__host__ __device__ __forceinline__ int wsig_inv(int nl) { return 128 * ((nl >> 5) & 1) + 32 * (nl >> 6) + (nl & 31); }

__device__ __forceinline__ void p0_transpose_item(const float* W, int K, int N, bf16* WT, int row_off, bool sig, const float* gain, LAS float* scr, int item, int lane) {
    const int nblk = N / 32, kb = item / nblk, nb = item % nblk, k0 = 64 * kb, n0 = 32 * nb;
    float tv[32];
#pragma unroll
    for (int i = 0; i < 32; ++i) { const int kk = 2 * i + (lane >> 5); tv[i] = W[(size_t)(k0 + kk) * N + n0 + (lane & 31)]; }
    if (gain) {
#pragma unroll
        for (int i = 0; i < 32; ++i) tv[i] *= gain[k0 + 2 * i + (lane >> 5)]; }
#pragma unroll
    for (int i = 0; i < 32; ++i) scr[(2 * i + (lane >> 5)) * 33 + (lane & 31)] = tv[i];
    LDS_WAIT(); asm volatile("" ::: "memory");
    const int c = lane & 7;
    int nbase = row_off + n0; if (sig) { const int ng = row_off + n0; nbase = (ng & ~255) + wsig_inv(ng & 255); }
#pragma unroll
    for (int j = 0; j < 4; ++j) { const int n = (lane >> 3) + 8 * j; const LAS float* s = scr + (8 * c) * 33 + n;
        v4u o; o.x = cvt_pk_bf16(s[0 * 33], s[1 * 33]); o.y = cvt_pk_bf16(s[2 * 33], s[3 * 33]); o.z = cvt_pk_bf16(s[4 * 33], s[5 * 33]); o.w = cvt_pk_bf16(s[6 * 33], s[7 * 33]);
        *(GAS v4u*)(WT + (size_t)(nbase + n) * K + k0 + 8 * c) = o; }
    LDS_WAIT(); asm volatile("" ::: "memory");
}
__device__ __forceinline__ void row_to_bf16_ssq(const float* xrow, bf16* orow, float* ssqrow, int lane) {
    const GAS f32x4* xr = (const GAS f32x4*)xrow + lane;
    f32x4 v[4]; float s = 0.f;
#pragma unroll
    for (int j = 0; j < 4; ++j) { v[j] = xr[64 * j]; s += (v[j].x * v[j].x + v[j].y * v[j].y) + (v[j].z * v[j].z + v[j].w * v[j].w); }
    s = wave_sum(s);
    GAS v2u* o8 = (GAS v2u*)orow + lane;
#pragma unroll
    for (int j = 0; j < 4; ++j) o8[64 * j] = pack4(v[j]);
    if (lane < 16) ssqrow[lane] = lane == 0 ? s : 0.f;
}
__device__ __forceinline__ void p0_prologue(Frame& F) {
    LAS float* scr = (LAS float*)(F.lds + RING_OFF + F.wave * 16384);
    const int gw = F.vcu * NWAVES + F.wave, NGW = F.G * NWAVES;
    unsigned char* ws = F.ws;
    int it = gw;
#define P0_JOB(Wp, K_, N_, WTp, roff, sg, gn) { const int ni = ((K_) / 64) * ((N_) / 32); for (; it < ni; it += NGW) p0_transpose_item((Wp), (K_), (N_), (WTp), (roff), (sg), (gn), scr, it, F.lane); it -= ni; }
    P0_JOB(F.in[I_WINA], DM, NCOLA, (bf16*)(ws + WS_WA), 0, false, F.in[I_NMIX]);
    P0_JOB(F.in[I_WOUT], DM, DM, (bf16*)(ws + WS_WOUT), 0, false, nullptr);
    P0_JOB(F.in[I_WOUT] + (size_t)DM * DM, DM, DM, (bf16*)(ws + WS_WOUT) + (size_t)DM * DM, 0, false, nullptr);
    P0_JOB(F.in[I_WUP], DM, FF, (bf16*)(ws + WS_WUP), 0, false, F.in[I_NMLP]);
    P0_JOB(F.in[I_WUP] + (size_t)DM * FF, DM, FF, (bf16*)(ws + WS_WUP) + (size_t)DM * FF, 0, false, F.in[I_NMLP] + DM);
    P0_JOB(F.in[I_WDN], FF, DM, (bf16*)(ws + WS_WDN), 0, false, nullptr);
    P0_JOB(F.in[I_WDN] + (size_t)DM * FF, FF, DM, (bf16*)(ws + WS_WDN) + (size_t)DM * FF, 0, false, nullptr);
    P0_JOB(F.in[I_WINB], DM, DM, (bf16*)(ws + WS_WB), 0, true, F.in[I_NMIX] + DM);
    P0_JOB(F.in[I_WKV], DM, 512, (bf16*)(ws + WS_WB), 1024, true, F.in[I_KVN]);
    P0_JOB(F.in[I_WMKV], DM, 512, (bf16*)(ws + WS_WM), 0, true, F.in[I_MNORM]);
    P0_JOB(F.in[I_WMKV] + (size_t)DM * 512, DM, 512, (bf16*)(ws + WS_WM), 512, true, F.in[I_MNORM] + DM);
    P0_JOB(F.in[I_WW2], 64, 768, (bf16*)(ws + WS_WW2), 0, false, nullptr);
    P0_JOB(F.in[I_WA2], 64, 768, (bf16*)(ws + WS_WA2), 0, false, nullptr);
    P0_JOB(F.in[I_WG2], 128, 768, (bf16*)(ws + WS_WG2), 0, false, nullptr);
#undef P0_JOB
    for (int m = gw; m < R; m += NGW) { const float* xr = m < RP ? F.in[I_XP] + (size_t)m * DM : F.in[I_XS] + (size_t)(m - RP) * DM;
        row_to_bf16_ssq(xr, (bf16*)(ws + WS_HB) + (size_t)m * DM, (float*)(ws + WS_SSQ) + (size_t)m * 16, F.lane); }
    for (int m = gw; m < 512; m += NGW) row_to_bf16_ssq(F.in[I_MEMP] + (size_t)m * DM, (bf16*)(ws + WS_MB) + (size_t)m * DM, (float*)(ws + WS_SSQM) + (size_t)m * 16, F.lane);
    { const int gt = F.vcu * NWAVES * 64 + F.tid, NGT = F.G * NWAVES * 64; float* rt = (float*)(ws + WS_ROPE);
      for (int i = gt; i < 8196 * 32; i += NGT) { const int p = i >> 5, f = i & 31; const float pos = (float)(p < 8192 ? p : 16384 + (p - 8192));
          double fq_ = 1.0; for (int k = 0; k < f; ++k) fq_ *= 0.74989420933245582730; const float ang = pos * (float)fq_; const double rev = (double)ang * 0.15915494309189535; const float fr = (float)(rev - floor(rev));
          rt[2 * i] = __builtin_amdgcn_cosf(fr); rt[2 * i + 1] = __builtin_amdgcn_sinf(fr); } }
    { const int gt = F.vcu * NWAVES * 64 + F.tid, NGT = F.G * NWAVES * 64; const int per = 124 * 256 / 4;
      for (int i = gt; i < SB * per; i += NGT) { const int b = i / per, r = i % per;
          ((GAS f32x4*)(F.out + O_SSK + (size_t)b * 128 * 256))[r] = ((const GAS f32x4*)(F.in[I_CSK] + (size_t)b * 128 * 256 + 4 * 256))[r];
          ((GAS f32x4*)(F.out + O_SSV + (size_t)b * 128 * 256))[r] = ((const GAS f32x4*)(F.in[I_CSV] + (size_t)b * 128 * 256 + 4 * 256))[r]; } }
}

constexpr int LSTR = 144, SLOT = 64 * LSTR;
__device__ __forceinline__ int rec_index(int chunk, int h) { return ((chunk >> 7) * NH + h) * 128 + (chunk & 127); }
constexpr int REC_PT = 0, REC_QS = 8192, REC_RY = 16384, REC_YL = 24576, REC_BV = 32768;
__device__ __forceinline__ bf16x8 lfrag(const LAS unsigned char* m, int row, int k) { return *(const LAS bf16x8*)(m + row * LSTR + k * 2); }
__device__ __forceinline__ void mm_strip(f32x4 (&acc)[4], const LAS unsigned char* X, const LAS unsigned char* Y, int w, int c, int g) {
#pragma unroll
    for (int ks = 0; ks < 2; ++ks) { const bf16x8 a = lfrag(X, 16 * w + c, 32 * ks + 8 * g);
#pragma unroll
        for (int n = 0; n < 4; ++n) acc[n] = mfma16(a, lfrag(Y, 16 * n + c, 32 * ks + 8 * g), acc[n]); }
}
__device__ __forceinline__ void mm_strip2(f32x4 (&acc0)[4], f32x4 (&acc1)[4], const LAS unsigned char* X, const LAS unsigned char* Y0, const LAS unsigned char* Y1, int w, int c, int g) {
#pragma unroll
    for (int ks = 0; ks < 2; ++ks) { const bf16x8 a = lfrag(X, 16 * w + c, 32 * ks + 8 * g);
#pragma unroll
        for (int n = 0; n < 4; ++n) { acc0[n] = mfma16(a, lfrag(Y0, 16 * n + c, 32 * ks + 8 * g), acc0[n]); acc1[n] = mfma16(a, lfrag(Y1, 16 * n + c, 32 * ks + 8 * g), acc1[n]); } }
}
__device__ __forceinline__ void zero4(f32x4 (&a)[4]) {
#pragma unroll
    for (int n = 0; n < 4; ++n) a[n] = (f32x4){0.f, 0.f, 0.f, 0.f};
}
__device__ __forceinline__ void st_T(LAS unsigned char* dest, const f32x4 (&acc)[4], int w, int c, int g) {
#pragma unroll
    for (int n = 0; n < 4; ++n) *(LAS v2u*)(dest + (16 * n + c) * LSTR + (16 * w + 4 * g) * 2) = pack4(acc[n]);
}
__device__ __forceinline__ void st_T_global(unsigned char* dest  , const f32x4 (&acc)[4], int w, int c, int g) {
#pragma unroll
    for (int n = 0; n < 4; ++n) *(GAS v2u*)(dest + (16 * n + c) * 128 + (16 * w + 4 * g) * 2) = pack4(acc[n]);
}
__device__ __forceinline__ void load_shift8(const bf16* cur, const bf16* prv, const float* mu, float (&o)[8]) {
    const v4u cw = *(const GAS v4u*)cur; v4u pw = {0u, 0u, 0u, 0u}; if (prv) pw = *(const GAS v4u*)prv;
    const f32x4 m0 = *(const GAS f32x4*)mu, m1 = *(const GAS f32x4*)(mu + 4);
    const float cf[8] = {bflo(cw.x), bfhi(cw.x), bflo(cw.y), bfhi(cw.y), bflo(cw.z), bfhi(cw.z), bflo(cw.w), bfhi(cw.w)};
    const float pf[8] = {bflo(pw.x), bfhi(pw.x), bflo(pw.y), bfhi(pw.y), bflo(pw.z), bfhi(pw.z), bflo(pw.w), bfhi(pw.w)};
    const float mf[8] = {m0[0], m0[1], m0[2], m0[3], m1[0], m1[1], m1[2], m1[3]};
#pragma unroll
    for (int i = 0; i < 8; ++i) o[i] = cf[i] + (pf[i] - cf[i]) * mf[i];
}
__device__ __forceinline__ bf16x8 pack_frag(const float (&v)[8]) {
    v4u w; w.x = cvt_pk_bf16(v[0], v[1]); w.y = cvt_pk_bf16(v[2], v[3]); w.z = cvt_pk_bf16(v[4], v[5]); w.w = cvt_pk_bf16(v[6], v[7]); return __builtin_bit_cast(bf16x8, w);
}

__device__ __forceinline__ void rwkv_prep_unit(Frame& F, int unit, LAS unsigned char* hb, LAS float* wtot, int stage_limit = 99) {
    int w_ = F.wave & 3, lane_ = F.lane; asm volatile("" : "+s"(w_), "+v"(lane_));
    const int w = w_, lane = lane_, g = lane >> 4, c = lane & 15;
    const int chunk = unit / NH, h = unit % NH, row0 = chunk * 64; const bool first = (chunk & 127) == 0;
    const bf16* proj = (const bf16*)(F.ws + WS_PROJ);
    unsigned char* rec = F.ws + WS_REC + (size_t)rec_index(chunk, h) * REC_BYTES;
    LAS unsigned char* const s0 = hb, * const s1 = hb + SLOT, * const s2 = hb + 2 * SLOT, * const s3 = hb + 3 * SLOT, * const s4 = hb + 4 * SLOT, * const s5 = hb + 5 * SLOT, * const s6 = hb + 6 * SLOT, * const s7 = hb + 7 * SLOT;
    f32x4 dw[4], da[4]; zero4(dw); zero4(da);
    {
        const int t = 16 * w + c; const bf16* cr = proj + (size_t)(row0 + t) * NCOLA; const bf16* pr = (first && t == 0) ? nullptr : cr - NCOLA;
        const bf16* Ww2 = (const bf16*)(F.ws + WS_WW2); const bf16* Wa2 = (const bf16*)(F.ws + WS_WA2);
#pragma unroll
        for (int ks = 0; ks < 2; ++ks) { const int l0 = 32 * ks + 8 * g; float x[8];
            load_shift8(cr + 2304 + l0, pr ? pr + 2304 + l0 : nullptr, F.in[I_MU] + 2304 + l0, x);
#pragma unroll
            for (int i = 0; i < 8; ++i) x[i] = ftanh(x[i]);
            const bf16x8 aw = pack_frag(x);
            load_shift8(cr + 2368 + l0, pr ? pr + 2368 + l0 : nullptr, F.in[I_MU] + 2368 + l0, x);
            const bf16x8 aa = pack_frag(x);
#pragma unroll
            for (int n = 0; n < 4; ++n) { const size_t wo = (size_t)(h * 64 + 16 * n + c) * 64 + l0;
                dw[n] = mfma16(aw, *(const GAS bf16x8*)(Ww2 + wo), dw[n]); da[n] = mfma16(aa, *(const GAS bf16x8*)(Wa2 + wo), da[n]); } }
    }
    f32x4 rt[4], kh[4], lw[4], at_[4], bt_[4], kt_[4], bh_[4], vv[4]; float gam[4]; float bon[4] = {0.f, 0.f, 0.f, 0.f}; float ssk[4] = {0.f, 0.f, 0.f, 0.f};
    f32x4 kkr[4], aa_[4], kp[4], rr[4];
    {
        float mur[4], muk[4], muv[4], w0[4], a0[4], kkc[4], kac[4], rkc[4];
#pragma unroll
        for (int n = 0; n < 4; ++n) { const int col = h * 64 + 16 * n + c; mur[n] = F.in[I_MU][col]; muk[n] = F.in[I_MU][768 + col]; muv[n] = F.in[I_MU][1536 + col];
            w0[n] = F.in[I_W0][col]; a0[n] = F.in[I_A0][col]; kkc[n] = F.in[I_KK][col]; kac[n] = F.in[I_KA][col]; rkc[n] = F.in[I_RK][col]; }
#pragma unroll
        for (int reg = 0; reg < 4; ++reg) { const int t = 16 * w + 4 * g + reg; const bool hp = !(first && t == 0);
            const GAS bf16* cr = (const GAS bf16*)(proj + (size_t)(row0 + t) * NCOLA + h * 64 + c); const GAS bf16* pr = hp ? cr - NCOLA : cr;
#pragma unroll
            for (int n = 0; n < 4; ++n) {
                const float r0 = bf2f(cr[16 * n]), k0 = bf2f(cr[16 * n + 768]), v0 = bf2f(cr[16 * n + 1536]);
                float r1 = bf2f(pr[16 * n]), k1 = bf2f(pr[16 * n + 768]), v1 = bf2f(pr[16 * n + 1536]);
                if (!hp) { r1 = 0.f; k1 = 0.f; v1 = 0.f; }
                const float r = r0 + (r1 - r0) * mur[n], k = k0 + (k1 - k0) * muk[n], v = v0 + (v1 - v0) * muv[n];
                const float y = -(w0[n] + dw[n][reg]);
                const float sp = fmaxf(y, 0.f) + __logf(1.0f + __expf(-fabsf(y)));
                lw[n][reg] = -__expf(-sp - 0.5f);
                const float a = fsigmoid(a0[n] + da[n][reg]);
                aa_[n][reg] = a; kkr[n][reg] = k * kkc[n]; kp[n][reg] = k * (1.0f + (a - 1.0f) * kac[n]); rr[n][reg] = r; vv[n][reg] = v;
                ssk[reg] += kkr[n][reg] * kkr[n][reg]; bon[reg] += r * kp[n][reg] * rkc[n]; }
            asm volatile("" ::: "memory"); }
    }
#pragma unroll
    for (int reg = 0; reg < 4; ++reg) { ssk[reg] = sum16(ssk[reg]); bon[reg] = sum16(bon[reg]); ssk[reg] = 1.0f / fmaxf(sqrtf(ssk[reg]), 1e-12f); }
    f32x4 Lc[4];
#pragma unroll
    for (int n = 0; n < 4; ++n) { f32x4 inc; inc[0] = lw[n][0]; inc[1] = inc[0] + lw[n][1]; inc[2] = inc[1] + lw[n][2]; inc[3] = inc[2] + lw[n][3];
        const float tot = inc[3]; const float t1 = __shfl(tot, (lane - 16) & 63), t2 = __shfl(tot, (lane - 32) & 63), t3 = __shfl(tot, (lane - 48) & 63);
        const float pre = (g >= 1 ? t1 : 0.f) + (g >= 2 ? t2 : 0.f) + (g >= 3 ? t3 : 0.f);
        Lc[n] = inc + pre; if (g == 3) wtot[w * 64 + 16 * n + c] = pre + tot; }
    __syncthreads();
#pragma unroll
    for (int n = 0; n < 4; ++n) { const int j = 16 * n + c; const float t0 = wtot[j], t1 = wtot[64 + j], t2 = wtot[128 + j], t3 = wtot[192 + j];
        const float base = (w >= 1 ? t0 : 0.f) + (w >= 2 ? t1 : 0.f) + (w >= 3 ? t2 : 0.f); const float LC = (t0 + t1) + (t2 + t3);
        gam[n] = __expf(LC);
#pragma unroll
        for (int reg = 0; reg < 4; ++reg) { const float L = Lc[n][reg] + base; const float eL = __expf(L), eLi = __expf(-L), eP = __expf(L - lw[n][reg]), eC = __expf(LC - L);
            const float kk = kkr[n][reg] * ssk[reg], bsc = kk * aa_[n][reg];
            at_[n][reg] = -kk * eP; rt[n][reg] = rr[n][reg] * eL; bt_[n][reg] = bsc * eLi; kt_[n][reg] = kp[n][reg] * eLi; bh_[n][reg] = bsc * eC; kh[n][reg] = kp[n][reg] * eC;
            const int t = 16 * w + 4 * g + reg;
            *(LAS bf16*)(s0 + t * LSTR + j * 2) = f2bf(at_[n][reg]); *(LAS bf16*)(s1 + t * LSTR + j * 2) = f2bf(bt_[n][reg]);
            *(LAS bf16*)(s2 + t * LSTR + j * 2) = f2bf(kt_[n][reg]); *(LAS bf16*)(s3 + t * LSTR + j * 2) = f2bf(rt[n][reg]); }
        *(LAS v2u*)(s4 + j * LSTR + (16 * w + 4 * g) * 2) = pack4(at_[n]); *(LAS v2u*)(s5 + j * LSTR + (16 * w + 4 * g) * 2) = pack4(bh_[n]); *(LAS v2u*)(s6 + j * LSTR + (16 * w + 4 * g) * 2) = pack4(vv[n]);
        f32x4 bv;
#pragma unroll
        for (int reg = 0; reg < 4; ++reg) bv[reg] = bon[reg] * vv[n][reg];
        *(GAS v2u*)(rec + REC_BV + ((w * 64 + lane) * 4 + n) * 8) = pack4(bv); }
    __syncthreads();
    if (stage_limit <= 3) return;
    f32x4 aN[4], aMk[4], aMbr[4], aMkr[4]; zero4(aN); zero4(aMk); zero4(aMbr); zero4(aMkr);
    mm_strip2(aN, aMk, s0, s1, s2, w, c, g);
    mm_strip(aMbr, s1, s3, w, c, g); mm_strip(aMkr, s2, s3, w, c, g);
#pragma unroll
    for (int n = 0; n < 4; ++n)
#pragma unroll
        for (int reg = 0; reg < 4; ++reg) { const int row = 16 * w + 4 * g + reg, col = 16 * n + c;
            if (!(col < row)) { aN[n][reg] = 0.f; aMk[n][reg] = 0.f; } if (!(row <= col)) { aMbr[n][reg] = 0.f; aMkr[n][reg] = 0.f; } }
    __syncthreads();
    LAS float* Nf = (LAS float*)s0;
#pragma unroll
    for (int n = 0; n < 4; ++n)
#pragma unroll
        for (int reg = 0; reg < 4; ++reg) Nf[(16 * w + 4 * g + reg) * 64 + 16 * n + c] = aN[n][reg];
    st_T(s2, aMk, w, c, g);
    st_T(s3, aMbr, w, c, g);
    __syncthreads();
    if (w == 0) {
        float col[64];
#pragma unroll
        for (int t = 0; t < 64; ++t) col[t] = 0.f;
#pragma unroll
        for (int t = 0; t < 64; ++t) { float pv[4] = {(t == lane) ? 1.0f : 0.0f, 0.f, 0.f, 0.f};
#pragma unroll
            for (int u4 = 0; u4 < (t + 3) / 4; ++u4) { const f32x4 nv = *(const LAS f32x4*)(Nf + t * 64 + 4 * u4);
#pragma unroll
                for (int e = 0; e < 4; ++e) if (4 * u4 + e < t) pv[e] = fmaf(nv[e], col[4 * u4 + e], pv[e]); }
            const float val = (pv[0] + pv[1]) + (pv[2] + pv[3]);
            col[t] = val; *(LAS bf16*)(s7 + t * LSTR + lane * 2) = f2bf(val); }
    }
    __syncthreads();
    if (stage_limit <= 5) return;
    { f32x4 aW[4], aNk[4]; zero4(aW); zero4(aNk); mm_strip2(aW, aNk, s7, s4, s2, w, c, g); st_T(s0, aW, w, c, g); st_T(s1, aNk, w, c, g); }
    __syncthreads();
    { f32x4 aP[4]; zero4(aP); mm_strip(aP, s0, s5, w, c, g);
#pragma unroll
      for (int n = 0; n < 4; ++n)
#pragma unroll
          for (int reg = 0; reg < 4; ++reg) if (n == w && c == 4 * g + reg) aP[n][reg] += gam[n];
#pragma unroll
      for (int n = 0; n < 4; ++n) *(GAS v2u*)(rec + REC_PT + ((n * 2 + (w >> 1)) * 64 + lane) * 16 + 8 * (w & 1)) = pack4(aP[n]); }
    { f32x4 aZq[4], aZy[4]; zero4(aZq); zero4(aZy); mm_strip2(aZq, aZy, s1, s5, s3, w, c, g);
#pragma unroll
      for (int n = 0; n < 4; ++n) { aZq[n] += kh[n]; aZy[n] += aMkr[n]; }
      f32x4 aRy[4]; zero4(aRy); mm_strip(aRy, s3, s0, w, c, g);
#pragma unroll
      for (int n = 0; n < 4; ++n)
#pragma unroll
          for (int reg = 0; reg < 4; ++reg) *(GAS bf16*)(rec + REC_RY + ((w * 2 + (n >> 1)) * 64 + 16 * (2 * (n & 1) + (c >> 3)) + 4 * g + reg) * 16 + 2 * (c & 7)) = f2bf(aRy[n][reg] + rt[n][reg]);
      st_T(s4, aZq, w, c, g);
      st_T(s7, aZy, w, c, g); }
    __syncthreads();
    { f32x4 aQ[4], aY[4]; zero4(aQ); zero4(aY); mm_strip(aQ, s4, s6, w, c, g); mm_strip(aY, s7, s6, w, c, g);
#pragma unroll
      for (int n = 0; n < 4; ++n) { *(GAS v2u*)(rec + REC_QS + ((n * 64 + lane) * 4 + w) * 8) = pack4(aQ[n]);
                                    *(GAS v2u*)(rec + REC_YL + ((w * 64 + lane) * 4 + n) * 8) = pack4(aY[n]); } }
}

__device__ __forceinline__ float rdlane(float v, int l) { return __int_as_float(__builtin_amdgcn_readlane(__float_as_int(v), l)); }
__device__ __forceinline__ void rwkv_sample_task(Frame& F, int task) {
    int lane_ = F.lane; asm volatile("" : "+v"(lane_)); const int lane = lane_;
    const int b = task / NH, h = task % NH, col = h * 64 + lane;
    const bf16* proj = (const bf16*)(F.ws + WS_PROJ);
    const float* sh = F.in[I_SSHIFT] + (size_t)b * RWKV_COLS;
    const float* mu = F.in[I_MU];
    float S[64];
    { const GAS f32x4* sp = (const GAS f32x4*)(F.in[I_SWKV] + (((size_t)b * NH + h) * 64 + lane) * 64);
#pragma unroll
      for (int q = 0; q < 16; ++q) { const f32x4 v = sp[q]; S[4 * q] = v[0]; S[4 * q + 1] = v[1]; S[4 * q + 2] = v[2]; S[4 * q + 3] = v[3]; } }
    const float w0 = F.in[I_W0][col], a0 = F.in[I_A0][col], kkc = F.in[I_KK][col], kac = F.in[I_KA][col], rkc = F.in[I_RK][col], lnw = F.in[I_LNW][col], lnb = F.in[I_LNB][col];
    float rr[ST], kq[ST], vq[ST], twd[ST], adv[ST], gd0[ST], gd1[ST];
#pragma unroll
    for (int i = 0; i < ST; ++i) { const int row = RP + b * ST + i; const bf16* cr = proj + (size_t)row * NCOLA;
#define SHIFTED(cc) ({ const float p_ = bf2f(cr[(cc)]); const float q_ = (i == 0) ? sh[(cc)] : bf2f(cr[(cc) - NCOLA]); p_ + (q_ - p_) * mu[(cc)]; })
        rr[i] = SHIFTED(col); kq[i] = SHIFTED(768 + col); vq[i] = SHIFTED(1536 + col);
        twd[i] = ftanh(SHIFTED(2304 + lane)); adv[i] = SHIFTED(2368 + lane); gd0[i] = fsigmoid(SHIFTED(2432 + lane)); gd1[i] = fsigmoid(SHIFTED(2496 + lane));
#undef SHIFTED
    }
    float dwv[ST] = {0.f, 0.f, 0.f, 0.f}, dav[ST] = {0.f, 0.f, 0.f, 0.f}, ggv[ST] = {0.f, 0.f, 0.f, 0.f};
    { const GAS float* W2 = (const GAS float*)(F.in[I_WW2] + col); const GAS float* A2 = (const GAS float*)(F.in[I_WA2] + col); const GAS float* G2 = (const GAS float*)(F.in[I_WG2] + col);
#pragma unroll 16
      for (int l = 0; l < 64; ++l) { const float w2 = W2[0], a2 = A2[0], g2a = G2[0], g2b = G2[64 * 768]; W2 += 768; A2 += 768; G2 += 768;
#pragma unroll
          for (int i = 0; i < ST; ++i) { dwv[i] = fmaf(rdlane(twd[i], l), w2, dwv[i]); dav[i] = fmaf(rdlane(adv[i], l), a2, dav[i]); ggv[i] = fmaf(rdlane(gd0[i], l), g2a, ggv[i]); ggv[i] = fmaf(rdlane(gd1[i], l), g2b, ggv[i]); } } }
#pragma unroll
    for (int i = 0; i < ST; ++i) {
        const int row = RP + b * ST + i;
        const float r = rr[i], k = kq[i], v = vq[i], dw = dwv[i], da = dav[i], gg = ggv[i];
        const float y0 = -(w0 + dw); const float sp = fmaxf(y0, 0.f) + __logf(1.0f + __expf(-fabsf(y0)));
        const float wdec = __expf(-__expf(-sp - 0.5f));
        const float a = fsigmoid(a0 + da);
        const float kkr = k * kkc; const float nrm = fmaxf(sqrtf(wave_sum(kkr * kkr)), 1e-12f); const float kk = kkr / nrm;
        const float kp = k * (1.0f + (a - 1.0f) * kac);
        const float asc = -kk, bsc = kk * a;
        const float bonus = wave_sum(r * kp * rkc);
        float sa = 0.f;
#pragma unroll
        for (int j = 0; j < 64; ++j) sa = fmaf(S[j], rdlane(asc, j), sa);
        const float vi = v;
        float y = 0.f;
#pragma unroll
        for (int j = 0; j < 64; ++j) { const float wj = rdlane(wdec, j), bj = rdlane(bsc, j), kj = rdlane(kp, j), rj = rdlane(r, j);
            S[j] = fmaf(S[j], wj, fmaf(sa, bj, vi * kj)); y = fmaf(S[j], rj, y); }
        const float mean = wave_sum(y) * (1.0f / 64.0f); const float dy = y - mean; const float var = wave_sum(dy * dy) * (1.0f / 64.0f);
        const float o = (dy * rsqrtf(var + 6.4e-4f) * lnw + lnb + bonus * vi) * gg;
        ((bf16*)(F.ws + WS_MIX))[(size_t)row * DM + col] = f2bf(o);
        asm volatile("" ::: "memory");
    }
    { GAS f32x4* sp = (GAS f32x4*)(F.out + O_SWKV + (((size_t)b * NH + h) * 64 + lane) * 64);
#pragma unroll
      for (int q = 0; q < 16; ++q) sp[q] = (f32x4){S[4 * q], S[4 * q + 1], S[4 * q + 2], S[4 * q + 3]}; }
    if (h == 0) { const bf16* lr = proj + (size_t)(RP + b * ST + ST - 1) * NCOLA; float* o = F.out + O_SSHIFT + (size_t)b * RWKV_COLS;
        for (int q = lane; q < RWKV_COLS; q += 64) o[q] = bf2f(lr[q]); }
}

__device__ __forceinline__ void rwkv_scan_chain(Frame& F, int bh, int w) {
    int lane_ = F.lane; asm volatile("" : "+v"(lane_)); const int lane = lane_, g = lane >> 4, c = lane & 15; const int b = bh / NH, h = bh % NH;
    f32x4 acc[4]; zero4(acc);
    const int vrow = 16 * w + c;
    auto recp = [&](int cc) -> unsigned char* { return F.ws + WS_REC + (size_t)((b * NH + h) * 128 + cc) * REC_BYTES; };
    constexpr int DPF = 4;
    bf16x8 pa[DPF][4][2]; v4u qa[DPF][2];
#define SCAN_LOAD(d, cc_) do { const unsigned char* rp_ = recp(cc_); \
        qa[d][0] = *(const GAS v4u*)(rp_ + REC_QS + (w * 64 + lane) * 32); qa[d][1] = *(const GAS v4u*)(rp_ + REC_QS + (w * 64 + lane) * 32 + 16); \
        _Pragma("unroll") for (int mt = 0; mt < 4; ++mt) _Pragma("unroll") for (int ks = 0; ks < 2; ++ks) pa[d][mt][ks] = *(const GAS bf16x8*)(rp_ + REC_PT + ((mt * 2 + ks) * 64 + lane) * 16); } while (0)
#pragma unroll
    for (int d = 0; d < DPF; ++d) SCAN_LOAD(d, d);
    for (int cc0 = 0; cc0 < 128; cc0 += DPF) {
#pragma unroll
        for (int d = 0; d < DPF; ++d) { const int cc = cc0 + d;
            unsigned char* sp_ = F.ws + WS_HB + (size_t)((b * NH + h) * 128 + cc) * 8192;
            v2u sb[4]; f32x4 nacc[4];
#pragma unroll
            for (int mt = 0; mt < 4; ++mt) sb[mt] = pack4(acc[mt]);
            nacc[0] = unpack4((v2u){qa[d][0].x, qa[d][0].y}); nacc[1] = unpack4((v2u){qa[d][0].z, qa[d][0].w}); nacc[2] = unpack4((v2u){qa[d][1].x, qa[d][1].y}); nacc[3] = unpack4((v2u){qa[d][1].z, qa[d][1].w});
#pragma unroll
            for (int mt = 0; mt < 4; ++mt) *(GAS v2u*)(sp_ + ((w * 2 + (mt >> 1)) * 64 + 16 * (2 * (mt & 1) + (g >> 1)) + c) * 16 + 8 * (g & 1)) = sb[mt];
            bf16x8 bf[2];
#pragma unroll
            for (int ks = 0; ks < 2; ++ks) { v4u t; t.x = sb[2 * ks].x; t.y = sb[2 * ks].y; t.z = sb[2 * ks + 1].x; t.w = sb[2 * ks + 1].y; bf[ks] = __builtin_bit_cast(bf16x8, t); }
#pragma unroll
            for (int mt = 0; mt < 4; ++mt) { nacc[mt] = mfma16(pa[d][mt][0], bf[0], nacc[mt]); nacc[mt] = mfma16(pa[d][mt][1], bf[1], nacc[mt]); acc[mt] = nacc[mt]; }
            if (cc + DPF < 128) SCAN_LOAD(d, cc + DPF);
        }
    }
#undef SCAN_LOAD
    float* o = F.out + O_PWKV + (((size_t)b * NH + h) * 64 + vrow) * 64;
#pragma unroll
    for (int mt = 0; mt < 4; ++mt) *(GAS f32x4*)(o + 16 * mt + 4 * g) = acc[mt];
}

__device__ __forceinline__ void rwkv_yout_item(Frame& F, int item) {
    int lane_ = F.lane; asm volatile("" : "+v"(lane_)); const int lane = lane_, g = lane >> 4, c = lane & 15; const int unit = item >> 2, w = item & 3;
    const int chunk = unit / NH, h = unit % NH, row0 = chunk * 64; const bool first = (chunk & 127) == 0;
    const unsigned char* rec = F.ws + WS_REC + (size_t)rec_index(chunk, h) * REC_BYTES; const unsigned char* srec = F.ws + WS_HB + (size_t)rec_index(chunk, h) * 8192;
    const bf16* proj = (const bf16*)(F.ws + WS_PROJ);
    f32x4 y[4], gt[4]; zero4(gt);
    { const v4u y01 = *(const GAS v4u*)(rec + REC_YL + (w * 64 + lane) * 32), y23 = *(const GAS v4u*)(rec + REC_YL + (w * 64 + lane) * 32 + 16);
      y[0] = unpack4((v2u){y01.x, y01.y}); y[1] = unpack4((v2u){y01.z, y01.w}); y[2] = unpack4((v2u){y23.x, y23.y}); y[3] = unpack4((v2u){y23.z, y23.w}); }
#pragma unroll
    for (int ks = 0; ks < 2; ++ks) { const bf16x8 a = *(const GAS bf16x8*)(rec + REC_RY + ((w * 2 + ks) * 64 + lane) * 16);
#pragma unroll
        for (int n = 0; n < 4; ++n) y[n] = mfma16(a, *(const GAS bf16x8*)(srec + ((n * 2 + ks) * 64 + lane) * 16), y[n]); }
    { const int t = 16 * w + c; const bf16* cr = proj + (size_t)(row0 + t) * NCOLA; const bf16* pr = (first && t == 0) ? nullptr : cr - NCOLA; const bf16* Wg2 = (const bf16*)(F.ws + WS_WG2);
#pragma unroll
      for (int ks = 0; ks < 4; ++ks) { const int l0 = 32 * ks + 8 * g; float x[8]; load_shift8(cr + 2432 + l0, pr ? pr + 2432 + l0 : nullptr, F.in[I_MU] + 2432 + l0, x);
#pragma unroll
          for (int i = 0; i < 8; ++i) x[i] = fsigmoid(x[i]);
          const bf16x8 ag = pack_frag(x);
#pragma unroll
          for (int n = 0; n < 4; ++n) gt[n] = mfma16(ag, *(const GAS bf16x8*)(Wg2 + (size_t)(h * 64 + 16 * n + c) * 128 + l0), gt[n]); } }
    float mean[4], rstd[4];
#pragma unroll
    for (int reg = 0; reg < 4; ++reg) { float s = (y[0][reg] + y[1][reg]) + (y[2][reg] + y[3][reg]); s = sum16(s); mean[reg] = s * (1.0f / 64.0f);
        float q = 0.f;
#pragma unroll
        for (int n = 0; n < 4; ++n) { const float d = y[n][reg] - mean[reg]; q += d * d; }
        q = sum16(q); rstd[reg] = rsqrtf(q * (1.0f / 64.0f) + 6.4e-4f); }
    bf16* mix = (bf16*)(F.ws + WS_MIX);
#pragma unroll
    for (int n = 0; n < 4; ++n) { const int col = h * 64 + 16 * n + c; const float lnw = F.in[I_LNW][col], lnb = F.in[I_LNB][col];
        const f32x4 bv = unpack4(*(const GAS v2u*)(rec + REC_BV + ((w * 64 + lane) * 4 + n) * 8));
#pragma unroll
        for (int reg = 0; reg < 4; ++reg) { const float o = ((y[n][reg] - mean[reg]) * rstd[reg] * lnw + lnb + bv[reg]) * gt[n][reg];
            mix[(size_t)(row0 + 16 * w + 4 * g + reg) * DM + col] = f2bf(o); } }
}

__device__ __forceinline__ int crow32(int r, int hi) { return (r & 3) + 8 * (r >> 2) + 4 * hi; }
template <bool MASKED, int GB>
__device__ __forceinline__ void flash32(const bf16x8 (&qf)[4], const bf16* Kp, int kstr, const bf16* VTp, int vstr, int kb_lo, int nblk, int qpos, float m0, float l0,
                                        f32x16& o0, f32x16& o1, float& lsum, int lane) {
    const int r32 = lane & 31, hh = lane >> 5;
    float m = m0, l = hh == 0 ? l0 : 0.f;
#pragma unroll
    for (int r = 0; r < 16; ++r) { o0[r] = 0.f; o1[r] = 0.f; }
    for (int b0 = 0; b0 < nblk; b0 += GB) {
        bf16x8 kf[GB][4]; v2u vf[GB][2][2][2];
#pragma unroll
        for (int i = 0; i < GB; ++i) if (b0 + i < nblk) { const int kb = kb_lo + 32 * (b0 + i);
#pragma unroll
            for (int ks = 0; ks < 4; ++ks) kf[i][ks] = *(const GAS bf16x8*)(Kp + (size_t)(kb + r32) * kstr + 16 * ks + 8 * hh);
#pragma unroll
            for (int s2 = 0; s2 < 2; ++s2)
#pragma unroll
                for (int dt = 0; dt < 2; ++dt) { const bf16* vp = VTp + (size_t)(32 * dt + r32) * vstr + kb + 16 * s2 + 4 * hh; vf[i][s2][dt][0] = *(const GAS v2u*)vp; vf[i][s2][dt][1] = *(const GAS v2u*)(vp + 8); } }
#pragma unroll
        for (int i = 0; i < GB; ++i) if (b0 + i < nblk) { const int kb = kb_lo + 32 * (b0 + i);
            f32x16 s;
#pragma unroll
            for (int r = 0; r < 16; ++r) s[r] = 0.f;
#pragma unroll
            for (int ks = 0; ks < 4; ++ks) s = mfma32(kf[i][ks], qf[ks], s);
            if (MASKED) {
#pragma unroll
                for (int r = 0; r < 16; ++r) { const int rel = qpos - (kb + crow32(r, hh)); if (rel < 0 || rel >= 128) s[r] = -1e30f; } }
            float bm = s[0];
#pragma unroll
            for (int r = 1; r < 16; ++r) bm = fmaxf(bm, s[r]);
            bm = max_x32(bm);
            const float mn = fmaxf(m, bm), alpha = __builtin_amdgcn_exp2f(m - mn); m = mn;
            float ps = 0.f;
#pragma unroll
            for (int r = 0; r < 16; ++r) { s[r] = __builtin_amdgcn_exp2f(s[r] - mn); ps += s[r]; }
            l = l * alpha + ps;
#pragma unroll
            for (int r = 0; r < 16; ++r) { o0[r] *= alpha; o1[r] *= alpha; }
#pragma unroll
            for (int s2 = 0; s2 < 2; ++s2) {
                v4u pw; pw.x = cvt_pk_bf16(s[8 * s2], s[8 * s2 + 1]); pw.y = cvt_pk_bf16(s[8 * s2 + 2], s[8 * s2 + 3]); pw.z = cvt_pk_bf16(s[8 * s2 + 4], s[8 * s2 + 5]); pw.w = cvt_pk_bf16(s[8 * s2 + 6], s[8 * s2 + 7]);
                const bf16x8 pb = __builtin_bit_cast(bf16x8, pw);
                { v4u aw; aw.x = vf[i][s2][0][0].x; aw.y = vf[i][s2][0][0].y; aw.z = vf[i][s2][0][1].x; aw.w = vf[i][s2][0][1].y; o0 = mfma32(__builtin_bit_cast(bf16x8, aw), pb, o0); }
                { v4u aw; aw.x = vf[i][s2][1][0].x; aw.y = vf[i][s2][1][0].y; aw.z = vf[i][s2][1][1].x; aw.w = vf[i][s2][1][1].y; o1 = mfma32(__builtin_bit_cast(bf16x8, aw), pb, o1); } }
        }
    }
    lsum = add_x32(l);
}
__device__ __forceinline__ void flash_store(bf16* dst  , int rstride, const f32x16& o0, const f32x16& o1, float lsum, int lane) {
    const int r32 = lane & 31, hh = lane >> 5; const float inv = 1.0f / lsum; bf16* p = dst + (size_t)r32 * rstride + 4 * hh;
#pragma unroll
    for (int k = 0; k < 4; ++k) { *(GAS v2u*)(p + 8 * k) = pack4((f32x4){o0[4 * k] * inv, o0[4 * k + 1] * inv, o0[4 * k + 2] * inv, o0[4 * k + 3] * inv});
        *(GAS v2u*)(p + 32 + 8 * k) = pack4((f32x4){o1[4 * k] * inv, o1[4 * k + 1] * inv, o1[4 * k + 2] * inv, o1[4 * k + 3] * inv}); }
}
__device__ __forceinline__ void memattn_prompt_task(Frame& F, int layer, int task) {
    int lane_ = F.lane; asm volatile("" : "+v"(lane_)); const int lane = lane_, r32 = lane & 31, hh = lane >> 5; const int hm = task & 3, qt = task >> 2;
    const int row = qt * 32 + r32, b = (qt * 32) >> 13;
    bf16x8 qf[4];
    if (layer == 0) { const bf16* qp = (const bf16*)(F.ws + WS_PROJ) + (size_t)row * NCOLA + RWKV_COLS + hm * 64; const float* gn = F.in[I_MQN];
        float x[4][8]; float ss = 0.f;
#pragma unroll
        for (int ks = 0; ks < 4; ++ks) { const v4u w = *(const GAS v4u*)(qp + 16 * ks + 8 * hh); const unsigned ww[4] = {w.x, w.y, w.z, w.w};
#pragma unroll
            for (int i = 0; i < 4; ++i) { x[ks][2 * i] = bflo(ww[i]); x[ks][2 * i + 1] = bfhi(ww[i]); ss += x[ks][2 * i] * x[ks][2 * i] + x[ks][2 * i + 1] * x[ks][2 * i + 1]; } }
        ss = add_x32(ss); const float rs = rsqrtf(ss * (1.0f / 64.0f) + 1e-6f) * C2Q;
#pragma unroll
        for (int ks = 0; ks < 4; ++ks) {
#pragma unroll
            for (int i = 0; i < 8; ++i) x[ks][i] *= rs * gn[16 * ks + 8 * hh + i];
            qf[ks] = pack_frag(x[ks]); }
    } else { const bf16* qp = (const bf16*)(F.ws + WS_Q1) + (size_t)row * DM + 768 + hm * 64;
#pragma unroll
        for (int ks = 0; ks < 4; ++ks) qf[ks] = *(const GAS bf16x8*)(qp + 16 * ks + 8 * hh); }
    const bf16* Kp = (const bf16*)(F.ws + WS_MK) + (size_t)((layer * 2 + b) * 4 + hm) * 256 * 64;
    const bf16* VTp = (const bf16*)(F.ws + WS_MVT) + (size_t)((layer * 2 + b) * 4 + hm) * 64 * 256;
    f32x16 o0, o1; float ls;
    flash32<false, 4>(qf, Kp, 64, VTp, 256, 0, 8, 0, -1e30f, 0.f, o0, o1, ls, lane);
    flash_store((bf16*)(F.ws + WS_MIX) + (size_t)(qt * 32) * DM + 768 + hm * 64, DM, o0, o1, ls, lane);
}
__device__ __forceinline__ void swa_prompt_task(Frame& F, int task) {
    int lane_ = F.lane; asm volatile("" : "+v"(lane_)); const int lane = lane_, r32 = lane & 31, hh = lane >> 5; const int hq = task % NH, qt = task / NH;
    const int b = qt >> 8, tq = (qt & 255) * 32, row = qt * 32 + r32, kvh = hq / 3;
    const bf16* qp = (const bf16*)(F.ws + WS_Q1) + (size_t)row * DM + hq * 64;
    bf16x8 qf[4];
#pragma unroll
    for (int ks = 0; ks < 4; ++ks) qf[ks] = *(const GAS bf16x8*)(qp + 16 * ks + 8 * hh);
    const bf16* Kp = (const bf16*)(F.ws + WS_K1) + (size_t)(b * T) * 256 + kvh * 64;
    const bf16* VTp = (const bf16*)(F.ws + WS_VT1) + (size_t)(b * 4 + kvh) * 64 * T;
    const int kb_lo = tq >= 128 ? tq - 128 : 0, nblk = (tq - kb_lo) / 32 + 1;
    const float sink = F.in[I_SINKS][hq] * LOG2E;
    f32x16 o0, o1; float ls;
    flash32<true, 3>(qf, Kp, 256, VTp, T, kb_lo, nblk, tq + r32, sink, 1.0f, o0, o1, ls, lane);
    flash_store((bf16*)(F.ws + WS_MIX) + (size_t)(qt * 32) * DM + hq * 64, DM, o0, o1, ls, lane);
}
template <int NQ, bool WINDOW>
__device__ __forceinline__ void small_attn(const LAS float* ql, LAS float* sc, int NKP, const float* k1, const float* v1, int kst1, int nk1, const bf16* k2, const bf16* v2, int kst2, int nk2,
                                           const float* sinkg  , bf16* out0, int ostride_q, int lane) {
    const int sub = lane >> 4, dq = lane & 15, nk = nk1 + nk2;
    f32x4 qv[NQ];
#pragma unroll
    for (int qi = 0; qi < NQ; ++qi) qv[qi] = *(const LAS f32x4*)(ql + qi * 64 + 4 * dq);
    constexpr int KBAT = NQ > 4 ? 4 : 8;
    for (int kg0 = 0; kg0 < nk1; kg0 += 4 * KBAT) { f32x4 kv[KBAT];
#pragma unroll
        for (int u = 0; u < KBAT; ++u) kv[u] = *(const GAS f32x4*)(k1 + (size_t)(kg0 + 4 * u + sub) * kst1 + 4 * dq);
#pragma unroll
        for (int u = 0; u < KBAT; ++u) { const int key = kg0 + 4 * u + sub;
#pragma unroll
            for (int qi = 0; qi < NQ; ++qi) { const f32x4 p = qv[qi] * kv[u]; const float s = sum16((p[0] + p[1]) + (p[2] + p[3])); if (dq == 0) sc[qi * NKP + key] = s; } } }
    for (int kg = nk1; kg < nk; kg += 4) { const int key = kg + sub; const f32x4 kv = unpack4(*(const GAS v2u*)(k2 + (size_t)(key - nk1) * kst2 + 4 * dq));
#pragma unroll
        for (int qi = 0; qi < NQ; ++qi) { const f32x4 p = qv[qi] * kv; const float s = sum16((p[0] + p[1]) + (p[2] + p[3])); if (dq == 0) sc[qi * NKP + key] = s; } }
    LDS_WAIT(); asm volatile("" ::: "memory");
#pragma unroll
    for (int qi = 0; qi < NQ; ++qi) { float sv[5]; const float sk_ = sinkg ? sinkg[qi >> 2] * LOG2E : -1e30f; float mx = sk_;
#pragma unroll
        for (int t = 0; t < 5; ++t) { const int key = lane + 64 * t; float s = -1e30f; if (key < nk) { s = sc[qi * NKP + key]; if (WINDOW) { const int i = qi & 3; if (key < i + 1 || key > 128 + i) s = -1e30f; } } sv[t] = s; mx = fmaxf(mx, s); }
        mx = wave_max(mx); float sum = 0.f;
#pragma unroll
        for (int t = 0; t < 5; ++t) { sv[t] = __builtin_amdgcn_exp2f(sv[t] - mx); sum += sv[t]; }
        sum = wave_sum(sum) + (sinkg ? __builtin_amdgcn_exp2f(sk_ - mx) : 0.f); const float inv = 1.0f / sum;
#pragma unroll
        for (int t = 0; t < 5; ++t) { const int key = lane + 64 * t; if (key < nk) sc[qi * NKP + key] = sv[t] * inv; } }
    LDS_WAIT(); asm volatile("" ::: "memory");
    f32x4 acc[NQ];
#pragma unroll
    for (int qi = 0; qi < NQ; ++qi) acc[qi] = (f32x4){0.f, 0.f, 0.f, 0.f};
    for (int kg0 = 0; kg0 < nk1; kg0 += 4 * KBAT) { f32x4 vv[KBAT];
#pragma unroll
        for (int u = 0; u < KBAT; ++u) vv[u] = *(const GAS f32x4*)(v1 + (size_t)(kg0 + 4 * u + sub) * kst1 + 4 * dq);
#pragma unroll
        for (int u = 0; u < KBAT; ++u) { const int key = kg0 + 4 * u + sub;
#pragma unroll
            for (int qi = 0; qi < NQ; ++qi) acc[qi] += vv[u] * sc[qi * NKP + key]; } }
    for (int kg = nk1; kg < nk; kg += 4) { const int key = kg + sub; const f32x4 vv = unpack4(*(const GAS v2u*)(v2 + (size_t)(key - nk1) * kst2 + 4 * dq));
#pragma unroll
        for (int qi = 0; qi < NQ; ++qi) acc[qi] += vv * sc[qi * NKP + key]; }
#pragma unroll
    for (int qi = 0; qi < NQ; ++qi) { f32x4 a = acc[qi];
#pragma unroll
        for (int e = 0; e < 4; ++e) { a[e] = add_x16(a[e]); a[e] = add_x32(a[e]); }
        if (sub == 0) *(GAS v2u*)(out0 + (size_t)(qi & 3) * ostride_q + (qi >> 2) * 64 + 4 * dq) = pack4(a); }
    LDS_WAIT(); asm volatile("" ::: "memory");
}
__device__ __forceinline__ void memattn_sample_task(Frame& F, int layer, int task, LAS float* wl  ) {
    int lane_ = F.lane; asm volatile("" : "+v"(lane_)); const int lane = lane_, b = task >> 2, hm = task & 3; LAS float* ql = wl; LAS float* sc = wl + 12 * 64;
#pragma unroll
    for (int i = 0; i < 4; ++i) { const int row = RP + b * ST + i; float x;
        if (layer == 0) { x = bf2f(((const bf16*)(F.ws + WS_PROJ))[(size_t)row * NCOLA + RWKV_COLS + hm * 64 + lane]); const float ss = wave_sum(x * x); x *= rsqrtf(ss * (1.0f / 64.0f) + 1e-6f) * C2Q * F.in[I_MQN][lane]; }
        else x = bf2f(((const bf16*)(F.ws + WS_Q1))[(size_t)row * DM + 768 + hm * 64 + lane]);
        ql[i * 64 + lane] = x; }
    LDS_WAIT(); asm volatile("" ::: "memory");
    const float* k1 = F.in[I_CMK] + (((size_t)layer * SB + b) * NMEM * 4 + hm) * 64; const float* v1 = F.in[I_CMV] + (((size_t)layer * SB + b) * NMEM * 4 + hm) * 64;
    small_attn<4, false>(ql, sc, 264, k1, v1, 256, 256, nullptr, nullptr, 0, 0, nullptr, (bf16*)(F.ws + WS_MIX) + (size_t)(RP + b * ST) * DM + 768 + hm * 64, DM, lane);
}
__device__ __forceinline__ void swa_sample_task(Frame& F, int task, LAS float* wl) {
    int lane_ = F.lane; asm volatile("" : "+v"(lane_)); const int lane = lane_, b = task >> 2, kvh = task & 3; LAS float* ql = wl; LAS float* sc = wl + 12 * 64;
#pragma unroll
    for (int qi = 0; qi < 12; ++qi) { const int i = qi & 3, gq = qi >> 2, hq = kvh * 3 + gq; const int row = RP + b * ST + i;
        ql[qi * 64 + lane] = bf2f(((const bf16*)(F.ws + WS_Q1))[(size_t)row * DM + hq * 64 + lane]); }
    LDS_WAIT(); asm volatile("" ::: "memory");
    const float* k1 = F.in[I_CSK] + ((size_t)b * 128 * 4 + kvh) * 64; const float* v1 = F.in[I_CSV] + ((size_t)b * 128 * 4 + kvh) * 64;
    const bf16* k2 = (const bf16*)(F.ws + WS_K1) + (size_t)(RP + b * ST) * 256 + kvh * 64; const bf16* v2 = (const bf16*)(F.ws + WS_V1) + (size_t)(RP + b * ST) * 256 + kvh * 64;
    small_attn<12, true>(ql, sc, 136, k1, v1, 256, 128, k2, v2, 256, 4, F.in[I_SINKS] + kvh * 3, (bf16*)(F.ws + WS_MIX) + (size_t)(RP + b * ST) * DM + kvh * 3 * 64, DM, lane);
}

constexpr int N_PHASES = 13;
template <int PM> __global__ void __launch_bounds__(NWAVES * 64, 2) yoco_fwd(Args args) {
    extern __shared__ __attribute__((aligned(16))) unsigned char lds[];
    Frame F;
    F.lds = (LAS unsigned char*)lds; F.lds_g = lds;
    F.wave = __builtin_amdgcn_readfirstlane((int)threadIdx.x >> 6); F.lane = mk_lane(); F.tid = F.wave * 64 + F.lane;
    F.G = gridDim.x; { const int bx = blockIdx.x; F.vcu = (F.G % 8 == 0) ? (bx % 8) * (F.G / 8) + bx / 8 : bx; }
    F.in = args.in; F.out = args.out; F.ws = args.ws; F.ctl = (gu32*)(args.ws + WS_CTL);
    for (int u = F.tid; u < (LDS_BYTES - LDSCTL_OFF) / 4; u += NWAVES * 64) ((LAS unsigned*)(F.lds + LDSCTL_OFF))[u] = 0u;
    __syncthreads();
    const int lo = args.ph_lo, hi = args.ph_hi;
    XcdBarrier bar; bar.wave0 = F.wave == 0; bar.bar = (unsigned*)(F.ctl + CW_BAR); bar.x = 0; bar.st = nullptr;
    if (hi - lo > 1) bar = xcd_barrier_post((unsigned*)(F.ctl + CW_BAR), (volatile LAS unsigned*)(F.lds + MISC_OFF) + 8, F.wave == 0);
#define IN(k) (((PM >> (k)) & 1) && lo <= (k) && (k) < hi)
#ifndef MK_DUP
#define MK_DUP -1
#endif
#define PH_REP(k) ((MK_DUP == (k)) ? 2 : 1)
#define SEAM(k) do { if (IN(k) && IN((k) + 1)) xcd_barrier(bar); } while (0)
    const int gw = F.vcu * NWAVES + F.wave, NGW = F.G * NWAVES;
#define SSQ ((float*)(F.ws + WS_SSQ))
#define HB ((bf16*)(F.ws + WS_HB))
#define MIX ((bf16*)(F.ws + WS_MIX))
#define HH ((bf16*)(F.ws + WS_H))
#define PHASE_BEGIN() do { int z_ = 0; unsigned char* ws_ = args.ws; float* out_ = args.out; asm volatile("" : "+s"(z_), "+s"(ws_), "+s"(out_)); F.in = args.in + z_; F.ws = ws_; F.out = out_; \
                           F.lane = mk_lane(); F.tid = F.wave * 64 + F.lane; } while (0)

    if (IN(0)) for (int rep_ = 0; rep_ < PH_REP(0); ++rep_) { PHASE_BEGIN(); p0_prologue(F); } SEAM(0);

    if (IN(1)) for (int rep_ = 0; rep_ < PH_REP(1); ++rep_) { PHASE_BEGIN();
        { pg8::Gemm g{HB, (const bf16*)(F.ws + WS_WA), R, NCOLA, DM}; pg8::StaticOrder S; S.init(R, NCOLA, F.G, (int)blockIdx.x);
          pg8::EpiScaleBf16<0> E{(bf16*)(F.ws + WS_PROJ), NCOLA, SSQ};
          pg8::gemm_phase<pg8::EpiScaleBf16<0>, pg8::StaticOrder, true, true>(F.lds + RING_OFF, g, S, E, F.wave, F.lane); }
#ifndef NO_MEMKV
        { pg8::Gemm g{(const bf16*)(F.ws + WS_MB), (const bf16*)(F.ws + WS_WM), 512, 1024, DM}; pg8::StaticOrder S; S.init(512, 1024, F.G, (int)blockIdx.x);
          pg8::EpiMemKV E{F.ws, F.out, F.in[I_MKN]};
          pg8::gemm_phase<pg8::EpiMemKV, pg8::StaticOrder, true, true>(F.lds + RING_OFF, g, S, E, F.wave, F.lane); }
#endif
    } SEAM(1);

    if (IN(2)) for (int rep_ = 0; rep_ < ((MK_DUP == 2 || (MK_DUP >= 20 && MK_DUP < 30)) ? 2 : 1); ++rep_) { PHASE_BEGIN();
        const int half = F.wave >> 2; const int gw = F.vcu * NWAVES + F.wave, NGW = F.G * NWAVES;
        LAS unsigned char* hb = F.lds + half * PREP_HALF; LAS float* wtot = (LAS float*)(F.lds + WTOT_OFF + half * 1024);
        const int slim = (rep_ == 1 && MK_DUP == 21) ? 3 : (rep_ == 1 && MK_DUP == 22) ? 5 : 99;
        if (!(rep_ == 1 && MK_DUP == 20)) for (int pi = F.vcu; pi < NUNIT / 2; pi += F.G) rwkv_prep_unit(F, 2 * pi + half, hb, wtot, slim);
        if (!(rep_ == 1 && (MK_DUP == 21 || MK_DUP == 22))) for (int t = gw; t < SB * NH + 2; t += NGW) {
            if (t < SB * NH) rwkv_sample_task(F, t);
            else { const int b = t - SB * NH; const bf16* lr = (const bf16*)(F.ws + WS_PROJ) + (size_t)(b * T + T - 1) * NCOLA; float* o = F.out + O_PSHIFT + (size_t)b * RWKV_COLS;
                for (int q = F.lane; q < RWKV_COLS; q += 64) o[q] = bf2f(lr[q]); } }
    } SEAM(2);

    if (IN(3)) for (int rep_ = 0; rep_ < ((MK_DUP == 30 || MK_DUP == 31) ? 2 : 1); ++rep_) { PHASE_BEGIN();
        const int nscan = NB * NH * 4;
        if (F.vcu < nscan) { if (F.wave == 0 && (rep_ == 0 || MK_DUP == 31)) rwkv_scan_chain(F, F.vcu >> 2, F.vcu & 3); }
        else if (rep_ == 0 || MK_DUP == 30) { const int ow = (F.vcu - nscan) * NWAVES + F.wave, NOW = (F.G - nscan) * NWAVES; LAS float* wl = (LAS float*)(F.lds + F.wave * 12288);
            for (int t = ow; t < 2048 + 512; t += NOW) { if (t < 2048) memattn_prompt_task(F, 0, t); else memattn_sample_task(F, 0, t - 2048, wl); } }
    } SEAM(3);

    if (IN(4)) for (int rep_ = 0; rep_ < PH_REP(4); ++rep_) { PHASE_BEGIN(); for (int it = gw; it < NUNIT * 4; it += NGW) rwkv_yout_item(F, it); } SEAM(4);

    if (IN(5)) for (int rep_ = 0; rep_ < PH_REP(5); ++rep_) { PHASE_BEGIN(); pg8::Gemm g{MIX, (const bf16*)(F.ws + WS_WOUT), R, DM, DM}; pg8::StaticOrder S; S.init(R, DM, F.G, (int)blockIdx.x);
        pg8::EpiResid E{F.in[I_XP], F.in[I_XS], RP, F.out + O_Y, HB, SSQ};
        pg8::gemm_phase<pg8::EpiResid, pg8::StaticOrder, true, true>(F.lds + RING_OFF, g, S, E, F.wave, F.lane); } SEAM(5);
    if (IN(6)) for (int rep_ = 0; rep_ < PH_REP(6); ++rep_) { PHASE_BEGIN(); pg8::Gemm g{HB, (const bf16*)(F.ws + WS_WUP), R, FF, DM}; pg8::StaticOrder S; S.init(R, FF, F.G, (int)blockIdx.x);
        pg8::EpiScaleBf16<1> E{HH, FF, SSQ};
        pg8::gemm_phase<pg8::EpiScaleBf16<1>, pg8::StaticOrder, true, true>(F.lds + RING_OFF, g, S, E, F.wave, F.lane); } SEAM(6);
    if (IN(7)) for (int rep_ = 0; rep_ < PH_REP(7); ++rep_) { PHASE_BEGIN(); pg8::Gemm g{HH, (const bf16*)(F.ws + WS_WDN), R, DM, FF}; pg8::StaticOrder S; S.init(R, DM, F.G, (int)blockIdx.x);
        pg8::EpiResid E{F.out + O_Y, F.out + O_Y + (size_t)RP * DM, RP, F.out + O_Y, HB, SSQ};
        pg8::gemm_phase<pg8::EpiResid, pg8::StaticOrder, true, true>(F.lds + RING_OFF, g, S, E, F.wave, F.lane); } SEAM(7);

    if (IN(8)) for (int rep_ = 0; rep_ < PH_REP(8); ++rep_) { PHASE_BEGIN(); pg8::Gemm g{HB, (const bf16*)(F.ws + WS_WB), R, NCOLB, DM}; pg8::StaticOrder S; S.init(R, NCOLB, F.G, (int)blockIdx.x);
        pg8::EpiL1 E{F.ws, F.out, F.in[I_QN], F.in[I_MQN] + 64, F.in[I_KN]};
        pg8::gemm_phase<pg8::EpiL1, pg8::StaticOrder, true, true>(F.lds + RING_OFF, g, S, E, F.wave, F.lane); } SEAM(8);

    if (IN(9)) for (int rep_ = 0; rep_ < PH_REP(9); ++rep_) { PHASE_BEGIN(); LAS float* wl = (LAS float*)(F.lds + F.wave * 12288);
        for (int t = gw; t < 6144 + 2048 + 512 + 512; t += NGW) {
            if (t < 6144) swa_prompt_task(F, t); else if (t < 8192) memattn_prompt_task(F, 1, t - 6144);
            else if (t < 8704) swa_sample_task(F, t - 8192, wl); else memattn_sample_task(F, 1, t - 8704, wl); }
    } SEAM(9);

    if (IN(10)) for (int rep_ = 0; rep_ < PH_REP(10); ++rep_) { PHASE_BEGIN(); pg8::Gemm g{MIX, (const bf16*)(F.ws + WS_WOUT) + (size_t)DM * DM, R, DM, DM}; pg8::StaticOrder S; S.init(R, DM, F.G, (int)blockIdx.x);
        pg8::EpiResid E{F.out + O_Y, F.out + O_Y + (size_t)RP * DM, RP, F.out + O_Y, HB, SSQ};
        pg8::gemm_phase<pg8::EpiResid, pg8::StaticOrder, true, true>(F.lds + RING_OFF, g, S, E, F.wave, F.lane); } SEAM(10);
    if (IN(11)) for (int rep_ = 0; rep_ < PH_REP(11); ++rep_) { PHASE_BEGIN(); pg8::Gemm g{HB, (const bf16*)(F.ws + WS_WUP) + (size_t)DM * FF, R, FF, DM}; pg8::StaticOrder S; S.init(R, FF, F.G, (int)blockIdx.x);
        pg8::EpiScaleBf16<1> E{HH, FF, SSQ};
        pg8::gemm_phase<pg8::EpiScaleBf16<1>, pg8::StaticOrder, true, true>(F.lds + RING_OFF, g, S, E, F.wave, F.lane); } SEAM(11);
    if (IN(12)) for (int rep_ = 0; rep_ < PH_REP(12); ++rep_) { PHASE_BEGIN(); pg8::Gemm g{HH, (const bf16*)(F.ws + WS_WDN) + (size_t)DM * FF, R, DM, FF}; pg8::StaticOrder S; S.init(R, DM, F.G, (int)blockIdx.x);
        pg8::EpiResid E{F.out + O_Y, F.out + O_Y + (size_t)RP * DM, RP, F.out + O_Y, nullptr, nullptr};
        pg8::gemm_phase<pg8::EpiResid, pg8::StaticOrder, true, true>(F.lds + RING_OFF, g, S, E, F.wave, F.lane); }
#undef IN
#undef SEAM
#undef SSQ
#undef HB
#undef MIX
#undef HH
#undef PHASE_BEGIN
}

template <int PM> static void launch_pm(int grid, hipStream_t stream, const Args& a) { hipLaunchKernelGGL(yoco_fwd<PM>, dim3(grid), dim3(NWAVES * 64), LDS_BYTES, stream, a); }
template <int PM> static bool set_lds() { return hipFuncSetAttribute((const void*)yoco_fwd<PM>, hipFuncAttributeMaxDynamicSharedMemorySize, LDS_BYTES) == hipSuccess; }
extern "C" void kernel_launch(void* const* d_in, const int* in_sizes, int n_in, void* d_out, int out_size, void* d_ws, size_t ws_size, hipStream_t stream) {
    static int grid = 0;
    if (grid == 0) {
        if (n_in != N_IN || (size_t)out_size != O_END || ws_size < WS_END) { fprintf(stderr, "kernel_launch: unexpected shapes (n_in %d, out %d, ws %zu < %zu)\n", n_in, out_size, ws_size, (size_t)WS_END); grid = -1; return; }
        int dev = 0, cus = 0;
        if (hipGetDevice(&dev) != hipSuccess || hipDeviceGetAttribute(&cus, hipDeviceAttributeMultiprocessorCount, dev) != hipSuccess) { grid = -1; return; }
        bool ok = true;
#if MK_ONE_LAUNCH
        ok = set_lds<0x1fff>();
#else
        ok = set_lds<1>() && set_lds<2>() && set_lds<4>() && set_lds<8>() && set_lds<16>() && set_lds<32>() && set_lds<64>() && set_lds<128>() && set_lds<256>() && set_lds<512>() && set_lds<1024>() && set_lds<2048>() && set_lds<4096>();
#endif
        if (!ok) { grid = -1; return; }
        (void)hipGetLastError();
        grid = cus;
    }
    if (grid < 0) return;
    (void)hipMemsetAsync((char*)d_ws + WS_CTL, 0, CTL_ZERO_BYTES, stream);
    Args a{};
    for (int i = 0; i < N_IN; ++i) a.in[i] = (const float*)d_in[i];
    a.out = (float*)d_out; a.ws = (unsigned char*)d_ws;
#if MK_ONE_LAUNCH
    a.ph_lo = 0; a.ph_hi = N_PHASES; launch_pm<0x1fff>(grid, stream, a);
#else
#define LP(p) a.ph_lo = (p); a.ph_hi = (p) + 1; launch_pm<(1 << (p))>(grid, stream, a);
    LP(0) LP(1) LP(2) LP(3) LP(4) LP(5) LP(6) LP(7) LP(8) LP(9) LP(10) LP(11) LP(12)
#undef LP
#endif
}
```

```cpp
#include <hip/hip_runtime.h>
#include <cstdio>
#include <cstdint>
namespace pg8 {
#define PG8_LAS __attribute__((address_space(3)))
typedef unsigned short bf16_t;
typedef short bf16x8 __attribute__((ext_vector_type(8)));
typedef float f32x4 __attribute__((ext_vector_type(4)));
typedef unsigned u32x4 __attribute__((ext_vector_type(4)));
constexpr int BM = 256, BK = 64, HALF = 128, HTB = HALF * BK * 2  , STAGE_BYTES = 8 * HTB, NXCD = 8, WGM = 8;

__host__ __device__ __forceinline__ int lds_byte(int r, int c) { const int st = (r >> 4) * 2 + (c >> 5), rr = r & 15, cc = c & 31, ob = rr * 64 + cc * 2; return st * 1024 + (ob ^ (((ob >> 9) & 1) << 5)); }
__host__ __device__ __forceinline__ void stage_rc(int b, int& R, int& C) { const int st = b / 1024, sb = b % 1024, swz = sb ^ (((sb >> 9) & 1) << 5); R = (st >> 1) * 16 + swz / 64; C = (st & 1) * 32 + (swz % 64) / 2; }
__host__ __device__ __forceinline__ int perm32(int rho) { const int n = rho >> 4, i = rho & 15; return 8 * (i >> 2) + 4 * n + (i & 3); }

struct Unit { int pm, pn, kt0, nt; };
struct Gemm { const bf16_t* A; const bf16_t* Bt; int M, N, K; };

struct StaticOrder {
    int nM, nN, nwg, G, c, ntf;
    __host__ __device__ void init(int M, int N, int G_, int c_, int K_) { nM = M / BM; nN = N / BM; nwg = nM * nN; G = G_; c = c_; ntf = K_ / BK; }
    __host__ __device__ bool next(int i, Unit& u) const {
        const long L = (long)i * G + c; if (L >= nwg) return false;
        int wgid = (int)L; { const int q = nwg / NXCD, r = nwg % NXCD, xcd = wgid % NXCD, off = wgid / NXCD; wgid = (xcd < r ? xcd * (q + 1) : r * (q + 1) + (xcd - r) * q) + off; }
        const int nig = WGM * nN, gid = wgid / nig, fm = gid * WGM, gsz = (nM - fm) < WGM ? (nM - fm) : WGM;
        u.pm = fm + ((wgid % nig) % gsz); u.pn = (wgid % nig) / gsz; u.kt0 = 0; u.nt = ntf; return true;
    }
    __device__ __forceinline__ void a_ready(const Unit&) const {}
    __device__ __forceinline__ void done(const Unit&) const {}
};
struct TailOrder {
    StaticOrder P; int S, ntf;
    __host__ __device__ void init(int G_, int c_, int K_, int S_) { P.init(64 * BM, 4 * BM, G_, c_, K_); S = S_; ntf = K_ / BK; }
    __host__ __device__ bool next(int i, Unit& u) const {
        const long L = (long)i * P.G + P.c; if (L >= 256 + 8 * S) return false;
        const int Li = (int)L; const bool prm = Li < 256;
        const int w0 = prm ? Li : 0, wg = (w0 % NXCD) * (256 / NXCD) + w0 / NXCD, nig = WGM * 4, gid = wg / nig, fm = gid * WGM;
        const int pmP = fm + ((wg % nig) % WGM), pnP = (wg % nig) / WGM;
        const int Ls = prm ? 0 : Li - 256, tile = Ls / S, sl = Ls % S, nts = ntf / S;
        u.pm = prm ? pmP : 64 + (tile >> 2); u.pn = prm ? pnP : (tile & 3); u.nt = prm ? ntf : nts; u.kt0 = prm ? 0 : sl * nts; return true;
    }
    __device__ __forceinline__ void a_ready(const Unit&) const {}
    __device__ __forceinline__ void done(const Unit&) const {}
};


typedef float f32x2_t __attribute__((ext_vector_type(2))); typedef __bf16 bf16x2_t __attribute__((ext_vector_type(2)));
__device__ __forceinline__ unsigned cvt_pk_bf16(float lo, float hi) { f32x2_t v = {lo, hi}; bf16x2_t b = __builtin_convertvector(v, bf16x2_t); return __builtin_bit_cast(unsigned, b); }
__device__ __forceinline__ u32x4 pack8(f32x4 v0, f32x4 v1) { u32x4 w; w.x = cvt_pk_bf16(v0[0], v0[1]); w.y = cvt_pk_bf16(v0[2], v0[3]); w.z = cvt_pk_bf16(v1[0], v1[1]); w.w = cvt_pk_bf16(v1[2], v1[3]); return w; }

template <int M> __device__ __forceinline__ float swz_xor(float v) { return __int_as_float(__builtin_amdgcn_ds_swizzle(__float_as_int(v), (M << 10) | 0x1f)); }
__device__ __forceinline__ float add_x32(float v) { auto r = __builtin_amdgcn_permlane32_swap(__float_as_uint(v), __float_as_uint(v), false, false); return __uint_as_float(r[0]) + __uint_as_float(r[1]); }
__device__ __forceinline__ float max_x32(float v) { auto r = __builtin_amdgcn_permlane32_swap(__float_as_uint(v), __float_as_uint(v), false, false); return fmaxf(__uint_as_float(r[0]), __uint_as_float(r[1])); }
__device__ __forceinline__ float add_x16(float v) { return v + swz_xor<16>(v); }
__device__ __forceinline__ float hsum4(f32x4 a) { return (a[0] + a[1]) + (a[2] + a[3]); }
__device__ __forceinline__ float row_rstd(const float* ssq, int row) {
    const f32x4* p = (const f32x4*)(ssq + (size_t)row * 16);
    const f32x4 a = p[0], b = p[1], c = p[2], d = p[3];
    const float s = (hsum4(a) + hsum4(b)) + (hsum4(c) + hsum4(d));
    return rsqrtf(s * (1.0f / 1024.0f) + 1e-6f);
}
template <int ACT> struct EpiScaleBf16 {
    static constexpr bool PERM = true, AFTER_DRAIN = false;
    bf16_t* O; int ldc; const float* ssq;
    __device__ __forceinline__ void operator()(const f32x4 (&acc)[2][2][4][2], const Unit& u, int wr, int wc, int fr_, int fq_) const {
        int fr = fr_, fq = fq_; asm volatile("" : "+v"(fr), "+v"(fq));
        const int row0 = u.pm * BM + wr * 64 + fr, col0 = u.pn * BM + wc * 32 + 8 * fq;
#pragma unroll
        for (int ai = 0; ai < 2; ++ai)
#pragma unroll
            for (int m = 0; m < 4; ++m) { const int row = row0 + ai * HALF + m * 16; const float rs = row_rstd(ssq, row); bf16_t* rowp = O + (size_t)row * ldc + col0;
#pragma unroll
                for (int bj = 0; bj < 2; ++bj) { f32x4 v0 = acc[ai][bj][m][0] * rs, v1 = acc[ai][bj][m][1] * rs;
                    if (ACT == 1) {
#pragma unroll
                        for (int e = 0; e < 4; ++e) { const float a = fmaxf(v0[e], 0.f), b = fmaxf(v1[e], 0.f); v0[e] = a * a; v1[e] = b * b; } }
                    *(u32x4*)(rowp + bj * HALF) = pack8(v0, v1); } }
    }
};
struct EpiResid {
    static constexpr bool PERM = true, AFTER_DRAIN = false;
    const float* base; const float* base2; int split; float* out; bf16_t* hb; float* ssq_out; float* slab; int S;
    __device__ __forceinline__ void operator()(const f32x4 (&acc)[2][2][4][2], const Unit& u, int wr, int wc, int fr_, int fq_) const {
        int fr = fr_, fq = fq_; asm volatile("" : "+v"(fr), "+v"(fq));
        if (slab && u.pm >= 64) {
            float* sp = slab + ((size_t)((((u.pm - 64) << 2) + u.pn) * S + u.kt0 / u.nt) << 16) + (size_t)(wr * 64 + fr) * 256 + wc * 32 + 8 * fq;
#pragma unroll
            for (int ai = 0; ai < 2; ++ai)
#pragma unroll
                for (int m = 0; m < 4; ++m)
#pragma unroll
                    for (int bj = 0; bj < 2; ++bj) { float* p = sp + (size_t)(ai * HALF + m * 16) * 256 + bj * HALF; *(f32x4*)p = acc[ai][bj][m][0]; *(f32x4*)(p + 4) = acc[ai][bj][m][1]; }
            return;
        }
        const int row0 = u.pm * BM + wr * 64 + fr, col0 = u.pn * BM + wc * 32 + 8 * fq;
#pragma unroll
        for (int ai = 0; ai < 2; ++ai)
#pragma unroll
            for (int m = 0; m < 4; ++m) { const int row = row0 + ai * HALF + m * 16;
                const float* bp = (row < split ? base + (size_t)row * 1024 : base2 + (size_t)(row - split) * 1024) + col0;
                float* op = out + (size_t)row * 1024 + col0; float ss = 0.f;
#pragma unroll
                for (int bj = 0; bj < 2; ++bj) { const f32x4 b0 = *(const f32x4*)(bp + bj * HALF), b1 = *(const f32x4*)(bp + bj * HALF + 4);
                    const f32x4 h0 = b0 + acc[ai][bj][m][0], h1 = b1 + acc[ai][bj][m][1];
                    *(f32x4*)(op + bj * HALF) = h0; *(f32x4*)(op + bj * HALF + 4) = h1;
                    if (hb) *(u32x4*)(hb + (size_t)row * 1024 + col0 + bj * HALF) = pack8(h0, h1);
                    ss += hsum4(h0 * h0) + hsum4(h1 * h1); }
                if (ssq_out) { ss = add_x16(ss); ss = add_x32(ss); if (fq == 0) ssq_out[(size_t)row * 16 + u.pn * 4 + wc] = ss; }
                if (m & 1) asm volatile("" ::: "memory"); }
    }
};
template <class Epi, class Sched, bool ALIGN_EPI = false, bool SP2 = false>
__device__ __forceinline__ void gemm_phase(PG8_LAS unsigned char* lds, const Gemm g, const Sched& S, const Epi& E, int wid_in, int lane_in) {
    const int wid = wid_in, lane = lane_in, tid = wid * 64 + lane, wr = wid >> 2, wc = wid & 3, fr = lane & 15, fq = lane >> 4;
    const int K = g.K;
    unsigned voffA[2], voffB[2];
#pragma unroll
    for (int i = 0; i < 2; ++i) { int R, C; stage_rc(tid * 16 + i * 8192, R, C); const int Rb = Epi::PERM ? ((R & ~31) + perm32(R & 31)) : R;
        voffA[i] = (unsigned)(R * K + C) * 2u; voffB[i] = (unsigned)(Rb * K + C) * 2u; }
    const size_t kstep = (size_t)(BK * 2);
    const size_t hstep = (size_t)HALF * K * 2;
    const size_t tstep = 2 * hstep;
    const unsigned ldsw = (unsigned)wid * 1024u;
    const int aoff = lds_byte(wr * 64 + fr, fq * 8), boff = lds_byte(wc * 32 + fr, fq * 8);
#define PG8_SA(b, h) (((b) * 2 + (h)) * HTB)
#define PG8_SB(b, h) ((4 + (b) * 2 + (h)) * HTB)
#define PG8_STAGE(bufoff, gbase, voff) do { _Pragma("unroll") for (int _i = 0; _i < 2; ++_i) \
        __builtin_amdgcn_global_load_lds((const unsigned*)((const char*)(gbase) + (voff)[_i]), (PG8_LAS unsigned*)(lds + (bufoff) + ldsw + _i * 8192), 16, 0, 0); } while (0)
#define PG8_LDA(dst, b, h) do { _Pragma("unroll") for (int m = 0; m < 4; ++m) _Pragma("unroll") for (int k = 0; k < 2; ++k) dst[m][k] = *(const PG8_LAS bf16x8*)(lds + PG8_SA(b, h) + aoff + m * 2048 + k * 1024); } while (0)
#define PG8_LDB(dst, b, h) do { _Pragma("unroll") for (int n = 0; n < 2; ++n) _Pragma("unroll") for (int k = 0; k < 2; ++k) dst[n][k] = *(const PG8_LAS bf16x8*)(lds + PG8_SB(b, h) + boff + n * 2048 + k * 1024); } while (0)
#define PG8_MMA(ai, bj, At, Bt) do { __builtin_amdgcn_s_setprio(1); _Pragma("unroll") for (int m = 0; m < 4; ++m) _Pragma("unroll") for (int n = 0; n < 2; ++n) _Pragma("unroll") for (int k = 0; k < 2; ++k) \
        acc[ai][bj][m][n] = __builtin_amdgcn_mfma_f32_16x16x32_bf16(Bt[n][k], At[m][k], acc[ai][bj][m][n], 0, 0, 0); __builtin_amdgcn_s_setprio(0); } while (0)
#define PG8_WAIT_V(n) asm volatile("s_waitcnt vmcnt(" #n ")" ::: "memory")
#define PG8_WAIT_L(n) asm volatile("s_waitcnt lgkmcnt(" #n ")" ::: "memory")
#define PG8_BAR __builtin_amdgcn_s_barrier()
#define PG8_SCHED __builtin_amdgcn_sched_barrier(0)
    Unit cur, nxt; int ui = 0;
    if (!S.next(0, cur)) return;
    f32x4 acc[2][2][4][2];
#pragma unroll
    for (int a = 0; a < 2; ++a)
#pragma unroll
        for (int b = 0; b < 2; ++b)
#pragma unroll
            for (int m = 0; m < 4; ++m)
#pragma unroll
                for (int n = 0; n < 2; ++n) acc[a][b][m][n] = (f32x4){0.f, 0.f, 0.f, 0.f};
    bf16x8 At[4][2], B0[2][2], B1[2][2];
    const char* cA = (const char*)g.A + (size_t)cur.pm * tstep + (size_t)cur.kt0 * kstep; const char* cB = (const char*)g.Bt + (size_t)cur.pn * tstep + (size_t)cur.kt0 * kstep;
    S.a_ready(cur);
    if constexpr (SP2) {
        PG8_STAGE(PG8_SB(0, 0), cB, voffB); PG8_STAGE(PG8_SB(0, 1), cB + hstep, voffB); PG8_STAGE(PG8_SA(0, 0), cA, voffA); PG8_STAGE(PG8_SA(0, 1), cA + hstep, voffA);
        if (wr == 1) PG8_BAR;
        PG8_WAIT_V(2); PG8_BAR;
        PG8_STAGE(PG8_SB(1, 0), cB + kstep, voffB); PG8_STAGE(PG8_SA(1, 0), cA + kstep, voffA); PG8_STAGE(PG8_SB(1, 1), cB + hstep + kstep, voffB);
        PG8_WAIT_V(6); PG8_BAR;
    } else {
        PG8_STAGE(PG8_SB(0, 0), cB, voffB); PG8_STAGE(PG8_SA(0, 0), cA, voffA); PG8_STAGE(PG8_SB(0, 1), cB + hstep, voffB); PG8_STAGE(PG8_SA(0, 1), cA + hstep, voffA);
        if (wr == 1) PG8_BAR;
        PG8_WAIT_V(4); PG8_BAR;
        PG8_STAGE(PG8_SB(1, 0), cB + kstep, voffB); PG8_STAGE(PG8_SA(1, 0), cA + kstep, voffA); PG8_STAGE(PG8_SB(1, 1), cB + hstep + kstep, voffB);
        PG8_WAIT_V(6); PG8_BAR;
    }
    for (;;) {
        const bool has_next = S.next(ui + 1, nxt);
        const char* nA = has_next ? (const char*)g.A + (size_t)nxt.pm * tstep + (size_t)nxt.kt0 * kstep : cA; const char* nB = has_next ? (const char*)g.Bt + (size_t)nxt.pn * tstep + (size_t)nxt.kt0 * kstep : cB;
        const int nt = cur.nt;
        for (int t = 0; t < nt; t += 2) {
            const bool last = (t == nt - 2);
            const char* a1 = cA + (size_t)(t + 1) * kstep;
            const char* a2 = last ? nA : cA + (size_t)(t + 2) * kstep; const char* b2 = last ? nB : cB + (size_t)(t + 2) * kstep;
            const char* a3 = a2 + kstep; const char* b3 = b2 + kstep;
            if (last && has_next) S.a_ready(nxt);
            if constexpr (SP2) {
            PG8_LDB(B0, 0, 0); PG8_LDB(B1, 0, 1); PG8_SCHED; PG8_LDA(At, 0, 0); PG8_STAGE(PG8_SA(1, 1), a1 + hstep, voffA);
            PG8_WAIT_V(8); PG8_WAIT_L(0); PG8_BAR; PG8_MMA(0, 0, At, B0); PG8_MMA(0, 1, At, B1); PG8_BAR; PG8_SCHED;
            PG8_LDA(At, 0, 1); PG8_STAGE(PG8_SB(0, 0), b2, voffB); PG8_STAGE(PG8_SB(0, 1), b2 + hstep, voffB); PG8_STAGE(PG8_SA(0, 0), a2, voffA);
            PG8_WAIT_V(8); PG8_WAIT_L(0); PG8_BAR; PG8_MMA(1, 0, At, B0); PG8_MMA(1, 1, At, B1); PG8_BAR; PG8_SCHED;
            PG8_LDB(B0, 1, 0); PG8_LDB(B1, 1, 1); PG8_SCHED; PG8_LDA(At, 1, 0); PG8_STAGE(PG8_SA(0, 1), a2 + hstep, voffA);
            PG8_WAIT_V(8); PG8_WAIT_L(0); PG8_BAR; PG8_MMA(0, 0, At, B0); PG8_MMA(0, 1, At, B1); PG8_BAR; PG8_SCHED;
            PG8_LDA(At, 1, 1); PG8_STAGE(PG8_SB(1, 0), b3, voffB); PG8_STAGE(PG8_SB(1, 1), b3 + hstep, voffB); PG8_STAGE(PG8_SA(1, 0), a3, voffA);
            PG8_WAIT_V(8); PG8_WAIT_L(0); PG8_BAR; PG8_MMA(1, 0, At, B0); PG8_MMA(1, 1, At, B1); PG8_BAR; PG8_SCHED;
            } else {
            PG8_LDB(B0, 0, 0); PG8_SCHED; PG8_LDA(At, 0, 0); PG8_STAGE(PG8_SA(1, 1), a1 + hstep, voffA);
            PG8_WAIT_L(8); PG8_BAR; PG8_WAIT_L(0); PG8_MMA(0, 0, At, B0); PG8_BAR; PG8_SCHED;
            PG8_LDB(B1, 0, 1); PG8_STAGE(PG8_SB(0, 0), b2, voffB);
            PG8_BAR; PG8_WAIT_L(0); PG8_MMA(0, 1, At, B1); PG8_BAR;
            PG8_LDA(At, 0, 1); PG8_STAGE(PG8_SA(0, 0), a2, voffA);
            PG8_BAR; PG8_WAIT_L(0); PG8_MMA(1, 0, At, B0); PG8_BAR; PG8_SCHED;
            PG8_STAGE(PG8_SB(0, 1), b2 + hstep, voffB);
            PG8_WAIT_V(6); PG8_BAR; PG8_MMA(1, 1, At, B1); PG8_BAR;
            PG8_LDB(B0, 1, 0); PG8_SCHED; PG8_LDA(At, 1, 0); PG8_STAGE(PG8_SA(0, 1), a2 + hstep, voffA);
            PG8_WAIT_L(8); PG8_BAR; PG8_WAIT_L(0); PG8_MMA(0, 0, At, B0); PG8_BAR; PG8_SCHED;
            PG8_LDB(B1, 1, 1); PG8_STAGE(PG8_SB(1, 0), b3, voffB);
            PG8_BAR; PG8_WAIT_L(0); PG8_MMA(0, 1, At, B1); PG8_BAR;
            PG8_LDA(At, 1, 1); PG8_STAGE(PG8_SA(1, 0), a3, voffA);
            PG8_BAR; PG8_WAIT_L(0); PG8_MMA(1, 0, At, B0); PG8_BAR; PG8_SCHED;
            PG8_STAGE(PG8_SB(1, 1), b3 + hstep, voffB);
            PG8_WAIT_V(6); PG8_BAR; PG8_MMA(1, 1, At, B1); PG8_BAR;
            }
        }
        if constexpr (ALIGN_EPI) { if (wr == 0) PG8_BAR; }
        if constexpr (!Epi::AFTER_DRAIN) { E(acc, cur, wr, wc, fr, fq); S.done(cur); }
        if (!has_next) break;
#pragma unroll
        for (int a = 0; a < 2; ++a)
#pragma unroll
            for (int b = 0; b < 2; ++b)
#pragma unroll
                for (int m = 0; m < 4; ++m)
#pragma unroll
                    for (int n = 0; n < 2; ++n) acc[a][b][m][n] = (f32x4){0.f, 0.f, 0.f, 0.f};
        cur = nxt; cA = nA; cB = nB; ++ui;
        if constexpr (ALIGN_EPI) { if (wr == 1) PG8_BAR; }
    }
    PG8_WAIT_V(0);
    if constexpr (!ALIGN_EPI) { if (wr == 0) PG8_BAR; }
    PG8_BAR;
    if constexpr (Epi::AFTER_DRAIN) { E.fused(acc, cur, wr, wc, fr, fq, lds, wid, lane); S.done(cur); }
#undef PG8_SA
#undef PG8_SB
#undef PG8_STAGE
#undef PG8_LDA
#undef PG8_LDB
#undef PG8_MMA
#undef PG8_WAIT_V
#undef PG8_WAIT_L
#undef PG8_BAR
#undef PG8_SCHED
}
}

constexpr int NWAVES = 8;
#ifndef MK_ONE_LAUNCH
#define MK_ONE_LAUNCH 1
#endif
constexpr int DM = 1024, RP = 16384  , RS = 512  , R = RP + RS, T = 8192, NB = 2, SB = 128, ST = 4;
constexpr int NCOLA = 2816, RWKV_COLS = 2560, NH = 12, HD = 64, FF = 4096, NCOLB = 1536, NMEM = 256;
constexpr int NCHUNK = RP / 64  , NUNIT = NCHUNK * NH  ;
constexpr float C2Q = 0.125f * 1.4426950408889634f;
constexpr float LOG2E = 1.4426950408889634f;
enum { I_XP = 0, I_XS, I_SSHIFT, I_SWKV, I_CSK, I_CSV, I_CMK, I_CMV, I_MEMP, I_NMIX, I_NMLP, I_WOUT, I_WUP, I_WDN, I_MNORM, I_WMKV, I_MQN, I_MKN,
       I_WINA, I_MU, I_WW2, I_W0, I_WA2, I_A0, I_WG2, I_KK, I_KA, I_RK, I_LNW, I_LNB, I_WINB, I_QN, I_SINKS, I_KVN, I_WKV, I_KN, N_IN };
constexpr size_t O_Y = 0, O_PSHIFT = (size_t)R * DM, O_PWKV = O_PSHIFT + 2 * RWKV_COLS, O_PSK = O_PWKV + 2 * 12 * 4096, O_PSV = O_PSK + 2 * 128 * 256,
                 O_PMK = O_PSV + 2 * 128 * 256, O_PMV = O_PMK + 2 * 2 * 256 * 256, O_SSHIFT = O_PMV + 2 * 2 * 256 * 256, O_SWKV = O_SSHIFT + (size_t)SB * RWKV_COLS,
                 O_SSK = O_SWKV + (size_t)SB * 12 * 4096, O_SSV = O_SSK + (size_t)SB * 128 * 256, O_END = O_SSV + (size_t)SB * 128 * 256;
constexpr size_t al256(size_t x) { return (x + 255) & ~(size_t)255; }
constexpr size_t WS_CTL = 0, CTL_ZERO_BYTES = 1u << 20;
constexpr size_t WS_WA = CTL_ZERO_BYTES;
constexpr size_t WS_WOUT = WS_WA + (size_t)NCOLA * DM * 2;
constexpr size_t WS_WUP = WS_WOUT + (size_t)2 * DM * DM * 2;
constexpr size_t WS_WDN = WS_WUP + (size_t)2 * FF * DM * 2;
constexpr size_t WS_WB = WS_WDN + (size_t)2 * FF * DM * 2;
constexpr size_t WS_WM = WS_WB + (size_t)NCOLB * DM * 2;
constexpr size_t WS_WW2 = WS_WM + (size_t)DM * DM * 2;
constexpr size_t WS_WA2 = WS_WW2 + (size_t)768 * 64 * 2;
constexpr size_t WS_WG2 = WS_WA2 + (size_t)768 * 64 * 2;
constexpr size_t WS_ROPE = WS_WG2 + (size_t)768 * 128 * 2;
constexpr size_t WS_SSQ = al256(WS_ROPE + (size_t)8196 * 64 * 4);
constexpr size_t WS_SSQM = WS_SSQ + (size_t)R * 16 * 4;
constexpr size_t WS_MB = WS_SSQM + (size_t)512 * 16 * 4;
constexpr size_t WS_MK = WS_MB + (size_t)512 * DM * 2;
constexpr size_t WS_MVT = WS_MK + (size_t)2 * 2 * 4 * 256 * 64 * 2;
constexpr size_t WS_HB = WS_MVT + (size_t)2 * 2 * 4 * 256 * 64 * 2;
constexpr size_t WS_MIX = WS_HB + (size_t)R * DM * 2;
constexpr size_t WS_BIG = WS_MIX + (size_t)R * DM * 2;
constexpr size_t WS_PROJ = WS_BIG;
constexpr size_t WS_REC = WS_PROJ + (size_t)R * NCOLA * 2;
constexpr size_t REC_BYTES = 5 * 8192;
constexpr size_t WS_END0 = WS_REC + (size_t)NUNIT * REC_BYTES;
constexpr size_t WS_H = WS_BIG;
constexpr size_t WS_END1 = WS_H + (size_t)R * FF * 2;
constexpr size_t WS_SLAB = WS_BIG + ((size_t)160 << 20);
constexpr int S_K1 = 4, S_K4 = 16;
constexpr size_t WS_Q1 = WS_BIG;
constexpr size_t WS_K1 = WS_Q1 + (size_t)R * DM * 2;
constexpr size_t WS_V1 = WS_K1 + (size_t)R * 256 * 2;
constexpr size_t WS_VT1 = WS_V1 + (size_t)R * 256 * 2;
constexpr size_t WS_END = WS_END0 > WS_END1 ? WS_END0 : WS_END1;
static_assert(WS_VT1 + (size_t)2 * 4 * 64 * 8192 * 2 <= WS_END && WS_END1 <= WS_SLAB && WS_SLAB + ((size_t)32 << 20) <= WS_END, "ws map");
constexpr int CW_BAR = 4096;
constexpr int RING_OFF = 0, RING_BYTES = 131072, PREP_HALF = 73728, LDSCTL_OFF = 147456, MISC_OFF = LDSCTL_OFF + 320, WTOT_OFF = LDSCTL_OFF + 1024, LDS_BYTES = LDSCTL_OFF + 4096;

#define GAS __attribute__((address_space(1)))
#define LAS __attribute__((address_space(3)))
typedef unsigned short bf16;
typedef unsigned v4u __attribute__((ext_vector_type(4)));
typedef unsigned v2u __attribute__((ext_vector_type(2)));
typedef float f32x4 __attribute__((ext_vector_type(4)));
typedef float f32x16 __attribute__((ext_vector_type(16)));
typedef short bf16x8 __attribute__((ext_vector_type(8)));
typedef short bf16x4 __attribute__((ext_vector_type(4)));
typedef GAS unsigned gu32;
#define RLX_AGENT __ATOMIC_RELAXED, __HIP_MEMORY_SCOPE_AGENT
#define LDS_WAIT() asm volatile("s_waitcnt lgkmcnt(0)" ::: "memory")
#define VM_WAIT() asm volatile("s_waitcnt vmcnt(0)" ::: "memory")
using pg8::cvt_pk_bf16;
__device__ __forceinline__ int mk_lane() { int l; asm volatile("v_mbcnt_lo_u32_b32 %0, -1, 0\n\tv_mbcnt_hi_u32_b32 %0, -1, %0" : "=v"(l)); return l; }
__device__ __forceinline__ float bf2f(unsigned v) { return __uint_as_float(v << 16); }
__device__ __forceinline__ float bflo(unsigned w) { return __uint_as_float(w << 16); }
__device__ __forceinline__ float bfhi(unsigned w) { return __uint_as_float(w & 0xffff0000u); }
__device__ __forceinline__ bf16 f2bf(float f) { return (bf16)(cvt_pk_bf16(f, 0.f) & 0xffffu); }
__device__ __forceinline__ v2u pack4(f32x4 v) { v2u w; w.x = cvt_pk_bf16(v[0], v[1]); w.y = cvt_pk_bf16(v[2], v[3]); return w; }
__device__ __forceinline__ f32x4 unpack4(v2u w) { return (f32x4){bflo(w.x), bfhi(w.x), bflo(w.y), bfhi(w.y)}; }
__device__ __forceinline__ f32x4 mfma16(bf16x8 a, bf16x8 b, f32x4 c) { return __builtin_amdgcn_mfma_f32_16x16x32_bf16(a, b, c, 0, 0, 0); }
__device__ __forceinline__ f32x16 mfma32(bf16x8 a, bf16x8 b, f32x16 c) { return __builtin_amdgcn_mfma_f32_32x32x16_bf16(a, b, c, 0, 0, 0); }
using pg8::swz_xor; using pg8::add_x32; using pg8::max_x32; using pg8::add_x16;
__device__ __forceinline__ float sum16(float v) { v += swz_xor<1>(v); v += swz_xor<2>(v); v += swz_xor<4>(v); v += swz_xor<8>(v); return v; }
__device__ __forceinline__ float wave_sum(float v) { v = sum16(v); v = add_x16(v); return add_x32(v); }
__device__ __forceinline__ float wave_max(float v) { v = fmaxf(v, swz_xor<1>(v)); v = fmaxf(v, swz_xor<2>(v)); v = fmaxf(v, swz_xor<4>(v)); v = fmaxf(v, swz_xor<8>(v)); v = fmaxf(v, swz_xor<16>(v)); return max_x32(v); }
__device__ __forceinline__ float fsigmoid(float x) { return 1.0f / (1.0f + __expf(-x)); }
__device__ __forceinline__ float ftanh(float x) { const float e = __expf(2.0f * x); return 1.0f - 2.0f / (e + 1.0f); }
namespace pg8 {
__device__ __forceinline__ void head_norm(f32x4 (&x)[2][2], const float* gain, int fq) {
    float ss = 0.f;
#pragma unroll
    for (int bj = 0; bj < 2; ++bj)
#pragma unroll
        for (int n = 0; n < 2; ++n) ss += hsum4(x[bj][n] * x[bj][n]);
    ss = add_x16(ss); ss = add_x32(ss);
    const float rs = rsqrtf(ss * (1.0f / 64.0f) + 1e-6f);
#pragma unroll
    for (int bj = 0; bj < 2; ++bj)
#pragma unroll
        for (int n = 0; n < 2; ++n) { const f32x4 g = *(const f32x4*)(gain + 32 * bj + 8 * fq + 4 * n); x[bj][n] = x[bj][n] * rs * g; }
}
__device__ __forceinline__ void head_rope(f32x4 (&x)[2][2], const float* cs  , int fq) {
#pragma unroll
    for (int n = 0; n < 2; ++n) { const f32x4 t0 = *(const f32x4*)(cs + 2 * (8 * fq + 4 * n)), t1 = *(const f32x4*)(cs + 2 * (8 * fq + 4 * n) + 4);
        const f32x4 cc = {t0[0], t0[2], t1[0], t1[2]}, sn = {t0[1], t0[3], t1[1], t1[3]};
        const f32x4 x1 = x[0][n], x2 = x[1][n]; x[0][n] = x1 * cc - x2 * sn; x[1][n] = x2 * cc + x1 * sn; }
}
struct EpiL1 {
    static constexpr bool PERM = true, AFTER_DRAIN = false;
    unsigned char* ws; float* outp; const float* g_q; const float* g_mq; const float* g_k;
    __device__ __forceinline__ void operator()(const f32x4 (&acc)[2][2][4][2], const Unit& u, int wr, int wc, int fr_, int fq_) const {
        int fr = fr_, fq = fq_; asm volatile("" : "+v"(fr), "+v"(fq));
        const float* ssq = (const float*)(ws + WS_SSQ); const float* rope = (const float*)(ws + WS_ROPE); const float c2 = C2Q;
        bf16_t* Q1 = (bf16_t*)(ws + WS_Q1); bf16_t* K1 = (bf16_t*)(ws + WS_K1); bf16_t* V1 = (bf16_t*)(ws + WS_V1); bf16_t* VT1 = (bf16_t*)(ws + WS_VT1);
        float* p_k = outp + O_PSK; float* p_v = outp + O_PSV; float* s_k = outp + O_SSK; float* s_v = outp + O_SSV;
        const int H = u.pn * 4 + wc, row0 = u.pm * BM + wr * 64 + fr;
#pragma unroll
        for (int ai = 0; ai < 2; ++ai)
#pragma unroll
            for (int m = 0; m < 4; ++m) { const int row = row0 + ai * HALF + m * 16; const float rs = row_rstd(ssq, row);
                const int pidx = row < 16384 ? (row & 8191) : 8192 + ((row - 16384) & 3);
                f32x4 x[2][2];
#pragma unroll
                for (int bj = 0; bj < 2; ++bj)
#pragma unroll
                    for (int n = 0; n < 2; ++n) x[bj][n] = acc[ai][bj][m][n] * rs;
                if (H < 16) {
                    head_norm(x, H < 12 ? g_q : g_mq, fq);
                    if (H < 12) head_rope(x, rope + (size_t)pidx * 64, fq);
#pragma unroll
                    for (int bj = 0; bj < 2; ++bj) *(u32x4*)(Q1 + (size_t)row * 1024 + H * 64 + 32 * bj + 8 * fq) = pack8(x[bj][0] * c2, x[bj][1] * c2);
                } else {
                    const int kh = (H - 16) & 3; const bool isk = H < 20;
                    if (isk) { head_norm(x, g_k, fq); head_rope(x, rope + (size_t)pidx * 64, fq); }
                    bf16_t* dst = isk ? K1 : V1;
#pragma unroll
                    for (int bj = 0; bj < 2; ++bj) *(u32x4*)(dst + (size_t)row * 256 + kh * 64 + 32 * bj + 8 * fq) = pack8(x[bj][0], x[bj][1]);
                    if (!isk && row < 16384) {
                        const int b = row >> 13, t = row & 8191;
#pragma unroll
                        for (int bj = 0; bj < 2; ++bj)
#pragma unroll
                            for (int n = 0; n < 2; ++n)
#pragma unroll
                                for (int e = 0; e < 4; ++e) { const int d = 32 * bj + 8 * fq + 4 * n + e; VT1[((size_t)(b * 4 + kh) * 64 + d) * 8192 + t] = (bf16_t)(cvt_pk_bf16(x[bj][n][e], 0.f) & 0xffffu); } }
                    float* o = nullptr;
                    if (row < 16384) { const int b = row >> 13, t = row & 8191; if (t >= 8064) o = (isk ? p_k : p_v) + ((size_t)(b * 128 + (t - 8064)) * 4 + kh) * 64; }
                    else { const int b = (row - 16384) >> 2, i = (row - 16384) & 3; o = (isk ? s_k : s_v) + ((size_t)(b * 128 + 124 + i) * 4 + kh) * 64; }
                    if (o) {
#pragma unroll
                        for (int bj = 0; bj < 2; ++bj) { *(f32x4*)(o + 32 * bj + 8 * fq) = x[bj][0]; *(f32x4*)(o + 32 * bj + 8 * fq + 4) = x[bj][1]; } }
                }
                asm volatile("" ::: "memory");
            }
    }
};
struct EpiMemKV {
    static constexpr bool PERM = true, AFTER_DRAIN = false;
    unsigned char* ws; float* outp; const float* g_k  ;
    __device__ __forceinline__ void operator()(const f32x4 (&acc)[2][2][4][2], const Unit& u, int wr, int wc, int fr_, int fq_) const {
        int fr = fr_, fq = fq_; asm volatile("" : "+v"(fr), "+v"(fq));
        const float* ssq = (const float*)(ws + WS_SSQM); float* p_k = outp + O_PMK; float* p_v = outp + O_PMV; bf16_t* MK = (bf16_t*)(ws + WS_MK)  ; bf16_t* MVT = (bf16_t*)(ws + WS_MVT)  ;
        const int H = u.pn * 4 + wc, l = H >> 3, isv = (H >> 2) & 1, hh = H & 3, row0 = u.pm * BM + wr * 64 + fr;
#pragma unroll
        for (int ai = 0; ai < 2; ++ai)
#pragma unroll
            for (int m = 0; m < 4; ++m) { const int row = row0 + ai * HALF + m * 16; const float rs = row_rstd(ssq, row); const int b = row >> 8, mm = row & 255;
                f32x4 x[2][2];
#pragma unroll
                for (int bj = 0; bj < 2; ++bj)
#pragma unroll
                    for (int n = 0; n < 2; ++n) x[bj][n] = acc[ai][bj][m][n] * rs;
                if (!isv) head_norm(x, g_k + l * 64, fq);
                float* o = (isv ? p_v : p_k) + ((((size_t)l * 2 + b) * 256 + mm) * 4 + hh) * 64;
#pragma unroll
                for (int bj = 0; bj < 2; ++bj) { *(f32x4*)(o + 32 * bj + 8 * fq) = x[bj][0]; *(f32x4*)(o + 32 * bj + 8 * fq + 4) = x[bj][1]; }
                if (!isv) {
#pragma unroll
                    for (int bj = 0; bj < 2; ++bj) *(u32x4*)(MK + ((((size_t)l * 2 + b) * 4 + hh) * 256 + mm) * 64 + 32 * bj + 8 * fq) = pack8(x[bj][0], x[bj][1]);
                } else {
#pragma unroll
                    for (int bj = 0; bj < 2; ++bj)
#pragma unroll
                        for (int n = 0; n < 2; ++n)
#pragma unroll
                            for (int e = 0; e < 4; ++e) { const int d = 32 * bj + 8 * fq + 4 * n + e; MVT[((((size_t)l * 2 + b) * 4 + hh) * 64 + d) * 256 + mm] = (bf16_t)(cvt_pk_bf16(x[bj][n][e], 0.f) & 0xffffu); }
                }
                asm volatile("" ::: "memory");
            }
    }
};
}
#define XB_TMO      128
#define XB_XCNT(j)  (256  + 64 * (j))
#define XB_XSUB(j)  (1280 + 64 * (j))
#define XB_XGEN(j)  (2304 + 64 * (j))
#define XB_TOP      3328
#define XB_TOPGEN   3392
#define XCD_BAR_WORDS 3456
#define XB_SPIN_CAP (1u << 18)

__device__ __forceinline__ unsigned xb_ld(unsigned* p)              { return __hip_atomic_load(p, __ATOMIC_RELAXED, __HIP_MEMORY_SCOPE_AGENT); }
__device__ __forceinline__ unsigned xb_add(unsigned* p, unsigned v) { return __hip_atomic_fetch_add(p, v, __ATOMIC_RELAXED, __HIP_MEMORY_SCOPE_AGENT); }
__device__ __forceinline__ unsigned xb_xcc_id() { return (unsigned)__builtin_amdgcn_s_getreg((3 << 11) | 20) & 0xFu; }
#define XB_SPIN(cond, bar) do { unsigned _sp = 0; while (cond) { __builtin_amdgcn_s_sleep(1); \
    if ((++_sp & 255u) == 0u) { if (xb_ld(&(bar)[XB_TMO])) break; if (_sp > XB_SPIN_CAP) { atomicAdd(&(bar)[XB_TMO], 1u); break; } } } } while (0)

struct XcdBarrier {
    bool wave0;
    unsigned* bar; unsigned x;
    volatile LAS unsigned* st;
};

__device__ __forceinline__ XcdBarrier xcd_barrier_post(unsigned* bar, volatile LAS unsigned* st, bool wave0) {
    XcdBarrier b; b.wave0 = wave0; b.bar = bar; b.x = xb_xcc_id(); b.st = st;
    if (wave0 && mk_lane() == 0) (void)xb_add(&bar[XB_XCNT(b.x)], 1u);
    return b;
}
__device__ __forceinline__ void xcd_barrier_complete(unsigned* bar, unsigned x, unsigned& nloc, unsigned& nx) {
    const unsigned G = gridDim.x * gridDim.y * gridDim.z;
    unsigned sum, cnt, mine, sp = 0u;
    for (;;) {
        sum = 0u; cnt = 0u; mine = 0u;
#pragma unroll
        for (unsigned j = 0; j < 16; ++j) { const unsigned c = xb_ld(&bar[XB_XCNT(j)]); sum += c; cnt += (c > 0u) ? 1u : 0u; mine = (j == x) ? c : mine; }
        if (sum == G) break;
        __builtin_amdgcn_s_sleep(1);
        if ((++sp & 255u) == 0u) { if (xb_ld(&bar[XB_TMO])) break; if (sp > XB_SPIN_CAP) { atomicAdd(&bar[XB_TMO], 1u); break; } }
    }
    nloc = mine > 0u ? mine : 1u; nx = cnt > 0u ? cnt : 1u;
}

__device__ __forceinline__ void xcd_barrier(const XcdBarrier& b) {
    asm volatile("s_waitcnt vmcnt(0)" ::: "memory");
    __syncthreads();
    if (b.wave0 && mk_lane() == 0) {
        unsigned* bar = b.bar;
        __builtin_amdgcn_s_waitcnt(0);
        unsigned nloc = b.st[0], nx = b.st[1];
        if (nloc == 0u) { xcd_barrier_complete(bar, b.x, nloc, nx); b.st[0] = nloc; b.st[1] = nx; }
        const unsigned old = xb_add(&bar[XB_XSUB(b.x)], 1u);
        const unsigned gen = old / nloc;
        if (old + 1u == (gen + 1u) * nloc) {
            __builtin_amdgcn_fence(__ATOMIC_RELEASE, "agent");
            asm volatile("s_waitcnt vmcnt(0)" ::: "memory");
            const unsigned og = xb_add(&bar[XB_TOP], 1u);
            const unsigned tg = og / nx;
            if (og + 1u == (tg + 1u) * nx) xb_add(&bar[XB_TOPGEN], 1u);
            else XB_SPIN(xb_ld(&bar[XB_TOPGEN]) == tg, bar);
            __builtin_amdgcn_fence(__ATOMIC_ACQUIRE, "agent");
            xb_add(&bar[XB_XGEN(b.x)], 1u);
            asm volatile("s_waitcnt vmcnt(0)" ::: "memory");
        } else {
            XB_SPIN(xb_ld(&bar[XB_XGEN(b.x)]) == gen, bar);
            __builtin_amdgcn_fence(__ATOMIC_ACQUIRE, "agent");
            asm volatile("s_waitcnt vmcnt(0)" ::: "memory");
        }
    }
    __syncthreads();
}

struct Args { const float* in[N_IN]; float* out; unsigned char* ws; int ph_lo, ph_hi; };
struct Frame {
    LAS unsigned char* lds; unsigned char* lds_g;
    gu32* ctl;
    int tid, lane, wave, vcu, G;
    const float* const* in; float* out; unsigned char* ws;
};
__host__ __device__ __forceinline__ int wsig_inv(int nl) { return 128 * ((nl >> 5) & 1) + 32 * (nl >> 6) + (nl & 31); }

__device__ __forceinline__ void p0_transpose_item(const float* W, int K, int N, bf16* WT, int row_off, bool sig, const float* gain, LAS float* scr, int item, int lane) {
    const int nblk = N / 32, kb = item / nblk, nb = item % nblk, k0 = 64 * kb, n0 = 32 * nb;
    float tv[32];
#pragma unroll
    for (int i = 0; i < 32; ++i) { const int kk = 2 * i + (lane >> 5); tv[i] = W[(size_t)(k0 + kk) * N + n0 + (lane & 31)]; }
    if (gain) {
#pragma unroll
        for (int i = 0; i < 32; ++i) tv[i] *= gain[k0 + 2 * i + (lane >> 5)]; }
#pragma unroll
    for (int i = 0; i < 32; ++i) scr[(2 * i + (lane >> 5)) * 33 + (lane & 31)] = tv[i];
    LDS_WAIT(); asm volatile("" ::: "memory");
    const int c = lane & 7;
    int nbase = row_off + n0; if (sig) { const int ng = row_off + n0; nbase = (ng & ~255) + wsig_inv(ng & 255); }
#pragma unroll
    for (int j = 0; j < 4; ++j) { const int n = (lane >> 3) + 8 * j; const LAS float* s = scr + (8 * c) * 33 + n;
        v4u o; o.x = cvt_pk_bf16(s[0 * 33], s[1 * 33]); o.y = cvt_pk_bf16(s[2 * 33], s[3 * 33]); o.z = cvt_pk_bf16(s[4 * 33], s[5 * 33]); o.w = cvt_pk_bf16(s[6 * 33], s[7 * 33]);
        *(GAS v4u*)(WT + (size_t)(nbase + n) * K + k0 + 8 * c) = o; }
    LDS_WAIT(); asm volatile("" ::: "memory");
}
__device__ __forceinline__ void row_to_bf16_ssq(const float* xrow, bf16* orow, float* ssqrow, int lane) {
    const GAS f32x4* xr = (const GAS f32x4*)xrow + lane;
    f32x4 v[4]; float s = 0.f;
#pragma unroll
    for (int j = 0; j < 4; ++j) { v[j] = xr[64 * j]; s += (v[j].x * v[j].x + v[j].y * v[j].y) + (v[j].z * v[j].z + v[j].w * v[j].w); }
    s = wave_sum(s);
    GAS v2u* o8 = (GAS v2u*)orow + lane;
#pragma unroll
    for (int j = 0; j < 4; ++j) o8[64 * j] = pack4(v[j]);
    if (lane < 16) ssqrow[lane] = lane == 0 ? s : 0.f;
}
__device__ __forceinline__ void p0_prologue(Frame& F) {
    LAS float* scr = (LAS float*)(F.lds + RING_OFF + F.wave * 16384);
    const int gw = F.vcu * NWAVES + F.wave, NGW = F.G * NWAVES;
    unsigned char* ws = F.ws;
    int it = gw;
#define P0_JOB(Wp, K_, N_, WTp, roff, sg, gn) { const int ni = ((K_) / 64) * ((N_) / 32); for (; it < ni; it += NGW) p0_transpose_item((Wp), (K_), (N_), (WTp), (roff), (sg), (gn), scr, it, F.lane); it -= ni; }
    P0_JOB(F.in[I_WINA], DM, NCOLA, (bf16*)(ws + WS_WA), 0, false, F.in[I_NMIX]);
    P0_JOB(F.in[I_WOUT], DM, DM, (bf16*)(ws + WS_WOUT), 0, false, nullptr);
    P0_JOB(F.in[I_WOUT] + (size_t)DM * DM, DM, DM, (bf16*)(ws + WS_WOUT) + (size_t)DM * DM, 0, false, nullptr);
    P0_JOB(F.in[I_WUP], DM, FF, (bf16*)(ws + WS_WUP), 0, false, F.in[I_NMLP]);
    P0_JOB(F.in[I_WUP] + (size_t)DM * FF, DM, FF, (bf16*)(ws + WS_WUP) + (size_t)DM * FF, 0, false, F.in[I_NMLP] + DM);
    P0_JOB(F.in[I_WDN], FF, DM, (bf16*)(ws + WS_WDN), 0, false, nullptr);
    P0_JOB(F.in[I_WDN] + (size_t)DM * FF, FF, DM, (bf16*)(ws + WS_WDN) + (size_t)DM * FF, 0, false, nullptr);
    P0_JOB(F.in[I_WINB], DM, DM, (bf16*)(ws + WS_WB), 0, true, F.in[I_NMIX] + DM);
    P0_JOB(F.in[I_WKV], DM, 512, (bf16*)(ws + WS_WB), 1024, true, F.in[I_KVN]);
    P0_JOB(F.in[I_WMKV], DM, 512, (bf16*)(ws + WS_WM), 0, true, F.in[I_MNORM]);
    P0_JOB(F.in[I_WMKV] + (size_t)DM * 512, DM, 512, (bf16*)(ws + WS_WM), 512, true, F.in[I_MNORM] + DM);
    P0_JOB(F.in[I_WW2], 64, 768, (bf16*)(ws + WS_WW2), 0, false, nullptr);
    P0_JOB(F.in[I_WA2], 64, 768, (bf16*)(ws + WS_WA2), 0, false, nullptr);
    P0_JOB(F.in[I_WG2], 128, 768, (bf16*)(ws + WS_WG2), 0, false, nullptr);
#undef P0_JOB
    for (int m = gw; m < R; m += NGW) { const float* xr = m < RP ? F.in[I_XP] + (size_t)m * DM : F.in[I_XS] + (size_t)(m - RP) * DM;
        row_to_bf16_ssq(xr, (bf16*)(ws + WS_HB) + (size_t)m * DM, (float*)(ws + WS_SSQ) + (size_t)m * 16, F.lane); }
    for (int m = gw; m < 512; m += NGW) row_to_bf16_ssq(F.in[I_MEMP] + (size_t)m * DM, (bf16*)(ws + WS_MB) + (size_t)m * DM, (float*)(ws + WS_SSQM) + (size_t)m * 16, F.lane);
    { const int gt = F.vcu * NWAVES * 64 + F.tid, NGT = F.G * NWAVES * 64; float* rt = (float*)(ws + WS_ROPE);
      for (int i = gt; i < 8196 * 32; i += NGT) { const int p = i >> 5, f = i & 31; const float pos = (float)(p < 8192 ? p : 16384 + (p - 8192));
          double fq_ = 1.0; for (int k = 0; k < f; ++k) fq_ *= 0.74989420933245582730; const float ang = pos * (float)fq_; const double rev = (double)ang * 0.15915494309189535; const float fr = (float)(rev - floor(rev));
          rt[2 * i] = __builtin_amdgcn_cosf(fr); rt[2 * i + 1] = __builtin_amdgcn_sinf(fr); } }
    { const int gt = F.vcu * NWAVES * 64 + F.tid, NGT = F.G * NWAVES * 64; const int per = 124 * 256 / 4;
      for (int i = gt; i < SB * per; i += NGT) { const int b = i / per, r = i % per;
          ((GAS f32x4*)(F.out + O_SSK + (size_t)b * 128 * 256))[r] = ((const GAS f32x4*)(F.in[I_CSK] + (size_t)b * 128 * 256 + 4 * 256))[r];
          ((GAS f32x4*)(F.out + O_SSV + (size_t)b * 128 * 256))[r] = ((const GAS f32x4*)(F.in[I_CSV] + (size_t)b * 128 * 256 + 4 * 256))[r]; } }
}

__device__ __forceinline__ void finalize_sample(Frame& F, const float* base  , int S, bool want_hb) {
    const int gw = F.vcu * NWAVES + F.wave, NGW = F.G * NWAVES; const float* slab = (const float*)(F.ws + WS_SLAB);
    for (int rs = gw; rs < RS; rs += NGW) { const int row = RP + rs, tile0 = (rs >> 8) << 2, r = rs & 255; float ss = 0.f;
#pragma unroll
        for (int pn = 0; pn < 4; ++pn) { f32x4 h = *(const GAS f32x4*)(base + (size_t)rs * DM + pn * 256 + 4 * F.lane);
            for (int s = 0; s < S; ++s) h += *(const GAS f32x4*)(slab + ((size_t)((tile0 + pn) * S + s) << 16) + r * 256 + 4 * F.lane);
            *(GAS f32x4*)(F.out + O_Y + (size_t)row * DM + pn * 256 + 4 * F.lane) = h;
            if (want_hb) *(GAS v2u*)((bf16*)(F.ws + WS_HB) + (size_t)row * DM + pn * 256 + 4 * F.lane) = pack4(h);
            ss += (h[0] * h[0] + h[1] * h[1]) + (h[2] * h[2] + h[3] * h[3]); }
        if (want_hb) { ss = wave_sum(ss); if (F.lane < 16) ((float*)(F.ws + WS_SSQ))[(size_t)row * 16 + F.lane] = F.lane == 0 ? ss : 0.f; } }
}

constexpr int LSTR = 144, SLOT = 64 * LSTR;
__device__ __forceinline__ int rec_index(int chunk, int h) { return ((chunk >> 7) * NH + h) * 128 + (chunk & 127); }
constexpr int REC_PT = 0, REC_QS = 8192, REC_RY = 16384, REC_YL = 24576, REC_BV = 32768;
__device__ __forceinline__ bf16x8 lfrag(const LAS unsigned char* m, int row, int k) { return *(const LAS bf16x8*)(m + row * LSTR + k * 2); }
__device__ __forceinline__ void mm_strip(f32x4 (&acc)[4], const LAS unsigned char* X, const LAS unsigned char* Y, int w, int c, int g) {
#pragma unroll
    for (int ks = 0; ks < 2; ++ks) { const bf16x8 a = lfrag(X, 16 * w + c, 32 * ks + 8 * g);
#pragma unroll
        for (int n = 0; n < 4; ++n) acc[n] = mfma16(a, lfrag(Y, 16 * n + c, 32 * ks + 8 * g), acc[n]); }
}
__device__ __forceinline__ void mm_strip2(f32x4 (&acc0)[4], f32x4 (&acc1)[4], const LAS unsigned char* X, const LAS unsigned char* Y0, const LAS unsigned char* Y1, int w, int c, int g) {
#pragma unroll
    for (int ks = 0; ks < 2; ++ks) { const bf16x8 a = lfrag(X, 16 * w + c, 32 * ks + 8 * g);
#pragma unroll
        for (int n = 0; n < 4; ++n) { acc0[n] = mfma16(a, lfrag(Y0, 16 * n + c, 32 * ks + 8 * g), acc0[n]); acc1[n] = mfma16(a, lfrag(Y1, 16 * n + c, 32 * ks + 8 * g), acc1[n]); } }
}
__device__ __forceinline__ void zero4(f32x4 (&a)[4]) {
#pragma unroll
    for (int n = 0; n < 4; ++n) a[n] = (f32x4){0.f, 0.f, 0.f, 0.f};
}
__device__ __forceinline__ void st_T(LAS unsigned char* dest, const f32x4 (&acc)[4], int w, int c, int g) {
#pragma unroll
    for (int n = 0; n < 4; ++n) *(LAS v2u*)(dest + (16 * n + c) * LSTR + (16 * w + 4 * g) * 2) = pack4(acc[n]);
}
__device__ __forceinline__ void st_T_global(unsigned char* dest  , const f32x4 (&acc)[4], int w, int c, int g) {
#pragma unroll
    for (int n = 0; n < 4; ++n) *(GAS v2u*)(dest + (16 * n + c) * 128 + (16 * w + 4 * g) * 2) = pack4(acc[n]);
}
__device__ __forceinline__ void load_shift8(const bf16* cur, const bf16* prv, const float* mu, float (&o)[8]) {
    const v4u cw = *(const GAS v4u*)cur; v4u pw = {0u, 0u, 0u, 0u}; if (prv) pw = *(const GAS v4u*)prv;
    const f32x4 m0 = *(const GAS f32x4*)mu, m1 = *(const GAS f32x4*)(mu + 4);
    const float cf[8] = {bflo(cw.x), bfhi(cw.x), bflo(cw.y), bfhi(cw.y), bflo(cw.z), bfhi(cw.z), bflo(cw.w), bfhi(cw.w)};
    const float pf[8] = {bflo(pw.x), bfhi(pw.x), bflo(pw.y), bfhi(pw.y), bflo(pw.z), bfhi(pw.z), bflo(pw.w), bfhi(pw.w)};
    const float mf[8] = {m0[0], m0[1], m0[2], m0[3], m1[0], m1[1], m1[2], m1[3]};
#pragma unroll
    for (int i = 0; i < 8; ++i) o[i] = cf[i] + (pf[i] - cf[i]) * mf[i];
}
__device__ __forceinline__ bf16x8 pack_frag(const float (&v)[8]) {
    v4u w; w.x = cvt_pk_bf16(v[0], v[1]); w.y = cvt_pk_bf16(v[2], v[3]); w.z = cvt_pk_bf16(v[4], v[5]); w.w = cvt_pk_bf16(v[6], v[7]); return __builtin_bit_cast(bf16x8, w);
}

__device__ __forceinline__ void rwkv_prep_unit(Frame& F, int unit, LAS unsigned char* hb, LAS float* wtot, int stage_limit = 99) {
    int w_ = F.wave & 3, lane_ = F.lane; asm volatile("" : "+s"(w_), "+v"(lane_));
    const int w = w_, lane = lane_, g = lane >> 4, c = lane & 15;
    const int chunk = unit / NH, h = unit % NH, row0 = chunk * 64; const bool first = (chunk & 127) == 0;
    const bf16* proj = (const bf16*)(F.ws + WS_PROJ);
    unsigned char* rec = F.ws + WS_REC + (size_t)rec_index(chunk, h) * REC_BYTES;
    LAS unsigned char* const s0 = hb, * const s1 = hb + SLOT, * const s2 = hb + 2 * SLOT, * const s3 = hb + 3 * SLOT, * const s4 = hb + 4 * SLOT, * const s5 = hb + 5 * SLOT, * const s6 = hb + 6 * SLOT, * const s7 = hb + 7 * SLOT;
    f32x4 dw[4], da[4]; zero4(dw); zero4(da);
    {
        const int t = 16 * w + c; const bf16* cr = proj + (size_t)(row0 + t) * NCOLA; const bf16* pr = (first && t == 0) ? nullptr : cr - NCOLA;
        const bf16* Ww2 = (const bf16*)(F.ws + WS_WW2); const bf16* Wa2 = (const bf16*)(F.ws + WS_WA2);
#pragma unroll
        for (int ks = 0; ks < 2; ++ks) { const int l0 = 32 * ks + 8 * g; float x[8];
            load_shift8(cr + 2304 + l0, pr ? pr + 2304 + l0 : nullptr, F.in[I_MU] + 2304 + l0, x);
#pragma unroll
            for (int i = 0; i < 8; ++i) x[i] = ftanh(x[i]);
            const bf16x8 aw = pack_frag(x);
            load_shift8(cr + 2368 + l0, pr ? pr + 2368 + l0 : nullptr, F.in[I_MU] + 2368 + l0, x);
            const bf16x8 aa = pack_frag(x);
#pragma unroll
            for (int n = 0; n < 4; ++n) { const size_t wo = (size_t)(h * 64 + 16 * n + c) * 64 + l0;
                dw[n] = mfma16(aw, *(const GAS bf16x8*)(Ww2 + wo), dw[n]); da[n] = mfma16(aa, *(const GAS bf16x8*)(Wa2 + wo), da[n]); } }
    }
    f32x4 rt[4], kh[4], lw[4], at_[4], bt_[4], kt_[4], bh_[4], vv[4]; float gam[4]; float bon[4] = {0.f, 0.f, 0.f, 0.f}; float ssk[4] = {0.f, 0.f, 0.f, 0.f};
    f32x4 kkr[4], aa_[4], kp[4], rr[4];
    {
        float mur[4], muk[4], muv[4], w0[4], a0[4], kkc[4], kac[4], rkc[4];
#pragma unroll
        for (int n = 0; n < 4; ++n) { const int col = h * 64 + 16 * n + c; mur[n] = F.in[I_MU][col]; muk[n] = F.in[I_MU][768 + col]; muv[n] = F.in[I_MU][1536 + col];
            w0[n] = F.in[I_W0][col]; a0[n] = F.in[I_A0][col]; kkc[n] = F.in[I_KK][col]; kac[n] = F.in[I_KA][col]; rkc[n] = F.in[I_RK][col]; }
#pragma unroll
        for (int reg = 0; reg < 4; ++reg) { const int t = 16 * w + 4 * g + reg; const bool hp = !(first && t == 0);
            const GAS bf16* cr = (const GAS bf16*)(proj + (size_t)(row0 + t) * NCOLA + h * 64 + c); const GAS bf16* pr = hp ? cr - NCOLA : cr;
#pragma unroll
            for (int n = 0; n < 4; ++n) {
                const float r0 = bf2f(cr[16 * n]), k0 = bf2f(cr[16 * n + 768]), v0 = bf2f(cr[16 * n + 1536]);
                float r1 = bf2f(pr[16 * n]), k1 = bf2f(pr[16 * n + 768]), v1 = bf2f(pr[16 * n + 1536]);
                if (!hp) { r1 = 0.f; k1 = 0.f; v1 = 0.f; }
                const float r = r0 + (r1 - r0) * mur[n], k = k0 + (k1 - k0) * muk[n], v = v0 + (v1 - v0) * muv[n];
                const float y = -(w0[n] + dw[n][reg]);
                const float sp = fmaxf(y, 0.f) + __logf(1.0f + __expf(-fabsf(y)));
                lw[n][reg] = -__expf(-sp - 0.5f);
                const float a = fsigmoid(a0[n] + da[n][reg]);
                aa_[n][reg] = a; kkr[n][reg] = k * kkc[n]; kp[n][reg] = k * (1.0f + (a - 1.0f) * kac[n]); rr[n][reg] = r; vv[n][reg] = v;
                ssk[reg] += kkr[n][reg] * kkr[n][reg]; bon[reg] += r * kp[n][reg] * rkc[n]; }
            asm volatile("" ::: "memory"); }
    }
#pragma unroll
    for (int reg = 0; reg < 4; ++reg) { ssk[reg] = sum16(ssk[reg]); bon[reg] = sum16(bon[reg]); ssk[reg] = 1.0f / fmaxf(sqrtf(ssk[reg]), 1e-12f); }
    f32x4 Lc[4];
#pragma unroll
    for (int n = 0; n < 4; ++n) { f32x4 inc; inc[0] = lw[n][0]; inc[1] = inc[0] + lw[n][1]; inc[2] = inc[1] + lw[n][2]; inc[3] = inc[2] + lw[n][3];
        const float tot = inc[3]; const float t1 = __shfl(tot, (lane - 16) & 63), t2 = __shfl(tot, (lane - 32) & 63), t3 = __shfl(tot, (lane - 48) & 63);
        const float pre = (g >= 1 ? t1 : 0.f) + (g >= 2 ? t2 : 0.f) + (g >= 3 ? t3 : 0.f);
        Lc[n] = inc + pre; if (g == 3) wtot[w * 64 + 16 * n + c] = pre + tot; }
    __syncthreads();
#pragma unroll
    for (int n = 0; n < 4; ++n) { const int j = 16 * n + c; const float t0 = wtot[j], t1 = wtot[64 + j], t2 = wtot[128 + j], t3 = wtot[192 + j];
        const float base = (w >= 1 ? t0 : 0.f) + (w >= 2 ? t1 : 0.f) + (w >= 3 ? t2 : 0.f); const float LC = (t0 + t1) + (t2 + t3);
        gam[n] = __expf(LC);
#pragma unroll
        for (int reg = 0; reg < 4; ++reg) { const float L = Lc[n][reg] + base; const float eL = __expf(L), eLi = __expf(-L), eP = __expf(L - lw[n][reg]), eC = __expf(LC - L);
            const float kk = kkr[n][reg] * ssk[reg], bsc = kk * aa_[n][reg];
            at_[n][reg] = -kk * eP; rt[n][reg] = rr[n][reg] * eL; bt_[n][reg] = bsc * eLi; kt_[n][reg] = kp[n][reg] * eLi; bh_[n][reg] = bsc * eC; kh[n][reg] = kp[n][reg] * eC;
            const int t = 16 * w + 4 * g + reg;
            *(LAS bf16*)(s0 + t * LSTR + j * 2) = f2bf(at_[n][reg]); *(LAS bf16*)(s1 + t * LSTR + j * 2) = f2bf(bt_[n][reg]);
            *(LAS bf16*)(s2 + t * LSTR + j * 2) = f2bf(kt_[n][reg]); *(LAS bf16*)(s3 + t * LSTR + j * 2) = f2bf(rt[n][reg]); }
        *(LAS v2u*)(s4 + j * LSTR + (16 * w + 4 * g) * 2) = pack4(at_[n]); *(LAS v2u*)(s5 + j * LSTR + (16 * w + 4 * g) * 2) = pack4(bh_[n]); *(LAS v2u*)(s6 + j * LSTR + (16 * w + 4 * g) * 2) = pack4(vv[n]);
        f32x4 bv;
#pragma unroll
        for (int reg = 0; reg < 4; ++reg) bv[reg] = bon[reg] * vv[n][reg];
        *(GAS v2u*)(rec + REC_BV + ((w * 64 + lane) * 4 + n) * 8) = pack4(bv); }
    __syncthreads();
    if (stage_limit <= 3) return;
    f32x4 aN[4], aMk[4], aMbr[4], aMkr[4]; zero4(aN); zero4(aMk); zero4(aMbr); zero4(aMkr);
    mm_strip2(aN, aMk, s0, s1, s2, w, c, g);
    mm_strip(aMbr, s1, s3, w, c, g); mm_strip(aMkr, s2, s3, w, c, g);
#pragma unroll
    for (int n = 0; n < 4; ++n)
#pragma unroll
        for (int reg = 0; reg < 4; ++reg) { const int row = 16 * w + 4 * g + reg, col = 16 * n + c;
            if (!(col < row)) { aN[n][reg] = 0.f; aMk[n][reg] = 0.f; } if (!(row <= col)) { aMbr[n][reg] = 0.f; aMkr[n][reg] = 0.f; } }
    __syncthreads();
    LAS float* Nf = (LAS float*)s0;
#pragma unroll
    for (int n = 0; n < 4; ++n)
#pragma unroll
        for (int reg = 0; reg < 4; ++reg) Nf[(16 * w + 4 * g + reg) * 64 + 16 * n + c] = aN[n][reg];
    st_T(s2, aMk, w, c, g);
    st_T(s3, aMbr, w, c, g);
    __syncthreads();
    if (w == 0) {
        float col[64];
#pragma unroll
        for (int t = 0; t < 64; ++t) col[t] = 0.f;
#pragma unroll
        for (int t = 0; t < 64; ++t) { float pv[4] = {(t == lane) ? 1.0f : 0.0f, 0.f, 0.f, 0.f};
#pragma unroll
            for (int u4 = 0; u4 < (t + 3) / 4; ++u4) { const f32x4 nv = *(const LAS f32x4*)(Nf + t * 64 + 4 * u4);
#pragma unroll
                for (int e = 0; e < 4; ++e) if (4 * u4 + e < t) pv[e] = fmaf(nv[e], col[4 * u4 + e], pv[e]); }
            const float val = (pv[0] + pv[1]) + (pv[2] + pv[3]);
            col[t] = val; *(LAS bf16*)(s7 + t * LSTR + lane * 2) = f2bf(val); }
    }
    __syncthreads();
    if (stage_limit <= 5) return;
    { f32x4 aW[4], aNk[4]; zero4(aW); zero4(aNk); mm_strip2(aW, aNk, s7, s4, s2, w, c, g); st_T(s0, aW, w, c, g); st_T(s1, aNk, w, c, g); }
    __syncthreads();
    { f32x4 aP[4]; zero4(aP); mm_strip(aP, s0, s5, w, c, g);
#pragma unroll
      for (int n = 0; n < 4; ++n)
#pragma unroll
          for (int reg = 0; reg < 4; ++reg) if (n == w && c == 4 * g + reg) aP[n][reg] += gam[n];
#pragma unroll
      for (int n = 0; n < 4; ++n) *(GAS v2u*)(rec + REC_PT + ((n * 2 + (w >> 1)) * 64 + lane) * 16 + 8 * (w & 1)) = pack4(aP[n]); }
    { f32x4 aZq[4], aZy[4]; zero4(aZq); zero4(aZy); mm_strip2(aZq, aZy, s1, s5, s3, w, c, g);
#pragma unroll
      for (int n = 0; n < 4; ++n) { aZq[n] += kh[n]; aZy[n] += aMkr[n]; }
      f32x4 aRy[4]; zero4(aRy); mm_strip(aRy, s3, s0, w, c, g);
#pragma unroll
      for (int n = 0; n < 4; ++n)
#pragma unroll
          for (int reg = 0; reg < 4; ++reg) *(GAS bf16*)(rec + REC_RY + ((w * 2 + (n >> 1)) * 64 + 16 * (2 * (n & 1) + (c >> 3)) + 4 * g + reg) * 16 + 2 * (c & 7)) = f2bf(aRy[n][reg] + rt[n][reg]);
      st_T(s4, aZq, w, c, g);
      st_T(s7, aZy, w, c, g); }
    __syncthreads();
    { f32x4 aQ[4], aY[4]; zero4(aQ); zero4(aY); mm_strip(aQ, s4, s6, w, c, g); mm_strip(aY, s7, s6, w, c, g);
#pragma unroll
      for (int n = 0; n < 4; ++n) { *(GAS v2u*)(rec + REC_QS + ((n * 64 + lane) * 4 + w) * 8) = pack4(aQ[n]);
                                    *(GAS v2u*)(rec + REC_YL + ((w * 64 + lane) * 4 + n) * 8) = pack4(aY[n]); } }
}

__device__ __forceinline__ float rdlane(float v, int l) { return __int_as_float(__builtin_amdgcn_readlane(__float_as_int(v), l)); }
__device__ __forceinline__ void rwkv_sample_task(Frame& F, int task) {
    int lane_ = F.lane; asm volatile("" : "+v"(lane_)); const int lane = lane_;
    const int b = task / NH, h = task % NH, col = h * 64 + lane;
    const bf16* proj = (const bf16*)(F.ws + WS_PROJ);
    const float* sh = F.in[I_SSHIFT] + (size_t)b * RWKV_COLS;
    const float* mu = F.in[I_MU];
    float S[64];
    { const GAS f32x4* sp = (const GAS f32x4*)(F.in[I_SWKV] + (((size_t)b * NH + h) * 64 + lane) * 64);
#pragma unroll
      for (int q = 0; q < 16; ++q) { const f32x4 v = sp[q]; S[4 * q] = v[0]; S[4 * q + 1] = v[1]; S[4 * q + 2] = v[2]; S[4 * q + 3] = v[3]; } }
    const float w0 = F.in[I_W0][col], a0 = F.in[I_A0][col], kkc = F.in[I_KK][col], kac = F.in[I_KA][col], rkc = F.in[I_RK][col], lnw = F.in[I_LNW][col], lnb = F.in[I_LNB][col];
    float rr[ST], kq[ST], vq[ST], twd[ST], adv[ST], gd0[ST], gd1[ST];
#pragma unroll
    for (int i = 0; i < ST; ++i) { const int row = RP + b * ST + i; const bf16* cr = proj + (size_t)row * NCOLA;
#define SHIFTED(cc) ({ const float p_ = bf2f(cr[(cc)]); const float q_ = (i == 0) ? sh[(cc)] : bf2f(cr[(cc) - NCOLA]); p_ + (q_ - p_) * mu[(cc)]; })
        rr[i] = SHIFTED(col); kq[i] = SHIFTED(768 + col); vq[i] = SHIFTED(1536 + col);
        twd[i] = ftanh(SHIFTED(2304 + lane)); adv[i] = SHIFTED(2368 + lane); gd0[i] = fsigmoid(SHIFTED(2432 + lane)); gd1[i] = fsigmoid(SHIFTED(2496 + lane));
#undef SHIFTED
    }
    float dwv[ST] = {0.f, 0.f, 0.f, 0.f}, dav[ST] = {0.f, 0.f, 0.f, 0.f}, ggv[ST] = {0.f, 0.f, 0.f, 0.f};
    { const GAS float* W2 = (const GAS float*)(F.in[I_WW2] + col); const GAS float* A2 = (const GAS float*)(F.in[I_WA2] + col); const GAS float* G2 = (const GAS float*)(F.in[I_WG2] + col);
#pragma unroll 16
      for (int l = 0; l < 64; ++l) { const float w2 = W2[0], a2 = A2[0], g2a = G2[0], g2b = G2[64 * 768]; W2 += 768; A2 += 768; G2 += 768;
#pragma unroll
          for (int i = 0; i < ST; ++i) { dwv[i] = fmaf(rdlane(twd[i], l), w2, dwv[i]); dav[i] = fmaf(rdlane(adv[i], l), a2, dav[i]); ggv[i] = fmaf(rdlane(gd0[i], l), g2a, ggv[i]); ggv[i] = fmaf(rdlane(gd1[i], l), g2b, ggv[i]); } } }
#pragma unroll
    for (int i = 0; i < ST; ++i) {
        const int row = RP + b * ST + i;
        const float r = rr[i], k = kq[i], v = vq[i], dw = dwv[i], da = dav[i], gg = ggv[i];
        const float y0 = -(w0 + dw); const float sp = fmaxf(y0, 0.f) + __logf(1.0f + __expf(-fabsf(y0)));
        const float wdec = __expf(-__expf(-sp - 0.5f));
        const float a = fsigmoid(a0 + da);
        const float kkr = k * kkc; const float nrm = fmaxf(sqrtf(wave_sum(kkr * kkr)), 1e-12f); const float kk = kkr / nrm;
        const float kp = k * (1.0f + (a - 1.0f) * kac);
        const float asc = -kk, bsc = kk * a;
        const float bonus = wave_sum(r * kp * rkc);
        float sa = 0.f;
#pragma unroll
        for (int j = 0; j < 64; ++j) sa = fmaf(S[j], rdlane(asc, j), sa);
        const float vi = v;
        float y = 0.f;
#pragma unroll
        for (int j = 0; j < 64; ++j) { const float wj = rdlane(wdec, j), bj = rdlane(bsc, j), kj = rdlane(kp, j), rj = rdlane(r, j);
            S[j] = fmaf(S[j], wj, fmaf(sa, bj, vi * kj)); y = fmaf(S[j], rj, y); }
        const float mean = wave_sum(y) * (1.0f / 64.0f); const float dy = y - mean; const float var = wave_sum(dy * dy) * (1.0f / 64.0f);
        const float o = (dy * rsqrtf(var + 6.4e-4f) * lnw + lnb + bonus * vi) * gg;
        ((bf16*)(F.ws + WS_MIX))[(size_t)row * DM + col] = f2bf(o);
        asm volatile("" ::: "memory");
    }
    { GAS f32x4* sp = (GAS f32x4*)(F.out + O_SWKV + (((size_t)b * NH + h) * 64 + lane) * 64);
#pragma unroll
      for (int q = 0; q < 16; ++q) sp[q] = (f32x4){S[4 * q], S[4 * q + 1], S[4 * q + 2], S[4 * q + 3]}; }
    if (h == 0) { const bf16* lr = proj + (size_t)(RP + b * ST + ST - 1) * NCOLA; float* o = F.out + O_SSHIFT + (size_t)b * RWKV_COLS;
        for (int q = lane; q < RWKV_COLS; q += 64) o[q] = bf2f(lr[q]); }
}

__device__ __forceinline__ void rwkv_scan_chain(Frame& F, int bh, int w) {
    int lane_ = F.lane; asm volatile("" : "+v"(lane_)); const int lane = lane_, g = lane >> 4, c = lane & 15; const int b = bh / NH, h = bh % NH;
    f32x4 acc[4]; zero4(acc);
    const int vrow = 16 * w + c;
    auto recp = [&](int cc) -> unsigned char* { return F.ws + WS_REC + (size_t)((b * NH + h) * 128 + cc) * REC_BYTES; };
    constexpr int DPF = 4;
    bf16x8 pa[DPF][4][2]; v4u qa[DPF][2];
#define SCAN_LOAD(d, cc_) do { const unsigned char* rp_ = recp(cc_); \
        qa[d][0] = *(const GAS v4u*)(rp_ + REC_QS + (w * 64 + lane) * 32); qa[d][1] = *(const GAS v4u*)(rp_ + REC_QS + (w * 64 + lane) * 32 + 16); \
        _Pragma("unroll") for (int mt = 0; mt < 4; ++mt) _Pragma("unroll") for (int ks = 0; ks < 2; ++ks) pa[d][mt][ks] = *(const GAS bf16x8*)(rp_ + REC_PT + ((mt * 2 + ks) * 64 + lane) * 16); } while (0)
#pragma unroll
    for (int d = 0; d < DPF; ++d) SCAN_LOAD(d, d);
    for (int cc0 = 0; cc0 < 128; cc0 += DPF) {
#pragma unroll
        for (int d = 0; d < DPF; ++d) { const int cc = cc0 + d;
            unsigned char* sp_ = F.ws + WS_HB + (size_t)((b * NH + h) * 128 + cc) * 8192;
            v2u sb[4]; f32x4 nacc[4];
#pragma unroll
            for (int mt = 0; mt < 4; ++mt) sb[mt] = pack4(acc[mt]);
            nacc[0] = unpack4((v2u){qa[d][0].x, qa[d][0].y}); nacc[1] = unpack4((v2u){qa[d][0].z, qa[d][0].w}); nacc[2] = unpack4((v2u){qa[d][1].x, qa[d][1].y}); nacc[3] = unpack4((v2u){qa[d][1].z, qa[d][1].w});
#pragma unroll
            for (int mt = 0; mt < 4; ++mt) *(GAS v2u*)(sp_ + ((w * 2 + (mt >> 1)) * 64 + 16 * (2 * (mt & 1) + (g >> 1)) + c) * 16 + 8 * (g & 1)) = sb[mt];
            bf16x8 bf[2];
#pragma unroll
            for (int ks = 0; ks < 2; ++ks) { v4u t; t.x = sb[2 * ks].x; t.y = sb[2 * ks].y; t.z = sb[2 * ks + 1].x; t.w = sb[2 * ks + 1].y; bf[ks] = __builtin_bit_cast(bf16x8, t); }
#pragma unroll
            for (int mt = 0; mt < 4; ++mt) { nacc[mt] = mfma16(pa[d][mt][0], bf[0], nacc[mt]); nacc[mt] = mfma16(pa[d][mt][1], bf[1], nacc[mt]); acc[mt] = nacc[mt]; }
            if (cc + DPF < 128) SCAN_LOAD(d, cc + DPF);
        }
    }
#undef SCAN_LOAD
    float* o = F.out + O_PWKV + (((size_t)b * NH + h) * 64 + vrow) * 64;
#pragma unroll
    for (int mt = 0; mt < 4; ++mt) *(GAS f32x4*)(o + 16 * mt + 4 * g) = acc[mt];
}

__device__ __forceinline__ void rwkv_yout_item(Frame& F, int item) {
    int lane_ = F.lane; asm volatile("" : "+v"(lane_)); const int lane = lane_, g = lane >> 4, c = lane & 15; const int unit = item >> 2, w = item & 3;
    const int chunk = unit / NH, h = unit % NH, row0 = chunk * 64; const bool first = (chunk & 127) == 0;
    const unsigned char* rec = F.ws + WS_REC + (size_t)rec_index(chunk, h) * REC_BYTES; const unsigned char* srec = F.ws + WS_HB + (size_t)rec_index(chunk, h) * 8192;
    const bf16* proj = (const bf16*)(F.ws + WS_PROJ);
    f32x4 y[4], gt[4]; zero4(gt);
    { const v4u y01 = *(const GAS v4u*)(rec + REC_YL + (w * 64 + lane) * 32), y23 = *(const GAS v4u*)(rec + REC_YL + (w * 64 + lane) * 32 + 16);
      y[0] = unpack4((v2u){y01.x, y01.y}); y[1] = unpack4((v2u){y01.z, y01.w}); y[2] = unpack4((v2u){y23.x, y23.y}); y[3] = unpack4((v2u){y23.z, y23.w}); }
#pragma unroll
    for (int ks = 0; ks < 2; ++ks) { const bf16x8 a = *(const GAS bf16x8*)(rec + REC_RY + ((w * 2 + ks) * 64 + lane) * 16);
#pragma unroll
        for (int n = 0; n < 4; ++n) y[n] = mfma16(a, *(const GAS bf16x8*)(srec + ((n * 2 + ks) * 64 + lane) * 16), y[n]); }
    { const int t = 16 * w + c; const bf16* cr = proj + (size_t)(row0 + t) * NCOLA; const bf16* pr = (first && t == 0) ? nullptr : cr - NCOLA; const bf16* Wg2 = (const bf16*)(F.ws + WS_WG2);
#pragma unroll
      for (int ks = 0; ks < 4; ++ks) { const int l0 = 32 * ks + 8 * g; float x[8]; load_shift8(cr + 2432 + l0, pr ? pr + 2432 + l0 : nullptr, F.in[I_MU] + 2432 + l0, x);
#pragma unroll
          for (int i = 0; i < 8; ++i) x[i] = fsigmoid(x[i]);
          const bf16x8 ag = pack_frag(x);
#pragma unroll
          for (int n = 0; n < 4; ++n) gt[n] = mfma16(ag, *(const GAS bf16x8*)(Wg2 + (size_t)(h * 64 + 16 * n + c) * 128 + l0), gt[n]); } }
    float mean[4], rstd[4];
#pragma unroll
    for (int reg = 0; reg < 4; ++reg) { float s = (y[0][reg] + y[1][reg]) + (y[2][reg] + y[3][reg]); s = sum16(s); mean[reg] = s * (1.0f / 64.0f);
        float q = 0.f;
#pragma unroll
        for (int n = 0; n < 4; ++n) { const float d = y[n][reg] - mean[reg]; q += d * d; }
        q = sum16(q); rstd[reg] = rsqrtf(q * (1.0f / 64.0f) + 6.4e-4f); }
    bf16* mix = (bf16*)(F.ws + WS_MIX);
#pragma unroll
    for (int n = 0; n < 4; ++n) { const int col = h * 64 + 16 * n + c; const float lnw = F.in[I_LNW][col], lnb = F.in[I_LNB][col];
        const f32x4 bv = unpack4(*(const GAS v2u*)(rec + REC_BV + ((w * 64 + lane) * 4 + n) * 8));
#pragma unroll
        for (int reg = 0; reg < 4; ++reg) { const float o = ((y[n][reg] - mean[reg]) * rstd[reg] * lnw + lnb + bv[reg]) * gt[n][reg];
            mix[(size_t)(row0 + 16 * w + 4 * g + reg) * DM + col] = f2bf(o); } }
}

__device__ __forceinline__ int crow32(int r, int hi) { return (r & 3) + 8 * (r >> 2) + 4 * hi; }
template <bool MASKED, int GB>
__device__ __forceinline__ void flash32(const bf16x8 (&qf)[4], const bf16* Kp, int kstr, const bf16* VTp, int vstr, int kb_lo, int nblk, int qpos, float m0, float l0,
                                        f32x16& o0, f32x16& o1, float& lsum, int lane) {
    const int r32 = lane & 31, hh = lane >> 5;
    float m = m0, l = hh == 0 ? l0 : 0.f;
#pragma unroll
    for (int r = 0; r < 16; ++r) { o0[r] = 0.f; o1[r] = 0.f; }
    for (int b0 = 0; b0 < nblk; b0 += GB) {
        bf16x8 kf[GB][4]; v2u vf[GB][2][2][2];
#pragma unroll
        for (int i = 0; i < GB; ++i) if (b0 + i < nblk) { const int kb = kb_lo + 32 * (b0 + i);
#pragma unroll
            for (int ks = 0; ks < 4; ++ks) kf[i][ks] = *(const GAS bf16x8*)(Kp + (size_t)(kb + r32) * kstr + 16 * ks + 8 * hh);
#pragma unroll
            for (int s2 = 0; s2 < 2; ++s2)
#pragma unroll
                for (int dt = 0; dt < 2; ++dt) { const bf16* vp = VTp + (size_t)(32 * dt + r32) * vstr + kb + 16 * s2 + 4 * hh; vf[i][s2][dt][0] = *(const GAS v2u*)vp; vf[i][s2][dt][1] = *(const GAS v2u*)(vp + 8); } }
#pragma unroll
        for (int i = 0; i < GB; ++i) if (b0 + i < nblk) { const int kb = kb_lo + 32 * (b0 + i);
            f32x16 s;
#pragma unroll
            for (int r = 0; r < 16; ++r) s[r] = 0.f;
#pragma unroll
            for (int ks = 0; ks < 4; ++ks) s = mfma32(kf[i][ks], qf[ks], s);
            if (MASKED) {
#pragma unroll
                for (int r = 0; r < 16; ++r) { const int rel = qpos - (kb + crow32(r, hh)); if (rel < 0 || rel >= 128) s[r] = -1e30f; } }
            float bm = s[0];
#pragma unroll
            for (int r = 1; r < 16; ++r) bm = fmaxf(bm, s[r]);
            bm = max_x32(bm);
            const float mn = fmaxf(m, bm), alpha = __builtin_amdgcn_exp2f(m - mn); m = mn;
            float ps = 0.f;
#pragma unroll
            for (int r = 0; r < 16; ++r) { s[r] = __builtin_amdgcn_exp2f(s[r] - mn); ps += s[r]; }
            l = l * alpha + ps;
#pragma unroll
            for (int r = 0; r < 16; ++r) { o0[r] *= alpha; o1[r] *= alpha; }
#pragma unroll
            for (int s2 = 0; s2 < 2; ++s2) {
                v4u pw; pw.x = cvt_pk_bf16(s[8 * s2], s[8 * s2 + 1]); pw.y = cvt_pk_bf16(s[8 * s2 + 2], s[8 * s2 + 3]); pw.z = cvt_pk_bf16(s[8 * s2 + 4], s[8 * s2 + 5]); pw.w = cvt_pk_bf16(s[8 * s2 + 6], s[8 * s2 + 7]);
                const bf16x8 pb = __builtin_bit_cast(bf16x8, pw);
                { v4u aw; aw.x = vf[i][s2][0][0].x; aw.y = vf[i][s2][0][0].y; aw.z = vf[i][s2][0][1].x; aw.w = vf[i][s2][0][1].y; o0 = mfma32(__builtin_bit_cast(bf16x8, aw), pb, o0); }
                { v4u aw; aw.x = vf[i][s2][1][0].x; aw.y = vf[i][s2][1][0].y; aw.z = vf[i][s2][1][1].x; aw.w = vf[i][s2][1][1].y; o1 = mfma32(__builtin_bit_cast(bf16x8, aw), pb, o1); } }
        }
    }
    lsum = add_x32(l);
}
__device__ __forceinline__ void flash_store(bf16* dst  , int rstride, const f32x16& o0, const f32x16& o1, float lsum, int lane) {
    const int r32 = lane & 31, hh = lane >> 5; const float inv = 1.0f / lsum; bf16* p = dst + (size_t)r32 * rstride + 4 * hh;
#pragma unroll
    for (int k = 0; k < 4; ++k) { *(GAS v2u*)(p + 8 * k) = pack4((f32x4){o0[4 * k] * inv, o0[4 * k + 1] * inv, o0[4 * k + 2] * inv, o0[4 * k + 3] * inv});
        *(GAS v2u*)(p + 32 + 8 * k) = pack4((f32x4){o1[4 * k] * inv, o1[4 * k + 1] * inv, o1[4 * k + 2] * inv, o1[4 * k + 3] * inv}); }
}
__device__ __forceinline__ void memattn_prompt_task(Frame& F, int layer, int task) {
    int lane_ = F.lane; asm volatile("" : "+v"(lane_)); const int lane = lane_, r32 = lane & 31, hh = lane >> 5; const int hm = task & 3, qt = task >> 2;
    const int row = qt * 32 + r32, b = (qt * 32) >> 13;
    bf16x8 qf[4];
    if (layer == 0) { const bf16* qp = (const bf16*)(F.ws + WS_PROJ) + (size_t)row * NCOLA + RWKV_COLS + hm * 64; const float* gn = F.in[I_MQN];
        float x[4][8]; float ss = 0.f;
#pragma unroll
        for (int ks = 0; ks < 4; ++ks) { const v4u w = *(const GAS v4u*)(qp + 16 * ks + 8 * hh); const unsigned ww[4] = {w.x, w.y, w.z, w.w};
#pragma unroll
            for (int i = 0; i < 4; ++i) { x[ks][2 * i] = bflo(ww[i]); x[ks][2 * i + 1] = bfhi(ww[i]); ss += x[ks][2 * i] * x[ks][2 * i] + x[ks][2 * i + 1] * x[ks][2 * i + 1]; } }
        ss = add_x32(ss); const float rs = rsqrtf(ss * (1.0f / 64.0f) + 1e-6f) * C2Q;
#pragma unroll
        for (int ks = 0; ks < 4; ++ks) {
#pragma unroll
            for (int i = 0; i < 8; ++i) x[ks][i] *= rs * gn[16 * ks + 8 * hh + i];
            qf[ks] = pack_frag(x[ks]); }
    } else { const bf16* qp = (const bf16*)(F.ws + WS_Q1) + (size_t)row * DM + 768 + hm * 64;
#pragma unroll
        for (int ks = 0; ks < 4; ++ks) qf[ks] = *(const GAS bf16x8*)(qp + 16 * ks + 8 * hh); }
    const bf16* Kp = (const bf16*)(F.ws + WS_MK) + (size_t)((layer * 2 + b) * 4 + hm) * 256 * 64;
    const bf16* VTp = (const bf16*)(F.ws + WS_MVT) + (size_t)((layer * 2 + b) * 4 + hm) * 64 * 256;
    f32x16 o0, o1; float ls;
    flash32<false, 4>(qf, Kp, 64, VTp, 256, 0, 8, 0, -1e30f, 0.f, o0, o1, ls, lane);
    flash_store((bf16*)(F.ws + WS_MIX) + (size_t)(qt * 32) * DM + 768 + hm * 64, DM, o0, o1, ls, lane);
}
__device__ __forceinline__ void swa_prompt_task(Frame& F, int task) {
    int lane_ = F.lane; asm volatile("" : "+v"(lane_)); const int lane = lane_, r32 = lane & 31, hh = lane >> 5; const int hq = task % NH, qt = task / NH;
    const int b = qt >> 8, tq = (qt & 255) * 32, row = qt * 32 + r32, kvh = hq / 3;
    const bf16* qp = (const bf16*)(F.ws + WS_Q1) + (size_t)row * DM + hq * 64;
    bf16x8 qf[4];
#pragma unroll
    for (int ks = 0; ks < 4; ++ks) qf[ks] = *(const GAS bf16x8*)(qp + 16 * ks + 8 * hh);
    const bf16* Kp = (const bf16*)(F.ws + WS_K1) + (size_t)(b * T) * 256 + kvh * 64;
    const bf16* VTp = (const bf16*)(F.ws + WS_VT1) + (size_t)(b * 4 + kvh) * 64 * T;
    const int kb_lo = tq >= 128 ? tq - 128 : 0, nblk = (tq - kb_lo) / 32 + 1;
    const float sink = F.in[I_SINKS][hq] * LOG2E;
    f32x16 o0, o1; float ls;
    flash32<true, 3>(qf, Kp, 256, VTp, T, kb_lo, nblk, tq + r32, sink, 1.0f, o0, o1, ls, lane);
    flash_store((bf16*)(F.ws + WS_MIX) + (size_t)(qt * 32) * DM + hq * 64, DM, o0, o1, ls, lane);
}
template <int NQ, bool WINDOW>
__device__ __forceinline__ void small_attn(const LAS float* ql, LAS float* sc, int NKP, const float* k1, const float* v1, int kst1, int nk1, const bf16* k2, const bf16* v2, int kst2, int nk2,
                                           const float* sinkg  , bf16* out0, int ostride_q, int lane) {
    const int sub = lane >> 4, dq = lane & 15, nk = nk1 + nk2;
    f32x4 qv[NQ];
#pragma unroll
    for (int qi = 0; qi < NQ; ++qi) qv[qi] = *(const LAS f32x4*)(ql + qi * 64 + 4 * dq);
    constexpr int KBAT = NQ > 4 ? 4 : 8;
    for (int kg0 = 0; kg0 < nk1; kg0 += 4 * KBAT) { f32x4 kv[KBAT];
#pragma unroll
        for (int u = 0; u < KBAT; ++u) kv[u] = *(const GAS f32x4*)(k1 + (size_t)(kg0 + 4 * u + sub) * kst1 + 4 * dq);
#pragma unroll
        for (int u = 0; u < KBAT; ++u) { const int key = kg0 + 4 * u + sub;
#pragma unroll
            for (int qi = 0; qi < NQ; ++qi) { const f32x4 p = qv[qi] * kv[u]; const float s = sum16((p[0] + p[1]) + (p[2] + p[3])); if (dq == 0) sc[qi * NKP + key] = s; } } }
    for (int kg = nk1; kg < nk; kg += 4) { const int key = kg + sub; const f32x4 kv = unpack4(*(const GAS v2u*)(k2 + (size_t)(key - nk1) * kst2 + 4 * dq));
#pragma unroll
        for (int qi = 0; qi < NQ; ++qi) { const f32x4 p = qv[qi] * kv; const float s = sum16((p[0] + p[1]) + (p[2] + p[3])); if (dq == 0) sc[qi * NKP + key] = s; } }
    LDS_WAIT(); asm volatile("" ::: "memory");
#pragma unroll
    for (int qi = 0; qi < NQ; ++qi) { float sv[5]; const float sk_ = sinkg ? sinkg[qi >> 2] * LOG2E : -1e30f; float mx = sk_;
#pragma unroll
        for (int t = 0; t < 5; ++t) { const int key = lane + 64 * t; float s = -1e30f; if (key < nk) { s = sc[qi * NKP + key]; if (WINDOW) { const int i = qi & 3; if (key < i + 1 || key > 128 + i) s = -1e30f; } } sv[t] = s; mx = fmaxf(mx, s); }
        mx = wave_max(mx); float sum = 0.f;
#pragma unroll
        for (int t = 0; t < 5; ++t) { sv[t] = __builtin_amdgcn_exp2f(sv[t] - mx); sum += sv[t]; }
        sum = wave_sum(sum) + (sinkg ? __builtin_amdgcn_exp2f(sk_ - mx) : 0.f); const float inv = 1.0f / sum;
#pragma unroll
        for (int t = 0; t < 5; ++t) { const int key = lane + 64 * t; if (key < nk) sc[qi * NKP + key] = sv[t] * inv; } }
    LDS_WAIT(); asm volatile("" ::: "memory");
    f32x4 acc[NQ];
#pragma unroll
    for (int qi = 0; qi < NQ; ++qi) acc[qi] = (f32x4){0.f, 0.f, 0.f, 0.f};
    for (int kg0 = 0; kg0 < nk1; kg0 += 4 * KBAT) { f32x4 vv[KBAT];
#pragma unroll
        for (int u = 0; u < KBAT; ++u) vv[u] = *(const GAS f32x4*)(v1 + (size_t)(kg0 + 4 * u + sub) * kst1 + 4 * dq);
#pragma unroll
        for (int u = 0; u < KBAT; ++u) { const int key = kg0 + 4 * u + sub;
#pragma unroll
            for (int qi = 0; qi < NQ; ++qi) acc[qi] += vv[u] * sc[qi * NKP + key]; } }
    for (int kg = nk1; kg < nk; kg += 4) { const int key = kg + sub; const f32x4 vv = unpack4(*(const GAS v2u*)(v2 + (size_t)(key - nk1) * kst2 + 4 * dq));
#pragma unroll
        for (int qi = 0; qi < NQ; ++qi) acc[qi] += vv * sc[qi * NKP + key]; }
#pragma unroll
    for (int qi = 0; qi < NQ; ++qi) { f32x4 a = acc[qi];
#pragma unroll
        for (int e = 0; e < 4; ++e) { a[e] = add_x16(a[e]); a[e] = add_x32(a[e]); }
        if (sub == 0) *(GAS v2u*)(out0 + (size_t)(qi & 3) * ostride_q + (qi >> 2) * 64 + 4 * dq) = pack4(a); }
    LDS_WAIT(); asm volatile("" ::: "memory");
}
__device__ __forceinline__ void memattn_sample_task(Frame& F, int layer, int task, LAS float* wl  ) {
    int lane_ = F.lane; asm volatile("" : "+v"(lane_)); const int lane = lane_, b = task >> 2, hm = task & 3; LAS float* ql = wl; LAS float* sc = wl + 12 * 64;
#pragma unroll
    for (int i = 0; i < 4; ++i) { const int row = RP + b * ST + i; float x;
        if (layer == 0) { x = bf2f(((const bf16*)(F.ws + WS_PROJ))[(size_t)row * NCOLA + RWKV_COLS + hm * 64 + lane]); const float ss = wave_sum(x * x); x *= rsqrtf(ss * (1.0f / 64.0f) + 1e-6f) * C2Q * F.in[I_MQN][lane]; }
        else x = bf2f(((const bf16*)(F.ws + WS_Q1))[(size_t)row * DM + 768 + hm * 64 + lane]);
        ql[i * 64 + lane] = x; }
    LDS_WAIT(); asm volatile("" ::: "memory");
    const float* k1 = F.in[I_CMK] + (((size_t)layer * SB + b) * NMEM * 4 + hm) * 64; const float* v1 = F.in[I_CMV] + (((size_t)layer * SB + b) * NMEM * 4 + hm) * 64;
    small_attn<4, false>(ql, sc, 264, k1, v1, 256, 256, nullptr, nullptr, 0, 0, nullptr, (bf16*)(F.ws + WS_MIX) + (size_t)(RP + b * ST) * DM + 768 + hm * 64, DM, lane);
}
__device__ __forceinline__ void swa_sample_task(Frame& F, int task, LAS float* wl) {
    int lane_ = F.lane; asm volatile("" : "+v"(lane_)); const int lane = lane_, b = task >> 2, kvh = task & 3; LAS float* ql = wl; LAS float* sc = wl + 12 * 64;
#pragma unroll
    for (int qi = 0; qi < 12; ++qi) { const int i = qi & 3, gq = qi >> 2, hq = kvh * 3 + gq; const int row = RP + b * ST + i;
        ql[qi * 64 + lane] = bf2f(((const bf16*)(F.ws + WS_Q1))[(size_t)row * DM + hq * 64 + lane]); }
    LDS_WAIT(); asm volatile("" ::: "memory");
    const float* k1 = F.in[I_CSK] + ((size_t)b * 128 * 4 + kvh) * 64; const float* v1 = F.in[I_CSV] + ((size_t)b * 128 * 4 + kvh) * 64;
    const bf16* k2 = (const bf16*)(F.ws + WS_K1) + (size_t)(RP + b * ST) * 256 + kvh * 64; const bf16* v2 = (const bf16*)(F.ws + WS_V1) + (size_t)(RP + b * ST) * 256 + kvh * 64;
    small_attn<12, true>(ql, sc, 136, k1, v1, 256, 128, k2, v2, 256, 4, F.in[I_SINKS] + kvh * 3, (bf16*)(F.ws + WS_MIX) + (size_t)(RP + b * ST) * DM + kvh * 3 * 64, DM, lane);
}

constexpr int N_PHASES = 13;
template <int PM> __global__ void __launch_bounds__(NWAVES * 64, 2) yoco_fwd(Args args) {
    extern __shared__ __attribute__((aligned(16))) unsigned char lds[];
    Frame F;
    F.lds = (LAS unsigned char*)lds; F.lds_g = lds;
    F.wave = __builtin_amdgcn_readfirstlane((int)threadIdx.x >> 6); F.lane = mk_lane(); F.tid = F.wave * 64 + F.lane;
    F.G = gridDim.x; { const int bx = blockIdx.x; F.vcu = (F.G % 8 == 0) ? (bx % 8) * (F.G / 8) + bx / 8 : bx; }
    F.in = args.in; F.out = args.out; F.ws = args.ws; F.ctl = (gu32*)(args.ws + WS_CTL);
    for (int u = F.tid; u < (LDS_BYTES - LDSCTL_OFF) / 4; u += NWAVES * 64) ((LAS unsigned*)(F.lds + LDSCTL_OFF))[u] = 0u;
    __syncthreads();
    const int lo = args.ph_lo, hi = args.ph_hi;
    XcdBarrier bar; bar.wave0 = F.wave == 0; bar.bar = (unsigned*)(F.ctl + CW_BAR); bar.x = 0; bar.st = nullptr;
    bar = xcd_barrier_post((unsigned*)(F.ctl + CW_BAR), (volatile LAS unsigned*)(F.lds + MISC_OFF) + 8, F.wave == 0);
#define IN(k) (((PM >> (k)) & 1) && lo <= (k) && (k) < hi)
#ifndef MK_DUP
#define MK_DUP -1
#endif
#define PH_REP(k) ((MK_DUP == (k)) ? 2 : 1)
#define SEAM(k) do { if (IN(k) && IN((k) + 1)) xcd_barrier(bar); } while (0)
    const int gw = F.vcu * NWAVES + F.wave, NGW = F.G * NWAVES;
#define SSQ ((float*)(F.ws + WS_SSQ))
#define HB ((bf16*)(F.ws + WS_HB))
#define MIX ((bf16*)(F.ws + WS_MIX))
#define HH ((bf16*)(F.ws + WS_H))
#define PHASE_BEGIN() do { int z_ = 0; unsigned char* ws_ = args.ws; float* out_ = args.out; asm volatile("" : "+s"(z_), "+s"(ws_), "+s"(out_)); F.in = args.in + z_; F.ws = ws_; F.out = out_; \
                           F.lane = mk_lane(); F.tid = F.wave * 64 + F.lane; } while (0)

    if (IN(0)) for (int rep_ = 0; rep_ < PH_REP(0); ++rep_) { PHASE_BEGIN(); p0_prologue(F); } SEAM(0);

    if (IN(1)) for (int rep_ = 0; rep_ < PH_REP(1); ++rep_) { PHASE_BEGIN();
        { pg8::Gemm g{HB, (const bf16*)(F.ws + WS_WA), R, NCOLA, DM}; pg8::StaticOrder S; S.init(R, NCOLA, F.G, (int)blockIdx.x, DM);
          pg8::EpiScaleBf16<0> E{(bf16*)(F.ws + WS_PROJ), NCOLA, SSQ};
          pg8::gemm_phase<pg8::EpiScaleBf16<0>, pg8::StaticOrder, true, true>(F.lds + RING_OFF, g, S, E, F.wave, F.lane); }
#ifndef NO_MEMKV
        { pg8::Gemm g{(const bf16*)(F.ws + WS_MB), (const bf16*)(F.ws + WS_WM), 512, 1024, DM}; pg8::StaticOrder S; S.init(512, 1024, F.G, (int)blockIdx.x, DM);
          pg8::EpiMemKV E{F.ws, F.out, F.in[I_MKN]};
          pg8::gemm_phase<pg8::EpiMemKV, pg8::StaticOrder, true, true>(F.lds + RING_OFF, g, S, E, F.wave, F.lane); }
#endif
    } SEAM(1);

    if (IN(2)) for (int rep_ = 0; rep_ < ((MK_DUP == 2 || (MK_DUP >= 20 && MK_DUP < 30)) ? 2 : 1); ++rep_) { PHASE_BEGIN();
        const int half = F.wave >> 2; const int gw = F.vcu * NWAVES + F.wave, NGW = F.G * NWAVES;
        LAS unsigned char* hb = F.lds + half * PREP_HALF; LAS float* wtot = (LAS float*)(F.lds + WTOT_OFF + half * 1024);
        const int slim = (rep_ == 1 && MK_DUP == 21) ? 3 : (rep_ == 1 && MK_DUP == 22) ? 5 : 99;
        if (!(rep_ == 1 && MK_DUP == 20)) for (int pi = F.vcu; pi < NUNIT / 2; pi += F.G) rwkv_prep_unit(F, 2 * pi + half, hb, wtot, slim);
        if (!(rep_ == 1 && (MK_DUP == 21 || MK_DUP == 22))) for (int t = gw; t < SB * NH + 2; t += NGW) {
            if (t < SB * NH) rwkv_sample_task(F, t);
            else { const int b = t - SB * NH; const bf16* lr = (const bf16*)(F.ws + WS_PROJ) + (size_t)(b * T + T - 1) * NCOLA; float* o = F.out + O_PSHIFT + (size_t)b * RWKV_COLS;
                for (int q = F.lane; q < RWKV_COLS; q += 64) o[q] = bf2f(lr[q]); } }
    } SEAM(2);

    if (IN(3)) for (int rep_ = 0; rep_ < ((MK_DUP == 30 || MK_DUP == 31) ? 2 : 1); ++rep_) { PHASE_BEGIN();
        const int nscan = NB * NH * 4;
        if (F.vcu < nscan) { if (F.wave == 0 && (rep_ == 0 || MK_DUP == 31)) rwkv_scan_chain(F, F.vcu >> 2, F.vcu & 3); }
        else if (rep_ == 0 || MK_DUP == 30) { const int ow = (F.vcu - nscan) * NWAVES + F.wave, NOW = (F.G - nscan) * NWAVES; LAS float* wl = (LAS float*)(F.lds + F.wave * 12288);
            for (int t = ow; t < 2048 + 512; t += NOW) { if (t < 2048) memattn_prompt_task(F, 0, t); else memattn_sample_task(F, 0, t - 2048, wl); } }
    } SEAM(3);

    if (IN(4)) for (int rep_ = 0; rep_ < PH_REP(4); ++rep_) { PHASE_BEGIN(); for (int it = gw; it < NUNIT * 4; it += NGW) rwkv_yout_item(F, it); } SEAM(4);

    if (IN(5)) for (int rep_ = 0; rep_ < PH_REP(5); ++rep_) { PHASE_BEGIN(); pg8::Gemm g{MIX, (const bf16*)(F.ws + WS_WOUT), R, DM, DM}; pg8::TailOrder S; S.init(F.G, (int)blockIdx.x, DM, S_K1);
        pg8::EpiResid E{F.in[I_XP], F.in[I_XS], RP, F.out + O_Y, HB, SSQ, (float*)(F.ws + WS_SLAB), S_K1};
        pg8::gemm_phase<pg8::EpiResid, pg8::TailOrder, true, true>(F.lds + RING_OFF, g, S, E, F.wave, F.lane); } SEAM(5);
    if (IN(6)) for (int rep_ = 0; rep_ < PH_REP(6); ++rep_) { PHASE_BEGIN(); finalize_sample(F, F.in[I_XS], S_K1, true); xcd_barrier(bar);
        pg8::Gemm g{HB, (const bf16*)(F.ws + WS_WUP), R, FF, DM}; pg8::StaticOrder S; S.init(R, FF, F.G, (int)blockIdx.x, DM);
        pg8::EpiScaleBf16<1> E{HH, FF, SSQ};
        pg8::gemm_phase<pg8::EpiScaleBf16<1>, pg8::StaticOrder, true, true>(F.lds + RING_OFF, g, S, E, F.wave, F.lane); } SEAM(6);
    if (IN(7)) for (int rep_ = 0; rep_ < PH_REP(7); ++rep_) { PHASE_BEGIN(); pg8::Gemm g{HH, (const bf16*)(F.ws + WS_WDN), R, DM, FF}; pg8::TailOrder S; S.init(F.G, (int)blockIdx.x, FF, S_K4);
        pg8::EpiResid E{F.out + O_Y, F.out + O_Y + (size_t)RP * DM, RP, F.out + O_Y, HB, SSQ, (float*)(F.ws + WS_SLAB), S_K4};
        pg8::gemm_phase<pg8::EpiResid, pg8::TailOrder, true, true>(F.lds + RING_OFF, g, S, E, F.wave, F.lane); } SEAM(7);

    if (IN(8)) for (int rep_ = 0; rep_ < PH_REP(8); ++rep_) { PHASE_BEGIN(); finalize_sample(F, F.out + O_Y + (size_t)RP * DM, S_K4, true); xcd_barrier(bar);
        pg8::Gemm g{HB, (const bf16*)(F.ws + WS_WB), R, NCOLB, DM}; pg8::StaticOrder S; S.init(R, NCOLB, F.G, (int)blockIdx.x, DM);
        pg8::EpiL1 E{F.ws, F.out, F.in[I_QN], F.in[I_MQN] + 64, F.in[I_KN]};
        pg8::gemm_phase<pg8::EpiL1, pg8::StaticOrder, true, true>(F.lds + RING_OFF, g, S, E, F.wave, F.lane); } SEAM(8);

    if (IN(9)) for (int rep_ = 0; rep_ < PH_REP(9); ++rep_) { PHASE_BEGIN(); LAS float* wl = (LAS float*)(F.lds + F.wave * 12288);
        for (int t = gw; t < 6144 + 2048 + 512 + 512; t += NGW) {
            if (t < 6144) swa_prompt_task(F, t); else if (t < 8192) memattn_prompt_task(F, 1, t - 6144);
            else if (t < 8704) swa_sample_task(F, t - 8192, wl); else memattn_sample_task(F, 1, t - 8704, wl); }
    } SEAM(9);

    if (IN(10)) for (int rep_ = 0; rep_ < PH_REP(10); ++rep_) { PHASE_BEGIN(); pg8::Gemm g{MIX, (const bf16*)(F.ws + WS_WOUT) + (size_t)DM * DM, R, DM, DM}; pg8::TailOrder S; S.init(F.G, (int)blockIdx.x, DM, S_K1);
        pg8::EpiResid E{F.out + O_Y, F.out + O_Y + (size_t)RP * DM, RP, F.out + O_Y, HB, SSQ, (float*)(F.ws + WS_SLAB), S_K1};
        pg8::gemm_phase<pg8::EpiResid, pg8::TailOrder, true, true>(F.lds + RING_OFF, g, S, E, F.wave, F.lane); } SEAM(10);
    if (IN(11)) for (int rep_ = 0; rep_ < PH_REP(11); ++rep_) { PHASE_BEGIN(); finalize_sample(F, F.out + O_Y + (size_t)RP * DM, S_K1, true); xcd_barrier(bar);
        pg8::Gemm g{HB, (const bf16*)(F.ws + WS_WUP) + (size_t)DM * FF, R, FF, DM}; pg8::StaticOrder S; S.init(R, FF, F.G, (int)blockIdx.x, DM);
        pg8::EpiScaleBf16<1> E{HH, FF, SSQ};
        pg8::gemm_phase<pg8::EpiScaleBf16<1>, pg8::StaticOrder, true, true>(F.lds + RING_OFF, g, S, E, F.wave, F.lane); } SEAM(11);
    if (IN(12)) for (int rep_ = 0; rep_ < PH_REP(12); ++rep_) { PHASE_BEGIN(); pg8::Gemm g{HH, (const bf16*)(F.ws + WS_WDN) + (size_t)DM * FF, R, DM, FF}; pg8::TailOrder S; S.init(F.G, (int)blockIdx.x, FF, S_K4);
        pg8::EpiResid E{F.out + O_Y, F.out + O_Y + (size_t)RP * DM, RP, F.out + O_Y, nullptr, nullptr, (float*)(F.ws + WS_SLAB), S_K4};
        pg8::gemm_phase<pg8::EpiResid, pg8::TailOrder, true, true>(F.lds + RING_OFF, g, S, E, F.wave, F.lane);
        xcd_barrier(bar); finalize_sample(F, F.out + O_Y + (size_t)RP * DM, S_K4, false); }
#undef IN
#undef SEAM
#undef SSQ
#undef HB
#undef MIX
#undef HH
#undef PHASE_BEGIN
}

template <int PM> static void launch_pm(int grid, hipStream_t stream, const Args& a) { hipLaunchKernelGGL(yoco_fwd<PM>, dim3(grid), dim3(NWAVES * 64), LDS_BYTES, stream, a); }
template <int PM> static bool set_lds() { return hipFuncSetAttribute((const void*)yoco_fwd<PM>, hipFuncAttributeMaxDynamicSharedMemorySize, LDS_BYTES) == hipSuccess; }
extern "C" void kernel_launch(void* const* d_in, const int* in_sizes, int n_in, void* d_out, int out_size, void* d_ws, size_t ws_size, hipStream_t stream) {
    static int grid = 0;
    if (grid == 0) {
        if (n_in != N_IN || (size_t)out_size != O_END || ws_size < WS_END) { fprintf(stderr, "kernel_launch: unexpected shapes (n_in %d, out %d, ws %zu < %zu)\n", n_in, out_size, ws_size, (size_t)WS_END); grid = -1; return; }
        int dev = 0, cus = 0;
        if (hipGetDevice(&dev) != hipSuccess || hipDeviceGetAttribute(&cus, hipDeviceAttributeMultiprocessorCount, dev) != hipSuccess) { grid = -1; return; }
        bool ok = true;
#if MK_ONE_LAUNCH
        ok = set_lds<0x1fff>();
#else
        ok = set_lds<1>() && set_lds<2>() && set_lds<4>() && set_lds<8>() && set_lds<16>() && set_lds<32>() && set_lds<64>() && set_lds<128>() && set_lds<256>() && set_lds<512>() && set_lds<1024>() && set_lds<2048>() && set_lds<4096>();
#endif
        if (!ok) { grid = -1; return; }
        (void)hipGetLastError();
        grid = cus;
    }
    if (grid < 0) return;
    (void)hipMemsetAsync((char*)d_ws + WS_CTL, 0, CTL_ZERO_BYTES, stream);
    Args a{};
    for (int i = 0; i < N_IN; ++i) a.in[i] = (const float*)d_in[i];
    a.out = (float*)d_out; a.ws = (unsigned char*)d_ws;
#if MK_ONE_LAUNCH
    a.ph_lo = 0; a.ph_hi = N_PHASES; launch_pm<0x1fff>(grid, stream, a);
#else
#define LP(p) a.ph_lo = (p); a.ph_hi = (p) + 1; launch_pm<(1 << (p))>(grid, stream, a);
    LP(0) LP(1) LP(2) LP(3) LP(4) LP(5) LP(6) LP(7) LP(8) LP(9) LP(10) LP(11) LP(12)
#undef LP
#endif
}
```

```cpp
#include <hip/hip_runtime.h>
#include <cstdio>
#include <cstdint>
namespace pg8 {
#define PG8_LAS __attribute__((address_space(3)))
typedef unsigned short bf16_t;
typedef short bf16x8 __attribute__((ext_vector_type(8)));
typedef float f32x4 __attribute__((ext_vector_type(4)));
typedef unsigned u32x4 __attribute__((ext_vector_type(4)));
constexpr int BM = 256, BK = 64, HALF = 128, HTB = HALF * BK * 2  , STAGE_BYTES = 8 * HTB, NXCD = 8, WGM = 8;

__host__ __device__ __forceinline__ int lds_byte(int r, int c) { const int st = (r >> 4) * 2 + (c >> 5), rr = r & 15, cc = c & 31, ob = rr * 64 + cc * 2; return st * 1024 + (ob ^ (((ob >> 9) & 1) << 5)); }
__host__ __device__ __forceinline__ void stage_rc(int b, int& R, int& C) { const int st = b / 1024, sb = b % 1024, swz = sb ^ (((sb >> 9) & 1) << 5); R = (st >> 1) * 16 + swz / 64; C = (st & 1) * 32 + (swz % 64) / 2; }
__host__ __device__ __forceinline__ int perm32(int rho) { const int n = rho >> 4, i = rho & 15; return 8 * (i >> 2) + 4 * n + (i & 3); }

struct Unit { int pm, pn, kt0, nt; };
struct Gemm { const bf16_t* A; const bf16_t* Bt; int M, N, K; };

struct StaticOrder {
    int nM, nN, nwg, G, c, ntf;
    __host__ __device__ void init(int M, int N, int G_, int c_, int K_) { nM = M / BM; nN = N / BM; nwg = nM * nN; G = G_; c = c_; ntf = K_ / BK; }
    __host__ __device__ bool next(int i, Unit& u) const {
        const long L = (long)i * G + c; if (L >= nwg) return false;
        int wgid = (int)L; { const int q = nwg / NXCD, r = nwg % NXCD, xcd = wgid % NXCD, off = wgid / NXCD; wgid = (xcd < r ? xcd * (q + 1) : r * (q + 1) + (xcd - r) * q) + off; }
        const int nig = WGM * nN, gid = wgid / nig, fm = gid * WGM, gsz = (nM - fm) < WGM ? (nM - fm) : WGM;
        u.pm = fm + ((wgid % nig) % gsz); u.pn = (wgid % nig) / gsz; u.kt0 = 0; u.nt = ntf; return true;
    }
    __device__ __forceinline__ void a_ready(const Unit&) const {}
    __device__ __forceinline__ void done(const Unit&) const {}
};
struct TailOrder {
    StaticOrder P; int S, ntf;
    __host__ __device__ void init(int G_, int c_, int K_, int S_) { P.init(64 * BM, 4 * BM, G_, c_, K_); S = S_; ntf = K_ / BK; }
    __host__ __device__ bool next(int i, Unit& u) const {
        const long L = (long)i * P.G + P.c; if (L >= 256 + 8 * S) return false;
        const int Li = (int)L; const bool prm = Li < 256;
        const int w0 = prm ? Li : 0, wg = (w0 % NXCD) * (256 / NXCD) + w0 / NXCD, nig = WGM * 4, gid = wg / nig, fm = gid * WGM;
        const int pmP = fm + ((wg % nig) % WGM), pnP = (wg % nig) / WGM;
        const int Ls = prm ? 0 : Li - 256, tile = Ls / S, sl = Ls % S, nts = ntf / S;
        u.pm = prm ? pmP : 64 + (tile >> 2); u.pn = prm ? pnP : (tile & 3); u.nt = prm ? ntf : nts; u.kt0 = prm ? 0 : sl * nts; return true;
    }
    __device__ __forceinline__ void a_ready(const Unit&) const {}
    __device__ __forceinline__ void done(const Unit&) const {}
};


typedef float f32x2_t __attribute__((ext_vector_type(2))); typedef __bf16 bf16x2_t __attribute__((ext_vector_type(2)));
__device__ __forceinline__ unsigned cvt_pk_bf16(float lo, float hi) { f32x2_t v = {lo, hi}; bf16x2_t b = __builtin_convertvector(v, bf16x2_t); return __builtin_bit_cast(unsigned, b); }
__device__ __forceinline__ u32x4 pack8(f32x4 v0, f32x4 v1) { u32x4 w; w.x = cvt_pk_bf16(v0[0], v0[1]); w.y = cvt_pk_bf16(v0[2], v0[3]); w.z = cvt_pk_bf16(v1[0], v1[1]); w.w = cvt_pk_bf16(v1[2], v1[3]); return w; }

template <int M> __device__ __forceinline__ float swz_xor(float v) { return __int_as_float(__builtin_amdgcn_ds_swizzle(__float_as_int(v), (M << 10) | 0x1f)); }
__device__ __forceinline__ float add_x32(float v) { auto r = __builtin_amdgcn_permlane32_swap(__float_as_uint(v), __float_as_uint(v), false, false); return __uint_as_float(r[0]) + __uint_as_float(r[1]); }
__device__ __forceinline__ float max_x32(float v) { auto r = __builtin_amdgcn_permlane32_swap(__float_as_uint(v), __float_as_uint(v), false, false); return fmaxf(__uint_as_float(r[0]), __uint_as_float(r[1])); }
__device__ __forceinline__ float add_x16(float v) { return v + swz_xor<16>(v); }
template <int CTRL> __device__ __forceinline__ float dpp_mov(float v) { return __int_as_float(__builtin_amdgcn_update_dpp(0, __float_as_int(v), CTRL, 0xf, 0xf, false)); }
__device__ __forceinline__ float sum16_dpp(float v) { v += dpp_mov<0xB1>(v); v += dpp_mov<0x4E>(v); v += dpp_mov<0x141>(v); v += dpp_mov<0x140>(v); return v; }
__device__ __forceinline__ float max16_dpp(float v) { v = fmaxf(v, dpp_mov<0xB1>(v)); v = fmaxf(v, dpp_mov<0x4E>(v)); v = fmaxf(v, dpp_mov<0x141>(v)); v = fmaxf(v, dpp_mov<0x140>(v)); return v; }
__device__ __forceinline__ float sum4_dpp(float v) { v += dpp_mov<0xB1>(v); v += dpp_mov<0x4E>(v); return v; }
__device__ __forceinline__ float hsum4(f32x4 a) { return (a[0] + a[1]) + (a[2] + a[3]); }
__device__ __forceinline__ float row_rstd(const float* ssq, int row) {
    const f32x4* p = (const f32x4*)(ssq + (size_t)row * 16);
    const f32x4 a = p[0], b = p[1], c = p[2], d = p[3];
    const float s = (hsum4(a) + hsum4(b)) + (hsum4(c) + hsum4(d));
    return rsqrtf(s * (1.0f / 1024.0f) + 1e-6f);
}
template <int ACT> struct EpiScaleBf16 {
    static constexpr bool PERM = true, AFTER_DRAIN = false;
    bf16_t* O; int ldc; const float* ssq;
    __device__ __forceinline__ void operator()(const f32x4 (&acc)[2][2][4][2], const Unit& u, int wr, int wc, int fr_, int fq_) const {
        int fr = fr_, fq = fq_; asm volatile("" : "+v"(fr), "+v"(fq));
        const int row0 = u.pm * BM + wr * 64 + fr, col0 = u.pn * BM + wc * 32 + 8 * fq;
#pragma unroll
        for (int ai = 0; ai < 2; ++ai)
#pragma unroll
            for (int m = 0; m < 4; ++m) { const int row = row0 + ai * HALF + m * 16; const float rs = row_rstd(ssq, row); bf16_t* rowp = O + (size_t)row * ldc + col0;
#pragma unroll
                for (int bj = 0; bj < 2; ++bj) { f32x4 v0 = acc[ai][bj][m][0] * rs, v1 = acc[ai][bj][m][1] * rs;
                    if (ACT == 1) {
#pragma unroll
                        for (int e = 0; e < 4; ++e) { const float a = fmaxf(v0[e], 0.f), b = fmaxf(v1[e], 0.f); v0[e] = a * a; v1[e] = b * b; } }
                    *(u32x4*)(rowp + bj * HALF) = pack8(v0, v1); } }
    }
};
struct EpiResid {
    static constexpr bool PERM = true, AFTER_DRAIN = false;
    const float* base; const float* base2; int split; float* out; bf16_t* hb; float* ssq_out; float* slab; int S; int omask = -1;
    __device__ __forceinline__ void operator()(const f32x4 (&acc)[2][2][4][2], const Unit& u, int wr, int wc, int fr_, int fq_) const {
        int fr = fr_, fq = fq_; asm volatile("" : "+v"(fr), "+v"(fq));
        if (slab && u.pm >= 64) {
            float* sp = slab + ((size_t)((((u.pm - 64) << 2) + u.pn) * S + u.kt0 / u.nt) << 16) + (size_t)(wr * 64 + fr) * 256 + wc * 32 + 8 * fq;
#pragma unroll
            for (int ai = 0; ai < 2; ++ai)
#pragma unroll
                for (int m = 0; m < 4; ++m)
#pragma unroll
                    for (int bj = 0; bj < 2; ++bj) { float* p = sp + (size_t)(ai * HALF + m * 16) * 256 + bj * HALF; *(f32x4*)p = acc[ai][bj][m][0]; *(f32x4*)(p + 4) = acc[ai][bj][m][1]; }
            return;
        }
        const int row0 = u.pm * BM + wr * 64 + fr, col0 = u.pn * BM + wc * 32 + 8 * fq;
#pragma unroll
        for (int ai = 0; ai < 2; ++ai)
#pragma unroll
            for (int m = 0; m < 4; ++m) { const int row = row0 + ai * HALF + m * 16;
                const float* bp = (row < split ? base + (size_t)row * 1024 : base2 + (size_t)(row - split) * 1024) + col0;
                float* op = out + (size_t)(row & omask) * 1024 + col0; float ss = 0.f;
#pragma unroll
                for (int bj = 0; bj < 2; ++bj) { const f32x4 b0 = *(const f32x4*)(bp + bj * HALF), b1 = *(const f32x4*)(bp + bj * HALF + 4);
                    const f32x4 h0 = b0 + acc[ai][bj][m][0], h1 = b1 + acc[ai][bj][m][1];
                    *(f32x4*)(op + bj * HALF) = h0; *(f32x4*)(op + bj * HALF + 4) = h1;
                    if (hb) *(u32x4*)(hb + (size_t)row * 1024 + col0 + bj * HALF) = pack8(h0, h1);
                    ss += hsum4(h0 * h0) + hsum4(h1 * h1); }
                if (ssq_out) { ss = add_x16(ss); ss = add_x32(ss); if (fq == 0) ssq_out[(size_t)row * 16 + u.pn * 4 + wc] = ss; }
                if (m & 1) asm volatile("" ::: "memory"); }
    }
};
template <class Epi, class Sched, bool ALIGN_EPI = false, bool SP2 = false>
__device__ __forceinline__ void gemm_phase(PG8_LAS unsigned char* lds, const Gemm g, const Sched& S, const Epi& E, int wid_in, int lane_in) {
    const int wid = wid_in, lane = lane_in, tid = wid * 64 + lane, wr = wid >> 2, wc = wid & 3, fr = lane & 15, fq = lane >> 4;
    const int K = g.K;
    unsigned voffA[2], voffB[2];
#pragma unroll
    for (int i = 0; i < 2; ++i) { int R, C; stage_rc(tid * 16 + i * 8192, R, C); const int Rb = Epi::PERM ? ((R & ~31) + perm32(R & 31)) : R;
        voffA[i] = (unsigned)(R * K + C) * 2u; voffB[i] = (unsigned)(Rb * K + C) * 2u; }
    const size_t kstep = (size_t)(BK * 2);
    const size_t hstep = (size_t)HALF * K * 2;
    const size_t tstep = 2 * hstep;
    const unsigned ldsw = (unsigned)wid * 1024u;
    const int aoff = lds_byte(wr * 64 + fr, fq * 8), boff = lds_byte(wc * 32 + fr, fq * 8);
#define PG8_SA(b, h) (((b) * 2 + (h)) * HTB)
#define PG8_SB(b, h) ((4 + (b) * 2 + (h)) * HTB)
#define PG8_STAGE(bufoff, gbase, voff) do { _Pragma("unroll") for (int _i = 0; _i < 2; ++_i) \
        __builtin_amdgcn_global_load_lds((const unsigned*)((const char*)(gbase) + (voff)[_i]), (PG8_LAS unsigned*)(lds + (bufoff) + ldsw + _i * 8192), 16, 0, 0); } while (0)
#define PG8_LDA(dst, b, h) do { _Pragma("unroll") for (int m = 0; m < 4; ++m) _Pragma("unroll") for (int k = 0; k < 2; ++k) dst[m][k] = *(const PG8_LAS bf16x8*)(lds + PG8_SA(b, h) + aoff + m * 2048 + k * 1024); } while (0)
#define PG8_LDB(dst, b, h) do { _Pragma("unroll") for (int n = 0; n < 2; ++n) _Pragma("unroll") for (int k = 0; k < 2; ++k) dst[n][k] = *(const PG8_LAS bf16x8*)(lds + PG8_SB(b, h) + boff + n * 2048 + k * 1024); } while (0)
#define PG8_MMA(ai, bj, At, Bt) do { __builtin_amdgcn_s_setprio(1); _Pragma("unroll") for (int m = 0; m < 4; ++m) _Pragma("unroll") for (int n = 0; n < 2; ++n) _Pragma("unroll") for (int k = 0; k < 2; ++k) \
        acc[ai][bj][m][n] = __builtin_amdgcn_mfma_f32_16x16x32_bf16(Bt[n][k], At[m][k], acc[ai][bj][m][n], 0, 0, 0); __builtin_amdgcn_s_setprio(0); } while (0)
#define PG8_WAIT_V(n) asm volatile("s_waitcnt vmcnt(" #n ")" ::: "memory")
#define PG8_WAIT_L(n) asm volatile("s_waitcnt lgkmcnt(" #n ")" ::: "memory")
#define PG8_BAR __builtin_amdgcn_s_barrier()
#define PG8_SCHED __builtin_amdgcn_sched_barrier(0)
    Unit cur, nxt; int ui = 0;
    if (!S.next(0, cur)) return;
    f32x4 acc[2][2][4][2];
#pragma unroll
    for (int a = 0; a < 2; ++a)
#pragma unroll
        for (int b = 0; b < 2; ++b)
#pragma unroll
            for (int m = 0; m < 4; ++m)
#pragma unroll
                for (int n = 0; n < 2; ++n) acc[a][b][m][n] = (f32x4){0.f, 0.f, 0.f, 0.f};
    bf16x8 At[4][2], B0[2][2], B1[2][2];
    const char* cA = (const char*)g.A + (size_t)cur.pm * tstep + (size_t)cur.kt0 * kstep; const char* cB = (const char*)g.Bt + (size_t)cur.pn * tstep + (size_t)cur.kt0 * kstep;
    S.a_ready(cur);
    if constexpr (SP2) {
        PG8_STAGE(PG8_SB(0, 0), cB, voffB); PG8_STAGE(PG8_SB(0, 1), cB + hstep, voffB); PG8_STAGE(PG8_SA(0, 0), cA, voffA); PG8_STAGE(PG8_SA(0, 1), cA + hstep, voffA);
        if (wr == 1) PG8_BAR;
        PG8_WAIT_V(2); PG8_BAR;
        PG8_STAGE(PG8_SB(1, 0), cB + kstep, voffB); PG8_STAGE(PG8_SA(1, 0), cA + kstep, voffA); PG8_STAGE(PG8_SB(1, 1), cB + hstep + kstep, voffB);
        PG8_WAIT_V(6); PG8_BAR;
    } else {
        PG8_STAGE(PG8_SB(0, 0), cB, voffB); PG8_STAGE(PG8_SA(0, 0), cA, voffA); PG8_STAGE(PG8_SB(0, 1), cB + hstep, voffB); PG8_STAGE(PG8_SA(0, 1), cA + hstep, voffA);
        if (wr == 1) PG8_BAR;
        PG8_WAIT_V(4); PG8_BAR;
        PG8_STAGE(PG8_SB(1, 0), cB + kstep, voffB); PG8_STAGE(PG8_SA(1, 0), cA + kstep, voffA); PG8_STAGE(PG8_SB(1, 1), cB + hstep + kstep, voffB);
        PG8_WAIT_V(6); PG8_BAR;
    }
    for (;;) {
        const bool has_next = S.next(ui + 1, nxt);
        const char* nA = has_next ? (const char*)g.A + (size_t)nxt.pm * tstep + (size_t)nxt.kt0 * kstep : cA; const char* nB = has_next ? (const char*)g.Bt + (size_t)nxt.pn * tstep + (size_t)nxt.kt0 * kstep : cB;
        const int nt = cur.nt;
        for (int t = 0; t < nt; t += 2) {
            const bool last = (t == nt - 2);
            const char* a1 = cA + (size_t)(t + 1) * kstep;
            const char* a2 = last ? nA : cA + (size_t)(t + 2) * kstep; const char* b2 = last ? nB : cB + (size_t)(t + 2) * kstep;
            const char* a3 = a2 + kstep; const char* b3 = b2 + kstep;
            if (last && has_next) S.a_ready(nxt);
            if constexpr (SP2) {
            PG8_LDB(B0, 0, 0); PG8_LDB(B1, 0, 1); PG8_SCHED; PG8_LDA(At, 0, 0); PG8_STAGE(PG8_SA(1, 1), a1 + hstep, voffA);
            PG8_WAIT_V(8); PG8_WAIT_L(0); PG8_BAR; PG8_MMA(0, 0, At, B0); PG8_MMA(0, 1, At, B1); PG8_BAR; PG8_SCHED;
            PG8_LDA(At, 0, 1); PG8_STAGE(PG8_SB(0, 0), b2, voffB); PG8_STAGE(PG8_SB(0, 1), b2 + hstep, voffB); PG8_STAGE(PG8_SA(0, 0), a2, voffA);
            PG8_WAIT_V(8); PG8_WAIT_L(0); PG8_BAR; PG8_MMA(1, 0, At, B0); PG8_MMA(1, 1, At, B1); PG8_BAR; PG8_SCHED;
            PG8_LDB(B0, 1, 0); PG8_LDB(B1, 1, 1); PG8_SCHED; PG8_LDA(At, 1, 0); PG8_STAGE(PG8_SA(0, 1), a2 + hstep, voffA);
            PG8_WAIT_V(8); PG8_WAIT_L(0); PG8_BAR; PG8_MMA(0, 0, At, B0); PG8_MMA(0, 1, At, B1); PG8_BAR; PG8_SCHED;
            PG8_LDA(At, 1, 1); PG8_STAGE(PG8_SB(1, 0), b3, voffB); PG8_STAGE(PG8_SB(1, 1), b3 + hstep, voffB); PG8_STAGE(PG8_SA(1, 0), a3, voffA);
            PG8_WAIT_V(8); PG8_WAIT_L(0); PG8_BAR; PG8_MMA(1, 0, At, B0); PG8_MMA(1, 1, At, B1); PG8_BAR; PG8_SCHED;
            } else {
            PG8_LDB(B0, 0, 0); PG8_SCHED; PG8_LDA(At, 0, 0); PG8_STAGE(PG8_SA(1, 1), a1 + hstep, voffA);
            PG8_WAIT_L(8); PG8_BAR; PG8_WAIT_L(0); PG8_MMA(0, 0, At, B0); PG8_BAR; PG8_SCHED;
            PG8_LDB(B1, 0, 1); PG8_STAGE(PG8_SB(0, 0), b2, voffB);
            PG8_BAR; PG8_WAIT_L(0); PG8_MMA(0, 1, At, B1); PG8_BAR;
            PG8_LDA(At, 0, 1); PG8_STAGE(PG8_SA(0, 0), a2, voffA);
            PG8_BAR; PG8_WAIT_L(0); PG8_MMA(1, 0, At, B0); PG8_BAR; PG8_SCHED;
            PG8_STAGE(PG8_SB(0, 1), b2 + hstep, voffB);
            PG8_WAIT_V(6); PG8_BAR; PG8_MMA(1, 1, At, B1); PG8_BAR;
            PG8_LDB(B0, 1, 0); PG8_SCHED; PG8_LDA(At, 1, 0); PG8_STAGE(PG8_SA(0, 1), a2 + hstep, voffA);
            PG8_WAIT_L(8); PG8_BAR; PG8_WAIT_L(0); PG8_MMA(0, 0, At, B0); PG8_BAR; PG8_SCHED;
            PG8_LDB(B1, 1, 1); PG8_STAGE(PG8_SB(1, 0), b3, voffB);
            PG8_BAR; PG8_WAIT_L(0); PG8_MMA(0, 1, At, B1); PG8_BAR;
            PG8_LDA(At, 1, 1); PG8_STAGE(PG8_SA(1, 0), a3, voffA);
            PG8_BAR; PG8_WAIT_L(0); PG8_MMA(1, 0, At, B0); PG8_BAR; PG8_SCHED;
            PG8_STAGE(PG8_SB(1, 1), b3 + hstep, voffB);
            PG8_WAIT_V(6); PG8_BAR; PG8_MMA(1, 1, At, B1); PG8_BAR;
            }
        }
        if constexpr (ALIGN_EPI) { if (wr == 0) PG8_BAR; }
        if constexpr (!Epi::AFTER_DRAIN) { E(acc, cur, wr, wc, fr, fq); S.done(cur); }
        if (!has_next) break;
#pragma unroll
        for (int a = 0; a < 2; ++a)
#pragma unroll
            for (int b = 0; b < 2; ++b)
#pragma unroll
                for (int m = 0; m < 4; ++m)
#pragma unroll
                    for (int n = 0; n < 2; ++n) acc[a][b][m][n] = (f32x4){0.f, 0.f, 0.f, 0.f};
        cur = nxt; cA = nA; cB = nB; ++ui;
        if constexpr (ALIGN_EPI) { if (wr == 1) PG8_BAR; }
    }
    PG8_WAIT_V(0);
    if constexpr (!ALIGN_EPI) { if (wr == 0) PG8_BAR; }
    PG8_BAR;
    if constexpr (Epi::AFTER_DRAIN) { E.fused(acc, cur, wr, wc, fr, fq, lds, wid, lane); S.done(cur); }
#undef PG8_SA
#undef PG8_SB
#undef PG8_STAGE
#undef PG8_LDA
#undef PG8_LDB
#undef PG8_MMA
#undef PG8_WAIT_V
#undef PG8_WAIT_L
#undef PG8_BAR
#undef PG8_SCHED
}
}

constexpr int NWAVES = 8;
#ifndef MK_ONE_LAUNCH
#define MK_ONE_LAUNCH 1
#endif
constexpr int DM = 1024, RP = 16384  , RS = 512  , R = RP + RS, T = 8192, NB = 2, SB = 128, ST = 4;
constexpr int NCOLA = 2816, RWKV_COLS = 2560, NH = 12, HD = 64, FF = 4096, NCOLB = 1536, NMEM = 256;
constexpr int NCHUNK = RP / 64  , NUNIT = NCHUNK * NH  ;
constexpr float C2Q = 0.125f * 1.4426950408889634f;
constexpr float LOG2E = 1.4426950408889634f;
enum { I_XP = 0, I_XS, I_SSHIFT, I_SWKV, I_CSK, I_CSV, I_CMK, I_CMV, I_MEMP, I_NMIX, I_NMLP, I_WOUT, I_WUP, I_WDN, I_MNORM, I_WMKV, I_MQN, I_MKN,
       I_WINA, I_MU, I_WW2, I_W0, I_WA2, I_A0, I_WG2, I_KK, I_KA, I_RK, I_LNW, I_LNB, I_WINB, I_QN, I_SINKS, I_KVN, I_WKV, I_KN, N_IN };
constexpr size_t O_Y = 0, O_PSHIFT = (size_t)R * DM, O_PWKV = O_PSHIFT + 2 * RWKV_COLS, O_PSK = O_PWKV + 2 * 12 * 4096, O_PSV = O_PSK + 2 * 128 * 256,
                 O_PMK = O_PSV + 2 * 128 * 256, O_PMV = O_PMK + 2 * 2 * 256 * 256, O_SSHIFT = O_PMV + 2 * 2 * 256 * 256, O_SWKV = O_SSHIFT + (size_t)SB * RWKV_COLS,
                 O_SSK = O_SWKV + (size_t)SB * 12 * 4096, O_SSV = O_SSK + (size_t)SB * 128 * 256, O_END = O_SSV + (size_t)SB * 128 * 256;
constexpr size_t al256(size_t x) { return (x + 255) & ~(size_t)255; }
constexpr size_t WS_CTL = 0, CTL_ZERO_BYTES = 1u << 20;
constexpr size_t WS_WA = CTL_ZERO_BYTES;
constexpr size_t WS_WOUT = WS_WA + (size_t)NCOLA * DM * 2;
constexpr size_t WS_WUP = WS_WOUT + (size_t)2 * DM * DM * 2;
constexpr size_t WS_WDN = WS_WUP + (size_t)2 * FF * DM * 2;
constexpr size_t WS_WB = WS_WDN + (size_t)2 * FF * DM * 2;
constexpr size_t WS_WM = WS_WB + (size_t)NCOLB * DM * 2;
constexpr size_t WS_WW2 = WS_WM + (size_t)DM * DM * 2;
constexpr size_t WS_WA2 = WS_WW2 + (size_t)768 * 64 * 2;
constexpr size_t WS_WG2 = WS_WA2 + (size_t)768 * 64 * 2;
constexpr size_t WS_ROPE = WS_WG2 + (size_t)768 * 128 * 2;
constexpr size_t WS_SSQ = al256(WS_ROPE + (size_t)8196 * 64 * 4);
constexpr size_t WS_SSQM = WS_SSQ + (size_t)R * 16 * 4;
constexpr size_t WS_MB = WS_SSQM + (size_t)512 * 16 * 4;
constexpr size_t WS_MK = WS_MB + (size_t)512 * DM * 2;
constexpr size_t WS_MVT = WS_MK + (size_t)2 * 2 * 4 * 256 * 64 * 2;
constexpr size_t WS_HB = WS_MVT + (size_t)2 * 2 * 4 * 256 * 64 * 2;
constexpr size_t WS_MIX = WS_HB + (size_t)R * DM * 2;
constexpr size_t WS_BIG = WS_MIX + (size_t)R * DM * 2;
constexpr size_t WS_PROJ = WS_BIG;
constexpr size_t WS_REC = WS_PROJ + (size_t)R * NCOLA * 2;
constexpr size_t REC_BYTES = 5 * 8192;
constexpr size_t WS_END0 = WS_REC + (size_t)NUNIT * REC_BYTES;
constexpr size_t WS_H = WS_BIG;
constexpr size_t WS_END1 = WS_H + (size_t)R * FF * 2;
constexpr size_t WS_SLAB = WS_BIG + ((size_t)160 << 20);
constexpr int S_K1 = 4, S_K4 = 16;
constexpr size_t WS_Q1 = WS_BIG;
constexpr size_t WS_K1 = WS_Q1 + (size_t)R * DM * 2;
constexpr size_t WS_V1 = WS_K1 + (size_t)R * 256 * 2;
constexpr size_t WS_VT1 = WS_V1 + (size_t)R * 256 * 2;
constexpr size_t WS_END = WS_END0 > WS_END1 ? WS_END0 : WS_END1;
static_assert(WS_VT1 + (size_t)2 * 4 * 64 * 8192 * 2 <= WS_END && WS_END1 <= WS_SLAB && WS_SLAB + ((size_t)32 << 20) <= WS_END, "ws map");
constexpr int CW_BAR = 4096;
constexpr int RING_OFF = 0, RING_BYTES = 131072, PREP_HALF = 73728, LDSCTL_OFF = 147456, MISC_OFF = LDSCTL_OFF + 320, WTOT_OFF = LDSCTL_OFF + 1024, LDS_BYTES = LDSCTL_OFF + 4096;

#define GAS __attribute__((address_space(1)))
#define LAS __attribute__((address_space(3)))
typedef unsigned short bf16;
typedef unsigned v4u __attribute__((ext_vector_type(4)));
typedef unsigned v2u __attribute__((ext_vector_type(2)));
typedef float f32x4 __attribute__((ext_vector_type(4)));
typedef float f32x16 __attribute__((ext_vector_type(16)));
typedef short bf16x8 __attribute__((ext_vector_type(8)));
typedef short bf16x4 __attribute__((ext_vector_type(4)));
typedef GAS unsigned gu32;
#define RLX_AGENT __ATOMIC_RELAXED, __HIP_MEMORY_SCOPE_AGENT
#define LDS_WAIT() asm volatile("s_waitcnt lgkmcnt(0)" ::: "memory")
#define VM_WAIT() asm volatile("s_waitcnt vmcnt(0)" ::: "memory")
using pg8::cvt_pk_bf16;
__device__ __forceinline__ int mk_lane() { int l; asm volatile("v_mbcnt_lo_u32_b32 %0, -1, 0\n\tv_mbcnt_hi_u32_b32 %0, -1, %0" : "=v"(l)); return l; }
__device__ __forceinline__ float bf2f(unsigned v) { return __uint_as_float(v << 16); }
__device__ __forceinline__ float bflo(unsigned w) { return __uint_as_float(w << 16); }
__device__ __forceinline__ float bfhi(unsigned w) { return __uint_as_float(w & 0xffff0000u); }
__device__ __forceinline__ bf16 f2bf(float f) { return (bf16)(cvt_pk_bf16(f, 0.f) & 0xffffu); }
__device__ __forceinline__ v2u pack4(f32x4 v) { v2u w; w.x = cvt_pk_bf16(v[0], v[1]); w.y = cvt_pk_bf16(v[2], v[3]); return w; }
__device__ __forceinline__ f32x4 unpack4(v2u w) { return (f32x4){bflo(w.x), bfhi(w.x), bflo(w.y), bfhi(w.y)}; }
__device__ __forceinline__ f32x4 mfma16(bf16x8 a, bf16x8 b, f32x4 c) { return __builtin_amdgcn_mfma_f32_16x16x32_bf16(a, b, c, 0, 0, 0); }
__device__ __forceinline__ f32x16 mfma32(bf16x8 a, bf16x8 b, f32x16 c) { return __builtin_amdgcn_mfma_f32_32x32x16_bf16(a, b, c, 0, 0, 0); }
using pg8::swz_xor; using pg8::add_x32; using pg8::max_x32; using pg8::add_x16; using pg8::sum16_dpp; using pg8::max16_dpp; using pg8::sum4_dpp;
__device__ __forceinline__ float sum16(float v) { return sum16_dpp(v); }
__device__ __forceinline__ float wave_sum(float v) { v = sum16_dpp(v); v = add_x16(v); return add_x32(v); }
__device__ __forceinline__ float wave_max(float v) { v = max16_dpp(v); v = fmaxf(v, swz_xor<16>(v)); return max_x32(v); }
__device__ __forceinline__ float fsigmoid(float x) { return 1.0f / (1.0f + __expf(-x)); }
__device__ __forceinline__ float ftanh(float x) { const float e = __expf(2.0f * x); return 1.0f - 2.0f / (e + 1.0f); }
namespace pg8 {
__device__ __forceinline__ void head_norm(f32x4 (&x)[2][2], const float* gain, int fq) {
    float ss = 0.f;
#pragma unroll
    for (int bj = 0; bj < 2; ++bj)
#pragma unroll
        for (int n = 0; n < 2; ++n) ss += hsum4(x[bj][n] * x[bj][n]);
    ss = add_x16(ss); ss = add_x32(ss);
    const float rs = rsqrtf(ss * (1.0f / 64.0f) + 1e-6f);
#pragma unroll
    for (int bj = 0; bj < 2; ++bj)
#pragma unroll
        for (int n = 0; n < 2; ++n) { const f32x4 g = *(const f32x4*)(gain + 32 * bj + 8 * fq + 4 * n); x[bj][n] = x[bj][n] * rs * g; }
}
__device__ __forceinline__ void head_rope(f32x4 (&x)[2][2], const float* cs  , int fq) {
#pragma unroll
    for (int n = 0; n < 2; ++n) { const f32x4 t0 = *(const f32x4*)(cs + 2 * (8 * fq + 4 * n)), t1 = *(const f32x4*)(cs + 2 * (8 * fq + 4 * n) + 4);
        const f32x4 cc = {t0[0], t0[2], t1[0], t1[2]}, sn = {t0[1], t0[3], t1[1], t1[3]};
        const f32x4 x1 = x[0][n], x2 = x[1][n]; x[0][n] = x1 * cc - x2 * sn; x[1][n] = x2 * cc + x1 * sn; }
}
struct EpiL1 {
    static constexpr bool PERM = true, AFTER_DRAIN = false;
    unsigned char* ws; float* outp; const float* g_q; const float* g_mq; const float* g_k;
    __device__ __forceinline__ void operator()(const f32x4 (&acc)[2][2][4][2], const Unit& u, int wr, int wc, int fr_, int fq_) const {
        int fr = fr_, fq = fq_; asm volatile("" : "+v"(fr), "+v"(fq));
        const float* ssq = (const float*)(ws + WS_SSQ); const float* rope = (const float*)(ws + WS_ROPE); const float c2 = C2Q;
        bf16_t* Q1 = (bf16_t*)(ws + WS_Q1); bf16_t* K1 = (bf16_t*)(ws + WS_K1); bf16_t* V1 = (bf16_t*)(ws + WS_V1); bf16_t* VT1 = (bf16_t*)(ws + WS_VT1);
        float* p_k = outp + O_PSK; float* p_v = outp + O_PSV; float* s_k = outp + O_SSK; float* s_v = outp + O_SSV;
        const int H = u.pn * 4 + wc, row0 = u.pm * BM + wr * 64 + fr;
#pragma unroll
        for (int ai = 0; ai < 2; ++ai)
#pragma unroll
            for (int m = 0; m < 4; ++m) { const int row = row0 + ai * HALF + m * 16; const float rs = row_rstd(ssq, row);
                const int pidx = row < 16384 ? (row & 8191) : 8192 + ((row - 16384) & 3);
                f32x4 x[2][2];
#pragma unroll
                for (int bj = 0; bj < 2; ++bj)
#pragma unroll
                    for (int n = 0; n < 2; ++n) x[bj][n] = acc[ai][bj][m][n] * rs;
                if (H < 16) {
                    head_norm(x, H < 12 ? g_q : g_mq, fq);
                    if (H < 12) head_rope(x, rope + (size_t)pidx * 64, fq);
#pragma unroll
                    for (int bj = 0; bj < 2; ++bj) *(u32x4*)(Q1 + (size_t)row * 1024 + H * 64 + 32 * bj + 8 * fq) = pack8(x[bj][0] * c2, x[bj][1] * c2);
                } else {
                    const int kh = (H - 16) & 3; const bool isk = H < 20;
                    if (isk) { head_norm(x, g_k, fq); head_rope(x, rope + (size_t)pidx * 64, fq); }
                    bf16_t* dst = isk ? K1 : V1;
#pragma unroll
                    for (int bj = 0; bj < 2; ++bj) *(u32x4*)(dst + (size_t)row * 256 + kh * 64 + 32 * bj + 8 * fq) = pack8(x[bj][0], x[bj][1]);
                    if (!isk && row < 16384) {
                        const int b = row >> 13, t = row & 8191;
#pragma unroll
                        for (int bj = 0; bj < 2; ++bj)
#pragma unroll
                            for (int n = 0; n < 2; ++n)
#pragma unroll
                                for (int e = 0; e < 4; ++e) { const int d = 32 * bj + 8 * fq + 4 * n + e; VT1[((size_t)(b * 4 + kh) * 64 + d) * 8192 + t] = (bf16_t)(cvt_pk_bf16(x[bj][n][e], 0.f) & 0xffffu); } }
                    float* o = nullptr;
                    if (row < 16384) { const int b = row >> 13, t = row & 8191; if (t >= 8064) o = (isk ? p_k : p_v) + ((size_t)(b * 128 + (t - 8064)) * 4 + kh) * 64; }
                    else { const int b = (row - 16384) >> 2, i = (row - 16384) & 3; o = (isk ? s_k : s_v) + ((size_t)(b * 128 + 124 + i) * 4 + kh) * 64; }
                    if (o) {
#pragma unroll
                        for (int bj = 0; bj < 2; ++bj) { *(f32x4*)(o + 32 * bj + 8 * fq) = x[bj][0]; *(f32x4*)(o + 32 * bj + 8 * fq + 4) = x[bj][1]; } }
                }
                asm volatile("" ::: "memory");
            }
    }
};
struct EpiMemKV {
    static constexpr bool PERM = true, AFTER_DRAIN = false;
    unsigned char* ws; float* outp; const float* g_k  ;
    __device__ __forceinline__ void operator()(const f32x4 (&acc)[2][2][4][2], const Unit& u, int wr, int wc, int fr_, int fq_) const {
        int fr = fr_, fq = fq_; asm volatile("" : "+v"(fr), "+v"(fq));
        const float* ssq = (const float*)(ws + WS_SSQM); float* p_k = outp + O_PMK; float* p_v = outp + O_PMV; bf16_t* MK = (bf16_t*)(ws + WS_MK)  ; bf16_t* MVT = (bf16_t*)(ws + WS_MVT)  ;
        const int H = u.pn * 4 + wc, l = H >> 3, isv = (H >> 2) & 1, hh = H & 3, row0 = u.pm * BM + wr * 64 + fr;
#pragma unroll
        for (int ai = 0; ai < 2; ++ai)
#pragma unroll
            for (int m = 0; m < 4; ++m) { const int row = row0 + ai * HALF + m * 16; const float rs = row_rstd(ssq, row); const int b = row >> 8, mm = row & 255;
                f32x4 x[2][2];
#pragma unroll
                for (int bj = 0; bj < 2; ++bj)
#pragma unroll
                    for (int n = 0; n < 2; ++n) x[bj][n] = acc[ai][bj][m][n] * rs;
                if (!isv) head_norm(x, g_k + l * 64, fq);
                float* o = (isv ? p_v : p_k) + ((((size_t)l * 2 + b) * 256 + mm) * 4 + hh) * 64;
#pragma unroll
                for (int bj = 0; bj < 2; ++bj) { *(f32x4*)(o + 32 * bj + 8 * fq) = x[bj][0]; *(f32x4*)(o + 32 * bj + 8 * fq + 4) = x[bj][1]; }
                if (!isv) {
#pragma unroll
                    for (int bj = 0; bj < 2; ++bj) *(u32x4*)(MK + ((((size_t)l * 2 + b) * 4 + hh) * 256 + mm) * 64 + 32 * bj + 8 * fq) = pack8(x[bj][0], x[bj][1]);
                } else {
#pragma unroll
                    for (int bj = 0; bj < 2; ++bj)
#pragma unroll
                        for (int n = 0; n < 2; ++n)
#pragma unroll
                            for (int e = 0; e < 4; ++e) { const int d = 32 * bj + 8 * fq + 4 * n + e; MVT[((((size_t)l * 2 + b) * 4 + hh) * 64 + d) * 256 + mm] = (bf16_t)(cvt_pk_bf16(x[bj][n][e], 0.f) & 0xffffu); }
                }
                asm volatile("" ::: "memory");
            }
    }
};
}
#define XB_TMO      128
#define XB_XCNT(j)  (256  + 64 * (j))
#define XB_XSUB(j)  (1280 + 64 * (j))
#define XB_XGEN(j)  (2304 + 64 * (j))
#define XB_TOP      3328
#define XB_TOPGEN   3392
#define XCD_BAR_WORDS 3456
#define XB_SPIN_CAP (1u << 18)

__device__ __forceinline__ unsigned xb_ld(unsigned* p)              { return __hip_atomic_load(p, __ATOMIC_RELAXED, __HIP_MEMORY_SCOPE_AGENT); }
__device__ __forceinline__ unsigned xb_add(unsigned* p, unsigned v) { return __hip_atomic_fetch_add(p, v, __ATOMIC_RELAXED, __HIP_MEMORY_SCOPE_AGENT); }
__device__ __forceinline__ unsigned xb_xcc_id() { return (unsigned)__builtin_amdgcn_s_getreg((3 << 11) | 20) & 0xFu; }
#define XB_SPIN(cond, bar) do { unsigned _sp = 0; while (cond) { __builtin_amdgcn_s_sleep(1); \
    if ((++_sp & 255u) == 0u) { if (xb_ld(&(bar)[XB_TMO])) break; if (_sp > XB_SPIN_CAP) { atomicAdd(&(bar)[XB_TMO], 1u); break; } } } } while (0)

struct XcdBarrier {
    bool wave0;
    unsigned* bar; unsigned x;
    volatile LAS unsigned* st;
};

__device__ __forceinline__ XcdBarrier xcd_barrier_post(unsigned* bar, volatile LAS unsigned* st, bool wave0) {
    XcdBarrier b; b.wave0 = wave0; b.bar = bar; b.x = xb_xcc_id(); b.st = st;
    if (wave0 && mk_lane() == 0) (void)xb_add(&bar[XB_XCNT(b.x)], 1u);
    return b;
}
__device__ __forceinline__ void xcd_barrier_complete(unsigned* bar, unsigned x, unsigned& nloc, unsigned& nx) {
    const unsigned G = gridDim.x * gridDim.y * gridDim.z;
    unsigned sum, cnt, mine, sp = 0u;
    for (;;) {
        sum = 0u; cnt = 0u; mine = 0u;
#pragma unroll
        for (unsigned j = 0; j < 16; ++j) { const unsigned c = xb_ld(&bar[XB_XCNT(j)]); sum += c; cnt += (c > 0u) ? 1u : 0u; mine = (j == x) ? c : mine; }
        if (sum == G) break;
        __builtin_amdgcn_s_sleep(1);
        if ((++sp & 255u) == 0u) { if (xb_ld(&bar[XB_TMO])) break; if (sp > XB_SPIN_CAP) { atomicAdd(&bar[XB_TMO], 1u); break; } }
    }
    nloc = mine > 0u ? mine : 1u; nx = cnt > 0u ? cnt : 1u;
}

__device__ __forceinline__ void xcd_barrier(const XcdBarrier& b) {
    asm volatile("s_waitcnt vmcnt(0)" ::: "memory");
    __syncthreads();
    if (b.wave0 && mk_lane() == 0) {
        unsigned* bar = b.bar;
        __builtin_amdgcn_s_waitcnt(0);
        unsigned nloc = b.st[0], nx = b.st[1];
        if (nloc == 0u) { xcd_barrier_complete(bar, b.x, nloc, nx); b.st[0] = nloc; b.st[1] = nx; }
        const unsigned old = xb_add(&bar[XB_XSUB(b.x)], 1u);
        const unsigned gen = old / nloc;
        if (old + 1u == (gen + 1u) * nloc) {
            __builtin_amdgcn_fence(__ATOMIC_RELEASE, "agent");
            asm volatile("s_waitcnt vmcnt(0)" ::: "memory");
            const unsigned og = xb_add(&bar[XB_TOP], 1u);
            const unsigned tg = og / nx;
            if (og + 1u == (tg + 1u) * nx) xb_add(&bar[XB_TOPGEN], 1u);
            else XB_SPIN(xb_ld(&bar[XB_TOPGEN]) == tg, bar);
            __builtin_amdgcn_fence(__ATOMIC_ACQUIRE, "agent");
            xb_add(&bar[XB_XGEN(b.x)], 1u);
            asm volatile("s_waitcnt vmcnt(0)" ::: "memory");
        } else {
            XB_SPIN(xb_ld(&bar[XB_XGEN(b.x)]) == gen, bar);
            __builtin_amdgcn_fence(__ATOMIC_ACQUIRE, "agent");
            asm volatile("s_waitcnt vmcnt(0)" ::: "memory");
        }
    }
    __syncthreads();
}

struct Args { const float* in[N_IN]; float* out; unsigned char* ws; int ph_lo, ph_hi; };
struct Frame {
    LAS unsigned char* lds; unsigned char* lds_g;
    gu32* ctl;
    int tid, lane, wave, vcu, G;
    const float* const* in; float* out; unsigned char* ws;
};
__host__ __device__ __forceinline__ int wsig_inv(int nl) { return 128 * ((nl >> 5) & 1) + 32 * (nl >> 6) + (nl & 31); }

__device__ __forceinline__ void p0_transpose_item(const float* W, int K, int N, bf16* WT, int row_off, bool sig, const float* gain, LAS float* scr, int item, int lane) {
    const int nblk = N / 32, kb = item / nblk, nb = item % nblk, k0 = 64 * kb, n0 = 32 * nb;
    float tv[32];
#pragma unroll
    for (int i = 0; i < 32; ++i) { const int kk = 2 * i + (lane >> 5); tv[i] = W[(size_t)(k0 + kk) * N + n0 + (lane & 31)]; }
    if (gain) {
#pragma unroll
        for (int i = 0; i < 32; ++i) tv[i] *= gain[k0 + 2 * i + (lane >> 5)]; }
#pragma unroll
    for (int i = 0; i < 32; ++i) scr[(2 * i + (lane >> 5)) * 33 + (lane & 31)] = tv[i];
    LDS_WAIT(); asm volatile("" ::: "memory");
    const int c = lane & 7;
    int nbase = row_off + n0; if (sig) { const int ng = row_off + n0; nbase = (ng & ~255) + wsig_inv(ng & 255); }
#pragma unroll
    for (int j = 0; j < 4; ++j) { const int n = (lane >> 3) + 8 * j; const LAS float* s = scr + (8 * c) * 33 + n;
        v4u o; o.x = cvt_pk_bf16(s[0 * 33], s[1 * 33]); o.y = cvt_pk_bf16(s[2 * 33], s[3 * 33]); o.z = cvt_pk_bf16(s[4 * 33], s[5 * 33]); o.w = cvt_pk_bf16(s[6 * 33], s[7 * 33]);
        *(GAS v4u*)(WT + (size_t)(nbase + n) * K + k0 + 8 * c) = o; }
    LDS_WAIT(); asm volatile("" ::: "memory");
}
__device__ __forceinline__ void row_to_bf16_ssq(const float* xrow, bf16* orow, float* ssqrow, int lane) {
    const GAS f32x4* xr = (const GAS f32x4*)xrow + lane;
    f32x4 v[4]; float s = 0.f;
#pragma unroll
    for (int j = 0; j < 4; ++j) { v[j] = xr[64 * j]; s += (v[j].x * v[j].x + v[j].y * v[j].y) + (v[j].z * v[j].z + v[j].w * v[j].w); }
    s = wave_sum(s);
    GAS v2u* o8 = (GAS v2u*)orow + lane;
#pragma unroll
    for (int j = 0; j < 4; ++j) o8[64 * j] = pack4(v[j]);
    if (lane < 16) ssqrow[lane] = lane == 0 ? s : 0.f;
}
__device__ __forceinline__ void p0_prologue(Frame& F) {
    LAS float* scr = (LAS float*)(F.lds + RING_OFF + F.wave * 16384);
    const int gw = F.vcu * NWAVES + F.wave, NGW = F.G * NWAVES;
    unsigned char* ws = F.ws;
    int it = gw;
#define P0_JOB(Wp, K_, N_, WTp, roff, sg, gn) { const int ni = ((K_) / 64) * ((N_) / 32); for (; it < ni; it += NGW) p0_transpose_item((Wp), (K_), (N_), (WTp), (roff), (sg), (gn), scr, it, F.lane); it -= ni; }
    P0_JOB(F.in[I_WINA], DM, NCOLA, (bf16*)(ws + WS_WA), 0, false, F.in[I_NMIX]);
    P0_JOB(F.in[I_WOUT], DM, DM, (bf16*)(ws + WS_WOUT), 0, false, nullptr);
    P0_JOB(F.in[I_WOUT] + (size_t)DM * DM, DM, DM, (bf16*)(ws + WS_WOUT) + (size_t)DM * DM, 0, false, nullptr);
    P0_JOB(F.in[I_WUP], DM, FF, (bf16*)(ws + WS_WUP), 0, false, F.in[I_NMLP]);
    P0_JOB(F.in[I_WUP] + (size_t)DM * FF, DM, FF, (bf16*)(ws + WS_WUP) + (size_t)DM * FF, 0, false, F.in[I_NMLP] + DM);
    P0_JOB(F.in[I_WDN], FF, DM, (bf16*)(ws + WS_WDN), 0, false, nullptr);
    P0_JOB(F.in[I_WDN] + (size_t)DM * FF, FF, DM, (bf16*)(ws + WS_WDN) + (size_t)DM * FF, 0, false, nullptr);
    P0_JOB(F.in[I_WINB], DM, DM, (bf16*)(ws + WS_WB), 0, true, F.in[I_NMIX] + DM);
    P0_JOB(F.in[I_WKV], DM, 512, (bf16*)(ws + WS_WB), 1024, true, F.in[I_KVN]);
    P0_JOB(F.in[I_WMKV], DM, 512, (bf16*)(ws + WS_WM), 0, true, F.in[I_MNORM]);
    P0_JOB(F.in[I_WMKV] + (size_t)DM * 512, DM, 512, (bf16*)(ws + WS_WM), 512, true, F.in[I_MNORM] + DM);
    P0_JOB(F.in[I_WW2], 64, 768, (bf16*)(ws + WS_WW2), 0, false, nullptr);
    P0_JOB(F.in[I_WA2], 64, 768, (bf16*)(ws + WS_WA2), 0, false, nullptr);
    P0_JOB(F.in[I_WG2], 128, 768, (bf16*)(ws + WS_WG2), 0, false, nullptr);
#undef P0_JOB
    for (int m = gw; m < R; m += NGW) { const float* xr = m < RP ? F.in[I_XP] + (size_t)m * DM : F.in[I_XS] + (size_t)(m - RP) * DM;
        row_to_bf16_ssq(xr, (bf16*)(ws + WS_HB) + (size_t)m * DM, (float*)(ws + WS_SSQ) + (size_t)m * 16, F.lane); }
    for (int m = gw; m < 512; m += NGW) row_to_bf16_ssq(F.in[I_MEMP] + (size_t)m * DM, (bf16*)(ws + WS_MB) + (size_t)m * DM, (float*)(ws + WS_SSQM) + (size_t)m * 16, F.lane);
    { const int gt = F.vcu * NWAVES * 64 + F.tid, NGT = F.G * NWAVES * 64; float* rt = (float*)(ws + WS_ROPE);
      for (int i = gt; i < 8196 * 32; i += NGT) { const int p = i >> 5, f = i & 31; const float pos = (float)(p < 8192 ? p : 16384 + (p - 8192));
          double fq_ = 1.0; for (int k = 0; k < f; ++k) fq_ *= 0.74989420933245582730; const float ang = pos * (float)fq_; const double rev = (double)ang * 0.15915494309189535; const float fr = (float)(rev - floor(rev));
          rt[2 * i] = __builtin_amdgcn_cosf(fr); rt[2 * i + 1] = __builtin_amdgcn_sinf(fr); } }
    { const int gt = F.vcu * NWAVES * 64 + F.tid, NGT = F.G * NWAVES * 64; const int per = 124 * 256 / 4;
      for (int i = gt; i < SB * per; i += NGT) { const int b = i / per, r = i % per;
          ((GAS f32x4*)(F.out + O_SSK + (size_t)b * 128 * 256))[r] = ((const GAS f32x4*)(F.in[I_CSK] + (size_t)b * 128 * 256 + 4 * 256))[r];
          ((GAS f32x4*)(F.out + O_SSV + (size_t)b * 128 * 256))[r] = ((const GAS f32x4*)(F.in[I_CSV] + (size_t)b * 128 * 256 + 4 * 256))[r]; } }
}

__device__ __forceinline__ void finalize_sample(Frame& F, const float* base  , int S, bool want_hb) {
    const int gw = F.vcu * NWAVES + F.wave, NGW = F.G * NWAVES; const float* slab = (const float*)(F.ws + WS_SLAB);
    for (int rs = gw; rs < RS; rs += NGW) { const int row = RP + rs, tile0 = (rs >> 8) << 2, r = rs & 255; float ss = 0.f;
#pragma unroll
        for (int pn = 0; pn < 4; ++pn) { f32x4 h = *(const GAS f32x4*)(base + (size_t)rs * DM + pn * 256 + 4 * F.lane);
            for (int s = 0; s < S; ++s) h += *(const GAS f32x4*)(slab + ((size_t)((tile0 + pn) * S + s) << 16) + r * 256 + 4 * F.lane);
            *(GAS f32x4*)(F.out + O_Y + (size_t)row * DM + pn * 256 + 4 * F.lane) = h;
            if (want_hb) *(GAS v2u*)((bf16*)(F.ws + WS_HB) + (size_t)row * DM + pn * 256 + 4 * F.lane) = pack4(h);
            ss += (h[0] * h[0] + h[1] * h[1]) + (h[2] * h[2] + h[3] * h[3]); }
        if (want_hb) { ss = wave_sum(ss); if (F.lane < 16) ((float*)(F.ws + WS_SSQ))[(size_t)row * 16 + F.lane] = F.lane == 0 ? ss : 0.f; } }
}

constexpr int LSTR = 144, SLOT = 64 * LSTR;
__device__ __forceinline__ int rec_index(int chunk, int h) { return ((chunk >> 7) * NH + h) * 128 + (chunk & 127); }
constexpr int REC_PT = 0, REC_QS = 8192, REC_RY = 16384, REC_YL = 24576, REC_BV = 32768;
__device__ __forceinline__ bf16x8 lfrag(const LAS unsigned char* m, int row, int k) { return *(const LAS bf16x8*)(m + row * LSTR + k * 2); }
__device__ __forceinline__ void mm_strip(f32x4 (&acc)[4], const LAS unsigned char* X, const LAS unsigned char* Y, int w, int c, int g) {
#pragma unroll
    for (int ks = 0; ks < 2; ++ks) { const bf16x8 a = lfrag(X, 16 * w + c, 32 * ks + 8 * g);
#pragma unroll
        for (int n = 0; n < 4; ++n) acc[n] = mfma16(a, lfrag(Y, 16 * n + c, 32 * ks + 8 * g), acc[n]); }
}
__device__ __forceinline__ void mm_strip2(f32x4 (&acc0)[4], f32x4 (&acc1)[4], const LAS unsigned char* X, const LAS unsigned char* Y0, const LAS unsigned char* Y1, int w, int c, int g) {
#pragma unroll
    for (int ks = 0; ks < 2; ++ks) { const bf16x8 a = lfrag(X, 16 * w + c, 32 * ks + 8 * g);
#pragma unroll
        for (int n = 0; n < 4; ++n) { acc0[n] = mfma16(a, lfrag(Y0, 16 * n + c, 32 * ks + 8 * g), acc0[n]); acc1[n] = mfma16(a, lfrag(Y1, 16 * n + c, 32 * ks + 8 * g), acc1[n]); } }
}
__device__ __forceinline__ void zero4(f32x4 (&a)[4]) {
#pragma unroll
    for (int n = 0; n < 4; ++n) a[n] = (f32x4){0.f, 0.f, 0.f, 0.f};
}
__device__ __forceinline__ void st_T(LAS unsigned char* dest, const f32x4 (&acc)[4], int w, int c, int g) {
#pragma unroll
    for (int n = 0; n < 4; ++n) *(LAS v2u*)(dest + (16 * n + c) * LSTR + (16 * w + 4 * g) * 2) = pack4(acc[n]);
}
__device__ __forceinline__ void st_T_global(unsigned char* dest  , const f32x4 (&acc)[4], int w, int c, int g) {
#pragma unroll
    for (int n = 0; n < 4; ++n) *(GAS v2u*)(dest + (16 * n + c) * 128 + (16 * w + 4 * g) * 2) = pack4(acc[n]);
}
__device__ __forceinline__ void load_shift8(const bf16* cur, const bf16* prv, const float* mu, float (&o)[8]) {
    const v4u cw = *(const GAS v4u*)cur; v4u pw = {0u, 0u, 0u, 0u}; if (prv) pw = *(const GAS v4u*)prv;
    const f32x4 m0 = *(const GAS f32x4*)mu, m1 = *(const GAS f32x4*)(mu + 4);
    const float cf[8] = {bflo(cw.x), bfhi(cw.x), bflo(cw.y), bfhi(cw.y), bflo(cw.z), bfhi(cw.z), bflo(cw.w), bfhi(cw.w)};
    const float pf[8] = {bflo(pw.x), bfhi(pw.x), bflo(pw.y), bfhi(pw.y), bflo(pw.z), bfhi(pw.z), bflo(pw.w), bfhi(pw.w)};
    const float mf[8] = {m0[0], m0[1], m0[2], m0[3], m1[0], m1[1], m1[2], m1[3]};
#pragma unroll
    for (int i = 0; i < 8; ++i) o[i] = cf[i] + (pf[i] - cf[i]) * mf[i];
}
__device__ __forceinline__ bf16x8 pack_frag(const float (&v)[8]) {
    v4u w; w.x = cvt_pk_bf16(v[0], v[1]); w.y = cvt_pk_bf16(v[2], v[3]); w.z = cvt_pk_bf16(v[4], v[5]); w.w = cvt_pk_bf16(v[6], v[7]); return __builtin_bit_cast(bf16x8, w);
}

struct PrepPf { v4u raw[3][2]; v4u prv; v4u lc[2][2], lp[2][2]; };
__device__ __forceinline__ void prep_issue(Frame& F, int unit, PrepPf& pf) {
    const int th = (F.wave & 3) * 64 + F.lane; const int chunk = unit / NH, h = unit % NH, row0 = chunk * 64; const bool first = (chunk & 127) == 0;
    const bf16* proj = (const bf16*)(F.ws + WS_PROJ);
#pragma unroll
    for (int a = 0; a < 3; ++a)
#pragma unroll
        for (int i = 0; i < 2; ++i) { const int id = th + 256 * i; pf.raw[a][i] = *(const GAS v4u*)(proj + (size_t)(row0 + (id >> 3)) * NCOLA + a * 768 + h * 64 + (id & 7) * 8); }
    pf.prv = (v4u){0u, 0u, 0u, 0u};
    if (th < 24 && !first) pf.prv = *(const GAS v4u*)(proj + (size_t)(row0 - 1) * NCOLA + (th >> 3) * 768 + h * 64 + (th & 7) * 8);
    { const int w = F.wave & 3, g = F.lane >> 4, c = F.lane & 15, t = 16 * w + c; const bf16* cr = proj + (size_t)(row0 + t) * NCOLA; const bool hp = !(first && t == 0);
#pragma unroll
      for (int a = 0; a < 2; ++a)
#pragma unroll
          for (int ks = 0; ks < 2; ++ks) { const int col = 2304 + 64 * a + 32 * ks + 8 * g; pf.lc[a][ks] = *(const GAS v4u*)(cr + col); pf.lp[a][ks] = (v4u){0u, 0u, 0u, 0u}; if (hp) pf.lp[a][ks] = *(const GAS v4u*)(cr - NCOLA + col); } }
}
__device__ __forceinline__ void shift8(v4u cw, v4u pw, const float* mu, float (&o)[8]) {
    const f32x4 m0 = *(const GAS f32x4*)mu, m1 = *(const GAS f32x4*)(mu + 4);
    const float cf[8] = {bflo(cw.x), bfhi(cw.x), bflo(cw.y), bfhi(cw.y), bflo(cw.z), bfhi(cw.z), bflo(cw.w), bfhi(cw.w)};
    const float pf_[8] = {bflo(pw.x), bfhi(pw.x), bflo(pw.y), bfhi(pw.y), bflo(pw.z), bfhi(pw.z), bflo(pw.w), bfhi(pw.w)};
    const float mf[8] = {m0[0], m0[1], m0[2], m0[3], m1[0], m1[1], m1[2], m1[3]};
#pragma unroll
    for (int i = 0; i < 8; ++i) o[i] = cf[i] + (pf_[i] - cf[i]) * mf[i];
}
#define HBAR() do { asm volatile("s_waitcnt lgkmcnt(0)" ::: "memory"); __builtin_amdgcn_s_barrier(); asm volatile("" ::: "memory"); } while (0)
__device__ __forceinline__ void rwkv_prep_unit(Frame& F, int unit, LAS unsigned char* hb, LAS float* wtot, LAS unsigned char* prow, PrepPf& pf, bool has_next, int next_unit, int stage_limit = 99) {
    int w_ = F.wave & 3, lane_ = F.lane; asm volatile("" : "+s"(w_), "+v"(lane_));
    const int w = w_, lane = lane_, g = lane >> 4, c = lane & 15;
    const int chunk = unit / NH, h = unit % NH, row0 = chunk * 64; const bool first = (chunk & 127) == 0;
    const bf16* proj = (const bf16*)(F.ws + WS_PROJ);
    unsigned char* rec = F.ws + WS_REC + (size_t)rec_index(chunk, h) * REC_BYTES;
    LAS unsigned char* const s0 = hb, * const s1 = hb + SLOT, * const s2 = hb + 2 * SLOT, * const s3 = hb + 3 * SLOT, * const s4 = hb + 4 * SLOT, * const s5 = hb + 5 * SLOT, * const s6 = hb + 6 * SLOT, * const s7 = hb + 7 * SLOT;
    float mur[4], muk[4], muv[4], w0[4], a0[4], kkc[4], kac[4], rkc[4];
#pragma unroll
    for (int n = 0; n < 4; ++n) { const int col = h * 64 + 16 * n + c; mur[n] = F.in[I_MU][col]; muk[n] = F.in[I_MU][768 + col]; muv[n] = F.in[I_MU][1536 + col];
        w0[n] = F.in[I_W0][col]; a0[n] = F.in[I_A0][col]; kkc[n] = F.in[I_KK][col]; kac[n] = F.in[I_KA][col]; rkc[n] = F.in[I_RK][col]; }
    f32x4 dw[4], da[4]; zero4(dw); zero4(da);
    { const int th = w * 64 + lane;
#pragma unroll
      for (int a = 0; a < 3; ++a)
#pragma unroll
          for (int i = 0; i < 2; ++i) { const int id = th + 256 * i; *(LAS v4u*)(hb + a * SLOT + (id >> 3) * LSTR + (id & 7) * 16) = pf.raw[a][i]; }
      if (th < 24) *(LAS v4u*)(prow + (th >> 3) * 128 + (th & 7) * 16) = pf.prv; }
    {
        const bf16* Ww2 = (const bf16*)(F.ws + WS_WW2); const bf16* Wa2 = (const bf16*)(F.ws + WS_WA2);
#pragma unroll
        for (int ks = 0; ks < 2; ++ks) { const int l0 = 32 * ks + 8 * g; float x[8];
            shift8(pf.lc[0][ks], pf.lp[0][ks], F.in[I_MU] + 2304 + l0, x);
#pragma unroll
            for (int i = 0; i < 8; ++i) x[i] = ftanh(x[i]);
            const bf16x8 aw = pack_frag(x);
            shift8(pf.lc[1][ks], pf.lp[1][ks], F.in[I_MU] + 2368 + l0, x);
            const bf16x8 aa = pack_frag(x);
#pragma unroll
            for (int n = 0; n < 4; ++n) { const size_t wo = (size_t)(h * 64 + 16 * n + c) * 64 + l0;
                dw[n] = mfma16(aw, *(const GAS bf16x8*)(Ww2 + wo), dw[n]); da[n] = mfma16(aa, *(const GAS bf16x8*)(Wa2 + wo), da[n]); } }
    }
    HBAR();
    if (has_next) prep_issue(F, next_unit, pf);
    f32x4 rt[4], kh[4], lw[4], at_[4], bt_[4], kt_[4], bh_[4], vv[4]; float gam[4]; float bon[4] = {0.f, 0.f, 0.f, 0.f}; float ssk[4] = {0.f, 0.f, 0.f, 0.f};
    f32x4 kkr[4], aa_[4], kp[4], rr[4];
    {

        const LAS unsigned char* pbase = (w == 0 && g == 0) ? prow + c * 2 : hb + (16 * w + 4 * g - 1) * LSTR + c * 2; const int pstr = (w == 0 && g == 0) ? 128 : SLOT;
        float rp[4], kpv[4], vp[4];
#pragma unroll
        for (int n = 0; n < 4; ++n) { rp[n] = bf2f(*(const LAS bf16*)(pbase + 32 * n)); kpv[n] = bf2f(*(const LAS bf16*)(pbase + pstr + 32 * n)); vp[n] = bf2f(*(const LAS bf16*)(pbase + 2 * pstr + 32 * n)); }
#pragma unroll
        for (int reg = 0; reg < 4; ++reg) { const int t = 16 * w + 4 * g + reg; const LAS unsigned char* cr = hb + t * LSTR + c * 2;
#pragma unroll
            for (int n = 0; n < 4; ++n) {
                const float r0 = bf2f(*(const LAS bf16*)(cr + 32 * n)), k0 = bf2f(*(const LAS bf16*)(cr + SLOT + 32 * n)), v0 = bf2f(*(const LAS bf16*)(cr + 2 * SLOT + 32 * n));
                const float r1 = rp[n], k1 = kpv[n], v1 = vp[n]; rp[n] = r0; kpv[n] = k0; vp[n] = v0;
                const float r = r0 + (r1 - r0) * mur[n], k = k0 + (k1 - k0) * muk[n], v = v0 + (v1 - v0) * muv[n];
                const float y = -(w0[n] + dw[n][reg]);
                const float sp = fmaxf(y, 0.f) + __logf(1.0f + __expf(-fabsf(y)));
                lw[n][reg] = -__expf(-sp - 0.5f);
                const float a = fsigmoid(a0[n] + da[n][reg]);
                aa_[n][reg] = a; kkr[n][reg] = k * kkc[n]; kp[n][reg] = k * (1.0f + (a - 1.0f) * kac[n]); rr[n][reg] = r; vv[n][reg] = v;
                ssk[reg] += kkr[n][reg] * kkr[n][reg]; bon[reg] += r * kp[n][reg] * rkc[n]; } }
    }
#pragma unroll
    for (int reg = 0; reg < 4; ++reg) { ssk[reg] = sum16(ssk[reg]); bon[reg] = sum16(bon[reg]); ssk[reg] = 1.0f / fmaxf(sqrtf(ssk[reg]), 1e-12f); }
    f32x4 Lc[4];
#pragma unroll
    for (int n = 0; n < 4; ++n) { f32x4 inc; inc[0] = lw[n][0]; inc[1] = inc[0] + lw[n][1]; inc[2] = inc[1] + lw[n][2]; inc[3] = inc[2] + lw[n][3];
        const float tot = inc[3]; const float t1 = __shfl(tot, (lane - 16) & 63), t2 = __shfl(tot, (lane - 32) & 63), t3 = __shfl(tot, (lane - 48) & 63);
        const float pre = (g >= 1 ? t1 : 0.f) + (g >= 2 ? t2 : 0.f) + (g >= 3 ? t3 : 0.f);
        Lc[n] = inc + pre; if (g == 3) wtot[w * 64 + 16 * n + c] = pre + tot; }
    HBAR();
#pragma unroll
    for (int n = 0; n < 4; ++n) { const int j = 16 * n + c; const float t0 = wtot[j], t1 = wtot[64 + j], t2 = wtot[128 + j], t3 = wtot[192 + j];
        const float base = (w >= 1 ? t0 : 0.f) + (w >= 2 ? t1 : 0.f) + (w >= 3 ? t2 : 0.f); const float LC = (t0 + t1) + (t2 + t3);
        gam[n] = __expf(LC);
#pragma unroll
        for (int reg = 0; reg < 4; ++reg) { const float L = Lc[n][reg] + base; const float eL = __expf(L), eLi = __expf(-L), eP = __expf(L - lw[n][reg]), eC = __expf(LC - L);
            const float kk = kkr[n][reg] * ssk[reg], bsc = kk * aa_[n][reg];
            at_[n][reg] = -kk * eP; rt[n][reg] = rr[n][reg] * eL; bt_[n][reg] = bsc * eLi; kt_[n][reg] = kp[n][reg] * eLi; bh_[n][reg] = bsc * eC; kh[n][reg] = kp[n][reg] * eC;
            const int t = 16 * w + 4 * g + reg;
            *(LAS bf16*)(s0 + t * LSTR + j * 2) = f2bf(at_[n][reg]); *(LAS bf16*)(s1 + t * LSTR + j * 2) = f2bf(bt_[n][reg]);
            *(LAS bf16*)(s2 + t * LSTR + j * 2) = f2bf(kt_[n][reg]); *(LAS bf16*)(s3 + t * LSTR + j * 2) = f2bf(rt[n][reg]); }
        *(LAS v2u*)(s4 + j * LSTR + (16 * w + 4 * g) * 2) = pack4(at_[n]); *(LAS v2u*)(s5 + j * LSTR + (16 * w + 4 * g) * 2) = pack4(bh_[n]); *(LAS v2u*)(s6 + j * LSTR + (16 * w + 4 * g) * 2) = pack4(vv[n]);
        f32x4 bv;
#pragma unroll
        for (int reg = 0; reg < 4; ++reg) bv[reg] = bon[reg] * vv[n][reg];
        *(GAS v2u*)(rec + REC_BV + ((w * 64 + lane) * 4 + n) * 8) = pack4(bv); }
    HBAR();
    if (stage_limit <= 3) return;
    f32x4 aN[4], aMk[4], aMbr[4], aMkr[4]; zero4(aN); zero4(aMk); zero4(aMbr); zero4(aMkr);
    mm_strip2(aN, aMk, s0, s1, s2, w, c, g);
    mm_strip(aMbr, s1, s3, w, c, g); mm_strip(aMkr, s2, s3, w, c, g);
#pragma unroll
    for (int n = 0; n < 4; ++n)
#pragma unroll
        for (int reg = 0; reg < 4; ++reg) { const int row = 16 * w + 4 * g + reg, col = 16 * n + c;
            if (!(col < row)) { aN[n][reg] = 0.f; aMk[n][reg] = 0.f; } if (!(row <= col)) { aMbr[n][reg] = 0.f; aMkr[n][reg] = 0.f; } }
    HBAR();
    LAS float* Nf = (LAS float*)s0;
#pragma unroll
    for (int n = 0; n < 4; ++n)
#pragma unroll
        for (int reg = 0; reg < 4; ++reg) Nf[(16 * w + 4 * g + reg) * 64 + (c & 3) * 16 + 4 * n + (c >> 2)] = aN[n][reg];
    st_T(s2, aMk, w, c, g);
    st_T(s3, aMbr, w, c, g);
    HBAR();
    {
        const int q = lane & 3, sl = lane >> 2; float cq[16];
#pragma unroll
        for (int k = 0; k < 16; ++k) cq[k] = 0.f;
        for (int t = 0; t < 16 * w; ++t) if (q == 0) *(LAS bf16*)(s7 + t * LSTR + (16 * w + sl) * 2) = (bf16)0;
#pragma unroll
        for (int t = 0; t < 64; ++t) if (t >= 16 * w) {
            float part = 0.f;
#pragma unroll
            for (int k4 = 0; k4 < (t + 15) / 16; ++k4) { const f32x4 nv = *(const LAS f32x4*)(Nf + t * 64 + q * 16 + 4 * k4);
#pragma unroll
                for (int e = 0; e < 4; ++e) if (4 * (4 * k4 + e) < t) part = fmaf(nv[e], cq[4 * k4 + e], part); }
            part = sum4_dpp(part);
            const float val = part + ((t == 16 * w + sl) ? 1.0f : 0.0f);
            cq[t >> 2] = (q == (t & 3)) ? val : cq[t >> 2];
            if (q == 0) *(LAS bf16*)(s7 + t * LSTR + (16 * w + sl) * 2) = f2bf(val);
        }
    }
    HBAR();
    if (stage_limit <= 5) return;
    { f32x4 aW[4], aNk[4]; zero4(aW); zero4(aNk); mm_strip2(aW, aNk, s7, s4, s2, w, c, g); st_T(s0, aW, w, c, g); st_T(s1, aNk, w, c, g); }
    HBAR();
    { f32x4 aP[4]; zero4(aP); mm_strip(aP, s0, s5, w, c, g);
#pragma unroll
      for (int n = 0; n < 4; ++n)
#pragma unroll
          for (int reg = 0; reg < 4; ++reg) if (n == w && c == 4 * g + reg) aP[n][reg] += gam[n];
#pragma unroll
      for (int n = 0; n < 4; ++n) *(GAS v2u*)(rec + REC_PT + ((n * 2 + (w >> 1)) * 64 + lane) * 16 + 8 * (w & 1)) = pack4(aP[n]); }
    { f32x4 aZq[4], aZy[4]; zero4(aZq); zero4(aZy); mm_strip2(aZq, aZy, s1, s5, s3, w, c, g);
#pragma unroll
      for (int n = 0; n < 4; ++n) { aZq[n] += kh[n]; aZy[n] += aMkr[n]; }
      f32x4 aRy[4]; zero4(aRy); mm_strip(aRy, s3, s0, w, c, g);
#pragma unroll
      for (int n = 0; n < 4; ++n)
#pragma unroll
          for (int reg = 0; reg < 4; ++reg) *(GAS bf16*)(rec + REC_RY + ((w * 2 + (n >> 1)) * 64 + 16 * (2 * (n & 1) + (c >> 3)) + 4 * g + reg) * 16 + 2 * (c & 7)) = f2bf(aRy[n][reg] + rt[n][reg]);
      st_T(s4, aZq, w, c, g);
      st_T(s7, aZy, w, c, g); }
    HBAR();
    { f32x4 aQ[4], aY[4]; zero4(aQ); zero4(aY); mm_strip(aQ, s4, s6, w, c, g); mm_strip(aY, s7, s6, w, c, g);
#pragma unroll
      for (int n = 0; n < 4; ++n) { *(GAS v2u*)(rec + REC_QS + ((n * 64 + lane) * 4 + w) * 8) = pack4(aQ[n]);
                                    *(GAS v2u*)(rec + REC_YL + ((w * 64 + lane) * 4 + n) * 8) = pack4(aY[n]); } }
}

__device__ __forceinline__ float rdlane(float v, int l) { return __int_as_float(__builtin_amdgcn_readlane(__float_as_int(v), l)); }
__device__ __forceinline__ void rwkv_sample_task(Frame& F, int task) {
    int lane_ = F.lane; asm volatile("" : "+v"(lane_)); const int lane = lane_;
    const int b = task / NH, h = task % NH, col = h * 64 + lane;
    const bf16* proj = (const bf16*)(F.ws + WS_PROJ);
    const float* sh = F.in[I_SSHIFT] + (size_t)b * RWKV_COLS;
    const float* mu = F.in[I_MU];
    float S[64];
    { const GAS f32x4* sp = (const GAS f32x4*)(F.in[I_SWKV] + (((size_t)b * NH + h) * 64 + lane) * 64);
#pragma unroll
      for (int q = 0; q < 16; ++q) { const f32x4 v = sp[q]; S[4 * q] = v[0]; S[4 * q + 1] = v[1]; S[4 * q + 2] = v[2]; S[4 * q + 3] = v[3]; } }
    const float w0 = F.in[I_W0][col], a0 = F.in[I_A0][col], kkc = F.in[I_KK][col], kac = F.in[I_KA][col], rkc = F.in[I_RK][col], lnw = F.in[I_LNW][col], lnb = F.in[I_LNB][col];
    float rr[ST], kq[ST], vq[ST], twd[ST], adv[ST], gd0[ST], gd1[ST];
#pragma unroll
    for (int i = 0; i < ST; ++i) { const int row = RP + b * ST + i; const bf16* cr = proj + (size_t)row * NCOLA;
#define SHIFTED(cc) ({ const float p_ = bf2f(cr[(cc)]); const float q_ = (i == 0) ? sh[(cc)] : bf2f(cr[(cc) - NCOLA]); p_ + (q_ - p_) * mu[(cc)]; })
        rr[i] = SHIFTED(col); kq[i] = SHIFTED(768 + col); vq[i] = SHIFTED(1536 + col);
        twd[i] = ftanh(SHIFTED(2304 + lane)); adv[i] = SHIFTED(2368 + lane); gd0[i] = fsigmoid(SHIFTED(2432 + lane)); gd1[i] = fsigmoid(SHIFTED(2496 + lane));
#undef SHIFTED
    }
    float dwv[ST] = {0.f, 0.f, 0.f, 0.f}, dav[ST] = {0.f, 0.f, 0.f, 0.f}, ggv[ST] = {0.f, 0.f, 0.f, 0.f};
    { const GAS float* W2 = (const GAS float*)(F.in[I_WW2] + col); const GAS float* A2 = (const GAS float*)(F.in[I_WA2] + col); const GAS float* G2 = (const GAS float*)(F.in[I_WG2] + col);
#pragma unroll 16
      for (int l = 0; l < 64; ++l) { const float w2 = W2[0], a2 = A2[0], g2a = G2[0], g2b = G2[64 * 768]; W2 += 768; A2 += 768; G2 += 768;
#pragma unroll
          for (int i = 0; i < ST; ++i) { dwv[i] = fmaf(rdlane(twd[i], l), w2, dwv[i]); dav[i] = fmaf(rdlane(adv[i], l), a2, dav[i]); ggv[i] = fmaf(rdlane(gd0[i], l), g2a, ggv[i]); ggv[i] = fmaf(rdlane(gd1[i], l), g2b, ggv[i]); } } }
#pragma unroll
    for (int i = 0; i < ST; ++i) {
        const int row = RP + b * ST + i;
        const float r = rr[i], k = kq[i], v = vq[i], dw = dwv[i], da = dav[i], gg = ggv[i];
        const float y0 = -(w0 + dw); const float sp = fmaxf(y0, 0.f) + __logf(1.0f + __expf(-fabsf(y0)));
        const float wdec = __expf(-__expf(-sp - 0.5f));
        const float a = fsigmoid(a0 + da);
        const float kkr = k * kkc; const float nrm = fmaxf(sqrtf(wave_sum(kkr * kkr)), 1e-12f); const float kk = kkr / nrm;
        const float kp = k * (1.0f + (a - 1.0f) * kac);
        const float asc = -kk, bsc = kk * a;
        const float bonus = wave_sum(r * kp * rkc);
        float sa = 0.f;
#pragma unroll
        for (int j = 0; j < 64; ++j) sa = fmaf(S[j], rdlane(asc, j), sa);
        const float vi = v;
        float y = 0.f;
#pragma unroll
        for (int j = 0; j < 64; ++j) { const float wj = rdlane(wdec, j), bj = rdlane(bsc, j), kj = rdlane(kp, j), rj = rdlane(r, j);
            S[j] = fmaf(S[j], wj, fmaf(sa, bj, vi * kj)); y = fmaf(S[j], rj, y); }
        const float mean = wave_sum(y) * (1.0f / 64.0f); const float dy = y - mean; const float var = wave_sum(dy * dy) * (1.0f / 64.0f);
        const float o = (dy * rsqrtf(var + 6.4e-4f) * lnw + lnb + bonus * vi) * gg;
        ((bf16*)(F.ws + WS_MIX))[(size_t)row * DM + col] = f2bf(o);
        asm volatile("" ::: "memory");
    }
    { GAS f32x4* sp = (GAS f32x4*)(F.out + O_SWKV + (((size_t)b * NH + h) * 64 + lane) * 64);
#pragma unroll
      for (int q = 0; q < 16; ++q) sp[q] = (f32x4){S[4 * q], S[4 * q + 1], S[4 * q + 2], S[4 * q + 3]}; }
    if (h == 0) { const bf16* lr = proj + (size_t)(RP + b * ST + ST - 1) * NCOLA; float* o = F.out + O_SSHIFT + (size_t)b * RWKV_COLS;
        for (int q = lane; q < RWKV_COLS; q += 64) o[q] = bf2f(lr[q]); }
}

__device__ __forceinline__ void rwkv_scan_chain(Frame& F, int bh, int w) {
    int lane_ = F.lane; asm volatile("" : "+v"(lane_)); const int lane = lane_, g = lane >> 4, c = lane & 15; const int b = bh / NH, h = bh % NH;
    f32x4 acc[4]; zero4(acc);
    const int vrow = 16 * w + c;
    auto recp = [&](int cc) -> unsigned char* { return F.ws + WS_REC + (size_t)((b * NH + h) * 128 + cc) * REC_BYTES; };
    constexpr int DPF = 4;
    bf16x8 pa[DPF][4][2]; v4u qa[DPF][2];
#define SCAN_LOAD(d, cc_) do { const unsigned char* rp_ = recp(cc_); \
        qa[d][0] = *(const GAS v4u*)(rp_ + REC_QS + (w * 64 + lane) * 32); qa[d][1] = *(const GAS v4u*)(rp_ + REC_QS + (w * 64 + lane) * 32 + 16); \
        _Pragma("unroll") for (int mt = 0; mt < 4; ++mt) _Pragma("unroll") for (int ks = 0; ks < 2; ++ks) pa[d][mt][ks] = *(const GAS bf16x8*)(rp_ + REC_PT + ((mt * 2 + ks) * 64 + lane) * 16); } while (0)
#pragma unroll
    for (int d = 0; d < DPF; ++d) SCAN_LOAD(d, d);
    for (int cc0 = 0; cc0 < 128; cc0 += DPF) {
#pragma unroll
        for (int d = 0; d < DPF; ++d) { const int cc = cc0 + d;
            unsigned char* sp_ = F.ws + WS_HB + (size_t)((b * NH + h) * 128 + cc) * 8192;
            v2u sb[4]; f32x4 nacc[4];
#pragma unroll
            for (int mt = 0; mt < 4; ++mt) sb[mt] = pack4(acc[mt]);
            nacc[0] = unpack4((v2u){qa[d][0].x, qa[d][0].y}); nacc[1] = unpack4((v2u){qa[d][0].z, qa[d][0].w}); nacc[2] = unpack4((v2u){qa[d][1].x, qa[d][1].y}); nacc[3] = unpack4((v2u){qa[d][1].z, qa[d][1].w});
#pragma unroll
            for (int mt = 0; mt < 4; ++mt) *(GAS v2u*)(sp_ + ((w * 2 + (mt >> 1)) * 64 + 16 * (2 * (mt & 1) + (g >> 1)) + c) * 16 + 8 * (g & 1)) = sb[mt];
            bf16x8 bf[2];
#pragma unroll
            for (int ks = 0; ks < 2; ++ks) { v4u t; t.x = sb[2 * ks].x; t.y = sb[2 * ks].y; t.z = sb[2 * ks + 1].x; t.w = sb[2 * ks + 1].y; bf[ks] = __builtin_bit_cast(bf16x8, t); }
#pragma unroll
            for (int mt = 0; mt < 4; ++mt) { nacc[mt] = mfma16(pa[d][mt][0], bf[0], nacc[mt]); nacc[mt] = mfma16(pa[d][mt][1], bf[1], nacc[mt]); acc[mt] = nacc[mt]; }
            if (cc + DPF < 128) SCAN_LOAD(d, cc + DPF);
        }
    }
#undef SCAN_LOAD
    float* o = F.out + O_PWKV + (((size_t)b * NH + h) * 64 + vrow) * 64;
#pragma unroll
    for (int mt = 0; mt < 4; ++mt) *(GAS f32x4*)(o + 16 * mt + 4 * g) = acc[mt];
}

__device__ __forceinline__ void rwkv_yout_item(Frame& F, int item) {
    int lane_ = F.lane; asm volatile("" : "+v"(lane_)); const int lane = lane_, g = lane >> 4, c = lane & 15; const int unit = item >> 2, w = item & 3;
    const int chunk = unit / NH, h = unit % NH, row0 = chunk * 64; const bool first = (chunk & 127) == 0;
    const unsigned char* rec = F.ws + WS_REC + (size_t)rec_index(chunk, h) * REC_BYTES; const unsigned char* srec = F.ws + WS_HB + (size_t)rec_index(chunk, h) * 8192;
    const bf16* proj = (const bf16*)(F.ws + WS_PROJ);
    f32x4 y[4], gt[4]; zero4(gt);
    { const v4u y01 = *(const GAS v4u*)(rec + REC_YL + (w * 64 + lane) * 32), y23 = *(const GAS v4u*)(rec + REC_YL + (w * 64 + lane) * 32 + 16);
      y[0] = unpack4((v2u){y01.x, y01.y}); y[1] = unpack4((v2u){y01.z, y01.w}); y[2] = unpack4((v2u){y23.x, y23.y}); y[3] = unpack4((v2u){y23.z, y23.w}); }
#pragma unroll
    for (int ks = 0; ks < 2; ++ks) { const bf16x8 a = *(const GAS bf16x8*)(rec + REC_RY + ((w * 2 + ks) * 64 + lane) * 16);
#pragma unroll
        for (int n = 0; n < 4; ++n) y[n] = mfma16(a, *(const GAS bf16x8*)(srec + ((n * 2 + ks) * 64 + lane) * 16), y[n]); }
    { const int t = 16 * w + c; const bf16* cr = proj + (size_t)(row0 + t) * NCOLA; const bf16* pr = (first && t == 0) ? nullptr : cr - NCOLA; const bf16* Wg2 = (const bf16*)(F.ws + WS_WG2);
#pragma unroll
      for (int ks = 0; ks < 4; ++ks) { const int l0 = 32 * ks + 8 * g; float x[8]; load_shift8(cr + 2432 + l0, pr ? pr + 2432 + l0 : nullptr, F.in[I_MU] + 2432 + l0, x);
#pragma unroll
          for (int i = 0; i < 8; ++i) x[i] = fsigmoid(x[i]);
          const bf16x8 ag = pack_frag(x);
#pragma unroll
          for (int n = 0; n < 4; ++n) gt[n] = mfma16(ag, *(const GAS bf16x8*)(Wg2 + (size_t)(h * 64 + 16 * n + c) * 128 + l0), gt[n]); } }
    float mean[4], rstd[4];
#pragma unroll
    for (int reg = 0; reg < 4; ++reg) { float s = (y[0][reg] + y[1][reg]) + (y[2][reg] + y[3][reg]); s = sum16(s); mean[reg] = s * (1.0f / 64.0f);
        float q = 0.f;
#pragma unroll
        for (int n = 0; n < 4; ++n) { const float d = y[n][reg] - mean[reg]; q += d * d; }
        q = sum16(q); rstd[reg] = rsqrtf(q * (1.0f / 64.0f) + 6.4e-4f); }
    bf16* mix = (bf16*)(F.ws + WS_MIX);
#pragma unroll
    for (int n = 0; n < 4; ++n) { const int col = h * 64 + 16 * n + c; const float lnw = F.in[I_LNW][col], lnb = F.in[I_LNB][col];
        const f32x4 bv = unpack4(*(const GAS v2u*)(rec + REC_BV + ((w * 64 + lane) * 4 + n) * 8));
#pragma unroll
        for (int reg = 0; reg < 4; ++reg) { const float o = ((y[n][reg] - mean[reg]) * rstd[reg] * lnw + lnb + bv[reg]) * gt[n][reg];
            mix[(size_t)(row0 + 16 * w + 4 * g + reg) * DM + col] = f2bf(o); } }
}

__device__ __forceinline__ int crow32(int r, int hi) { return (r & 3) + 8 * (r >> 2) + 4 * hi; }
template <bool MASKED, int GB>
__device__ __forceinline__ void flash32(const bf16x8 (&qf)[4], const bf16* Kp, int kstr, const bf16* VTp, int vstr, int kb_lo, int nblk, int qpos, float m0, float l0,
                                        f32x16& o0, f32x16& o1, float& lsum, int lane) {
    const int r32 = lane & 31, hh = lane >> 5;
    float m = m0, l = hh == 0 ? l0 : 0.f;
#pragma unroll
    for (int r = 0; r < 16; ++r) { o0[r] = 0.f; o1[r] = 0.f; }
    for (int b0 = 0; b0 < nblk; b0 += GB) {
        bf16x8 kf[GB][4]; v2u vf[GB][2][2][2];
#pragma unroll
        for (int i = 0; i < GB; ++i) if (b0 + i < nblk) { const int kb = kb_lo + 32 * (b0 + i);
#pragma unroll
            for (int ks = 0; ks < 4; ++ks) kf[i][ks] = *(const GAS bf16x8*)(Kp + (size_t)(kb + r32) * kstr + 16 * ks + 8 * hh);
#pragma unroll
            for (int s2 = 0; s2 < 2; ++s2)
#pragma unroll
                for (int dt = 0; dt < 2; ++dt) { const bf16* vp = VTp + (size_t)(32 * dt + r32) * vstr + kb + 16 * s2 + 4 * hh; vf[i][s2][dt][0] = *(const GAS v2u*)vp; vf[i][s2][dt][1] = *(const GAS v2u*)(vp + 8); } }
#pragma unroll
        for (int i = 0; i < GB; ++i) if (b0 + i < nblk) { const int kb = kb_lo + 32 * (b0 + i);
            f32x16 s;
#pragma unroll
            for (int r = 0; r < 16; ++r) s[r] = 0.f;
#pragma unroll
            for (int ks = 0; ks < 4; ++ks) s = mfma32(kf[i][ks], qf[ks], s);
            if (MASKED) {
#pragma unroll
                for (int r = 0; r < 16; ++r) { const int rel = qpos - (kb + crow32(r, hh)); if (rel < 0 || rel >= 128) s[r] = -1e30f; } }
            float bm = s[0];
#pragma unroll
            for (int r = 1; r < 16; ++r) bm = fmaxf(bm, s[r]);
            bm = max_x32(bm);
            const float mn = fmaxf(m, bm), alpha = __builtin_amdgcn_exp2f(m - mn); m = mn;
            float ps = 0.f;
#pragma unroll
            for (int r = 0; r < 16; ++r) { s[r] = __builtin_amdgcn_exp2f(s[r] - mn); ps += s[r]; }
            l = l * alpha + ps;
#pragma unroll
            for (int r = 0; r < 16; ++r) { o0[r] *= alpha; o1[r] *= alpha; }
#pragma unroll
            for (int s2 = 0; s2 < 2; ++s2) {
                v4u pw; pw.x = cvt_pk_bf16(s[8 * s2], s[8 * s2 + 1]); pw.y = cvt_pk_bf16(s[8 * s2 + 2], s[8 * s2 + 3]); pw.z = cvt_pk_bf16(s[8 * s2 + 4], s[8 * s2 + 5]); pw.w = cvt_pk_bf16(s[8 * s2 + 6], s[8 * s2 + 7]);
                const bf16x8 pb = __builtin_bit_cast(bf16x8, pw);
                { v4u aw; aw.x = vf[i][s2][0][0].x; aw.y = vf[i][s2][0][0].y; aw.z = vf[i][s2][0][1].x; aw.w = vf[i][s2][0][1].y; o0 = mfma32(__builtin_bit_cast(bf16x8, aw), pb, o0); }
                { v4u aw; aw.x = vf[i][s2][1][0].x; aw.y = vf[i][s2][1][0].y; aw.z = vf[i][s2][1][1].x; aw.w = vf[i][s2][1][1].y; o1 = mfma32(__builtin_bit_cast(bf16x8, aw), pb, o1); } }
        }
    }
    lsum = add_x32(l);
}
__device__ __forceinline__ void flash_store(bf16* dst  , int rstride, const f32x16& o0, const f32x16& o1, float lsum, int lane) {
    const int r32 = lane & 31, hh = lane >> 5; const float inv = 1.0f / lsum; bf16* p = dst + (size_t)r32 * rstride + 4 * hh;
#pragma unroll
    for (int k = 0; k < 4; ++k) { *(GAS v2u*)(p + 8 * k) = pack4((f32x4){o0[4 * k] * inv, o0[4 * k + 1] * inv, o0[4 * k + 2] * inv, o0[4 * k + 3] * inv});
        *(GAS v2u*)(p + 32 + 8 * k) = pack4((f32x4){o1[4 * k] * inv, o1[4 * k + 1] * inv, o1[4 * k + 2] * inv, o1[4 * k + 3] * inv}); }
}
__device__ __forceinline__ void memattn_prompt_task(Frame& F, int layer, int task) {
    int lane_ = F.lane; asm volatile("" : "+v"(lane_)); const int lane = lane_, r32 = lane & 31, hh = lane >> 5; const int hm = task & 3, qt = task >> 2;
    const int row = qt * 32 + r32, b = (qt * 32) >> 13;
    bf16x8 qf[4];
    if (layer == 0) { const bf16* qp = (const bf16*)(F.ws + WS_PROJ) + (size_t)row * NCOLA + RWKV_COLS + hm * 64; const float* gn = F.in[I_MQN];
        float x[4][8]; float ss = 0.f;
#pragma unroll
        for (int ks = 0; ks < 4; ++ks) { const v4u w = *(const GAS v4u*)(qp + 16 * ks + 8 * hh); const unsigned ww[4] = {w.x, w.y, w.z, w.w};
#pragma unroll
            for (int i = 0; i < 4; ++i) { x[ks][2 * i] = bflo(ww[i]); x[ks][2 * i + 1] = bfhi(ww[i]); ss += x[ks][2 * i] * x[ks][2 * i] + x[ks][2 * i + 1] * x[ks][2 * i + 1]; } }
        ss = add_x32(ss); const float rs = rsqrtf(ss * (1.0f / 64.0f) + 1e-6f) * C2Q;
#pragma unroll
        for (int ks = 0; ks < 4; ++ks) {
#pragma unroll
            for (int i = 0; i < 8; ++i) x[ks][i] *= rs * gn[16 * ks + 8 * hh + i];
            qf[ks] = pack_frag(x[ks]); }
    } else { const bf16* qp = (const bf16*)(F.ws + WS_Q1) + (size_t)row * DM + 768 + hm * 64;
#pragma unroll
        for (int ks = 0; ks < 4; ++ks) qf[ks] = *(const GAS bf16x8*)(qp + 16 * ks + 8 * hh); }
    const bf16* Kp = (const bf16*)(F.ws + WS_MK) + (size_t)((layer * 2 + b) * 4 + hm) * 256 * 64;
    const bf16* VTp = (const bf16*)(F.ws + WS_MVT) + (size_t)((layer * 2 + b) * 4 + hm) * 64 * 256;
    f32x16 o0, o1; float ls;
    flash32<false, 4>(qf, Kp, 64, VTp, 256, 0, 8, 0, -1e30f, 0.f, o0, o1, ls, lane);
    flash_store((bf16*)(F.ws + WS_MIX) + (size_t)(qt * 32) * DM + 768 + hm * 64, DM, o0, o1, ls, lane);
}
__device__ __forceinline__ void swa_prompt_task(Frame& F, int task) {
    int lane_ = F.lane; asm volatile("" : "+v"(lane_)); const int lane = lane_, r32 = lane & 31, hh = lane >> 5; const int hq = task % NH, qt = task / NH;
    const int b = qt >> 8, tq = (qt & 255) * 32, row = qt * 32 + r32, kvh = hq / 3;
    const bf16* qp = (const bf16*)(F.ws + WS_Q1) + (size_t)row * DM + hq * 64;
    bf16x8 qf[4];
#pragma unroll
    for (int ks = 0; ks < 4; ++ks) qf[ks] = *(const GAS bf16x8*)(qp + 16 * ks + 8 * hh);
    const bf16* Kp = (const bf16*)(F.ws + WS_K1) + (size_t)(b * T) * 256 + kvh * 64;
    const bf16* VTp = (const bf16*)(F.ws + WS_VT1) + (size_t)(b * 4 + kvh) * 64 * T;
    const int kb_lo = tq >= 128 ? tq - 128 : 0, nblk = (tq - kb_lo) / 32 + 1;
    const float sink = F.in[I_SINKS][hq] * LOG2E;
    f32x16 o0, o1; float ls;
    flash32<true, 3>(qf, Kp, 256, VTp, T, kb_lo, nblk, tq + r32, sink, 1.0f, o0, o1, ls, lane);
    flash_store((bf16*)(F.ws + WS_MIX) + (size_t)(qt * 32) * DM + hq * 64, DM, o0, o1, ls, lane);
}
template <int NQ, bool WINDOW>
__device__ __forceinline__ void small_attn(const LAS float* ql, LAS float* sc, int NKP, const float* k1, const float* v1, int kst1, int nk1, const bf16* k2, const bf16* v2, int kst2, int nk2,
                                           const float* sinkg  , bf16* out0, int ostride_q, int lane) {
    const int sub = lane >> 4, dq = lane & 15, nk = nk1 + nk2;
    f32x4 qv[NQ];
#pragma unroll
    for (int qi = 0; qi < NQ; ++qi) qv[qi] = *(const LAS f32x4*)(ql + qi * 64 + 4 * dq);
    constexpr int KBAT = NQ > 4 ? 4 : 8;
    for (int kg0 = 0; kg0 < nk1; kg0 += 4 * KBAT) { f32x4 kv[KBAT];
#pragma unroll
        for (int u = 0; u < KBAT; ++u) kv[u] = *(const GAS f32x4*)(k1 + (size_t)(kg0 + 4 * u + sub) * kst1 + 4 * dq);
#pragma unroll
        for (int u = 0; u < KBAT; ++u) { const int key = kg0 + 4 * u + sub;
#pragma unroll
            for (int qi = 0; qi < NQ; ++qi) { const f32x4 p = qv[qi] * kv[u]; const float s = sum16((p[0] + p[1]) + (p[2] + p[3])); if (dq == 0) sc[qi * NKP + key] = s; } } }
    for (int kg = nk1; kg < nk; kg += 4) { const int key = kg + sub; const f32x4 kv = unpack4(*(const GAS v2u*)(k2 + (size_t)(key - nk1) * kst2 + 4 * dq));
#pragma unroll
        for (int qi = 0; qi < NQ; ++qi) { const f32x4 p = qv[qi] * kv; const float s = sum16((p[0] + p[1]) + (p[2] + p[3])); if (dq == 0) sc[qi * NKP + key] = s; } }
    LDS_WAIT(); asm volatile("" ::: "memory");
#pragma unroll
    for (int qi = 0; qi < NQ; ++qi) { float sv[5]; const float sk_ = sinkg ? sinkg[qi >> 2] * LOG2E : -1e30f; float mx = sk_;
#pragma unroll
        for (int t = 0; t < 5; ++t) { const int key = lane + 64 * t; float s = -1e30f; if (key < nk) { s = sc[qi * NKP + key]; if (WINDOW) { const int i = qi & 3; if (key < i + 1 || key > 128 + i) s = -1e30f; } } sv[t] = s; mx = fmaxf(mx, s); }
        mx = wave_max(mx); float sum = 0.f;
#pragma unroll
        for (int t = 0; t < 5; ++t) { sv[t] = __builtin_amdgcn_exp2f(sv[t] - mx); sum += sv[t]; }
        sum = wave_sum(sum) + (sinkg ? __builtin_amdgcn_exp2f(sk_ - mx) : 0.f); const float inv = 1.0f / sum;
#pragma unroll
        for (int t = 0; t < 5; ++t) { const int key = lane + 64 * t; if (key < nk) sc[qi * NKP + key] = sv[t] * inv; } }
    LDS_WAIT(); asm volatile("" ::: "memory");
    f32x4 acc[NQ];
#pragma unroll
    for (int qi = 0; qi < NQ; ++qi) acc[qi] = (f32x4){0.f, 0.f, 0.f, 0.f};
    for (int kg0 = 0; kg0 < nk1; kg0 += 4 * KBAT) { f32x4 vv[KBAT];
#pragma unroll
        for (int u = 0; u < KBAT; ++u) vv[u] = *(const GAS f32x4*)(v1 + (size_t)(kg0 + 4 * u + sub) * kst1 + 4 * dq);
#pragma unroll
        for (int u = 0; u < KBAT; ++u) { const int key = kg0 + 4 * u + sub;
#pragma unroll
            for (int qi = 0; qi < NQ; ++qi) acc[qi] += vv[u] * sc[qi * NKP + key]; } }
    for (int kg = nk1; kg < nk; kg += 4) { const int key = kg + sub; const f32x4 vv = unpack4(*(const GAS v2u*)(v2 + (size_t)(key - nk1) * kst2 + 4 * dq));
#pragma unroll
        for (int qi = 0; qi < NQ; ++qi) acc[qi] += vv * sc[qi * NKP + key]; }
#pragma unroll
    for (int qi = 0; qi < NQ; ++qi) { f32x4 a = acc[qi];
#pragma unroll
        for (int e = 0; e < 4; ++e) { a[e] = add_x16(a[e]); a[e] = add_x32(a[e]); }
        if (sub == 0) *(GAS v2u*)(out0 + (size_t)(qi & 3) * ostride_q + (qi >> 2) * 64 + 4 * dq) = pack4(a); }
    LDS_WAIT(); asm volatile("" ::: "memory");
}
__device__ __forceinline__ void memattn_sample_task(Frame& F, int layer, int task, LAS float* wl  ) {
    int lane_ = F.lane; asm volatile("" : "+v"(lane_)); const int lane = lane_, b = task >> 2, hm = task & 3; LAS float* ql = wl; LAS float* sc = wl + 12 * 64;
#pragma unroll
    for (int i = 0; i < 4; ++i) { const int row = RP + b * ST + i; float x;
        if (layer == 0) { x = bf2f(((const bf16*)(F.ws + WS_PROJ))[(size_t)row * NCOLA + RWKV_COLS + hm * 64 + lane]); const float ss = wave_sum(x * x); x *= rsqrtf(ss * (1.0f / 64.0f) + 1e-6f) * C2Q * F.in[I_MQN][lane]; }
        else x = bf2f(((const bf16*)(F.ws + WS_Q1))[(size_t)row * DM + 768 + hm * 64 + lane]);
        ql[i * 64 + lane] = x; }
    LDS_WAIT(); asm volatile("" ::: "memory");
    const float* k1 = F.in[I_CMK] + (((size_t)layer * SB + b) * NMEM * 4 + hm) * 64; const float* v1 = F.in[I_CMV] + (((size_t)layer * SB + b) * NMEM * 4 + hm) * 64;
    small_attn<4, false>(ql, sc, 264, k1, v1, 256, 256, nullptr, nullptr, 0, 0, nullptr, (bf16*)(F.ws + WS_MIX) + (size_t)(RP + b * ST) * DM + 768 + hm * 64, DM, lane);
}
__device__ __forceinline__ void swa_sample_task(Frame& F, int task, LAS float* wl) {
    int lane_ = F.lane; asm volatile("" : "+v"(lane_)); const int lane = lane_, b = task >> 2, kvh = task & 3; LAS float* ql = wl; LAS float* sc = wl + 12 * 64;
#pragma unroll
    for (int qi = 0; qi < 12; ++qi) { const int i = qi & 3, gq = qi >> 2, hq = kvh * 3 + gq; const int row = RP + b * ST + i;
        ql[qi * 64 + lane] = bf2f(((const bf16*)(F.ws + WS_Q1))[(size_t)row * DM + hq * 64 + lane]); }
    LDS_WAIT(); asm volatile("" ::: "memory");
    const float* k1 = F.in[I_CSK] + ((size_t)b * 128 * 4 + kvh) * 64; const float* v1 = F.in[I_CSV] + ((size_t)b * 128 * 4 + kvh) * 64;
    const bf16* k2 = (const bf16*)(F.ws + WS_K1) + (size_t)(RP + b * ST) * 256 + kvh * 64; const bf16* v2 = (const bf16*)(F.ws + WS_V1) + (size_t)(RP + b * ST) * 256 + kvh * 64;
    small_attn<12, true>(ql, sc, 136, k1, v1, 256, 128, k2, v2, 256, 4, F.in[I_SINKS] + kvh * 3, (bf16*)(F.ws + WS_MIX) + (size_t)(RP + b * ST) * DM + kvh * 3 * 64, DM, lane);
}

constexpr int N_PHASES = 13;
template <int PM> __global__ void __launch_bounds__(NWAVES * 64, 2) yoco_fwd(Args args) {
    extern __shared__ __attribute__((aligned(16))) unsigned char lds[];
    Frame F;
    F.lds = (LAS unsigned char*)lds; F.lds_g = lds;
    F.wave = __builtin_amdgcn_readfirstlane((int)threadIdx.x >> 6); F.lane = mk_lane(); F.tid = F.wave * 64 + F.lane;
    F.G = gridDim.x; { const int bx = blockIdx.x; F.vcu = (F.G % 8 == 0) ? (bx % 8) * (F.G / 8) + bx / 8 : bx; }
    F.in = args.in; F.out = args.out; F.ws = args.ws; F.ctl = (gu32*)(args.ws + WS_CTL);
    for (int u = F.tid; u < (LDS_BYTES - LDSCTL_OFF) / 4; u += NWAVES * 64) ((LAS unsigned*)(F.lds + LDSCTL_OFF))[u] = 0u;
    __syncthreads();
    const int lo = args.ph_lo, hi = args.ph_hi;
    XcdBarrier bar; bar.wave0 = F.wave == 0; bar.bar = (unsigned*)(F.ctl + CW_BAR); bar.x = 0; bar.st = nullptr;
    bar = xcd_barrier_post((unsigned*)(F.ctl + CW_BAR), (volatile LAS unsigned*)(F.lds + MISC_OFF) + 8, F.wave == 0);
#define IN(k) (((PM >> (k)) & 1) && lo <= (k) && (k) < hi)
#ifndef MK_DUP
#define MK_DUP -1
#endif
#define PH_REP(k) ((MK_DUP == (k)) ? 2 : 1)
#define SEAM(k) do { if (IN(k) && IN((k) + 1)) xcd_barrier(bar); } while (0)
    const int gw = F.vcu * NWAVES + F.wave, NGW = F.G * NWAVES;
#define SSQ ((float*)(F.ws + WS_SSQ))
#define HB ((bf16*)(F.ws + WS_HB))
#define MIX ((bf16*)(F.ws + WS_MIX))
#define HH ((bf16*)(F.ws + WS_H))
#define PHASE_BEGIN() do { int z_ = 0; unsigned char* ws_ = args.ws; float* out_ = args.out; asm volatile("" : "+s"(z_), "+s"(ws_), "+s"(out_)); F.in = args.in + z_; F.ws = ws_; F.out = out_; \
                           F.lane = mk_lane(); F.tid = F.wave * 64 + F.lane; } while (0)

    if (IN(0)) for (int rep_ = 0; rep_ < PH_REP(0); ++rep_) { PHASE_BEGIN(); p0_prologue(F); } SEAM(0);

    if (IN(1)) for (int rep_ = 0; rep_ < PH_REP(1); ++rep_) { PHASE_BEGIN();
        { pg8::Gemm g{HB, (const bf16*)(F.ws + WS_WA), R, NCOLA, DM}; pg8::StaticOrder S; S.init(R, NCOLA, F.G, (int)blockIdx.x, DM);
          pg8::EpiScaleBf16<0> E{(bf16*)(F.ws + WS_PROJ), NCOLA, SSQ};
          pg8::gemm_phase<pg8::EpiScaleBf16<0>, pg8::StaticOrder, true, true>(F.lds + RING_OFF, g, S, E, F.wave, F.lane); }
#ifndef NO_MEMKV
        { pg8::Gemm g{(const bf16*)(F.ws + WS_MB), (const bf16*)(F.ws + WS_WM), 512, 1024, DM}; pg8::StaticOrder S; S.init(512, 1024, F.G, (int)blockIdx.x, DM);
          pg8::EpiMemKV E{F.ws, F.out, F.in[I_MKN]};
          pg8::gemm_phase<pg8::EpiMemKV, pg8::StaticOrder, true, true>(F.lds + RING_OFF, g, S, E, F.wave, F.lane); }
#endif
    } SEAM(1);

    if (IN(2)) for (int rep_ = 0; rep_ < ((MK_DUP == 2 || (MK_DUP >= 20 && MK_DUP < 30)) ? 2 : 1); ++rep_) { PHASE_BEGIN();
        const int half = F.wave >> 2; const int gw = F.vcu * NWAVES + F.wave, NGW = F.G * NWAVES;
        LAS unsigned char* hb = F.lds + half * PREP_HALF; LAS float* wtot = (LAS float*)(F.lds + WTOT_OFF + half * 1024);
        const int slim = (rep_ == 1 && MK_DUP == 21) ? 3 : (rep_ == 1 && MK_DUP == 22) ? 5 : 99;
        if (!(rep_ == 1 && MK_DUP == 20)) { LAS unsigned char* prow = F.lds + WTOT_OFF + 2048 + half * 512; PrepPf pf; if (F.vcu < NUNIT / 2) prep_issue(F, 2 * F.vcu + half, pf);
            for (int pi = F.vcu; pi < NUNIT / 2; pi += F.G) rwkv_prep_unit(F, 2 * pi + half, hb, wtot, prow, pf, pi + F.G < NUNIT / 2, 2 * (pi + F.G) + half, slim); }
        if (!(rep_ == 1 && (MK_DUP == 21 || MK_DUP == 22))) for (int t = gw; t < SB * NH + 2; t += NGW) {
            if (t < SB * NH) rwkv_sample_task(F, t);
            else { const int b = t - SB * NH; const bf16* lr = (const bf16*)(F.ws + WS_PROJ) + (size_t)(b * T + T - 1) * NCOLA; float* o = F.out + O_PSHIFT + (size_t)b * RWKV_COLS;
                for (int q = F.lane; q < RWKV_COLS; q += 64) o[q] = bf2f(lr[q]); } }
    } SEAM(2);

    if (IN(3)) for (int rep_ = 0; rep_ < ((MK_DUP == 30 || MK_DUP == 31) ? 2 : 1); ++rep_) { PHASE_BEGIN();
        const int nscan = NB * NH * 4;
        if (F.vcu < nscan) { if (F.wave == 0 && (rep_ == 0 || MK_DUP == 31)) rwkv_scan_chain(F, F.vcu >> 2, F.vcu & 3); }
        else if (rep_ == 0 || MK_DUP == 30) { const int ow = (F.vcu - nscan) * NWAVES + F.wave, NOW = (F.G - nscan) * NWAVES; LAS float* wl = (LAS float*)(F.lds + F.wave * 12288);
            for (int t = ow; t < 2048 + 512; t += NOW) { if (t < 2048) memattn_prompt_task(F, 0, t); else memattn_sample_task(F, 0, t - 2048, wl); } }
    } SEAM(3);

    if (IN(4)) for (int rep_ = 0; rep_ < PH_REP(4); ++rep_) { PHASE_BEGIN(); for (int it = gw; it < NUNIT * 4; it += NGW) rwkv_yout_item(F, it); } SEAM(4);

    if (IN(5)) for (int rep_ = 0; rep_ < PH_REP(5); ++rep_) { PHASE_BEGIN(); pg8::Gemm g{MIX, (const bf16*)(F.ws + WS_WOUT), R, DM, DM}; pg8::TailOrder S; S.init(F.G, (int)blockIdx.x, DM, S_K1);
        pg8::EpiResid E{F.in[I_XP], F.in[I_XS], RP, F.out + O_Y, HB, SSQ, (float*)(F.ws + WS_SLAB), S_K1};
        pg8::gemm_phase<pg8::EpiResid, pg8::TailOrder, true, true>(F.lds + RING_OFF, g, S, E, F.wave, F.lane); } SEAM(5);
    if (IN(6)) for (int rep_ = 0; rep_ < PH_REP(6); ++rep_) { PHASE_BEGIN(); finalize_sample(F, F.in[I_XS], S_K1, true); xcd_barrier(bar);
        pg8::Gemm g{HB, (const bf16*)(F.ws + WS_WUP), R, FF, DM}; pg8::StaticOrder S; S.init(R, FF, F.G, (int)blockIdx.x, DM);
        pg8::EpiScaleBf16<1> E{HH, FF, SSQ};
        pg8::gemm_phase<pg8::EpiScaleBf16<1>, pg8::StaticOrder, true, true>(F.lds + RING_OFF, g, S, E, F.wave, F.lane); } SEAM(6);
    if (IN(7)) for (int rep_ = 0; rep_ < PH_REP(7); ++rep_) { PHASE_BEGIN(); pg8::Gemm g{HH, (const bf16*)(F.ws + WS_WDN), R, DM, FF}; pg8::TailOrder S; S.init(F.G, (int)blockIdx.x, FF, S_K4);
        pg8::EpiResid E{F.out + O_Y, F.out + O_Y + (size_t)RP * DM, RP, rep_ == 0 ? F.out + O_Y : (float*)(F.ws + WS_PROJ), rep_ == 0 ? HB : nullptr, rep_ == 0 ? SSQ : nullptr, (float*)(F.ws + WS_SLAB), S_K4, rep_ == 0 ? -1 : 255};
        pg8::gemm_phase<pg8::EpiResid, pg8::TailOrder, true, true>(F.lds + RING_OFF, g, S, E, F.wave, F.lane); } SEAM(7);

    if (IN(8)) for (int rep_ = 0; rep_ < PH_REP(8); ++rep_) { PHASE_BEGIN(); finalize_sample(F, F.out + O_Y + (size_t)RP * DM, S_K4, true); xcd_barrier(bar);
        pg8::Gemm g{HB, (const bf16*)(F.ws + WS_WB), R, NCOLB, DM}; pg8::StaticOrder S; S.init(R, NCOLB, F.G, (int)blockIdx.x, DM);
        pg8::EpiL1 E{F.ws, F.out, F.in[I_QN], F.in[I_MQN] + 64, F.in[I_KN]};
        pg8::gemm_phase<pg8::EpiL1, pg8::StaticOrder, true, true>(F.lds + RING_OFF, g, S, E, F.wave, F.lane); } SEAM(8);

    if (IN(9)) for (int rep_ = 0; rep_ < PH_REP(9); ++rep_) { PHASE_BEGIN(); LAS float* wl = (LAS float*)(F.lds + F.wave * 12288);
        for (int t = gw; t < 6144 + 2048 + 512 + 512; t += NGW) {
            if (t < 6144) swa_prompt_task(F, t); else if (t < 8192) memattn_prompt_task(F, 1, t - 6144);
            else if (t < 8704) swa_sample_task(F, t - 8192, wl); else memattn_sample_task(F, 1, t - 8704, wl); }
    } SEAM(9);

    if (IN(10)) for (int rep_ = 0; rep_ < PH_REP(10); ++rep_) { PHASE_BEGIN(); pg8::Gemm g{MIX, (const bf16*)(F.ws + WS_WOUT) + (size_t)DM * DM, R, DM, DM}; pg8::TailOrder S; S.init(F.G, (int)blockIdx.x, DM, S_K1);
        pg8::EpiResid E{F.out + O_Y, F.out + O_Y + (size_t)RP * DM, RP, F.out + O_Y, HB, SSQ, (float*)(F.ws + WS_SLAB), S_K1};
        pg8::gemm_phase<pg8::EpiResid, pg8::TailOrder, true, true>(F.lds + RING_OFF, g, S, E, F.wave, F.lane); } SEAM(10);
    if (IN(11)) for (int rep_ = 0; rep_ < PH_REP(11); ++rep_) { PHASE_BEGIN(); finalize_sample(F, F.out + O_Y + (size_t)RP * DM, S_K1, true); xcd_barrier(bar);
        pg8::Gemm g{HB, (const bf16*)(F.ws + WS_WUP) + (size_t)DM * FF, R, FF, DM}; pg8::StaticOrder S; S.init(R, FF, F.G, (int)blockIdx.x, DM);
        pg8::EpiScaleBf16<1> E{HH, FF, SSQ};
        pg8::gemm_phase<pg8::EpiScaleBf16<1>, pg8::StaticOrder, true, true>(F.lds + RING_OFF, g, S, E, F.wave, F.lane); } SEAM(11);
    if (IN(12)) for (int rep_ = 0; rep_ < PH_REP(12); ++rep_) { PHASE_BEGIN(); pg8::Gemm g{HH, (const bf16*)(F.ws + WS_WDN) + (size_t)DM * FF, R, DM, FF}; pg8::TailOrder S; S.init(F.G, (int)blockIdx.x, FF, S_K4);
        pg8::EpiResid E{F.out + O_Y, F.out + O_Y + (size_t)RP * DM, RP, F.out + O_Y, nullptr, nullptr, (float*)(F.ws + WS_SLAB), S_K4};
        pg8::gemm_phase<pg8::EpiResid, pg8::TailOrder, true, true>(F.lds + RING_OFF, g, S, E, F.wave, F.lane);
        xcd_barrier(bar); finalize_sample(F, F.out + O_Y + (size_t)RP * DM, S_K4, false); }
#undef IN
#undef SEAM
#undef SSQ
#undef HB
#undef MIX
#undef HH
#undef PHASE_BEGIN
}

template <int PM> static void launch_pm(int grid, hipStream_t stream, const Args& a) { hipLaunchKernelGGL(yoco_fwd<PM>, dim3(grid), dim3(NWAVES * 64), LDS_BYTES, stream, a); }
template <int PM> static bool set_lds() { return hipFuncSetAttribute((const void*)yoco_fwd<PM>, hipFuncAttributeMaxDynamicSharedMemorySize, LDS_BYTES) == hipSuccess; }
extern "C" void kernel_launch(void* const* d_in, const int* in_sizes, int n_in, void* d_out, int out_size, void* d_ws, size_t ws_size, hipStream_t stream) {
    static int grid = 0;
    if (grid == 0) {
        if (n_in != N_IN || (size_t)out_size != O_END || ws_size < WS_END) { fprintf(stderr, "kernel_launch: unexpected shapes (n_in %d, out %d, ws %zu < %zu)\n", n_in, out_size, ws_size, (size_t)WS_END); grid = -1; return; }
        int dev = 0, cus = 0;
        if (hipGetDevice(&dev) != hipSuccess || hipDeviceGetAttribute(&cus, hipDeviceAttributeMultiprocessorCount, dev) != hipSuccess) { grid = -1; return; }
        bool ok = true;
#if MK_ONE_LAUNCH
        ok = set_lds<0x1fff>();
#else
        ok = set_lds<1>() && set_lds<2>() && set_lds<4>() && set_lds<8>() && set_lds<16>() && set_lds<32>() && set_lds<64>() && set_lds<128>() && set_lds<256>() && set_lds<512>() && set_lds<1024>() && set_lds<2048>() && set_lds<4096>();
#endif
        if (!ok) { grid = -1; return; }
        (void)hipGetLastError();
        grid = cus;
    }
    if (grid < 0) return;
    (void)hipMemsetAsync((char*)d_ws + WS_CTL, 0, CTL_ZERO_BYTES, stream);
    Args a{};
    for (int i = 0; i < N_IN; ++i) a.in[i] = (const float*)d_in[i];
    a.out = (float*)d_out; a.ws = (unsigned char*)d_ws;
#if MK_ONE_LAUNCH
    a.ph_lo = 0; a.ph_hi = N_PHASES; launch_pm<0x1fff>(grid, stream, a);
#else
#define LP(p) a.ph_lo = (p); a.ph_hi = (p) + 1; launch_pm<(1 << (p))>(grid, stream, a);
    LP(0) LP(1) LP(2) LP(3) LP(4) LP(5) LP(6) LP(7) LP(8) LP(9) LP(10) LP(11) LP(12)
#undef LP
#endif
}
```

```cpp
#include <hip/hip_runtime.h>
#include <cstdio>
#include <cstdint>
namespace pg8 {
#define PG8_LAS __attribute__((address_space(3)))
typedef unsigned short bf16_t;
typedef short bf16x8 __attribute__((ext_vector_type(8)));
typedef float f32x4 __attribute__((ext_vector_type(4)));
typedef unsigned u32x4 __attribute__((ext_vector_type(4)));
constexpr int BM = 256, BK = 64, HALF = 128, HTB = HALF * BK * 2  , STAGE_BYTES = 8 * HTB, NXCD = 8, WGM = 8;

__host__ __device__ __forceinline__ int lds_byte(int r, int c) { const int st = (r >> 4) * 2 + (c >> 5), rr = r & 15, cc = c & 31, ob = rr * 64 + cc * 2; return st * 1024 + (ob ^ (((ob >> 9) & 1) << 5)); }
__host__ __device__ __forceinline__ void stage_rc(int b, int& R, int& C) { const int st = b / 1024, sb = b % 1024, swz = sb ^ (((sb >> 9) & 1) << 5); R = (st >> 1) * 16 + swz / 64; C = (st & 1) * 32 + (swz % 64) / 2; }
__host__ __device__ __forceinline__ int perm32(int rho) { const int n = rho >> 4, i = rho & 15; return 8 * (i >> 2) + 4 * n + (i & 3); }

struct Unit { int pm, pn, kt0, nt; };
struct Gemm { const bf16_t* A; const bf16_t* Bt; int M, N, K; };

struct StaticOrder {
    int nM, nN, nwg, G, c, ntf;
    __host__ __device__ void init(int M, int N, int G_, int c_, int K_) { nM = M / BM; nN = N / BM; nwg = nM * nN; G = G_; c = c_; ntf = K_ / BK; }
    __host__ __device__ bool next(int i, Unit& u) const {
        const long L = (long)i * G + c; if (L >= nwg) return false;
        int wgid = (int)L; { const int q = nwg / NXCD, r = nwg % NXCD, xcd = wgid % NXCD, off = wgid / NXCD; wgid = (xcd < r ? xcd * (q + 1) : r * (q + 1) + (xcd - r) * q) + off; }
        const int nig = WGM * nN, gid = wgid / nig, fm = gid * WGM, gsz = (nM - fm) < WGM ? (nM - fm) : WGM;
        u.pm = fm + ((wgid % nig) % gsz); u.pn = (wgid % nig) / gsz; u.kt0 = 0; u.nt = ntf; return true;
    }
    __device__ __forceinline__ void a_ready(const Unit&) const {}
    __device__ __forceinline__ void done(const Unit&) const {}
};
struct TailOrder {
    StaticOrder P; int S, ntf;
    __host__ __device__ void init(int G_, int c_, int K_, int S_) { P.init(64 * BM, 4 * BM, G_, c_, K_); S = S_; ntf = K_ / BK; }
    __host__ __device__ bool next(int i, Unit& u) const {
        const long L = (long)i * P.G + P.c; if (L >= 256 + 8 * S) return false;
        const int Li = (int)L; const bool prm = Li < 256;
        const int w0 = prm ? Li : 0, wg = (w0 % NXCD) * (256 / NXCD) + w0 / NXCD, nig = WGM * 4, gid = wg / nig, fm = gid * WGM;
        const int pmP = fm + ((wg % nig) % WGM), pnP = (wg % nig) / WGM;
        const int Ls = prm ? 0 : Li - 256, tile = Ls / S, sl = Ls % S, nts = ntf / S;
        u.pm = prm ? pmP : 64 + (tile >> 2); u.pn = prm ? pnP : (tile & 3); u.nt = prm ? ntf : nts; u.kt0 = prm ? 0 : sl * nts; return true;
    }
    __device__ __forceinline__ void a_ready(const Unit&) const {}
    __device__ __forceinline__ void done(const Unit&) const {}
};


typedef float f32x2_t __attribute__((ext_vector_type(2))); typedef __bf16 bf16x2_t __attribute__((ext_vector_type(2)));
__device__ __forceinline__ unsigned cvt_pk_bf16(float lo, float hi) { f32x2_t v = {lo, hi}; bf16x2_t b = __builtin_convertvector(v, bf16x2_t); return __builtin_bit_cast(unsigned, b); }
__device__ __forceinline__ u32x4 pack8(f32x4 v0, f32x4 v1) { u32x4 w; w.x = cvt_pk_bf16(v0[0], v0[1]); w.y = cvt_pk_bf16(v0[2], v0[3]); w.z = cvt_pk_bf16(v1[0], v1[1]); w.w = cvt_pk_bf16(v1[2], v1[3]); return w; }

template <int M> __device__ __forceinline__ float swz_xor(float v) { return __int_as_float(__builtin_amdgcn_ds_swizzle(__float_as_int(v), (M << 10) | 0x1f)); }
__device__ __forceinline__ float add_x32(float v) { auto r = __builtin_amdgcn_permlane32_swap(__float_as_uint(v), __float_as_uint(v), false, false); return __uint_as_float(r[0]) + __uint_as_float(r[1]); }
__device__ __forceinline__ float max_x32(float v) { auto r = __builtin_amdgcn_permlane32_swap(__float_as_uint(v), __float_as_uint(v), false, false); return fmaxf(__uint_as_float(r[0]), __uint_as_float(r[1])); }
__device__ __forceinline__ float add_x16(float v) { return v + swz_xor<16>(v); }
template <int CTRL> __device__ __forceinline__ float dpp_mov(float v) { return __int_as_float(__builtin_amdgcn_update_dpp(0, __float_as_int(v), CTRL, 0xf, 0xf, false)); }
__device__ __forceinline__ float sum16_dpp(float v) { v += dpp_mov<0xB1>(v); v += dpp_mov<0x4E>(v); v += dpp_mov<0x141>(v); v += dpp_mov<0x140>(v); return v; }
__device__ __forceinline__ float max16_dpp(float v) { v = fmaxf(v, dpp_mov<0xB1>(v)); v = fmaxf(v, dpp_mov<0x4E>(v)); v = fmaxf(v, dpp_mov<0x141>(v)); v = fmaxf(v, dpp_mov<0x140>(v)); return v; }
__device__ __forceinline__ float sum4_dpp(float v) { v += dpp_mov<0xB1>(v); v += dpp_mov<0x4E>(v); return v; }
__device__ __forceinline__ float hsum4(f32x4 a) { return (a[0] + a[1]) + (a[2] + a[3]); }
__device__ __forceinline__ float row_rstd(const float* ssq, int row) {
    const f32x4* p = (const f32x4*)(ssq + (size_t)row * 16);
    const f32x4 a = p[0], b = p[1], c = p[2], d = p[3];
    const float s = (hsum4(a) + hsum4(b)) + (hsum4(c) + hsum4(d));
    return rsqrtf(s * (1.0f / 1024.0f) + 1e-6f);
}
template <int ACT> struct EpiScaleBf16 {
    static constexpr bool PERM = true, AFTER_DRAIN = false;
    bf16_t* O; int ldc; const float* ssq;
    __device__ __forceinline__ void operator()(const f32x4 (&acc)[2][2][4][2], const Unit& u, int wr, int wc, int fr_, int fq_) const {
        int fr = fr_, fq = fq_; asm volatile("" : "+v"(fr), "+v"(fq));
        const int row0 = u.pm * BM + wr * 64 + fr, col0 = u.pn * BM + wc * 32 + 8 * fq;
#pragma unroll
        for (int ai = 0; ai < 2; ++ai)
#pragma unroll
            for (int m = 0; m < 4; ++m) { const int row = row0 + ai * HALF + m * 16; const float rs = row_rstd(ssq, row); bf16_t* rowp = O + (size_t)row * ldc + col0;
#pragma unroll
                for (int bj = 0; bj < 2; ++bj) { f32x4 v0 = acc[ai][bj][m][0] * rs, v1 = acc[ai][bj][m][1] * rs;
                    if (ACT == 1) {
#pragma unroll
                        for (int e = 0; e < 4; ++e) { const float a = fmaxf(v0[e], 0.f), b = fmaxf(v1[e], 0.f); v0[e] = a * a; v1[e] = b * b; } }
                    *(u32x4*)(rowp + bj * HALF) = pack8(v0, v1); } }
    }
};
struct EpiResid {
    static constexpr bool PERM = true, AFTER_DRAIN = false;
    const float* base; const float* base2; int split; float* out; bf16_t* hb; float* ssq_out; float* slab; int S; const bf16_t* hbase = nullptr; int omask = -1;
    __device__ __forceinline__ void operator()(const f32x4 (&acc)[2][2][4][2], const Unit& u, int wr, int wc, int fr_, int fq_) const {
        int fr = fr_, fq = fq_; asm volatile("" : "+v"(fr), "+v"(fq));
        if (slab && u.pm >= 64) {
            float* sp = slab + ((size_t)((((u.pm - 64) << 2) + u.pn) * S + u.kt0 / u.nt) << 16) + (size_t)(wr * 64 + fr) * 256 + wc * 32 + 8 * fq;
#pragma unroll
            for (int ai = 0; ai < 2; ++ai)
#pragma unroll
                for (int m = 0; m < 4; ++m)
#pragma unroll
                    for (int bj = 0; bj < 2; ++bj) { float* p = sp + (size_t)(ai * HALF + m * 16) * 256 + bj * HALF; *(f32x4*)p = acc[ai][bj][m][0]; *(f32x4*)(p + 4) = acc[ai][bj][m][1]; }
            return;
        }
        const int row0 = u.pm * BM + wr * 64 + fr, col0 = u.pn * BM + wc * 32 + 8 * fq;
#pragma unroll
        for (int ai = 0; ai < 2; ++ai)
#pragma unroll
            for (int m = 0; m < 4; ++m) { const int row = row0 + ai * HALF + m * 16;
                const float* bp = (row < split ? base + (size_t)row * 1024 : base2 + (size_t)(row - split) * 1024) + col0;
                float ss = 0.f;
#pragma unroll
                for (int bj = 0; bj < 2; ++bj) { f32x4 b0, b1;
                    if (hbase) { const u32x4 w = *(const u32x4*)(hbase + (size_t)row * 1024 + col0 + bj * HALF);
                        b0 = (f32x4){__uint_as_float(w.x << 16), __uint_as_float(w.x & 0xffff0000u), __uint_as_float(w.y << 16), __uint_as_float(w.y & 0xffff0000u)};
                        b1 = (f32x4){__uint_as_float(w.z << 16), __uint_as_float(w.z & 0xffff0000u), __uint_as_float(w.w << 16), __uint_as_float(w.w & 0xffff0000u)}; }
                    else { b0 = *(const f32x4*)(bp + bj * HALF); b1 = *(const f32x4*)(bp + bj * HALF + 4); }
                    const f32x4 h0 = b0 + acc[ai][bj][m][0], h1 = b1 + acc[ai][bj][m][1];
                    if (out) { float* op = out + (size_t)(row & omask) * 1024 + col0; *(f32x4*)(op + bj * HALF) = h0; *(f32x4*)(op + bj * HALF + 4) = h1; }
                    if (hb) *(u32x4*)(hb + (size_t)row * 1024 + col0 + bj * HALF) = pack8(h0, h1);
                    ss += hsum4(h0 * h0) + hsum4(h1 * h1); }
                if (ssq_out) { ss = add_x16(ss); ss = add_x32(ss); if (fq == 0) ssq_out[(size_t)row * 16 + u.pn * 4 + wc] = ss; }
                if (m & 1) asm volatile("" ::: "memory"); }
    }
};
template <class Epi, class Sched, bool ALIGN_EPI = false, bool SP2 = false>
__device__ __forceinline__ void gemm_phase(PG8_LAS unsigned char* lds, const Gemm g, const Sched& S, const Epi& E, int wid_in, int lane_in) {
    const int wid = wid_in, lane = lane_in, tid = wid * 64 + lane, wr = wid >> 2, wc = wid & 3, fr = lane & 15, fq = lane >> 4;
    const int K = g.K;
    unsigned voffA[2], voffB[2];
#pragma unroll
    for (int i = 0; i < 2; ++i) { int R, C; stage_rc(tid * 16 + i * 8192, R, C); const int Rb = Epi::PERM ? ((R & ~31) + perm32(R & 31)) : R;
        voffA[i] = (unsigned)(R * K + C) * 2u; voffB[i] = (unsigned)(Rb * K + C) * 2u; }
    const size_t kstep = (size_t)(BK * 2);
    const size_t hstep = (size_t)HALF * K * 2;
    const size_t tstep = 2 * hstep;
    const unsigned ldsw = (unsigned)wid * 1024u;
    const int aoff = lds_byte(wr * 64 + fr, fq * 8), boff = lds_byte(wc * 32 + fr, fq * 8);
#define PG8_SA(b, h) (((b) * 2 + (h)) * HTB)
#define PG8_SB(b, h) ((4 + (b) * 2 + (h)) * HTB)
#define PG8_STAGE(bufoff, gbase, voff) do { _Pragma("unroll") for (int _i = 0; _i < 2; ++_i) \
        __builtin_amdgcn_global_load_lds((const unsigned*)((const char*)(gbase) + (voff)[_i]), (PG8_LAS unsigned*)(lds + (bufoff) + ldsw + _i * 8192), 16, 0, 0); } while (0)
#define PG8_LDA(dst, b, h) do { _Pragma("unroll") for (int m = 0; m < 4; ++m) _Pragma("unroll") for (int k = 0; k < 2; ++k) dst[m][k] = *(const PG8_LAS bf16x8*)(lds + PG8_SA(b, h) + aoff + m * 2048 + k * 1024); } while (0)
#define PG8_LDB(dst, b, h) do { _Pragma("unroll") for (int n = 0; n < 2; ++n) _Pragma("unroll") for (int k = 0; k < 2; ++k) dst[n][k] = *(const PG8_LAS bf16x8*)(lds + PG8_SB(b, h) + boff + n * 2048 + k * 1024); } while (0)
#define PG8_MMA(ai, bj, At, Bt) do { __builtin_amdgcn_s_setprio(1); _Pragma("unroll") for (int m = 0; m < 4; ++m) _Pragma("unroll") for (int n = 0; n < 2; ++n) _Pragma("unroll") for (int k = 0; k < 2; ++k) \
        acc[ai][bj][m][n] = __builtin_amdgcn_mfma_f32_16x16x32_bf16(Bt[n][k], At[m][k], acc[ai][bj][m][n], 0, 0, 0); __builtin_amdgcn_s_setprio(0); } while (0)
#define PG8_WAIT_V(n) asm volatile("s_waitcnt vmcnt(" #n ")" ::: "memory")
#define PG8_WAIT_L(n) asm volatile("s_waitcnt lgkmcnt(" #n ")" ::: "memory")
#define PG8_BAR __builtin_amdgcn_s_barrier()
#define PG8_SCHED __builtin_amdgcn_sched_barrier(0)
    Unit cur, nxt; int ui = 0;
    if (!S.next(0, cur)) return;
    f32x4 acc[2][2][4][2];
#pragma unroll
    for (int a = 0; a < 2; ++a)
#pragma unroll
        for (int b = 0; b < 2; ++b)
#pragma unroll
            for (int m = 0; m < 4; ++m)
#pragma unroll
                for (int n = 0; n < 2; ++n) acc[a][b][m][n] = (f32x4){0.f, 0.f, 0.f, 0.f};
    bf16x8 At[4][2], B0[2][2], B1[2][2];
    const char* cA = (const char*)g.A + (size_t)cur.pm * tstep + (size_t)cur.kt0 * kstep; const char* cB = (const char*)g.Bt + (size_t)cur.pn * tstep + (size_t)cur.kt0 * kstep;
    S.a_ready(cur);
    if constexpr (SP2) {
        PG8_STAGE(PG8_SB(0, 0), cB, voffB); PG8_STAGE(PG8_SB(0, 1), cB + hstep, voffB); PG8_STAGE(PG8_SA(0, 0), cA, voffA); PG8_STAGE(PG8_SA(0, 1), cA + hstep, voffA);
        if (wr == 1) PG8_BAR;
        PG8_WAIT_V(2); PG8_BAR;
        PG8_STAGE(PG8_SB(1, 0), cB + kstep, voffB); PG8_STAGE(PG8_SA(1, 0), cA + kstep, voffA); PG8_STAGE(PG8_SB(1, 1), cB + hstep + kstep, voffB);
        PG8_WAIT_V(6); PG8_BAR;
    } else {
        PG8_STAGE(PG8_SB(0, 0), cB, voffB); PG8_STAGE(PG8_SA(0, 0), cA, voffA); PG8_STAGE(PG8_SB(0, 1), cB + hstep, voffB); PG8_STAGE(PG8_SA(0, 1), cA + hstep, voffA);
        if (wr == 1) PG8_BAR;
        PG8_WAIT_V(4); PG8_BAR;
        PG8_STAGE(PG8_SB(1, 0), cB + kstep, voffB); PG8_STAGE(PG8_SA(1, 0), cA + kstep, voffA); PG8_STAGE(PG8_SB(1, 1), cB + hstep + kstep, voffB);
        PG8_WAIT_V(6); PG8_BAR;
    }
    for (;;) {
        const bool has_next = S.next(ui + 1, nxt);
        const char* nA = has_next ? (const char*)g.A + (size_t)nxt.pm * tstep + (size_t)nxt.kt0 * kstep : cA; const char* nB = has_next ? (const char*)g.Bt + (size_t)nxt.pn * tstep + (size_t)nxt.kt0 * kstep : cB;
        const int nt = cur.nt;
        for (int t = 0; t < nt; t += 2) {
            const bool last = (t == nt - 2);
            const char* a1 = cA + (size_t)(t + 1) * kstep;
            const char* a2 = last ? nA : cA + (size_t)(t + 2) * kstep; const char* b2 = last ? nB : cB + (size_t)(t + 2) * kstep;
            const char* a3 = a2 + kstep; const char* b3 = b2 + kstep;
            if (last && has_next) S.a_ready(nxt);
            if constexpr (SP2) {
            PG8_LDB(B0, 0, 0); PG8_LDB(B1, 0, 1); PG8_SCHED; PG8_LDA(At, 0, 0); PG8_STAGE(PG8_SA(1, 1), a1 + hstep, voffA);
            PG8_WAIT_V(8); PG8_WAIT_L(0); PG8_BAR; PG8_MMA(0, 0, At, B0); PG8_MMA(0, 1, At, B1); PG8_BAR; PG8_SCHED;
            PG8_LDA(At, 0, 1); PG8_STAGE(PG8_SB(0, 0), b2, voffB); PG8_STAGE(PG8_SB(0, 1), b2 + hstep, voffB); PG8_STAGE(PG8_SA(0, 0), a2, voffA);
            PG8_WAIT_V(8); PG8_WAIT_L(0); PG8_BAR; PG8_MMA(1, 0, At, B0); PG8_MMA(1, 1, At, B1); PG8_BAR; PG8_SCHED;
            PG8_LDB(B0, 1, 0); PG8_LDB(B1, 1, 1); PG8_SCHED; PG8_LDA(At, 1, 0); PG8_STAGE(PG8_SA(0, 1), a2 + hstep, voffA);
            PG8_WAIT_V(8); PG8_WAIT_L(0); PG8_BAR; PG8_MMA(0, 0, At, B0); PG8_MMA(0, 1, At, B1); PG8_BAR; PG8_SCHED;
            PG8_LDA(At, 1, 1); PG8_STAGE(PG8_SB(1, 0), b3, voffB); PG8_STAGE(PG8_SB(1, 1), b3 + hstep, voffB); PG8_STAGE(PG8_SA(1, 0), a3, voffA);
            PG8_WAIT_V(8); PG8_WAIT_L(0); PG8_BAR; PG8_MMA(1, 0, At, B0); PG8_MMA(1, 1, At, B1); PG8_BAR; PG8_SCHED;
            } else {
            PG8_LDB(B0, 0, 0); PG8_SCHED; PG8_LDA(At, 0, 0); PG8_STAGE(PG8_SA(1, 1), a1 + hstep, voffA);
            PG8_WAIT_L(8); PG8_BAR; PG8_WAIT_L(0); PG8_MMA(0, 0, At, B0); PG8_BAR; PG8_SCHED;
            PG8_LDB(B1, 0, 1); PG8_STAGE(PG8_SB(0, 0), b2, voffB);
            PG8_BAR; PG8_WAIT_L(0); PG8_MMA(0, 1, At, B1); PG8_BAR;
            PG8_LDA(At, 0, 1); PG8_STAGE(PG8_SA(0, 0), a2, voffA);
            PG8_BAR; PG8_WAIT_L(0); PG8_MMA(1, 0, At, B0); PG8_BAR; PG8_SCHED;
            PG8_STAGE(PG8_SB(0, 1), b2 + hstep, voffB);
            PG8_WAIT_V(6); PG8_BAR; PG8_MMA(1, 1, At, B1); PG8_BAR;
            PG8_LDB(B0, 1, 0); PG8_SCHED; PG8_LDA(At, 1, 0); PG8_STAGE(PG8_SA(0, 1), a2 + hstep, voffA);
            PG8_WAIT_L(8); PG8_BAR; PG8_WAIT_L(0); PG8_MMA(0, 0, At, B0); PG8_BAR; PG8_SCHED;
            PG8_LDB(B1, 1, 1); PG8_STAGE(PG8_SB(1, 0), b3, voffB);
            PG8_BAR; PG8_WAIT_L(0); PG8_MMA(0, 1, At, B1); PG8_BAR;
            PG8_LDA(At, 1, 1); PG8_STAGE(PG8_SA(1, 0), a3, voffA);
            PG8_BAR; PG8_WAIT_L(0); PG8_MMA(1, 0, At, B0); PG8_BAR; PG8_SCHED;
            PG8_STAGE(PG8_SB(1, 1), b3 + hstep, voffB);
            PG8_WAIT_V(6); PG8_BAR; PG8_MMA(1, 1, At, B1); PG8_BAR;
            }
        }
        if constexpr (ALIGN_EPI) { if (wr == 0) PG8_BAR; }
        if constexpr (!Epi::AFTER_DRAIN) { E(acc, cur, wr, wc, fr, fq); S.done(cur); }
        if (!has_next) break;
#pragma unroll
        for (int a = 0; a < 2; ++a)
#pragma unroll
            for (int b = 0; b < 2; ++b)
#pragma unroll
                for (int m = 0; m < 4; ++m)
#pragma unroll
                    for (int n = 0; n < 2; ++n) acc[a][b][m][n] = (f32x4){0.f, 0.f, 0.f, 0.f};
        cur = nxt; cA = nA; cB = nB; ++ui;
        if constexpr (ALIGN_EPI) { if (wr == 1) PG8_BAR; }
    }
    PG8_WAIT_V(0);
    if constexpr (!ALIGN_EPI) { if (wr == 0) PG8_BAR; }
    PG8_BAR;
    if constexpr (Epi::AFTER_DRAIN) { E.fused(acc, cur, wr, wc, fr, fq, lds, wid, lane); S.done(cur); }
#undef PG8_SA
#undef PG8_SB
#undef PG8_STAGE
#undef PG8_LDA
#undef PG8_LDB
#undef PG8_MMA
#undef PG8_WAIT_V
#undef PG8_WAIT_L
#undef PG8_BAR
#undef PG8_SCHED
}
}

constexpr int NWAVES = 8;
#ifndef MK_ONE_LAUNCH
#define MK_ONE_LAUNCH 1
#endif
constexpr int DM = 1024, RP = 16384  , RS = 512  , R = RP + RS, T = 8192, NB = 2, SB = 128, ST = 4;
constexpr int NCOLA = 2816, RWKV_COLS = 2560, NH = 12, HD = 64, FF = 4096, NCOLB = 1536, NMEM = 256;
constexpr int NCHUNK = RP / 64  , NUNIT = NCHUNK * NH  ;
constexpr float C2Q = 0.125f * 1.4426950408889634f;
constexpr float LOG2E = 1.4426950408889634f;
enum { I_XP = 0, I_XS, I_SSHIFT, I_SWKV, I_CSK, I_CSV, I_CMK, I_CMV, I_MEMP, I_NMIX, I_NMLP, I_WOUT, I_WUP, I_WDN, I_MNORM, I_WMKV, I_MQN, I_MKN,
       I_WINA, I_MU, I_WW2, I_W0, I_WA2, I_A0, I_WG2, I_KK, I_KA, I_RK, I_LNW, I_LNB, I_WINB, I_QN, I_SINKS, I_KVN, I_WKV, I_KN, N_IN };
constexpr size_t O_Y = 0, O_PSHIFT = (size_t)R * DM, O_PWKV = O_PSHIFT + 2 * RWKV_COLS, O_PSK = O_PWKV + 2 * 12 * 4096, O_PSV = O_PSK + 2 * 128 * 256,
                 O_PMK = O_PSV + 2 * 128 * 256, O_PMV = O_PMK + 2 * 2 * 256 * 256, O_SSHIFT = O_PMV + 2 * 2 * 256 * 256, O_SWKV = O_SSHIFT + (size_t)SB * RWKV_COLS,
                 O_SSK = O_SWKV + (size_t)SB * 12 * 4096, O_SSV = O_SSK + (size_t)SB * 128 * 256, O_END = O_SSV + (size_t)SB * 128 * 256;
constexpr size_t al256(size_t x) { return (x + 255) & ~(size_t)255; }
constexpr size_t WS_CTL = 0, CTL_ZERO_BYTES = 1u << 20;
constexpr size_t WS_WA = CTL_ZERO_BYTES;
constexpr size_t WS_WOUT = WS_WA + (size_t)NCOLA * DM * 2;
constexpr size_t WS_WUP = WS_WOUT + (size_t)2 * DM * DM * 2;
constexpr size_t WS_WDN = WS_WUP + (size_t)2 * FF * DM * 2;
constexpr size_t WS_WB = WS_WDN + (size_t)2 * FF * DM * 2;
constexpr size_t WS_WM = WS_WB + (size_t)NCOLB * DM * 2;
constexpr size_t WS_WW2 = WS_WM + (size_t)DM * DM * 2;
constexpr size_t WS_WA2 = WS_WW2 + (size_t)768 * 64 * 2;
constexpr size_t WS_WG2 = WS_WA2 + (size_t)768 * 64 * 2;
constexpr size_t WS_ROPE = WS_WG2 + (size_t)768 * 128 * 2;
constexpr size_t WS_SSQ = al256(WS_ROPE + (size_t)8196 * 64 * 4);
constexpr size_t WS_SSQM = WS_SSQ + (size_t)R * 16 * 4;
constexpr size_t WS_MB = WS_SSQM + (size_t)512 * 16 * 4;
constexpr size_t WS_MK = WS_MB + (size_t)512 * DM * 2;
constexpr size_t WS_MVT = WS_MK + (size_t)2 * 2 * 4 * 256 * 64 * 2;
constexpr size_t WS_HB = WS_MVT + (size_t)2 * 2 * 4 * 256 * 64 * 2;
constexpr size_t WS_MIX = WS_HB + (size_t)R * DM * 2;
constexpr size_t WS_BIG = WS_MIX + (size_t)R * DM * 2;
constexpr size_t WS_PROJ = WS_BIG;
constexpr size_t WS_REC = WS_PROJ + (size_t)R * NCOLA * 2;
constexpr size_t REC_BYTES = 5 * 8192;
constexpr size_t WS_END0 = WS_REC + (size_t)NUNIT * REC_BYTES;
constexpr size_t WS_H = WS_BIG;
constexpr size_t WS_END1 = WS_H + (size_t)R * FF * 2;
constexpr size_t WS_SLAB = WS_BIG + ((size_t)160 << 20);
constexpr int S_K1 = 4, S_K4 = 16;
constexpr size_t WS_Q1 = WS_BIG;
constexpr size_t WS_K1 = WS_Q1 + (size_t)R * DM * 2;
constexpr size_t WS_V1 = WS_K1 + (size_t)R * 256 * 2;
constexpr size_t WS_VT1 = WS_V1 + (size_t)R * 256 * 2;
constexpr size_t WS_END = WS_END0 > WS_END1 ? WS_END0 : WS_END1;
static_assert(WS_VT1 + (size_t)2 * 4 * 64 * 8192 * 2 <= WS_END && WS_END1 <= WS_SLAB && WS_SLAB + ((size_t)32 << 20) <= WS_END, "ws map");
constexpr int CW_BAR = 4096;
constexpr int RING_OFF = 0, RING_BYTES = 131072, PREP_HALF = 73728, LDSCTL_OFF = 147456, MISC_OFF = LDSCTL_OFF + 320, WTOT_OFF = LDSCTL_OFF + 1024, LDS_BYTES = LDSCTL_OFF + 4096;

#define GAS __attribute__((address_space(1)))
#define LAS __attribute__((address_space(3)))
typedef unsigned short bf16;
typedef unsigned v4u __attribute__((ext_vector_type(4)));
typedef unsigned v2u __attribute__((ext_vector_type(2)));
typedef float f32x4 __attribute__((ext_vector_type(4)));
typedef float f32x16 __attribute__((ext_vector_type(16)));
typedef short bf16x8 __attribute__((ext_vector_type(8)));
typedef short bf16x4 __attribute__((ext_vector_type(4)));
typedef GAS unsigned gu32;
#define RLX_AGENT __ATOMIC_RELAXED, __HIP_MEMORY_SCOPE_AGENT
#define LDS_WAIT() asm volatile("s_waitcnt lgkmcnt(0)" ::: "memory")
#define VM_WAIT() asm volatile("s_waitcnt vmcnt(0)" ::: "memory")
using pg8::cvt_pk_bf16;
__device__ __forceinline__ int mk_lane() { int l; asm volatile("v_mbcnt_lo_u32_b32 %0, -1, 0\n\tv_mbcnt_hi_u32_b32 %0, -1, %0" : "=v"(l)); return l; }
__device__ __forceinline__ float bf2f(unsigned v) { return __uint_as_float(v << 16); }
__device__ __forceinline__ float bflo(unsigned w) { return __uint_as_float(w << 16); }
__device__ __forceinline__ float bfhi(unsigned w) { return __uint_as_float(w & 0xffff0000u); }
__device__ __forceinline__ bf16 f2bf(float f) { return (bf16)(cvt_pk_bf16(f, 0.f) & 0xffffu); }
__device__ __forceinline__ v2u pack4(f32x4 v) { v2u w; w.x = cvt_pk_bf16(v[0], v[1]); w.y = cvt_pk_bf16(v[2], v[3]); return w; }
__device__ __forceinline__ f32x4 unpack4(v2u w) { return (f32x4){bflo(w.x), bfhi(w.x), bflo(w.y), bfhi(w.y)}; }
__device__ __forceinline__ f32x4 mfma16(bf16x8 a, bf16x8 b, f32x4 c) { return __builtin_amdgcn_mfma_f32_16x16x32_bf16(a, b, c, 0, 0, 0); }
__device__ __forceinline__ f32x16 mfma32(bf16x8 a, bf16x8 b, f32x16 c) { return __builtin_amdgcn_mfma_f32_32x32x16_bf16(a, b, c, 0, 0, 0); }
using pg8::swz_xor; using pg8::add_x32; using pg8::max_x32; using pg8::add_x16; using pg8::sum16_dpp; using pg8::max16_dpp; using pg8::sum4_dpp;
__device__ __forceinline__ float sum16(float v) { return sum16_dpp(v); }
__device__ __forceinline__ float wave_sum(float v) { v = sum16_dpp(v); v = add_x16(v); return add_x32(v); }
__device__ __forceinline__ float wave_max(float v) { v = max16_dpp(v); v = fmaxf(v, swz_xor<16>(v)); return max_x32(v); }
__device__ __forceinline__ float fsigmoid(float x) { return 1.0f / (1.0f + __expf(-x)); }
__device__ __forceinline__ float ftanh(float x) { const float e = __expf(2.0f * x); return 1.0f - 2.0f / (e + 1.0f); }
namespace pg8 {
__device__ __forceinline__ void head_norm(f32x4 (&x)[2][2], const float* gain, int fq) {
    float ss = 0.f;
#pragma unroll
    for (int bj = 0; bj < 2; ++bj)
#pragma unroll
        for (int n = 0; n < 2; ++n) ss += hsum4(x[bj][n] * x[bj][n]);
    ss = add_x16(ss); ss = add_x32(ss);
    const float rs = rsqrtf(ss * (1.0f / 64.0f) + 1e-6f);
#pragma unroll
    for (int bj = 0; bj < 2; ++bj)
#pragma unroll
        for (int n = 0; n < 2; ++n) { const f32x4 g = *(const f32x4*)(gain + 32 * bj + 8 * fq + 4 * n); x[bj][n] = x[bj][n] * rs * g; }
}
__device__ __forceinline__ void head_rope(f32x4 (&x)[2][2], const float* cs  , int fq) {
#pragma unroll
    for (int n = 0; n < 2; ++n) { const f32x4 t0 = *(const f32x4*)(cs + 2 * (8 * fq + 4 * n)), t1 = *(const f32x4*)(cs + 2 * (8 * fq + 4 * n) + 4);
        const f32x4 cc = {t0[0], t0[2], t1[0], t1[2]}, sn = {t0[1], t0[3], t1[1], t1[3]};
        const f32x4 x1 = x[0][n], x2 = x[1][n]; x[0][n] = x1 * cc - x2 * sn; x[1][n] = x2 * cc + x1 * sn; }
}
struct EpiL1 {
    static constexpr bool PERM = true, AFTER_DRAIN = false;
    unsigned char* ws; float* outp; const float* g_q; const float* g_mq; const float* g_k;
    __device__ __forceinline__ void operator()(const f32x4 (&acc)[2][2][4][2], const Unit& u, int wr, int wc, int fr_, int fq_) const {
        int fr = fr_, fq = fq_; asm volatile("" : "+v"(fr), "+v"(fq));
        const float* ssq = (const float*)(ws + WS_SSQ); const float* rope = (const float*)(ws + WS_ROPE); const float c2 = C2Q;
        bf16_t* Q1 = (bf16_t*)(ws + WS_Q1); bf16_t* K1 = (bf16_t*)(ws + WS_K1); bf16_t* V1 = (bf16_t*)(ws + WS_V1); bf16_t* VT1 = (bf16_t*)(ws + WS_VT1);
        float* p_k = outp + O_PSK; float* p_v = outp + O_PSV; float* s_k = outp + O_SSK; float* s_v = outp + O_SSV;
        const int H = u.pn * 4 + wc, row0 = u.pm * BM + wr * 64 + fr;
#pragma unroll
        for (int ai = 0; ai < 2; ++ai)
#pragma unroll
            for (int m = 0; m < 4; ++m) { const int row = row0 + ai * HALF + m * 16; const float rs = row_rstd(ssq, row);
                const int pidx = row < 16384 ? (row & 8191) : 8192 + ((row - 16384) & 3);
                f32x4 x[2][2];
#pragma unroll
                for (int bj = 0; bj < 2; ++bj)
#pragma unroll
                    for (int n = 0; n < 2; ++n) x[bj][n] = acc[ai][bj][m][n] * rs;
                if (H < 16) {
                    head_norm(x, H < 12 ? g_q : g_mq, fq);
                    if (H < 12) head_rope(x, rope + (size_t)pidx * 64, fq);
#pragma unroll
                    for (int bj = 0; bj < 2; ++bj) *(u32x4*)(Q1 + (size_t)row * 1024 + H * 64 + 32 * bj + 8 * fq) = pack8(x[bj][0] * c2, x[bj][1] * c2);
                } else {
                    const int kh = (H - 16) & 3; const bool isk = H < 20;
                    if (isk) { head_norm(x, g_k, fq); head_rope(x, rope + (size_t)pidx * 64, fq); }
                    bf16_t* dst = isk ? K1 : V1;
#pragma unroll
                    for (int bj = 0; bj < 2; ++bj) *(u32x4*)(dst + (size_t)row * 256 + kh * 64 + 32 * bj + 8 * fq) = pack8(x[bj][0], x[bj][1]);
                    if (!isk && row < 16384) {
                        const int b = row >> 13, t = row & 8191;
#pragma unroll
                        for (int bj = 0; bj < 2; ++bj)
#pragma unroll
                            for (int n = 0; n < 2; ++n)
#pragma unroll
                                for (int e = 0; e < 4; ++e) { const int d = 32 * bj + 8 * fq + 4 * n + e; VT1[((size_t)(b * 4 + kh) * 64 + d) * 8192 + t] = (bf16_t)(cvt_pk_bf16(x[bj][n][e], 0.f) & 0xffffu); } }
                    float* o = nullptr;
                    if (row < 16384) { const int b = row >> 13, t = row & 8191; if (t >= 8064) o = (isk ? p_k : p_v) + ((size_t)(b * 128 + (t - 8064)) * 4 + kh) * 64; }
                    else { const int b = (row - 16384) >> 2, i = (row - 16384) & 3; o = (isk ? s_k : s_v) + ((size_t)(b * 128 + 124 + i) * 4 + kh) * 64; }
                    if (o) {
#pragma unroll
                        for (int bj = 0; bj < 2; ++bj) { *(f32x4*)(o + 32 * bj + 8 * fq) = x[bj][0]; *(f32x4*)(o + 32 * bj + 8 * fq + 4) = x[bj][1]; } }
                }
                asm volatile("" ::: "memory");
            }
    }
};
struct EpiMemKV {
    static constexpr bool PERM = true, AFTER_DRAIN = false;
    unsigned char* ws; float* outp; const float* g_k  ;
    __device__ __forceinline__ void operator()(const f32x4 (&acc)[2][2][4][2], const Unit& u, int wr, int wc, int fr_, int fq_) const {
        int fr = fr_, fq = fq_; asm volatile("" : "+v"(fr), "+v"(fq));
        const float* ssq = (const float*)(ws + WS_SSQM); float* p_k = outp + O_PMK; float* p_v = outp + O_PMV; bf16_t* MK = (bf16_t*)(ws + WS_MK)  ; bf16_t* MVT = (bf16_t*)(ws + WS_MVT)  ;
        const int H = u.pn * 4 + wc, l = H >> 3, isv = (H >> 2) & 1, hh = H & 3, row0 = u.pm * BM + wr * 64 + fr;
#pragma unroll
        for (int ai = 0; ai < 2; ++ai)
#pragma unroll
            for (int m = 0; m < 4; ++m) { const int row = row0 + ai * HALF + m * 16; const float rs = row_rstd(ssq, row); const int b = row >> 8, mm = row & 255;
                f32x4 x[2][2];
#pragma unroll
                for (int bj = 0; bj < 2; ++bj)
#pragma unroll
                    for (int n = 0; n < 2; ++n) x[bj][n] = acc[ai][bj][m][n] * rs;
                if (!isv) head_norm(x, g_k + l * 64, fq);
                float* o = (isv ? p_v : p_k) + ((((size_t)l * 2 + b) * 256 + mm) * 4 + hh) * 64;
#pragma unroll
                for (int bj = 0; bj < 2; ++bj) { *(f32x4*)(o + 32 * bj + 8 * fq) = x[bj][0]; *(f32x4*)(o + 32 * bj + 8 * fq + 4) = x[bj][1]; }
                if (!isv) {
#pragma unroll
                    for (int bj = 0; bj < 2; ++bj) *(u32x4*)(MK + ((((size_t)l * 2 + b) * 4 + hh) * 256 + mm) * 64 + 32 * bj + 8 * fq) = pack8(x[bj][0], x[bj][1]);
                } else {
#pragma unroll
                    for (int bj = 0; bj < 2; ++bj)
#pragma unroll
                        for (int n = 0; n < 2; ++n)
#pragma unroll
                            for (int e = 0; e < 4; ++e) { const int d = 32 * bj + 8 * fq + 4 * n + e; MVT[((((size_t)l * 2 + b) * 4 + hh) * 64 + d) * 256 + mm] = (bf16_t)(cvt_pk_bf16(x[bj][n][e], 0.f) & 0xffffu); }
                }
                asm volatile("" ::: "memory");
            }
    }
};
}
#define XB_TMO      128
#define XB_XCNT(j)  (256  + 64 * (j))
#define XB_XSUB(j)  (1280 + 64 * (j))
#define XB_XGEN(j)  (2304 + 64 * (j))
#define XB_TOP      3328
#define XB_TOPGEN   3392
#define XCD_BAR_WORDS 3456
#define XB_SPIN_CAP (1u << 18)

__device__ __forceinline__ unsigned xb_ld(unsigned* p)              { return __hip_atomic_load(p, __ATOMIC_RELAXED, __HIP_MEMORY_SCOPE_AGENT); }
__device__ __forceinline__ unsigned xb_add(unsigned* p, unsigned v) { return __hip_atomic_fetch_add(p, v, __ATOMIC_RELAXED, __HIP_MEMORY_SCOPE_AGENT); }
__device__ __forceinline__ unsigned xb_xcc_id() { return (unsigned)__builtin_amdgcn_s_getreg((3 << 11) | 20) & 0xFu; }
#define XB_SPIN(cond, bar) do { unsigned _sp = 0; while (cond) { __builtin_amdgcn_s_sleep(1); \
    if ((++_sp & 255u) == 0u) { if (xb_ld(&(bar)[XB_TMO])) break; if (_sp > XB_SPIN_CAP) { atomicAdd(&(bar)[XB_TMO], 1u); break; } } } } while (0)

struct XcdBarrier {
    bool wave0;
    unsigned* bar; unsigned x;
    volatile LAS unsigned* st;
};

__device__ __forceinline__ XcdBarrier xcd_barrier_post(unsigned* bar, volatile LAS unsigned* st, bool wave0) {
    XcdBarrier b; b.wave0 = wave0; b.bar = bar; b.x = xb_xcc_id(); b.st = st;
    if (wave0 && mk_lane() == 0) (void)xb_add(&bar[XB_XCNT(b.x)], 1u);
    return b;
}
__device__ __forceinline__ void xcd_barrier_complete(unsigned* bar, unsigned x, unsigned& nloc, unsigned& nx) {
    const unsigned G = gridDim.x * gridDim.y * gridDim.z;
    unsigned sum, cnt, mine, sp = 0u;
    for (;;) {
        sum = 0u; cnt = 0u; mine = 0u;
#pragma unroll
        for (unsigned j = 0; j < 16; ++j) { const unsigned c = xb_ld(&bar[XB_XCNT(j)]); sum += c; cnt += (c > 0u) ? 1u : 0u; mine = (j == x) ? c : mine; }
        if (sum == G) break;
        __builtin_amdgcn_s_sleep(1);
        if ((++sp & 255u) == 0u) { if (xb_ld(&bar[XB_TMO])) break; if (sp > XB_SPIN_CAP) { atomicAdd(&bar[XB_TMO], 1u); break; } }
    }
    nloc = mine > 0u ? mine : 1u; nx = cnt > 0u ? cnt : 1u;
}

__device__ __forceinline__ void xcd_barrier(const XcdBarrier& b) {
    asm volatile("s_waitcnt vmcnt(0)" ::: "memory");
    __syncthreads();
    if (b.wave0 && mk_lane() == 0) {
        unsigned* bar = b.bar;
        __builtin_amdgcn_s_waitcnt(0);
        unsigned nloc = b.st[0], nx = b.st[1];
        if (nloc == 0u) { xcd_barrier_complete(bar, b.x, nloc, nx); b.st[0] = nloc; b.st[1] = nx; }
        const unsigned old = xb_add(&bar[XB_XSUB(b.x)], 1u);
        const unsigned gen = old / nloc;
        if (old + 1u == (gen + 1u) * nloc) {
            __builtin_amdgcn_fence(__ATOMIC_RELEASE, "agent");
            asm volatile("s_waitcnt vmcnt(0)" ::: "memory");
            const unsigned og = xb_add(&bar[XB_TOP], 1u);
            const unsigned tg = og / nx;
            if (og + 1u == (tg + 1u) * nx) xb_add(&bar[XB_TOPGEN], 1u);
            else XB_SPIN(xb_ld(&bar[XB_TOPGEN]) == tg, bar);
            __builtin_amdgcn_fence(__ATOMIC_ACQUIRE, "agent");
            xb_add(&bar[XB_XGEN(b.x)], 1u);
            asm volatile("s_waitcnt vmcnt(0)" ::: "memory");
        } else {
            XB_SPIN(xb_ld(&bar[XB_XGEN(b.x)]) == gen, bar);
            __builtin_amdgcn_fence(__ATOMIC_ACQUIRE, "agent");
            asm volatile("s_waitcnt vmcnt(0)" ::: "memory");
        }
    }
    __syncthreads();
}

struct Args { const float* in[N_IN]; float* out; unsigned char* ws; int ph_lo, ph_hi; };
struct Frame {
    LAS unsigned char* lds; unsigned char* lds_g;
    gu32* ctl;
    int tid, lane, wave, vcu, G;
    const float* const* in; float* out; unsigned char* ws;
};
__host__ __device__ __forceinline__ int wsig_inv(int nl) { return 128 * ((nl >> 5) & 1) + 32 * (nl >> 6) + (nl & 31); }

__device__ __forceinline__ void p0_transpose_item(const float* W, int K, int N, bf16* WT, int row_off, bool sig, const float* gain, LAS float* scr, int item, int lane) {
    const int nblk = N / 32, kb = item / nblk, nb = item % nblk, k0 = 64 * kb, n0 = 32 * nb;
    float tv[32];
#pragma unroll
    for (int i = 0; i < 32; ++i) { const int kk = 2 * i + (lane >> 5); tv[i] = W[(size_t)(k0 + kk) * N + n0 + (lane & 31)]; }
    if (gain) {
#pragma unroll
        for (int i = 0; i < 32; ++i) tv[i] *= gain[k0 + 2 * i + (lane >> 5)]; }
#pragma unroll
    for (int i = 0; i < 32; ++i) scr[(2 * i + (lane >> 5)) * 33 + (lane & 31)] = tv[i];
    LDS_WAIT(); asm volatile("" ::: "memory");
    const int c = lane & 7;
    int nbase = row_off + n0; if (sig) { const int ng = row_off + n0; nbase = (ng & ~255) + wsig_inv(ng & 255); }
#pragma unroll
    for (int j = 0; j < 4; ++j) { const int n = (lane >> 3) + 8 * j; const LAS float* s = scr + (8 * c) * 33 + n;
        v4u o; o.x = cvt_pk_bf16(s[0 * 33], s[1 * 33]); o.y = cvt_pk_bf16(s[2 * 33], s[3 * 33]); o.z = cvt_pk_bf16(s[4 * 33], s[5 * 33]); o.w = cvt_pk_bf16(s[6 * 33], s[7 * 33]);
        *(GAS v4u*)(WT + (size_t)(nbase + n) * K + k0 + 8 * c) = o; }
    LDS_WAIT(); asm volatile("" ::: "memory");
}
__device__ __forceinline__ void row_to_bf16_ssq(const float* xrow, bf16* orow, float* ssqrow, int lane) {
    const GAS f32x4* xr = (const GAS f32x4*)xrow + lane;
    f32x4 v[4]; float s = 0.f;
#pragma unroll
    for (int j = 0; j < 4; ++j) { v[j] = xr[64 * j]; s += (v[j].x * v[j].x + v[j].y * v[j].y) + (v[j].z * v[j].z + v[j].w * v[j].w); }
    s = wave_sum(s);
    GAS v2u* o8 = (GAS v2u*)orow + lane;
#pragma unroll
    for (int j = 0; j < 4; ++j) o8[64 * j] = pack4(v[j]);
    if (lane < 16) ssqrow[lane] = lane == 0 ? s : 0.f;
}
__device__ __forceinline__ void p0_prologue(Frame& F) {
    LAS float* scr = (LAS float*)(F.lds + RING_OFF + F.wave * 16384);
    const int gw = F.vcu * NWAVES + F.wave, NGW = F.G * NWAVES;
    unsigned char* ws = F.ws;
    int it = gw;
#define P0_JOB(Wp, K_, N_, WTp, roff, sg, gn) { const int ni = ((K_) / 64) * ((N_) / 32); for (; it < ni; it += NGW) p0_transpose_item((Wp), (K_), (N_), (WTp), (roff), (sg), (gn), scr, it, F.lane); it -= ni; }
    P0_JOB(F.in[I_WINA], DM, NCOLA, (bf16*)(ws + WS_WA), 0, false, F.in[I_NMIX]);
    P0_JOB(F.in[I_WOUT], DM, DM, (bf16*)(ws + WS_WOUT), 0, false, nullptr);
    P0_JOB(F.in[I_WOUT] + (size_t)DM * DM, DM, DM, (bf16*)(ws + WS_WOUT) + (size_t)DM * DM, 0, false, nullptr);
    P0_JOB(F.in[I_WUP], DM, FF, (bf16*)(ws + WS_WUP), 0, false, F.in[I_NMLP]);
    P0_JOB(F.in[I_WUP] + (size_t)DM * FF, DM, FF, (bf16*)(ws + WS_WUP) + (size_t)DM * FF, 0, false, F.in[I_NMLP] + DM);
    P0_JOB(F.in[I_WDN], FF, DM, (bf16*)(ws + WS_WDN), 0, false, nullptr);
    P0_JOB(F.in[I_WDN] + (size_t)DM * FF, FF, DM, (bf16*)(ws + WS_WDN) + (size_t)DM * FF, 0, false, nullptr);
    P0_JOB(F.in[I_WINB], DM, DM, (bf16*)(ws + WS_WB), 0, true, F.in[I_NMIX] + DM);
    P0_JOB(F.in[I_WKV], DM, 512, (bf16*)(ws + WS_WB), 1024, true, F.in[I_KVN]);
    P0_JOB(F.in[I_WMKV], DM, 512, (bf16*)(ws + WS_WM), 0, true, F.in[I_MNORM]);
    P0_JOB(F.in[I_WMKV] + (size_t)DM * 512, DM, 512, (bf16*)(ws + WS_WM), 512, true, F.in[I_MNORM] + DM);
    P0_JOB(F.in[I_WW2], 64, 768, (bf16*)(ws + WS_WW2), 0, false, nullptr);
    P0_JOB(F.in[I_WA2], 64, 768, (bf16*)(ws + WS_WA2), 0, false, nullptr);
    P0_JOB(F.in[I_WG2], 128, 768, (bf16*)(ws + WS_WG2), 0, false, nullptr);
#undef P0_JOB
    for (int m = gw; m < R; m += NGW) { const float* xr = m < RP ? F.in[I_XP] + (size_t)m * DM : F.in[I_XS] + (size_t)(m - RP) * DM;
        row_to_bf16_ssq(xr, (bf16*)(ws + WS_HB) + (size_t)m * DM, (float*)(ws + WS_SSQ) + (size_t)m * 16, F.lane); }
    for (int m = gw; m < 512; m += NGW) row_to_bf16_ssq(F.in[I_MEMP] + (size_t)m * DM, (bf16*)(ws + WS_MB) + (size_t)m * DM, (float*)(ws + WS_SSQM) + (size_t)m * 16, F.lane);
    { const int gt = F.vcu * NWAVES * 64 + F.tid, NGT = F.G * NWAVES * 64; float* rt = (float*)(ws + WS_ROPE);
      for (int i = gt; i < 8196 * 32; i += NGT) { const int p = i >> 5, f = i & 31; const float pos = (float)(p < 8192 ? p : 16384 + (p - 8192));
          double fq_ = 1.0; for (int k = 0; k < f; ++k) fq_ *= 0.74989420933245582730; const float ang = pos * (float)fq_; const double rev = (double)ang * 0.15915494309189535; const float fr = (float)(rev - floor(rev));
          rt[2 * i] = __builtin_amdgcn_cosf(fr); rt[2 * i + 1] = __builtin_amdgcn_sinf(fr); } }
    { const int gt = F.vcu * NWAVES * 64 + F.tid, NGT = F.G * NWAVES * 64; const int per = 124 * 256 / 4;
      for (int i = gt; i < SB * per; i += NGT) { const int b = i / per, r = i % per;
          ((GAS f32x4*)(F.out + O_SSK + (size_t)b * 128 * 256))[r] = ((const GAS f32x4*)(F.in[I_CSK] + (size_t)b * 128 * 256 + 4 * 256))[r];
          ((GAS f32x4*)(F.out + O_SSV + (size_t)b * 128 * 256))[r] = ((const GAS f32x4*)(F.in[I_CSV] + (size_t)b * 128 * 256 + 4 * 256))[r]; } }
}

__device__ __forceinline__ void finalize_sample(Frame& F, const float* fbase  , int S, bool last) {
    const int gw = F.vcu * NWAVES + F.wave, NGW = F.G * NWAVES; const float* slab = (const float*)(F.ws + WS_SLAB);
    for (int rs = gw; rs < RS; rs += NGW) { const int row = RP + rs, tile0 = (rs >> 8) << 2, r = rs & 255; float ss = 0.f;
#pragma unroll
        for (int pn = 0; pn < 4; ++pn) { f32x4 h;
            if (fbase) h = *(const GAS f32x4*)(fbase + (size_t)rs * DM + pn * 256 + 4 * F.lane);
            else h = unpack4(*(const GAS v2u*)((const bf16*)(F.ws + WS_HB) + (size_t)row * DM + pn * 256 + 4 * F.lane));
            for (int s = 0; s < S; ++s) h += *(const GAS f32x4*)(slab + ((size_t)((tile0 + pn) * S + s) << 16) + r * 256 + 4 * F.lane);
            if (last) *(GAS f32x4*)(F.out + O_Y + (size_t)row * DM + pn * 256 + 4 * F.lane) = h;
            else *(GAS v2u*)((bf16*)(F.ws + WS_HB) + (size_t)row * DM + pn * 256 + 4 * F.lane) = pack4(h);
            ss += (h[0] * h[0] + h[1] * h[1]) + (h[2] * h[2] + h[3] * h[3]); }
        if (!last) { ss = wave_sum(ss); if (F.lane < 16) ((float*)(F.ws + WS_SSQ))[(size_t)row * 16 + F.lane] = F.lane == 0 ? ss : 0.f; } }
}

constexpr int LSTR = 144, SLOT = 64 * LSTR;
__device__ __forceinline__ int rec_index(int chunk, int h) { return ((chunk >> 7) * NH + h) * 128 + (chunk & 127); }
constexpr int REC_PT = 0, REC_QS = 8192, REC_RY = 16384, REC_YL = 24576, REC_BV = 32768;
__device__ __forceinline__ bf16x8 lfrag(const LAS unsigned char* m, int row, int k) { return *(const LAS bf16x8*)(m + row * LSTR + k * 2); }
__device__ __forceinline__ void mm_strip(f32x4 (&acc)[4], const LAS unsigned char* X, const LAS unsigned char* Y, int w, int c, int g) {
#pragma unroll
    for (int ks = 0; ks < 2; ++ks) { const bf16x8 a = lfrag(X, 16 * w + c, 32 * ks + 8 * g);
#pragma unroll
        for (int n = 0; n < 4; ++n) acc[n] = mfma16(a, lfrag(Y, 16 * n + c, 32 * ks + 8 * g), acc[n]); }
}
__device__ __forceinline__ void mm_strip2(f32x4 (&acc0)[4], f32x4 (&acc1)[4], const LAS unsigned char* X, const LAS unsigned char* Y0, const LAS unsigned char* Y1, int w, int c, int g) {
#pragma unroll
    for (int ks = 0; ks < 2; ++ks) { const bf16x8 a = lfrag(X, 16 * w + c, 32 * ks + 8 * g);
#pragma unroll
        for (int n = 0; n < 4; ++n) { acc0[n] = mfma16(a, lfrag(Y0, 16 * n + c, 32 * ks + 8 * g), acc0[n]); acc1[n] = mfma16(a, lfrag(Y1, 16 * n + c, 32 * ks + 8 * g), acc1[n]); } }
}
__device__ __forceinline__ void zero4(f32x4 (&a)[4]) {
#pragma unroll
    for (int n = 0; n < 4; ++n) a[n] = (f32x4){0.f, 0.f, 0.f, 0.f};
}
__device__ __forceinline__ void st_T(LAS unsigned char* dest, const f32x4 (&acc)[4], int w, int c, int g) {
#pragma unroll
    for (int n = 0; n < 4; ++n) *(LAS v2u*)(dest + (16 * n + c) * LSTR + (16 * w + 4 * g) * 2) = pack4(acc[n]);
}
__device__ __forceinline__ void st_T_global(unsigned char* dest  , const f32x4 (&acc)[4], int w, int c, int g) {
#pragma unroll
    for (int n = 0; n < 4; ++n) *(GAS v2u*)(dest + (16 * n + c) * 128 + (16 * w + 4 * g) * 2) = pack4(acc[n]);
}
__device__ __forceinline__ void load_shift8(const bf16* cur, const bf16* prv, const float* mu, float (&o)[8]) {
    const v4u cw = *(const GAS v4u*)cur; v4u pw = {0u, 0u, 0u, 0u}; if (prv) pw = *(const GAS v4u*)prv;
    const f32x4 m0 = *(const GAS f32x4*)mu, m1 = *(const GAS f32x4*)(mu + 4);
    const float cf[8] = {bflo(cw.x), bfhi(cw.x), bflo(cw.y), bfhi(cw.y), bflo(cw.z), bfhi(cw.z), bflo(cw.w), bfhi(cw.w)};
    const float pf[8] = {bflo(pw.x), bfhi(pw.x), bflo(pw.y), bfhi(pw.y), bflo(pw.z), bfhi(pw.z), bflo(pw.w), bfhi(pw.w)};
    const float mf[8] = {m0[0], m0[1], m0[2], m0[3], m1[0], m1[1], m1[2], m1[3]};
#pragma unroll
    for (int i = 0; i < 8; ++i) o[i] = cf[i] + (pf[i] - cf[i]) * mf[i];
}
__device__ __forceinline__ bf16x8 pack_frag(const float (&v)[8]) {
    v4u w; w.x = cvt_pk_bf16(v[0], v[1]); w.y = cvt_pk_bf16(v[2], v[3]); w.z = cvt_pk_bf16(v[4], v[5]); w.w = cvt_pk_bf16(v[6], v[7]); return __builtin_bit_cast(bf16x8, w);
}

struct PrepPf { v4u raw[3][2]; v4u prv; v4u lc[2][2], lp[2][2]; };
__device__ __forceinline__ void prep_issue(Frame& F, int unit, PrepPf& pf) {
    const int th = (F.wave & 3) * 64 + F.lane; const int chunk = unit / NH, h = unit % NH, row0 = chunk * 64; const bool first = (chunk & 127) == 0;
    const bf16* proj = (const bf16*)(F.ws + WS_PROJ);
#pragma unroll
    for (int a = 0; a < 3; ++a)
#pragma unroll
        for (int i = 0; i < 2; ++i) { const int id = th + 256 * i; pf.raw[a][i] = *(const GAS v4u*)(proj + (size_t)(row0 + (id >> 3)) * NCOLA + a * 768 + h * 64 + (id & 7) * 8); }
    pf.prv = (v4u){0u, 0u, 0u, 0u};
    if (th < 24 && !first) pf.prv = *(const GAS v4u*)(proj + (size_t)(row0 - 1) * NCOLA + (th >> 3) * 768 + h * 64 + (th & 7) * 8);
    { const int w = F.wave & 3, g = F.lane >> 4, c = F.lane & 15, t = 16 * w + c; const bf16* cr = proj + (size_t)(row0 + t) * NCOLA; const bool hp = !(first && t == 0);
#pragma unroll
      for (int a = 0; a < 2; ++a)
#pragma unroll
          for (int ks = 0; ks < 2; ++ks) { const int col = 2304 + 64 * a + 32 * ks + 8 * g; pf.lc[a][ks] = *(const GAS v4u*)(cr + col); pf.lp[a][ks] = (v4u){0u, 0u, 0u, 0u}; if (hp) pf.lp[a][ks] = *(const GAS v4u*)(cr - NCOLA + col); } }
}
__device__ __forceinline__ void shift8(v4u cw, v4u pw, const float* mu, float (&o)[8]) {
    const f32x4 m0 = *(const GAS f32x4*)mu, m1 = *(const GAS f32x4*)(mu + 4);
    const float cf[8] = {bflo(cw.x), bfhi(cw.x), bflo(cw.y), bfhi(cw.y), bflo(cw.z), bfhi(cw.z), bflo(cw.w), bfhi(cw.w)};
    const float pf_[8] = {bflo(pw.x), bfhi(pw.x), bflo(pw.y), bfhi(pw.y), bflo(pw.z), bfhi(pw.z), bflo(pw.w), bfhi(pw.w)};
    const float mf[8] = {m0[0], m0[1], m0[2], m0[3], m1[0], m1[1], m1[2], m1[3]};
#pragma unroll
    for (int i = 0; i < 8; ++i) o[i] = cf[i] + (pf_[i] - cf[i]) * mf[i];
}
#define HBAR() do { asm volatile("s_waitcnt lgkmcnt(0)" ::: "memory"); __builtin_amdgcn_s_barrier(); asm volatile("" ::: "memory"); } while (0)
__device__ __forceinline__ void rwkv_prep_unit(Frame& F, int unit, LAS unsigned char* hb, LAS float* wtot, LAS unsigned char* prow, PrepPf& pf, bool has_next, int next_unit, int stage_limit = 99) {
    int w_ = F.wave & 3, lane_ = F.lane; asm volatile("" : "+s"(w_), "+v"(lane_));
    const int w = w_, lane = lane_, g = lane >> 4, c = lane & 15;
    const int chunk = unit / NH, h = unit % NH, row0 = chunk * 64; const bool first = (chunk & 127) == 0;
    const bf16* proj = (const bf16*)(F.ws + WS_PROJ);
    unsigned char* rec = F.ws + WS_REC + (size_t)rec_index(chunk, h) * REC_BYTES;
    LAS unsigned char* const s0 = hb, * const s1 = hb + SLOT, * const s2 = hb + 2 * SLOT, * const s3 = hb + 3 * SLOT, * const s4 = hb + 4 * SLOT, * const s5 = hb + 5 * SLOT, * const s6 = hb + 6 * SLOT, * const s7 = hb + 7 * SLOT;
    float mur[4], muk[4], muv[4], w0[4], a0[4], kkc[4], kac[4], rkc[4];
#pragma unroll
    for (int n = 0; n < 4; ++n) { const int col = h * 64 + 16 * n + c; mur[n] = F.in[I_MU][col]; muk[n] = F.in[I_MU][768 + col]; muv[n] = F.in[I_MU][1536 + col];
        w0[n] = F.in[I_W0][col]; a0[n] = F.in[I_A0][col]; kkc[n] = F.in[I_KK][col]; kac[n] = F.in[I_KA][col]; rkc[n] = F.in[I_RK][col]; }
    f32x4 dw[4], da[4]; zero4(dw); zero4(da);
    { const int th = w * 64 + lane;
#pragma unroll
      for (int a = 0; a < 3; ++a)
#pragma unroll
          for (int i = 0; i < 2; ++i) { const int id = th + 256 * i; *(LAS v4u*)(hb + a * SLOT + (id >> 3) * LSTR + (id & 7) * 16) = pf.raw[a][i]; }
      if (th < 24) *(LAS v4u*)(prow + (th >> 3) * 128 + (th & 7) * 16) = pf.prv; }
    {
        const bf16* Ww2 = (const bf16*)(F.ws + WS_WW2); const bf16* Wa2 = (const bf16*)(F.ws + WS_WA2);
#pragma unroll
        for (int ks = 0; ks < 2; ++ks) { const int l0 = 32 * ks + 8 * g; float x[8];
            shift8(pf.lc[0][ks], pf.lp[0][ks], F.in[I_MU] + 2304 + l0, x);
#pragma unroll
            for (int i = 0; i < 8; ++i) x[i] = ftanh(x[i]);
            const bf16x8 aw = pack_frag(x);
            shift8(pf.lc[1][ks], pf.lp[1][ks], F.in[I_MU] + 2368 + l0, x);
            const bf16x8 aa = pack_frag(x);
#pragma unroll
            for (int n = 0; n < 4; ++n) { const size_t wo = (size_t)(h * 64 + 16 * n + c) * 64 + l0;
                dw[n] = mfma16(aw, *(const GAS bf16x8*)(Ww2 + wo), dw[n]); da[n] = mfma16(aa, *(const GAS bf16x8*)(Wa2 + wo), da[n]); } }
    }
    HBAR();
    if (has_next) prep_issue(F, next_unit, pf);
    f32x4 rt[4], kh[4], lw[4], at_[4], bt_[4], kt_[4], bh_[4], vv[4]; float gam[4]; float bon[4] = {0.f, 0.f, 0.f, 0.f}; float ssk[4] = {0.f, 0.f, 0.f, 0.f};
    f32x4 kkr[4], aa_[4], kp[4], rr[4];
    {

        const LAS unsigned char* pbase = (w == 0 && g == 0) ? prow + c * 2 : hb + (16 * w + 4 * g - 1) * LSTR + c * 2; const int pstr = (w == 0 && g == 0) ? 128 : SLOT;
        float rp[4], kpv[4], vp[4];
#pragma unroll
        for (int n = 0; n < 4; ++n) { rp[n] = bf2f(*(const LAS bf16*)(pbase + 32 * n)); kpv[n] = bf2f(*(const LAS bf16*)(pbase + pstr + 32 * n)); vp[n] = bf2f(*(const LAS bf16*)(pbase + 2 * pstr + 32 * n)); }
#pragma unroll
        for (int reg = 0; reg < 4; ++reg) { const int t = 16 * w + 4 * g + reg; const LAS unsigned char* cr = hb + t * LSTR + c * 2;
#pragma unroll
            for (int n = 0; n < 4; ++n) {
                const float r0 = bf2f(*(const LAS bf16*)(cr + 32 * n)), k0 = bf2f(*(const LAS bf16*)(cr + SLOT + 32 * n)), v0 = bf2f(*(const LAS bf16*)(cr + 2 * SLOT + 32 * n));
                const float r1 = rp[n], k1 = kpv[n], v1 = vp[n]; rp[n] = r0; kpv[n] = k0; vp[n] = v0;
                const float r = r0 + (r1 - r0) * mur[n], k = k0 + (k1 - k0) * muk[n], v = v0 + (v1 - v0) * muv[n];
                const float y = -(w0[n] + dw[n][reg]);
                const float sp = fmaxf(y, 0.f) + __logf(1.0f + __expf(-fabsf(y)));
                lw[n][reg] = -__expf(-sp - 0.5f);
                const float a = fsigmoid(a0[n] + da[n][reg]);
                aa_[n][reg] = a; kkr[n][reg] = k * kkc[n]; kp[n][reg] = k * (1.0f + (a - 1.0f) * kac[n]); rr[n][reg] = r; vv[n][reg] = v;
                ssk[reg] += kkr[n][reg] * kkr[n][reg]; bon[reg] += r * kp[n][reg] * rkc[n]; } }
    }
#pragma unroll
    for (int reg = 0; reg < 4; ++reg) { ssk[reg] = sum16(ssk[reg]); bon[reg] = sum16(bon[reg]); ssk[reg] = 1.0f / fmaxf(sqrtf(ssk[reg]), 1e-12f); }
    f32x4 Lc[4];
#pragma unroll
    for (int n = 0; n < 4; ++n) { f32x4 inc; inc[0] = lw[n][0]; inc[1] = inc[0] + lw[n][1]; inc[2] = inc[1] + lw[n][2]; inc[3] = inc[2] + lw[n][3];
        const float tot = inc[3]; const float t1 = __shfl(tot, (lane - 16) & 63), t2 = __shfl(tot, (lane - 32) & 63), t3 = __shfl(tot, (lane - 48) & 63);
        const float pre = (g >= 1 ? t1 : 0.f) + (g >= 2 ? t2 : 0.f) + (g >= 3 ? t3 : 0.f);
        Lc[n] = inc + pre; if (g == 3) wtot[w * 64 + 16 * n + c] = pre + tot; }
    HBAR();
#pragma unroll
    for (int n = 0; n < 4; ++n) { const int j = 16 * n + c; const float t0 = wtot[j], t1 = wtot[64 + j], t2 = wtot[128 + j], t3 = wtot[192 + j];
        const float base = (w >= 1 ? t0 : 0.f) + (w >= 2 ? t1 : 0.f) + (w >= 3 ? t2 : 0.f); const float LC = (t0 + t1) + (t2 + t3);
        gam[n] = __expf(LC);
#pragma unroll
        for (int reg = 0; reg < 4; ++reg) { const float L = Lc[n][reg] + base; const float eL = __expf(L), eLi = __expf(-L), eP = __expf(L - lw[n][reg]), eC = __expf(LC - L);
            const float kk = kkr[n][reg] * ssk[reg], bsc = kk * aa_[n][reg];
            at_[n][reg] = -kk * eP; rt[n][reg] = rr[n][reg] * eL; bt_[n][reg] = bsc * eLi; kt_[n][reg] = kp[n][reg] * eLi; bh_[n][reg] = bsc * eC; kh[n][reg] = kp[n][reg] * eC;
            const int t = 16 * w + 4 * g + reg;
            *(LAS bf16*)(s0 + t * LSTR + j * 2) = f2bf(at_[n][reg]); *(LAS bf16*)(s1 + t * LSTR + j * 2) = f2bf(bt_[n][reg]);
            *(LAS bf16*)(s2 + t * LSTR + j * 2) = f2bf(kt_[n][reg]); *(LAS bf16*)(s3 + t * LSTR + j * 2) = f2bf(rt[n][reg]); }
        *(LAS v2u*)(s4 + j * LSTR + (16 * w + 4 * g) * 2) = pack4(at_[n]); *(LAS v2u*)(s5 + j * LSTR + (16 * w + 4 * g) * 2) = pack4(bh_[n]); *(LAS v2u*)(s6 + j * LSTR + (16 * w + 4 * g) * 2) = pack4(vv[n]);
        f32x4 bv;
#pragma unroll
        for (int reg = 0; reg < 4; ++reg) bv[reg] = bon[reg] * vv[n][reg];
        *(GAS v2u*)(rec + REC_BV + ((w * 64 + lane) * 4 + n) * 8) = pack4(bv); }
    HBAR();
    if (stage_limit <= 3) return;
    f32x4 aN[4], aMk[4], aMbr[4], aMkr[4]; zero4(aN); zero4(aMk); zero4(aMbr); zero4(aMkr);
    mm_strip2(aN, aMk, s0, s1, s2, w, c, g);
    mm_strip(aMbr, s1, s3, w, c, g); mm_strip(aMkr, s2, s3, w, c, g);
#pragma unroll
    for (int n = 0; n < 4; ++n)
#pragma unroll
        for (int reg = 0; reg < 4; ++reg) { const int row = 16 * w + 4 * g + reg, col = 16 * n + c;
            if (!(col < row)) { aN[n][reg] = 0.f; aMk[n][reg] = 0.f; } if (!(row <= col)) { aMbr[n][reg] = 0.f; aMkr[n][reg] = 0.f; } }
    HBAR();
    LAS float* Nf = (LAS float*)s0;
#pragma unroll
    for (int n = 0; n < 4; ++n)
#pragma unroll
        for (int reg = 0; reg < 4; ++reg) Nf[(16 * w + 4 * g + reg) * 64 + (c & 3) * 16 + 4 * n + (c >> 2)] = aN[n][reg];
    st_T(s2, aMk, w, c, g);
    st_T(s3, aMbr, w, c, g);
    HBAR();
    {
        const int q = lane & 3, sl = lane >> 2; float cq[16];
#pragma unroll
        for (int k = 0; k < 16; ++k) cq[k] = 0.f;
        for (int t = 0; t < 16 * w; ++t) if (q == 0) *(LAS bf16*)(s7 + t * LSTR + (16 * w + sl) * 2) = (bf16)0;
#pragma unroll
        for (int t = 0; t < 64; ++t) if (t >= 16 * w) {
            float part = 0.f;
#pragma unroll
            for (int k4 = 0; k4 < (t + 15) / 16; ++k4) { const f32x4 nv = *(const LAS f32x4*)(Nf + t * 64 + q * 16 + 4 * k4);
#pragma unroll
                for (int e = 0; e < 4; ++e) if (4 * (4 * k4 + e) < t) part = fmaf(nv[e], cq[4 * k4 + e], part); }
            part = sum4_dpp(part);
            const float val = part + ((t == 16 * w + sl) ? 1.0f : 0.0f);
            cq[t >> 2] = (q == (t & 3)) ? val : cq[t >> 2];
            if (q == 0) *(LAS bf16*)(s7 + t * LSTR + (16 * w + sl) * 2) = f2bf(val);
        }
    }
    HBAR();
    if (stage_limit <= 5) return;
    { f32x4 aW[4], aNk[4]; zero4(aW); zero4(aNk); mm_strip2(aW, aNk, s7, s4, s2, w, c, g); st_T(s0, aW, w, c, g); st_T(s1, aNk, w, c, g); }
    HBAR();
    { f32x4 aP[4]; zero4(aP); mm_strip(aP, s0, s5, w, c, g);
#pragma unroll
      for (int n = 0; n < 4; ++n)
#pragma unroll
          for (int reg = 0; reg < 4; ++reg) if (n == w && c == 4 * g + reg) aP[n][reg] += gam[n];
#pragma unroll
      for (int n = 0; n < 4; ++n) *(GAS v2u*)(rec + REC_PT + ((n * 2 + (w >> 1)) * 64 + lane) * 16 + 8 * (w & 1)) = pack4(aP[n]); }
    { f32x4 aZq[4], aZy[4]; zero4(aZq); zero4(aZy); mm_strip2(aZq, aZy, s1, s5, s3, w, c, g);
#pragma unroll
      for (int n = 0; n < 4; ++n) { aZq[n] += kh[n]; aZy[n] += aMkr[n]; }
      f32x4 aRy[4]; zero4(aRy); mm_strip(aRy, s3, s0, w, c, g);
#pragma unroll
      for (int n = 0; n < 4; ++n)
#pragma unroll
          for (int reg = 0; reg < 4; ++reg) *(GAS bf16*)(rec + REC_RY + ((w * 2 + (n >> 1)) * 64 + 16 * (2 * (n & 1) + (c >> 3)) + 4 * g + reg) * 16 + 2 * (c & 7)) = f2bf(aRy[n][reg] + rt[n][reg]);
      st_T(s4, aZq, w, c, g);
      st_T(s7, aZy, w, c, g); }
    HBAR();
    { f32x4 aQ[4], aY[4]; zero4(aQ); zero4(aY); mm_strip(aQ, s4, s6, w, c, g); mm_strip(aY, s7, s6, w, c, g);
#pragma unroll
      for (int n = 0; n < 4; ++n) { *(GAS v2u*)(rec + REC_QS + ((n * 64 + lane) * 4 + w) * 8) = pack4(aQ[n]);
                                    *(GAS v2u*)(rec + REC_YL + ((w * 64 + lane) * 4 + n) * 8) = pack4(aY[n]); } }
}

__device__ __forceinline__ float rdlane(float v, int l) { return __int_as_float(__builtin_amdgcn_readlane(__float_as_int(v), l)); }
__device__ __forceinline__ void rwkv_sample_task(Frame& F, int task) {
    int lane_ = F.lane; asm volatile("" : "+v"(lane_)); const int lane = lane_;
    const int b = task / NH, h = task % NH, col = h * 64 + lane;
    const bf16* proj = (const bf16*)(F.ws + WS_PROJ);
    const float* sh = F.in[I_SSHIFT] + (size_t)b * RWKV_COLS;
    const float* mu = F.in[I_MU];
    float S[64];
    { const GAS f32x4* sp = (const GAS f32x4*)(F.in[I_SWKV] + (((size_t)b * NH + h) * 64 + lane) * 64);
#pragma unroll
      for (int q = 0; q < 16; ++q) { const f32x4 v = sp[q]; S[4 * q] = v[0]; S[4 * q + 1] = v[1]; S[4 * q + 2] = v[2]; S[4 * q + 3] = v[3]; } }
    const float w0 = F.in[I_W0][col], a0 = F.in[I_A0][col], kkc = F.in[I_KK][col], kac = F.in[I_KA][col], rkc = F.in[I_RK][col], lnw = F.in[I_LNW][col], lnb = F.in[I_LNB][col];
    float rr[ST], kq[ST], vq[ST], twd[ST], adv[ST], gd0[ST], gd1[ST];
#pragma unroll
    for (int i = 0; i < ST; ++i) { const int row = RP + b * ST + i; const bf16* cr = proj + (size_t)row * NCOLA;
#define SHIFTED(cc) ({ const float p_ = bf2f(cr[(cc)]); const float q_ = (i == 0) ? sh[(cc)] : bf2f(cr[(cc) - NCOLA]); p_ + (q_ - p_) * mu[(cc)]; })
        rr[i] = SHIFTED(col); kq[i] = SHIFTED(768 + col); vq[i] = SHIFTED(1536 + col);
        twd[i] = ftanh(SHIFTED(2304 + lane)); adv[i] = SHIFTED(2368 + lane); gd0[i] = fsigmoid(SHIFTED(2432 + lane)); gd1[i] = fsigmoid(SHIFTED(2496 + lane));
#undef SHIFTED
    }
    float dwv[ST] = {0.f, 0.f, 0.f, 0.f}, dav[ST] = {0.f, 0.f, 0.f, 0.f}, ggv[ST] = {0.f, 0.f, 0.f, 0.f};
    { const GAS float* W2 = (const GAS float*)(F.in[I_WW2] + col); const GAS float* A2 = (const GAS float*)(F.in[I_WA2] + col); const GAS float* G2 = (const GAS float*)(F.in[I_WG2] + col);
#pragma unroll 16
      for (int l = 0; l < 64; ++l) { const float w2 = W2[0], a2 = A2[0], g2a = G2[0], g2b = G2[64 * 768]; W2 += 768; A2 += 768; G2 += 768;
#pragma unroll
          for (int i = 0; i < ST; ++i) { dwv[i] = fmaf(rdlane(twd[i], l), w2, dwv[i]); dav[i] = fmaf(rdlane(adv[i], l), a2, dav[i]); ggv[i] = fmaf(rdlane(gd0[i], l), g2a, ggv[i]); ggv[i] = fmaf(rdlane(gd1[i], l), g2b, ggv[i]); } } }
#pragma unroll
    for (int i = 0; i < ST; ++i) {
        const int row = RP + b * ST + i;
        const float r = rr[i], k = kq[i], v = vq[i], dw = dwv[i], da = dav[i], gg = ggv[i];
        const float y0 = -(w0 + dw); const float sp = fmaxf(y0, 0.f) + __logf(1.0f + __expf(-fabsf(y0)));
        const float wdec = __expf(-__expf(-sp - 0.5f));
        const float a = fsigmoid(a0 + da);
        const float kkr = k * kkc; const float nrm = fmaxf(sqrtf(wave_sum(kkr * kkr)), 1e-12f); const float kk = kkr / nrm;
        const float kp = k * (1.0f + (a - 1.0f) * kac);
        const float asc = -kk, bsc = kk * a;
        const float bonus = wave_sum(r * kp * rkc);
        float sa = 0.f;
#pragma unroll
        for (int j = 0; j < 64; ++j) sa = fmaf(S[j], rdlane(asc, j), sa);
        const float vi = v;
        float y = 0.f;
#pragma unroll
        for (int j = 0; j < 64; ++j) { const float wj = rdlane(wdec, j), bj = rdlane(bsc, j), kj = rdlane(kp, j), rj = rdlane(r, j);
            S[j] = fmaf(S[j], wj, fmaf(sa, bj, vi * kj)); y = fmaf(S[j], rj, y); }
        const float mean = wave_sum(y) * (1.0f / 64.0f); const float dy = y - mean; const float var = wave_sum(dy * dy) * (1.0f / 64.0f);
        const float o = (dy * rsqrtf(var + 6.4e-4f) * lnw + lnb + bonus * vi) * gg;
        ((bf16*)(F.ws + WS_MIX))[(size_t)row * DM + col] = f2bf(o);
        asm volatile("" ::: "memory");
    }
    { GAS f32x4* sp = (GAS f32x4*)(F.out + O_SWKV + (((size_t)b * NH + h) * 64 + lane) * 64);
#pragma unroll
      for (int q = 0; q < 16; ++q) sp[q] = (f32x4){S[4 * q], S[4 * q + 1], S[4 * q + 2], S[4 * q + 3]}; }
    if (h == 0) { const bf16* lr = proj + (size_t)(RP + b * ST + ST - 1) * NCOLA; float* o = F.out + O_SSHIFT + (size_t)b * RWKV_COLS;
        for (int q = lane; q < RWKV_COLS; q += 64) o[q] = bf2f(lr[q]); }
}

__device__ __forceinline__ void rwkv_scan_chain(Frame& F, int bh, int w) {
    int lane_ = F.lane; asm volatile("" : "+v"(lane_)); const int lane = lane_, g = lane >> 4, c = lane & 15; const int b = bh / NH, h = bh % NH;
    f32x4 acc[4]; zero4(acc);
    const int vrow = 16 * w + c;
    auto recp = [&](int cc) -> unsigned char* { return F.ws + WS_REC + (size_t)((b * NH + h) * 128 + cc) * REC_BYTES; };
    constexpr int DPF = 4;
    bf16x8 pa[DPF][4][2]; v4u qa[DPF][2];
#define SCAN_LOAD(d, cc_) do { const unsigned char* rp_ = recp(cc_); \
        qa[d][0] = *(const GAS v4u*)(rp_ + REC_QS + (w * 64 + lane) * 32); qa[d][1] = *(const GAS v4u*)(rp_ + REC_QS + (w * 64 + lane) * 32 + 16); \
        _Pragma("unroll") for (int mt = 0; mt < 4; ++mt) _Pragma("unroll") for (int ks = 0; ks < 2; ++ks) pa[d][mt][ks] = *(const GAS bf16x8*)(rp_ + REC_PT + ((mt * 2 + ks) * 64 + lane) * 16); } while (0)
#pragma unroll
    for (int d = 0; d < DPF; ++d) SCAN_LOAD(d, d);
    for (int cc0 = 0; cc0 < 128; cc0 += DPF) {
#pragma unroll
        for (int d = 0; d < DPF; ++d) { const int cc = cc0 + d;
            unsigned char* sp_ = F.ws + WS_HB + (size_t)((b * NH + h) * 128 + cc) * 8192;
            v2u sb[4]; f32x4 nacc[4];
#pragma unroll
            for (int mt = 0; mt < 4; ++mt) sb[mt] = pack4(acc[mt]);
            nacc[0] = unpack4((v2u){qa[d][0].x, qa[d][0].y}); nacc[1] = unpack4((v2u){qa[d][0].z, qa[d][0].w}); nacc[2] = unpack4((v2u){qa[d][1].x, qa[d][1].y}); nacc[3] = unpack4((v2u){qa[d][1].z, qa[d][1].w});
#pragma unroll
            for (int mt = 0; mt < 4; ++mt) *(GAS v2u*)(sp_ + ((w * 2 + (mt >> 1)) * 64 + 16 * (2 * (mt & 1) + (g >> 1)) + c) * 16 + 8 * (g & 1)) = sb[mt];
            bf16x8 bf[2];
#pragma unroll
            for (int ks = 0; ks < 2; ++ks) { v4u t; t.x = sb[2 * ks].x; t.y = sb[2 * ks].y; t.z = sb[2 * ks + 1].x; t.w = sb[2 * ks + 1].y; bf[ks] = __builtin_bit_cast(bf16x8, t); }
#pragma unroll
            for (int mt = 0; mt < 4; ++mt) { nacc[mt] = mfma16(pa[d][mt][0], bf[0], nacc[mt]); nacc[mt] = mfma16(pa[d][mt][1], bf[1], nacc[mt]); acc[mt] = nacc[mt]; }
            if (cc + DPF < 128) SCAN_LOAD(d, cc + DPF);
        }
    }
#undef SCAN_LOAD
    float* o = F.out + O_PWKV + (((size_t)b * NH + h) * 64 + vrow) * 64;
#pragma unroll
    for (int mt = 0; mt < 4; ++mt) *(GAS f32x4*)(o + 16 * mt + 4 * g) = acc[mt];
}

__device__ __forceinline__ void rwkv_yout_item(Frame& F, int item) {
    int lane_ = F.lane; asm volatile("" : "+v"(lane_)); const int lane = lane_, g = lane >> 4, c = lane & 15; const int unit = item >> 2, w = item & 3;
    const int chunk = unit / NH, h = unit % NH, row0 = chunk * 64; const bool first = (chunk & 127) == 0;
    const unsigned char* rec = F.ws + WS_REC + (size_t)rec_index(chunk, h) * REC_BYTES; const unsigned char* srec = F.ws + WS_HB + (size_t)rec_index(chunk, h) * 8192;
    const bf16* proj = (const bf16*)(F.ws + WS_PROJ);
    f32x4 y[4], gt[4]; zero4(gt);
    { const v4u y01 = *(const GAS v4u*)(rec + REC_YL + (w * 64 + lane) * 32), y23 = *(const GAS v4u*)(rec + REC_YL + (w * 64 + lane) * 32 + 16);
      y[0] = unpack4((v2u){y01.x, y01.y}); y[1] = unpack4((v2u){y01.z, y01.w}); y[2] = unpack4((v2u){y23.x, y23.y}); y[3] = unpack4((v2u){y23.z, y23.w}); }
#pragma unroll
    for (int ks = 0; ks < 2; ++ks) { const bf16x8 a = *(const GAS bf16x8*)(rec + REC_RY + ((w * 2 + ks) * 64 + lane) * 16);
#pragma unroll
        for (int n = 0; n < 4; ++n) y[n] = mfma16(a, *(const GAS bf16x8*)(srec + ((n * 2 + ks) * 64 + lane) * 16), y[n]); }
    { const int t = 16 * w + c; const bf16* cr = proj + (size_t)(row0 + t) * NCOLA; const bf16* pr = (first && t == 0) ? nullptr : cr - NCOLA; const bf16* Wg2 = (const bf16*)(F.ws + WS_WG2);
#pragma unroll
      for (int ks = 0; ks < 4; ++ks) { const int l0 = 32 * ks + 8 * g; float x[8]; load_shift8(cr + 2432 + l0, pr ? pr + 2432 + l0 : nullptr, F.in[I_MU] + 2432 + l0, x);
#pragma unroll
          for (int i = 0; i < 8; ++i) x[i] = fsigmoid(x[i]);
          const bf16x8 ag = pack_frag(x);
#pragma unroll
          for (int n = 0; n < 4; ++n) gt[n] = mfma16(ag, *(const GAS bf16x8*)(Wg2 + (size_t)(h * 64 + 16 * n + c) * 128 + l0), gt[n]); } }
    float mean[4], rstd[4];
#pragma unroll
    for (int reg = 0; reg < 4; ++reg) { float s = (y[0][reg] + y[1][reg]) + (y[2][reg] + y[3][reg]); s = sum16(s); mean[reg] = s * (1.0f / 64.0f);
        float q = 0.f;
#pragma unroll
        for (int n = 0; n < 4; ++n) { const float d = y[n][reg] - mean[reg]; q += d * d; }
        q = sum16(q); rstd[reg] = rsqrtf(q * (1.0f / 64.0f) + 6.4e-4f); }
    bf16* mix = (bf16*)(F.ws + WS_MIX);
#pragma unroll
    for (int n = 0; n < 4; ++n) { const int col = h * 64 + 16 * n + c; const float lnw = F.in[I_LNW][col], lnb = F.in[I_LNB][col];
        const f32x4 bv = unpack4(*(const GAS v2u*)(rec + REC_BV + ((w * 64 + lane) * 4 + n) * 8));
#pragma unroll
        for (int reg = 0; reg < 4; ++reg) { const float o = ((y[n][reg] - mean[reg]) * rstd[reg] * lnw + lnb + bv[reg]) * gt[n][reg];
            mix[(size_t)(row0 + 16 * w + 4 * g + reg) * DM + col] = f2bf(o); } }
}

__device__ __forceinline__ int crow32(int r, int hi) { return (r & 3) + 8 * (r >> 2) + 4 * hi; }
template <bool MASKED, int GB>
__device__ __forceinline__ void flash32(const bf16x8 (&qf)[4], const bf16* Kp, int kstr, const bf16* VTp, int vstr, int kb_lo, int nblk, int qpos, float m0, float l0,
                                        f32x16& o0, f32x16& o1, float& lsum, int lane) {
    const int r32 = lane & 31, hh = lane >> 5;
    float m = m0, l = hh == 0 ? l0 : 0.f;
#pragma unroll
    for (int r = 0; r < 16; ++r) { o0[r] = 0.f; o1[r] = 0.f; }
    for (int b0 = 0; b0 < nblk; b0 += GB) {
        bf16x8 kf[GB][4]; v2u vf[GB][2][2][2];
#pragma unroll
        for (int i = 0; i < GB; ++i) if (b0 + i < nblk) { const int kb = kb_lo + 32 * (b0 + i);
#pragma unroll
            for (int ks = 0; ks < 4; ++ks) kf[i][ks] = *(const GAS bf16x8*)(Kp + (size_t)(kb + r32) * kstr + 16 * ks + 8 * hh);
#pragma unroll
            for (int s2 = 0; s2 < 2; ++s2)
#pragma unroll
                for (int dt = 0; dt < 2; ++dt) { const bf16* vp = VTp + (size_t)(32 * dt + r32) * vstr + kb + 16 * s2 + 4 * hh; vf[i][s2][dt][0] = *(const GAS v2u*)vp; vf[i][s2][dt][1] = *(const GAS v2u*)(vp + 8); } }
#pragma unroll
        for (int i = 0; i < GB; ++i) if (b0 + i < nblk) { const int kb = kb_lo + 32 * (b0 + i);
            f32x16 s;
#pragma unroll
            for (int r = 0; r < 16; ++r) s[r] = 0.f;
#pragma unroll
            for (int ks = 0; ks < 4; ++ks) s = mfma32(kf[i][ks], qf[ks], s);
            if (MASKED) {
#pragma unroll
                for (int r = 0; r < 16; ++r) { const int rel = qpos - (kb + crow32(r, hh)); if (rel < 0 || rel >= 128) s[r] = -1e30f; } }
            float bm = s[0];
#pragma unroll
            for (int r = 1; r < 16; ++r) bm = fmaxf(bm, s[r]);
            bm = max_x32(bm);
            const float mn = fmaxf(m, bm), alpha = __builtin_amdgcn_exp2f(m - mn); m = mn;
            float ps = 0.f;
#pragma unroll
            for (int r = 0; r < 16; ++r) { s[r] = __builtin_amdgcn_exp2f(s[r] - mn); ps += s[r]; }
            l = l * alpha + ps;
#pragma unroll
            for (int r = 0; r < 16; ++r) { o0[r] *= alpha; o1[r] *= alpha; }
#pragma unroll
            for (int s2 = 0; s2 < 2; ++s2) {
                v4u pw; pw.x = cvt_pk_bf16(s[8 * s2], s[8 * s2 + 1]); pw.y = cvt_pk_bf16(s[8 * s2 + 2], s[8 * s2 + 3]); pw.z = cvt_pk_bf16(s[8 * s2 + 4], s[8 * s2 + 5]); pw.w = cvt_pk_bf16(s[8 * s2 + 6], s[8 * s2 + 7]);
                const bf16x8 pb = __builtin_bit_cast(bf16x8, pw);
                { v4u aw; aw.x = vf[i][s2][0][0].x; aw.y = vf[i][s2][0][0].y; aw.z = vf[i][s2][0][1].x; aw.w = vf[i][s2][0][1].y; o0 = mfma32(__builtin_bit_cast(bf16x8, aw), pb, o0); }
                { v4u aw; aw.x = vf[i][s2][1][0].x; aw.y = vf[i][s2][1][0].y; aw.z = vf[i][s2][1][1].x; aw.w = vf[i][s2][1][1].y; o1 = mfma32(__builtin_bit_cast(bf16x8, aw), pb, o1); } }
        }
    }
    lsum = add_x32(l);
}
__device__ __forceinline__ void flash_store(bf16* dst  , int rstride, const f32x16& o0, const f32x16& o1, float lsum, int lane) {
    const int r32 = lane & 31, hh = lane >> 5; const float inv = 1.0f / lsum; bf16* p = dst + (size_t)r32 * rstride + 4 * hh;
#pragma unroll
    for (int k = 0; k < 4; ++k) { *(GAS v2u*)(p + 8 * k) = pack4((f32x4){o0[4 * k] * inv, o0[4 * k + 1] * inv, o0[4 * k + 2] * inv, o0[4 * k + 3] * inv});
        *(GAS v2u*)(p + 32 + 8 * k) = pack4((f32x4){o1[4 * k] * inv, o1[4 * k + 1] * inv, o1[4 * k + 2] * inv, o1[4 * k + 3] * inv}); }
}
__device__ __forceinline__ void memattn_prompt_task(Frame& F, int layer, int task) {
    int lane_ = F.lane; asm volatile("" : "+v"(lane_)); const int lane = lane_, r32 = lane & 31, hh = lane >> 5; const int hm = task & 3, qt = task >> 2;
    const int row = qt * 32 + r32, b = (qt * 32) >> 13;
    bf16x8 qf[4];
    if (layer == 0) { const bf16* qp = (const bf16*)(F.ws + WS_PROJ) + (size_t)row * NCOLA + RWKV_COLS + hm * 64; const float* gn = F.in[I_MQN];
        float x[4][8]; float ss = 0.f;
#pragma unroll
        for (int ks = 0; ks < 4; ++ks) { const v4u w = *(const GAS v4u*)(qp + 16 * ks + 8 * hh); const unsigned ww[4] = {w.x, w.y, w.z, w.w};
#pragma unroll
            for (int i = 0; i < 4; ++i) { x[ks][2 * i] = bflo(ww[i]); x[ks][2 * i + 1] = bfhi(ww[i]); ss += x[ks][2 * i] * x[ks][2 * i] + x[ks][2 * i + 1] * x[ks][2 * i + 1]; } }
        ss = add_x32(ss); const float rs = rsqrtf(ss * (1.0f / 64.0f) + 1e-6f) * C2Q;
#pragma unroll
        for (int ks = 0; ks < 4; ++ks) {
#pragma unroll
            for (int i = 0; i < 8; ++i) x[ks][i] *= rs * gn[16 * ks + 8 * hh + i];
            qf[ks] = pack_frag(x[ks]); }
    } else { const bf16* qp = (const bf16*)(F.ws + WS_Q1) + (size_t)row * DM + 768 + hm * 64;
#pragma unroll
        for (int ks = 0; ks < 4; ++ks) qf[ks] = *(const GAS bf16x8*)(qp + 16 * ks + 8 * hh); }
    const bf16* Kp = (const bf16*)(F.ws + WS_MK) + (size_t)((layer * 2 + b) * 4 + hm) * 256 * 64;
    const bf16* VTp = (const bf16*)(F.ws + WS_MVT) + (size_t)((layer * 2 + b) * 4 + hm) * 64 * 256;
    f32x16 o0, o1; float ls;
    flash32<false, 4>(qf, Kp, 64, VTp, 256, 0, 8, 0, -1e30f, 0.f, o0, o1, ls, lane);
    flash_store((bf16*)(F.ws + WS_MIX) + (size_t)(qt * 32) * DM + 768 + hm * 64, DM, o0, o1, ls, lane);
}
__device__ __forceinline__ void swa_prompt_task(Frame& F, int task) {
    int lane_ = F.lane; asm volatile("" : "+v"(lane_)); const int lane = lane_, r32 = lane & 31, hh = lane >> 5; const int hq = task % NH, qt = task / NH;
    const int b = qt >> 8, tq = (qt & 255) * 32, row = qt * 32 + r32, kvh = hq / 3;
    const bf16* qp = (const bf16*)(F.ws + WS_Q1) + (size_t)row * DM + hq * 64;
    bf16x8 qf[4];
#pragma unroll
    for (int ks = 0; ks < 4; ++ks) qf[ks] = *(const GAS bf16x8*)(qp + 16 * ks + 8 * hh);
    const bf16* Kp = (const bf16*)(F.ws + WS_K1) + (size_t)(b * T) * 256 + kvh * 64;
    const bf16* VTp = (const bf16*)(F.ws + WS_VT1) + (size_t)(b * 4 + kvh) * 64 * T;
    const int kb_lo = tq >= 128 ? tq - 128 : 0, nblk = (tq - kb_lo) / 32 + 1;
    const float sink = F.in[I_SINKS][hq] * LOG2E;
    f32x16 o0, o1; float ls;
    flash32<true, 3>(qf, Kp, 256, VTp, T, kb_lo, nblk, tq + r32, sink, 1.0f, o0, o1, ls, lane);
    flash_store((bf16*)(F.ws + WS_MIX) + (size_t)(qt * 32) * DM + hq * 64, DM, o0, o1, ls, lane);
}
template <int NQ, bool WINDOW>
__device__ __forceinline__ void small_attn(const LAS float* ql, LAS float* sc, int NKP, const float* k1, const float* v1, int kst1, int nk1, const bf16* k2, const bf16* v2, int kst2, int nk2,
                                           const float* sinkg  , bf16* out0, int ostride_q, int lane) {
    const int sub = lane >> 4, dq = lane & 15, nk = nk1 + nk2;
    f32x4 qv[NQ];
#pragma unroll
    for (int qi = 0; qi < NQ; ++qi) qv[qi] = *(const LAS f32x4*)(ql + qi * 64 + 4 * dq);
    constexpr int KBAT = NQ > 4 ? 4 : 8;
    for (int kg0 = 0; kg0 < nk1; kg0 += 4 * KBAT) { f32x4 kv[KBAT];
#pragma unroll
        for (int u = 0; u < KBAT; ++u) kv[u] = *(const GAS f32x4*)(k1 + (size_t)(kg0 + 4 * u + sub) * kst1 + 4 * dq);
#pragma unroll
        for (int u = 0; u < KBAT; ++u) { const int key = kg0 + 4 * u + sub;
#pragma unroll
            for (int qi = 0; qi < NQ; ++qi) { const f32x4 p = qv[qi] * kv[u]; const float s = sum16((p[0] + p[1]) + (p[2] + p[3])); if (dq == 0) sc[qi * NKP + key] = s; } } }
    for (int kg = nk1; kg < nk; kg += 4) { const int key = kg + sub; const f32x4 kv = unpack4(*(const GAS v2u*)(k2 + (size_t)(key - nk1) * kst2 + 4 * dq));
#pragma unroll
        for (int qi = 0; qi < NQ; ++qi) { const f32x4 p = qv[qi] * kv; const float s = sum16((p[0] + p[1]) + (p[2] + p[3])); if (dq == 0) sc[qi * NKP + key] = s; } }
    LDS_WAIT(); asm volatile("" ::: "memory");
#pragma unroll
    for (int qi = 0; qi < NQ; ++qi) { float sv[5]; const float sk_ = sinkg ? sinkg[qi >> 2] * LOG2E : -1e30f; float mx = sk_;
#pragma unroll
        for (int t = 0; t < 5; ++t) { const int key = lane + 64 * t; float s = -1e30f; if (key < nk) { s = sc[qi * NKP + key]; if (WINDOW) { const int i = qi & 3; if (key < i + 1 || key > 128 + i) s = -1e30f; } } sv[t] = s; mx = fmaxf(mx, s); }
        mx = wave_max(mx); float sum = 0.f;
#pragma unroll
        for (int t = 0; t < 5; ++t) { sv[t] = __builtin_amdgcn_exp2f(sv[t] - mx); sum += sv[t]; }
        sum = wave_sum(sum) + (sinkg ? __builtin_amdgcn_exp2f(sk_ - mx) : 0.f); const float inv = 1.0f / sum;
#pragma unroll
        for (int t = 0; t < 5; ++t) { const int key = lane + 64 * t; if (key < nk) sc[qi * NKP + key] = sv[t] * inv; } }
    LDS_WAIT(); asm volatile("" ::: "memory");
    f32x4 acc[NQ];
#pragma unroll
    for (int qi = 0; qi < NQ; ++qi) acc[qi] = (f32x4){0.f, 0.f, 0.f, 0.f};
    for (int kg0 = 0; kg0 < nk1; kg0 += 4 * KBAT) { f32x4 vv[KBAT];
#pragma unroll
        for (int u = 0; u < KBAT; ++u) vv[u] = *(const GAS f32x4*)(v1 + (size_t)(kg0 + 4 * u + sub) * kst1 + 4 * dq);
#pragma unroll
        for (int u = 0; u < KBAT; ++u) { const int key = kg0 + 4 * u + sub;
#pragma unroll
            for (int qi = 0; qi < NQ; ++qi) acc[qi] += vv[u] * sc[qi * NKP + key]; } }
    for (int kg = nk1; kg < nk; kg += 4) { const int key = kg + sub; const f32x4 vv = unpack4(*(const GAS v2u*)(v2 + (size_t)(key - nk1) * kst2 + 4 * dq));
#pragma unroll
        for (int qi = 0; qi < NQ; ++qi) acc[qi] += vv * sc[qi * NKP + key]; }
#pragma unroll
    for (int qi = 0; qi < NQ; ++qi) { f32x4 a = acc[qi];
#pragma unroll
        for (int e = 0; e < 4; ++e) { a[e] = add_x16(a[e]); a[e] = add_x32(a[e]); }
        if (sub == 0) *(GAS v2u*)(out0 + (size_t)(qi & 3) * ostride_q + (qi >> 2) * 64 + 4 * dq) = pack4(a); }
    LDS_WAIT(); asm volatile("" ::: "memory");
}
__device__ __forceinline__ void memattn_sample_task(Frame& F, int layer, int task, LAS float* wl  ) {
    int lane_ = F.lane; asm volatile("" : "+v"(lane_)); const int lane = lane_, b = task >> 2, hm = task & 3; LAS float* ql = wl; LAS float* sc = wl + 12 * 64;
#pragma unroll
    for (int i = 0; i < 4; ++i) { const int row = RP + b * ST + i; float x;
        if (layer == 0) { x = bf2f(((const bf16*)(F.ws + WS_PROJ))[(size_t)row * NCOLA + RWKV_COLS + hm * 64 + lane]); const float ss = wave_sum(x * x); x *= rsqrtf(ss * (1.0f / 64.0f) + 1e-6f) * C2Q * F.in[I_MQN][lane]; }
        else x = bf2f(((const bf16*)(F.ws + WS_Q1))[(size_t)row * DM + 768 + hm * 64 + lane]);
        ql[i * 64 + lane] = x; }
    LDS_WAIT(); asm volatile("" ::: "memory");
    const float* k1 = F.in[I_CMK] + (((size_t)layer * SB + b) * NMEM * 4 + hm) * 64; const float* v1 = F.in[I_CMV] + (((size_t)layer * SB + b) * NMEM * 4 + hm) * 64;
    small_attn<4, false>(ql, sc, 264, k1, v1, 256, 256, nullptr, nullptr, 0, 0, nullptr, (bf16*)(F.ws + WS_MIX) + (size_t)(RP + b * ST) * DM + 768 + hm * 64, DM, lane);
}
__device__ __forceinline__ void swa_sample_task(Frame& F, int task, LAS float* wl) {
    int lane_ = F.lane; asm volatile("" : "+v"(lane_)); const int lane = lane_, b = task >> 2, kvh = task & 3; LAS float* ql = wl; LAS float* sc = wl + 12 * 64;
#pragma unroll
    for (int qi = 0; qi < 12; ++qi) { const int i = qi & 3, gq = qi >> 2, hq = kvh * 3 + gq; const int row = RP + b * ST + i;
        ql[qi * 64 + lane] = bf2f(((const bf16*)(F.ws + WS_Q1))[(size_t)row * DM + hq * 64 + lane]); }
    LDS_WAIT(); asm volatile("" ::: "memory");
    const float* k1 = F.in[I_CSK] + ((size_t)b * 128 * 4 + kvh) * 64; const float* v1 = F.in[I_CSV] + ((size_t)b * 128 * 4 + kvh) * 64;
    const bf16* k2 = (const bf16*)(F.ws + WS_K1) + (size_t)(RP + b * ST) * 256 + kvh * 64; const bf16* v2 = (const bf16*)(F.ws + WS_V1) + (size_t)(RP + b * ST) * 256 + kvh * 64;
    small_attn<12, true>(ql, sc, 136, k1, v1, 256, 128, k2, v2, 256, 4, F.in[I_SINKS] + kvh * 3, (bf16*)(F.ws + WS_MIX) + (size_t)(RP + b * ST) * DM + kvh * 3 * 64, DM, lane);
}

constexpr int N_PHASES = 13;
template <int PM> __global__ void __launch_bounds__(NWAVES * 64, 2) yoco_fwd(Args args) {
    extern __shared__ __attribute__((aligned(16))) unsigned char lds[];
    Frame F;
    F.lds = (LAS unsigned char*)lds; F.lds_g = lds;
    F.wave = __builtin_amdgcn_readfirstlane((int)threadIdx.x >> 6); F.lane = mk_lane(); F.tid = F.wave * 64 + F.lane;
    F.G = gridDim.x; { const int bx = blockIdx.x; F.vcu = (F.G % 8 == 0) ? (bx % 8) * (F.G / 8) + bx / 8 : bx; }
    F.in = args.in; F.out = args.out; F.ws = args.ws; F.ctl = (gu32*)(args.ws + WS_CTL);
    for (int u = F.tid; u < (LDS_BYTES - LDSCTL_OFF) / 4; u += NWAVES * 64) ((LAS unsigned*)(F.lds + LDSCTL_OFF))[u] = 0u;
    __syncthreads();
    const int lo = args.ph_lo, hi = args.ph_hi;
    XcdBarrier bar; bar.wave0 = F.wave == 0; bar.bar = (unsigned*)(F.ctl + CW_BAR); bar.x = 0; bar.st = nullptr;
    bar = xcd_barrier_post((unsigned*)(F.ctl + CW_BAR), (volatile LAS unsigned*)(F.lds + MISC_OFF) + 8, F.wave == 0);
#define IN(k) (((PM >> (k)) & 1) && lo <= (k) && (k) < hi)
#ifndef MK_DUP
#define MK_DUP -1
#endif
#define PH_REP(k) ((MK_DUP == (k)) ? 2 : 1)
#define SEAM(k) do { if (IN(k) && IN((k) + 1)) xcd_barrier(bar); } while (0)
    const int gw = F.vcu * NWAVES + F.wave, NGW = F.G * NWAVES;
#define SSQ ((float*)(F.ws + WS_SSQ))
#define HB ((bf16*)(F.ws + WS_HB))
#define MIX ((bf16*)(F.ws + WS_MIX))
#define HH ((bf16*)(F.ws + WS_H))
#define PHASE_BEGIN() do { int z_ = 0; unsigned char* ws_ = args.ws; float* out_ = args.out; asm volatile("" : "+s"(z_), "+s"(ws_), "+s"(out_)); F.in = args.in + z_; F.ws = ws_; F.out = out_; \
                           F.lane = mk_lane(); F.tid = F.wave * 64 + F.lane; } while (0)

    if (IN(0)) for (int rep_ = 0; rep_ < PH_REP(0); ++rep_) { PHASE_BEGIN(); p0_prologue(F); } SEAM(0);

    if (IN(1)) for (int rep_ = 0; rep_ < PH_REP(1); ++rep_) { PHASE_BEGIN();
        { pg8::Gemm g{HB, (const bf16*)(F.ws + WS_WA), R, NCOLA, DM}; pg8::StaticOrder S; S.init(R, NCOLA, F.G, (int)blockIdx.x, DM);
          pg8::EpiScaleBf16<0> E{(bf16*)(F.ws + WS_PROJ), NCOLA, SSQ};
          pg8::gemm_phase<pg8::EpiScaleBf16<0>, pg8::StaticOrder, true, true>(F.lds + RING_OFF, g, S, E, F.wave, F.lane); }
#ifndef NO_MEMKV
        { pg8::Gemm g{(const bf16*)(F.ws + WS_MB), (const bf16*)(F.ws + WS_WM), 512, 1024, DM}; pg8::StaticOrder S; S.init(512, 1024, F.G, (int)blockIdx.x, DM);
          pg8::EpiMemKV E{F.ws, F.out, F.in[I_MKN]};
          pg8::gemm_phase<pg8::EpiMemKV, pg8::StaticOrder, true, true>(F.lds + RING_OFF, g, S, E, F.wave, F.lane); }
#endif
    } SEAM(1);

    if (IN(2)) for (int rep_ = 0; rep_ < ((MK_DUP == 2 || (MK_DUP >= 20 && MK_DUP < 30)) ? 2 : 1); ++rep_) { PHASE_BEGIN();
        const int half = F.wave >> 2; const int gw = F.vcu * NWAVES + F.wave, NGW = F.G * NWAVES;
        LAS unsigned char* hb = F.lds + half * PREP_HALF; LAS float* wtot = (LAS float*)(F.lds + WTOT_OFF + half * 1024);
        const int slim = (rep_ == 1 && MK_DUP == 21) ? 3 : (rep_ == 1 && MK_DUP == 22) ? 5 : 99;
        if (!(rep_ == 1 && MK_DUP == 20)) { LAS unsigned char* prow = F.lds + WTOT_OFF + 2048 + half * 512; PrepPf pf; if (F.vcu < NUNIT / 2) prep_issue(F, 2 * F.vcu + half, pf);
            for (int pi = F.vcu; pi < NUNIT / 2; pi += F.G) rwkv_prep_unit(F, 2 * pi + half, hb, wtot, prow, pf, pi + F.G < NUNIT / 2, 2 * (pi + F.G) + half, slim); }
        if (!(rep_ == 1 && (MK_DUP == 21 || MK_DUP == 22))) for (int t = gw; t < SB * NH + 2; t += NGW) {
            if (t < SB * NH) rwkv_sample_task(F, t);
            else { const int b = t - SB * NH; const bf16* lr = (const bf16*)(F.ws + WS_PROJ) + (size_t)(b * T + T - 1) * NCOLA; float* o = F.out + O_PSHIFT + (size_t)b * RWKV_COLS;
                for (int q = F.lane; q < RWKV_COLS; q += 64) o[q] = bf2f(lr[q]); } }
    } SEAM(2);

    if (IN(3)) for (int rep_ = 0; rep_ < ((MK_DUP == 30 || MK_DUP == 31) ? 2 : 1); ++rep_) { PHASE_BEGIN();
        const int nscan = NB * NH * 4;
        if (F.vcu < nscan) { if (F.wave == 0 && (rep_ == 0 || MK_DUP == 31)) rwkv_scan_chain(F, F.vcu >> 2, F.vcu & 3); }
        else if (rep_ == 0 || MK_DUP == 30) { const int ow = (F.vcu - nscan) * NWAVES + F.wave, NOW = (F.G - nscan) * NWAVES; LAS float* wl = (LAS float*)(F.lds + F.wave * 12288);
            for (int t = ow; t < 2048 + 512; t += NOW) { if (t < 2048) memattn_prompt_task(F, 0, t); else memattn_sample_task(F, 0, t - 2048, wl); } }
    } SEAM(3);

    if (IN(4)) for (int rep_ = 0; rep_ < PH_REP(4); ++rep_) { PHASE_BEGIN(); for (int it = gw; it < NUNIT * 4; it += NGW) rwkv_yout_item(F, it); } SEAM(4);

    if (IN(5)) for (int rep_ = 0; rep_ < PH_REP(5); ++rep_) { PHASE_BEGIN(); pg8::Gemm g{MIX, (const bf16*)(F.ws + WS_WOUT), R, DM, DM}; pg8::TailOrder S; S.init(F.G, (int)blockIdx.x, DM, S_K1);
        pg8::EpiResid E{F.in[I_XP], F.in[I_XS], RP, nullptr, HB, SSQ, (float*)(F.ws + WS_SLAB), S_K1};
        pg8::gemm_phase<pg8::EpiResid, pg8::TailOrder, true, true>(F.lds + RING_OFF, g, S, E, F.wave, F.lane); } SEAM(5);
    if (IN(6)) for (int rep_ = 0; rep_ < PH_REP(6); ++rep_) { PHASE_BEGIN(); finalize_sample(F, F.in[I_XS], S_K1, false); xcd_barrier(bar);
        pg8::Gemm g{HB, (const bf16*)(F.ws + WS_WUP), R, FF, DM}; pg8::StaticOrder S; S.init(R, FF, F.G, (int)blockIdx.x, DM);
        pg8::EpiScaleBf16<1> E{HH, FF, SSQ};
        pg8::gemm_phase<pg8::EpiScaleBf16<1>, pg8::StaticOrder, true, true>(F.lds + RING_OFF, g, S, E, F.wave, F.lane); } SEAM(6);
    if (IN(7)) { PHASE_BEGIN(); pg8::Gemm g{HH, (const bf16*)(F.ws + WS_WDN), R, DM, FF}; pg8::TailOrder S; S.init(F.G, (int)blockIdx.x, FF, S_K4);
        pg8::EpiResid E{nullptr, nullptr, RP, nullptr, HB, SSQ, (float*)(F.ws + WS_SLAB), S_K4, HB};
        pg8::gemm_phase<pg8::EpiResid, pg8::TailOrder, true, true>(F.lds + RING_OFF, g, S, E, F.wave, F.lane); } SEAM(7);

    if (IN(8)) for (int rep_ = 0; rep_ < PH_REP(8); ++rep_) { PHASE_BEGIN(); finalize_sample(F, nullptr, S_K4, false); xcd_barrier(bar);
        pg8::Gemm g{HB, (const bf16*)(F.ws + WS_WB), R, NCOLB, DM}; pg8::StaticOrder S; S.init(R, NCOLB, F.G, (int)blockIdx.x, DM);
        pg8::EpiL1 E{F.ws, F.out, F.in[I_QN], F.in[I_MQN] + 64, F.in[I_KN]};
        pg8::gemm_phase<pg8::EpiL1, pg8::StaticOrder, true, true>(F.lds + RING_OFF, g, S, E, F.wave, F.lane); } SEAM(8);

    if (IN(9)) for (int rep_ = 0; rep_ < PH_REP(9); ++rep_) { PHASE_BEGIN(); LAS float* wl = (LAS float*)(F.lds + F.wave * 12288);
        for (int t = gw; t < 6144 + 2048 + 512 + 512; t += NGW) {
            if (t < 6144) swa_prompt_task(F, t); else if (t < 8192) memattn_prompt_task(F, 1, t - 6144);
            else if (t < 8704) swa_sample_task(F, t - 8192, wl); else memattn_sample_task(F, 1, t - 8704, wl); }
    } SEAM(9);

    if (IN(10)) for (int rep_ = 0; rep_ < PH_REP(10); ++rep_) { PHASE_BEGIN(); pg8::Gemm g{MIX, (const bf16*)(F.ws + WS_WOUT) + (size_t)DM * DM, R, DM, DM}; pg8::TailOrder S; S.init(F.G, (int)blockIdx.x, DM, S_K1);
        pg8::EpiResid E{nullptr, nullptr, RP, nullptr, HB, SSQ, (float*)(F.ws + WS_SLAB), S_K1, HB};
        pg8::gemm_phase<pg8::EpiResid, pg8::TailOrder, true, true>(F.lds + RING_OFF, g, S, E, F.wave, F.lane); } SEAM(10);
    if (IN(11)) for (int rep_ = 0; rep_ < PH_REP(11); ++rep_) { PHASE_BEGIN(); finalize_sample(F, nullptr, S_K1, false); xcd_barrier(bar);
        pg8::Gemm g{HB, (const bf16*)(F.ws + WS_WUP) + (size_t)DM * FF, R, FF, DM}; pg8::StaticOrder S; S.init(R, FF, F.G, (int)blockIdx.x, DM);
        pg8::EpiScaleBf16<1> E{HH, FF, SSQ};
        pg8::gemm_phase<pg8::EpiScaleBf16<1>, pg8::StaticOrder, true, true>(F.lds + RING_OFF, g, S, E, F.wave, F.lane); } SEAM(11);
    if (IN(12)) for (int rep_ = 0; rep_ < PH_REP(12); ++rep_) { PHASE_BEGIN(); pg8::Gemm g{HH, (const bf16*)(F.ws + WS_WDN) + (size_t)DM * FF, R, DM, FF}; pg8::TailOrder S; S.init(F.G, (int)blockIdx.x, FF, S_K4);
        pg8::EpiResid E{nullptr, nullptr, RP, F.out + O_Y, nullptr, nullptr, (float*)(F.ws + WS_SLAB), S_K4, HB};
        pg8::gemm_phase<pg8::EpiResid, pg8::TailOrder, true, true>(F.lds + RING_OFF, g, S, E, F.wave, F.lane);
        xcd_barrier(bar); finalize_sample(F, nullptr, S_K4, true); }
#undef IN
#undef SEAM
#undef SSQ
#undef HB
#undef MIX
#undef HH
#undef PHASE_BEGIN
}

template <int PM> static void launch_pm(int grid, hipStream_t stream, const Args& a) { hipLaunchKernelGGL(yoco_fwd<PM>, dim3(grid), dim3(NWAVES * 64), LDS_BYTES, stream, a); }
template <int PM> static bool set_lds() { return hipFuncSetAttribute((const void*)yoco_fwd<PM>, hipFuncAttributeMaxDynamicSharedMemorySize, LDS_BYTES) == hipSuccess; }
extern "C" void kernel_launch(void* const* d_in, const int* in_sizes, int n_in, void* d_out, int out_size, void* d_ws, size_t ws_size, hipStream_t stream) {
    static int grid = 0;
    if (grid == 0) {
        if (n_in != N_IN || (size_t)out_size != O_END || ws_size < WS_END) { fprintf(stderr, "kernel_launch: unexpected shapes (n_in %d, out %d, ws %zu < %zu)\n", n_in, out_size, ws_size, (size_t)WS_END); grid = -1; return; }
        int dev = 0, cus = 0;
        if (hipGetDevice(&dev) != hipSuccess || hipDeviceGetAttribute(&cus, hipDeviceAttributeMultiprocessorCount, dev) != hipSuccess) { grid = -1; return; }
        bool ok = true;
#if MK_ONE_LAUNCH
        ok = set_lds<0x1fff>();
#else
        ok = set_lds<1>() && set_lds<2>() && set_lds<4>() && set_lds<8>() && set_lds<16>() && set_lds<32>() && set_lds<64>() && set_lds<128>() && set_lds<256>() && set_lds<512>() && set_lds<1024>() && set_lds<2048>() && set_lds<4096>();
#endif
        if (!ok) { grid = -1; return; }
        (void)hipGetLastError();
        grid = cus;
    }
    if (grid < 0) return;
    (void)hipMemsetAsync((char*)d_ws + WS_CTL, 0, CTL_ZERO_BYTES, stream);
    Args a{};
    for (int i = 0; i < N_IN; ++i) a.in[i] = (const float*)d_in[i];
    a.out = (float*)d_out; a.ws = (unsigned char*)d_ws;
#if MK_ONE_LAUNCH
    a.ph_lo = 0; a.ph_hi = N_PHASES; launch_pm<0x1fff>(grid, stream, a);
#else
#define LP(p) a.ph_lo = (p); a.ph_hi = (p) + 1; launch_pm<(1 << (p))>(grid, stream, a);
    LP(0) LP(1) LP(2) LP(3) LP(4) LP(5) LP(6) LP(7) LP(8) LP(9) LP(10) LP(11) LP(12)
#undef LP
#endif
}
```

```cpp
#include <hip/hip_runtime.h>
#include <cstdio>
#include <cstdint>
namespace pg8 {
#define PG8_LAS __attribute__((address_space(3)))
typedef unsigned short bf16_t;
typedef short bf16x8 __attribute__((ext_vector_type(8)));
typedef float f32x4 __attribute__((ext_vector_type(4)));
typedef unsigned u32x4 __attribute__((ext_vector_type(4)));
constexpr int BM = 256, BK = 64, HALF = 128, HTB = HALF * BK * 2  , STAGE_BYTES = 8 * HTB, NXCD = 8, WGM = 8;

__host__ __device__ __forceinline__ int lds_byte(int r, int c) { const int st = (r >> 4) * 2 + (c >> 5), rr = r & 15, cc = c & 31, ob = rr * 64 + cc * 2; return st * 1024 + (ob ^ (((ob >> 9) & 1) << 5)); }
__host__ __device__ __forceinline__ void stage_rc(int b, int& R, int& C) { const int st = b / 1024, sb = b % 1024, swz = sb ^ (((sb >> 9) & 1) << 5); R = (st >> 1) * 16 + swz / 64; C = (st & 1) * 32 + (swz % 64) / 2; }
__host__ __device__ __forceinline__ int perm32(int rho) { const int n = rho >> 4, i = rho & 15; return 8 * (i >> 2) + 4 * n + (i & 3); }

struct Unit { int pm, pn, kt0, nt; };
struct Gemm { const bf16_t* A; const bf16_t* Bt; int M, N, K; };

struct StaticOrder {
    int nM, nN, nwg, G, c, ntf;
    __host__ __device__ void init(int M, int N, int G_, int c_, int K_) { nM = M / BM; nN = N / BM; nwg = nM * nN; G = G_; c = c_; ntf = K_ / BK; }
    __host__ __device__ bool next(int i, Unit& u) const {
        const long L = (long)i * G + c; if (L >= nwg) return false;
        int wgid = (int)L; { const int q = nwg / NXCD, r = nwg % NXCD, xcd = wgid % NXCD, off = wgid / NXCD; wgid = (xcd < r ? xcd * (q + 1) : r * (q + 1) + (xcd - r) * q) + off; }
        const int nig = WGM * nN, gid = wgid / nig, fm = gid * WGM, gsz = (nM - fm) < WGM ? (nM - fm) : WGM;
        u.pm = fm + ((wgid % nig) % gsz); u.pn = (wgid % nig) / gsz; u.kt0 = 0; u.nt = ntf; return true;
    }
    __device__ __forceinline__ void a_ready(const Unit&) const {}
    __device__ __forceinline__ void done(const Unit&) const {}
};
struct TailOrder {
    StaticOrder P; int S, ntf;
    __host__ __device__ void init(int G_, int c_, int K_, int S_) { P.init(64 * BM, 4 * BM, G_, c_, K_); S = S_; ntf = K_ / BK; }
    __host__ __device__ bool next(int i, Unit& u) const {
        const long L = (long)i * P.G + P.c; if (L >= 256 + 8 * S) return false;
        const int Li = (int)L; const bool prm = Li < 256;
        const int w0 = prm ? Li : 0, wg = (w0 % NXCD) * (256 / NXCD) + w0 / NXCD, nig = WGM * 4, gid = wg / nig, fm = gid * WGM;
        const int pmP = fm + ((wg % nig) % WGM), pnP = (wg % nig) / WGM;
        const int Ls = prm ? 0 : Li - 256, tile = Ls / S, sl = Ls % S, nts = ntf / S;
        u.pm = prm ? pmP : 64 + (tile >> 2); u.pn = prm ? pnP : (tile & 3); u.nt = prm ? ntf : nts; u.kt0 = prm ? 0 : sl * nts; return true;
    }
    __device__ __forceinline__ void a_ready(const Unit&) const {}
    __device__ __forceinline__ void done(const Unit&) const {}
};


typedef float f32x2_t __attribute__((ext_vector_type(2))); typedef __bf16 bf16x2_t __attribute__((ext_vector_type(2)));
__device__ __forceinline__ unsigned cvt_pk_bf16(float lo, float hi) { f32x2_t v = {lo, hi}; bf16x2_t b = __builtin_convertvector(v, bf16x2_t); return __builtin_bit_cast(unsigned, b); }
__device__ __forceinline__ u32x4 pack8(f32x4 v0, f32x4 v1) { u32x4 w; w.x = cvt_pk_bf16(v0[0], v0[1]); w.y = cvt_pk_bf16(v0[2], v0[3]); w.z = cvt_pk_bf16(v1[0], v1[1]); w.w = cvt_pk_bf16(v1[2], v1[3]); return w; }

template <int M> __device__ __forceinline__ float swz_xor(float v) { return __int_as_float(__builtin_amdgcn_ds_swizzle(__float_as_int(v), (M << 10) | 0x1f)); }
__device__ __forceinline__ float add_x32(float v) { auto r = __builtin_amdgcn_permlane32_swap(__float_as_uint(v), __float_as_uint(v), false, false); return __uint_as_float(r[0]) + __uint_as_float(r[1]); }
__device__ __forceinline__ float max_x32(float v) { auto r = __builtin_amdgcn_permlane32_swap(__float_as_uint(v), __float_as_uint(v), false, false); return fmaxf(__uint_as_float(r[0]), __uint_as_float(r[1])); }
__device__ __forceinline__ float add_x16(float v) { return v + swz_xor<16>(v); }
template <int CTRL> __device__ __forceinline__ float dpp_mov(float v) { return __int_as_float(__builtin_amdgcn_update_dpp(0, __float_as_int(v), CTRL, 0xf, 0xf, false)); }
__device__ __forceinline__ float sum16_dpp(float v) { v += dpp_mov<0xB1>(v); v += dpp_mov<0x4E>(v); v += dpp_mov<0x141>(v); v += dpp_mov<0x140>(v); return v; }
__device__ __forceinline__ float max16_dpp(float v) { v = fmaxf(v, dpp_mov<0xB1>(v)); v = fmaxf(v, dpp_mov<0x4E>(v)); v = fmaxf(v, dpp_mov<0x141>(v)); v = fmaxf(v, dpp_mov<0x140>(v)); return v; }
__device__ __forceinline__ float sum4_dpp(float v) { v += dpp_mov<0xB1>(v); v += dpp_mov<0x4E>(v); return v; }
__device__ __forceinline__ float hsum4(f32x4 a) { return (a[0] + a[1]) + (a[2] + a[3]); }
__device__ __forceinline__ float row_rstd(const float* ssq, int row) {
    const f32x4* p = (const f32x4*)(ssq + (size_t)row * 16);
    const f32x4 a = p[0], b = p[1], c = p[2], d = p[3];
    const float s = (hsum4(a) + hsum4(b)) + (hsum4(c) + hsum4(d));
    return rsqrtf(s * (1.0f / 1024.0f) + 1e-6f);
}
template <int ACT> struct EpiScaleBf16 {
    static constexpr bool PERM = true, AFTER_DRAIN = false;
    bf16_t* O; int ldc; const float* ssq;
    __device__ __forceinline__ void operator()(const f32x4 (&acc)[2][2][4][2], const Unit& u, int wr, int wc, int fr_, int fq_) const {
        int fr = fr_, fq = fq_; asm volatile("" : "+v"(fr), "+v"(fq));
        const int row0 = u.pm * BM + wr * 64 + fr, col0 = u.pn * BM + wc * 32 + 8 * fq;
#pragma unroll
        for (int ai = 0; ai < 2; ++ai)
#pragma unroll
            for (int m = 0; m < 4; ++m) { const int row = row0 + ai * HALF + m * 16; const float rs = row_rstd(ssq, row); bf16_t* rowp = O + (size_t)row * ldc + col0;
#pragma unroll
                for (int bj = 0; bj < 2; ++bj) { f32x4 v0 = acc[ai][bj][m][0] * rs, v1 = acc[ai][bj][m][1] * rs;
                    if (ACT == 1) {
#pragma unroll
                        for (int e = 0; e < 4; ++e) { const float a = fmaxf(v0[e], 0.f), b = fmaxf(v1[e], 0.f); v0[e] = a * a; v1[e] = b * b; } }
                    *(u32x4*)(rowp + bj * HALF) = pack8(v0, v1); } }
    }
};
struct EpiResid {
    static constexpr bool PERM = true, AFTER_DRAIN = false;
    const float* base; const float* base2; int split; float* out; bf16_t* hb; float* ssq_out; float* slab; int S; const bf16_t* hbase = nullptr; int omask = -1;
    __device__ __forceinline__ void operator()(const f32x4 (&acc)[2][2][4][2], const Unit& u, int wr, int wc, int fr_, int fq_) const {
        int fr = fr_, fq = fq_; asm volatile("" : "+v"(fr), "+v"(fq));
        if (slab && u.pm >= 64) {
            float* sp = slab + ((size_t)((((u.pm - 64) << 2) + u.pn) * S + u.kt0 / u.nt) << 16) + (size_t)(wr * 64 + fr) * 256 + wc * 32 + 8 * fq;
#pragma unroll
            for (int ai = 0; ai < 2; ++ai)
#pragma unroll
                for (int m = 0; m < 4; ++m)
#pragma unroll
                    for (int bj = 0; bj < 2; ++bj) { float* p = sp + (size_t)(ai * HALF + m * 16) * 256 + bj * HALF; *(f32x4*)p = acc[ai][bj][m][0]; *(f32x4*)(p + 4) = acc[ai][bj][m][1]; }
            return;
        }
        const int row0 = u.pm * BM + wr * 64 + fr, col0 = u.pn * BM + wc * 32 + 8 * fq;
#pragma unroll
        for (int ai = 0; ai < 2; ++ai)
#pragma unroll
            for (int m = 0; m < 4; ++m) { const int row = row0 + ai * HALF + m * 16;
                const float* bp = (row < split ? base + (size_t)row * 1024 : base2 + (size_t)(row - split) * 1024) + col0;
                float ss = 0.f;
#pragma unroll
                for (int bj = 0; bj < 2; ++bj) { f32x4 b0, b1;
                    if (hbase) { const u32x4 w = *(const u32x4*)(hbase + (size_t)row * 1024 + col0 + bj * HALF);
                        b0 = (f32x4){__uint_as_float(w.x << 16), __uint_as_float(w.x & 0xffff0000u), __uint_as_float(w.y << 16), __uint_as_float(w.y & 0xffff0000u)};
                        b1 = (f32x4){__uint_as_float(w.z << 16), __uint_as_float(w.z & 0xffff0000u), __uint_as_float(w.w << 16), __uint_as_float(w.w & 0xffff0000u)}; }
                    else { b0 = *(const f32x4*)(bp + bj * HALF); b1 = *(const f32x4*)(bp + bj * HALF + 4); }
                    const f32x4 h0 = b0 + acc[ai][bj][m][0], h1 = b1 + acc[ai][bj][m][1];
                    if (out) { float* op = out + (size_t)(row & omask) * 1024 + col0; *(f32x4*)(op + bj * HALF) = h0; *(f32x4*)(op + bj * HALF + 4) = h1; }
                    if (hb) *(u32x4*)(hb + (size_t)row * 1024 + col0 + bj * HALF) = pack8(h0, h1);
                    ss += hsum4(h0 * h0) + hsum4(h1 * h1); }
                if (ssq_out) { ss = add_x16(ss); ss = add_x32(ss); if (fq == 0) ssq_out[(size_t)row * 16 + u.pn * 4 + wc] = ss; }
                if (m & 1) asm volatile("" ::: "memory"); }
    }
};
template <class Epi, class Sched, bool ALIGN_EPI = false, bool SP2 = false>
__device__ __forceinline__ void gemm_phase(PG8_LAS unsigned char* lds, const Gemm g, const Sched& S, const Epi& E, int wid_in, int lane_in) {
    const int wid = wid_in, lane = lane_in, tid = wid * 64 + lane, wr = wid >> 2, wc = wid & 3, fr = lane & 15, fq = lane >> 4;
    const int K = g.K;
    unsigned voffA[2], voffB[2];
#pragma unroll
    for (int i = 0; i < 2; ++i) { int R, C; stage_rc(tid * 16 + i * 8192, R, C); const int Rb = Epi::PERM ? ((R & ~31) + perm32(R & 31)) : R;
        voffA[i] = (unsigned)(R * K + C) * 2u; voffB[i] = (unsigned)(Rb * K + C) * 2u; }
    const size_t kstep = (size_t)(BK * 2);
    const size_t hstep = (size_t)HALF * K * 2;
    const size_t tstep = 2 * hstep;
    const unsigned ldsw = (unsigned)wid * 1024u;
    const int aoff = lds_byte(wr * 64 + fr, fq * 8), boff = lds_byte(wc * 32 + fr, fq * 8);
#define PG8_SA(b, h) (((b) * 2 + (h)) * HTB)
#define PG8_SB(b, h) ((4 + (b) * 2 + (h)) * HTB)
#define PG8_STAGE(bufoff, gbase, voff) do { _Pragma("unroll") for (int _i = 0; _i < 2; ++_i) \
        __builtin_amdgcn_global_load_lds((const unsigned*)((const char*)(gbase) + (voff)[_i]), (PG8_LAS unsigned*)(lds + (bufoff) + ldsw + _i * 8192), 16, 0, 0); } while (0)
#define PG8_LDA(dst, b, h) do { _Pragma("unroll") for (int m = 0; m < 4; ++m) _Pragma("unroll") for (int k = 0; k < 2; ++k) dst[m][k] = *(const PG8_LAS bf16x8*)(lds + PG8_SA(b, h) + aoff + m * 2048 + k * 1024); } while (0)
#define PG8_LDB(dst, b, h) do { _Pragma("unroll") for (int n = 0; n < 2; ++n) _Pragma("unroll") for (int k = 0; k < 2; ++k) dst[n][k] = *(const PG8_LAS bf16x8*)(lds + PG8_SB(b, h) + boff + n * 2048 + k * 1024); } while (0)
#define PG8_MMA(ai, bj, At, Bt) do { __builtin_amdgcn_s_setprio(1); _Pragma("unroll") for (int m = 0; m < 4; ++m) _Pragma("unroll") for (int n = 0; n < 2; ++n) _Pragma("unroll") for (int k = 0; k < 2; ++k) \
        acc[ai][bj][m][n] = __builtin_amdgcn_mfma_f32_16x16x32_bf16(Bt[n][k], At[m][k], acc[ai][bj][m][n], 0, 0, 0); __builtin_amdgcn_s_setprio(0); } while (0)
#define PG8_WAIT_V(n) asm volatile("s_waitcnt vmcnt(" #n ")" ::: "memory")
#define PG8_WAIT_L(n) asm volatile("s_waitcnt lgkmcnt(" #n ")" ::: "memory")
#define PG8_BAR __builtin_amdgcn_s_barrier()
#define PG8_SCHED __builtin_amdgcn_sched_barrier(0)
    Unit cur, nxt; int ui = 0;
    if (!S.next(0, cur)) return;
    f32x4 acc[2][2][4][2];
#pragma unroll
    for (int a = 0; a < 2; ++a)
#pragma unroll
        for (int b = 0; b < 2; ++b)
#pragma unroll
            for (int m = 0; m < 4; ++m)
#pragma unroll
                for (int n = 0; n < 2; ++n) acc[a][b][m][n] = (f32x4){0.f, 0.f, 0.f, 0.f};
    bf16x8 At[4][2], B0[2][2], B1[2][2];
    const char* cA = (const char*)g.A + (size_t)cur.pm * tstep + (size_t)cur.kt0 * kstep; const char* cB = (const char*)g.Bt + (size_t)cur.pn * tstep + (size_t)cur.kt0 * kstep;
    S.a_ready(cur);
    if constexpr (SP2) {
        PG8_STAGE(PG8_SB(0, 0), cB, voffB); PG8_STAGE(PG8_SB(0, 1), cB + hstep, voffB); PG8_STAGE(PG8_SA(0, 0), cA, voffA); PG8_STAGE(PG8_SA(0, 1), cA + hstep, voffA);
        if (wr == 1) PG8_BAR;
        PG8_WAIT_V(2); PG8_BAR;
        PG8_STAGE(PG8_SB(1, 0), cB + kstep, voffB); PG8_STAGE(PG8_SA(1, 0), cA + kstep, voffA); PG8_STAGE(PG8_SB(1, 1), cB + hstep + kstep, voffB);
        PG8_WAIT_V(6); PG8_BAR;
    } else {
        PG8_STAGE(PG8_SB(0, 0), cB, voffB); PG8_STAGE(PG8_SA(0, 0), cA, voffA); PG8_STAGE(PG8_SB(0, 1), cB + hstep, voffB); PG8_STAGE(PG8_SA(0, 1), cA + hstep, voffA);
        if (wr == 1) PG8_BAR;
        PG8_WAIT_V(4); PG8_BAR;
        PG8_STAGE(PG8_SB(1, 0), cB + kstep, voffB); PG8_STAGE(PG8_SA(1, 0), cA + kstep, voffA); PG8_STAGE(PG8_SB(1, 1), cB + hstep + kstep, voffB);
        PG8_WAIT_V(6); PG8_BAR;
    }
    for (;;) {
        const bool has_next = S.next(ui + 1, nxt);
        const char* nA = has_next ? (const char*)g.A + (size_t)nxt.pm * tstep + (size_t)nxt.kt0 * kstep : cA; const char* nB = has_next ? (const char*)g.Bt + (size_t)nxt.pn * tstep + (size_t)nxt.kt0 * kstep : cB;
        const int nt = cur.nt;
        for (int t = 0; t < nt; t += 2) {
            const bool last = (t == nt - 2);
            const char* a1 = cA + (size_t)(t + 1) * kstep;
            const char* a2 = last ? nA : cA + (size_t)(t + 2) * kstep; const char* b2 = last ? nB : cB + (size_t)(t + 2) * kstep;
            const char* a3 = a2 + kstep; const char* b3 = b2 + kstep;
            if (last && has_next) S.a_ready(nxt);
            if constexpr (SP2) {
            PG8_LDB(B0, 0, 0); PG8_LDB(B1, 0, 1); PG8_SCHED; PG8_LDA(At, 0, 0); PG8_STAGE(PG8_SA(1, 1), a1 + hstep, voffA);
            PG8_WAIT_V(8); PG8_WAIT_L(0); PG8_BAR; PG8_MMA(0, 0, At, B0); PG8_MMA(0, 1, At, B1); PG8_BAR; PG8_SCHED;
            PG8_LDA(At, 0, 1); PG8_STAGE(PG8_SB(0, 0), b2, voffB); PG8_STAGE(PG8_SB(0, 1), b2 + hstep, voffB); PG8_STAGE(PG8_SA(0, 0), a2, voffA);
            PG8_WAIT_V(8); PG8_WAIT_L(0); PG8_BAR; PG8_MMA(1, 0, At, B0); PG8_MMA(1, 1, At, B1); PG8_BAR; PG8_SCHED;
            PG8_LDB(B0, 1, 0); PG8_LDB(B1, 1, 1); PG8_SCHED; PG8_LDA(At, 1, 0); PG8_STAGE(PG8_SA(0, 1), a2 + hstep, voffA);
            PG8_WAIT_V(8); PG8_WAIT_L(0); PG8_BAR; PG8_MMA(0, 0, At, B0); PG8_MMA(0, 1, At, B1); PG8_BAR; PG8_SCHED;
            PG8_LDA(At, 1, 1); PG8_STAGE(PG8_SB(1, 0), b3, voffB); PG8_STAGE(PG8_SB(1, 1), b3 + hstep, voffB); PG8_STAGE(PG8_SA(1, 0), a3, voffA);
            PG8_WAIT_V(8); PG8_WAIT_L(0); PG8_BAR; PG8_MMA(1, 0, At, B0); PG8_MMA(1, 1, At, B1); PG8_BAR; PG8_SCHED;
            } else {
            PG8_LDB(B0, 0, 0); PG8_SCHED; PG8_LDA(At, 0, 0); PG8_STAGE(PG8_SA(1, 1), a1 + hstep, voffA);
            PG8_WAIT_L(8); PG8_BAR; PG8_WAIT_L(0); PG8_MMA(0, 0, At, B0); PG8_BAR; PG8_SCHED;
            PG8_LDB(B1, 0, 1); PG8_STAGE(PG8_SB(0, 0), b2, voffB);
            PG8_BAR; PG8_WAIT_L(0); PG8_MMA(0, 1, At, B1); PG8_BAR;
            PG8_LDA(At, 0, 1); PG8_STAGE(PG8_SA(0, 0), a2, voffA);
            PG8_BAR; PG8_WAIT_L(0); PG8_MMA(1, 0, At, B0); PG8_BAR; PG8_SCHED;
            PG8_STAGE(PG8_SB(0, 1), b2 + hstep, voffB);
            PG8_WAIT_V(6); PG8_BAR; PG8_MMA(1, 1, At, B1); PG8_BAR;
            PG8_LDB(B0, 1, 0); PG8_SCHED; PG8_LDA(At, 1, 0); PG8_STAGE(PG8_SA(0, 1), a2 + hstep, voffA);
            PG8_WAIT_L(8); PG8_BAR; PG8_WAIT_L(0); PG8_MMA(0, 0, At, B0); PG8_BAR; PG8_SCHED;
            PG8_LDB(B1, 1, 1); PG8_STAGE(PG8_SB(1, 0), b3, voffB);
            PG8_BAR; PG8_WAIT_L(0); PG8_MMA(0, 1, At, B1); PG8_BAR;
            PG8_LDA(At, 1, 1); PG8_STAGE(PG8_SA(1, 0), a3, voffA);
            PG8_BAR; PG8_WAIT_L(0); PG8_MMA(1, 0, At, B0); PG8_BAR; PG8_SCHED;
            PG8_STAGE(PG8_SB(1, 1), b3 + hstep, voffB);
            PG8_WAIT_V(6); PG8_BAR; PG8_MMA(1, 1, At, B1); PG8_BAR;
            }
        }
        if constexpr (ALIGN_EPI) { if (wr == 0) PG8_BAR; }
        if constexpr (!Epi::AFTER_DRAIN) { E(acc, cur, wr, wc, fr, fq); S.done(cur); }
        if (!has_next) break;
#pragma unroll
        for (int a = 0; a < 2; ++a)
#pragma unroll
            for (int b = 0; b < 2; ++b)
#pragma unroll
                for (int m = 0; m < 4; ++m)
#pragma unroll
                    for (int n = 0; n < 2; ++n) acc[a][b][m][n] = (f32x4){0.f, 0.f, 0.f, 0.f};
        cur = nxt; cA = nA; cB = nB; ++ui;
        if constexpr (ALIGN_EPI) { if (wr == 1) PG8_BAR; }
    }
    PG8_WAIT_V(0);
    if constexpr (!ALIGN_EPI) { if (wr == 0) PG8_BAR; }
    PG8_BAR;
    if constexpr (Epi::AFTER_DRAIN) { E.fused(acc, cur, wr, wc, fr, fq, lds, wid, lane); S.done(cur); }
#undef PG8_SA
#undef PG8_SB
#undef PG8_STAGE
#undef PG8_LDA
#undef PG8_LDB
#undef PG8_MMA
#undef PG8_WAIT_V
#undef PG8_WAIT_L
#undef PG8_BAR
#undef PG8_SCHED
}
}

constexpr int NWAVES = 8;
#ifndef MK_ONE_LAUNCH
#define MK_ONE_LAUNCH 1
#endif
constexpr int DM = 1024, RP = 16384  , RS = 512  , R = RP + RS, T = 8192, NB = 2, SB = 128, ST = 4;
constexpr int NCOLA = 2816, RWKV_COLS = 2560, NH = 12, HD = 64, FF = 4096, NCOLB = 1536, NMEM = 256;
constexpr int NCHUNK = RP / 64  , NUNIT = NCHUNK * NH  ;
constexpr float C2Q = 0.125f * 1.4426950408889634f;
constexpr float LOG2E = 1.4426950408889634f;
enum { I_XP = 0, I_XS, I_SSHIFT, I_SWKV, I_CSK, I_CSV, I_CMK, I_CMV, I_MEMP, I_NMIX, I_NMLP, I_WOUT, I_WUP, I_WDN, I_MNORM, I_WMKV, I_MQN, I_MKN,
       I_WINA, I_MU, I_WW2, I_W0, I_WA2, I_A0, I_WG2, I_KK, I_KA, I_RK, I_LNW, I_LNB, I_WINB, I_QN, I_SINKS, I_KVN, I_WKV, I_KN, N_IN };
constexpr size_t O_Y = 0, O_PSHIFT = (size_t)R * DM, O_PWKV = O_PSHIFT + 2 * RWKV_COLS, O_PSK = O_PWKV + 2 * 12 * 4096, O_PSV = O_PSK + 2 * 128 * 256,
                 O_PMK = O_PSV + 2 * 128 * 256, O_PMV = O_PMK + 2 * 2 * 256 * 256, O_SSHIFT = O_PMV + 2 * 2 * 256 * 256, O_SWKV = O_SSHIFT + (size_t)SB * RWKV_COLS,
                 O_SSK = O_SWKV + (size_t)SB * 12 * 4096, O_SSV = O_SSK + (size_t)SB * 128 * 256, O_END = O_SSV + (size_t)SB * 128 * 256;
constexpr size_t al256(size_t x) { return (x + 255) & ~(size_t)255; }
constexpr size_t WS_CTL = 0, CTL_ZERO_BYTES = 1u << 20;
constexpr size_t WS_WA = CTL_ZERO_BYTES;
constexpr size_t WS_WOUT = WS_WA + (size_t)NCOLA * DM * 2;
constexpr size_t WS_WUP = WS_WOUT + (size_t)2 * DM * DM * 2;
constexpr size_t WS_WDN = WS_WUP + (size_t)2 * FF * DM * 2;
constexpr size_t WS_WB = WS_WDN + (size_t)2 * FF * DM * 2;
constexpr size_t WS_WM = WS_WB + (size_t)NCOLB * DM * 2;
constexpr size_t WS_WW2 = WS_WM + (size_t)DM * DM * 2;
constexpr size_t WS_WA2 = WS_WW2 + (size_t)768 * 64 * 2;
constexpr size_t WS_WG2 = WS_WA2 + (size_t)768 * 64 * 2;
constexpr size_t WS_ROPE = WS_WG2 + (size_t)768 * 128 * 2;
constexpr size_t WS_SSQ = al256(WS_ROPE + (size_t)8196 * 64 * 4);
constexpr size_t WS_SSQM = WS_SSQ + (size_t)R * 16 * 4;
constexpr size_t WS_MB = WS_SSQM + (size_t)512 * 16 * 4;
constexpr size_t WS_MK = WS_MB + (size_t)512 * DM * 2;
constexpr size_t WS_MVT = WS_MK + (size_t)2 * 2 * 4 * 256 * 64 * 2;
constexpr size_t WS_HB = WS_MVT + (size_t)2 * 2 * 4 * 256 * 64 * 2;
constexpr size_t WS_MIX = WS_HB + (size_t)R * DM * 2;
constexpr size_t WS_BIG = WS_MIX + (size_t)R * DM * 2;
constexpr size_t WS_PROJ = WS_BIG;
constexpr size_t WS_REC = WS_PROJ + (size_t)R * NCOLA * 2;
constexpr size_t REC_BYTES = 5 * 8192;
constexpr size_t WS_END0 = WS_REC + (size_t)NUNIT * REC_BYTES;
constexpr size_t WS_H = WS_BIG;
constexpr size_t WS_END1 = WS_H + (size_t)R * FF * 2;
constexpr size_t WS_SLAB = WS_BIG + ((size_t)160 << 20);
constexpr int S_K1 = 4, S_K4 = 16;
constexpr size_t WS_Q1 = WS_BIG;
constexpr size_t WS_K1 = WS_Q1 + (size_t)R * DM * 2;
constexpr size_t WS_V1 = WS_K1 + (size_t)R * 256 * 2;
constexpr size_t WS_VT1 = WS_V1 + (size_t)R * 256 * 2;
constexpr size_t WS_END = WS_END0 > WS_END1 ? WS_END0 : WS_END1;
static_assert(WS_VT1 + (size_t)2 * 4 * 64 * 8192 * 2 <= WS_END && WS_END1 <= WS_SLAB && WS_SLAB + ((size_t)32 << 20) <= WS_END, "ws map");
constexpr int CW_BAR = 4096;
constexpr int RING_OFF = 0, RING_BYTES = 131072, PREP_HALF = 73728, LDSCTL_OFF = 147456, MISC_OFF = LDSCTL_OFF + 320, WTOT_OFF = LDSCTL_OFF + 1024, LDS_BYTES = LDSCTL_OFF + 4096;

#define GAS __attribute__((address_space(1)))
#define LAS __attribute__((address_space(3)))
typedef unsigned short bf16;
typedef unsigned v4u __attribute__((ext_vector_type(4)));
typedef unsigned v2u __attribute__((ext_vector_type(2)));
typedef float f32x4 __attribute__((ext_vector_type(4)));
typedef float f32x16 __attribute__((ext_vector_type(16)));
typedef short bf16x8 __attribute__((ext_vector_type(8)));
typedef short bf16x4 __attribute__((ext_vector_type(4)));
typedef GAS unsigned gu32;
#define RLX_AGENT __ATOMIC_RELAXED, __HIP_MEMORY_SCOPE_AGENT
#define LDS_WAIT() asm volatile("s_waitcnt lgkmcnt(0)" ::: "memory")
#define VM_WAIT() asm volatile("s_waitcnt vmcnt(0)" ::: "memory")
using pg8::cvt_pk_bf16;
__device__ __forceinline__ int mk_lane() { int l; asm volatile("v_mbcnt_lo_u32_b32 %0, -1, 0\n\tv_mbcnt_hi_u32_b32 %0, -1, %0" : "=v"(l)); return l; }
__device__ __forceinline__ float bf2f(unsigned v) { return __uint_as_float(v << 16); }
__device__ __forceinline__ float bflo(unsigned w) { return __uint_as_float(w << 16); }
__device__ __forceinline__ float bfhi(unsigned w) { return __uint_as_float(w & 0xffff0000u); }
__device__ __forceinline__ bf16 f2bf(float f) { return (bf16)(cvt_pk_bf16(f, 0.f) & 0xffffu); }
__device__ __forceinline__ v2u pack4(f32x4 v) { v2u w; w.x = cvt_pk_bf16(v[0], v[1]); w.y = cvt_pk_bf16(v[2], v[3]); return w; }
__device__ __forceinline__ f32x4 unpack4(v2u w) { return (f32x4){bflo(w.x), bfhi(w.x), bflo(w.y), bfhi(w.y)}; }
__device__ __forceinline__ f32x4 mfma16(bf16x8 a, bf16x8 b, f32x4 c) { return __builtin_amdgcn_mfma_f32_16x16x32_bf16(a, b, c, 0, 0, 0); }
__device__ __forceinline__ f32x16 mfma32(bf16x8 a, bf16x8 b, f32x16 c) { return __builtin_amdgcn_mfma_f32_32x32x16_bf16(a, b, c, 0, 0, 0); }
using pg8::swz_xor; using pg8::add_x32; using pg8::max_x32; using pg8::add_x16; using pg8::sum16_dpp; using pg8::max16_dpp; using pg8::sum4_dpp;
__device__ __forceinline__ float sum16(float v) { return sum16_dpp(v); }
__device__ __forceinline__ float wave_sum(float v) { v = sum16_dpp(v); v = add_x16(v); return add_x32(v); }
__device__ __forceinline__ float wave_max(float v) { v = max16_dpp(v); v = fmaxf(v, swz_xor<16>(v)); return max_x32(v); }
__device__ __forceinline__ float fsigmoid(float x) { return 1.0f / (1.0f + __expf(-x)); }
__device__ __forceinline__ float ftanh(float x) { const float e = __expf(2.0f * x); return 1.0f - 2.0f / (e + 1.0f); }
namespace pg8 {
__device__ __forceinline__ void head_norm(f32x4 (&x)[2][2], const float* gain, int fq) {
    float ss = 0.f;
#pragma unroll
    for (int bj = 0; bj < 2; ++bj)
#pragma unroll
        for (int n = 0; n < 2; ++n) ss += hsum4(x[bj][n] * x[bj][n]);
    ss = add_x16(ss); ss = add_x32(ss);
    const float rs = rsqrtf(ss * (1.0f / 64.0f) + 1e-6f);
#pragma unroll
    for (int bj = 0; bj < 2; ++bj)
#pragma unroll
        for (int n = 0; n < 2; ++n) { const f32x4 g = *(const f32x4*)(gain + 32 * bj + 8 * fq + 4 * n); x[bj][n] = x[bj][n] * rs * g; }
}
__device__ __forceinline__ void head_rope(f32x4 (&x)[2][2], const float* cs  , int fq) {
#pragma unroll
    for (int n = 0; n < 2; ++n) { const f32x4 t0 = *(const f32x4*)(cs + 2 * (8 * fq + 4 * n)), t1 = *(const f32x4*)(cs + 2 * (8 * fq + 4 * n) + 4);
        const f32x4 cc = {t0[0], t0[2], t1[0], t1[2]}, sn = {t0[1], t0[3], t1[1], t1[3]};
        const f32x4 x1 = x[0][n], x2 = x[1][n]; x[0][n] = x1 * cc - x2 * sn; x[1][n] = x2 * cc + x1 * sn; }
}
struct EpiL1 {
    static constexpr bool PERM = true, AFTER_DRAIN = false;
    unsigned char* ws; float* outp; const float* g_q; const float* g_mq; const float* g_k;
    __device__ __forceinline__ void operator()(const f32x4 (&acc)[2][2][4][2], const Unit& u, int wr, int wc, int fr_, int fq_) const {
        int fr = fr_, fq = fq_; asm volatile("" : "+v"(fr), "+v"(fq));
        const float* ssq = (const float*)(ws + WS_SSQ); const float* rope = (const float*)(ws + WS_ROPE); const float c2 = C2Q;
        bf16_t* Q1 = (bf16_t*)(ws + WS_Q1); bf16_t* K1 = (bf16_t*)(ws + WS_K1); bf16_t* V1 = (bf16_t*)(ws + WS_V1); bf16_t* VT1 = (bf16_t*)(ws + WS_VT1);
        float* p_k = outp + O_PSK; float* p_v = outp + O_PSV; float* s_k = outp + O_SSK; float* s_v = outp + O_SSV;
        const int H = u.pn * 4 + wc, row0 = u.pm * BM + wr * 64 + fr;
#pragma unroll
        for (int ai = 0; ai < 2; ++ai)
#pragma unroll
            for (int m = 0; m < 4; ++m) { const int row = row0 + ai * HALF + m * 16; const float rs = row_rstd(ssq, row);
                const int pidx = row < 16384 ? (row & 8191) : 8192 + ((row - 16384) & 3);
                f32x4 x[2][2];
#pragma unroll
                for (int bj = 0; bj < 2; ++bj)
#pragma unroll
                    for (int n = 0; n < 2; ++n) x[bj][n] = acc[ai][bj][m][n] * rs;
                if (H < 16) {
                    head_norm(x, H < 12 ? g_q : g_mq, fq);
                    if (H < 12) head_rope(x, rope + (size_t)pidx * 64, fq);
#pragma unroll
                    for (int bj = 0; bj < 2; ++bj) *(u32x4*)(Q1 + (size_t)row * 1024 + H * 64 + 32 * bj + 8 * fq) = pack8(x[bj][0] * c2, x[bj][1] * c2);
                } else {
                    const int kh = (H - 16) & 3; const bool isk = H < 20;
                    if (isk) { head_norm(x, g_k, fq); head_rope(x, rope + (size_t)pidx * 64, fq); }
                    bf16_t* dst = isk ? K1 : V1;
#pragma unroll
                    for (int bj = 0; bj < 2; ++bj) *(u32x4*)(dst + (size_t)row * 256 + kh * 64 + 32 * bj + 8 * fq) = pack8(x[bj][0], x[bj][1]);
                    if (!isk && row < 16384) {
                        const int b = row >> 13, t = row & 8191;
#pragma unroll
                        for (int bj = 0; bj < 2; ++bj)
#pragma unroll
                            for (int n = 0; n < 2; ++n)
#pragma unroll
                                for (int e = 0; e < 4; ++e) { const int d = 32 * bj + 8 * fq + 4 * n + e; VT1[((size_t)(b * 4 + kh) * 64 + d) * 8192 + t] = (bf16_t)(cvt_pk_bf16(x[bj][n][e], 0.f) & 0xffffu); } }
                    float* o = nullptr;
                    if (row < 16384) { const int b = row >> 13, t = row & 8191; if (t >= 8064) o = (isk ? p_k : p_v) + ((size_t)(b * 128 + (t - 8064)) * 4 + kh) * 64; }
                    else { const int b = (row - 16384) >> 2, i = (row - 16384) & 3; o = (isk ? s_k : s_v) + ((size_t)(b * 128 + 124 + i) * 4 + kh) * 64; }
                    if (o) {
#pragma unroll
                        for (int bj = 0; bj < 2; ++bj) { *(f32x4*)(o + 32 * bj + 8 * fq) = x[bj][0]; *(f32x4*)(o + 32 * bj + 8 * fq + 4) = x[bj][1]; } }
                }
                asm volatile("" ::: "memory");
            }
    }
};
struct EpiMemKV {
    static constexpr bool PERM = true, AFTER_DRAIN = false;
    unsigned char* ws; float* outp; const float* g_k  ;
    __device__ __forceinline__ void operator()(const f32x4 (&acc)[2][2][4][2], const Unit& u, int wr, int wc, int fr_, int fq_) const {
        int fr = fr_, fq = fq_; asm volatile("" : "+v"(fr), "+v"(fq));
        const float* ssq = (const float*)(ws + WS_SSQM); float* p_k = outp + O_PMK; float* p_v = outp + O_PMV; bf16_t* MK = (bf16_t*)(ws + WS_MK)  ; bf16_t* MVT = (bf16_t*)(ws + WS_MVT)  ;
        const int H = u.pn * 4 + wc, l = H >> 3, isv = (H >> 2) & 1, hh = H & 3, row0 = u.pm * BM + wr * 64 + fr;
#pragma unroll
        for (int ai = 0; ai < 2; ++ai)
#pragma unroll
            for (int m = 0; m < 4; ++m) { const int row = row0 + ai * HALF + m * 16; const float rs = row_rstd(ssq, row); const int b = row >> 8, mm = row & 255;
                f32x4 x[2][2];
#pragma unroll
                for (int bj = 0; bj < 2; ++bj)
#pragma unroll
                    for (int n = 0; n < 2; ++n) x[bj][n] = acc[ai][bj][m][n] * rs;
                if (!isv) head_norm(x, g_k + l * 64, fq);
                float* o = (isv ? p_v : p_k) + ((((size_t)l * 2 + b) * 256 + mm) * 4 + hh) * 64;
#pragma unroll
                for (int bj = 0; bj < 2; ++bj) { *(f32x4*)(o + 32 * bj + 8 * fq) = x[bj][0]; *(f32x4*)(o + 32 * bj + 8 * fq + 4) = x[bj][1]; }
                if (!isv) {
#pragma unroll
                    for (int bj = 0; bj < 2; ++bj) *(u32x4*)(MK + ((((size_t)l * 2 + b) * 4 + hh) * 256 + mm) * 64 + 32 * bj + 8 * fq) = pack8(x[bj][0], x[bj][1]);
                } else {
#pragma unroll
                    for (int bj = 0; bj < 2; ++bj)
#pragma unroll
                        for (int n = 0; n < 2; ++n)
#pragma unroll
                            for (int e = 0; e < 4; ++e) { const int d = 32 * bj + 8 * fq + 4 * n + e; MVT[((((size_t)l * 2 + b) * 4 + hh) * 64 + d) * 256 + mm] = (bf16_t)(cvt_pk_bf16(x[bj][n][e], 0.f) & 0xffffu); }
                }
                asm volatile("" ::: "memory");
            }
    }
};
}
#define XB_TMO      128
#define XB_XCNT(j)  (256  + 64 * (j))
#define XB_XSUB(j)  (1280 + 64 * (j))
#define XB_XGEN(j)  (2304 + 64 * (j))
#define XB_TOP      3328
#define XB_TOPGEN   3392
#define XCD_BAR_WORDS 3456
#define XB_SPIN_CAP (1u << 18)

__device__ __forceinline__ unsigned xb_ld(unsigned* p)              { return __hip_atomic_load(p, __ATOMIC_RELAXED, __HIP_MEMORY_SCOPE_AGENT); }
__device__ __forceinline__ unsigned xb_add(unsigned* p, unsigned v) { return __hip_atomic_fetch_add(p, v, __ATOMIC_RELAXED, __HIP_MEMORY_SCOPE_AGENT); }
__device__ __forceinline__ unsigned xb_xcc_id() { return (unsigned)__builtin_amdgcn_s_getreg((3 << 11) | 20) & 0xFu; }
#define XB_SPIN(cond, bar) do { unsigned _sp = 0; while (cond) { __builtin_amdgcn_s_sleep(1); \
    if ((++_sp & 255u) == 0u) { if (xb_ld(&(bar)[XB_TMO])) break; if (_sp > XB_SPIN_CAP) { atomicAdd(&(bar)[XB_TMO], 1u); break; } } } } while (0)

struct XcdBarrier {
    bool wave0;
    unsigned* bar; unsigned x;
    volatile LAS unsigned* st;
};

__device__ __forceinline__ XcdBarrier xcd_barrier_post(unsigned* bar, volatile LAS unsigned* st, bool wave0) {
    XcdBarrier b; b.wave0 = wave0; b.bar = bar; b.x = xb_xcc_id(); b.st = st;
    if (wave0 && mk_lane() == 0) (void)xb_add(&bar[XB_XCNT(b.x)], 1u);
    return b;
}
__device__ __forceinline__ void xcd_barrier_complete(unsigned* bar, unsigned x, unsigned& nloc, unsigned& nx) {
    const unsigned G = gridDim.x * gridDim.y * gridDim.z;
    unsigned sum, cnt, mine, sp = 0u;
    for (;;) {
        sum = 0u; cnt = 0u; mine = 0u;
#pragma unroll
        for (unsigned j = 0; j < 16; ++j) { const unsigned c = xb_ld(&bar[XB_XCNT(j)]); sum += c; cnt += (c > 0u) ? 1u : 0u; mine = (j == x) ? c : mine; }
        if (sum == G) break;
        __builtin_amdgcn_s_sleep(1);
        if ((++sp & 255u) == 0u) { if (xb_ld(&bar[XB_TMO])) break; if (sp > XB_SPIN_CAP) { atomicAdd(&bar[XB_TMO], 1u); break; } }
    }
    nloc = mine > 0u ? mine : 1u; nx = cnt > 0u ? cnt : 1u;
}

__device__ __forceinline__ void xcd_barrier(const XcdBarrier& b) {
    asm volatile("s_waitcnt vmcnt(0)" ::: "memory");
    __syncthreads();
    if (b.wave0 && mk_lane() == 0) {
        unsigned* bar = b.bar;
        __builtin_amdgcn_s_waitcnt(0);
        unsigned nloc = b.st[0], nx = b.st[1];
        if (nloc == 0u) { xcd_barrier_complete(bar, b.x, nloc, nx); b.st[0] = nloc; b.st[1] = nx; }
        const unsigned old = xb_add(&bar[XB_XSUB(b.x)], 1u);
        const unsigned gen = old / nloc;
        if (old + 1u == (gen + 1u) * nloc) {
            __builtin_amdgcn_fence(__ATOMIC_RELEASE, "agent");
            asm volatile("s_waitcnt vmcnt(0)" ::: "memory");
            const unsigned og = xb_add(&bar[XB_TOP], 1u);
            const unsigned tg = og / nx;
            if (og + 1u == (tg + 1u) * nx) xb_add(&bar[XB_TOPGEN], 1u);
            else XB_SPIN(xb_ld(&bar[XB_TOPGEN]) == tg, bar);
            __builtin_amdgcn_fence(__ATOMIC_ACQUIRE, "agent");
            xb_add(&bar[XB_XGEN(b.x)], 1u);
            asm volatile("s_waitcnt vmcnt(0)" ::: "memory");
        } else {
            XB_SPIN(xb_ld(&bar[XB_XGEN(b.x)]) == gen, bar);
            __builtin_amdgcn_fence(__ATOMIC_ACQUIRE, "agent");
            asm volatile("s_waitcnt vmcnt(0)" ::: "memory");
        }
    }
    __syncthreads();
}

struct Args { const float* in[N_IN]; float* out; unsigned char* ws; int ph_lo, ph_hi; };
struct Frame {
    LAS unsigned char* lds; unsigned char* lds_g;
    gu32* ctl;
    int tid, lane, wave, vcu, G;
    const float* const* in; float* out; unsigned char* ws;
};
__host__ __device__ __forceinline__ int wsig_inv(int nl) { return 128 * ((nl >> 5) & 1) + 32 * (nl >> 6) + (nl & 31); }

__device__ __forceinline__ void p0_transpose_item(const float* W, int K, int N, bf16* WT, int row_off, bool sig, const float* gain, LAS float* scr, int item, int lane) {
    const int nblk = N / 32, kb = item / nblk, nb = item % nblk, k0 = 64 * kb, n0 = 32 * nb;
    float tv[32];
#pragma unroll
    for (int i = 0; i < 32; ++i) { const int kk = 2 * i + (lane >> 5); tv[i] = W[(size_t)(k0 + kk) * N + n0 + (lane & 31)]; }
    if (gain) {
#pragma unroll
        for (int i = 0; i < 32; ++i) tv[i] *= gain[k0 + 2 * i + (lane >> 5)]; }
#pragma unroll
    for (int i = 0; i < 32; ++i) scr[(2 * i + (lane >> 5)) * 33 + (lane & 31)] = tv[i];
    LDS_WAIT(); asm volatile("" ::: "memory");
    const int c = lane & 7;
    int nbase = row_off + n0; if (sig) { const int ng = row_off + n0; nbase = (ng & ~255) + wsig_inv(ng & 255); }
#pragma unroll
    for (int j = 0; j < 4; ++j) { const int n = (lane >> 3) + 8 * j; const LAS float* s = scr + (8 * c) * 33 + n;
        v4u o; o.x = cvt_pk_bf16(s[0 * 33], s[1 * 33]); o.y = cvt_pk_bf16(s[2 * 33], s[3 * 33]); o.z = cvt_pk_bf16(s[4 * 33], s[5 * 33]); o.w = cvt_pk_bf16(s[6 * 33], s[7 * 33]);
        *(GAS v4u*)(WT + (size_t)(nbase + n) * K + k0 + 8 * c) = o; }
    LDS_WAIT(); asm volatile("" ::: "memory");
}
__device__ __forceinline__ void row_to_bf16_ssq(const float* xrow, bf16* orow, float* ssqrow, int lane) {
    const GAS f32x4* xr = (const GAS f32x4*)xrow + lane;
    f32x4 v[4]; float s = 0.f;
#pragma unroll
    for (int j = 0; j < 4; ++j) { v[j] = xr[64 * j]; s += (v[j].x * v[j].x + v[j].y * v[j].y) + (v[j].z * v[j].z + v[j].w * v[j].w); }
    s = wave_sum(s);
    GAS v2u* o8 = (GAS v2u*)orow + lane;
#pragma unroll
    for (int j = 0; j < 4; ++j) o8[64 * j] = pack4(v[j]);
    if (lane < 16) ssqrow[lane] = lane == 0 ? s : 0.f;
}
__device__ __forceinline__ void p0_prologue(Frame& F) {
    LAS float* scr = (LAS float*)(F.lds + RING_OFF + F.wave * 16384);
    const int gw = F.vcu * NWAVES + F.wave, NGW = F.G * NWAVES;
    unsigned char* ws = F.ws;
    int it = gw;
#define P0_JOB(Wp, K_, N_, WTp, roff, sg, gn) { const int ni = ((K_) / 64) * ((N_) / 32); for (; it < ni; it += NGW) p0_transpose_item((Wp), (K_), (N_), (WTp), (roff), (sg), (gn), scr, it, F.lane); it -= ni; }
    P0_JOB(F.in[I_WINA], DM, NCOLA, (bf16*)(ws + WS_WA), 0, false, F.in[I_NMIX]);
    P0_JOB(F.in[I_WOUT], DM, DM, (bf16*)(ws + WS_WOUT), 0, false, nullptr);
    P0_JOB(F.in[I_WOUT] + (size_t)DM * DM, DM, DM, (bf16*)(ws + WS_WOUT) + (size_t)DM * DM, 0, false, nullptr);
    P0_JOB(F.in[I_WUP], DM, FF, (bf16*)(ws + WS_WUP), 0, false, F.in[I_NMLP]);
    P0_JOB(F.in[I_WUP] + (size_t)DM * FF, DM, FF, (bf16*)(ws + WS_WUP) + (size_t)DM * FF, 0, false, F.in[I_NMLP] + DM);
    P0_JOB(F.in[I_WDN], FF, DM, (bf16*)(ws + WS_WDN), 0, false, nullptr);
    P0_JOB(F.in[I_WDN] + (size_t)DM * FF, FF, DM, (bf16*)(ws + WS_WDN) + (size_t)DM * FF, 0, false, nullptr);
    P0_JOB(F.in[I_WINB], DM, DM, (bf16*)(ws + WS_WB), 0, true, F.in[I_NMIX] + DM);
    P0_JOB(F.in[I_WKV], DM, 512, (bf16*)(ws + WS_WB), 1024, true, F.in[I_KVN]);
    P0_JOB(F.in[I_WMKV], DM, 512, (bf16*)(ws + WS_WM), 0, true, F.in[I_MNORM]);
    P0_JOB(F.in[I_WMKV] + (size_t)DM * 512, DM, 512, (bf16*)(ws + WS_WM), 512, true, F.in[I_MNORM] + DM);
    P0_JOB(F.in[I_WW2], 64, 768, (bf16*)(ws + WS_WW2), 0, false, nullptr);
    P0_JOB(F.in[I_WA2], 64, 768, (bf16*)(ws + WS_WA2), 0, false, nullptr);
    P0_JOB(F.in[I_WG2], 128, 768, (bf16*)(ws + WS_WG2), 0, false, nullptr);
#undef P0_JOB
    for (int m = gw; m < R; m += NGW) { const float* xr = m < RP ? F.in[I_XP] + (size_t)m * DM : F.in[I_XS] + (size_t)(m - RP) * DM;
        row_to_bf16_ssq(xr, (bf16*)(ws + WS_HB) + (size_t)m * DM, (float*)(ws + WS_SSQ) + (size_t)m * 16, F.lane); }
    for (int m = gw; m < 512; m += NGW) row_to_bf16_ssq(F.in[I_MEMP] + (size_t)m * DM, (bf16*)(ws + WS_MB) + (size_t)m * DM, (float*)(ws + WS_SSQM) + (size_t)m * 16, F.lane);
    { const int gt = F.vcu * NWAVES * 64 + F.tid, NGT = F.G * NWAVES * 64; float* rt = (float*)(ws + WS_ROPE);
      for (int i = gt; i < 8196 * 32; i += NGT) { const int p = i >> 5, f = i & 31; const float pos = (float)(p < 8192 ? p : 16384 + (p - 8192));
          double fq_ = 1.0; for (int k = 0; k < f; ++k) fq_ *= 0.74989420933245582730; const float ang = pos * (float)fq_; const double rev = (double)ang * 0.15915494309189535; const float fr = (float)(rev - floor(rev));
          rt[2 * i] = __builtin_amdgcn_cosf(fr); rt[2 * i + 1] = __builtin_amdgcn_sinf(fr); } }
    { const int gt = F.vcu * NWAVES * 64 + F.tid, NGT = F.G * NWAVES * 64; const int per = 124 * 256 / 4;
      for (int i = gt; i < SB * per; i += NGT) { const int b = i / per, r = i % per;
          ((GAS f32x4*)(F.out + O_SSK + (size_t)b * 128 * 256))[r] = ((const GAS f32x4*)(F.in[I_CSK] + (size_t)b * 128 * 256 + 4 * 256))[r];
          ((GAS f32x4*)(F.out + O_SSV + (size_t)b * 128 * 256))[r] = ((const GAS f32x4*)(F.in[I_CSV] + (size_t)b * 128 * 256 + 4 * 256))[r]; } }
}

__device__ __forceinline__ void finalize_sample(Frame& F, const float* fbase  , int S, bool last) {
    const int gw = F.vcu * NWAVES + F.wave, NGW = F.G * NWAVES; const float* slab = (const float*)(F.ws + WS_SLAB);
    for (int rs = gw; rs < RS; rs += NGW) { const int row = RP + rs, tile0 = (rs >> 8) << 2, r = rs & 255; float ss = 0.f;
#pragma unroll
        for (int pn = 0; pn < 4; ++pn) { f32x4 h;
            if (fbase) h = *(const GAS f32x4*)(fbase + (size_t)rs * DM + pn * 256 + 4 * F.lane);
            else h = unpack4(*(const GAS v2u*)((const bf16*)(F.ws + WS_HB) + (size_t)row * DM + pn * 256 + 4 * F.lane));
            for (int s = 0; s < S; ++s) h += *(const GAS f32x4*)(slab + ((size_t)((tile0 + pn) * S + s) << 16) + r * 256 + 4 * F.lane);
            if (last) *(GAS f32x4*)(F.out + O_Y + (size_t)row * DM + pn * 256 + 4 * F.lane) = h;
            else *(GAS v2u*)((bf16*)(F.ws + WS_HB) + (size_t)row * DM + pn * 256 + 4 * F.lane) = pack4(h);
            ss += (h[0] * h[0] + h[1] * h[1]) + (h[2] * h[2] + h[3] * h[3]); }
        if (!last) { ss = wave_sum(ss); if (F.lane < 16) ((float*)(F.ws + WS_SSQ))[(size_t)row * 16 + F.lane] = F.lane == 0 ? ss : 0.f; } }
}

constexpr int LSTR = 144, SLOT = 64 * LSTR;
__device__ __forceinline__ int rec_index(int chunk, int h) { return ((chunk >> 7) * NH + h) * 128 + (chunk & 127); }
constexpr int REC_PT = 0, REC_QS = 8192, REC_RY = 16384, REC_YL = 24576, REC_BV = 32768;
__device__ __forceinline__ bf16x8 lfrag(const LAS unsigned char* m, int row, int k) { return *(const LAS bf16x8*)(m + row * LSTR + k * 2); }
__device__ __forceinline__ void mm_strip(f32x4 (&acc)[4], const LAS unsigned char* X, const LAS unsigned char* Y, int w, int c, int g) {
#pragma unroll
    for (int ks = 0; ks < 2; ++ks) { const bf16x8 a = lfrag(X, 16 * w + c, 32 * ks + 8 * g);
#pragma unroll
        for (int n = 0; n < 4; ++n) acc[n] = mfma16(a, lfrag(Y, 16 * n + c, 32 * ks + 8 * g), acc[n]); }
}
__device__ __forceinline__ void mm_strip2(f32x4 (&acc0)[4], f32x4 (&acc1)[4], const LAS unsigned char* X, const LAS unsigned char* Y0, const LAS unsigned char* Y1, int w, int c, int g) {
#pragma unroll
    for (int ks = 0; ks < 2; ++ks) { const bf16x8 a = lfrag(X, 16 * w + c, 32 * ks + 8 * g);
#pragma unroll
        for (int n = 0; n < 4; ++n) { acc0[n] = mfma16(a, lfrag(Y0, 16 * n + c, 32 * ks + 8 * g), acc0[n]); acc1[n] = mfma16(a, lfrag(Y1, 16 * n + c, 32 * ks + 8 * g), acc1[n]); } }
}
__device__ __forceinline__ void zero4(f32x4 (&a)[4]) {
#pragma unroll
    for (int n = 0; n < 4; ++n) a[n] = (f32x4){0.f, 0.f, 0.f, 0.f};
}
__device__ __forceinline__ void st_T(LAS unsigned char* dest, const f32x4 (&acc)[4], int w, int c, int g) {
#pragma unroll
    for (int n = 0; n < 4; ++n) *(LAS v2u*)(dest + (16 * n + c) * LSTR + (16 * w + 4 * g) * 2) = pack4(acc[n]);
}
__device__ __forceinline__ void st_T_global(unsigned char* dest  , const f32x4 (&acc)[4], int w, int c, int g) {
#pragma unroll
    for (int n = 0; n < 4; ++n) *(GAS v2u*)(dest + (16 * n + c) * 128 + (16 * w + 4 * g) * 2) = pack4(acc[n]);
}
__device__ __forceinline__ void load_shift8(const bf16* cur, const bf16* prv, const float* mu, float (&o)[8]) {
    const v4u cw = *(const GAS v4u*)cur; v4u pw = {0u, 0u, 0u, 0u}; if (prv) pw = *(const GAS v4u*)prv;
    const f32x4 m0 = *(const GAS f32x4*)mu, m1 = *(const GAS f32x4*)(mu + 4);
    const float cf[8] = {bflo(cw.x), bfhi(cw.x), bflo(cw.y), bfhi(cw.y), bflo(cw.z), bfhi(cw.z), bflo(cw.w), bfhi(cw.w)};
    const float pf[8] = {bflo(pw.x), bfhi(pw.x), bflo(pw.y), bfhi(pw.y), bflo(pw.z), bfhi(pw.z), bflo(pw.w), bfhi(pw.w)};
    const float mf[8] = {m0[0], m0[1], m0[2], m0[3], m1[0], m1[1], m1[2], m1[3]};
#pragma unroll
    for (int i = 0; i < 8; ++i) o[i] = cf[i] + (pf[i] - cf[i]) * mf[i];
}
__device__ __forceinline__ bf16x8 pack_frag(const float (&v)[8]) {
    v4u w; w.x = cvt_pk_bf16(v[0], v[1]); w.y = cvt_pk_bf16(v[2], v[3]); w.z = cvt_pk_bf16(v[4], v[5]); w.w = cvt_pk_bf16(v[6], v[7]); return __builtin_bit_cast(bf16x8, w);
}

struct PrepPf { v4u raw[3][2]; v4u prv; v4u lc[2][2], lp[2][2]; };
__device__ __forceinline__ void prep_issue(Frame& F, int unit, PrepPf& pf) {
    const int th = (F.wave & 3) * 64 + F.lane; const int chunk = unit / NH, h = unit % NH, row0 = chunk * 64; const bool first = (chunk & 127) == 0;
    const bf16* proj = (const bf16*)(F.ws + WS_PROJ);
#pragma unroll
    for (int a = 0; a < 3; ++a)
#pragma unroll
        for (int i = 0; i < 2; ++i) { const int id = th + 256 * i; pf.raw[a][i] = *(const GAS v4u*)(proj + (size_t)(row0 + (id >> 3)) * NCOLA + a * 768 + h * 64 + (id & 7) * 8); }
    pf.prv = (v4u){0u, 0u, 0u, 0u};
    if (th < 24 && !first) pf.prv = *(const GAS v4u*)(proj + (size_t)(row0 - 1) * NCOLA + (th >> 3) * 768 + h * 64 + (th & 7) * 8);
    { const int w = F.wave & 3, g = F.lane >> 4, c = F.lane & 15, t = 16 * w + c; const bf16* cr = proj + (size_t)(row0 + t) * NCOLA; const bool hp = !(first && t == 0);
#pragma unroll
      for (int a = 0; a < 2; ++a)
#pragma unroll
          for (int ks = 0; ks < 2; ++ks) { const int col = 2304 + 64 * a + 32 * ks + 8 * g; pf.lc[a][ks] = *(const GAS v4u*)(cr + col); pf.lp[a][ks] = (v4u){0u, 0u, 0u, 0u}; if (hp) pf.lp[a][ks] = *(const GAS v4u*)(cr - NCOLA + col); } }
}
__device__ __forceinline__ void shift8(v4u cw, v4u pw, const float* mu, float (&o)[8]) {
    const f32x4 m0 = *(const GAS f32x4*)mu, m1 = *(const GAS f32x4*)(mu + 4);
    const float cf[8] = {bflo(cw.x), bfhi(cw.x), bflo(cw.y), bfhi(cw.y), bflo(cw.z), bfhi(cw.z), bflo(cw.w), bfhi(cw.w)};
    const float pf_[8] = {bflo(pw.x), bfhi(pw.x), bflo(pw.y), bfhi(pw.y), bflo(pw.z), bfhi(pw.z), bflo(pw.w), bfhi(pw.w)};
    const float mf[8] = {m0[0], m0[1], m0[2], m0[3], m1[0], m1[1], m1[2], m1[3]};
#pragma unroll
    for (int i = 0; i < 8; ++i) o[i] = cf[i] + (pf_[i] - cf[i]) * mf[i];
}
#define HBAR() do { asm volatile("s_waitcnt lgkmcnt(0)" ::: "memory"); __builtin_amdgcn_s_barrier(); asm volatile("" ::: "memory"); } while (0)
__device__ __forceinline__ void rwkv_prep_unit(Frame& F, int unit, LAS unsigned char* hb, LAS float* wtot, LAS unsigned char* prow, PrepPf& pf, bool has_next, int next_unit, int stage_limit = 99) {
    int w_ = F.wave & 3, lane_ = F.lane; asm volatile("" : "+s"(w_), "+v"(lane_));
    const int w = w_, lane = lane_, g = lane >> 4, c = lane & 15;
    const int chunk = unit / NH, h = unit % NH, row0 = chunk * 64; const bool first = (chunk & 127) == 0;
    const bf16* proj = (const bf16*)(F.ws + WS_PROJ);
    unsigned char* rec = F.ws + WS_REC + (size_t)rec_index(chunk, h) * REC_BYTES;
    LAS unsigned char* const s0 = hb, * const s1 = hb + SLOT, * const s2 = hb + 2 * SLOT, * const s3 = hb + 3 * SLOT, * const s4 = hb + 4 * SLOT, * const s5 = hb + 5 * SLOT, * const s6 = hb + 6 * SLOT, * const s7 = hb + 7 * SLOT;
    float mur[4], muk[4], muv[4], w0[4], a0[4], kkc[4], kac[4], rkc[4];
#pragma unroll
    for (int n = 0; n < 4; ++n) { const int col = h * 64 + 16 * n + c; mur[n] = F.in[I_MU][col]; muk[n] = F.in[I_MU][768 + col]; muv[n] = F.in[I_MU][1536 + col];
        w0[n] = F.in[I_W0][col]; a0[n] = F.in[I_A0][col]; kkc[n] = F.in[I_KK][col]; kac[n] = F.in[I_KA][col]; rkc[n] = F.in[I_RK][col]; }
    f32x4 dw[4], da[4]; zero4(dw); zero4(da);
    { const int th = w * 64 + lane;
#pragma unroll
      for (int a = 0; a < 3; ++a)
#pragma unroll
          for (int i = 0; i < 2; ++i) { const int id = th + 256 * i; *(LAS v4u*)(hb + a * SLOT + (id >> 3) * LSTR + (id & 7) * 16) = pf.raw[a][i]; }
      if (th < 24) *(LAS v4u*)(prow + (th >> 3) * 128 + (th & 7) * 16) = pf.prv; }
    {
        const bf16* Ww2 = (const bf16*)(F.ws + WS_WW2); const bf16* Wa2 = (const bf16*)(F.ws + WS_WA2);
#pragma unroll
        for (int ks = 0; ks < 2; ++ks) { const int l0 = 32 * ks + 8 * g; float x[8];
            shift8(pf.lc[0][ks], pf.lp[0][ks], F.in[I_MU] + 2304 + l0, x);
#pragma unroll
            for (int i = 0; i < 8; ++i) x[i] = ftanh(x[i]);
            const bf16x8 aw = pack_frag(x);
            shift8(pf.lc[1][ks], pf.lp[1][ks], F.in[I_MU] + 2368 + l0, x);
            const bf16x8 aa = pack_frag(x);
#pragma unroll
            for (int n = 0; n < 4; ++n) { const size_t wo = (size_t)(h * 64 + 16 * n + c) * 64 + l0;
                dw[n] = mfma16(aw, *(const GAS bf16x8*)(Ww2 + wo), dw[n]); da[n] = mfma16(aa, *(const GAS bf16x8*)(Wa2 + wo), da[n]); } }
    }
    HBAR();
    if (has_next) prep_issue(F, next_unit, pf);
    f32x4 rt[4], kh[4], lw[4], at_[4], bt_[4], kt_[4], bh_[4], vv[4]; float gam[4]; float bon[4] = {0.f, 0.f, 0.f, 0.f}; float ssk[4] = {0.f, 0.f, 0.f, 0.f};
    f32x4 kkr[4], aa_[4], kp[4], rr[4];
    {

        const LAS unsigned char* pbase = (w == 0 && g == 0) ? prow + c * 2 : hb + (16 * w + 4 * g - 1) * LSTR + c * 2; const int pstr = (w == 0 && g == 0) ? 128 : SLOT;
        float rp[4], kpv[4], vp[4];
#pragma unroll
        for (int n = 0; n < 4; ++n) { rp[n] = bf2f(*(const LAS bf16*)(pbase + 32 * n)); kpv[n] = bf2f(*(const LAS bf16*)(pbase + pstr + 32 * n)); vp[n] = bf2f(*(const LAS bf16*)(pbase + 2 * pstr + 32 * n)); }
#pragma unroll
        for (int reg = 0; reg < 4; ++reg) { const int t = 16 * w + 4 * g + reg; const LAS unsigned char* cr = hb + t * LSTR + c * 2;
#pragma unroll
            for (int n = 0; n < 4; ++n) {
                const float r0 = bf2f(*(const LAS bf16*)(cr + 32 * n)), k0 = bf2f(*(const LAS bf16*)(cr + SLOT + 32 * n)), v0 = bf2f(*(const LAS bf16*)(cr + 2 * SLOT + 32 * n));
                const float r1 = rp[n], k1 = kpv[n], v1 = vp[n]; rp[n] = r0; kpv[n] = k0; vp[n] = v0;
                const float r = r0 + (r1 - r0) * mur[n], k = k0 + (k1 - k0) * muk[n], v = v0 + (v1 - v0) * muv[n];
                const float y = -(w0[n] + dw[n][reg]);
                const float sp = fmaxf(y, 0.f) + __logf(1.0f + __expf(-fabsf(y)));
                lw[n][reg] = -__expf(-sp - 0.5f);
                const float a = fsigmoid(a0[n] + da[n][reg]);
                aa_[n][reg] = a; kkr[n][reg] = k * kkc[n]; kp[n][reg] = k * (1.0f + (a - 1.0f) * kac[n]); rr[n][reg] = r; vv[n][reg] = v;
                ssk[reg] += kkr[n][reg] * kkr[n][reg]; bon[reg] += r * kp[n][reg] * rkc[n]; } }
    }
#pragma unroll
    for (int reg = 0; reg < 4; ++reg) { ssk[reg] = sum16(ssk[reg]); bon[reg] = sum16(bon[reg]); ssk[reg] = 1.0f / fmaxf(sqrtf(ssk[reg]), 1e-12f); }
    f32x4 Lc[4];
#pragma unroll
    for (int n = 0; n < 4; ++n) { f32x4 inc; inc[0] = lw[n][0]; inc[1] = inc[0] + lw[n][1]; inc[2] = inc[1] + lw[n][2]; inc[3] = inc[2] + lw[n][3];
        const float tot = inc[3]; const float t1 = __shfl(tot, (lane - 16) & 63), t2 = __shfl(tot, (lane - 32) & 63), t3 = __shfl(tot, (lane - 48) & 63);
        const float pre = (g >= 1 ? t1 : 0.f) + (g >= 2 ? t2 : 0.f) + (g >= 3 ? t3 : 0.f);
        Lc[n] = inc + pre; if (g == 3) wtot[w * 64 + 16 * n + c] = pre + tot; }
    HBAR();
#pragma unroll
    for (int n = 0; n < 4; ++n) { const int j = 16 * n + c; const float t0 = wtot[j], t1 = wtot[64 + j], t2 = wtot[128 + j], t3 = wtot[192 + j];
        const float base = (w >= 1 ? t0 : 0.f) + (w >= 2 ? t1 : 0.f) + (w >= 3 ? t2 : 0.f); const float LC = (t0 + t1) + (t2 + t3);
        gam[n] = __expf(LC);
#pragma unroll
        for (int reg = 0; reg < 4; ++reg) { const float L = Lc[n][reg] + base; const float eL = __expf(L), eLi = __expf(-L), eP = __expf(L - lw[n][reg]), eC = __expf(LC - L);
            const float kk = kkr[n][reg] * ssk[reg], bsc = kk * aa_[n][reg];
            at_[n][reg] = -kk * eP; rt[n][reg] = rr[n][reg] * eL; bt_[n][reg] = bsc * eLi; kt_[n][reg] = kp[n][reg] * eLi; bh_[n][reg] = bsc * eC; kh[n][reg] = kp[n][reg] * eC;
            const int t = 16 * w + 4 * g + reg;
            *(LAS bf16*)(s0 + t * LSTR + j * 2) = f2bf(at_[n][reg]); *(LAS bf16*)(s1 + t * LSTR + j * 2) = f2bf(bt_[n][reg]);
            *(LAS bf16*)(s2 + t * LSTR + j * 2) = f2bf(kt_[n][reg]); *(LAS bf16*)(s3 + t * LSTR + j * 2) = f2bf(rt[n][reg]); }
        *(LAS v2u*)(s4 + j * LSTR + (16 * w + 4 * g) * 2) = pack4(at_[n]); *(LAS v2u*)(s5 + j * LSTR + (16 * w + 4 * g) * 2) = pack4(bh_[n]); *(LAS v2u*)(s6 + j * LSTR + (16 * w + 4 * g) * 2) = pack4(vv[n]);
        f32x4 bv;
#pragma unroll
        for (int reg = 0; reg < 4; ++reg) bv[reg] = bon[reg] * vv[n][reg];
        *(GAS v2u*)(rec + REC_BV + ((w * 64 + lane) * 4 + n) * 8) = pack4(bv); }
    HBAR();
    if (stage_limit <= 3) return;
    f32x4 aN[4], aMk[4], aMbr[4], aMkr[4]; zero4(aN); zero4(aMk); zero4(aMbr); zero4(aMkr);
    mm_strip2(aN, aMk, s0, s1, s2, w, c, g);
    mm_strip(aMbr, s1, s3, w, c, g); mm_strip(aMkr, s2, s3, w, c, g);
#pragma unroll
    for (int n = 0; n < 4; ++n)
#pragma unroll
        for (int reg = 0; reg < 4; ++reg) { const int row = 16 * w + 4 * g + reg, col = 16 * n + c;
            if (!(col < row)) { aN[n][reg] = 0.f; aMk[n][reg] = 0.f; } if (!(row <= col)) { aMbr[n][reg] = 0.f; aMkr[n][reg] = 0.f; } }
    HBAR();
    LAS float* Nf = (LAS float*)s0;
#pragma unroll
    for (int n = 0; n < 4; ++n)
#pragma unroll
        for (int reg = 0; reg < 4; ++reg) Nf[(16 * w + 4 * g + reg) * 64 + (c & 3) * 16 + 4 * n + (c >> 2)] = aN[n][reg];
    st_T(s2, aMk, w, c, g);
    st_T(s3, aMbr, w, c, g);
    HBAR();
    {
        const int q = lane & 3, sl = lane >> 2; float cq[16];
#pragma unroll
        for (int k = 0; k < 16; ++k) cq[k] = 0.f;
        for (int t = 0; t < 16 * w; ++t) if (q == 0) *(LAS bf16*)(s7 + t * LSTR + (16 * w + sl) * 2) = (bf16)0;
#pragma unroll
        for (int t = 0; t < 64; ++t) if (t >= 16 * w) {
            float part = 0.f;
#pragma unroll
            for (int k4 = 0; k4 < (t + 15) / 16; ++k4) { const f32x4 nv = *(const LAS f32x4*)(Nf + t * 64 + q * 16 + 4 * k4);
#pragma unroll
                for (int e = 0; e < 4; ++e) if (4 * (4 * k4 + e) < t) part = fmaf(nv[e], cq[4 * k4 + e], part); }
            part = sum4_dpp(part);
            const float val = part + ((t == 16 * w + sl) ? 1.0f : 0.0f);
            cq[t >> 2] = (q == (t & 3)) ? val : cq[t >> 2];
            if (q == 0) *(LAS bf16*)(s7 + t * LSTR + (16 * w + sl) * 2) = f2bf(val);
        }
    }
    HBAR();
    if (stage_limit <= 5) return;
    { f32x4 aW[4], aNk[4]; zero4(aW); zero4(aNk); mm_strip2(aW, aNk, s7, s4, s2, w, c, g); st_T(s0, aW, w, c, g); st_T(s1, aNk, w, c, g); }
    HBAR();
    { f32x4 aP[4]; zero4(aP); mm_strip(aP, s0, s5, w, c, g);
#pragma unroll
      for (int n = 0; n < 4; ++n)
#pragma unroll
          for (int reg = 0; reg < 4; ++reg) if (n == w && c == 4 * g + reg) aP[n][reg] += gam[n];
#pragma unroll
      for (int n = 0; n < 4; ++n) *(GAS v2u*)(rec + REC_PT + ((n * 2 + (w >> 1)) * 64 + lane) * 16 + 8 * (w & 1)) = pack4(aP[n]); }
    { f32x4 aZq[4], aZy[4]; zero4(aZq); zero4(aZy); mm_strip2(aZq, aZy, s1, s5, s3, w, c, g);
#pragma unroll
      for (int n = 0; n < 4; ++n) { aZq[n] += kh[n]; aZy[n] += aMkr[n]; }
      f32x4 aRy[4]; zero4(aRy); mm_strip(aRy, s3, s0, w, c, g);
#pragma unroll
      for (int n = 0; n < 4; ++n)
#pragma unroll
          for (int reg = 0; reg < 4; ++reg) *(GAS bf16*)(rec + REC_RY + ((w * 2 + (n >> 1)) * 64 + 16 * (2 * (n & 1) + (c >> 3)) + 4 * g + reg) * 16 + 2 * (c & 7)) = f2bf(aRy[n][reg] + rt[n][reg]);
      st_T(s4, aZq, w, c, g);
      st_T(s7, aZy, w, c, g); }
    HBAR();
    { f32x4 aQ[4], aY[4]; zero4(aQ); zero4(aY); mm_strip(aQ, s4, s6, w, c, g); mm_strip(aY, s7, s6, w, c, g);
#pragma unroll
      for (int n = 0; n < 4; ++n) { *(GAS v2u*)(rec + REC_QS + ((n * 64 + lane) * 4 + w) * 8) = pack4(aQ[n]);
                                    *(GAS v2u*)(rec + REC_YL + ((w * 64 + lane) * 4 + n) * 8) = pack4(aY[n]); } }
}

__device__ __forceinline__ float rdlane(float v, int l) { return __int_as_float(__builtin_amdgcn_readlane(__float_as_int(v), l)); }
__device__ __forceinline__ void rwkv_sample_task(Frame& F, int task) {
    int lane_ = F.lane; asm volatile("" : "+v"(lane_)); const int lane = lane_;
    const int b = task / NH, h = task % NH, col = h * 64 + lane;
    const bf16* proj = (const bf16*)(F.ws + WS_PROJ);
    const float* sh = F.in[I_SSHIFT] + (size_t)b * RWKV_COLS;
    const float* mu = F.in[I_MU];
    float S[64];
    { const GAS f32x4* sp = (const GAS f32x4*)(F.in[I_SWKV] + (((size_t)b * NH + h) * 64 + lane) * 64);
#pragma unroll
      for (int q = 0; q < 16; ++q) { const f32x4 v = sp[q]; S[4 * q] = v[0]; S[4 * q + 1] = v[1]; S[4 * q + 2] = v[2]; S[4 * q + 3] = v[3]; } }
    const float w0 = F.in[I_W0][col], a0 = F.in[I_A0][col], kkc = F.in[I_KK][col], kac = F.in[I_KA][col], rkc = F.in[I_RK][col], lnw = F.in[I_LNW][col], lnb = F.in[I_LNB][col];
    float rr[ST], kq[ST], vq[ST], twd[ST], adv[ST], gd0[ST], gd1[ST];
#pragma unroll
    for (int i = 0; i < ST; ++i) { const int row = RP + b * ST + i; const bf16* cr = proj + (size_t)row * NCOLA;
#define SHIFTED(cc) ({ const float p_ = bf2f(cr[(cc)]); const float q_ = (i == 0) ? sh[(cc)] : bf2f(cr[(cc) - NCOLA]); p_ + (q_ - p_) * mu[(cc)]; })
        rr[i] = SHIFTED(col); kq[i] = SHIFTED(768 + col); vq[i] = SHIFTED(1536 + col);
        twd[i] = ftanh(SHIFTED(2304 + lane)); adv[i] = SHIFTED(2368 + lane); gd0[i] = fsigmoid(SHIFTED(2432 + lane)); gd1[i] = fsigmoid(SHIFTED(2496 + lane));
#undef SHIFTED
    }
    float dwv[ST] = {0.f, 0.f, 0.f, 0.f}, dav[ST] = {0.f, 0.f, 0.f, 0.f}, ggv[ST] = {0.f, 0.f, 0.f, 0.f};
    { const GAS float* W2 = (const GAS float*)(F.in[I_WW2] + col); const GAS float* A2 = (const GAS float*)(F.in[I_WA2] + col); const GAS float* G2 = (const GAS float*)(F.in[I_WG2] + col);
#pragma unroll 16
      for (int l = 0; l < 64; ++l) { const float w2 = W2[0], a2 = A2[0], g2a = G2[0], g2b = G2[64 * 768]; W2 += 768; A2 += 768; G2 += 768;
#pragma unroll
          for (int i = 0; i < ST; ++i) { dwv[i] = fmaf(rdlane(twd[i], l), w2, dwv[i]); dav[i] = fmaf(rdlane(adv[i], l), a2, dav[i]); ggv[i] = fmaf(rdlane(gd0[i], l), g2a, ggv[i]); ggv[i] = fmaf(rdlane(gd1[i], l), g2b, ggv[i]); } } }
#pragma unroll
    for (int i = 0; i < ST; ++i) {
        const int row = RP + b * ST + i;
        const float r = rr[i], k = kq[i], v = vq[i], dw = dwv[i], da = dav[i], gg = ggv[i];
        const float y0 = -(w0 + dw); const float sp = fmaxf(y0, 0.f) + __logf(1.0f + __expf(-fabsf(y0)));
        const float wdec = __expf(-__expf(-sp - 0.5f));
        const float a = fsigmoid(a0 + da);
        const float kkr = k * kkc; const float nrm = fmaxf(sqrtf(wave_sum(kkr * kkr)), 1e-12f); const float kk = kkr / nrm;
        const float kp = k * (1.0f + (a - 1.0f) * kac);
        const float asc = -kk, bsc = kk * a;
        const float bonus = wave_sum(r * kp * rkc);
        float sa = 0.f;
#pragma unroll
        for (int j = 0; j < 64; ++j) sa = fmaf(S[j], rdlane(asc, j), sa);
        const float vi = v;
        float y = 0.f;
#pragma unroll
        for (int j = 0; j < 64; ++j) { const float wj = rdlane(wdec, j), bj = rdlane(bsc, j), kj = rdlane(kp, j), rj = rdlane(r, j);
            S[j] = fmaf(S[j], wj, fmaf(sa, bj, vi * kj)); y = fmaf(S[j], rj, y); }
        const float mean = wave_sum(y) * (1.0f / 64.0f); const float dy = y - mean; const float var = wave_sum(dy * dy) * (1.0f / 64.0f);
        const float o = (dy * rsqrtf(var + 6.4e-4f) * lnw + lnb + bonus * vi) * gg;
        ((bf16*)(F.ws + WS_MIX))[(size_t)row * DM + col] = f2bf(o);
        asm volatile("" ::: "memory");
    }
    { GAS f32x4* sp = (GAS f32x4*)(F.out + O_SWKV + (((size_t)b * NH + h) * 64 + lane) * 64);
#pragma unroll
      for (int q = 0; q < 16; ++q) sp[q] = (f32x4){S[4 * q], S[4 * q + 1], S[4 * q + 2], S[4 * q + 3]}; }
    if (h == 0) { const bf16* lr = proj + (size_t)(RP + b * ST + ST - 1) * NCOLA; float* o = F.out + O_SSHIFT + (size_t)b * RWKV_COLS;
        for (int q = lane; q < RWKV_COLS; q += 64) o[q] = bf2f(lr[q]); }
}

__device__ __forceinline__ void rwkv_scan_chain(Frame& F, int bh, int w) {
    int lane_ = F.lane; asm volatile("" : "+v"(lane_)); const int lane = lane_, g = lane >> 4, c = lane & 15; const int b = bh / NH, h = bh % NH;
    f32x4 acc[4]; zero4(acc);
    const int vrow = 16 * w + c;
    auto recp = [&](int cc) -> unsigned char* { return F.ws + WS_REC + (size_t)((b * NH + h) * 128 + cc) * REC_BYTES; };
    constexpr int DPF = 4;
    bf16x8 pa[DPF][4][2]; v4u qa[DPF][2];
#define SCAN_LOAD(d, cc_) do { const unsigned char* rp_ = recp(cc_); \
        qa[d][0] = *(const GAS v4u*)(rp_ + REC_QS + (w * 64 + lane) * 32); qa[d][1] = *(const GAS v4u*)(rp_ + REC_QS + (w * 64 + lane) * 32 + 16); \
        _Pragma("unroll") for (int mt = 0; mt < 4; ++mt) _Pragma("unroll") for (int ks = 0; ks < 2; ++ks) pa[d][mt][ks] = *(const GAS bf16x8*)(rp_ + REC_PT + ((mt * 2 + ks) * 64 + lane) * 16); } while (0)
#pragma unroll
    for (int d = 0; d < DPF; ++d) SCAN_LOAD(d, d);
    for (int cc0 = 0; cc0 < 128; cc0 += DPF) {
#pragma unroll
        for (int d = 0; d < DPF; ++d) { const int cc = cc0 + d;
            unsigned char* sp_ = F.ws + WS_HB + (size_t)((b * NH + h) * 128 + cc) * 8192;
            v2u sb[4]; f32x4 nacc[4];
#pragma unroll
            for (int mt = 0; mt < 4; ++mt) sb[mt] = pack4(acc[mt]);
            nacc[0] = unpack4((v2u){qa[d][0].x, qa[d][0].y}); nacc[1] = unpack4((v2u){qa[d][0].z, qa[d][0].w}); nacc[2] = unpack4((v2u){qa[d][1].x, qa[d][1].y}); nacc[3] = unpack4((v2u){qa[d][1].z, qa[d][1].w});
#pragma unroll
            for (int mt = 0; mt < 4; ++mt) *(GAS v2u*)(sp_ + ((w * 2 + (mt >> 1)) * 64 + 16 * (2 * (mt & 1) + (g >> 1)) + c) * 16 + 8 * (g & 1)) = sb[mt];
            bf16x8 bf[2];
#pragma unroll
            for (int ks = 0; ks < 2; ++ks) { v4u t; t.x = sb[2 * ks].x; t.y = sb[2 * ks].y; t.z = sb[2 * ks + 1].x; t.w = sb[2 * ks + 1].y; bf[ks] = __builtin_bit_cast(bf16x8, t); }
#pragma unroll
            for (int mt = 0; mt < 4; ++mt) { nacc[mt] = mfma16(pa[d][mt][0], bf[0], nacc[mt]); nacc[mt] = mfma16(pa[d][mt][1], bf[1], nacc[mt]); acc[mt] = nacc[mt]; }
            if (cc + DPF < 128) SCAN_LOAD(d, cc + DPF);
        }
    }
#undef SCAN_LOAD
    float* o = F.out + O_PWKV + (((size_t)b * NH + h) * 64 + vrow) * 64;
#pragma unroll
    for (int mt = 0; mt < 4; ++mt) *(GAS f32x4*)(o + 16 * mt + 4 * g) = acc[mt];
}

__device__ __forceinline__ void rwkv_yout_item(Frame& F, int item) {
    int lane_ = F.lane; asm volatile("" : "+v"(lane_)); const int lane = lane_, g = lane >> 4, c = lane & 15; const int unit = item >> 2, w = item & 3;
    const int chunk = unit / NH, h = unit % NH, row0 = chunk * 64; const bool first = (chunk & 127) == 0;
    const unsigned char* rec = F.ws + WS_REC + (size_t)rec_index(chunk, h) * REC_BYTES; const unsigned char* srec = F.ws + WS_HB + (size_t)rec_index(chunk, h) * 8192;
    const bf16* proj = (const bf16*)(F.ws + WS_PROJ);
    f32x4 y[4], gt[4]; zero4(gt);
    { const v4u y01 = *(const GAS v4u*)(rec + REC_YL + (w * 64 + lane) * 32), y23 = *(const GAS v4u*)(rec + REC_YL + (w * 64 + lane) * 32 + 16);
      y[0] = unpack4((v2u){y01.x, y01.y}); y[1] = unpack4((v2u){y01.z, y01.w}); y[2] = unpack4((v2u){y23.x, y23.y}); y[3] = unpack4((v2u){y23.z, y23.w}); }
#pragma unroll
    for (int ks = 0; ks < 2; ++ks) { const bf16x8 a = *(const GAS bf16x8*)(rec + REC_RY + ((w * 2 + ks) * 64 + lane) * 16);
#pragma unroll
        for (int n = 0; n < 4; ++n) y[n] = mfma16(a, *(const GAS bf16x8*)(srec + ((n * 2 + ks) * 64 + lane) * 16), y[n]); }
    { const int t = 16 * w + c; const bf16* cr = proj + (size_t)(row0 + t) * NCOLA; const bf16* pr = (first && t == 0) ? nullptr : cr - NCOLA; const bf16* Wg2 = (const bf16*)(F.ws + WS_WG2);
#pragma unroll
      for (int ks = 0; ks < 4; ++ks) { const int l0 = 32 * ks + 8 * g; float x[8]; load_shift8(cr + 2432 + l0, pr ? pr + 2432 + l0 : nullptr, F.in[I_MU] + 2432 + l0, x);
#pragma unroll
          for (int i = 0; i < 8; ++i) x[i] = fsigmoid(x[i]);
          const bf16x8 ag = pack_frag(x);
#pragma unroll
          for (int n = 0; n < 4; ++n) gt[n] = mfma16(ag, *(const GAS bf16x8*)(Wg2 + (size_t)(h * 64 + 16 * n + c) * 128 + l0), gt[n]); } }
    float mean[4], rstd[4];
#pragma unroll
    for (int reg = 0; reg < 4; ++reg) { float s = (y[0][reg] + y[1][reg]) + (y[2][reg] + y[3][reg]); s = sum16(s); mean[reg] = s * (1.0f / 64.0f);
        float q = 0.f;
#pragma unroll
        for (int n = 0; n < 4; ++n) { const float d = y[n][reg] - mean[reg]; q += d * d; }
        q = sum16(q); rstd[reg] = rsqrtf(q * (1.0f / 64.0f) + 6.4e-4f); }
    bf16* mix = (bf16*)(F.ws + WS_MIX);
#pragma unroll
    for (int n = 0; n < 4; ++n) { const int col = h * 64 + 16 * n + c; const float lnw = F.in[I_LNW][col], lnb = F.in[I_LNB][col];
        const f32x4 bv = unpack4(*(const GAS v2u*)(rec + REC_BV + ((w * 64 + lane) * 4 + n) * 8));
#pragma unroll
        for (int reg = 0; reg < 4; ++reg) { const float o = ((y[n][reg] - mean[reg]) * rstd[reg] * lnw + lnb + bv[reg]) * gt[n][reg];
            mix[(size_t)(row0 + 16 * w + 4 * g + reg) * DM + col] = f2bf(o); } }
}

__device__ __forceinline__ int crow32(int r, int hi) { return (r & 3) + 8 * (r >> 2) + 4 * hi; }
template <bool MASKED, int GB>
__device__ __forceinline__ void flash32(const bf16x8 (&qf)[4], const bf16* Kp, int kstr, const bf16* VTp, int vstr, int kb_lo, int nblk, int qpos, float m0, float l0,
                                        f32x16& o0, f32x16& o1, float& lsum, int lane) {
    const int r32 = lane & 31, hh = lane >> 5;
    float m = m0, l = hh == 0 ? l0 : 0.f;
#pragma unroll
    for (int r = 0; r < 16; ++r) { o0[r] = 0.f; o1[r] = 0.f; }
    for (int b0 = 0; b0 < nblk; b0 += GB) {
        bf16x8 kf[GB][4]; v2u vf[GB][2][2][2];
#pragma unroll
        for (int i = 0; i < GB; ++i) if (b0 + i < nblk) { const int kb = kb_lo + 32 * (b0 + i);
#pragma unroll
            for (int ks = 0; ks < 4; ++ks) kf[i][ks] = *(const GAS bf16x8*)(Kp + (size_t)(kb + r32) * kstr + 16 * ks + 8 * hh);
#pragma unroll
            for (int s2 = 0; s2 < 2; ++s2)
#pragma unroll
                for (int dt = 0; dt < 2; ++dt) { const bf16* vp = VTp + (size_t)(32 * dt + r32) * vstr + kb + 16 * s2 + 4 * hh; vf[i][s2][dt][0] = *(const GAS v2u*)vp; vf[i][s2][dt][1] = *(const GAS v2u*)(vp + 8); } }
#pragma unroll
        for (int i = 0; i < GB; ++i) if (b0 + i < nblk) { const int kb = kb_lo + 32 * (b0 + i);
            f32x16 s;
#pragma unroll
            for (int r = 0; r < 16; ++r) s[r] = 0.f;
#pragma unroll
            for (int ks = 0; ks < 4; ++ks) s = mfma32(kf[i][ks], qf[ks], s);
            if (MASKED) {
#pragma unroll
                for (int r = 0; r < 16; ++r) { const int rel = qpos - (kb + crow32(r, hh)); if (rel < 0 || rel >= 128) s[r] = -1e30f; } }
            float bm = s[0];
#pragma unroll
            for (int r = 1; r < 16; ++r) bm = fmaxf(bm, s[r]);
            bm = max_x32(bm);
            const float mn = fmaxf(m, bm), alpha = __builtin_amdgcn_exp2f(m - mn); m = mn;
            float ps = 0.f;
#pragma unroll
            for (int r = 0; r < 16; ++r) { s[r] = __builtin_amdgcn_exp2f(s[r] - mn); ps += s[r]; }
            l = l * alpha + ps;
#pragma unroll
            for (int r = 0; r < 16; ++r) { o0[r] *= alpha; o1[r] *= alpha; }
#pragma unroll
            for (int s2 = 0; s2 < 2; ++s2) {
                v4u pw; pw.x = cvt_pk_bf16(s[8 * s2], s[8 * s2 + 1]); pw.y = cvt_pk_bf16(s[8 * s2 + 2], s[8 * s2 + 3]); pw.z = cvt_pk_bf16(s[8 * s2 + 4], s[8 * s2 + 5]); pw.w = cvt_pk_bf16(s[8 * s2 + 6], s[8 * s2 + 7]);
                const bf16x8 pb = __builtin_bit_cast(bf16x8, pw);
                { v4u aw; aw.x = vf[i][s2][0][0].x; aw.y = vf[i][s2][0][0].y; aw.z = vf[i][s2][0][1].x; aw.w = vf[i][s2][0][1].y; o0 = mfma32(__builtin_bit_cast(bf16x8, aw), pb, o0); }
                { v4u aw; aw.x = vf[i][s2][1][0].x; aw.y = vf[i][s2][1][0].y; aw.z = vf[i][s2][1][1].x; aw.w = vf[i][s2][1][1].y; o1 = mfma32(__builtin_bit_cast(bf16x8, aw), pb, o1); } }
        }
    }
    lsum = add_x32(l);
}
__device__ __forceinline__ void flash_store(bf16* dst  , int rstride, const f32x16& o0, const f32x16& o1, float lsum, int lane) {
    const int r32 = lane & 31, hh = lane >> 5; const float inv = 1.0f / lsum; bf16* p = dst + (size_t)r32 * rstride + 4 * hh;
#pragma unroll
    for (int k = 0; k < 4; ++k) { *(GAS v2u*)(p + 8 * k) = pack4((f32x4){o0[4 * k] * inv, o0[4 * k + 1] * inv, o0[4 * k + 2] * inv, o0[4 * k + 3] * inv});
        *(GAS v2u*)(p + 32 + 8 * k) = pack4((f32x4){o1[4 * k] * inv, o1[4 * k + 1] * inv, o1[4 * k + 2] * inv, o1[4 * k + 3] * inv}); }
}
constexpr int KL_STR = 144;
template <bool MASKED>
__device__ __forceinline__ void flash32_lds(const bf16x8 (&qf)[4], const LAS unsigned char* Kl, const LAS unsigned char* Vl, int vstr, int lk_lo, int nblk, int kpos_lo, int qpos, float m0, float l0,
                                            f32x16& o0, f32x16& o1, float& lsum, int lane) {
    const int r32 = lane & 31, hh = lane >> 5;
    float m = m0, l = hh == 0 ? l0 : 0.f;
#pragma unroll
    for (int r = 0; r < 16; ++r) { o0[r] = 0.f; o1[r] = 0.f; }
    for (int blk = 0; blk < nblk; ++blk) { const int lk = lk_lo + 32 * blk;
        f32x16 s;
#pragma unroll
        for (int r = 0; r < 16; ++r) s[r] = 0.f;
#pragma unroll
        for (int ks = 0; ks < 4; ++ks) s = mfma32(*(const LAS bf16x8*)(Kl + (lk + r32) * KL_STR + (16 * ks + 8 * hh) * 2), qf[ks], s);
        if (MASKED) {
#pragma unroll
            for (int r = 0; r < 16; ++r) { const int rel = qpos - (kpos_lo + 32 * blk + crow32(r, hh)); if (rel < 0 || rel >= 128) s[r] = -1e30f; } }
        float bm = s[0];
#pragma unroll
        for (int r = 1; r < 16; ++r) bm = fmaxf(bm, s[r]);
        bm = max_x32(bm);
        const float mn = fmaxf(m, bm), alpha = __builtin_amdgcn_exp2f(m - mn); m = mn;
        float ps = 0.f;
#pragma unroll
        for (int r = 0; r < 16; ++r) { s[r] = __builtin_amdgcn_exp2f(s[r] - mn); ps += s[r]; }
        l = l * alpha + ps;
#pragma unroll
        for (int r = 0; r < 16; ++r) { o0[r] *= alpha; o1[r] *= alpha; }
#pragma unroll
        for (int s2 = 0; s2 < 2; ++s2) {
            v4u pw; pw.x = cvt_pk_bf16(s[8 * s2], s[8 * s2 + 1]); pw.y = cvt_pk_bf16(s[8 * s2 + 2], s[8 * s2 + 3]); pw.z = cvt_pk_bf16(s[8 * s2 + 4], s[8 * s2 + 5]); pw.w = cvt_pk_bf16(s[8 * s2 + 6], s[8 * s2 + 7]);
            const bf16x8 pb = __builtin_bit_cast(bf16x8, pw);
#pragma unroll
            for (int dt = 0; dt < 2; ++dt) { const LAS unsigned char* vp = Vl + (32 * dt + r32) * vstr + (lk + 16 * s2 + 4 * hh) * 2;
                const v2u a0 = *(const LAS v2u*)vp, a1 = *(const LAS v2u*)(vp + 16); v4u aw; aw.x = a0.x; aw.y = a0.y; aw.z = a1.x; aw.w = a1.y;
                if (dt == 0) o0 = mfma32(__builtin_bit_cast(bf16x8, aw), pb, o0); else o1 = mfma32(__builtin_bit_cast(bf16x8, aw), pb, o1); } }
    }
    lsum = add_x32(l);
}
__device__ __forceinline__ void stage_kv(LAS unsigned char* Kl, LAS unsigned char* Vl, int vstr, const bf16* Kg, int kstr, const bf16* VTg, int vstr_g, int nkeys, int tid) {
    for (int id = tid; id < nkeys * 8; id += NWAVES * 64) { const int key = id >> 3, ch = id & 7; *(LAS v4u*)(Kl + key * KL_STR + ch * 16) = *(const GAS v4u*)(Kg + (size_t)key * kstr + ch * 8); }
    const int cpr = nkeys >> 3;
    for (int id = tid; id < 64 * cpr; id += NWAVES * 64) { const int d = id / cpr, ch = id % cpr; *(LAS v4u*)(Vl + d * vstr + ch * 16) = *(const GAS v4u*)(VTg + (size_t)d * vstr_g + ch * 8); }
}
__device__ __forceinline__ void memattn_prompt_unit(Frame& F, int layer, int unit) {
    int lane_ = F.lane; asm volatile("" : "+v"(lane_)); const int lane = lane_, r32 = lane & 31, hh = lane >> 5;
    const int b = unit >> 7, hm = (unit >> 5) & 3, qblk = unit & 31; const int row = b * T + qblk * 256 + F.wave * 32 + r32;
    LAS unsigned char* Kl = F.lds; LAS unsigned char* Vl = F.lds + 256 * KL_STR; constexpr int VSTR = 256 * 2 + 16;
    __syncthreads();
    stage_kv(Kl, Vl, VSTR, (const bf16*)(F.ws + WS_MK) + (size_t)((layer * 2 + b) * 4 + hm) * 256 * 64, 64, (const bf16*)(F.ws + WS_MVT) + (size_t)((layer * 2 + b) * 4 + hm) * 64 * 256, 256, 256, F.wave * 64 + lane);
    bf16x8 qf[4];
    if (layer == 0) { const bf16* qp = (const bf16*)(F.ws + WS_PROJ) + (size_t)row * NCOLA + RWKV_COLS + hm * 64; const float* gn = F.in[I_MQN];
        float x[4][8]; float ss = 0.f;
#pragma unroll
        for (int ks = 0; ks < 4; ++ks) { const v4u w = *(const GAS v4u*)(qp + 16 * ks + 8 * hh); const unsigned ww[4] = {w.x, w.y, w.z, w.w};
#pragma unroll
            for (int i = 0; i < 4; ++i) { x[ks][2 * i] = bflo(ww[i]); x[ks][2 * i + 1] = bfhi(ww[i]); ss += x[ks][2 * i] * x[ks][2 * i] + x[ks][2 * i + 1] * x[ks][2 * i + 1]; } }
        ss = add_x32(ss); const float rs = rsqrtf(ss * (1.0f / 64.0f) + 1e-6f) * C2Q;
#pragma unroll
        for (int ks = 0; ks < 4; ++ks) {
#pragma unroll
            for (int i = 0; i < 8; ++i) x[ks][i] *= rs * gn[16 * ks + 8 * hh + i];
            qf[ks] = pack_frag(x[ks]); }
    } else { const bf16* qp = (const bf16*)(F.ws + WS_Q1) + (size_t)row * DM + 768 + hm * 64;
#pragma unroll
        for (int ks = 0; ks < 4; ++ks) qf[ks] = *(const GAS bf16x8*)(qp + 16 * ks + 8 * hh); }
    __syncthreads();
    f32x16 o0, o1; float ls;
    flash32_lds<false>(qf, Kl, Vl, VSTR, 0, 8, 0, 0, -1e30f, 0.f, o0, o1, ls, lane);
    flash_store((bf16*)(F.ws + WS_MIX) + (size_t)(b * T + qblk * 256 + F.wave * 32) * DM + 768 + hm * 64, DM, o0, o1, ls, lane);
}
__device__ __forceinline__ void swa_prompt_unit(Frame& F, int unit) {
    int lane_ = F.lane; asm volatile("" : "+v"(lane_)); const int lane = lane_, r32 = lane & 31, hh = lane >> 5;
    const int b = unit >> 7, kvh = (unit >> 5) & 3, qblk = unit & 31, q0 = qblk * 256, kb0 = q0 >= 128 ? q0 - 128 : 0, nkeys = q0 + 256 - kb0;
    LAS unsigned char* Kl = F.lds; LAS unsigned char* Vl = F.lds + 384 * KL_STR; constexpr int VSTR = 384 * 2 + 16;
    __syncthreads();
    stage_kv(Kl, Vl, VSTR, (const bf16*)(F.ws + WS_K1) + (size_t)(b * T + kb0) * 256 + kvh * 64, 256, (const bf16*)(F.ws + WS_VT1) + (size_t)(b * 4 + kvh) * 64 * T + kb0, T, nkeys, F.wave * 64 + lane);
    const int tq = q0 + F.wave * 32, row = b * T + tq + r32;
    bf16x8 qf[3][4];
#pragma unroll
    for (int gq = 0; gq < 3; ++gq) { const bf16* qp = (const bf16*)(F.ws + WS_Q1) + (size_t)row * DM + (kvh * 3 + gq) * 64;
#pragma unroll
        for (int ks = 0; ks < 4; ++ks) qf[gq][ks] = *(const GAS bf16x8*)(qp + 16 * ks + 8 * hh); }
    __syncthreads();
    const int kp_lo = tq >= 128 ? tq - 128 : 0, nblk = (tq - kp_lo) / 32 + 1;
#pragma unroll
    for (int gq = 0; gq < 3; ++gq) { const int hq = kvh * 3 + gq; const float sink = F.in[I_SINKS][hq] * LOG2E;
        f32x16 o0, o1; float ls;
        flash32_lds<true>(qf[gq], Kl, Vl, VSTR, kp_lo - kb0, nblk, kp_lo, tq + r32, sink, 1.0f, o0, o1, ls, lane);
        flash_store((bf16*)(F.ws + WS_MIX) + (size_t)(b * T + tq) * DM + hq * 64, DM, o0, o1, ls, lane); }
}
template <int NQ, bool WINDOW>
__device__ __forceinline__ void small_attn(const LAS float* ql, LAS float* sc, int NKP, const float* k1, const float* v1, int kst1, int nk1, const bf16* k2, const bf16* v2, int kst2, int nk2,
                                           const float* sinkg  , bf16* out0, int ostride_q, int lane) {
    const int sub = lane >> 4, dq = lane & 15, nk = nk1 + nk2;
    f32x4 qv[NQ];
#pragma unroll
    for (int qi = 0; qi < NQ; ++qi) qv[qi] = *(const LAS f32x4*)(ql + qi * 64 + 4 * dq);
    constexpr int KBAT = NQ > 4 ? 4 : 8;
    for (int kg0 = 0; kg0 < nk1; kg0 += 4 * KBAT) { f32x4 kv[KBAT];
#pragma unroll
        for (int u = 0; u < KBAT; ++u) kv[u] = *(const GAS f32x4*)(k1 + (size_t)(kg0 + 4 * u + sub) * kst1 + 4 * dq);
#pragma unroll
        for (int u = 0; u < KBAT; ++u) { const int key = kg0 + 4 * u + sub;
#pragma unroll
            for (int qi = 0; qi < NQ; ++qi) { const f32x4 p = qv[qi] * kv[u]; const float s = sum16((p[0] + p[1]) + (p[2] + p[3])); if (dq == 0) sc[qi * NKP + key] = s; } } }
    for (int kg = nk1; kg < nk; kg += 4) { const int key = kg + sub; const f32x4 kv = unpack4(*(const GAS v2u*)(k2 + (size_t)(key - nk1) * kst2 + 4 * dq));
#pragma unroll
        for (int qi = 0; qi < NQ; ++qi) { const f32x4 p = qv[qi] * kv; const float s = sum16((p[0] + p[1]) + (p[2] + p[3])); if (dq == 0) sc[qi * NKP + key] = s; } }
    LDS_WAIT(); asm volatile("" ::: "memory");
#pragma unroll
    for (int qi = 0; qi < NQ; ++qi) { float sv[5]; const float sk_ = sinkg ? sinkg[qi >> 2] * LOG2E : -1e30f; float mx = sk_;
#pragma unroll
        for (int t = 0; t < 5; ++t) { const int key = lane + 64 * t; float s = -1e30f; if (key < nk) { s = sc[qi * NKP + key]; if (WINDOW) { const int i = qi & 3; if (key < i + 1 || key > 128 + i) s = -1e30f; } } sv[t] = s; mx = fmaxf(mx, s); }
        mx = wave_max(mx); float sum = 0.f;
#pragma unroll
        for (int t = 0; t < 5; ++t) { sv[t] = __builtin_amdgcn_exp2f(sv[t] - mx); sum += sv[t]; }
        sum = wave_sum(sum) + (sinkg ? __builtin_amdgcn_exp2f(sk_ - mx) : 0.f); const float inv = 1.0f / sum;
#pragma unroll
        for (int t = 0; t < 5; ++t) { const int key = lane + 64 * t; if (key < nk) sc[qi * NKP + key] = sv[t] * inv; } }
    LDS_WAIT(); asm volatile("" ::: "memory");
    f32x4 acc[NQ];
#pragma unroll
    for (int qi = 0; qi < NQ; ++qi) acc[qi] = (f32x4){0.f, 0.f, 0.f, 0.f};
    for (int kg0 = 0; kg0 < nk1; kg0 += 4 * KBAT) { f32x4 vv[KBAT];
#pragma unroll
        for (int u = 0; u < KBAT; ++u) vv[u] = *(const GAS f32x4*)(v1 + (size_t)(kg0 + 4 * u + sub) * kst1 + 4 * dq);
#pragma unroll
        for (int u = 0; u < KBAT; ++u) { const int key = kg0 + 4 * u + sub;
#pragma unroll
            for (int qi = 0; qi < NQ; ++qi) acc[qi] += vv[u] * sc[qi * NKP + key]; } }
    for (int kg = nk1; kg < nk; kg += 4) { const int key = kg + sub; const f32x4 vv = unpack4(*(const GAS v2u*)(v2 + (size_t)(key - nk1) * kst2 + 4 * dq));
#pragma unroll
        for (int qi = 0; qi < NQ; ++qi) acc[qi] += vv * sc[qi * NKP + key]; }
#pragma unroll
    for (int qi = 0; qi < NQ; ++qi) { f32x4 a = acc[qi];
#pragma unroll
        for (int e = 0; e < 4; ++e) { a[e] = add_x16(a[e]); a[e] = add_x32(a[e]); }
        if (sub == 0) *(GAS v2u*)(out0 + (size_t)(qi & 3) * ostride_q + (qi >> 2) * 64 + 4 * dq) = pack4(a); }
    LDS_WAIT(); asm volatile("" ::: "memory");
}
__device__ __forceinline__ void memattn_sample_task(Frame& F, int layer, int task, LAS float* wl  ) {
    int lane_ = F.lane; asm volatile("" : "+v"(lane_)); const int lane = lane_, b = task >> 2, hm = task & 3; LAS float* ql = wl; LAS float* sc = wl + 12 * 64;
#pragma unroll
    for (int i = 0; i < 4; ++i) { const int row = RP + b * ST + i; float x;
        if (layer == 0) { x = bf2f(((const bf16*)(F.ws + WS_PROJ))[(size_t)row * NCOLA + RWKV_COLS + hm * 64 + lane]); const float ss = wave_sum(x * x); x *= rsqrtf(ss * (1.0f / 64.0f) + 1e-6f) * C2Q * F.in[I_MQN][lane]; }
        else x = bf2f(((const bf16*)(F.ws + WS_Q1))[(size_t)row * DM + 768 + hm * 64 + lane]);
        ql[i * 64 + lane] = x; }
    LDS_WAIT(); asm volatile("" ::: "memory");
    const float* k1 = F.in[I_CMK] + (((size_t)layer * SB + b) * NMEM * 4 + hm) * 64; const float* v1 = F.in[I_CMV] + (((size_t)layer * SB + b) * NMEM * 4 + hm) * 64;
    small_attn<4, false>(ql, sc, 264, k1, v1, 256, 256, nullptr, nullptr, 0, 0, nullptr, (bf16*)(F.ws + WS_MIX) + (size_t)(RP + b * ST) * DM + 768 + hm * 64, DM, lane);
}
__device__ __forceinline__ void swa_sample_task(Frame& F, int task, LAS float* wl) {
    int lane_ = F.lane; asm volatile("" : "+v"(lane_)); const int lane = lane_, b = task >> 2, kvh = task & 3; LAS float* ql = wl; LAS float* sc = wl + 12 * 64;
#pragma unroll
    for (int qi = 0; qi < 12; ++qi) { const int i = qi & 3, gq = qi >> 2, hq = kvh * 3 + gq; const int row = RP + b * ST + i;
        ql[qi * 64 + lane] = bf2f(((const bf16*)(F.ws + WS_Q1))[(size_t)row * DM + hq * 64 + lane]); }
    LDS_WAIT(); asm volatile("" ::: "memory");
    const float* k1 = F.in[I_CSK] + ((size_t)b * 128 * 4 + kvh) * 64; const float* v1 = F.in[I_CSV] + ((size_t)b * 128 * 4 + kvh) * 64;
    const bf16* k2 = (const bf16*)(F.ws + WS_K1) + (size_t)(RP + b * ST) * 256 + kvh * 64; const bf16* v2 = (const bf16*)(F.ws + WS_V1) + (size_t)(RP + b * ST) * 256 + kvh * 64;
    small_attn<12, true>(ql, sc, 136, k1, v1, 256, 128, k2, v2, 256, 4, F.in[I_SINKS] + kvh * 3, (bf16*)(F.ws + WS_MIX) + (size_t)(RP + b * ST) * DM + kvh * 3 * 64, DM, lane);
}

constexpr int N_PHASES = 13;
template <int PM> __global__ void __launch_bounds__(NWAVES * 64, 2) yoco_fwd(Args args) {
    extern __shared__ __attribute__((aligned(16))) unsigned char lds[];
    Frame F;
    F.lds = (LAS unsigned char*)lds; F.lds_g = lds;
    F.wave = __builtin_amdgcn_readfirstlane((int)threadIdx.x >> 6); F.lane = mk_lane(); F.tid = F.wave * 64 + F.lane;
    F.G = gridDim.x; { const int bx = blockIdx.x; F.vcu = (F.G % 8 == 0) ? (bx % 8) * (F.G / 8) + bx / 8 : bx; }
    F.in = args.in; F.out = args.out; F.ws = args.ws; F.ctl = (gu32*)(args.ws + WS_CTL);
    for (int u = F.tid; u < (LDS_BYTES - LDSCTL_OFF) / 4; u += NWAVES * 64) ((LAS unsigned*)(F.lds + LDSCTL_OFF))[u] = 0u;
    __syncthreads();
    const int lo = args.ph_lo, hi = args.ph_hi;
    XcdBarrier bar; bar.wave0 = F.wave == 0; bar.bar = (unsigned*)(F.ctl + CW_BAR); bar.x = 0; bar.st = nullptr;
    bar = xcd_barrier_post((unsigned*)(F.ctl + CW_BAR), (volatile LAS unsigned*)(F.lds + MISC_OFF) + 8, F.wave == 0);
#define IN(k) (((PM >> (k)) & 1) && lo <= (k) && (k) < hi)
#ifndef MK_DUP
#define MK_DUP -1
#endif
#define PH_REP(k) ((MK_DUP == (k)) ? 2 : 1)
#define SEAM(k) do { if (IN(k) && IN((k) + 1)) xcd_barrier(bar); } while (0)
    const int gw = F.vcu * NWAVES + F.wave, NGW = F.G * NWAVES;
#define SSQ ((float*)(F.ws + WS_SSQ))
#define HB ((bf16*)(F.ws + WS_HB))
#define MIX ((bf16*)(F.ws + WS_MIX))
#define HH ((bf16*)(F.ws + WS_H))
#define PHASE_BEGIN() do { int z_ = 0; unsigned char* ws_ = args.ws; float* out_ = args.out; asm volatile("" : "+s"(z_), "+s"(ws_), "+s"(out_)); F.in = args.in + z_; F.ws = ws_; F.out = out_; \
                           F.lane = mk_lane(); F.tid = F.wave * 64 + F.lane; } while (0)

    if (IN(0)) for (int rep_ = 0; rep_ < PH_REP(0); ++rep_) { PHASE_BEGIN(); p0_prologue(F); } SEAM(0);

    if (IN(1)) for (int rep_ = 0; rep_ < PH_REP(1); ++rep_) { PHASE_BEGIN();
        { pg8::Gemm g{HB, (const bf16*)(F.ws + WS_WA), R, NCOLA, DM}; pg8::StaticOrder S; S.init(R, NCOLA, F.G, (int)blockIdx.x, DM);
          pg8::EpiScaleBf16<0> E{(bf16*)(F.ws + WS_PROJ), NCOLA, SSQ};
          pg8::gemm_phase<pg8::EpiScaleBf16<0>, pg8::StaticOrder, true, true>(F.lds + RING_OFF, g, S, E, F.wave, F.lane); }
#ifndef NO_MEMKV
        { pg8::Gemm g{(const bf16*)(F.ws + WS_MB), (const bf16*)(F.ws + WS_WM), 512, 1024, DM}; pg8::StaticOrder S; S.init(512, 1024, F.G, (int)blockIdx.x, DM);
          pg8::EpiMemKV E{F.ws, F.out, F.in[I_MKN]};
          pg8::gemm_phase<pg8::EpiMemKV, pg8::StaticOrder, true, true>(F.lds + RING_OFF, g, S, E, F.wave, F.lane); }
#endif
    } SEAM(1);

    if (IN(2)) for (int rep_ = 0; rep_ < ((MK_DUP == 2 || (MK_DUP >= 20 && MK_DUP < 30)) ? 2 : 1); ++rep_) { PHASE_BEGIN();
        const int half = F.wave >> 2; const int gw = F.vcu * NWAVES + F.wave, NGW = F.G * NWAVES;
        LAS unsigned char* hb = F.lds + half * PREP_HALF; LAS float* wtot = (LAS float*)(F.lds + WTOT_OFF + half * 1024);
        const int slim = (rep_ == 1 && MK_DUP == 21) ? 3 : (rep_ == 1 && MK_DUP == 22) ? 5 : 99;
        if (!(rep_ == 1 && MK_DUP == 20)) { LAS unsigned char* prow = F.lds + WTOT_OFF + 2048 + half * 512; PrepPf pf; if (F.vcu < NUNIT / 2) prep_issue(F, 2 * F.vcu + half, pf);
            for (int pi = F.vcu; pi < NUNIT / 2; pi += F.G) rwkv_prep_unit(F, 2 * pi + half, hb, wtot, prow, pf, pi + F.G < NUNIT / 2, 2 * (pi + F.G) + half, slim); }
        if (!(rep_ == 1 && (MK_DUP == 21 || MK_DUP == 22))) for (int t = gw; t < SB * NH + 2; t += NGW) {
            if (t < SB * NH) rwkv_sample_task(F, t);
            else { const int b = t - SB * NH; const bf16* lr = (const bf16*)(F.ws + WS_PROJ) + (size_t)(b * T + T - 1) * NCOLA; float* o = F.out + O_PSHIFT + (size_t)b * RWKV_COLS;
                for (int q = F.lane; q < RWKV_COLS; q += 64) o[q] = bf2f(lr[q]); } }
    } SEAM(2);

    if (IN(3)) for (int rep_ = 0; rep_ < ((MK_DUP == 30 || MK_DUP == 31) ? 2 : 1); ++rep_) { PHASE_BEGIN();
        const int nscan = NB * NH * 4;
        if (F.vcu < nscan) { if (F.wave == 0 && (rep_ == 0 || MK_DUP == 31)) rwkv_scan_chain(F, F.vcu >> 2, F.vcu & 3); }
        else if (rep_ == 0 || MK_DUP == 30) { LAS float* wl = (LAS float*)(F.lds + F.wave * 12288);
            for (int u = F.vcu - nscan; u < 256; u += F.G - nscan) memattn_prompt_unit(F, 0, u);
            __syncthreads();
            const int ow = (F.vcu - nscan) * NWAVES + F.wave, NOW = (F.G - nscan) * NWAVES;
            for (int t = ow; t < 512; t += NOW) memattn_sample_task(F, 0, t, wl); }
    } SEAM(3);

    if (IN(4)) for (int rep_ = 0; rep_ < PH_REP(4); ++rep_) { PHASE_BEGIN(); for (int it = gw; it < NUNIT * 4; it += NGW) rwkv_yout_item(F, it); } SEAM(4);

    if (IN(5)) for (int rep_ = 0; rep_ < PH_REP(5); ++rep_) { PHASE_BEGIN(); pg8::Gemm g{MIX, (const bf16*)(F.ws + WS_WOUT), R, DM, DM}; pg8::TailOrder S; S.init(F.G, (int)blockIdx.x, DM, S_K1);
        pg8::EpiResid E{F.in[I_XP], F.in[I_XS], RP, nullptr, HB, SSQ, (float*)(F.ws + WS_SLAB), S_K1};
        pg8::gemm_phase<pg8::EpiResid, pg8::TailOrder, true, true>(F.lds + RING_OFF, g, S, E, F.wave, F.lane); } SEAM(5);
    if (IN(6)) for (int rep_ = 0; rep_ < PH_REP(6); ++rep_) { PHASE_BEGIN(); finalize_sample(F, F.in[I_XS], S_K1, false); xcd_barrier(bar);
        pg8::Gemm g{HB, (const bf16*)(F.ws + WS_WUP), R, FF, DM}; pg8::StaticOrder S; S.init(R, FF, F.G, (int)blockIdx.x, DM);
        pg8::EpiScaleBf16<1> E{HH, FF, SSQ};
        pg8::gemm_phase<pg8::EpiScaleBf16<1>, pg8::StaticOrder, true, true>(F.lds + RING_OFF, g, S, E, F.wave, F.lane); } SEAM(6);
    if (IN(7)) { PHASE_BEGIN(); pg8::Gemm g{HH, (const bf16*)(F.ws + WS_WDN), R, DM, FF}; pg8::TailOrder S; S.init(F.G, (int)blockIdx.x, FF, S_K4);
        pg8::EpiResid E{nullptr, nullptr, RP, nullptr, HB, SSQ, (float*)(F.ws + WS_SLAB), S_K4, HB};
        pg8::gemm_phase<pg8::EpiResid, pg8::TailOrder, true, true>(F.lds + RING_OFF, g, S, E, F.wave, F.lane); } SEAM(7);

    if (IN(8)) for (int rep_ = 0; rep_ < PH_REP(8); ++rep_) { PHASE_BEGIN(); finalize_sample(F, nullptr, S_K4, false); xcd_barrier(bar);
        pg8::Gemm g{HB, (const bf16*)(F.ws + WS_WB), R, NCOLB, DM}; pg8::StaticOrder S; S.init(R, NCOLB, F.G, (int)blockIdx.x, DM);
        pg8::EpiL1 E{F.ws, F.out, F.in[I_QN], F.in[I_MQN] + 64, F.in[I_KN]};
        pg8::gemm_phase<pg8::EpiL1, pg8::StaticOrder, true, true>(F.lds + RING_OFF, g, S, E, F.wave, F.lane); } SEAM(8);

    if (IN(9)) for (int rep_ = 0; rep_ < PH_REP(9); ++rep_) { PHASE_BEGIN(); LAS float* wl = (LAS float*)(F.lds + F.wave * 12288); const int gw = F.vcu * NWAVES + F.wave, NGW = F.G * NWAVES;
        for (int u = F.vcu; u < 256; u += F.G) swa_prompt_unit(F, u);
        for (int u = F.vcu; u < 256; u += F.G) memattn_prompt_unit(F, 1, u);
        __syncthreads();
        for (int t = gw; t < 512 + 512; t += NGW) { if (t < 512) swa_sample_task(F, t, wl); else memattn_sample_task(F, 1, t - 512, wl); }
    } SEAM(9);

    if (IN(10)) for (int rep_ = 0; rep_ < PH_REP(10); ++rep_) { PHASE_BEGIN(); pg8::Gemm g{MIX, (const bf16*)(F.ws + WS_WOUT) + (size_t)DM * DM, R, DM, DM}; pg8::TailOrder S; S.init(F.G, (int)blockIdx.x, DM, S_K1);
        pg8::EpiResid E{nullptr, nullptr, RP, nullptr, HB, SSQ, (float*)(F.ws + WS_SLAB), S_K1, HB};
        pg8::gemm_phase<pg8::EpiResid, pg8::TailOrder, true, true>(F.lds + RING_OFF, g, S, E, F.wave, F.lane); } SEAM(10);
    if (IN(11)) for (int rep_ = 0; rep_ < PH_REP(11); ++rep_) { PHASE_BEGIN(); finalize_sample(F, nullptr, S_K1, false); xcd_barrier(bar);
        pg8::Gemm g{HB, (const bf16*)(F.ws + WS_WUP) + (size_t)DM * FF, R, FF, DM}; pg8::StaticOrder S; S.init(R, FF, F.G, (int)blockIdx.x, DM);
        pg8::EpiScaleBf16<1> E{HH, FF, SSQ};
        pg8::gemm_phase<pg8::EpiScaleBf16<1>, pg8::StaticOrder, true, true>(F.lds + RING_OFF, g, S, E, F.wave, F.lane); } SEAM(11);
    if (IN(12)) for (int rep_ = 0; rep_ < PH_REP(12); ++rep_) { PHASE_BEGIN(); pg8::Gemm g{HH, (const bf16*)(F.ws + WS_WDN) + (size_t)DM * FF, R, DM, FF}; pg8::TailOrder S; S.init(F.G, (int)blockIdx.x, FF, S_K4);
        pg8::EpiResid E{nullptr, nullptr, RP, F.out + O_Y, nullptr, nullptr, (float*)(F.ws + WS_SLAB), S_K4, HB};
        pg8::gemm_phase<pg8::EpiResid, pg8::TailOrder, true, true>(F.lds + RING_OFF, g, S, E, F.wave, F.lane);
        xcd_barrier(bar); finalize_sample(F, nullptr, S_K4, true); }
#undef IN
#undef SEAM
#undef SSQ
#undef HB
#undef MIX
#undef HH
#undef PHASE_BEGIN
}

template <int PM> static void launch_pm(int grid, hipStream_t stream, const Args& a) { hipLaunchKernelGGL(yoco_fwd<PM>, dim3(grid), dim3(NWAVES * 64), LDS_BYTES, stream, a); }
template <int PM> static bool set_lds() { return hipFuncSetAttribute((const void*)yoco_fwd<PM>, hipFuncAttributeMaxDynamicSharedMemorySize, LDS_BYTES) == hipSuccess; }
extern "C" void kernel_launch(void* const* d_in, const int* in_sizes, int n_in, void* d_out, int out_size, void* d_ws, size_t ws_size, hipStream_t stream) {
    static int grid = 0;
    if (grid == 0) {
        if (n_in != N_IN || (size_t)out_size != O_END || ws_size < WS_END) { fprintf(stderr, "kernel_launch: unexpected shapes (n_in %d, out %d, ws %zu < %zu)\n", n_in, out_size, ws_size, (size_t)WS_END); grid = -1; return; }
        int dev = 0, cus = 0;
        if (hipGetDevice(&dev) != hipSuccess || hipDeviceGetAttribute(&cus, hipDeviceAttributeMultiprocessorCount, dev) != hipSuccess) { grid = -1; return; }
        bool ok = true;
#if MK_ONE_LAUNCH
        ok = set_lds<0x1fff>();
#else
        ok = set_lds<1>() && set_lds<2>() && set_lds<4>() && set_lds<8>() && set_lds<16>() && set_lds<32>() && set_lds<64>() && set_lds<128>() && set_lds<256>() && set_lds<512>() && set_lds<1024>() && set_lds<2048>() && set_lds<4096>();
#endif
        if (!ok) { grid = -1; return; }
        (void)hipGetLastError();
        grid = cus;
    }
    if (grid < 0) return;
    (void)hipMemsetAsync((char*)d_ws + WS_CTL, 0, CTL_ZERO_BYTES, stream);
    Args a{};
    for (int i = 0; i < N_IN; ++i) a.in[i] = (const float*)d_in[i];
    a.out = (float*)d_out; a.ws = (unsigned char*)d_ws;
#if MK_ONE_LAUNCH
    a.ph_lo = 0; a.ph_hi = N_PHASES; launch_pm<0x1fff>(grid, stream, a);
#else
#define LP(p) a.ph_lo = (p); a.ph_hi = (p) + 1; launch_pm<(1 << (p))>(grid, stream, a);
    LP(0) LP(1) LP(2) LP(3) LP(4) LP(5) LP(6) LP(7) LP(8) LP(9) LP(10) LP(11) LP(12)
#undef LP
#endif
}
```

```cpp
#include <hip/hip_runtime.h>
#include <cstdio>
#include <cstdint>
namespace pg8 {
#define PG8_LAS __attribute__((address_space(3)))
typedef unsigned short bf16_t;
typedef short bf16x8 __attribute__((ext_vector_type(8)));
typedef float f32x4 __attribute__((ext_vector_type(4)));
typedef unsigned u32x4 __attribute__((ext_vector_type(4)));
constexpr int BM = 256, BK = 64, HALF = 128, HTB = HALF * BK * 2  , STAGE_BYTES = 8 * HTB, NXCD = 8, WGM = 8;

__host__ __device__ __forceinline__ int lds_byte(int r, int c) { const int st = (r >> 4) * 2 + (c >> 5), rr = r & 15, cc = c & 31, ob = rr * 64 + cc * 2; return st * 1024 + (ob ^ (((ob >> 9) & 1) << 5)); }
__host__ __device__ __forceinline__ void stage_rc(int b, int& R, int& C) { const int st = b / 1024, sb = b % 1024, swz = sb ^ (((sb >> 9) & 1) << 5); R = (st >> 1) * 16 + swz / 64; C = (st & 1) * 32 + (swz % 64) / 2; }
__host__ __device__ __forceinline__ int perm32(int rho) { const int n = rho >> 4, i = rho & 15; return 8 * (i >> 2) + 4 * n + (i & 3); }

struct Unit { int pm, pn, kt0, nt; };
struct Gemm { const bf16_t* A; const bf16_t* Bt; int M, N, K; };

struct StaticOrder {
    int nM, nN, nwg, G, c, ntf;
    __host__ __device__ void init(int M, int N, int G_, int c_, int K_) { nM = M / BM; nN = N / BM; nwg = nM * nN; G = G_; c = c_; ntf = K_ / BK; }
    __host__ __device__ bool next(int i, Unit& u) const {
        const long L = (long)i * G + c; if (L >= nwg) return false;
        int wgid = (int)L; { const int q = nwg / NXCD, r = nwg % NXCD, xcd = wgid % NXCD, off = wgid / NXCD; wgid = (xcd < r ? xcd * (q + 1) : r * (q + 1) + (xcd - r) * q) + off; }
        const int nig = WGM * nN, gid = wgid / nig, fm = gid * WGM, gsz = (nM - fm) < WGM ? (nM - fm) : WGM;
        u.pm = fm + ((wgid % nig) % gsz); u.pn = (wgid % nig) / gsz; u.kt0 = 0; u.nt = ntf; return true;
    }
    __device__ __forceinline__ void a_ready(const Unit&) const {}
    __device__ __forceinline__ void done(const Unit&) const {}
};
struct TailOrder {
    StaticOrder P; int S, ntf;
    __host__ __device__ void init(int G_, int c_, int K_, int S_) { P.init(64 * BM, 4 * BM, G_, c_, K_); S = S_; ntf = K_ / BK; }
    __host__ __device__ bool next(int i, Unit& u) const {
        const long L = (long)i * P.G + P.c; if (L >= 256 + 8 * S) return false;
        const int Li = (int)L; const bool prm = Li < 256;
        const int w0 = prm ? Li : 0, wg = (w0 % NXCD) * (256 / NXCD) + w0 / NXCD, nig = WGM * 4, gid = wg / nig, fm = gid * WGM;
        const int pmP = fm + ((wg % nig) % WGM), pnP = (wg % nig) / WGM;
        const int Ls = prm ? 0 : Li - 256, tile = Ls / S, sl = Ls % S, nts = ntf / S;
        u.pm = prm ? pmP : 64 + (tile >> 2); u.pn = prm ? pnP : (tile & 3); u.nt = prm ? ntf : nts; u.kt0 = prm ? 0 : sl * nts; return true;
    }
    __device__ __forceinline__ void a_ready(const Unit&) const {}
    __device__ __forceinline__ void done(const Unit&) const {}
};


typedef float f32x2_t __attribute__((ext_vector_type(2))); typedef __bf16 bf16x2_t __attribute__((ext_vector_type(2)));
__device__ __forceinline__ unsigned cvt_pk_bf16(float lo, float hi) { f32x2_t v = {lo, hi}; bf16x2_t b = __builtin_convertvector(v, bf16x2_t); return __builtin_bit_cast(unsigned, b); }
__device__ __forceinline__ u32x4 pack8(f32x4 v0, f32x4 v1) { u32x4 w; w.x = cvt_pk_bf16(v0[0], v0[1]); w.y = cvt_pk_bf16(v0[2], v0[3]); w.z = cvt_pk_bf16(v1[0], v1[1]); w.w = cvt_pk_bf16(v1[2], v1[3]); return w; }

template <int M> __device__ __forceinline__ float swz_xor(float v) { return __int_as_float(__builtin_amdgcn_ds_swizzle(__float_as_int(v), (M << 10) | 0x1f)); }
__device__ __forceinline__ float add_x32(float v) { auto r = __builtin_amdgcn_permlane32_swap(__float_as_uint(v), __float_as_uint(v), false, false); return __uint_as_float(r[0]) + __uint_as_float(r[1]); }
__device__ __forceinline__ float max_x32(float v) { auto r = __builtin_amdgcn_permlane32_swap(__float_as_uint(v), __float_as_uint(v), false, false); return fmaxf(__uint_as_float(r[0]), __uint_as_float(r[1])); }
__device__ __forceinline__ float add_x16(float v) { return v + swz_xor<16>(v); }
template <int CTRL> __device__ __forceinline__ float dpp_mov(float v) { return __int_as_float(__builtin_amdgcn_update_dpp(0, __float_as_int(v), CTRL, 0xf, 0xf, false)); }
__device__ __forceinline__ float sum16_dpp(float v) { v += dpp_mov<0xB1>(v); v += dpp_mov<0x4E>(v); v += dpp_mov<0x141>(v); v += dpp_mov<0x140>(v); return v; }
__device__ __forceinline__ float max16_dpp(float v) { v = fmaxf(v, dpp_mov<0xB1>(v)); v = fmaxf(v, dpp_mov<0x4E>(v)); v = fmaxf(v, dpp_mov<0x141>(v)); v = fmaxf(v, dpp_mov<0x140>(v)); return v; }
__device__ __forceinline__ float sum4_dpp(float v) { v += dpp_mov<0xB1>(v); v += dpp_mov<0x4E>(v); return v; }
__device__ __forceinline__ float hsum4(f32x4 a) { return (a[0] + a[1]) + (a[2] + a[3]); }
__device__ __forceinline__ float row_rstd(const float* ssq, int row) {
    const f32x4* p = (const f32x4*)(ssq + (size_t)row * 16);
    const f32x4 a = p[0], b = p[1], c = p[2], d = p[3];
    const float s = (hsum4(a) + hsum4(b)) + (hsum4(c) + hsum4(d));
    return rsqrtf(s * (1.0f / 1024.0f) + 1e-6f);
}
template <int ACT> struct EpiScaleBf16 {
    static constexpr bool PERM = true, AFTER_DRAIN = false;
    bf16_t* O; int ldc; const float* ssq;
    __device__ __forceinline__ void operator()(const f32x4 (&acc)[2][2][4][2], const Unit& u, int wr, int wc, int fr_, int fq_) const {
        int fr = fr_, fq = fq_; asm volatile("" : "+v"(fr), "+v"(fq));
        const int row0 = u.pm * BM + wr * 64 + fr, col0 = u.pn * BM + wc * 32 + 8 * fq;
#pragma unroll
        for (int ai = 0; ai < 2; ++ai)
#pragma unroll
            for (int m = 0; m < 4; ++m) { const int row = row0 + ai * HALF + m * 16; const float rs = row_rstd(ssq, row); bf16_t* rowp = O + (size_t)row * ldc + col0;
#pragma unroll
                for (int bj = 0; bj < 2; ++bj) { f32x4 v0 = acc[ai][bj][m][0] * rs, v1 = acc[ai][bj][m][1] * rs;
                    if (ACT == 1) {
#pragma unroll
                        for (int e = 0; e < 4; ++e) { const float a = fmaxf(v0[e], 0.f), b = fmaxf(v1[e], 0.f); v0[e] = a * a; v1[e] = b * b; } }
                    *(u32x4*)(rowp + bj * HALF) = pack8(v0, v1); } }
    }
};
struct EpiResid {
    static constexpr bool PERM = true, AFTER_DRAIN = false;
    const float* base; const float* base2; int split; float* out; bf16_t* hb; float* ssq_out; float* slab; int S; const bf16_t* hbase = nullptr; int omask = -1;
    __device__ __forceinline__ void operator()(const f32x4 (&acc)[2][2][4][2], const Unit& u, int wr, int wc, int fr_, int fq_) const {
        int fr = fr_, fq = fq_; asm volatile("" : "+v"(fr), "+v"(fq));
        if (slab && u.pm >= 64) {
            float* sp = slab + ((size_t)((((u.pm - 64) << 2) + u.pn) * S + u.kt0 / u.nt) << 16) + (size_t)(wr * 64 + fr) * 256 + wc * 32 + 8 * fq;
#pragma unroll
            for (int ai = 0; ai < 2; ++ai)
#pragma unroll
                for (int m = 0; m < 4; ++m)
#pragma unroll
                    for (int bj = 0; bj < 2; ++bj) { float* p = sp + (size_t)(ai * HALF + m * 16) * 256 + bj * HALF; *(f32x4*)p = acc[ai][bj][m][0]; *(f32x4*)(p + 4) = acc[ai][bj][m][1]; }
            return;
        }
        const int row0 = u.pm * BM + wr * 64 + fr, col0 = u.pn * BM + wc * 32 + 8 * fq;
#pragma unroll
        for (int ai = 0; ai < 2; ++ai)
#pragma unroll
            for (int m = 0; m < 4; ++m) { const int row = row0 + ai * HALF + m * 16;
                const float* bp = (row < split ? base + (size_t)row * 1024 : base2 + (size_t)(row - split) * 1024) + col0;
                float ss = 0.f;
#pragma unroll
                for (int bj = 0; bj < 2; ++bj) { f32x4 b0, b1;
                    if (hbase) { const u32x4 w = *(const u32x4*)(hbase + (size_t)row * 1024 + col0 + bj * HALF);
                        b0 = (f32x4){__uint_as_float(w.x << 16), __uint_as_float(w.x & 0xffff0000u), __uint_as_float(w.y << 16), __uint_as_float(w.y & 0xffff0000u)};
                        b1 = (f32x4){__uint_as_float(w.z << 16), __uint_as_float(w.z & 0xffff0000u), __uint_as_float(w.w << 16), __uint_as_float(w.w & 0xffff0000u)}; }
                    else { b0 = *(const f32x4*)(bp + bj * HALF); b1 = *(const f32x4*)(bp + bj * HALF + 4); }
                    const f32x4 h0 = b0 + acc[ai][bj][m][0], h1 = b1 + acc[ai][bj][m][1];
                    if (out) { float* op = out + (size_t)(row & omask) * 1024 + col0; *(f32x4*)(op + bj * HALF) = h0; *(f32x4*)(op + bj * HALF + 4) = h1; }
                    if (hb) *(u32x4*)(hb + (size_t)row * 1024 + col0 + bj * HALF) = pack8(h0, h1);
                    ss += hsum4(h0 * h0) + hsum4(h1 * h1); }
                if (ssq_out) { ss = add_x16(ss); ss = add_x32(ss); if (fq == 0) ssq_out[(size_t)row * 16 + u.pn * 4 + wc] = ss; }
                if (m & 1) asm volatile("" ::: "memory"); }
    }
};
template <class Epi, class Sched, bool ALIGN_EPI = false, bool SP2 = false>
__device__ __forceinline__ void gemm_phase(PG8_LAS unsigned char* lds, const Gemm g, const Sched& S, const Epi& E, int wid_in, int lane_in) {
    const int wid = wid_in, lane = lane_in, tid = wid * 64 + lane, wr = wid >> 2, wc = wid & 3, fr = lane & 15, fq = lane >> 4;
    const int K = g.K;
    unsigned voffA[2], voffB[2];
#pragma unroll
    for (int i = 0; i < 2; ++i) { int R, C; stage_rc(tid * 16 + i * 8192, R, C); const int Rb = Epi::PERM ? ((R & ~31) + perm32(R & 31)) : R;
        voffA[i] = (unsigned)(R * K + C) * 2u; voffB[i] = (unsigned)(Rb * K + C) * 2u; }
    const size_t kstep = (size_t)(BK * 2);
    const size_t hstep = (size_t)HALF * K * 2;
    const size_t tstep = 2 * hstep;
    const unsigned ldsw = (unsigned)wid * 1024u;
    const int aoff = lds_byte(wr * 64 + fr, fq * 8), boff = lds_byte(wc * 32 + fr, fq * 8);
#define PG8_SA(b, h) (((b) * 2 + (h)) * HTB)
#define PG8_SB(b, h) ((4 + (b) * 2 + (h)) * HTB)
#define PG8_STAGE(bufoff, gbase, voff) do { _Pragma("unroll") for (int _i = 0; _i < 2; ++_i) \
        __builtin_amdgcn_global_load_lds((const unsigned*)((const char*)(gbase) + (voff)[_i]), (PG8_LAS unsigned*)(lds + (bufoff) + ldsw + _i * 8192), 16, 0, 0); } while (0)
#define PG8_LDA(dst, b, h) do { _Pragma("unroll") for (int m = 0; m < 4; ++m) _Pragma("unroll") for (int k = 0; k < 2; ++k) dst[m][k] = *(const PG8_LAS bf16x8*)(lds + PG8_SA(b, h) + aoff + m * 2048 + k * 1024); } while (0)
#define PG8_LDB(dst, b, h) do { _Pragma("unroll") for (int n = 0; n < 2; ++n) _Pragma("unroll") for (int k = 0; k < 2; ++k) dst[n][k] = *(const PG8_LAS bf16x8*)(lds + PG8_SB(b, h) + boff + n * 2048 + k * 1024); } while (0)
#define PG8_MMA(ai, bj, At, Bt) do { __builtin_amdgcn_s_setprio(1); _Pragma("unroll") for (int m = 0; m < 4; ++m) _Pragma("unroll") for (int n = 0; n < 2; ++n) _Pragma("unroll") for (int k = 0; k < 2; ++k) \
        acc[ai][bj][m][n] = __builtin_amdgcn_mfma_f32_16x16x32_bf16(Bt[n][k], At[m][k], acc[ai][bj][m][n], 0, 0, 0); __builtin_amdgcn_s_setprio(0); } while (0)
#define PG8_WAIT_V(n) asm volatile("s_waitcnt vmcnt(" #n ")" ::: "memory")
#define PG8_WAIT_L(n) asm volatile("s_waitcnt lgkmcnt(" #n ")" ::: "memory")
#define PG8_BAR __builtin_amdgcn_s_barrier()
#define PG8_SCHED __builtin_amdgcn_sched_barrier(0)
    Unit cur, nxt; int ui = 0;
    if (!S.next(0, cur)) return;
    f32x4 acc[2][2][4][2];
#pragma unroll
    for (int a = 0; a < 2; ++a)
#pragma unroll
        for (int b = 0; b < 2; ++b)
#pragma unroll
            for (int m = 0; m < 4; ++m)
#pragma unroll
                for (int n = 0; n < 2; ++n) acc[a][b][m][n] = (f32x4){0.f, 0.f, 0.f, 0.f};
    bf16x8 At[4][2], B0[2][2], B1[2][2];
    const char* cA = (const char*)g.A + (size_t)cur.pm * tstep + (size_t)cur.kt0 * kstep; const char* cB = (const char*)g.Bt + (size_t)cur.pn * tstep + (size_t)cur.kt0 * kstep;
    S.a_ready(cur);
    if constexpr (SP2) {
        PG8_STAGE(PG8_SB(0, 0), cB, voffB); PG8_STAGE(PG8_SB(0, 1), cB + hstep, voffB); PG8_STAGE(PG8_SA(0, 0), cA, voffA); PG8_STAGE(PG8_SA(0, 1), cA + hstep, voffA);
        if (wr == 1) PG8_BAR;
        PG8_WAIT_V(2); PG8_BAR;
        PG8_STAGE(PG8_SB(1, 0), cB + kstep, voffB); PG8_STAGE(PG8_SA(1, 0), cA + kstep, voffA); PG8_STAGE(PG8_SB(1, 1), cB + hstep + kstep, voffB);
        PG8_WAIT_V(6); PG8_BAR;
    } else {
        PG8_STAGE(PG8_SB(0, 0), cB, voffB); PG8_STAGE(PG8_SA(0, 0), cA, voffA); PG8_STAGE(PG8_SB(0, 1), cB + hstep, voffB); PG8_STAGE(PG8_SA(0, 1), cA + hstep, voffA);
        if (wr == 1) PG8_BAR;
        PG8_WAIT_V(4); PG8_BAR;
        PG8_STAGE(PG8_SB(1, 0), cB + kstep, voffB); PG8_STAGE(PG8_SA(1, 0), cA + kstep, voffA); PG8_STAGE(PG8_SB(1, 1), cB + hstep + kstep, voffB);
        PG8_WAIT_V(6); PG8_BAR;
    }
    for (;;) {
        const bool has_next = S.next(ui + 1, nxt);
        const char* nA = has_next ? (const char*)g.A + (size_t)nxt.pm * tstep + (size_t)nxt.kt0 * kstep : cA; const char* nB = has_next ? (const char*)g.Bt + (size_t)nxt.pn * tstep + (size_t)nxt.kt0 * kstep : cB;
        const int nt = cur.nt;
        for (int t = 0; t < nt; t += 2) {
            const bool last = (t == nt - 2);
            const char* a1 = cA + (size_t)(t + 1) * kstep;
            const char* a2 = last ? nA : cA + (size_t)(t + 2) * kstep; const char* b2 = last ? nB : cB + (size_t)(t + 2) * kstep;
            const char* a3 = a2 + kstep; const char* b3 = b2 + kstep;
            if (last && has_next) S.a_ready(nxt);
            if constexpr (SP2) {
            PG8_LDB(B0, 0, 0); PG8_LDB(B1, 0, 1); PG8_SCHED; PG8_LDA(At, 0, 0); PG8_STAGE(PG8_SA(1, 1), a1 + hstep, voffA);
            PG8_WAIT_V(8); PG8_WAIT_L(0); PG8_BAR; PG8_MMA(0, 0, At, B0); PG8_MMA(0, 1, At, B1); PG8_BAR; PG8_SCHED;
            PG8_LDA(At, 0, 1); PG8_STAGE(PG8_SB(0, 0), b2, voffB); PG8_STAGE(PG8_SB(0, 1), b2 + hstep, voffB); PG8_STAGE(PG8_SA(0, 0), a2, voffA);
            PG8_WAIT_V(8); PG8_WAIT_L(0); PG8_BAR; PG8_MMA(1, 0, At, B0); PG8_MMA(1, 1, At, B1); PG8_BAR; PG8_SCHED;
            PG8_LDB(B0, 1, 0); PG8_LDB(B1, 1, 1); PG8_SCHED; PG8_LDA(At, 1, 0); PG8_STAGE(PG8_SA(0, 1), a2 + hstep, voffA);
            PG8_WAIT_V(8); PG8_WAIT_L(0); PG8_BAR; PG8_MMA(0, 0, At, B0); PG8_MMA(0, 1, At, B1); PG8_BAR; PG8_SCHED;
            PG8_LDA(At, 1, 1); PG8_STAGE(PG8_SB(1, 0), b3, voffB); PG8_STAGE(PG8_SB(1, 1), b3 + hstep, voffB); PG8_STAGE(PG8_SA(1, 0), a3, voffA);
            PG8_WAIT_V(8); PG8_WAIT_L(0); PG8_BAR; PG8_MMA(1, 0, At, B0); PG8_MMA(1, 1, At, B1); PG8_BAR; PG8_SCHED;
            } else {
            PG8_LDB(B0, 0, 0); PG8_SCHED; PG8_LDA(At, 0, 0); PG8_STAGE(PG8_SA(1, 1), a1 + hstep, voffA);
            PG8_WAIT_L(8); PG8_BAR; PG8_WAIT_L(0); PG8_MMA(0, 0, At, B0); PG8_BAR; PG8_SCHED;
            PG8_LDB(B1, 0, 1); PG8_STAGE(PG8_SB(0, 0), b2, voffB);
            PG8_BAR; PG8_WAIT_L(0); PG8_MMA(0, 1, At, B1); PG8_BAR;
            PG8_LDA(At, 0, 1); PG8_STAGE(PG8_SA(0, 0), a2, voffA);
            PG8_BAR; PG8_WAIT_L(0); PG8_MMA(1, 0, At, B0); PG8_BAR; PG8_SCHED;
            PG8_STAGE(PG8_SB(0, 1), b2 + hstep, voffB);
            PG8_WAIT_V(6); PG8_BAR; PG8_MMA(1, 1, At, B1); PG8_BAR;
            PG8_LDB(B0, 1, 0); PG8_SCHED; PG8_LDA(At, 1, 0); PG8_STAGE(PG8_SA(0, 1), a2 + hstep, voffA);
            PG8_WAIT_L(8); PG8_BAR; PG8_WAIT_L(0); PG8_MMA(0, 0, At, B0); PG8_BAR; PG8_SCHED;
            PG8_LDB(B1, 1, 1); PG8_STAGE(PG8_SB(1, 0), b3, voffB);
            PG8_BAR; PG8_WAIT_L(0); PG8_MMA(0, 1, At, B1); PG8_BAR;
            PG8_LDA(At, 1, 1); PG8_STAGE(PG8_SA(1, 0), a3, voffA);
            PG8_BAR; PG8_WAIT_L(0); PG8_MMA(1, 0, At, B0); PG8_BAR; PG8_SCHED;
            PG8_STAGE(PG8_SB(1, 1), b3 + hstep, voffB);
            PG8_WAIT_V(6); PG8_BAR; PG8_MMA(1, 1, At, B1); PG8_BAR;
            }
        }
        if constexpr (ALIGN_EPI) { if (wr == 0) PG8_BAR; }
        if constexpr (!Epi::AFTER_DRAIN) { E(acc, cur, wr, wc, fr, fq); S.done(cur); }
        if (!has_next) break;
#pragma unroll
        for (int a = 0; a < 2; ++a)
#pragma unroll
            for (int b = 0; b < 2; ++b)
#pragma unroll
                for (int m = 0; m < 4; ++m)
#pragma unroll
                    for (int n = 0; n < 2; ++n) acc[a][b][m][n] = (f32x4){0.f, 0.f, 0.f, 0.f};
        cur = nxt; cA = nA; cB = nB; ++ui;
        if constexpr (ALIGN_EPI) { if (wr == 1) PG8_BAR; }
    }
    PG8_WAIT_V(0);
    if constexpr (!ALIGN_EPI) { if (wr == 0) PG8_BAR; }
    PG8_BAR;
    if constexpr (Epi::AFTER_DRAIN) { E.fused(acc, cur, wr, wc, fr, fq, lds, wid, lane); S.done(cur); }
#undef PG8_SA
#undef PG8_SB
#undef PG8_STAGE
#undef PG8_LDA
#undef PG8_LDB
#undef PG8_MMA
#undef PG8_WAIT_V
#undef PG8_WAIT_L
#undef PG8_BAR
#undef PG8_SCHED
}
}

constexpr int NWAVES = 8;
#ifndef MK_ONE_LAUNCH
#define MK_ONE_LAUNCH 1
#endif
constexpr int DM = 1024, RP = 16384  , RS = 512  , R = RP + RS, T = 8192, NB = 2, SB = 128, ST = 4;
constexpr int NCOLA = 2816, RWKV_COLS = 2560, NH = 12, HD = 64, FF = 4096, NCOLB = 1536, NMEM = 256;
constexpr int NCHUNK = RP / 64  , NUNIT = NCHUNK * NH  ;
constexpr float C2Q = 0.125f * 1.4426950408889634f;
constexpr float LOG2E = 1.4426950408889634f;
enum { I_XP = 0, I_XS, I_SSHIFT, I_SWKV, I_CSK, I_CSV, I_CMK, I_CMV, I_MEMP, I_NMIX, I_NMLP, I_WOUT, I_WUP, I_WDN, I_MNORM, I_WMKV, I_MQN, I_MKN,
       I_WINA, I_MU, I_WW2, I_W0, I_WA2, I_A0, I_WG2, I_KK, I_KA, I_RK, I_LNW, I_LNB, I_WINB, I_QN, I_SINKS, I_KVN, I_WKV, I_KN, N_IN };
constexpr size_t O_Y = 0, O_PSHIFT = (size_t)R * DM, O_PWKV = O_PSHIFT + 2 * RWKV_COLS, O_PSK = O_PWKV + 2 * 12 * 4096, O_PSV = O_PSK + 2 * 128 * 256,
                 O_PMK = O_PSV + 2 * 128 * 256, O_PMV = O_PMK + 2 * 2 * 256 * 256, O_SSHIFT = O_PMV + 2 * 2 * 256 * 256, O_SWKV = O_SSHIFT + (size_t)SB * RWKV_COLS,
                 O_SSK = O_SWKV + (size_t)SB * 12 * 4096, O_SSV = O_SSK + (size_t)SB * 128 * 256, O_END = O_SSV + (size_t)SB * 128 * 256;
constexpr size_t al256(size_t x) { return (x + 255) & ~(size_t)255; }
constexpr size_t WS_CTL = 0, CTL_ZERO_BYTES = 1u << 15;
constexpr size_t WS_WA = 1u << 20;
constexpr size_t WS_WOUT = WS_WA + (size_t)NCOLA * DM * 2;
constexpr size_t WS_WUP = WS_WOUT + (size_t)2 * DM * DM * 2;
constexpr size_t WS_WDN = WS_WUP + (size_t)2 * FF * DM * 2;
constexpr size_t WS_WB = WS_WDN + (size_t)2 * FF * DM * 2;
constexpr size_t WS_WM = WS_WB + (size_t)NCOLB * DM * 2;
constexpr size_t WS_WW2 = WS_WM + (size_t)DM * DM * 2;
constexpr size_t WS_WA2 = WS_WW2 + (size_t)768 * 64 * 2;
constexpr size_t WS_WG2 = WS_WA2 + (size_t)768 * 64 * 2;
constexpr size_t WS_ROPE = WS_WG2 + (size_t)768 * 128 * 2;
constexpr size_t WS_SSQ = al256(WS_ROPE + (size_t)8196 * 64 * 4);
constexpr size_t WS_SSQM = WS_SSQ + (size_t)R * 16 * 4;
constexpr size_t WS_MB = WS_SSQM + (size_t)512 * 16 * 4;
constexpr size_t WS_MK = WS_MB + (size_t)512 * DM * 2;
constexpr size_t WS_MVT = WS_MK + (size_t)2 * 2 * 4 * 256 * 64 * 2;
constexpr size_t WS_HB = WS_MVT + (size_t)2 * 2 * 4 * 256 * 64 * 2;
constexpr size_t WS_MIX = WS_HB + (size_t)R * DM * 2;
constexpr size_t WS_BIG = WS_MIX + (size_t)R * DM * 2;
constexpr size_t WS_PROJ = WS_BIG;
constexpr size_t WS_REC = WS_PROJ + (size_t)R * NCOLA * 2;
constexpr size_t REC_BYTES = 5 * 8192;
constexpr size_t WS_END0 = WS_REC + (size_t)NUNIT * REC_BYTES;
constexpr size_t WS_H = WS_BIG;
constexpr size_t WS_END1 = WS_H + (size_t)R * FF * 2;
constexpr size_t WS_SLAB = WS_BIG + ((size_t)160 << 20);
constexpr int S_K1 = 4, S_K4 = 16;
constexpr size_t WS_Q1 = WS_BIG;
constexpr size_t WS_K1 = WS_Q1 + (size_t)R * DM * 2;
constexpr size_t WS_V1 = WS_K1 + (size_t)R * 256 * 2;
constexpr size_t WS_VT1 = WS_V1 + (size_t)R * 256 * 2;
constexpr size_t WS_END = WS_END0 > WS_END1 ? WS_END0 : WS_END1;
static_assert(WS_VT1 + (size_t)2 * 4 * 64 * 8192 * 2 <= WS_END && WS_END1 <= WS_SLAB && WS_SLAB + ((size_t)32 << 20) <= WS_END, "ws map");
constexpr int CW_BAR = 4096;
constexpr int RING_OFF = 0, RING_BYTES = 131072, PREP_HALF = 73728, LDSCTL_OFF = 147456, MISC_OFF = LDSCTL_OFF + 320, WTOT_OFF = LDSCTL_OFF + 1024, LDS_BYTES = LDSCTL_OFF + 4096;

#define GAS __attribute__((address_space(1)))
#define LAS __attribute__((address_space(3)))
typedef unsigned short bf16;
typedef unsigned v4u __attribute__((ext_vector_type(4)));
typedef unsigned v2u __attribute__((ext_vector_type(2)));
typedef float f32x4 __attribute__((ext_vector_type(4)));
typedef float f32x16 __attribute__((ext_vector_type(16)));
typedef short bf16x8 __attribute__((ext_vector_type(8)));
typedef short bf16x4 __attribute__((ext_vector_type(4)));
typedef GAS unsigned gu32;
#define RLX_AGENT __ATOMIC_RELAXED, __HIP_MEMORY_SCOPE_AGENT
#define LDS_WAIT() asm volatile("s_waitcnt lgkmcnt(0)" ::: "memory")
#define VM_WAIT() asm volatile("s_waitcnt vmcnt(0)" ::: "memory")
using pg8::cvt_pk_bf16;
__device__ __forceinline__ int mk_lane() { int l; asm volatile("v_mbcnt_lo_u32_b32 %0, -1, 0\n\tv_mbcnt_hi_u32_b32 %0, -1, %0" : "=v"(l)); return l; }
__device__ __forceinline__ float bf2f(unsigned v) { return __uint_as_float(v << 16); }
__device__ __forceinline__ float bflo(unsigned w) { return __uint_as_float(w << 16); }
__device__ __forceinline__ float bfhi(unsigned w) { return __uint_as_float(w & 0xffff0000u); }
__device__ __forceinline__ bf16 f2bf(float f) { return (bf16)(cvt_pk_bf16(f, 0.f) & 0xffffu); }
__device__ __forceinline__ v2u pack4(f32x4 v) { v2u w; w.x = cvt_pk_bf16(v[0], v[1]); w.y = cvt_pk_bf16(v[2], v[3]); return w; }
__device__ __forceinline__ f32x4 unpack4(v2u w) { return (f32x4){bflo(w.x), bfhi(w.x), bflo(w.y), bfhi(w.y)}; }
__device__ __forceinline__ f32x4 mfma16(bf16x8 a, bf16x8 b, f32x4 c) { return __builtin_amdgcn_mfma_f32_16x16x32_bf16(a, b, c, 0, 0, 0); }
__device__ __forceinline__ f32x16 mfma32(bf16x8 a, bf16x8 b, f32x16 c) { return __builtin_amdgcn_mfma_f32_32x32x16_bf16(a, b, c, 0, 0, 0); }
using pg8::swz_xor; using pg8::add_x32; using pg8::max_x32; using pg8::add_x16; using pg8::sum16_dpp; using pg8::max16_dpp; using pg8::sum4_dpp;
__device__ __forceinline__ float sum16(float v) { return sum16_dpp(v); }
__device__ __forceinline__ float wave_sum(float v) { v = sum16_dpp(v); v = add_x16(v); return add_x32(v); }
__device__ __forceinline__ float wave_max(float v) { v = max16_dpp(v); v = fmaxf(v, swz_xor<16>(v)); return max_x32(v); }
__device__ __forceinline__ float fsigmoid(float x) { return __builtin_amdgcn_rcpf(1.0f + __expf(-x)); }
__device__ __forceinline__ float ftanh(float x) { const float e = __expf(2.0f * x); return 1.0f - 2.0f * __builtin_amdgcn_rcpf(e + 1.0f); }
namespace pg8 {
__device__ __forceinline__ void head_norm(f32x4 (&x)[2][2], const float* gain, int fq) {
    float ss = 0.f;
#pragma unroll
    for (int bj = 0; bj < 2; ++bj)
#pragma unroll
        for (int n = 0; n < 2; ++n) ss += hsum4(x[bj][n] * x[bj][n]);
    ss = add_x16(ss); ss = add_x32(ss);
    const float rs = rsqrtf(ss * (1.0f / 64.0f) + 1e-6f);
#pragma unroll
    for (int bj = 0; bj < 2; ++bj)
#pragma unroll
        for (int n = 0; n < 2; ++n) { const f32x4 g = *(const f32x4*)(gain + 32 * bj + 8 * fq + 4 * n); x[bj][n] = x[bj][n] * rs * g; }
}
__device__ __forceinline__ void head_rope(f32x4 (&x)[2][2], const float* cs  , int fq) {
#pragma unroll
    for (int n = 0; n < 2; ++n) { const f32x4 t0 = *(const f32x4*)(cs + 2 * (8 * fq + 4 * n)), t1 = *(const f32x4*)(cs + 2 * (8 * fq + 4 * n) + 4);
        const f32x4 cc = {t0[0], t0[2], t1[0], t1[2]}, sn = {t0[1], t0[3], t1[1], t1[3]};
        const f32x4 x1 = x[0][n], x2 = x[1][n]; x[0][n] = x1 * cc - x2 * sn; x[1][n] = x2 * cc + x1 * sn; }
}
struct EpiL1 {
    static constexpr bool PERM = true, AFTER_DRAIN = false;
    unsigned char* ws; float* outp; const float* g_q; const float* g_mq; const float* g_k;
    __device__ __forceinline__ void operator()(const f32x4 (&acc)[2][2][4][2], const Unit& u, int wr, int wc, int fr_, int fq_) const {
        int fr = fr_, fq = fq_; asm volatile("" : "+v"(fr), "+v"(fq));
        const float* ssq = (const float*)(ws + WS_SSQ); const float* rope = (const float*)(ws + WS_ROPE); const float c2 = C2Q;
        bf16_t* Q1 = (bf16_t*)(ws + WS_Q1); bf16_t* K1 = (bf16_t*)(ws + WS_K1); bf16_t* V1 = (bf16_t*)(ws + WS_V1);
        float* p_k = outp + O_PSK; float* p_v = outp + O_PSV; float* s_k = outp + O_SSK; float* s_v = outp + O_SSV;
        const int H = u.pn * 4 + wc, row0 = u.pm * BM + wr * 64 + fr;
#pragma unroll
        for (int ai = 0; ai < 2; ++ai)
#pragma unroll
            for (int m = 0; m < 4; ++m) { const int row = row0 + ai * HALF + m * 16; const float rs = row_rstd(ssq, row);
                const int pidx = row < 16384 ? (row & 8191) : 8192 + ((row - 16384) & 3);
                f32x4 x[2][2];
#pragma unroll
                for (int bj = 0; bj < 2; ++bj)
#pragma unroll
                    for (int n = 0; n < 2; ++n) x[bj][n] = acc[ai][bj][m][n] * rs;
                if (H < 16) {
                    head_norm(x, H < 12 ? g_q : g_mq, fq);
                    if (H < 12) head_rope(x, rope + (size_t)pidx * 64, fq);
#pragma unroll
                    for (int bj = 0; bj < 2; ++bj) *(u32x4*)(Q1 + (size_t)row * 1024 + H * 64 + 32 * bj + 8 * fq) = pack8(x[bj][0] * c2, x[bj][1] * c2);
                } else {
                    const int kh = (H - 16) & 3; const bool isk = H < 20;
                    if (isk) { head_norm(x, g_k, fq); head_rope(x, rope + (size_t)pidx * 64, fq); }
                    bf16_t* dst = isk ? K1 : V1;
#pragma unroll
                    for (int bj = 0; bj < 2; ++bj) *(u32x4*)(dst + (size_t)row * 256 + kh * 64 + 32 * bj + 8 * fq) = pack8(x[bj][0], x[bj][1]);
                    float* o = nullptr;
                    if (row < 16384) { const int b = row >> 13, t = row & 8191; if (t >= 8064) o = (isk ? p_k : p_v) + ((size_t)(b * 128 + (t - 8064)) * 4 + kh) * 64; }
                    else { const int b = (row - 16384) >> 2, i = (row - 16384) & 3; o = (isk ? s_k : s_v) + ((size_t)(b * 128 + 124 + i) * 4 + kh) * 64; }
                    if (o) {
#pragma unroll
                        for (int bj = 0; bj < 2; ++bj) { *(f32x4*)(o + 32 * bj + 8 * fq) = x[bj][0]; *(f32x4*)(o + 32 * bj + 8 * fq + 4) = x[bj][1]; } }
                }
                asm volatile("" ::: "memory");
            }
    }
};
struct EpiMemKV {
    static constexpr bool PERM = true, AFTER_DRAIN = false;
    unsigned char* ws; float* outp; const float* g_k  ;
    __device__ __forceinline__ void operator()(const f32x4 (&acc)[2][2][4][2], const Unit& u, int wr, int wc, int fr_, int fq_) const {
        int fr = fr_, fq = fq_; asm volatile("" : "+v"(fr), "+v"(fq));
        const float* ssq = (const float*)(ws + WS_SSQM); float* p_k = outp + O_PMK; float* p_v = outp + O_PMV; bf16_t* MK = (bf16_t*)(ws + WS_MK)  ; bf16_t* MVT = (bf16_t*)(ws + WS_MVT)  ;
        const int H = u.pn * 4 + wc, l = H >> 3, isv = (H >> 2) & 1, hh = H & 3, row0 = u.pm * BM + wr * 64 + fr;
#pragma unroll
        for (int ai = 0; ai < 2; ++ai)
#pragma unroll
            for (int m = 0; m < 4; ++m) { const int row = row0 + ai * HALF + m * 16; const float rs = row_rstd(ssq, row); const int b = row >> 8, mm = row & 255;
                f32x4 x[2][2];
#pragma unroll
                for (int bj = 0; bj < 2; ++bj)
#pragma unroll
                    for (int n = 0; n < 2; ++n) x[bj][n] = acc[ai][bj][m][n] * rs;
                if (!isv) head_norm(x, g_k + l * 64, fq);
                float* o = (isv ? p_v : p_k) + ((((size_t)l * 2 + b) * 256 + mm) * 4 + hh) * 64;
#pragma unroll
                for (int bj = 0; bj < 2; ++bj) { *(f32x4*)(o + 32 * bj + 8 * fq) = x[bj][0]; *(f32x4*)(o + 32 * bj + 8 * fq + 4) = x[bj][1]; }
                if (!isv) {
#pragma unroll
                    for (int bj = 0; bj < 2; ++bj) *(u32x4*)(MK + ((((size_t)l * 2 + b) * 4 + hh) * 256 + mm) * 64 + 32 * bj + 8 * fq) = pack8(x[bj][0], x[bj][1]);
                } else {
#pragma unroll
                    for (int bj = 0; bj < 2; ++bj)
#pragma unroll
                        for (int n = 0; n < 2; ++n)
#pragma unroll
                            for (int e = 0; e < 4; ++e) { const int d = 32 * bj + 8 * fq + 4 * n + e; MVT[((((size_t)l * 2 + b) * 4 + hh) * 64 + d) * 256 + mm] = (bf16_t)(cvt_pk_bf16(x[bj][n][e], 0.f) & 0xffffu); }
                }
                asm volatile("" ::: "memory");
            }
    }
};
}
#define XB_TMO      128
#define XB_XCNT(j)  (256  + 64 * (j))
#define XB_XSUB(j)  (1280 + 64 * (j))
#define XB_XGEN(j)  (2304 + 64 * (j))
#define XB_TOP      3328
#define XB_TOPGEN   3392
#define XCD_BAR_WORDS 3456
#define XB_SPIN_CAP (1u << 18)

__device__ __forceinline__ unsigned xb_ld(unsigned* p)              { return __hip_atomic_load(p, __ATOMIC_RELAXED, __HIP_MEMORY_SCOPE_AGENT); }
__device__ __forceinline__ unsigned xb_add(unsigned* p, unsigned v) { return __hip_atomic_fetch_add(p, v, __ATOMIC_RELAXED, __HIP_MEMORY_SCOPE_AGENT); }
__device__ __forceinline__ unsigned xb_xcc_id() { return (unsigned)__builtin_amdgcn_s_getreg((3 << 11) | 20) & 0xFu; }
#define XB_SPIN(cond, bar) do { unsigned _sp = 0; while (cond) { __builtin_amdgcn_s_sleep(1); \
    if ((++_sp & 255u) == 0u) { if (xb_ld(&(bar)[XB_TMO])) break; if (_sp > XB_SPIN_CAP) { atomicAdd(&(bar)[XB_TMO], 1u); break; } } } } while (0)

struct XcdBarrier {
    bool wave0;
    unsigned* bar; unsigned x;
    volatile LAS unsigned* st;
};

__device__ __forceinline__ XcdBarrier xcd_barrier_post(unsigned* bar, volatile LAS unsigned* st, bool wave0) {
    XcdBarrier b; b.wave0 = wave0; b.bar = bar; b.x = xb_xcc_id(); b.st = st;
    if (wave0 && mk_lane() == 0) (void)xb_add(&bar[XB_XCNT(b.x)], 1u);
    return b;
}
__device__ __forceinline__ void xcd_barrier_complete(unsigned* bar, unsigned x, unsigned& nloc, unsigned& nx) {
    const unsigned G = gridDim.x * gridDim.y * gridDim.z;
    unsigned sum, cnt, mine, sp = 0u;
    for (;;) {
        sum = 0u; cnt = 0u; mine = 0u;
#pragma unroll
        for (unsigned j = 0; j < 16; ++j) { const unsigned c = xb_ld(&bar[XB_XCNT(j)]); sum += c; cnt += (c > 0u) ? 1u : 0u; mine = (j == x) ? c : mine; }
        if (sum == G) break;
        __builtin_amdgcn_s_sleep(1);
        if ((++sp & 255u) == 0u) { if (xb_ld(&bar[XB_TMO])) break; if (sp > XB_SPIN_CAP) { atomicAdd(&bar[XB_TMO], 1u); break; } }
    }
    nloc = mine > 0u ? mine : 1u; nx = cnt > 0u ? cnt : 1u;
}

__device__ __forceinline__ void xcd_barrier(const XcdBarrier& b) {
    asm volatile("s_waitcnt vmcnt(0)" ::: "memory");
    __syncthreads();
    if (b.wave0 && mk_lane() == 0) {
        unsigned* bar = b.bar;
        __builtin_amdgcn_s_waitcnt(0);
        unsigned nloc = b.st[0], nx = b.st[1];
        if (nloc == 0u) { xcd_barrier_complete(bar, b.x, nloc, nx); b.st[0] = nloc; b.st[1] = nx; }
        const unsigned old = xb_add(&bar[XB_XSUB(b.x)], 1u);
        const unsigned gen = old / nloc;
        if (old + 1u == (gen + 1u) * nloc) {
            __builtin_amdgcn_fence(__ATOMIC_RELEASE, "agent");
            asm volatile("s_waitcnt vmcnt(0)" ::: "memory");
            const unsigned og = xb_add(&bar[XB_TOP], 1u);
            const unsigned tg = og / nx;
            if (og + 1u == (tg + 1u) * nx) xb_add(&bar[XB_TOPGEN], 1u);
            else XB_SPIN(xb_ld(&bar[XB_TOPGEN]) == tg, bar);
            __builtin_amdgcn_fence(__ATOMIC_ACQUIRE, "agent");
            xb_add(&bar[XB_XGEN(b.x)], 1u);
            asm volatile("s_waitcnt vmcnt(0)" ::: "memory");
        } else {
            XB_SPIN(xb_ld(&bar[XB_XGEN(b.x)]) == gen, bar);
            __builtin_amdgcn_fence(__ATOMIC_ACQUIRE, "agent");
            asm volatile("s_waitcnt vmcnt(0)" ::: "memory");
        }
    }
    __syncthreads();
}

struct Args { const float* in[N_IN]; float* out; unsigned char* ws; int ph_lo, ph_hi; };
struct Frame {
    LAS unsigned char* lds; unsigned char* lds_g;
    gu32* ctl;
    int tid, lane, wave, vcu, G;
    const float* const* in; float* out; unsigned char* ws;
};
__host__ __device__ __forceinline__ int wsig_inv(int nl) { return 128 * ((nl >> 5) & 1) + 32 * (nl >> 6) + (nl & 31); }

__device__ __forceinline__ void p0_transpose_item(const float* W, int K, int N, bf16* WT, int row_off, bool sig, const float* gain, LAS float* scr, int item, int lane) {
    const int nblk = N / 32, kb = item / nblk, nb = item % nblk, k0 = 64 * kb, n0 = 32 * nb;
    float tv[32];
#pragma unroll
    for (int i = 0; i < 32; ++i) { const int kk = 2 * i + (lane >> 5); tv[i] = W[(size_t)(k0 + kk) * N + n0 + (lane & 31)]; }
    if (gain) {
#pragma unroll
        for (int i = 0; i < 32; ++i) tv[i] *= gain[k0 + 2 * i + (lane >> 5)]; }
#pragma unroll
    for (int i = 0; i < 32; ++i) scr[(2 * i + (lane >> 5)) * 33 + (lane & 31)] = tv[i];
    LDS_WAIT(); asm volatile("" ::: "memory");
    const int c = lane & 7;
    int nbase = row_off + n0; if (sig) { const int ng = row_off + n0; nbase = (ng & ~255) + wsig_inv(ng & 255); }
#pragma unroll
    for (int j = 0; j < 4; ++j) { const int n = (lane >> 3) + 8 * j; const LAS float* s = scr + (8 * c) * 33 + n;
        v4u o; o.x = cvt_pk_bf16(s[0 * 33], s[1 * 33]); o.y = cvt_pk_bf16(s[2 * 33], s[3 * 33]); o.z = cvt_pk_bf16(s[4 * 33], s[5 * 33]); o.w = cvt_pk_bf16(s[6 * 33], s[7 * 33]);
        *(GAS v4u*)(WT + (size_t)(nbase + n) * K + k0 + 8 * c) = o; }
    LDS_WAIT(); asm volatile("" ::: "memory");
}
__device__ __forceinline__ void row_to_bf16_ssq(const float* xrow, bf16* orow, float* ssqrow, int lane) {
    const GAS f32x4* xr = (const GAS f32x4*)xrow + lane;
    f32x4 v[4]; float s = 0.f;
#pragma unroll
    for (int j = 0; j < 4; ++j) { v[j] = xr[64 * j]; s += (v[j].x * v[j].x + v[j].y * v[j].y) + (v[j].z * v[j].z + v[j].w * v[j].w); }
    s = wave_sum(s);
    GAS v2u* o8 = (GAS v2u*)orow + lane;
#pragma unroll
    for (int j = 0; j < 4; ++j) o8[64 * j] = pack4(v[j]);
    if (lane < 16) ssqrow[lane] = lane == 0 ? s : 0.f;
}
__device__ __forceinline__ void p0_prologue(Frame& F) {
    LAS float* scr = (LAS float*)(F.lds + RING_OFF + F.wave * 16384);
    const int gw = F.vcu * NWAVES + F.wave, NGW = F.G * NWAVES;
    unsigned char* ws = F.ws;
    int it = gw;
#define P0_JOB(Wp, K_, N_, WTp, roff, sg, gn) { const int ni = ((K_) / 64) * ((N_) / 32); for (; it < ni; it += NGW) p0_transpose_item((Wp), (K_), (N_), (WTp), (roff), (sg), (gn), scr, it, F.lane); it -= ni; }
    P0_JOB(F.in[I_WINA], DM, NCOLA, (bf16*)(ws + WS_WA), 0, false, F.in[I_NMIX]);
    P0_JOB(F.in[I_WOUT], DM, DM, (bf16*)(ws + WS_WOUT), 0, false, nullptr);
    P0_JOB(F.in[I_WOUT] + (size_t)DM * DM, DM, DM, (bf16*)(ws + WS_WOUT) + (size_t)DM * DM, 0, false, nullptr);
    P0_JOB(F.in[I_WUP], DM, FF, (bf16*)(ws + WS_WUP), 0, false, F.in[I_NMLP]);
    P0_JOB(F.in[I_WUP] + (size_t)DM * FF, DM, FF, (bf16*)(ws + WS_WUP) + (size_t)DM * FF, 0, false, F.in[I_NMLP] + DM);
    P0_JOB(F.in[I_WDN], FF, DM, (bf16*)(ws + WS_WDN), 0, false, nullptr);
    P0_JOB(F.in[I_WDN] + (size_t)DM * FF, FF, DM, (bf16*)(ws + WS_WDN) + (size_t)DM * FF, 0, false, nullptr);
    P0_JOB(F.in[I_WINB], DM, DM, (bf16*)(ws + WS_WB), 0, true, F.in[I_NMIX] + DM);
    P0_JOB(F.in[I_WKV], DM, 512, (bf16*)(ws + WS_WB), 1024, true, F.in[I_KVN]);
    P0_JOB(F.in[I_WMKV], DM, 512, (bf16*)(ws + WS_WM), 0, true, F.in[I_MNORM]);
    P0_JOB(F.in[I_WMKV] + (size_t)DM * 512, DM, 512, (bf16*)(ws + WS_WM), 512, true, F.in[I_MNORM] + DM);
    P0_JOB(F.in[I_WW2], 64, 768, (bf16*)(ws + WS_WW2), 0, false, nullptr);
    P0_JOB(F.in[I_WA2], 64, 768, (bf16*)(ws + WS_WA2), 0, false, nullptr);
    P0_JOB(F.in[I_WG2], 128, 768, (bf16*)(ws + WS_WG2), 0, false, nullptr);
#undef P0_JOB
    for (int m = gw; m < R; m += NGW) { const float* xr = m < RP ? F.in[I_XP] + (size_t)m * DM : F.in[I_XS] + (size_t)(m - RP) * DM;
        row_to_bf16_ssq(xr, (bf16*)(ws + WS_HB) + (size_t)m * DM, (float*)(ws + WS_SSQ) + (size_t)m * 16, F.lane); }
    for (int m = gw; m < 512; m += NGW) row_to_bf16_ssq(F.in[I_MEMP] + (size_t)m * DM, (bf16*)(ws + WS_MB) + (size_t)m * DM, (float*)(ws + WS_SSQM) + (size_t)m * 16, F.lane);
    { const int gt = F.vcu * NWAVES * 64 + F.tid, NGT = F.G * NWAVES * 64; float* rt = (float*)(ws + WS_ROPE);
      for (int i = gt; i < 8196 * 32; i += NGT) { const int p = i >> 5, f = i & 31; const float pos = (float)(p < 8192 ? p : 16384 + (p - 8192));
          double fq_ = 1.0; for (int k = 0; k < f; ++k) fq_ *= 0.74989420933245582730; const float ang = pos * (float)fq_; const double rev = (double)ang * 0.15915494309189535; const float fr = (float)(rev - floor(rev));
          rt[2 * i] = __builtin_amdgcn_cosf(fr); rt[2 * i + 1] = __builtin_amdgcn_sinf(fr); } }
}

__device__ __forceinline__ void finalize_sample(Frame& F, const float* fbase  , int S, bool last) {
    const int gw = F.vcu * NWAVES + F.wave, NGW = F.G * NWAVES; const float* slab = (const float*)(F.ws + WS_SLAB);
    for (int rs = gw; rs < RS; rs += NGW) { const int row = RP + rs, tile0 = (rs >> 8) << 2, r = rs & 255; float ss = 0.f;
#pragma unroll
        for (int pn = 0; pn < 4; ++pn) { f32x4 h;
            if (fbase) h = *(const GAS f32x4*)(fbase + (size_t)rs * DM + pn * 256 + 4 * F.lane);
            else h = unpack4(*(const GAS v2u*)((const bf16*)(F.ws + WS_HB) + (size_t)row * DM + pn * 256 + 4 * F.lane));
            for (int s = 0; s < S; ++s) h += *(const GAS f32x4*)(slab + ((size_t)((tile0 + pn) * S + s) << 16) + r * 256 + 4 * F.lane);
            if (last) *(GAS f32x4*)(F.out + O_Y + (size_t)row * DM + pn * 256 + 4 * F.lane) = h;
            else *(GAS v2u*)((bf16*)(F.ws + WS_HB) + (size_t)row * DM + pn * 256 + 4 * F.lane) = pack4(h);
            ss += (h[0] * h[0] + h[1] * h[1]) + (h[2] * h[2] + h[3] * h[3]); }
        if (!last) { ss = wave_sum(ss); if (F.lane < 16) ((float*)(F.ws + WS_SSQ))[(size_t)row * 16 + F.lane] = F.lane == 0 ? ss : 0.f; } }
}

__device__ __forceinline__ void copy_window_cache(Frame& F, int gt, int NGT) {
    const int per = 124 * 256 / 4;
    for (int i = gt; i < SB * per; i += NGT) { const int b = i / per, r = i % per;
        ((GAS f32x4*)(F.out + O_SSK + (size_t)b * 128 * 256))[r] = ((const GAS f32x4*)(F.in[I_CSK] + (size_t)b * 128 * 256 + 4 * 256))[r];
        ((GAS f32x4*)(F.out + O_SSV + (size_t)b * 128 * 256))[r] = ((const GAS f32x4*)(F.in[I_CSV] + (size_t)b * 128 * 256 + 4 * 256))[r]; }
}

constexpr int LSTR = 144, SLOT = 64 * LSTR;
__device__ __forceinline__ int rec_index(int chunk, int h) { return ((chunk >> 7) * NH + h) * 128 + (chunk & 127); }
constexpr int REC_PT = 0, REC_QS = 8192, REC_RY = 16384, REC_YL = 24576, REC_BV = 32768;
__device__ __forceinline__ bf16x8 lfrag(const LAS unsigned char* m, int row, int k) { return *(const LAS bf16x8*)(m + row * LSTR + k * 2); }
__device__ __forceinline__ void mm_strip(f32x4 (&acc)[4], const LAS unsigned char* X, const LAS unsigned char* Y, int w, int c, int g) {
#pragma unroll
    for (int ks = 0; ks < 2; ++ks) { const bf16x8 a = lfrag(X, 16 * w + c, 32 * ks + 8 * g);
#pragma unroll
        for (int n = 0; n < 4; ++n) acc[n] = mfma16(a, lfrag(Y, 16 * n + c, 32 * ks + 8 * g), acc[n]); }
}
__device__ __forceinline__ void mm_strip2(f32x4 (&acc0)[4], f32x4 (&acc1)[4], const LAS unsigned char* X, const LAS unsigned char* Y0, const LAS unsigned char* Y1, int w, int c, int g) {
#pragma unroll
    for (int ks = 0; ks < 2; ++ks) { const bf16x8 a = lfrag(X, 16 * w + c, 32 * ks + 8 * g);
#pragma unroll
        for (int n = 0; n < 4; ++n) { acc0[n] = mfma16(a, lfrag(Y0, 16 * n + c, 32 * ks + 8 * g), acc0[n]); acc1[n] = mfma16(a, lfrag(Y1, 16 * n + c, 32 * ks + 8 * g), acc1[n]); } }
}
__device__ __forceinline__ void zero4(f32x4 (&a)[4]) {
#pragma unroll
    for (int n = 0; n < 4; ++n) a[n] = (f32x4){0.f, 0.f, 0.f, 0.f};
}
__device__ __forceinline__ void st_T(LAS unsigned char* dest, const f32x4 (&acc)[4], int w, int c, int g) {
#pragma unroll
    for (int n = 0; n < 4; ++n) *(LAS v2u*)(dest + (16 * n + c) * LSTR + (16 * w + 4 * g) * 2) = pack4(acc[n]);
}
__device__ __forceinline__ void st_T_global(unsigned char* dest  , const f32x4 (&acc)[4], int w, int c, int g) {
#pragma unroll
    for (int n = 0; n < 4; ++n) *(GAS v2u*)(dest + (16 * n + c) * 128 + (16 * w + 4 * g) * 2) = pack4(acc[n]);
}
__device__ __forceinline__ void load_shift8(const bf16* cur, const bf16* prv, const float* mu, float (&o)[8]) {
    const v4u cw = *(const GAS v4u*)cur; v4u pw = {0u, 0u, 0u, 0u}; if (prv) pw = *(const GAS v4u*)prv;
    const f32x4 m0 = *(const GAS f32x4*)mu, m1 = *(const GAS f32x4*)(mu + 4);
    const float cf[8] = {bflo(cw.x), bfhi(cw.x), bflo(cw.y), bfhi(cw.y), bflo(cw.z), bfhi(cw.z), bflo(cw.w), bfhi(cw.w)};
    const float pf[8] = {bflo(pw.x), bfhi(pw.x), bflo(pw.y), bfhi(pw.y), bflo(pw.z), bfhi(pw.z), bflo(pw.w), bfhi(pw.w)};
    const float mf[8] = {m0[0], m0[1], m0[2], m0[3], m1[0], m1[1], m1[2], m1[3]};
#pragma unroll
    for (int i = 0; i < 8; ++i) o[i] = cf[i] + (pf[i] - cf[i]) * mf[i];
}
__device__ __forceinline__ bf16x8 pack_frag(const float (&v)[8]) {
    v4u w; w.x = cvt_pk_bf16(v[0], v[1]); w.y = cvt_pk_bf16(v[2], v[3]); w.z = cvt_pk_bf16(v[4], v[5]); w.w = cvt_pk_bf16(v[6], v[7]); return __builtin_bit_cast(bf16x8, w);
}

struct PrepPf { v4u raw[3][2]; v4u prv; };
__device__ __forceinline__ void prep_issue(Frame& F, int unit, PrepPf& pf) {
    const int th = (F.wave & 3) * 64 + F.lane; const int chunk = unit / NH, h = unit % NH, row0 = chunk * 64; const bool first = (chunk & 127) == 0;
    const bf16* proj = (const bf16*)(F.ws + WS_PROJ);
#pragma unroll
    for (int a = 0; a < 3; ++a)
#pragma unroll
        for (int i = 0; i < 2; ++i) { const int id = th + 256 * i; pf.raw[a][i] = *(const GAS v4u*)(proj + (size_t)(row0 + (id >> 3)) * NCOLA + a * 768 + h * 64 + (id & 7) * 8); }
    pf.prv = (v4u){0u, 0u, 0u, 0u};
    if (th < 24 && !first) pf.prv = *(const GAS v4u*)(proj + (size_t)(row0 - 1) * NCOLA + (th >> 3) * 768 + h * 64 + (th & 7) * 8);
}
__device__ __forceinline__ void shift8(v4u cw, v4u pw, const float* mu, float (&o)[8]) {
    const f32x4 m0 = *(const GAS f32x4*)mu, m1 = *(const GAS f32x4*)(mu + 4);
    const float cf[8] = {bflo(cw.x), bfhi(cw.x), bflo(cw.y), bfhi(cw.y), bflo(cw.z), bfhi(cw.z), bflo(cw.w), bfhi(cw.w)};
    const float pf_[8] = {bflo(pw.x), bfhi(pw.x), bflo(pw.y), bfhi(pw.y), bflo(pw.z), bfhi(pw.z), bflo(pw.w), bfhi(pw.w)};
    const float mf[8] = {m0[0], m0[1], m0[2], m0[3], m1[0], m1[1], m1[2], m1[3]};
#pragma unroll
    for (int i = 0; i < 8; ++i) o[i] = cf[i] + (pf_[i] - cf[i]) * mf[i];
}
#define HBAR() do { asm volatile("s_waitcnt lgkmcnt(0)" ::: "memory"); __builtin_amdgcn_s_barrier(); asm volatile("" ::: "memory"); } while (0)
__device__ __forceinline__ void rwkv_prep_unit(Frame& F, int unit, LAS unsigned char* hb, LAS float* wtot, LAS unsigned char* prow, PrepPf& pf, bool has_next, int next_unit, int stage_limit = 99) {
    int w_ = F.wave & 3, lane_ = F.lane; asm volatile("" : "+s"(w_), "+v"(lane_));
    const int w = w_, lane = lane_, g = lane >> 4, c = lane & 15;
    const int chunk = unit / NH, h = unit % NH, row0 = chunk * 64; const bool first = (chunk & 127) == 0;
    const bf16* proj = (const bf16*)(F.ws + WS_PROJ);
    unsigned char* rec = F.ws + WS_REC + (size_t)rec_index(chunk, h) * REC_BYTES;
    LAS unsigned char* const s0 = hb, * const s1 = hb + SLOT, * const s2 = hb + 2 * SLOT, * const s3 = hb + 3 * SLOT, * const s4 = hb + 4 * SLOT, * const s5 = hb + 5 * SLOT, * const s6 = hb + 6 * SLOT, * const s7 = hb + 7 * SLOT;
    float mur[4], muk[4], muv[4], w0[4], a0[4], kkc[4], kac[4], rkc[4];
#pragma unroll
    for (int n = 0; n < 4; ++n) { const int col = h * 64 + 16 * n + c; mur[n] = F.in[I_MU][col]; muk[n] = F.in[I_MU][768 + col]; muv[n] = F.in[I_MU][1536 + col];
        w0[n] = F.in[I_W0][col]; a0[n] = F.in[I_A0][col]; kkc[n] = F.in[I_KK][col]; kac[n] = F.in[I_KA][col]; rkc[n] = F.in[I_RK][col]; }
    f32x4 dw[4], da[4]; zero4(dw); zero4(da);
    { const int th = w * 64 + lane;
#pragma unroll
      for (int a = 0; a < 3; ++a)
#pragma unroll
          for (int i = 0; i < 2; ++i) { const int id = th + 256 * i; *(LAS v4u*)(hb + a * SLOT + (id >> 3) * LSTR + (id & 7) * 16) = pf.raw[a][i]; }
      if (th < 24) *(LAS v4u*)(prow + (th >> 3) * 128 + (th & 7) * 16) = pf.prv; }
    {
        const bf16* Ww2 = (const bf16*)(F.ws + WS_WW2); const bf16* Wa2 = (const bf16*)(F.ws + WS_WA2);
        const int tl = 16 * w + c; const bf16* crl = proj + (size_t)(row0 + tl) * NCOLA; const bool hpl = !(first && tl == 0);
        v4u lc[2][2], lp[2][2];
#pragma unroll
        for (int a = 0; a < 2; ++a)
#pragma unroll
            for (int ks = 0; ks < 2; ++ks) { const int col = 2304 + 64 * a + 32 * ks + 8 * g; lc[a][ks] = *(const GAS v4u*)(crl + col); lp[a][ks] = (v4u){0u, 0u, 0u, 0u}; if (hpl) lp[a][ks] = *(const GAS v4u*)(crl - NCOLA + col); }
#pragma unroll
        for (int ks = 0; ks < 2; ++ks) { const int l0 = 32 * ks + 8 * g; float x[8];
            shift8(lc[0][ks], lp[0][ks], F.in[I_MU] + 2304 + l0, x);
#pragma unroll
            for (int i = 0; i < 8; ++i) x[i] = ftanh(x[i]);
            const bf16x8 aw = pack_frag(x);
            shift8(lc[1][ks], lp[1][ks], F.in[I_MU] + 2368 + l0, x);
            const bf16x8 aa = pack_frag(x);
#pragma unroll
            for (int n = 0; n < 4; ++n) { const size_t wo = (size_t)(h * 64 + 16 * n + c) * 64 + l0;
                dw[n] = mfma16(aw, *(const GAS bf16x8*)(Ww2 + wo), dw[n]); da[n] = mfma16(aa, *(const GAS bf16x8*)(Wa2 + wo), da[n]); } }
    }
    HBAR();
    if (has_next) prep_issue(F, next_unit, pf);
    f32x4 rt[4], kh[4], lw[4], at_[4], bt_[4], kt_[4], bh_[4], vv[4]; float gam[4]; float bon[4] = {0.f, 0.f, 0.f, 0.f}; float ssk[4] = {0.f, 0.f, 0.f, 0.f};
    f32x4 kkr[4], aa_[4], kp[4], rr[4];
    {

        const LAS unsigned char* pbase = (w == 0 && g == 0) ? prow + c * 2 : hb + (16 * w + 4 * g - 1) * LSTR + c * 2; const int pstr = (w == 0 && g == 0) ? 128 : SLOT;
        float rp[4], kpv[4], vp[4];
#pragma unroll
        for (int n = 0; n < 4; ++n) { rp[n] = bf2f(*(const LAS bf16*)(pbase + 32 * n)); kpv[n] = bf2f(*(const LAS bf16*)(pbase + pstr + 32 * n)); vp[n] = bf2f(*(const LAS bf16*)(pbase + 2 * pstr + 32 * n)); }
#pragma unroll
        for (int reg = 0; reg < 4; ++reg) { const int t = 16 * w + 4 * g + reg; const LAS unsigned char* cr = hb + t * LSTR + c * 2;
#pragma unroll
            for (int n = 0; n < 4; ++n) {
                const float r0 = bf2f(*(const LAS bf16*)(cr + 32 * n)), k0 = bf2f(*(const LAS bf16*)(cr + SLOT + 32 * n)), v0 = bf2f(*(const LAS bf16*)(cr + 2 * SLOT + 32 * n));
                const float r1 = rp[n], k1 = kpv[n], v1 = vp[n]; rp[n] = r0; kpv[n] = k0; vp[n] = v0;
                const float r = r0 + (r1 - r0) * mur[n], k = k0 + (k1 - k0) * muk[n], v = v0 + (v1 - v0) * muv[n];
                const float y = -(w0[n] + dw[n][reg]);
                const float sp = fmaxf(y, 0.f) + __logf(1.0f + __expf(-fabsf(y)));
                lw[n][reg] = -__expf(-sp - 0.5f);
                const float a = fsigmoid(a0[n] + da[n][reg]);
                aa_[n][reg] = a; kkr[n][reg] = k * kkc[n]; kp[n][reg] = k * (1.0f + (a - 1.0f) * kac[n]); rr[n][reg] = r; vv[n][reg] = v;
                ssk[reg] += kkr[n][reg] * kkr[n][reg]; bon[reg] += r * kp[n][reg] * rkc[n]; } }
    }
#pragma unroll
    for (int reg = 0; reg < 4; ++reg) { ssk[reg] = sum16(ssk[reg]); bon[reg] = sum16(bon[reg]); ssk[reg] = __builtin_amdgcn_rsqf(fmaxf(ssk[reg], 1e-24f)); }
    f32x4 Lc[4];
#pragma unroll
    for (int n = 0; n < 4; ++n) { f32x4 inc; inc[0] = lw[n][0]; inc[1] = inc[0] + lw[n][1]; inc[2] = inc[1] + lw[n][2]; inc[3] = inc[2] + lw[n][3];
        const float tot = inc[3]; const float t1 = __shfl(tot, (lane - 16) & 63), t2 = __shfl(tot, (lane - 32) & 63), t3 = __shfl(tot, (lane - 48) & 63);
        const float pre = (g >= 1 ? t1 : 0.f) + (g >= 2 ? t2 : 0.f) + (g >= 3 ? t3 : 0.f);
        Lc[n] = inc + pre; if (g == 3) wtot[w * 64 + 16 * n + c] = pre + tot; }
    HBAR();
#pragma unroll
    for (int n = 0; n < 4; ++n) { const int j = 16 * n + c; const float t0 = wtot[j], t1 = wtot[64 + j], t2 = wtot[128 + j], t3 = wtot[192 + j];
        const float base = (w >= 1 ? t0 : 0.f) + (w >= 2 ? t1 : 0.f) + (w >= 3 ? t2 : 0.f); const float LC = (t0 + t1) + (t2 + t3);
        gam[n] = __expf(LC);
#pragma unroll
        for (int reg = 0; reg < 4; ++reg) { const float L = Lc[n][reg] + base; const float eL = __expf(L), eLi = __builtin_amdgcn_rcpf(eL), eP = __expf(L - lw[n][reg]), eC = gam[n] * eLi;
            const float kk = kkr[n][reg] * ssk[reg], bsc = kk * aa_[n][reg];
            at_[n][reg] = -kk * eP; rt[n][reg] = rr[n][reg] * eL; bt_[n][reg] = bsc * eLi; kt_[n][reg] = kp[n][reg] * eLi; bh_[n][reg] = bsc * eC; kh[n][reg] = kp[n][reg] * eC;
            const int t = 16 * w + 4 * g + reg;
            *(LAS bf16*)(s0 + t * LSTR + j * 2) = f2bf(at_[n][reg]); *(LAS bf16*)(s1 + t * LSTR + j * 2) = f2bf(bt_[n][reg]);
            *(LAS bf16*)(s2 + t * LSTR + j * 2) = f2bf(kt_[n][reg]); *(LAS bf16*)(s3 + t * LSTR + j * 2) = f2bf(rt[n][reg]); }
        *(LAS v2u*)(s4 + j * LSTR + (16 * w + 4 * g) * 2) = pack4(at_[n]); *(LAS v2u*)(s5 + j * LSTR + (16 * w + 4 * g) * 2) = pack4(bh_[n]); *(LAS v2u*)(s6 + j * LSTR + (16 * w + 4 * g) * 2) = pack4(vv[n]);
        f32x4 bv;
#pragma unroll
        for (int reg = 0; reg < 4; ++reg) bv[reg] = bon[reg] * vv[n][reg];
        *(GAS v2u*)(rec + REC_BV + ((w * 64 + lane) * 4 + n) * 8) = pack4(bv); }
    HBAR();
    if (stage_limit <= 3) return;
    f32x4 aN[4], aMk[4], aMbr[4], aMkr[4]; zero4(aN); zero4(aMk); zero4(aMbr); zero4(aMkr);
    mm_strip2(aN, aMk, s0, s1, s2, w, c, g);
    mm_strip(aMbr, s1, s3, w, c, g); mm_strip(aMkr, s2, s3, w, c, g);
#pragma unroll
    for (int n = 0; n < 4; ++n)
#pragma unroll
        for (int reg = 0; reg < 4; ++reg) { const int row = 16 * w + 4 * g + reg, col = 16 * n + c;
            if (!(col < row)) { aN[n][reg] = 0.f; aMk[n][reg] = 0.f; } if (!(row <= col)) { aMbr[n][reg] = 0.f; aMkr[n][reg] = 0.f; } }
    HBAR();
    LAS float* Nf = (LAS float*)s0;
#pragma unroll
    for (int n = 0; n < 4; ++n)
#pragma unroll
        for (int reg = 0; reg < 4; ++reg) Nf[(16 * w + 4 * g + reg) * 64 + (c & 3) * 16 + 4 * n + (c >> 2)] = aN[n][reg];
    st_T(s2, aMk, w, c, g);
    st_T(s3, aMbr, w, c, g);
    HBAR();
    {
        const int q = lane & 3, sl = lane >> 2; float cq[16];
#pragma unroll
        for (int k = 0; k < 16; ++k) cq[k] = 0.f;
        for (int t = 0; t < 16 * w; ++t) if (q == 0) *(LAS bf16*)(s7 + t * LSTR + (16 * w + sl) * 2) = (bf16)0;
#pragma unroll
        for (int t = 0; t < 64; ++t) if (t >= 16 * w) {
            float part = 0.f;
#pragma unroll
            for (int k4 = 0; k4 < (t + 15) / 16; ++k4) { const f32x4 nv = *(const LAS f32x4*)(Nf + t * 64 + q * 16 + 4 * k4);
#pragma unroll
                for (int e = 0; e < 4; ++e) if (4 * (4 * k4 + e) < t) part = fmaf(nv[e], cq[4 * k4 + e], part); }
            part = sum4_dpp(part);
            const float val = part + ((t == 16 * w + sl) ? 1.0f : 0.0f);
            cq[t >> 2] = (q == (t & 3)) ? val : cq[t >> 2];
            if (q == 0) *(LAS bf16*)(s7 + t * LSTR + (16 * w + sl) * 2) = f2bf(val);
        }
    }
    HBAR();
    if (stage_limit <= 5) return;
    { f32x4 aW[4], aNk[4]; zero4(aW); zero4(aNk); mm_strip2(aW, aNk, s7, s4, s2, w, c, g); st_T(s0, aW, w, c, g); st_T(s1, aNk, w, c, g); }
    HBAR();
    { f32x4 aP[4]; zero4(aP); mm_strip(aP, s0, s5, w, c, g);
#pragma unroll
      for (int n = 0; n < 4; ++n)
#pragma unroll
          for (int reg = 0; reg < 4; ++reg) if (n == w && c == 4 * g + reg) aP[n][reg] += gam[n];
#pragma unroll
      for (int n = 0; n < 4; ++n) *(GAS v2u*)(rec + REC_PT + ((n * 2 + (w >> 1)) * 64 + lane) * 16 + 8 * (w & 1)) = pack4(aP[n]); }
    { f32x4 aZq[4], aZy[4]; zero4(aZq); zero4(aZy); mm_strip2(aZq, aZy, s1, s5, s3, w, c, g);
#pragma unroll
      for (int n = 0; n < 4; ++n) { aZq[n] += kh[n]; aZy[n] += aMkr[n]; }
      f32x4 aRy[4]; zero4(aRy); mm_strip(aRy, s3, s0, w, c, g);
#pragma unroll
      for (int n = 0; n < 4; ++n)
#pragma unroll
          for (int reg = 0; reg < 4; ++reg) *(GAS bf16*)(rec + REC_RY + ((w * 2 + (n >> 1)) * 64 + 16 * (2 * (n & 1) + (c >> 3)) + 4 * g + reg) * 16 + 2 * (c & 7)) = f2bf(aRy[n][reg] + rt[n][reg]);
      st_T(s4, aZq, w, c, g);
      st_T(s7, aZy, w, c, g); }
    HBAR();
    { f32x4 aQ[4], aY[4]; zero4(aQ); zero4(aY); mm_strip(aQ, s4, s6, w, c, g); mm_strip(aY, s7, s6, w, c, g);
#pragma unroll
      for (int n = 0; n < 4; ++n) { *(GAS v2u*)(rec + REC_QS + ((n * 64 + lane) * 4 + w) * 8) = pack4(aQ[n]);
                                    *(GAS v2u*)(rec + REC_YL + ((w * 64 + lane) * 4 + n) * 8) = pack4(aY[n]); } }
}

__device__ __forceinline__ float rdlane(float v, int l) { return __int_as_float(__builtin_amdgcn_readlane(__float_as_int(v), l)); }
__device__ __forceinline__ void rwkv_sample_task(Frame& F, int task) {
    int lane_ = F.lane; asm volatile("" : "+v"(lane_)); const int lane = lane_;
    const int b = task / NH, h = task % NH, col = h * 64 + lane;
    const bf16* proj = (const bf16*)(F.ws + WS_PROJ);
    const float* sh = F.in[I_SSHIFT] + (size_t)b * RWKV_COLS;
    const float* mu = F.in[I_MU];
    float S[64];
    { const GAS f32x4* sp = (const GAS f32x4*)(F.in[I_SWKV] + (((size_t)b * NH + h) * 64 + lane) * 64);
#pragma unroll
      for (int q = 0; q < 16; ++q) { const f32x4 v = sp[q]; S[4 * q] = v[0]; S[4 * q + 1] = v[1]; S[4 * q + 2] = v[2]; S[4 * q + 3] = v[3]; } }
    const float w0 = F.in[I_W0][col], a0 = F.in[I_A0][col], kkc = F.in[I_KK][col], kac = F.in[I_KA][col], rkc = F.in[I_RK][col], lnw = F.in[I_LNW][col], lnb = F.in[I_LNB][col];
    float rr[ST], kq[ST], vq[ST], twd[ST], adv[ST], gd0[ST], gd1[ST];
#pragma unroll
    for (int i = 0; i < ST; ++i) { const int row = RP + b * ST + i; const bf16* cr = proj + (size_t)row * NCOLA;
#define SHIFTED(cc) ({ const float p_ = bf2f(cr[(cc)]); const float q_ = (i == 0) ? sh[(cc)] : bf2f(cr[(cc) - NCOLA]); p_ + (q_ - p_) * mu[(cc)]; })
        rr[i] = SHIFTED(col); kq[i] = SHIFTED(768 + col); vq[i] = SHIFTED(1536 + col);
        twd[i] = ftanh(SHIFTED(2304 + lane)); adv[i] = SHIFTED(2368 + lane); gd0[i] = fsigmoid(SHIFTED(2432 + lane)); gd1[i] = fsigmoid(SHIFTED(2496 + lane));
#undef SHIFTED
    }
    float dwv[ST] = {0.f, 0.f, 0.f, 0.f}, dav[ST] = {0.f, 0.f, 0.f, 0.f}, ggv[ST] = {0.f, 0.f, 0.f, 0.f};
    { const GAS float* W2 = (const GAS float*)(F.in[I_WW2] + col); const GAS float* A2 = (const GAS float*)(F.in[I_WA2] + col); const GAS float* G2 = (const GAS float*)(F.in[I_WG2] + col);
#pragma unroll 16
      for (int l = 0; l < 64; ++l) { const float w2 = W2[0], a2 = A2[0], g2a = G2[0], g2b = G2[64 * 768]; W2 += 768; A2 += 768; G2 += 768;
#pragma unroll
          for (int i = 0; i < ST; ++i) { dwv[i] = fmaf(rdlane(twd[i], l), w2, dwv[i]); dav[i] = fmaf(rdlane(adv[i], l), a2, dav[i]); ggv[i] = fmaf(rdlane(gd0[i], l), g2a, ggv[i]); ggv[i] = fmaf(rdlane(gd1[i], l), g2b, ggv[i]); } } }
#pragma unroll
    for (int i = 0; i < ST; ++i) {
        const int row = RP + b * ST + i;
        const float r = rr[i], k = kq[i], v = vq[i], dw = dwv[i], da = dav[i], gg = ggv[i];
        const float y0 = -(w0 + dw); const float sp = fmaxf(y0, 0.f) + __logf(1.0f + __expf(-fabsf(y0)));
        const float wdec = __expf(-__expf(-sp - 0.5f));
        const float a = fsigmoid(a0 + da);
        const float kkr = k * kkc; const float nrm = fmaxf(sqrtf(wave_sum(kkr * kkr)), 1e-12f); const float kk = kkr / nrm;
        const float kp = k * (1.0f + (a - 1.0f) * kac);
        const float asc = -kk, bsc = kk * a;
        const float bonus = wave_sum(r * kp * rkc);
        float sa = 0.f;
#pragma unroll
        for (int j = 0; j < 64; ++j) sa = fmaf(S[j], rdlane(asc, j), sa);
        const float vi = v;
        float y = 0.f;
#pragma unroll
        for (int j = 0; j < 64; ++j) { const float wj = rdlane(wdec, j), bj = rdlane(bsc, j), kj = rdlane(kp, j), rj = rdlane(r, j);
            S[j] = fmaf(S[j], wj, fmaf(sa, bj, vi * kj)); y = fmaf(S[j], rj, y); }
        const float mean = wave_sum(y) * (1.0f / 64.0f); const float dy = y - mean; const float var = wave_sum(dy * dy) * (1.0f / 64.0f);
        const float o = (dy * rsqrtf(var + 6.4e-4f) * lnw + lnb + bonus * vi) * gg;
        ((bf16*)(F.ws + WS_MIX))[(size_t)row * DM + col] = f2bf(o);
        asm volatile("" ::: "memory");
    }
    { GAS f32x4* sp = (GAS f32x4*)(F.out + O_SWKV + (((size_t)b * NH + h) * 64 + lane) * 64);
#pragma unroll
      for (int q = 0; q < 16; ++q) sp[q] = (f32x4){S[4 * q], S[4 * q + 1], S[4 * q + 2], S[4 * q + 3]}; }
    if (h == 0) { const bf16* lr = proj + (size_t)(RP + b * ST + ST - 1) * NCOLA; float* o = F.out + O_SSHIFT + (size_t)b * RWKV_COLS;
        for (int q = lane; q < RWKV_COLS; q += 64) o[q] = bf2f(lr[q]); }
}

__device__ __forceinline__ void rwkv_scan_chain(Frame& F, int bh, int w) {
    int lane_ = F.lane; asm volatile("" : "+v"(lane_)); const int lane = lane_, g = lane >> 4, c = lane & 15; const int b = bh / NH, h = bh % NH;
    f32x4 acc[4]; zero4(acc);
    const int vrow = 16 * w + c;
    auto recp = [&](int cc) -> unsigned char* { return F.ws + WS_REC + (size_t)((b * NH + h) * 128 + cc) * REC_BYTES; };
    constexpr int DPF = 4;
    bf16x8 pa[DPF][4][2]; v4u qa[DPF][2];
#define SCAN_LOAD(d, cc_) do { const unsigned char* rp_ = recp(cc_); \
        qa[d][0] = *(const GAS v4u*)(rp_ + REC_QS + (w * 64 + lane) * 32); qa[d][1] = *(const GAS v4u*)(rp_ + REC_QS + (w * 64 + lane) * 32 + 16); \
        _Pragma("unroll") for (int mt = 0; mt < 4; ++mt) _Pragma("unroll") for (int ks = 0; ks < 2; ++ks) pa[d][mt][ks] = *(const GAS bf16x8*)(rp_ + REC_PT + ((mt * 2 + ks) * 64 + lane) * 16); } while (0)
#pragma unroll
    for (int d = 0; d < DPF; ++d) SCAN_LOAD(d, d);
    for (int cc0 = 0; cc0 < 128; cc0 += DPF) {
#pragma unroll
        for (int d = 0; d < DPF; ++d) { const int cc = cc0 + d;
            unsigned char* sp_ = F.ws + WS_HB + (size_t)((b * NH + h) * 128 + cc) * 8192;
            v2u sb[4]; f32x4 nacc[4];
#pragma unroll
            for (int mt = 0; mt < 4; ++mt) sb[mt] = pack4(acc[mt]);
            nacc[0] = unpack4((v2u){qa[d][0].x, qa[d][0].y}); nacc[1] = unpack4((v2u){qa[d][0].z, qa[d][0].w}); nacc[2] = unpack4((v2u){qa[d][1].x, qa[d][1].y}); nacc[3] = unpack4((v2u){qa[d][1].z, qa[d][1].w});
#pragma unroll
            for (int mt = 0; mt < 4; ++mt) *(GAS v2u*)(sp_ + ((w * 2 + (mt >> 1)) * 64 + 16 * (2 * (mt & 1) + (g >> 1)) + c) * 16 + 8 * (g & 1)) = sb[mt];
            bf16x8 bf[2];
#pragma unroll
            for (int ks = 0; ks < 2; ++ks) { v4u t; t.x = sb[2 * ks].x; t.y = sb[2 * ks].y; t.z = sb[2 * ks + 1].x; t.w = sb[2 * ks + 1].y; bf[ks] = __builtin_bit_cast(bf16x8, t); }
#pragma unroll
            for (int mt = 0; mt < 4; ++mt) { nacc[mt] = mfma16(pa[d][mt][0], bf[0], nacc[mt]); nacc[mt] = mfma16(pa[d][mt][1], bf[1], nacc[mt]); acc[mt] = nacc[mt]; }
            if (cc + DPF < 128) SCAN_LOAD(d, cc + DPF);
        }
    }
#undef SCAN_LOAD
    float* o = F.out + O_PWKV + (((size_t)b * NH + h) * 64 + vrow) * 64;
#pragma unroll
    for (int mt = 0; mt < 4; ++mt) *(GAS f32x4*)(o + 16 * mt + 4 * g) = acc[mt];
}

__device__ __forceinline__ void rwkv_yout_item(Frame& F, int item) {
    int lane_ = F.lane; asm volatile("" : "+v"(lane_)); const int lane = lane_, g = lane >> 4, c = lane & 15; const int unit = item >> 2, w = item & 3;
    const int chunk = unit / NH, h = unit % NH, row0 = chunk * 64; const bool first = (chunk & 127) == 0;
    const unsigned char* rec = F.ws + WS_REC + (size_t)rec_index(chunk, h) * REC_BYTES; const unsigned char* srec = F.ws + WS_HB + (size_t)rec_index(chunk, h) * 8192;
    const bf16* proj = (const bf16*)(F.ws + WS_PROJ);
    f32x4 y[4], gt[4]; zero4(gt);
    { const v4u y01 = *(const GAS v4u*)(rec + REC_YL + (w * 64 + lane) * 32), y23 = *(const GAS v4u*)(rec + REC_YL + (w * 64 + lane) * 32 + 16);
      y[0] = unpack4((v2u){y01.x, y01.y}); y[1] = unpack4((v2u){y01.z, y01.w}); y[2] = unpack4((v2u){y23.x, y23.y}); y[3] = unpack4((v2u){y23.z, y23.w}); }
#pragma unroll
    for (int ks = 0; ks < 2; ++ks) { const bf16x8 a = *(const GAS bf16x8*)(rec + REC_RY + ((w * 2 + ks) * 64 + lane) * 16);
#pragma unroll
        for (int n = 0; n < 4; ++n) y[n] = mfma16(a, *(const GAS bf16x8*)(srec + ((n * 2 + ks) * 64 + lane) * 16), y[n]); }
    { const int t = 16 * w + c; const bf16* cr = proj + (size_t)(row0 + t) * NCOLA; const bf16* pr = (first && t == 0) ? nullptr : cr - NCOLA; const bf16* Wg2 = (const bf16*)(F.ws + WS_WG2);
#pragma unroll
      for (int ks = 0; ks < 4; ++ks) { const int l0 = 32 * ks + 8 * g; float x[8]; load_shift8(cr + 2432 + l0, pr ? pr + 2432 + l0 : nullptr, F.in[I_MU] + 2432 + l0, x);
#pragma unroll
          for (int i = 0; i < 8; ++i) x[i] = fsigmoid(x[i]);
          const bf16x8 ag = pack_frag(x);
#pragma unroll
          for (int n = 0; n < 4; ++n) gt[n] = mfma16(ag, *(const GAS bf16x8*)(Wg2 + (size_t)(h * 64 + 16 * n + c) * 128 + l0), gt[n]); } }
    float mean[4], rstd[4];
#pragma unroll
    for (int reg = 0; reg < 4; ++reg) { float s = (y[0][reg] + y[1][reg]) + (y[2][reg] + y[3][reg]); s = sum16(s); mean[reg] = s * (1.0f / 64.0f);
        float q = 0.f;
#pragma unroll
        for (int n = 0; n < 4; ++n) { const float d = y[n][reg] - mean[reg]; q += d * d; }
        q = sum16(q); rstd[reg] = rsqrtf(q * (1.0f / 64.0f) + 6.4e-4f); }
    bf16* mix = (bf16*)(F.ws + WS_MIX);
#pragma unroll
    for (int n = 0; n < 4; ++n) { const int col = h * 64 + 16 * n + c; const float lnw = F.in[I_LNW][col], lnb = F.in[I_LNB][col];
        const f32x4 bv = unpack4(*(const GAS v2u*)(rec + REC_BV + ((w * 64 + lane) * 4 + n) * 8));
#pragma unroll
        for (int reg = 0; reg < 4; ++reg) { const float o = ((y[n][reg] - mean[reg]) * rstd[reg] * lnw + lnb + bv[reg]) * gt[n][reg];
            mix[(size_t)(row0 + 16 * w + 4 * g + reg) * DM + col] = f2bf(o); } }
}

__device__ __forceinline__ int crow32(int r, int hi) { return (r & 3) + 8 * (r >> 2) + 4 * hi; }
template <bool MASKED, int GB>
__device__ __forceinline__ void flash32(const bf16x8 (&qf)[4], const bf16* Kp, int kstr, const bf16* VTp, int vstr, int kb_lo, int nblk, int qpos, float m0, float l0,
                                        f32x16& o0, f32x16& o1, float& lsum, int lane) {
    const int r32 = lane & 31, hh = lane >> 5;
    float m = m0, l = hh == 0 ? l0 : 0.f;
#pragma unroll
    for (int r = 0; r < 16; ++r) { o0[r] = 0.f; o1[r] = 0.f; }
    for (int b0 = 0; b0 < nblk; b0 += GB) {
        bf16x8 kf[GB][4]; v2u vf[GB][2][2][2];
#pragma unroll
        for (int i = 0; i < GB; ++i) if (b0 + i < nblk) { const int kb = kb_lo + 32 * (b0 + i);
#pragma unroll
            for (int ks = 0; ks < 4; ++ks) kf[i][ks] = *(const GAS bf16x8*)(Kp + (size_t)(kb + r32) * kstr + 16 * ks + 8 * hh);
#pragma unroll
            for (int s2 = 0; s2 < 2; ++s2)
#pragma unroll
                for (int dt = 0; dt < 2; ++dt) { const bf16* vp = VTp + (size_t)(32 * dt + r32) * vstr + kb + 16 * s2 + 4 * hh; vf[i][s2][dt][0] = *(const GAS v2u*)vp; vf[i][s2][dt][1] = *(const GAS v2u*)(vp + 8); } }
#pragma unroll
        for (int i = 0; i < GB; ++i) if (b0 + i < nblk) { const int kb = kb_lo + 32 * (b0 + i);
            f32x16 s;
#pragma unroll
            for (int r = 0; r < 16; ++r) s[r] = 0.f;
#pragma unroll
            for (int ks = 0; ks < 4; ++ks) s = mfma32(kf[i][ks], qf[ks], s);
            if (MASKED) {
#pragma unroll
                for (int r = 0; r < 16; ++r) { const int rel = qpos - (kb + crow32(r, hh)); if (rel < 0 || rel >= 128) s[r] = -1e30f; } }
            float bm = s[0];
#pragma unroll
            for (int r = 1; r < 16; ++r) bm = fmaxf(bm, s[r]);
            bm = max_x32(bm);
            const float mn = fmaxf(m, bm), alpha = __builtin_amdgcn_exp2f(m - mn); m = mn;
            float ps = 0.f;
#pragma unroll
            for (int r = 0; r < 16; ++r) { s[r] = __builtin_amdgcn_exp2f(s[r] - mn); ps += s[r]; }
            l = l * alpha + ps;
#pragma unroll
            for (int r = 0; r < 16; ++r) { o0[r] *= alpha; o1[r] *= alpha; }
#pragma unroll
            for (int s2 = 0; s2 < 2; ++s2) {
                v4u pw; pw.x = cvt_pk_bf16(s[8 * s2], s[8 * s2 + 1]); pw.y = cvt_pk_bf16(s[8 * s2 + 2], s[8 * s2 + 3]); pw.z = cvt_pk_bf16(s[8 * s2 + 4], s[8 * s2 + 5]); pw.w = cvt_pk_bf16(s[8 * s2 + 6], s[8 * s2 + 7]);
                const bf16x8 pb = __builtin_bit_cast(bf16x8, pw);
                { v4u aw; aw.x = vf[i][s2][0][0].x; aw.y = vf[i][s2][0][0].y; aw.z = vf[i][s2][0][1].x; aw.w = vf[i][s2][0][1].y; o0 = mfma32(__builtin_bit_cast(bf16x8, aw), pb, o0); }
                { v4u aw; aw.x = vf[i][s2][1][0].x; aw.y = vf[i][s2][1][0].y; aw.z = vf[i][s2][1][1].x; aw.w = vf[i][s2][1][1].y; o1 = mfma32(__builtin_bit_cast(bf16x8, aw), pb, o1); } }
        }
    }
    lsum = add_x32(l);
}
__device__ __forceinline__ void flash_store(bf16* dst  , int rstride, const f32x16& o0, const f32x16& o1, float lsum, int lane) {
    const int r32 = lane & 31, hh = lane >> 5; const float inv = 1.0f / lsum; bf16* p = dst + (size_t)r32 * rstride + 4 * hh;
#pragma unroll
    for (int k = 0; k < 4; ++k) { *(GAS v2u*)(p + 8 * k) = pack4((f32x4){o0[4 * k] * inv, o0[4 * k + 1] * inv, o0[4 * k + 2] * inv, o0[4 * k + 3] * inv});
        *(GAS v2u*)(p + 32 + 8 * k) = pack4((f32x4){o1[4 * k] * inv, o1[4 * k + 1] * inv, o1[4 * k + 2] * inv, o1[4 * k + 3] * inv}); }
}
constexpr int KL_STR = 144;
template <bool MASKED>
__device__ __forceinline__ void flash32_lds(const bf16x8 (&qf)[4], const LAS unsigned char* Kl, const LAS unsigned char* Vl, int vstr, int lk_lo, int nblk, int kpos_lo, int qpos, float m0, float l0,
                                            f32x16& o0, f32x16& o1, float& lsum, int lane) {
    const int r32 = lane & 31, hh = lane >> 5;
    float m = m0, l = hh == 0 ? l0 : 0.f;
#pragma unroll
    for (int r = 0; r < 16; ++r) { o0[r] = 0.f; o1[r] = 0.f; }
    for (int blk = 0; blk < nblk; ++blk) { const int lk = lk_lo + 32 * blk;
        f32x16 s;
#pragma unroll
        for (int r = 0; r < 16; ++r) s[r] = 0.f;
#pragma unroll
        for (int ks = 0; ks < 4; ++ks) s = mfma32(*(const LAS bf16x8*)(Kl + (lk + r32) * KL_STR + (16 * ks + 8 * hh) * 2), qf[ks], s);
        if (MASKED && (blk == 0 || blk == nblk - 1)) {
#pragma unroll
            for (int r = 0; r < 16; ++r) { const int rel = qpos - (kpos_lo + 32 * blk + crow32(r, hh)); if (rel < 0 || rel >= 128) s[r] = -1e30f; } }
        float bm = s[0];
#pragma unroll
        for (int r = 1; r < 16; ++r) bm = fmaxf(bm, s[r]);
        bm = max_x32(bm);
        const float mn = fmaxf(m, bm), alpha = __builtin_amdgcn_exp2f(m - mn); m = mn;
        float ps = 0.f;
#pragma unroll
        for (int r = 0; r < 16; ++r) { s[r] = __builtin_amdgcn_exp2f(s[r] - mn); ps += s[r]; }
        l = l * alpha + ps;
#pragma unroll
        for (int r = 0; r < 16; ++r) { o0[r] *= alpha; o1[r] *= alpha; }
#pragma unroll
        for (int s2 = 0; s2 < 2; ++s2) {
            v4u pw; pw.x = cvt_pk_bf16(s[8 * s2], s[8 * s2 + 1]); pw.y = cvt_pk_bf16(s[8 * s2 + 2], s[8 * s2 + 3]); pw.z = cvt_pk_bf16(s[8 * s2 + 4], s[8 * s2 + 5]); pw.w = cvt_pk_bf16(s[8 * s2 + 6], s[8 * s2 + 7]);
            const bf16x8 pb = __builtin_bit_cast(bf16x8, pw);
#pragma unroll
            for (int dt = 0; dt < 2; ++dt) { const LAS unsigned char* vp = Vl + (32 * dt + r32) * vstr + (lk + 16 * s2 + 4 * hh) * 2;
                const v2u a0 = *(const LAS v2u*)vp, a1 = *(const LAS v2u*)(vp + 16); v4u aw; aw.x = a0.x; aw.y = a0.y; aw.z = a1.x; aw.w = a1.y;
                if (dt == 0) o0 = mfma32(__builtin_bit_cast(bf16x8, aw), pb, o0); else o1 = mfma32(__builtin_bit_cast(bf16x8, aw), pb, o1); } }
    }
    lsum = add_x32(l);
}
template <bool VT>
__device__ __forceinline__ void stage_kv(LAS unsigned char* Kl, LAS unsigned char* Vl, int vstr, const bf16* Kg, int kstr, const bf16* Vg, int vstr_g, int nkeys, int tid) {
    for (int id = tid; id < nkeys * 8; id += NWAVES * 64) { const int key = id >> 3, ch = id & 7; *(LAS v4u*)(Kl + key * KL_STR + ch * 16) = *(const GAS v4u*)(Kg + (size_t)key * kstr + ch * 8); }
    if (VT) { const int cpr = nkeys >> 3;
        for (int id = tid; id < 64 * cpr; id += NWAVES * 64) { const int d = id / cpr, ch = id % cpr; *(LAS v4u*)(Vl + d * vstr + ch * 16) = *(const GAS v4u*)(Vg + (size_t)d * vstr_g + ch * 8); } }
    else for (int id = tid; id < nkeys * 8; id += NWAVES * 64) { const int key = id >> 3, ch = id & 7; const v4u w = *(const GAS v4u*)(Vg + (size_t)key * vstr_g + ch * 8);
        LAS unsigned char* p = Vl + (8 * ch) * vstr + key * 2;
        *(LAS bf16*)(p) = (bf16)(w.x & 0xffffu); *(LAS bf16*)(p + vstr) = (bf16)(w.x >> 16); *(LAS bf16*)(p + 2 * vstr) = (bf16)(w.y & 0xffffu); *(LAS bf16*)(p + 3 * vstr) = (bf16)(w.y >> 16);
        *(LAS bf16*)(p + 4 * vstr) = (bf16)(w.z & 0xffffu); *(LAS bf16*)(p + 5 * vstr) = (bf16)(w.z >> 16); *(LAS bf16*)(p + 6 * vstr) = (bf16)(w.w & 0xffffu); *(LAS bf16*)(p + 7 * vstr) = (bf16)(w.w >> 16); }
}
__device__ __forceinline__ void memattn_prompt_unit(Frame& F, int layer, int unit) {
    int lane_ = F.lane; asm volatile("" : "+v"(lane_)); const int lane = lane_, r32 = lane & 31, hh = lane >> 5;
    const int b = unit >> 7, hm = (unit >> 5) & 3, qblk = unit & 31; const int row = b * T + qblk * 256 + F.wave * 32 + r32;
    LAS unsigned char* Kl = F.lds; LAS unsigned char* Vl = F.lds + 256 * KL_STR; constexpr int VSTR = 256 * 2 + 16;
    __syncthreads();
    stage_kv<true>(Kl, Vl, VSTR, (const bf16*)(F.ws + WS_MK) + (size_t)((layer * 2 + b) * 4 + hm) * 256 * 64, 64, (const bf16*)(F.ws + WS_MVT) + (size_t)((layer * 2 + b) * 4 + hm) * 64 * 256, 256, 256, F.wave * 64 + lane);
    bf16x8 qf[4];
    if (layer == 0) { const bf16* qp = (const bf16*)(F.ws + WS_PROJ) + (size_t)row * NCOLA + RWKV_COLS + hm * 64; const float* gn = F.in[I_MQN];
        float x[4][8]; float ss = 0.f;
#pragma unroll
        for (int ks = 0; ks < 4; ++ks) { const v4u w = *(const GAS v4u*)(qp + 16 * ks + 8 * hh); const unsigned ww[4] = {w.x, w.y, w.z, w.w};
#pragma unroll
            for (int i = 0; i < 4; ++i) { x[ks][2 * i] = bflo(ww[i]); x[ks][2 * i + 1] = bfhi(ww[i]); ss += x[ks][2 * i] * x[ks][2 * i] + x[ks][2 * i + 1] * x[ks][2 * i + 1]; } }
        ss = add_x32(ss); const float rs = rsqrtf(ss * (1.0f / 64.0f) + 1e-6f) * C2Q;
#pragma unroll
        for (int ks = 0; ks < 4; ++ks) {
#pragma unroll
            for (int i = 0; i < 8; ++i) x[ks][i] *= rs * gn[16 * ks + 8 * hh + i];
            qf[ks] = pack_frag(x[ks]); }
    } else { const bf16* qp = (const bf16*)(F.ws + WS_Q1) + (size_t)row * DM + 768 + hm * 64;
#pragma unroll
        for (int ks = 0; ks < 4; ++ks) qf[ks] = *(const GAS bf16x8*)(qp + 16 * ks + 8 * hh); }
    __syncthreads();
    f32x16 o0, o1; float ls;
    flash32_lds<false>(qf, Kl, Vl, VSTR, 0, 8, 0, 0, -1e30f, 0.f, o0, o1, ls, lane);
    flash_store((bf16*)(F.ws + WS_MIX) + (size_t)(b * T + qblk * 256 + F.wave * 32) * DM + 768 + hm * 64, DM, o0, o1, ls, lane);
}
__device__ __forceinline__ void swa_prompt_unit(Frame& F, int unit) {
    int lane_ = F.lane; asm volatile("" : "+v"(lane_)); const int lane = lane_, r32 = lane & 31, hh = lane >> 5;
    const int b = unit >> 7, kvh = (unit >> 5) & 3, qblk = unit & 31, q0 = qblk * 256, kb0 = q0 >= 128 ? q0 - 128 : 0, nkeys = q0 + 256 - kb0;
    LAS unsigned char* Kl = F.lds; LAS unsigned char* Vl = F.lds + 384 * KL_STR; constexpr int VSTR = 384 * 2 + 16;
    __syncthreads();
    stage_kv<false>(Kl, Vl, VSTR, (const bf16*)(F.ws + WS_K1) + (size_t)(b * T + kb0) * 256 + kvh * 64, 256, (const bf16*)(F.ws + WS_V1) + (size_t)(b * T + kb0) * 256 + kvh * 64, 256, nkeys, F.wave * 64 + lane);
    const int tq = q0 + F.wave * 32, row = b * T + tq + r32;
    bf16x8 qf[3][4];
#pragma unroll
    for (int gq = 0; gq < 3; ++gq) { const bf16* qp = (const bf16*)(F.ws + WS_Q1) + (size_t)row * DM + (kvh * 3 + gq) * 64;
#pragma unroll
        for (int ks = 0; ks < 4; ++ks) qf[gq][ks] = *(const GAS bf16x8*)(qp + 16 * ks + 8 * hh); }
    __syncthreads();
    const int kp_lo = tq >= 128 ? tq - 128 : 0, nblk = (tq - kp_lo) / 32 + 1;
#pragma unroll
    for (int gq = 0; gq < 3; ++gq) { const int hq = kvh * 3 + gq; const float sink = F.in[I_SINKS][hq] * LOG2E;
        f32x16 o0, o1; float ls;
        flash32_lds<true>(qf[gq], Kl, Vl, VSTR, kp_lo - kb0, nblk, kp_lo, tq + r32, sink, 1.0f, o0, o1, ls, lane);
        flash_store((bf16*)(F.ws + WS_MIX) + (size_t)(b * T + tq) * DM + hq * 64, DM, o0, o1, ls, lane); }
}
template <int NQ, bool WINDOW>
__device__ __forceinline__ void small_attn(const LAS float* ql, LAS float* sc, int NKP, const float* k1, const float* v1, int kst1, int nk1, const bf16* k2, const bf16* v2, int kst2, int nk2,
                                           const float* sinkg  , bf16* out0, int ostride_q, int lane) {
    const int sub = lane >> 4, dq = lane & 15, nk = nk1 + nk2;
    f32x4 qv[NQ];
#pragma unroll
    for (int qi = 0; qi < NQ; ++qi) qv[qi] = *(const LAS f32x4*)(ql + qi * 64 + 4 * dq);
    constexpr int KBAT = NQ > 4 ? 4 : 8;
    for (int kg0 = 0; kg0 < nk1; kg0 += 4 * KBAT) { f32x4 kv[KBAT];
#pragma unroll
        for (int u = 0; u < KBAT; ++u) kv[u] = *(const GAS f32x4*)(k1 + (size_t)(kg0 + 4 * u + sub) * kst1 + 4 * dq);
#pragma unroll
        for (int u = 0; u < KBAT; ++u) { const int key = kg0 + 4 * u + sub;
#pragma unroll
            for (int qi = 0; qi < NQ; ++qi) { const f32x4 p = qv[qi] * kv[u]; const float s = sum16((p[0] + p[1]) + (p[2] + p[3])); if (dq == 0) sc[qi * NKP + key] = s; } } }
    for (int kg = nk1; kg < nk; kg += 4) { const int key = kg + sub; const f32x4 kv = unpack4(*(const GAS v2u*)(k2 + (size_t)(key - nk1) * kst2 + 4 * dq));
#pragma unroll
        for (int qi = 0; qi < NQ; ++qi) { const f32x4 p = qv[qi] * kv; const float s = sum16((p[0] + p[1]) + (p[2] + p[3])); if (dq == 0) sc[qi * NKP + key] = s; } }
    LDS_WAIT(); asm volatile("" ::: "memory");
#pragma unroll
    for (int qi = 0; qi < NQ; ++qi) { float sv[5]; const float sk_ = sinkg ? sinkg[qi >> 2] * LOG2E : -1e30f; float mx = sk_;
#pragma unroll
        for (int t = 0; t < 5; ++t) { const int key = lane + 64 * t; float s = -1e30f; if (key < nk) { s = sc[qi * NKP + key]; if (WINDOW) { const int i = qi & 3; if (key < i + 1 || key > 128 + i) s = -1e30f; } } sv[t] = s; mx = fmaxf(mx, s); }
        mx = wave_max(mx); float sum = 0.f;
#pragma unroll
        for (int t = 0; t < 5; ++t) { sv[t] = __builtin_amdgcn_exp2f(sv[t] - mx); sum += sv[t]; }
        sum = wave_sum(sum) + (sinkg ? __builtin_amdgcn_exp2f(sk_ - mx) : 0.f); const float inv = 1.0f / sum;
#pragma unroll
        for (int t = 0; t < 5; ++t) { const int key = lane + 64 * t; if (key < nk) sc[qi * NKP + key] = sv[t] * inv; } }
    LDS_WAIT(); asm volatile("" ::: "memory");
    f32x4 acc[NQ];
#pragma unroll
    for (int qi = 0; qi < NQ; ++qi) acc[qi] = (f32x4){0.f, 0.f, 0.f, 0.f};
    for (int kg0 = 0; kg0 < nk1; kg0 += 4 * KBAT) { f32x4 vv[KBAT];
#pragma unroll
        for (int u = 0; u < KBAT; ++u) vv[u] = *(const GAS f32x4*)(v1 + (size_t)(kg0 + 4 * u + sub) * kst1 + 4 * dq);
#pragma unroll
        for (int u = 0; u < KBAT; ++u) { const int key = kg0 + 4 * u + sub;
#pragma unroll
            for (int qi = 0; qi < NQ; ++qi) acc[qi] += vv[u] * sc[qi * NKP + key]; } }
    for (int kg = nk1; kg < nk; kg += 4) { const int key = kg + sub; const f32x4 vv = unpack4(*(const GAS v2u*)(v2 + (size_t)(key - nk1) * kst2 + 4 * dq));
#pragma unroll
        for (int qi = 0; qi < NQ; ++qi) acc[qi] += vv * sc[qi * NKP + key]; }
#pragma unroll
    for (int qi = 0; qi < NQ; ++qi) { f32x4 a = acc[qi];
#pragma unroll
        for (int e = 0; e < 4; ++e) { a[e] = add_x16(a[e]); a[e] = add_x32(a[e]); }
        if (sub == 0) *(GAS v2u*)(out0 + (size_t)(qi & 3) * ostride_q + (qi >> 2) * 64 + 4 * dq) = pack4(a); }
    LDS_WAIT(); asm volatile("" ::: "memory");
}
__device__ __forceinline__ void memattn_sample_task(Frame& F, int layer, int task, LAS float* wl  ) {
    int lane_ = F.lane; asm volatile("" : "+v"(lane_)); const int lane = lane_, b = task >> 2, hm = task & 3; LAS float* ql = wl; LAS float* sc = wl + 12 * 64;
#pragma unroll
    for (int i = 0; i < 4; ++i) { const int row = RP + b * ST + i; float x;
        if (layer == 0) { x = bf2f(((const bf16*)(F.ws + WS_PROJ))[(size_t)row * NCOLA + RWKV_COLS + hm * 64 + lane]); const float ss = wave_sum(x * x); x *= rsqrtf(ss * (1.0f / 64.0f) + 1e-6f) * C2Q * F.in[I_MQN][lane]; }
        else x = bf2f(((const bf16*)(F.ws + WS_Q1))[(size_t)row * DM + 768 + hm * 64 + lane]);
        ql[i * 64 + lane] = x; }
    LDS_WAIT(); asm volatile("" ::: "memory");
    const float* k1 = F.in[I_CMK] + (((size_t)layer * SB + b) * NMEM * 4 + hm) * 64; const float* v1 = F.in[I_CMV] + (((size_t)layer * SB + b) * NMEM * 4 + hm) * 64;
    small_attn<4, false>(ql, sc, 264, k1, v1, 256, 256, nullptr, nullptr, 0, 0, nullptr, (bf16*)(F.ws + WS_MIX) + (size_t)(RP + b * ST) * DM + 768 + hm * 64, DM, lane);
}
__device__ __forceinline__ void swa_sample_task(Frame& F, int task, LAS float* wl) {
    int lane_ = F.lane; asm volatile("" : "+v"(lane_)); const int lane = lane_, b = task >> 2, kvh = task & 3; LAS float* ql = wl; LAS float* sc = wl + 12 * 64;
#pragma unroll
    for (int qi = 0; qi < 12; ++qi) { const int i = qi & 3, gq = qi >> 2, hq = kvh * 3 + gq; const int row = RP + b * ST + i;
        ql[qi * 64 + lane] = bf2f(((const bf16*)(F.ws + WS_Q1))[(size_t)row * DM + hq * 64 + lane]); }
    LDS_WAIT(); asm volatile("" ::: "memory");
    const float* k1 = F.in[I_CSK] + ((size_t)b * 128 * 4 + kvh) * 64; const float* v1 = F.in[I_CSV] + ((size_t)b * 128 * 4 + kvh) * 64;
    const bf16* k2 = (const bf16*)(F.ws + WS_K1) + (size_t)(RP + b * ST) * 256 + kvh * 64; const bf16* v2 = (const bf16*)(F.ws + WS_V1) + (size_t)(RP + b * ST) * 256 + kvh * 64;
    small_attn<12, true>(ql, sc, 136, k1, v1, 256, 128, k2, v2, 256, 4, F.in[I_SINKS] + kvh * 3, (bf16*)(F.ws + WS_MIX) + (size_t)(RP + b * ST) * DM + kvh * 3 * 64, DM, lane);
}

constexpr int N_PHASES = 13;
template <int PM> __global__ void __launch_bounds__(NWAVES * 64, 2) yoco_fwd(Args args) {
    extern __shared__ __attribute__((aligned(16))) unsigned char lds[];
    Frame F;
    F.lds = (LAS unsigned char*)lds; F.lds_g = lds;
    F.wave = __builtin_amdgcn_readfirstlane((int)threadIdx.x >> 6); F.lane = mk_lane(); F.tid = F.wave * 64 + F.lane;
    F.G = gridDim.x; { const int bx = blockIdx.x; F.vcu = (F.G % 8 == 0) ? (bx % 8) * (F.G / 8) + bx / 8 : bx; }
    F.in = args.in; F.out = args.out; F.ws = args.ws; F.ctl = (gu32*)(args.ws + WS_CTL);
    for (int u = F.tid; u < (LDS_BYTES - LDSCTL_OFF) / 4; u += NWAVES * 64) ((LAS unsigned*)(F.lds + LDSCTL_OFF))[u] = 0u;
    __syncthreads();
    const int lo = args.ph_lo, hi = args.ph_hi;
    XcdBarrier bar; bar.wave0 = F.wave == 0; bar.bar = (unsigned*)(F.ctl + CW_BAR); bar.x = 0; bar.st = nullptr;
    bar = xcd_barrier_post((unsigned*)(F.ctl + CW_BAR), (volatile LAS unsigned*)(F.lds + MISC_OFF) + 8, F.wave == 0);
#define IN(k) (((PM >> (k)) & 1) && lo <= (k) && (k) < hi)
#ifndef MK_DUP
#define MK_DUP -1
#endif
#define PH_REP(k) ((MK_DUP == (k)) ? 2 : 1)
#ifndef MK_TIME
#define MK_TIME -1
#endif
#define STAMP(k) do { if (MK_TIME >= 0 && blockIdx.x == 0 && F.wave == 0 && mk_lane() == 0) ((volatile LAS unsigned long long*)(F.lds + LDSCTL_OFF + 512))[(k)] = __builtin_amdgcn_s_memrealtime(); } while (0)
#define SEAM(k) do { if (IN(k) && IN((k) + 1)) xcd_barrier(bar); STAMP((k) + 1); } while (0)
    const int gw = F.vcu * NWAVES + F.wave, NGW = F.G * NWAVES;
    STAMP(0);
#define SSQ ((float*)(F.ws + WS_SSQ))
#define HB ((bf16*)(F.ws + WS_HB))
#define MIX ((bf16*)(F.ws + WS_MIX))
#define HH ((bf16*)(F.ws + WS_H))
#define PHASE_BEGIN() do { int z_ = 0; unsigned char* ws_ = args.ws; float* out_ = args.out; asm volatile("" : "+s"(z_), "+s"(ws_), "+s"(out_)); F.in = args.in + z_; F.ws = ws_; F.out = out_; \
                           F.lane = mk_lane(); F.tid = F.wave * 64 + F.lane; } while (0)

    if (IN(0)) for (int rep_ = 0; rep_ < PH_REP(0); ++rep_) { PHASE_BEGIN(); p0_prologue(F); } SEAM(0);

    if (IN(1)) for (int rep_ = 0; rep_ < PH_REP(1); ++rep_) { PHASE_BEGIN();
        { pg8::Gemm g{HB, (const bf16*)(F.ws + WS_WA), R, NCOLA, DM}; pg8::StaticOrder S; S.init(R, NCOLA, F.G, (int)blockIdx.x, DM);
          pg8::EpiScaleBf16<0> E{(bf16*)(F.ws + WS_PROJ), NCOLA, SSQ};
          pg8::gemm_phase<pg8::EpiScaleBf16<0>, pg8::StaticOrder, true, true>(F.lds + RING_OFF, g, S, E, F.wave, F.lane); }
#ifndef NO_MEMKV
        { pg8::Gemm g{(const bf16*)(F.ws + WS_MB), (const bf16*)(F.ws + WS_WM), 512, 1024, DM}; pg8::StaticOrder S; S.init(512, 1024, F.G, (int)blockIdx.x, DM);
          pg8::EpiMemKV E{F.ws, F.out, F.in[I_MKN]};
          pg8::gemm_phase<pg8::EpiMemKV, pg8::StaticOrder, true, true>(F.lds + RING_OFF, g, S, E, F.wave, F.lane); }
#endif
    } SEAM(1);

    if (IN(2)) for (int rep_ = 0; rep_ < ((MK_DUP == 2 || (MK_DUP >= 20 && MK_DUP < 30)) ? 2 : 1); ++rep_) { PHASE_BEGIN();
        const int half = F.wave >> 2; const int gw = F.vcu * NWAVES + F.wave, NGW = F.G * NWAVES;
        LAS unsigned char* hb = F.lds + half * PREP_HALF; LAS float* wtot = (LAS float*)(F.lds + WTOT_OFF + half * 1024);
        const int slim = (rep_ == 1 && MK_DUP == 21) ? 3 : (rep_ == 1 && MK_DUP == 22) ? 5 : 99;
        if (!(rep_ == 1 && MK_DUP == 20)) { LAS unsigned char* prow = F.lds + WTOT_OFF + 2048 + half * 512; PrepPf pf; if (F.vcu < NUNIT / 2) prep_issue(F, 2 * F.vcu + half, pf);
            for (int pi = F.vcu; pi < NUNIT / 2; pi += F.G) rwkv_prep_unit(F, 2 * pi + half, hb, wtot, prow, pf, pi + F.G < NUNIT / 2, 2 * (pi + F.G) + half, slim); }
        if (!(rep_ == 1 && (MK_DUP == 21 || MK_DUP == 22))) for (int t = gw; t < SB * NH + 2; t += NGW) {
            if (t < SB * NH) rwkv_sample_task(F, t);
            else { const int b = t - SB * NH; const bf16* lr = (const bf16*)(F.ws + WS_PROJ) + (size_t)(b * T + T - 1) * NCOLA; float* o = F.out + O_PSHIFT + (size_t)b * RWKV_COLS;
                for (int q = F.lane; q < RWKV_COLS; q += 64) o[q] = bf2f(lr[q]); } }
    } SEAM(2);

    if (IN(3)) for (int rep_ = 0; rep_ < ((MK_DUP == 30 || MK_DUP == 31) ? 2 : 1); ++rep_) { PHASE_BEGIN();
        const int nscan = NB * NH * 4;
        if (F.vcu < nscan) { if (F.wave == 0) { if (rep_ == 0 || MK_DUP == 31) rwkv_scan_chain(F, F.vcu >> 2, F.vcu & 3); }
                             else if (rep_ == 0) copy_window_cache(F, (F.vcu * 7 + F.wave - 1) * 64 + F.lane, nscan * 7 * 64); }
        else if (rep_ == 0 || MK_DUP == 30) { LAS float* wl = (LAS float*)(F.lds + F.wave * 12288);
            for (int u = F.vcu - nscan; u < 256; u += F.G - nscan) memattn_prompt_unit(F, 0, u);
            __syncthreads();
            const int ow = (F.vcu - nscan) * NWAVES + F.wave, NOW = (F.G - nscan) * NWAVES;
            for (int t = ow; t < 512; t += NOW) memattn_sample_task(F, 0, t, wl); }
    } SEAM(3);

    if (IN(4)) for (int rep_ = 0; rep_ < PH_REP(4); ++rep_) { PHASE_BEGIN(); _Pragma("unroll 2") for (int it = gw; it < NUNIT * 4; it += NGW) rwkv_yout_item(F, it); } SEAM(4); if (MK_DUP == 40) for (int i_ = 0; i_ < 10; ++i_) xcd_barrier(bar);

    if (IN(5)) for (int rep_ = 0; rep_ < PH_REP(5); ++rep_) { PHASE_BEGIN(); pg8::Gemm g{MIX, (const bf16*)(F.ws + WS_WOUT), R, DM, DM}; pg8::TailOrder S; S.init(F.G, (int)blockIdx.x, DM, S_K1);
        pg8::EpiResid E{F.in[I_XP], F.in[I_XS], RP, nullptr, HB, SSQ, (float*)(F.ws + WS_SLAB), S_K1};
        pg8::gemm_phase<pg8::EpiResid, pg8::TailOrder, true, true>(F.lds + RING_OFF, g, S, E, F.wave, F.lane); } SEAM(5);
    if (IN(6)) for (int rep_ = 0; rep_ < PH_REP(6); ++rep_) { PHASE_BEGIN(); finalize_sample(F, F.in[I_XS], S_K1, false); xcd_barrier(bar);
        pg8::Gemm g{HB, (const bf16*)(F.ws + WS_WUP), R, FF, DM}; pg8::StaticOrder S; S.init(R, FF, F.G, (int)blockIdx.x, DM);
        pg8::EpiScaleBf16<1> E{HH, FF, SSQ};
        pg8::gemm_phase<pg8::EpiScaleBf16<1>, pg8::StaticOrder, true, true>(F.lds + RING_OFF, g, S, E, F.wave, F.lane); } SEAM(6);
    if (IN(7)) { PHASE_BEGIN(); pg8::Gemm g{HH, (const bf16*)(F.ws + WS_WDN), R, DM, FF}; pg8::TailOrder S; S.init(F.G, (int)blockIdx.x, FF, S_K4);
        pg8::EpiResid E{nullptr, nullptr, RP, nullptr, HB, SSQ, (float*)(F.ws + WS_SLAB), S_K4, HB};
        pg8::gemm_phase<pg8::EpiResid, pg8::TailOrder, true, true>(F.lds + RING_OFF, g, S, E, F.wave, F.lane); } SEAM(7);

    if (IN(8)) for (int rep_ = 0; rep_ < PH_REP(8); ++rep_) { PHASE_BEGIN(); finalize_sample(F, nullptr, S_K4, false); xcd_barrier(bar);
        pg8::Gemm g{HB, (const bf16*)(F.ws + WS_WB), R, NCOLB, DM}; pg8::StaticOrder S; S.init(R, NCOLB, F.G, (int)blockIdx.x, DM);
        pg8::EpiL1 E{F.ws, F.out, F.in[I_QN], F.in[I_MQN] + 64, F.in[I_KN]};
        pg8::gemm_phase<pg8::EpiL1, pg8::StaticOrder, true, true>(F.lds + RING_OFF, g, S, E, F.wave, F.lane); } SEAM(8);

    if (IN(9)) for (int rep_ = 0; rep_ < PH_REP(9); ++rep_) { PHASE_BEGIN(); LAS float* wl = (LAS float*)(F.lds + F.wave * 12288); const int gw = F.vcu * NWAVES + F.wave, NGW = F.G * NWAVES;
        for (int u = F.vcu; u < 256; u += F.G) swa_prompt_unit(F, u);
        for (int u = F.vcu; u < 256; u += F.G) memattn_prompt_unit(F, 1, u);
        __syncthreads();
        for (int t = gw; t < 512 + 512; t += NGW) { if (t < 512) swa_sample_task(F, t, wl); else memattn_sample_task(F, 1, t - 512, wl); }
    } SEAM(9);

    if (IN(10)) for (int rep_ = 0; rep_ < PH_REP(10); ++rep_) { PHASE_BEGIN(); pg8::Gemm g{MIX, (const bf16*)(F.ws + WS_WOUT) + (size_t)DM * DM, R, DM, DM}; pg8::TailOrder S; S.init(F.G, (int)blockIdx.x, DM, S_K1);
        pg8::EpiResid E{nullptr, nullptr, RP, nullptr, HB, SSQ, (float*)(F.ws + WS_SLAB), S_K1, HB};
        pg8::gemm_phase<pg8::EpiResid, pg8::TailOrder, true, true>(F.lds + RING_OFF, g, S, E, F.wave, F.lane); } SEAM(10);
    if (IN(11)) for (int rep_ = 0; rep_ < PH_REP(11); ++rep_) { PHASE_BEGIN(); finalize_sample(F, nullptr, S_K1, false); xcd_barrier(bar);
        pg8::Gemm g{HB, (const bf16*)(F.ws + WS_WUP) + (size_t)DM * FF, R, FF, DM}; pg8::StaticOrder S; S.init(R, FF, F.G, (int)blockIdx.x, DM);
        pg8::EpiScaleBf16<1> E{HH, FF, SSQ};
        pg8::gemm_phase<pg8::EpiScaleBf16<1>, pg8::StaticOrder, true, true>(F.lds + RING_OFF, g, S, E, F.wave, F.lane); } SEAM(11);
    if (IN(12)) for (int rep_ = 0; rep_ < PH_REP(12); ++rep_) { PHASE_BEGIN(); pg8::Gemm g{HH, (const bf16*)(F.ws + WS_WDN) + (size_t)DM * FF, R, DM, FF}; pg8::TailOrder S; S.init(F.G, (int)blockIdx.x, FF, S_K4);
        pg8::EpiResid E{nullptr, nullptr, RP, F.out + O_Y, nullptr, nullptr, (float*)(F.ws + WS_SLAB), S_K4, HB};
        pg8::gemm_phase<pg8::EpiResid, pg8::TailOrder, true, true>(F.lds + RING_OFF, g, S, E, F.wave, F.lane);
        xcd_barrier(bar); finalize_sample(F, nullptr, S_K4, true); }
    STAMP(13);
    if (MK_TIME >= 0 && blockIdx.x == 0 && F.wave == 0 && mk_lane() == 0) {
        volatile LAS unsigned long long* ts = (volatile LAS unsigned long long*)(F.lds + LDSCTL_OFF + 512); const unsigned long long d = ts[MK_TIME + 1] - ts[MK_TIME], t0 = __builtin_amdgcn_s_memrealtime();
        while (__builtin_amdgcn_s_memrealtime() - t0 < d) __builtin_amdgcn_s_sleep(8); }
#undef IN
#undef SEAM
#undef SSQ
#undef HB
#undef MIX
#undef HH
#undef PHASE_BEGIN
}

template <int PM> static void launch_pm(int grid, hipStream_t stream, const Args& a) { hipLaunchKernelGGL(yoco_fwd<PM>, dim3(grid), dim3(NWAVES * 64), LDS_BYTES, stream, a); }
template <int PM> static bool set_lds() { return hipFuncSetAttribute((const void*)yoco_fwd<PM>, hipFuncAttributeMaxDynamicSharedMemorySize, LDS_BYTES) == hipSuccess; }
extern "C" void kernel_launch(void* const* d_in, const int* in_sizes, int n_in, void* d_out, int out_size, void* d_ws, size_t ws_size, hipStream_t stream) {
    static int grid = 0;
    if (grid == 0) {
        if (n_in != N_IN || (size_t)out_size != O_END || ws_size < WS_END) { fprintf(stderr, "kernel_launch: unexpected shapes (n_in %d, out %d, ws %zu < %zu)\n", n_in, out_size, ws_size, (size_t)WS_END); grid = -1; return; }
        int dev = 0, cus = 0;
        if (hipGetDevice(&dev) != hipSuccess || hipDeviceGetAttribute(&cus, hipDeviceAttributeMultiprocessorCount, dev) != hipSuccess) { grid = -1; return; }
        bool ok = true;
#if MK_ONE_LAUNCH
        ok = set_lds<0x1fff>();
#else
        ok = set_lds<1>() && set_lds<2>() && set_lds<4>() && set_lds<8>() && set_lds<16>() && set_lds<32>() && set_lds<64>() && set_lds<128>() && set_lds<256>() && set_lds<512>() && set_lds<1024>() && set_lds<2048>() && set_lds<4096>();
#endif
        if (!ok) { grid = -1; return; }
        (void)hipGetLastError();
        grid = cus;
    }
    if (grid < 0) return;
    (void)hipMemsetAsync((char*)d_ws + WS_CTL, 0, CTL_ZERO_BYTES, stream);
    Args a{};
    for (int i = 0; i < N_IN; ++i) a.in[i] = (const float*)d_in[i];
    a.out = (float*)d_out; a.ws = (unsigned char*)d_ws;
#if MK_ONE_LAUNCH
    a.ph_lo = 0; a.ph_hi = N_PHASES; launch_pm<0x1fff>(grid, stream, a);
#else
#define LP(p) a.ph_lo = (p); a.ph_hi = (p) + 1; launch_pm<(1 << (p))>(grid, stream, a);
    LP(0) LP(1) LP(2) LP(3) LP(4) LP(5) LP(6) LP(7) LP(8) LP(9) LP(10) LP(11) LP(12)
#undef LP
#endif
}
```

```cpp
#include <hip/hip_runtime.h>
#include <cstdio>
#include <cstdint>
namespace pg8 {
#define PG8_LAS __attribute__((address_space(3)))
typedef unsigned short bf16_t;
typedef short bf16x8 __attribute__((ext_vector_type(8)));
typedef float f32x4 __attribute__((ext_vector_type(4)));
typedef unsigned u32x4 __attribute__((ext_vector_type(4)));
constexpr int BM = 256, BK = 64, HALF = 128, HTB = HALF * BK * 2  , STAGE_BYTES = 8 * HTB, NXCD = 8, WGM = 8;

__host__ __device__ __forceinline__ int lds_byte(int r, int c) { const int st = (r >> 4) * 2 + (c >> 5), rr = r & 15, cc = c & 31, ob = rr * 64 + cc * 2; return st * 1024 + (ob ^ (((ob >> 9) & 1) << 5)); }
__host__ __device__ __forceinline__ void stage_rc(int b, int& R, int& C) { const int st = b / 1024, sb = b % 1024, swz = sb ^ (((sb >> 9) & 1) << 5); R = (st >> 1) * 16 + swz / 64; C = (st & 1) * 32 + (swz % 64) / 2; }
__host__ __device__ __forceinline__ int perm32(int rho) { const int n = rho >> 4, i = rho & 15; return 8 * (i >> 2) + 4 * n + (i & 3); }

struct Unit { int pm, pn, kt0, nt; };
struct Gemm { const bf16_t* A; const bf16_t* Bt; int M, N, K; };

struct StaticOrder {
    int nM, nN, nwg, G, c, ntf;
    __host__ __device__ void init(int M, int N, int G_, int c_, int K_) { nM = M / BM; nN = N / BM; nwg = nM * nN; G = G_; c = c_; ntf = K_ / BK; }
    __host__ __device__ bool next(int i, Unit& u) const {
        const long L = (long)i * G + c; if (L >= nwg) return false;
        int wgid = (int)L; { const int q = nwg / NXCD, r = nwg % NXCD, xcd = wgid % NXCD, off = wgid / NXCD; wgid = (xcd < r ? xcd * (q + 1) : r * (q + 1) + (xcd - r) * q) + off; }
        const int nig = WGM * nN, gid = wgid / nig, fm = gid * WGM, gsz = (nM - fm) < WGM ? (nM - fm) : WGM;
        u.pm = fm + ((wgid % nig) % gsz); u.pn = (wgid % nig) / gsz; u.kt0 = 0; u.nt = ntf; return true;
    }
    __device__ __forceinline__ void a_ready(const Unit&) const {}
    __device__ __forceinline__ void done(const Unit&) const {}
};
struct TailOrder {
    StaticOrder P; int S, ntf;
    __host__ __device__ void init(int G_, int c_, int K_, int S_) { P.init(64 * BM, 4 * BM, G_, c_, K_); S = S_; ntf = K_ / BK; }
    __host__ __device__ bool next(int i, Unit& u) const {
        const long L = (long)i * P.G + P.c; if (L >= 256 + 8 * S) return false;
        const int Li = (int)L; const bool prm = Li < 256;
        const int w0 = prm ? Li : 0, wg = (w0 % NXCD) * (256 / NXCD) + w0 / NXCD, nig = WGM * 4, gid = wg / nig, fm = gid * WGM;
        const int pmP = fm + ((wg % nig) % WGM), pnP = (wg % nig) / WGM;
        const int Ls = prm ? 0 : Li - 256, tile = Ls / S, sl = Ls % S, nts = ntf / S;
        u.pm = prm ? pmP : 64 + (tile >> 2); u.pn = prm ? pnP : (tile & 3); u.nt = prm ? ntf : nts; u.kt0 = prm ? 0 : sl * nts; return true;
    }
    __device__ __forceinline__ void a_ready(const Unit&) const {}
    __device__ __forceinline__ void done(const Unit&) const {}
};


typedef float f32x2_t __attribute__((ext_vector_type(2))); typedef __bf16 bf16x2_t __attribute__((ext_vector_type(2)));
__device__ __forceinline__ unsigned cvt_pk_bf16(float lo, float hi) { f32x2_t v = {lo, hi}; bf16x2_t b = __builtin_convertvector(v, bf16x2_t); return __builtin_bit_cast(unsigned, b); }
__device__ __forceinline__ u32x4 pack8(f32x4 v0, f32x4 v1) { u32x4 w; w.x = cvt_pk_bf16(v0[0], v0[1]); w.y = cvt_pk_bf16(v0[2], v0[3]); w.z = cvt_pk_bf16(v1[0], v1[1]); w.w = cvt_pk_bf16(v1[2], v1[3]); return w; }

template <int M> __device__ __forceinline__ float swz_xor(float v) { return __int_as_float(__builtin_amdgcn_ds_swizzle(__float_as_int(v), (M << 10) | 0x1f)); }
__device__ __forceinline__ float add_x32(float v) { auto r = __builtin_amdgcn_permlane32_swap(__float_as_uint(v), __float_as_uint(v), false, false); return __uint_as_float(r[0]) + __uint_as_float(r[1]); }
__device__ __forceinline__ float max_x32(float v) { auto r = __builtin_amdgcn_permlane32_swap(__float_as_uint(v), __float_as_uint(v), false, false); return fmaxf(__uint_as_float(r[0]), __uint_as_float(r[1])); }
__device__ __forceinline__ float add_x16(float v) { return v + swz_xor<16>(v); }
template <int CTRL> __device__ __forceinline__ float dpp_mov(float v) { return __int_as_float(__builtin_amdgcn_update_dpp(0, __float_as_int(v), CTRL, 0xf, 0xf, false)); }
__device__ __forceinline__ float sum16_dpp(float v) { v += dpp_mov<0xB1>(v); v += dpp_mov<0x4E>(v); v += dpp_mov<0x141>(v); v += dpp_mov<0x140>(v); return v; }
__device__ __forceinline__ float max16_dpp(float v) { v = fmaxf(v, dpp_mov<0xB1>(v)); v = fmaxf(v, dpp_mov<0x4E>(v)); v = fmaxf(v, dpp_mov<0x141>(v)); v = fmaxf(v, dpp_mov<0x140>(v)); return v; }
__device__ __forceinline__ float sum4_dpp(float v) { v += dpp_mov<0xB1>(v); v += dpp_mov<0x4E>(v); return v; }
__device__ __forceinline__ float hsum4(f32x4 a) { return (a[0] + a[1]) + (a[2] + a[3]); }
__device__ __forceinline__ float row_rstd(const float* ssq, int row) {
    const f32x4* p = (const f32x4*)(ssq + (size_t)row * 16);
    const f32x4 a = p[0], b = p[1], c = p[2], d = p[3];
    const float s = (hsum4(a) + hsum4(b)) + (hsum4(c) + hsum4(d));
    return rsqrtf(s * (1.0f / 1024.0f) + 1e-6f);
}
template <int ACT> struct EpiScaleBf16 {
    static constexpr bool PERM = true, AFTER_DRAIN = false;
    bf16_t* O; int ldc; const float* ssq;
    __device__ __forceinline__ void operator()(const f32x4 (&acc)[2][2][4][2], const Unit& u, int wr, int wc, int fr_, int fq_) const {
        int fr = fr_, fq = fq_; asm volatile("" : "+v"(fr), "+v"(fq));
        const int row0 = u.pm * BM + wr * 64 + fr, col0 = u.pn * BM + wc * 32 + 8 * fq;
#pragma unroll
        for (int ai = 0; ai < 2; ++ai)
#pragma unroll
            for (int m = 0; m < 4; ++m) { const int row = row0 + ai * HALF + m * 16; const float rs = row_rstd(ssq, row); bf16_t* rowp = O + (size_t)row * ldc + col0;
#pragma unroll
                for (int bj = 0; bj < 2; ++bj) { f32x4 v0 = acc[ai][bj][m][0] * rs, v1 = acc[ai][bj][m][1] * rs;
                    if (ACT == 1) {
#pragma unroll
                        for (int e = 0; e < 4; ++e) { const float a = fmaxf(v0[e], 0.f), b = fmaxf(v1[e], 0.f); v0[e] = a * a; v1[e] = b * b; } }
                    *(u32x4*)(rowp + bj * HALF) = pack8(v0, v1); } }
    }
};
struct EpiResid {
    static constexpr bool PERM = true, AFTER_DRAIN = false;
    const float* base; const float* base2; int split; float* out; bf16_t* hb; float* ssq_out; float* slab; int S; const bf16_t* hbase = nullptr; int omask = -1;
    __device__ __forceinline__ void operator()(const f32x4 (&acc)[2][2][4][2], const Unit& u, int wr, int wc, int fr_, int fq_) const {
        int fr = fr_, fq = fq_; asm volatile("" : "+v"(fr), "+v"(fq));
        if (slab && u.pm >= 64) {
            float* sp = slab + ((size_t)((((u.pm - 64) << 2) + u.pn) * S + u.kt0 / u.nt) << 16) + (size_t)(wr * 64 + fr) * 256 + wc * 32 + 8 * fq;
#pragma unroll
            for (int ai = 0; ai < 2; ++ai)
#pragma unroll
                for (int m = 0; m < 4; ++m)
#pragma unroll
                    for (int bj = 0; bj < 2; ++bj) { float* p = sp + (size_t)(ai * HALF + m * 16) * 256 + bj * HALF; *(f32x4*)p = acc[ai][bj][m][0]; *(f32x4*)(p + 4) = acc[ai][bj][m][1]; }
            return;
        }
        const int row0 = u.pm * BM + wr * 64 + fr, col0 = u.pn * BM + wc * 32 + 8 * fq;
#pragma unroll
        for (int ai = 0; ai < 2; ++ai)
#pragma unroll
            for (int m = 0; m < 4; ++m) { const int row = row0 + ai * HALF + m * 16;
                const float* bp = (row < split ? base + (size_t)row * 1024 : base2 + (size_t)(row - split) * 1024) + col0;
                float ss = 0.f;
#pragma unroll
                for (int bj = 0; bj < 2; ++bj) { f32x4 b0, b1;
                    if (hbase) { const u32x4 w = *(const u32x4*)(hbase + (size_t)row * 1024 + col0 + bj * HALF);
                        b0 = (f32x4){__uint_as_float(w.x << 16), __uint_as_float(w.x & 0xffff0000u), __uint_as_float(w.y << 16), __uint_as_float(w.y & 0xffff0000u)};
                        b1 = (f32x4){__uint_as_float(w.z << 16), __uint_as_float(w.z & 0xffff0000u), __uint_as_float(w.w << 16), __uint_as_float(w.w & 0xffff0000u)}; }
                    else { b0 = *(const f32x4*)(bp + bj * HALF); b1 = *(const f32x4*)(bp + bj * HALF + 4); }
                    const f32x4 h0 = b0 + acc[ai][bj][m][0], h1 = b1 + acc[ai][bj][m][1];
                    if (out) { float* op = out + (size_t)(row & omask) * 1024 + col0; *(f32x4*)(op + bj * HALF) = h0; *(f32x4*)(op + bj * HALF + 4) = h1; }
                    if (hb) *(u32x4*)(hb + (size_t)row * 1024 + col0 + bj * HALF) = pack8(h0, h1);
                    ss += hsum4(h0 * h0) + hsum4(h1 * h1); }
                if (ssq_out) { ss = add_x16(ss); ss = add_x32(ss); if (fq == 0) ssq_out[(size_t)row * 16 + u.pn * 4 + wc] = ss; }
                if (m == 3) asm volatile("" ::: "memory"); }
    }
};
template <class Epi, class Sched, bool ALIGN_EPI = false, bool SP2 = false>
__device__ __forceinline__ void gemm_phase(PG8_LAS unsigned char* lds, const Gemm g, const Sched& S, const Epi& E, int wid_in, int lane_in) {
    const int wid = wid_in, lane = lane_in, tid = wid * 64 + lane, wr = wid >> 2, wc = wid & 3, fr = lane & 15, fq = lane >> 4;
    const int K = g.K;
    unsigned voffA[2], voffB[2];
#pragma unroll
    for (int i = 0; i < 2; ++i) { int R, C; stage_rc(tid * 16 + i * 8192, R, C); const int Rb = Epi::PERM ? ((R & ~31) + perm32(R & 31)) : R;
        voffA[i] = (unsigned)(R * K + C) * 2u; voffB[i] = (unsigned)(Rb * K + C) * 2u; }
    const size_t kstep = (size_t)(BK * 2);
    const size_t hstep = (size_t)HALF * K * 2;
    const size_t tstep = 2 * hstep;
    const unsigned ldsw = (unsigned)wid * 1024u;
    const int aoff = lds_byte(wr * 64 + fr, fq * 8), boff = lds_byte(wc * 32 + fr, fq * 8);
#define PG8_SA(b, h) (((b) * 2 + (h)) * HTB)
#define PG8_SB(b, h) ((4 + (b) * 2 + (h)) * HTB)
#define PG8_STAGE(bufoff, gbase, voff) do { _Pragma("unroll") for (int _i = 0; _i < 2; ++_i) \
        __builtin_amdgcn_global_load_lds((const unsigned*)((const char*)(gbase) + (voff)[_i]), (PG8_LAS unsigned*)(lds + (bufoff) + ldsw + _i * 8192), 16, 0, 0); } while (0)
#define PG8_LDA(dst, b, h) do { _Pragma("unroll") for (int m = 0; m < 4; ++m) _Pragma("unroll") for (int k = 0; k < 2; ++k) dst[m][k] = *(const PG8_LAS bf16x8*)(lds + PG8_SA(b, h) + aoff + m * 2048 + k * 1024); } while (0)
#define PG8_LDB(dst, b, h) do { _Pragma("unroll") for (int n = 0; n < 2; ++n) _Pragma("unroll") for (int k = 0; k < 2; ++k) dst[n][k] = *(const PG8_LAS bf16x8*)(lds + PG8_SB(b, h) + boff + n * 2048 + k * 1024); } while (0)
#define PG8_MMA(ai, bj, At, Bt) do { __builtin_amdgcn_s_setprio(1); _Pragma("unroll") for (int m = 0; m < 4; ++m) _Pragma("unroll") for (int n = 0; n < 2; ++n) _Pragma("unroll") for (int k = 0; k < 2; ++k) \
        acc[ai][bj][m][n] = __builtin_amdgcn_mfma_f32_16x16x32_bf16(Bt[n][k], At[m][k], acc[ai][bj][m][n], 0, 0, 0); __builtin_amdgcn_s_setprio(0); } while (0)
#define PG8_WAIT_V(n) asm volatile("s_waitcnt vmcnt(" #n ")" ::: "memory")
#define PG8_WAIT_L(n) asm volatile("s_waitcnt lgkmcnt(" #n ")" ::: "memory")
#define PG8_BAR __builtin_amdgcn_s_barrier()
#define PG8_SCHED __builtin_amdgcn_sched_barrier(0)
    Unit cur, nxt; int ui = 0;
    if (!S.next(0, cur)) return;
    f32x4 acc[2][2][4][2];
#pragma unroll
    for (int a = 0; a < 2; ++a)
#pragma unroll
        for (int b = 0; b < 2; ++b)
#pragma unroll
            for (int m = 0; m < 4; ++m)
#pragma unroll
                for (int n = 0; n < 2; ++n) acc[a][b][m][n] = (f32x4){0.f, 0.f, 0.f, 0.f};
    bf16x8 At[4][2], B0[2][2], B1[2][2];
    const char* cA = (const char*)g.A + (size_t)cur.pm * tstep + (size_t)cur.kt0 * kstep; const char* cB = (const char*)g.Bt + (size_t)cur.pn * tstep + (size_t)cur.kt0 * kstep;
    S.a_ready(cur);
    if constexpr (SP2) {
        PG8_STAGE(PG8_SB(0, 0), cB, voffB); PG8_STAGE(PG8_SB(0, 1), cB + hstep, voffB); PG8_STAGE(PG8_SA(0, 0), cA, voffA); PG8_STAGE(PG8_SA(0, 1), cA + hstep, voffA);
        if (wr == 1) PG8_BAR;
        PG8_WAIT_V(2); PG8_BAR;
        PG8_STAGE(PG8_SB(1, 0), cB + kstep, voffB); PG8_STAGE(PG8_SA(1, 0), cA + kstep, voffA); PG8_STAGE(PG8_SB(1, 1), cB + hstep + kstep, voffB);
        PG8_WAIT_V(6); PG8_BAR;
    } else {
        PG8_STAGE(PG8_SB(0, 0), cB, voffB); PG8_STAGE(PG8_SA(0, 0), cA, voffA); PG8_STAGE(PG8_SB(0, 1), cB + hstep, voffB); PG8_STAGE(PG8_SA(0, 1), cA + hstep, voffA);
        if (wr == 1) PG8_BAR;
        PG8_WAIT_V(4); PG8_BAR;
        PG8_STAGE(PG8_SB(1, 0), cB + kstep, voffB); PG8_STAGE(PG8_SA(1, 0), cA + kstep, voffA); PG8_STAGE(PG8_SB(1, 1), cB + hstep + kstep, voffB);
        PG8_WAIT_V(6); PG8_BAR;
    }
    for (;;) {
        const bool has_next = S.next(ui + 1, nxt);
        const char* nA = has_next ? (const char*)g.A + (size_t)nxt.pm * tstep + (size_t)nxt.kt0 * kstep : cA; const char* nB = has_next ? (const char*)g.Bt + (size_t)nxt.pn * tstep + (size_t)nxt.kt0 * kstep : cB;
        const int nt = cur.nt;
        for (int t = 0; t < nt; t += 2) {
            const bool last = (t == nt - 2);
            const char* a1 = cA + (size_t)(t + 1) * kstep;
            const char* a2 = last ? nA : cA + (size_t)(t + 2) * kstep; const char* b2 = last ? nB : cB + (size_t)(t + 2) * kstep;
            const char* a3 = a2 + kstep; const char* b3 = b2 + kstep;
            if (last && has_next) S.a_ready(nxt);
            if constexpr (SP2) {
            PG8_LDB(B0, 0, 0); PG8_LDB(B1, 0, 1); PG8_SCHED; PG8_LDA(At, 0, 0); PG8_STAGE(PG8_SA(1, 1), a1 + hstep, voffA);
            PG8_WAIT_V(8); PG8_WAIT_L(0); PG8_BAR; PG8_MMA(0, 0, At, B0); PG8_MMA(0, 1, At, B1); PG8_BAR; PG8_SCHED;
            PG8_LDA(At, 0, 1); PG8_STAGE(PG8_SB(0, 0), b2, voffB); PG8_STAGE(PG8_SB(0, 1), b2 + hstep, voffB); PG8_STAGE(PG8_SA(0, 0), a2, voffA);
            PG8_WAIT_V(8); PG8_WAIT_L(0); PG8_BAR; PG8_MMA(1, 0, At, B0); PG8_MMA(1, 1, At, B1); PG8_BAR; PG8_SCHED;
            PG8_LDB(B0, 1, 0); PG8_LDB(B1, 1, 1); PG8_SCHED; PG8_LDA(At, 1, 0); PG8_STAGE(PG8_SA(0, 1), a2 + hstep, voffA);
            PG8_WAIT_V(8); PG8_WAIT_L(0); PG8_BAR; PG8_MMA(0, 0, At, B0); PG8_MMA(0, 1, At, B1); PG8_BAR; PG8_SCHED;
            PG8_LDA(At, 1, 1); PG8_STAGE(PG8_SB(1, 0), b3, voffB); PG8_STAGE(PG8_SB(1, 1), b3 + hstep, voffB); PG8_STAGE(PG8_SA(1, 0), a3, voffA);
            PG8_WAIT_V(8); PG8_WAIT_L(0); PG8_BAR; PG8_MMA(1, 0, At, B0); PG8_MMA(1, 1, At, B1); PG8_BAR; PG8_SCHED;
            } else {
            PG8_LDB(B0, 0, 0); PG8_SCHED; PG8_LDA(At, 0, 0); PG8_STAGE(PG8_SA(1, 1), a1 + hstep, voffA);
            PG8_WAIT_L(8); PG8_BAR; PG8_WAIT_L(0); PG8_MMA(0, 0, At, B0); PG8_BAR; PG8_SCHED;
            PG8_LDB(B1, 0, 1); PG8_STAGE(PG8_SB(0, 0), b2, voffB);
            PG8_BAR; PG8_WAIT_L(0); PG8_MMA(0, 1, At, B1); PG8_BAR;
            PG8_LDA(At, 0, 1); PG8_STAGE(PG8_SA(0, 0), a2, voffA);
            PG8_BAR; PG8_WAIT_L(0); PG8_MMA(1, 0, At, B0); PG8_BAR; PG8_SCHED;
            PG8_STAGE(PG8_SB(0, 1), b2 + hstep, voffB);
            PG8_WAIT_V(6); PG8_BAR; PG8_MMA(1, 1, At, B1); PG8_BAR;
            PG8_LDB(B0, 1, 0); PG8_SCHED; PG8_LDA(At, 1, 0); PG8_STAGE(PG8_SA(0, 1), a2 + hstep, voffA);
            PG8_WAIT_L(8); PG8_BAR; PG8_WAIT_L(0); PG8_MMA(0, 0, At, B0); PG8_BAR; PG8_SCHED;
            PG8_LDB(B1, 1, 1); PG8_STAGE(PG8_SB(1, 0), b3, voffB);
            PG8_BAR; PG8_WAIT_L(0); PG8_MMA(0, 1, At, B1); PG8_BAR;
            PG8_LDA(At, 1, 1); PG8_STAGE(PG8_SA(1, 0), a3, voffA);
            PG8_BAR; PG8_WAIT_L(0); PG8_MMA(1, 0, At, B0); PG8_BAR; PG8_SCHED;
            PG8_STAGE(PG8_SB(1, 1), b3 + hstep, voffB);
            PG8_WAIT_V(6); PG8_BAR; PG8_MMA(1, 1, At, B1); PG8_BAR;
            }
        }
        if constexpr (ALIGN_EPI) { if (wr == 0) PG8_BAR; }
        if constexpr (!Epi::AFTER_DRAIN) { E(acc, cur, wr, wc, fr, fq); S.done(cur); }
        if (!has_next) break;
#pragma unroll
        for (int a = 0; a < 2; ++a)
#pragma unroll
            for (int b = 0; b < 2; ++b)
#pragma unroll
                for (int m = 0; m < 4; ++m)
#pragma unroll
                    for (int n = 0; n < 2; ++n) acc[a][b][m][n] = (f32x4){0.f, 0.f, 0.f, 0.f};
        cur = nxt; cA = nA; cB = nB; ++ui;
        if constexpr (ALIGN_EPI) { if (wr == 1) PG8_BAR; }
    }
    PG8_WAIT_V(0);
    if constexpr (!ALIGN_EPI) { if (wr == 0) PG8_BAR; }
    PG8_BAR;
    if constexpr (Epi::AFTER_DRAIN) { E.fused(acc, cur, wr, wc, fr, fq, lds, wid, lane); S.done(cur); }
#undef PG8_SA
#undef PG8_SB
#undef PG8_STAGE
#undef PG8_LDA
#undef PG8_LDB
#undef PG8_MMA
#undef PG8_WAIT_V
#undef PG8_WAIT_L
#undef PG8_BAR
#undef PG8_SCHED
}
}

constexpr int NWAVES = 8;
#ifndef MK_ONE_LAUNCH
#define MK_ONE_LAUNCH 1
#endif
constexpr int DM = 1024, RP = 16384  , RS = 512  , R = RP + RS, T = 8192, NB = 2, SB = 128, ST = 4;
constexpr int NCOLA = 2816, RWKV_COLS = 2560, NH = 12, HD = 64, FF = 4096, NCOLB = 1536, NMEM = 256;
constexpr int NCHUNK = RP / 64  , NUNIT = NCHUNK * NH  ;
constexpr float C2Q = 0.125f * 1.4426950408889634f;
constexpr float LOG2E = 1.4426950408889634f;
enum { I_XP = 0, I_XS, I_SSHIFT, I_SWKV, I_CSK, I_CSV, I_CMK, I_CMV, I_MEMP, I_NMIX, I_NMLP, I_WOUT, I_WUP, I_WDN, I_MNORM, I_WMKV, I_MQN, I_MKN,
       I_WINA, I_MU, I_WW2, I_W0, I_WA2, I_A0, I_WG2, I_KK, I_KA, I_RK, I_LNW, I_LNB, I_WINB, I_QN, I_SINKS, I_KVN, I_WKV, I_KN, N_IN };
constexpr size_t O_Y = 0, O_PSHIFT = (size_t)R * DM, O_PWKV = O_PSHIFT + 2 * RWKV_COLS, O_PSK = O_PWKV + 2 * 12 * 4096, O_PSV = O_PSK + 2 * 128 * 256,
                 O_PMK = O_PSV + 2 * 128 * 256, O_PMV = O_PMK + 2 * 2 * 256 * 256, O_SSHIFT = O_PMV + 2 * 2 * 256 * 256, O_SWKV = O_SSHIFT + (size_t)SB * RWKV_COLS,
                 O_SSK = O_SWKV + (size_t)SB * 12 * 4096, O_SSV = O_SSK + (size_t)SB * 128 * 256, O_END = O_SSV + (size_t)SB * 128 * 256;
constexpr size_t al256(size_t x) { return (x + 255) & ~(size_t)255; }
constexpr size_t WS_CTL = 0, CTL_ZERO_BYTES = 1u << 15;
constexpr size_t WS_WA = 1u << 20;
constexpr size_t WS_WOUT = WS_WA + (size_t)NCOLA * DM * 2;
constexpr size_t WS_WUP = WS_WOUT + (size_t)2 * DM * DM * 2;
constexpr size_t WS_WDN = WS_WUP + (size_t)2 * FF * DM * 2;
constexpr size_t WS_WB = WS_WDN + (size_t)2 * FF * DM * 2;
constexpr size_t WS_WM = WS_WB + (size_t)NCOLB * DM * 2;
constexpr size_t WS_WW2 = WS_WM + (size_t)DM * DM * 2;
constexpr size_t WS_WA2 = WS_WW2 + (size_t)768 * 64 * 2;
constexpr size_t WS_WG2 = WS_WA2 + (size_t)768 * 64 * 2;
constexpr size_t WS_ROPE = WS_WG2 + (size_t)768 * 128 * 2;
constexpr size_t WS_SSQ = al256(WS_ROPE + (size_t)8196 * 64 * 4);
constexpr size_t WS_SSQM = WS_SSQ + (size_t)R * 16 * 4;
constexpr size_t WS_MB = WS_SSQM + (size_t)512 * 16 * 4;
constexpr size_t WS_MK = WS_MB + (size_t)512 * DM * 2;
constexpr size_t WS_MVT = WS_MK + (size_t)2 * 2 * 4 * 256 * 64 * 2;
constexpr size_t WS_HB = WS_MVT + (size_t)2 * 2 * 4 * 256 * 64 * 2;
constexpr size_t WS_MIX = WS_HB + (size_t)R * DM * 2;
constexpr size_t WS_BIG = WS_MIX + (size_t)R * DM * 2;
constexpr size_t WS_PROJ = WS_BIG;
constexpr size_t WS_REC = WS_PROJ + (size_t)R * NCOLA * 2;
constexpr size_t REC_BYTES = 5 * 8192;
constexpr size_t WS_END0 = WS_REC + (size_t)NUNIT * REC_BYTES;
constexpr size_t WS_H = WS_BIG;
constexpr size_t WS_END1 = WS_H + (size_t)R * FF * 2;
constexpr size_t WS_SLAB = WS_BIG + ((size_t)160 << 20);
constexpr int S_K1 = 4, S_K4 = 16;
constexpr size_t WS_Q1 = WS_BIG;
constexpr size_t WS_K1 = WS_Q1 + (size_t)R * DM * 2;
constexpr size_t WS_V1 = WS_K1 + (size_t)R * 256 * 2;
constexpr size_t WS_VT1 = WS_V1 + (size_t)R * 256 * 2;
constexpr size_t WS_END = WS_END0 > WS_END1 ? WS_END0 : WS_END1;
static_assert(WS_VT1 + (size_t)2 * 4 * 64 * 8192 * 2 <= WS_END && WS_END1 <= WS_SLAB && WS_SLAB + ((size_t)32 << 20) <= WS_END, "ws map");
constexpr int CW_BAR = 4096;
constexpr int RING_OFF = 0, RING_BYTES = 131072, PREP_HALF = 73728, LDSCTL_OFF = 147456, MISC_OFF = LDSCTL_OFF + 320, WTOT_OFF = LDSCTL_OFF + 1024, LDS_BYTES = LDSCTL_OFF + 4096;

#define GAS __attribute__((address_space(1)))
#define LAS __attribute__((address_space(3)))
typedef unsigned short bf16;
typedef unsigned v4u __attribute__((ext_vector_type(4)));
typedef unsigned v2u __attribute__((ext_vector_type(2)));
typedef float f32x4 __attribute__((ext_vector_type(4)));
typedef float f32x16 __attribute__((ext_vector_type(16)));
typedef short bf16x8 __attribute__((ext_vector_type(8)));
typedef short bf16x4 __attribute__((ext_vector_type(4)));
typedef GAS unsigned gu32;
#define RLX_AGENT __ATOMIC_RELAXED, __HIP_MEMORY_SCOPE_AGENT
#define LDS_WAIT() asm volatile("s_waitcnt lgkmcnt(0)" ::: "memory")
#define VM_WAIT() asm volatile("s_waitcnt vmcnt(0)" ::: "memory")
using pg8::cvt_pk_bf16;
__device__ __forceinline__ int mk_lane() { int l; asm volatile("v_mbcnt_lo_u32_b32 %0, -1, 0\n\tv_mbcnt_hi_u32_b32 %0, -1, %0" : "=v"(l)); return l; }
__device__ __forceinline__ float bf2f(unsigned v) { return __uint_as_float(v << 16); }
__device__ __forceinline__ float bflo(unsigned w) { return __uint_as_float(w << 16); }
__device__ __forceinline__ float bfhi(unsigned w) { return __uint_as_float(w & 0xffff0000u); }
__device__ __forceinline__ bf16 f2bf(float f) { return (bf16)(cvt_pk_bf16(f, 0.f) & 0xffffu); }
__device__ __forceinline__ v2u pack4(f32x4 v) { v2u w; w.x = cvt_pk_bf16(v[0], v[1]); w.y = cvt_pk_bf16(v[2], v[3]); return w; }
__device__ __forceinline__ f32x4 unpack4(v2u w) { return (f32x4){bflo(w.x), bfhi(w.x), bflo(w.y), bfhi(w.y)}; }
__device__ __forceinline__ f32x4 mfma16(bf16x8 a, bf16x8 b, f32x4 c) { return __builtin_amdgcn_mfma_f32_16x16x32_bf16(a, b, c, 0, 0, 0); }
__device__ __forceinline__ f32x16 mfma32(bf16x8 a, bf16x8 b, f32x16 c) { return __builtin_amdgcn_mfma_f32_32x32x16_bf16(a, b, c, 0, 0, 0); }
using pg8::swz_xor; using pg8::add_x32; using pg8::max_x32; using pg8::add_x16; using pg8::sum16_dpp; using pg8::max16_dpp; using pg8::sum4_dpp;
__device__ __forceinline__ float sum16(float v) { return sum16_dpp(v); }
__device__ __forceinline__ float wave_sum(float v) { v = sum16_dpp(v); v = add_x16(v); return add_x32(v); }
__device__ __forceinline__ float wave_max(float v) { v = max16_dpp(v); v = fmaxf(v, swz_xor<16>(v)); return max_x32(v); }
__device__ __forceinline__ float fsigmoid(float x) { return __builtin_amdgcn_rcpf(1.0f + __expf(-x)); }
__device__ __forceinline__ float ftanh(float x) { const float e = __expf(2.0f * x); return 1.0f - 2.0f * __builtin_amdgcn_rcpf(e + 1.0f); }
namespace pg8 {
__device__ __forceinline__ void head_norm(f32x4 (&x)[2][2], const float* gain, int fq) {
    float ss = 0.f;
#pragma unroll
    for (int bj = 0; bj < 2; ++bj)
#pragma unroll
        for (int n = 0; n < 2; ++n) ss += hsum4(x[bj][n] * x[bj][n]);
    ss = add_x16(ss); ss = add_x32(ss);
    const float rs = rsqrtf(ss * (1.0f / 64.0f) + 1e-6f);
#pragma unroll
    for (int bj = 0; bj < 2; ++bj)
#pragma unroll
        for (int n = 0; n < 2; ++n) { const f32x4 g = *(const f32x4*)(gain + 32 * bj + 8 * fq + 4 * n); x[bj][n] = x[bj][n] * rs * g; }
}
__device__ __forceinline__ void head_rope(f32x4 (&x)[2][2], const float* cs  , int fq) {
#pragma unroll
    for (int n = 0; n < 2; ++n) { const f32x4 t0 = *(const f32x4*)(cs + 2 * (8 * fq + 4 * n)), t1 = *(const f32x4*)(cs + 2 * (8 * fq + 4 * n) + 4);
        const f32x4 cc = {t0[0], t0[2], t1[0], t1[2]}, sn = {t0[1], t0[3], t1[1], t1[3]};
        const f32x4 x1 = x[0][n], x2 = x[1][n]; x[0][n] = x1 * cc - x2 * sn; x[1][n] = x2 * cc + x1 * sn; }
}
struct EpiL1 {
    static constexpr bool PERM = true, AFTER_DRAIN = false;
    unsigned char* ws; float* outp; const float* g_q; const float* g_mq; const float* g_k;
    __device__ __forceinline__ void operator()(const f32x4 (&acc)[2][2][4][2], const Unit& u, int wr, int wc, int fr_, int fq_) const {
        int fr = fr_, fq = fq_; asm volatile("" : "+v"(fr), "+v"(fq));
        const float* ssq = (const float*)(ws + WS_SSQ); const float* rope = (const float*)(ws + WS_ROPE); const float c2 = C2Q;
        bf16_t* Q1 = (bf16_t*)(ws + WS_Q1); bf16_t* K1 = (bf16_t*)(ws + WS_K1); bf16_t* V1 = (bf16_t*)(ws + WS_V1);
        float* p_k = outp + O_PSK; float* p_v = outp + O_PSV; float* s_k = outp + O_SSK; float* s_v = outp + O_SSV;
        const int H = u.pn * 4 + wc, row0 = u.pm * BM + wr * 64 + fr;
#pragma unroll
        for (int ai = 0; ai < 2; ++ai)
#pragma unroll
            for (int m = 0; m < 4; ++m) { const int row = row0 + ai * HALF + m * 16; const float rs = row_rstd(ssq, row);
                const int pidx = row < 16384 ? (row & 8191) : 8192 + ((row - 16384) & 3);
                f32x4 x[2][2];
#pragma unroll
                for (int bj = 0; bj < 2; ++bj)
#pragma unroll
                    for (int n = 0; n < 2; ++n) x[bj][n] = acc[ai][bj][m][n] * rs;
                if (H < 16) {
                    head_norm(x, H < 12 ? g_q : g_mq, fq);
                    if (H < 12) head_rope(x, rope + (size_t)pidx * 64, fq);
#pragma unroll
                    for (int bj = 0; bj < 2; ++bj) *(u32x4*)(Q1 + (size_t)row * 1024 + H * 64 + 32 * bj + 8 * fq) = pack8(x[bj][0] * c2, x[bj][1] * c2);
                } else {
                    const int kh = (H - 16) & 3; const bool isk = H < 20;
                    if (isk) { head_norm(x, g_k, fq); head_rope(x, rope + (size_t)pidx * 64, fq); }
                    bf16_t* dst = isk ? K1 : V1;
#pragma unroll
                    for (int bj = 0; bj < 2; ++bj) *(u32x4*)(dst + (size_t)row * 256 + kh * 64 + 32 * bj + 8 * fq) = pack8(x[bj][0], x[bj][1]);
                    float* o = nullptr;
                    if (row < 16384) { const int b = row >> 13, t = row & 8191; if (t >= 8064) o = (isk ? p_k : p_v) + ((size_t)(b * 128 + (t - 8064)) * 4 + kh) * 64; }
                    else { const int b = (row - 16384) >> 2, i = (row - 16384) & 3; o = (isk ? s_k : s_v) + ((size_t)(b * 128 + 124 + i) * 4 + kh) * 64; }
                    if (o) {
#pragma unroll
                        for (int bj = 0; bj < 2; ++bj) { *(f32x4*)(o + 32 * bj + 8 * fq) = x[bj][0]; *(f32x4*)(o + 32 * bj + 8 * fq + 4) = x[bj][1]; } }
                }
                if (m == 3) asm volatile("" ::: "memory");
            }
    }
};
struct EpiMemKV {
    static constexpr bool PERM = true, AFTER_DRAIN = false;
    unsigned char* ws; float* outp; const float* g_k  ;
    __device__ __forceinline__ void operator()(const f32x4 (&acc)[2][2][4][2], const Unit& u, int wr, int wc, int fr_, int fq_) const {
        int fr = fr_, fq = fq_; asm volatile("" : "+v"(fr), "+v"(fq));
        const float* ssq = (const float*)(ws + WS_SSQM); float* p_k = outp + O_PMK; float* p_v = outp + O_PMV; bf16_t* MK = (bf16_t*)(ws + WS_MK)  ; bf16_t* MVT = (bf16_t*)(ws + WS_MVT)  ;
        const int H = u.pn * 4 + wc, l = H >> 3, isv = (H >> 2) & 1, hh = H & 3, row0 = u.pm * BM + wr * 64 + fr;
#pragma unroll
        for (int ai = 0; ai < 2; ++ai)
#pragma unroll
            for (int m = 0; m < 4; ++m) { const int row = row0 + ai * HALF + m * 16; const float rs = row_rstd(ssq, row); const int b = row >> 8, mm = row & 255;
                f32x4 x[2][2];
#pragma unroll
                for (int bj = 0; bj < 2; ++bj)
#pragma unroll
                    for (int n = 0; n < 2; ++n) x[bj][n] = acc[ai][bj][m][n] * rs;
                if (!isv) head_norm(x, g_k + l * 64, fq);
                float* o = (isv ? p_v : p_k) + ((((size_t)l * 2 + b) * 256 + mm) * 4 + hh) * 64;
#pragma unroll
                for (int bj = 0; bj < 2; ++bj) { *(f32x4*)(o + 32 * bj + 8 * fq) = x[bj][0]; *(f32x4*)(o + 32 * bj + 8 * fq + 4) = x[bj][1]; }
                if (!isv) {
#pragma unroll
                    for (int bj = 0; bj < 2; ++bj) *(u32x4*)(MK + ((((size_t)l * 2 + b) * 4 + hh) * 256 + mm) * 64 + 32 * bj + 8 * fq) = pack8(x[bj][0], x[bj][1]);
                } else {
#pragma unroll
                    for (int bj = 0; bj < 2; ++bj)
#pragma unroll
                        for (int n = 0; n < 2; ++n)
#pragma unroll
                            for (int e = 0; e < 4; ++e) { const int d = 32 * bj + 8 * fq + 4 * n + e; MVT[((((size_t)l * 2 + b) * 4 + hh) * 64 + d) * 256 + mm] = (bf16_t)(cvt_pk_bf16(x[bj][n][e], 0.f) & 0xffffu); }
                }
                asm volatile("" ::: "memory");
            }
    }
};
}
#define XB_TMO      128
#define XB_XCNT(j)  (256  + 64 * (j))
#define XB_XSUB(j)  (1280 + 64 * (j))
#define XB_XGEN(j)  (2304 + 64 * (j))
#define XB_TOP      3328
#define XB_TOPGEN   3392
#define XCD_BAR_WORDS 3456
#define XB_SPIN_CAP (1u << 18)

__device__ __forceinline__ unsigned xb_ld(unsigned* p)              { return __hip_atomic_load(p, __ATOMIC_RELAXED, __HIP_MEMORY_SCOPE_AGENT); }
__device__ __forceinline__ unsigned xb_add(unsigned* p, unsigned v) { return __hip_atomic_fetch_add(p, v, __ATOMIC_RELAXED, __HIP_MEMORY_SCOPE_AGENT); }
__device__ __forceinline__ unsigned xb_xcc_id() { return (unsigned)__builtin_amdgcn_s_getreg((3 << 11) | 20) & 0xFu; }
#define XB_SPIN(cond, bar) do { unsigned _sp = 0; while (cond) { __builtin_amdgcn_s_sleep(1); \
    if ((++_sp & 255u) == 0u) { if (xb_ld(&(bar)[XB_TMO])) break; if (_sp > XB_SPIN_CAP) { atomicAdd(&(bar)[XB_TMO], 1u); break; } } } } while (0)

struct XcdBarrier {
    bool wave0;
    unsigned* bar; unsigned x;
    volatile LAS unsigned* st;
};

__device__ __forceinline__ XcdBarrier xcd_barrier_post(unsigned* bar, volatile LAS unsigned* st, bool wave0) {
    XcdBarrier b; b.wave0 = wave0; b.bar = bar; b.x = xb_xcc_id(); b.st = st;
    if (wave0 && mk_lane() == 0) (void)xb_add(&bar[XB_XCNT(b.x)], 1u);
    return b;
}
__device__ __forceinline__ void xcd_barrier_complete(unsigned* bar, unsigned x, unsigned& nloc, unsigned& nx) {
    const unsigned G = gridDim.x * gridDim.y * gridDim.z;
    unsigned sum, cnt, mine, sp = 0u;
    for (;;) {
        sum = 0u; cnt = 0u; mine = 0u;
#pragma unroll
        for (unsigned j = 0; j < 16; ++j) { const unsigned c = xb_ld(&bar[XB_XCNT(j)]); sum += c; cnt += (c > 0u) ? 1u : 0u; mine = (j == x) ? c : mine; }
        if (sum == G) break;
        __builtin_amdgcn_s_sleep(1);
        if ((++sp & 255u) == 0u) { if (xb_ld(&bar[XB_TMO])) break; if (sp > XB_SPIN_CAP) { atomicAdd(&bar[XB_TMO], 1u); break; } }
    }
    nloc = mine > 0u ? mine : 1u; nx = cnt > 0u ? cnt : 1u;
}

__device__ __forceinline__ void xcd_barrier(const XcdBarrier& b) {
    asm volatile("s_waitcnt vmcnt(0)" ::: "memory");
    __syncthreads();
    if (b.wave0 && mk_lane() == 0) {
        unsigned* bar = b.bar;
        __builtin_amdgcn_s_waitcnt(0);
        unsigned nloc = b.st[0], nx = b.st[1];
        if (nloc == 0u) { xcd_barrier_complete(bar, b.x, nloc, nx); b.st[0] = nloc; b.st[1] = nx; }
        const unsigned old = xb_add(&bar[XB_XSUB(b.x)], 1u);
        const unsigned gen = old / nloc;
        if (old + 1u == (gen + 1u) * nloc) {
            __builtin_amdgcn_fence(__ATOMIC_RELEASE, "agent");
            asm volatile("s_waitcnt vmcnt(0)" ::: "memory");
            const unsigned og = xb_add(&bar[XB_TOP], 1u);
            const unsigned tg = og / nx;
            if (og + 1u == (tg + 1u) * nx) xb_add(&bar[XB_TOPGEN], 1u);
            else XB_SPIN(xb_ld(&bar[XB_TOPGEN]) == tg, bar);
            __builtin_amdgcn_fence(__ATOMIC_ACQUIRE, "agent");
            xb_add(&bar[XB_XGEN(b.x)], 1u);
            asm volatile("s_waitcnt vmcnt(0)" ::: "memory");
        } else {
            XB_SPIN(xb_ld(&bar[XB_XGEN(b.x)]) == gen, bar);
            __builtin_amdgcn_fence(__ATOMIC_ACQUIRE, "agent");
            asm volatile("s_waitcnt vmcnt(0)" ::: "memory");
        }
    }
    __syncthreads();
}

struct Args { const float* in[N_IN]; float* out; unsigned char* ws; int ph_lo, ph_hi; };
struct Frame {
    LAS unsigned char* lds; unsigned char* lds_g;
    gu32* ctl;
    int tid, lane, wave, vcu, G;
    const float* const* in; float* out; unsigned char* ws;
};
__host__ __device__ __forceinline__ int wsig_inv(int nl) { return 128 * ((nl >> 5) & 1) + 32 * (nl >> 6) + (nl & 31); }

__device__ __forceinline__ void p0_transpose_item(const float* W, int K, int N, bf16* WT, int row_off, bool sig, const float* gain, LAS float* scr, int item, int lane) {
    const int nblk = N / 32, kb = item / nblk, nb = item % nblk, k0 = 64 * kb, n0 = 32 * nb;
    float tv[32];
#pragma unroll
    for (int i = 0; i < 32; ++i) { const int kk = 2 * i + (lane >> 5); tv[i] = W[(size_t)(k0 + kk) * N + n0 + (lane & 31)]; }
    __builtin_amdgcn_sched_barrier(0);
    if (gain) {
#pragma unroll
        for (int i = 0; i < 32; ++i) tv[i] *= gain[k0 + 2 * i + (lane >> 5)]; }
#pragma unroll
    for (int i = 0; i < 32; ++i) scr[(2 * i + (lane >> 5)) * 33 + (lane & 31)] = tv[i];
    LDS_WAIT(); asm volatile("" ::: "memory");
    const int c = lane & 7;
    int nbase = row_off + n0; if (sig) { const int ng = row_off + n0; nbase = (ng & ~255) + wsig_inv(ng & 255); }
#pragma unroll
    for (int j = 0; j < 4; ++j) { const int n = (lane >> 3) + 8 * j; const LAS float* s = scr + (8 * c) * 33 + n;
        v4u o; o.x = cvt_pk_bf16(s[0 * 33], s[1 * 33]); o.y = cvt_pk_bf16(s[2 * 33], s[3 * 33]); o.z = cvt_pk_bf16(s[4 * 33], s[5 * 33]); o.w = cvt_pk_bf16(s[6 * 33], s[7 * 33]);
        *(GAS v4u*)(WT + (size_t)(nbase + n) * K + k0 + 8 * c) = o; }
    LDS_WAIT(); asm volatile("" ::: "memory");
}
__device__ __forceinline__ void row_to_bf16_ssq(const float* xrow, bf16* orow, float* ssqrow, int lane) {
    const GAS f32x4* xr = (const GAS f32x4*)xrow + lane;
    f32x4 v[4]; float s = 0.f;
#pragma unroll
    for (int j = 0; j < 4; ++j) { v[j] = xr[64 * j]; s += (v[j].x * v[j].x + v[j].y * v[j].y) + (v[j].z * v[j].z + v[j].w * v[j].w); }
    s = wave_sum(s);
    GAS v2u* o8 = (GAS v2u*)orow + lane;
#pragma unroll
    for (int j = 0; j < 4; ++j) o8[64 * j] = pack4(v[j]);
    if (lane < 16) ssqrow[lane] = lane == 0 ? s : 0.f;
}
__device__ __forceinline__ void p0_weights(Frame& F, int part, int gw, int NGW, LAS float* scr) {
    unsigned char* ws = F.ws;
    int it = gw;
#define P0_JOB(Wp, K_, N_, WTp, roff, sg, gn) { const int ni = ((K_) / 64) * ((N_) / 32); for (; it < ni; it += NGW) p0_transpose_item((Wp), (K_), (N_), (WTp), (roff), (sg), (gn), scr, it, F.lane); it -= ni; }
    if (part == 0) {
    P0_JOB(F.in[I_WINA], DM, NCOLA, (bf16*)(ws + WS_WA), 0, false, F.in[I_NMIX]);
    P0_JOB(F.in[I_WMKV], DM, 512, (bf16*)(ws + WS_WM), 0, true, F.in[I_MNORM]);
    P0_JOB(F.in[I_WMKV] + (size_t)DM * 512, DM, 512, (bf16*)(ws + WS_WM), 512, true, F.in[I_MNORM] + DM);
    P0_JOB(F.in[I_WW2], 64, 768, (bf16*)(ws + WS_WW2), 0, false, nullptr);
    P0_JOB(F.in[I_WA2], 64, 768, (bf16*)(ws + WS_WA2), 0, false, nullptr);
    P0_JOB(F.in[I_WG2], 128, 768, (bf16*)(ws + WS_WG2), 0, false, nullptr);
    } else {
    P0_JOB(F.in[I_WOUT], DM, DM, (bf16*)(ws + WS_WOUT), 0, false, nullptr);
    P0_JOB(F.in[I_WUP], DM, FF, (bf16*)(ws + WS_WUP), 0, false, F.in[I_NMLP]);
    P0_JOB(F.in[I_WDN], FF, DM, (bf16*)(ws + WS_WDN), 0, false, nullptr);
    P0_JOB(F.in[I_WINB], DM, DM, (bf16*)(ws + WS_WB), 0, true, F.in[I_NMIX] + DM);
    P0_JOB(F.in[I_WKV], DM, 512, (bf16*)(ws + WS_WB), 1024, true, F.in[I_KVN]);
    P0_JOB(F.in[I_WOUT] + (size_t)DM * DM, DM, DM, (bf16*)(ws + WS_WOUT) + (size_t)DM * DM, 0, false, nullptr);
    P0_JOB(F.in[I_WUP] + (size_t)DM * FF, DM, FF, (bf16*)(ws + WS_WUP) + (size_t)DM * FF, 0, false, F.in[I_NMLP] + DM);
    P0_JOB(F.in[I_WDN] + (size_t)DM * FF, FF, DM, (bf16*)(ws + WS_WDN) + (size_t)DM * FF, 0, false, nullptr);
    }
#undef P0_JOB
}
__device__ __forceinline__ void p0_prologue(Frame& F) {
    LAS float* scr = (LAS float*)(F.lds + RING_OFF + F.wave * 16384);
    const int gw = F.vcu * NWAVES + F.wave, NGW = F.G * NWAVES;
    unsigned char* ws = F.ws;
    p0_weights(F, 0, gw, NGW, scr);
    for (int m = gw; m < R; m += NGW) { const float* xr = m < RP ? F.in[I_XP] + (size_t)m * DM : F.in[I_XS] + (size_t)(m - RP) * DM;
        row_to_bf16_ssq(xr, (bf16*)(ws + WS_HB) + (size_t)m * DM, (float*)(ws + WS_SSQ) + (size_t)m * 16, F.lane); }
    for (int m = gw; m < 512; m += NGW) row_to_bf16_ssq(F.in[I_MEMP] + (size_t)m * DM, (bf16*)(ws + WS_MB) + (size_t)m * DM, (float*)(ws + WS_SSQM) + (size_t)m * 16, F.lane);
    { const int gt = F.vcu * NWAVES * 64 + F.tid, NGT = F.G * NWAVES * 64; float* rt = (float*)(ws + WS_ROPE);
      for (int i = gt; i < 8196 * 32; i += NGT) { const int p = i >> 5, f = i & 31; const float pos = (float)(p < 8192 ? p : 16384 + (p - 8192));
          double fq_ = 1.0; for (int k = 0; k < f; ++k) fq_ *= 0.74989420933245582730; const float ang = pos * (float)fq_; const double rev = (double)ang * 0.15915494309189535; const float fr = (float)(rev - floor(rev));
          rt[2 * i] = __builtin_amdgcn_cosf(fr); rt[2 * i + 1] = __builtin_amdgcn_sinf(fr); } }
}

__device__ __forceinline__ void finalize_sample(Frame& F, const float* fbase  , int S, bool last) {
    const int gw = F.vcu * NWAVES + F.wave, NGW = F.G * NWAVES; const float* slab = (const float*)(F.ws + WS_SLAB);
    for (int rs = gw; rs < RS; rs += NGW) { const int row = RP + rs, tile0 = (rs >> 8) << 2, r = rs & 255; float ss = 0.f;
#pragma unroll
        for (int pn = 0; pn < 4; ++pn) { f32x4 h;
            if (fbase) h = *(const GAS f32x4*)(fbase + (size_t)rs * DM + pn * 256 + 4 * F.lane);
            else h = unpack4(*(const GAS v2u*)((const bf16*)(F.ws + WS_HB) + (size_t)row * DM + pn * 256 + 4 * F.lane));
            for (int s0 = 0; s0 < S; s0 += 4) { f32x4 pv[4];
#pragma unroll
                for (int s = 0; s < 4; ++s) pv[s] = *(const GAS f32x4*)(slab + ((size_t)((tile0 + pn) * S + s0 + s) << 16) + r * 256 + 4 * F.lane);
                __builtin_amdgcn_sched_barrier(0);
                h += (pv[0] + pv[1]) + (pv[2] + pv[3]); }
            if (last) *(GAS f32x4*)(F.out + O_Y + (size_t)row * DM + pn * 256 + 4 * F.lane) = h;
            else *(GAS v2u*)((bf16*)(F.ws + WS_HB) + (size_t)row * DM + pn * 256 + 4 * F.lane) = pack4(h);
            ss += (h[0] * h[0] + h[1] * h[1]) + (h[2] * h[2] + h[3] * h[3]); }
        if (!last) { ss = wave_sum(ss); if (F.lane < 16) ((float*)(F.ws + WS_SSQ))[(size_t)row * 16 + F.lane] = F.lane == 0 ? ss : 0.f; } }
}

__device__ __forceinline__ void copy_window_cache(Frame& F, int gt, int NGT) {
    const int per = 124 * 256 / 4;
    for (int i = gt; i < SB * per; i += NGT) { const int b = i / per, r = i % per;
        ((GAS f32x4*)(F.out + O_SSK + (size_t)b * 128 * 256))[r] = ((const GAS f32x4*)(F.in[I_CSK] + (size_t)b * 128 * 256 + 4 * 256))[r];
        ((GAS f32x4*)(F.out + O_SSV + (size_t)b * 128 * 256))[r] = ((const GAS f32x4*)(F.in[I_CSV] + (size_t)b * 128 * 256 + 4 * 256))[r]; }
}

constexpr int LSTR = 144, SLOT = 64 * LSTR;
__device__ __forceinline__ int rec_index(int chunk, int h) { return ((chunk >> 7) * NH + h) * 128 + (chunk & 127); }
constexpr int REC_PT = 0, REC_QS = 8192, REC_RY = 16384, REC_YL = 24576, REC_BV = 32768;
__device__ __forceinline__ bf16x8 lfrag(const LAS unsigned char* m, int row, int k) { return *(const LAS bf16x8*)(m + row * LSTR + k * 2); }
__device__ __forceinline__ void mm_strip(f32x4 (&acc)[4], const LAS unsigned char* X, const LAS unsigned char* Y, int w, int c, int g) {
#pragma unroll
    for (int ks = 0; ks < 2; ++ks) { const bf16x8 a = lfrag(X, 16 * w + c, 32 * ks + 8 * g);
#pragma unroll
        for (int n = 0; n < 4; ++n) acc[n] = mfma16(a, lfrag(Y, 16 * n + c, 32 * ks + 8 * g), acc[n]); }
}
__device__ __forceinline__ void mm_strip2(f32x4 (&acc0)[4], f32x4 (&acc1)[4], const LAS unsigned char* X, const LAS unsigned char* Y0, const LAS unsigned char* Y1, int w, int c, int g) {
#pragma unroll
    for (int ks = 0; ks < 2; ++ks) { const bf16x8 a = lfrag(X, 16 * w + c, 32 * ks + 8 * g);
#pragma unroll
        for (int n = 0; n < 4; ++n) { acc0[n] = mfma16(a, lfrag(Y0, 16 * n + c, 32 * ks + 8 * g), acc0[n]); acc1[n] = mfma16(a, lfrag(Y1, 16 * n + c, 32 * ks + 8 * g), acc1[n]); } }
}
__device__ __forceinline__ void zero4(f32x4 (&a)[4]) {
#pragma unroll
    for (int n = 0; n < 4; ++n) a[n] = (f32x4){0.f, 0.f, 0.f, 0.f};
}
__device__ __forceinline__ void st_T(LAS unsigned char* dest, const f32x4 (&acc)[4], int w, int c, int g) {
#pragma unroll
    for (int n = 0; n < 4; ++n) *(LAS v2u*)(dest + (16 * n + c) * LSTR + (16 * w + 4 * g) * 2) = pack4(acc[n]);
}
__device__ __forceinline__ void st_T_global(unsigned char* dest  , const f32x4 (&acc)[4], int w, int c, int g) {
#pragma unroll
    for (int n = 0; n < 4; ++n) *(GAS v2u*)(dest + (16 * n + c) * 128 + (16 * w + 4 * g) * 2) = pack4(acc[n]);
}
__device__ __forceinline__ void load_shift8(const bf16* cur, const bf16* prv, const float* mu, float (&o)[8]) {
    const v4u cw = *(const GAS v4u*)cur; v4u pw = {0u, 0u, 0u, 0u}; if (prv) pw = *(const GAS v4u*)prv;
    const f32x4 m0 = *(const GAS f32x4*)mu, m1 = *(const GAS f32x4*)(mu + 4);
    const float cf[8] = {bflo(cw.x), bfhi(cw.x), bflo(cw.y), bfhi(cw.y), bflo(cw.z), bfhi(cw.z), bflo(cw.w), bfhi(cw.w)};
    const float pf[8] = {bflo(pw.x), bfhi(pw.x), bflo(pw.y), bfhi(pw.y), bflo(pw.z), bfhi(pw.z), bflo(pw.w), bfhi(pw.w)};
    const float mf[8] = {m0[0], m0[1], m0[2], m0[3], m1[0], m1[1], m1[2], m1[3]};
#pragma unroll
    for (int i = 0; i < 8; ++i) o[i] = cf[i] + (pf[i] - cf[i]) * mf[i];
}
__device__ __forceinline__ bf16x8 pack_frag(const float (&v)[8]) {
    v4u w; w.x = cvt_pk_bf16(v[0], v[1]); w.y = cvt_pk_bf16(v[2], v[3]); w.z = cvt_pk_bf16(v[4], v[5]); w.w = cvt_pk_bf16(v[6], v[7]); return __builtin_bit_cast(bf16x8, w);
}

struct PrepPf { v4u raw[3][2]; v4u prv; };
__device__ __forceinline__ void prep_issue(Frame& F, int unit, PrepPf& pf) {
    const int th = (F.wave & 3) * 64 + F.lane; const int chunk = unit / NH, h = unit % NH, row0 = chunk * 64; const bool first = (chunk & 127) == 0;
    const bf16* proj = (const bf16*)(F.ws + WS_PROJ);
#pragma unroll
    for (int a = 0; a < 3; ++a)
#pragma unroll
        for (int i = 0; i < 2; ++i) { const int id = th + 256 * i; pf.raw[a][i] = *(const GAS v4u*)(proj + (size_t)(row0 + (id >> 3)) * NCOLA + a * 768 + h * 64 + (id & 7) * 8); }
    pf.prv = (v4u){0u, 0u, 0u, 0u};
    if (th < 24 && !first) pf.prv = *(const GAS v4u*)(proj + (size_t)(row0 - 1) * NCOLA + (th >> 3) * 768 + h * 64 + (th & 7) * 8);
}
__device__ __forceinline__ void shift8(v4u cw, v4u pw, const float* mu, float (&o)[8]) {
    const f32x4 m0 = *(const GAS f32x4*)mu, m1 = *(const GAS f32x4*)(mu + 4);
    const float cf[8] = {bflo(cw.x), bfhi(cw.x), bflo(cw.y), bfhi(cw.y), bflo(cw.z), bfhi(cw.z), bflo(cw.w), bfhi(cw.w)};
    const float pf_[8] = {bflo(pw.x), bfhi(pw.x), bflo(pw.y), bfhi(pw.y), bflo(pw.z), bfhi(pw.z), bflo(pw.w), bfhi(pw.w)};
    const float mf[8] = {m0[0], m0[1], m0[2], m0[3], m1[0], m1[1], m1[2], m1[3]};
#pragma unroll
    for (int i = 0; i < 8; ++i) o[i] = cf[i] + (pf_[i] - cf[i]) * mf[i];
}
#define HBAR() do { asm volatile("s_waitcnt lgkmcnt(0)" ::: "memory"); __builtin_amdgcn_s_barrier(); asm volatile("" ::: "memory"); } while (0)
__device__ __forceinline__ void rwkv_prep_unit(Frame& F, int unit, LAS unsigned char* hb, LAS float* wtot, LAS unsigned char* prow, PrepPf& pf, bool has_next, int next_unit, int stage_limit = 99) {
    int w_ = F.wave & 3, lane_ = F.lane; asm volatile("" : "+s"(w_), "+v"(lane_));
    const int w = w_, lane = lane_, g = lane >> 4, c = lane & 15;
    const int chunk = unit / NH, h = unit % NH, row0 = chunk * 64; const bool first = (chunk & 127) == 0;
    const bf16* proj = (const bf16*)(F.ws + WS_PROJ);
    unsigned char* rec = F.ws + WS_REC + (size_t)rec_index(chunk, h) * REC_BYTES;
    LAS unsigned char* const s0 = hb, * const s1 = hb + SLOT, * const s2 = hb + 2 * SLOT, * const s3 = hb + 3 * SLOT, * const s4 = hb + 4 * SLOT, * const s5 = hb + 5 * SLOT, * const s6 = hb + 6 * SLOT, * const s7 = hb + 7 * SLOT;
    float mur[4], muk[4], muv[4], w0[4], a0[4], kkc[4], kac[4], rkc[4];
#pragma unroll
    for (int n = 0; n < 4; ++n) { const int col = h * 64 + 16 * n + c; mur[n] = F.in[I_MU][col]; muk[n] = F.in[I_MU][768 + col]; muv[n] = F.in[I_MU][1536 + col];
        w0[n] = F.in[I_W0][col]; a0[n] = F.in[I_A0][col]; kkc[n] = F.in[I_KK][col]; kac[n] = F.in[I_KA][col]; rkc[n] = F.in[I_RK][col]; }
    f32x4 dw[4], da[4]; zero4(dw); zero4(da);
    { const int th = w * 64 + lane;
#pragma unroll
      for (int a = 0; a < 3; ++a)
#pragma unroll
          for (int i = 0; i < 2; ++i) { const int id = th + 256 * i; *(LAS v4u*)(hb + a * SLOT + (id >> 3) * LSTR + (id & 7) * 16) = pf.raw[a][i]; }
      if (th < 24) *(LAS v4u*)(prow + (th >> 3) * 128 + (th & 7) * 16) = pf.prv; }
    {
        const bf16* Ww2 = (const bf16*)(F.ws + WS_WW2); const bf16* Wa2 = (const bf16*)(F.ws + WS_WA2);
        const int tl = 16 * w + c; const bf16* crl = proj + (size_t)(row0 + tl) * NCOLA; const bool hpl = !(first && tl == 0);
        v4u lc[2][2], lp[2][2];
#pragma unroll
        for (int a = 0; a < 2; ++a)
#pragma unroll
            for (int ks = 0; ks < 2; ++ks) { const int col = 2304 + 64 * a + 32 * ks + 8 * g; lc[a][ks] = *(const GAS v4u*)(crl + col); lp[a][ks] = (v4u){0u, 0u, 0u, 0u}; if (hpl) lp[a][ks] = *(const GAS v4u*)(crl - NCOLA + col); }
#pragma unroll
        for (int ks = 0; ks < 2; ++ks) { const int l0 = 32 * ks + 8 * g; float x[8];
            shift8(lc[0][ks], lp[0][ks], F.in[I_MU] + 2304 + l0, x);
#pragma unroll
            for (int i = 0; i < 8; ++i) x[i] = ftanh(x[i]);
            const bf16x8 aw = pack_frag(x);
            shift8(lc[1][ks], lp[1][ks], F.in[I_MU] + 2368 + l0, x);
            const bf16x8 aa = pack_frag(x);
#pragma unroll
            for (int n = 0; n < 4; ++n) { const size_t wo = (size_t)(h * 64 + 16 * n + c) * 64 + l0;
                dw[n] = mfma16(aw, *(const GAS bf16x8*)(Ww2 + wo), dw[n]); da[n] = mfma16(aa, *(const GAS bf16x8*)(Wa2 + wo), da[n]); } }
    }
    HBAR();
    if (has_next) prep_issue(F, next_unit, pf);
    f32x4 rt[4], kh[4], lw[4], at_[4], bt_[4], kt_[4], bh_[4], vv[4]; float gam[4]; float bon[4] = {0.f, 0.f, 0.f, 0.f}; float ssk[4] = {0.f, 0.f, 0.f, 0.f};
    f32x4 kkr[4], aa_[4], kp[4], rr[4];
    {

        const LAS unsigned char* pbase = (w == 0 && g == 0) ? prow + c * 2 : hb + (16 * w + 4 * g - 1) * LSTR + c * 2; const int pstr = (w == 0 && g == 0) ? 128 : SLOT;
        float rp[4], kpv[4], vp[4];
#pragma unroll
        for (int n = 0; n < 4; ++n) { rp[n] = bf2f(*(const LAS bf16*)(pbase + 32 * n)); kpv[n] = bf2f(*(const LAS bf16*)(pbase + pstr + 32 * n)); vp[n] = bf2f(*(const LAS bf16*)(pbase + 2 * pstr + 32 * n)); }
#pragma unroll
        for (int reg = 0; reg < 4; ++reg) { const int t = 16 * w + 4 * g + reg; const LAS unsigned char* cr = hb + t * LSTR + c * 2;
#pragma unroll
            for (int n = 0; n < 4; ++n) {
                const float r0 = bf2f(*(const LAS bf16*)(cr + 32 * n)), k0 = bf2f(*(const LAS bf16*)(cr + SLOT + 32 * n)), v0 = bf2f(*(const LAS bf16*)(cr + 2 * SLOT + 32 * n));
                const float r1 = rp[n], k1 = kpv[n], v1 = vp[n]; rp[n] = r0; kpv[n] = k0; vp[n] = v0;
                const float r = r0 + (r1 - r0) * mur[n], k = k0 + (k1 - k0) * muk[n], v = v0 + (v1 - v0) * muv[n];
                const float y = -(w0[n] + dw[n][reg]);
                const float sp = fmaxf(y, 0.f) + __logf(1.0f + __expf(-fabsf(y)));
                lw[n][reg] = -__expf(-sp - 0.5f);
                const float a = fsigmoid(a0[n] + da[n][reg]);
                aa_[n][reg] = a; kkr[n][reg] = k * kkc[n]; kp[n][reg] = k * (1.0f + (a - 1.0f) * kac[n]); rr[n][reg] = r; vv[n][reg] = v;
                ssk[reg] += kkr[n][reg] * kkr[n][reg]; bon[reg] += r * kp[n][reg] * rkc[n]; } }
    }
#pragma unroll
    for (int reg = 0; reg < 4; ++reg) { ssk[reg] = sum16(ssk[reg]); bon[reg] = sum16(bon[reg]); ssk[reg] = __builtin_amdgcn_rsqf(fmaxf(ssk[reg], 1e-24f)); }
    f32x4 Lc[4];
#pragma unroll
    for (int n = 0; n < 4; ++n) { f32x4 inc; inc[0] = lw[n][0]; inc[1] = inc[0] + lw[n][1]; inc[2] = inc[1] + lw[n][2]; inc[3] = inc[2] + lw[n][3];
        const float tot = inc[3]; const float t1 = __shfl(tot, (lane - 16) & 63), t2 = __shfl(tot, (lane - 32) & 63), t3 = __shfl(tot, (lane - 48) & 63);
        const float pre = (g >= 1 ? t1 : 0.f) + (g >= 2 ? t2 : 0.f) + (g >= 3 ? t3 : 0.f);
        Lc[n] = inc + pre; if (g == 3) wtot[w * 64 + 16 * n + c] = pre + tot; }
    HBAR();
#pragma unroll
    for (int n = 0; n < 4; ++n) { const int j = 16 * n + c; const float t0 = wtot[j], t1 = wtot[64 + j], t2 = wtot[128 + j], t3 = wtot[192 + j];
        const float base = (w >= 1 ? t0 : 0.f) + (w >= 2 ? t1 : 0.f) + (w >= 3 ? t2 : 0.f); const float LC = (t0 + t1) + (t2 + t3);
        gam[n] = __expf(LC);
#pragma unroll
        for (int reg = 0; reg < 4; ++reg) { const float L = Lc[n][reg] + base; const float eL = __expf(L), eLi = __builtin_amdgcn_rcpf(eL), eP = __expf(L - lw[n][reg]), eC = gam[n] * eLi;
            const float kk = kkr[n][reg] * ssk[reg], bsc = kk * aa_[n][reg];
            at_[n][reg] = -kk * eP; rt[n][reg] = rr[n][reg] * eL; bt_[n][reg] = bsc * eLi; kt_[n][reg] = kp[n][reg] * eLi; bh_[n][reg] = bsc * eC; kh[n][reg] = kp[n][reg] * eC;
            const int t = 16 * w + 4 * g + reg;
            *(LAS bf16*)(s0 + t * LSTR + j * 2) = f2bf(at_[n][reg]); *(LAS bf16*)(s1 + t * LSTR + j * 2) = f2bf(bt_[n][reg]);
            *(LAS bf16*)(s2 + t * LSTR + j * 2) = f2bf(kt_[n][reg]); *(LAS bf16*)(s3 + t * LSTR + j * 2) = f2bf(rt[n][reg]); }
        *(LAS v2u*)(s4 + j * LSTR + (16 * w + 4 * g) * 2) = pack4(at_[n]); *(LAS v2u*)(s5 + j * LSTR + (16 * w + 4 * g) * 2) = pack4(bh_[n]); *(LAS v2u*)(s6 + j * LSTR + (16 * w + 4 * g) * 2) = pack4(vv[n]);
        f32x4 bv;
#pragma unroll
        for (int reg = 0; reg < 4; ++reg) bv[reg] = bon[reg] * vv[n][reg];
        *(GAS v2u*)(rec + REC_BV + ((w * 64 + lane) * 4 + n) * 8) = pack4(bv); }
    HBAR();
    if (stage_limit <= 3) return;
    f32x4 aN[4], aMk[4], aMbr[4], aMkr[4]; zero4(aN); zero4(aMk); zero4(aMbr); zero4(aMkr);
    mm_strip2(aN, aMk, s0, s1, s2, w, c, g);
    mm_strip(aMbr, s1, s3, w, c, g); mm_strip(aMkr, s2, s3, w, c, g);
#pragma unroll
    for (int n = 0; n < 4; ++n)
#pragma unroll
        for (int reg = 0; reg < 4; ++reg) { const int row = 16 * w + 4 * g + reg, col = 16 * n + c;
            if (!(col < row)) { aN[n][reg] = 0.f; aMk[n][reg] = 0.f; } if (!(row <= col)) { aMbr[n][reg] = 0.f; aMkr[n][reg] = 0.f; } }
    HBAR();
    LAS float* Nf = (LAS float*)s0;
#pragma unroll
    for (int n = 0; n < 4; ++n)
#pragma unroll
        for (int reg = 0; reg < 4; ++reg) Nf[(16 * w + 4 * g + reg) * 64 + (c & 3) * 16 + 4 * n + (c >> 2)] = aN[n][reg];
    st_T(s2, aMk, w, c, g);
    st_T(s3, aMbr, w, c, g);
    HBAR();
    {
        const int q = lane & 3, sl = lane >> 2; float cq[16];
#pragma unroll
        for (int k = 0; k < 16; ++k) cq[k] = 0.f;
        for (int t = 0; t < 16 * w; ++t) if (q == 0) *(LAS bf16*)(s7 + t * LSTR + (16 * w + sl) * 2) = (bf16)0;
#pragma unroll
        for (int t = 0; t < 64; ++t) if (t >= 16 * w) {
            float part = 0.f;
#pragma unroll
            for (int k4 = 0; k4 < (t + 15) / 16; ++k4) { const f32x4 nv = *(const LAS f32x4*)(Nf + t * 64 + q * 16 + 4 * k4);
#pragma unroll
                for (int e = 0; e < 4; ++e) if (4 * (4 * k4 + e) < t) part = fmaf(nv[e], cq[4 * k4 + e], part); }
            part = sum4_dpp(part);
            const float val = part + ((t == 16 * w + sl) ? 1.0f : 0.0f);
            cq[t >> 2] = (q == (t & 3)) ? val : cq[t >> 2];
            if (q == 0) *(LAS bf16*)(s7 + t * LSTR + (16 * w + sl) * 2) = f2bf(val);
        }
    }
    HBAR();
    if (stage_limit <= 5) return;
    { f32x4 aW[4], aNk[4]; zero4(aW); zero4(aNk); mm_strip2(aW, aNk, s7, s4, s2, w, c, g); st_T(s0, aW, w, c, g); st_T(s1, aNk, w, c, g); }
    HBAR();
    { f32x4 aP[4]; zero4(aP); mm_strip(aP, s0, s5, w, c, g);
#pragma unroll
      for (int n = 0; n < 4; ++n)
#pragma unroll
          for (int reg = 0; reg < 4; ++reg) if (n == w && c == 4 * g + reg) aP[n][reg] += gam[n];
#pragma unroll
      for (int n = 0; n < 4; ++n) *(GAS v2u*)(rec + REC_PT + ((n * 2 + (w >> 1)) * 64 + lane) * 16 + 8 * (w & 1)) = pack4(aP[n]); }
    { f32x4 aZq[4], aZy[4]; zero4(aZq); zero4(aZy); mm_strip2(aZq, aZy, s1, s5, s3, w, c, g);
#pragma unroll
      for (int n = 0; n < 4; ++n) { aZq[n] += kh[n]; aZy[n] += aMkr[n]; }
      f32x4 aRy[4]; zero4(aRy); mm_strip(aRy, s3, s0, w, c, g);
#pragma unroll
      for (int n = 0; n < 4; ++n)
#pragma unroll
          for (int reg = 0; reg < 4; ++reg) *(GAS bf16*)(rec + REC_RY + ((w * 2 + (n >> 1)) * 64 + 16 * (2 * (n & 1) + (c >> 3)) + 4 * g + reg) * 16 + 2 * (c & 7)) = f2bf(aRy[n][reg] + rt[n][reg]);
      st_T(s4, aZq, w, c, g);
      st_T(s7, aZy, w, c, g); }
    HBAR();
    { f32x4 aQ[4], aY[4]; zero4(aQ); zero4(aY); mm_strip(aQ, s4, s6, w, c, g); mm_strip(aY, s7, s6, w, c, g);
#pragma unroll
      for (int n = 0; n < 4; ++n) { *(GAS v2u*)(rec + REC_QS + ((n * 64 + lane) * 4 + w) * 8) = pack4(aQ[n]);
                                    *(GAS v2u*)(rec + REC_YL + ((w * 64 + lane) * 4 + n) * 8) = pack4(aY[n]); } }
}

__device__ __forceinline__ float rdlane(float v, int l) { return __int_as_float(__builtin_amdgcn_readlane(__float_as_int(v), l)); }
#ifndef MK_TIME
#define MK_TIME -1
#endif
#define STAMP2(k) do { if (MK_TIME >= 0 && blockIdx.x == 0 && F.wave == 0 && lane == 0) ((volatile LAS unsigned long long*)(F.lds + LDSCTL_OFF + 512))[(k)] = __builtin_amdgcn_s_memrealtime(); } while (0)
__device__ __forceinline__ void rwkv_sample_task(Frame& F, int task) {
    int lane_ = F.lane; asm volatile("" : "+v"(lane_)); const int lane = lane_;
    const int b = task / NH, h = task % NH, col = h * 64 + lane;
    const bf16* proj = (const bf16*)(F.ws + WS_PROJ);
    const float* sh = F.in[I_SSHIFT] + (size_t)b * RWKV_COLS;
    const float* mu = F.in[I_MU];
    float S[64];
    { const GAS f32x4* sp = (const GAS f32x4*)(F.in[I_SWKV] + (((size_t)b * NH + h) * 64 + lane) * 64);
#pragma unroll
      for (int q = 0; q < 16; ++q) { const f32x4 v = sp[q]; S[4 * q] = v[0]; S[4 * q + 1] = v[1]; S[4 * q + 2] = v[2]; S[4 * q + 3] = v[3]; } }
    const float w0 = F.in[I_W0][col], a0 = F.in[I_A0][col], kkc = F.in[I_KK][col], kac = F.in[I_KA][col], rkc = F.in[I_RK][col], lnw = F.in[I_LNW][col], lnb = F.in[I_LNB][col];
    float rr[ST], kq[ST], vq[ST], twd[ST], adv[ST], gd0[ST], gd1[ST];
#pragma unroll
    for (int i = 0; i < ST; ++i) { const int row = RP + b * ST + i; const bf16* cr = proj + (size_t)row * NCOLA;
#define SHIFTED(cc) ({ const float p_ = bf2f(cr[(cc)]); const float q_ = (i == 0) ? sh[(cc)] : bf2f(cr[(cc) - NCOLA]); p_ + (q_ - p_) * mu[(cc)]; })
        rr[i] = SHIFTED(col); kq[i] = SHIFTED(768 + col); vq[i] = SHIFTED(1536 + col);
        twd[i] = ftanh(SHIFTED(2304 + lane)); adv[i] = SHIFTED(2368 + lane); gd0[i] = fsigmoid(SHIFTED(2432 + lane)); gd1[i] = fsigmoid(SHIFTED(2496 + lane));
#undef SHIFTED
    }
    float dwv[ST] = {0.f, 0.f, 0.f, 0.f}, dav[ST] = {0.f, 0.f, 0.f, 0.f}, ggv[ST] = {0.f, 0.f, 0.f, 0.f};
    { const GAS float* W2 = (const GAS float*)(F.in[I_WW2] + col); const GAS float* A2 = (const GAS float*)(F.in[I_WA2] + col); const GAS float* G2 = (const GAS float*)(F.in[I_WG2] + col);
      for (int l0 = 0; l0 < 64; l0 += 16) {
          float w2[16], a2[16], ga[16], gb[16];
#pragma unroll
          for (int u = 0; u < 16; ++u) { w2[u] = W2[(size_t)u * 768]; a2[u] = A2[(size_t)u * 768]; ga[u] = G2[(size_t)u * 768]; gb[u] = G2[(size_t)(64 + u) * 768]; }
          W2 += 16 * 768; A2 += 16 * 768; G2 += 16 * 768;
          __builtin_amdgcn_sched_barrier(0);
#pragma unroll
          for (int u = 0; u < 16; ++u) { const int l = l0 + u;
#pragma unroll
              for (int i = 0; i < ST; ++i) { dwv[i] = fmaf(rdlane(twd[i], l), w2[u], dwv[i]); dav[i] = fmaf(rdlane(adv[i], l), a2[u], dav[i]); ggv[i] = fmaf(rdlane(gd0[i], l), ga[u], ggv[i]); ggv[i] = fmaf(rdlane(gd1[i], l), gb[u], ggv[i]); } } } }
    STAMP2(15);
#pragma unroll
    for (int i = 0; i < ST; ++i) {
        const int row = RP + b * ST + i;
        const float r = rr[i], k = kq[i], v = vq[i], dw = dwv[i], da = dav[i], gg = ggv[i];
        const float y0 = -(w0 + dw); const float sp = fmaxf(y0, 0.f) + __logf(1.0f + __expf(-fabsf(y0)));
        const float wdec = __expf(-__expf(-sp - 0.5f));
        const float a = fsigmoid(a0 + da);
        const float kkr = k * kkc; const float nrm = fmaxf(sqrtf(wave_sum(kkr * kkr)), 1e-12f); const float kk = kkr / nrm;
        const float kp = k * (1.0f + (a - 1.0f) * kac);
        const float asc = -kk, bsc = kk * a;
        const float bonus = wave_sum(r * kp * rkc);
        float sa = 0.f;
#pragma unroll
        for (int j = 0; j < 64; ++j) sa = fmaf(S[j], rdlane(asc, j), sa);
        const float vi = v;
        float y = 0.f;
#pragma unroll
        for (int j = 0; j < 64; ++j) { const float wj = rdlane(wdec, j), bj = rdlane(bsc, j), kj = rdlane(kp, j), rj = rdlane(r, j);
            S[j] = fmaf(S[j], wj, fmaf(sa, bj, vi * kj)); y = fmaf(S[j], rj, y); }
        const float mean = wave_sum(y) * (1.0f / 64.0f); const float dy = y - mean; const float var = wave_sum(dy * dy) * (1.0f / 64.0f);
        const float o = (dy * rsqrtf(var + 6.4e-4f) * lnw + lnb + bonus * vi) * gg;
        ((bf16*)(F.ws + WS_MIX))[(size_t)row * DM + col] = f2bf(o);
        asm volatile("" ::: "memory");
    }
    STAMP2(16);
    { GAS f32x4* sp = (GAS f32x4*)(F.out + O_SWKV + (((size_t)b * NH + h) * 64 + lane) * 64);
#pragma unroll
      for (int q = 0; q < 16; ++q) sp[q] = (f32x4){S[4 * q], S[4 * q + 1], S[4 * q + 2], S[4 * q + 3]}; }
    if (h == 0) { const bf16* lr = proj + (size_t)(RP + b * ST + ST - 1) * NCOLA; float* o = F.out + O_SSHIFT + (size_t)b * RWKV_COLS;
        for (int q = lane; q < RWKV_COLS; q += 64) o[q] = bf2f(lr[q]); }
}

__device__ __forceinline__ void rwkv_scan_chain(Frame& F, int bh, int w) {
    int lane_ = F.lane; asm volatile("" : "+v"(lane_)); const int lane = lane_, g = lane >> 4, c = lane & 15; const int b = bh / NH, h = bh % NH;
    f32x4 acc[4]; zero4(acc);
    const int vrow = 16 * w + c;
    auto recp = [&](int cc) -> unsigned char* { return F.ws + WS_REC + (size_t)((b * NH + h) * 128 + cc) * REC_BYTES; };
    constexpr int DPF = 4;
    bf16x8 pa[DPF][4][2]; v4u qa[DPF][2];
#define SCAN_LOAD(d, cc_) do { const unsigned char* rp_ = recp(cc_); \
        qa[d][0] = *(const GAS v4u*)(rp_ + REC_QS + (w * 64 + lane) * 32); qa[d][1] = *(const GAS v4u*)(rp_ + REC_QS + (w * 64 + lane) * 32 + 16); \
        _Pragma("unroll") for (int mt = 0; mt < 4; ++mt) _Pragma("unroll") for (int ks = 0; ks < 2; ++ks) pa[d][mt][ks] = *(const GAS bf16x8*)(rp_ + REC_PT + ((mt * 2 + ks) * 64 + lane) * 16); } while (0)
#pragma unroll
    for (int d = 0; d < DPF; ++d) SCAN_LOAD(d, d);
    for (int cc0 = 0; cc0 < 128; cc0 += DPF) {
#pragma unroll
        for (int d = 0; d < DPF; ++d) { const int cc = cc0 + d;
            unsigned char* sp_ = F.ws + WS_HB + (size_t)((b * NH + h) * 128 + cc) * 8192;
            v2u sb[4]; f32x4 nacc[4];
#pragma unroll
            for (int mt = 0; mt < 4; ++mt) sb[mt] = pack4(acc[mt]);
            nacc[0] = unpack4((v2u){qa[d][0].x, qa[d][0].y}); nacc[1] = unpack4((v2u){qa[d][0].z, qa[d][0].w}); nacc[2] = unpack4((v2u){qa[d][1].x, qa[d][1].y}); nacc[3] = unpack4((v2u){qa[d][1].z, qa[d][1].w});
#pragma unroll
            for (int mt = 0; mt < 4; ++mt) *(GAS v2u*)(sp_ + ((w * 2 + (mt >> 1)) * 64 + 16 * (2 * (mt & 1) + (g >> 1)) + c) * 16 + 8 * (g & 1)) = sb[mt];
            bf16x8 bf[2];
#pragma unroll
            for (int ks = 0; ks < 2; ++ks) { v4u t; t.x = sb[2 * ks].x; t.y = sb[2 * ks].y; t.z = sb[2 * ks + 1].x; t.w = sb[2 * ks + 1].y; bf[ks] = __builtin_bit_cast(bf16x8, t); }
#pragma unroll
            for (int mt = 0; mt < 4; ++mt) { nacc[mt] = mfma16(pa[d][mt][0], bf[0], nacc[mt]); nacc[mt] = mfma16(pa[d][mt][1], bf[1], nacc[mt]); acc[mt] = nacc[mt]; }
            if (cc + DPF < 128) SCAN_LOAD(d, cc + DPF);
        }
    }
#undef SCAN_LOAD
    float* o = F.out + O_PWKV + (((size_t)b * NH + h) * 64 + vrow) * 64;
#pragma unroll
    for (int mt = 0; mt < 4; ++mt) *(GAS f32x4*)(o + 16 * mt + 4 * g) = acc[mt];
}

__device__ __forceinline__ void rwkv_yout_item(Frame& F, int item) {
    int lane_ = F.lane; asm volatile("" : "+v"(lane_)); const int lane = lane_, g = lane >> 4, c = lane & 15; const int unit = item >> 2, w = item & 3;
    const int chunk = unit / NH, h = unit % NH, row0 = chunk * 64; const bool first = (chunk & 127) == 0;
    const unsigned char* rec = F.ws + WS_REC + (size_t)rec_index(chunk, h) * REC_BYTES; const unsigned char* srec = F.ws + WS_HB + (size_t)rec_index(chunk, h) * 8192;
    const bf16* proj = (const bf16*)(F.ws + WS_PROJ);
    f32x4 y[4], gt[4]; zero4(gt);
    { const v4u y01 = *(const GAS v4u*)(rec + REC_YL + (w * 64 + lane) * 32), y23 = *(const GAS v4u*)(rec + REC_YL + (w * 64 + lane) * 32 + 16);
      y[0] = unpack4((v2u){y01.x, y01.y}); y[1] = unpack4((v2u){y01.z, y01.w}); y[2] = unpack4((v2u){y23.x, y23.y}); y[3] = unpack4((v2u){y23.z, y23.w}); }
    { bf16x8 ar[2], sf[4][2]; v4u gc[4], gp[4]; v2u bvv[4];
      const int tg = 16 * w + c; const bf16* crg = proj + (size_t)(row0 + tg) * NCOLA; const bool hpg = !(first && tg == 0);
#pragma unroll
      for (int ks = 0; ks < 2; ++ks) { ar[ks] = *(const GAS bf16x8*)(rec + REC_RY + ((w * 2 + ks) * 64 + lane) * 16);
#pragma unroll
          for (int n = 0; n < 4; ++n) sf[n][ks] = *(const GAS bf16x8*)(srec + ((n * 2 + ks) * 64 + lane) * 16); }
      __builtin_amdgcn_sched_barrier(0);
#pragma unroll
      for (int ks = 0; ks < 2; ++ks)
#pragma unroll
          for (int n = 0; n < 4; ++n) y[n] = mfma16(ar[ks], sf[n][ks], y[n]); }
    { const int t = 16 * w + c; const bf16* cr = proj + (size_t)(row0 + t) * NCOLA; const bf16* pr = (first && t == 0) ? nullptr : cr - NCOLA; const bf16* Wg2 = (const bf16*)(F.ws + WS_WG2);
#pragma unroll
      for (int ks = 0; ks < 4; ++ks) { const int l0 = 32 * ks + 8 * g; float x[8]; load_shift8(cr + 2432 + l0, pr ? pr + 2432 + l0 : nullptr, F.in[I_MU] + 2432 + l0, x);
#pragma unroll
          for (int i = 0; i < 8; ++i) x[i] = fsigmoid(x[i]);
          const bf16x8 ag = pack_frag(x);
#pragma unroll
          for (int n = 0; n < 4; ++n) gt[n] = mfma16(ag, *(const GAS bf16x8*)(Wg2 + (size_t)(h * 64 + 16 * n + c) * 128 + l0), gt[n]); } }
    float mean[4], rstd[4];
#pragma unroll
    for (int reg = 0; reg < 4; ++reg) { float s = (y[0][reg] + y[1][reg]) + (y[2][reg] + y[3][reg]); s = sum16(s); mean[reg] = s * (1.0f / 64.0f);
        float q = 0.f;
#pragma unroll
        for (int n = 0; n < 4; ++n) { const float d = y[n][reg] - mean[reg]; q += d * d; }
        q = sum16(q); rstd[reg] = rsqrtf(q * (1.0f / 64.0f) + 6.4e-4f); }
    bf16* mix = (bf16*)(F.ws + WS_MIX);
#pragma unroll
    for (int n = 0; n < 4; ++n) { const int col = h * 64 + 16 * n + c; const float lnw = F.in[I_LNW][col], lnb = F.in[I_LNB][col];
        const f32x4 bv = unpack4(*(const GAS v2u*)(rec + REC_BV + ((w * 64 + lane) * 4 + n) * 8));
#pragma unroll
        for (int reg = 0; reg < 4; ++reg) { const float o = ((y[n][reg] - mean[reg]) * rstd[reg] * lnw + lnb + bv[reg]) * gt[n][reg];
            mix[(size_t)(row0 + 16 * w + 4 * g + reg) * DM + col] = f2bf(o); } }
}

__device__ __forceinline__ int crow32(int r, int hi) { return (r & 3) + 8 * (r >> 2) + 4 * hi; }
template <bool MASKED, int GB>
__device__ __forceinline__ void flash32(const bf16x8 (&qf)[4], const bf16* Kp, int kstr, const bf16* VTp, int vstr, int kb_lo, int nblk, int qpos, float m0, float l0,
                                        f32x16& o0, f32x16& o1, float& lsum, int lane) {
    const int r32 = lane & 31, hh = lane >> 5;
    float m = m0, l = hh == 0 ? l0 : 0.f;
#pragma unroll
    for (int r = 0; r < 16; ++r) { o0[r] = 0.f; o1[r] = 0.f; }
    for (int b0 = 0; b0 < nblk; b0 += GB) {
        bf16x8 kf[GB][4]; v2u vf[GB][2][2][2];
#pragma unroll
        for (int i = 0; i < GB; ++i) if (b0 + i < nblk) { const int kb = kb_lo + 32 * (b0 + i);
#pragma unroll
            for (int ks = 0; ks < 4; ++ks) kf[i][ks] = *(const GAS bf16x8*)(Kp + (size_t)(kb + r32) * kstr + 16 * ks + 8 * hh);
#pragma unroll
            for (int s2 = 0; s2 < 2; ++s2)
#pragma unroll
                for (int dt = 0; dt < 2; ++dt) { const bf16* vp = VTp + (size_t)(32 * dt + r32) * vstr + kb + 16 * s2 + 4 * hh; vf[i][s2][dt][0] = *(const GAS v2u*)vp; vf[i][s2][dt][1] = *(const GAS v2u*)(vp + 8); } }
#pragma unroll
        for (int i = 0; i < GB; ++i) if (b0 + i < nblk) { const int kb = kb_lo + 32 * (b0 + i);
            f32x16 s;
#pragma unroll
            for (int r = 0; r < 16; ++r) s[r] = 0.f;
#pragma unroll
            for (int ks = 0; ks < 4; ++ks) s = mfma32(kf[i][ks], qf[ks], s);
            if (MASKED) {
#pragma unroll
                for (int r = 0; r < 16; ++r) { const int rel = qpos - (kb + crow32(r, hh)); if (rel < 0 || rel >= 128) s[r] = -1e30f; } }
            float bm = s[0];
#pragma unroll
            for (int r = 1; r < 16; ++r) bm = fmaxf(bm, s[r]);
            bm = max_x32(bm);
            const float mn = fmaxf(m, bm), alpha = __builtin_amdgcn_exp2f(m - mn); m = mn;
            float ps = 0.f;
#pragma unroll
            for (int r = 0; r < 16; ++r) { s[r] = __builtin_amdgcn_exp2f(s[r] - mn); ps += s[r]; }
            l = l * alpha + ps;
#pragma unroll
            for (int r = 0; r < 16; ++r) { o0[r] *= alpha; o1[r] *= alpha; }
#pragma unroll
            for (int s2 = 0; s2 < 2; ++s2) {
                v4u pw; pw.x = cvt_pk_bf16(s[8 * s2], s[8 * s2 + 1]); pw.y = cvt_pk_bf16(s[8 * s2 + 2], s[8 * s2 + 3]); pw.z = cvt_pk_bf16(s[8 * s2 + 4], s[8 * s2 + 5]); pw.w = cvt_pk_bf16(s[8 * s2 + 6], s[8 * s2 + 7]);
                const bf16x8 pb = __builtin_bit_cast(bf16x8, pw);
                { v4u aw; aw.x = vf[i][s2][0][0].x; aw.y = vf[i][s2][0][0].y; aw.z = vf[i][s2][0][1].x; aw.w = vf[i][s2][0][1].y; o0 = mfma32(__builtin_bit_cast(bf16x8, aw), pb, o0); }
                { v4u aw; aw.x = vf[i][s2][1][0].x; aw.y = vf[i][s2][1][0].y; aw.z = vf[i][s2][1][1].x; aw.w = vf[i][s2][1][1].y; o1 = mfma32(__builtin_bit_cast(bf16x8, aw), pb, o1); } }
        }
    }
    lsum = add_x32(l);
}
__device__ __forceinline__ void flash_store(bf16* dst  , int rstride, const f32x16& o0, const f32x16& o1, float lsum, int lane) {
    const int r32 = lane & 31, hh = lane >> 5; const float inv = 1.0f / lsum; bf16* p = dst + (size_t)r32 * rstride + 4 * hh;
#pragma unroll
    for (int k = 0; k < 4; ++k) { *(GAS v2u*)(p + 8 * k) = pack4((f32x4){o0[4 * k] * inv, o0[4 * k + 1] * inv, o0[4 * k + 2] * inv, o0[4 * k + 3] * inv});
        *(GAS v2u*)(p + 32 + 8 * k) = pack4((f32x4){o1[4 * k] * inv, o1[4 * k + 1] * inv, o1[4 * k + 2] * inv, o1[4 * k + 3] * inv}); }
}
constexpr int KL_STR = 144;
template <bool MASKED>
__device__ __forceinline__ void flash32_lds(const bf16x8 (&qf)[4], const LAS unsigned char* Kl, const LAS unsigned char* Vl, int vstr, int lk_lo, int nblk, int kpos_lo, int qpos, float m0, float l0,
                                            f32x16& o0, f32x16& o1, float& lsum, int lane) {
    const int r32 = lane & 31, hh = lane >> 5;
    float m = m0, l = hh == 0 ? l0 : 0.f;
#pragma unroll
    for (int r = 0; r < 16; ++r) { o0[r] = 0.f; o1[r] = 0.f; }
    for (int blk = 0; blk < nblk; ++blk) { const int lk = lk_lo + 32 * blk;
        f32x16 s;
#pragma unroll
        for (int r = 0; r < 16; ++r) s[r] = 0.f;
#pragma unroll
        for (int ks = 0; ks < 4; ++ks) s = mfma32(*(const LAS bf16x8*)(Kl + (lk + r32) * KL_STR + (16 * ks + 8 * hh) * 2), qf[ks], s);
        if (MASKED && (blk == 0 || blk == nblk - 1)) {
#pragma unroll
            for (int r = 0; r < 16; ++r) { const int rel = qpos - (kpos_lo + 32 * blk + crow32(r, hh)); if (rel < 0 || rel >= 128) s[r] = -1e30f; } }
        float bm = s[0];
#pragma unroll
        for (int r = 1; r < 16; ++r) bm = fmaxf(bm, s[r]);
        bm = max_x32(bm);
        const float mn = fmaxf(m, bm), alpha = __builtin_amdgcn_exp2f(m - mn); m = mn;
        float ps = 0.f;
#pragma unroll
        for (int r = 0; r < 16; ++r) { s[r] = __builtin_amdgcn_exp2f(s[r] - mn); ps += s[r]; }
        l = l * alpha + ps;
#pragma unroll
        for (int r = 0; r < 16; ++r) { o0[r] *= alpha; o1[r] *= alpha; }
#pragma unroll
        for (int s2 = 0; s2 < 2; ++s2) {
            v4u pw; pw.x = cvt_pk_bf16(s[8 * s2], s[8 * s2 + 1]); pw.y = cvt_pk_bf16(s[8 * s2 + 2], s[8 * s2 + 3]); pw.z = cvt_pk_bf16(s[8 * s2 + 4], s[8 * s2 + 5]); pw.w = cvt_pk_bf16(s[8 * s2 + 6], s[8 * s2 + 7]);
            const bf16x8 pb = __builtin_bit_cast(bf16x8, pw);
#pragma unroll
            for (int dt = 0; dt < 2; ++dt) { const LAS unsigned char* vp = Vl + (32 * dt + r32) * vstr + (lk + 16 * s2 + 4 * hh) * 2;
                const v2u a0 = *(const LAS v2u*)vp, a1 = *(const LAS v2u*)(vp + 16); v4u aw; aw.x = a0.x; aw.y = a0.y; aw.z = a1.x; aw.w = a1.y;
                if (dt == 0) o0 = mfma32(__builtin_bit_cast(bf16x8, aw), pb, o0); else o1 = mfma32(__builtin_bit_cast(bf16x8, aw), pb, o1); } }
    }
    lsum = add_x32(l);
}
template <bool VT>
__device__ __forceinline__ void stage_kv(LAS unsigned char* Kl, LAS unsigned char* Vl, int vstr, const bf16* Kg, int kstr, const bf16* Vg, int vstr_g, int nkeys, int tid) {
    for (int id = tid; id < nkeys * 8; id += NWAVES * 64) { const int key = id >> 3, ch = id & 7; *(LAS v4u*)(Kl + key * KL_STR + ch * 16) = *(const GAS v4u*)(Kg + (size_t)key * kstr + ch * 8); }
    if (VT) { const int cpr = nkeys >> 3;
        for (int id = tid; id < 64 * cpr; id += NWAVES * 64) { const int d = id / cpr, ch = id % cpr; *(LAS v4u*)(Vl + d * vstr + ch * 16) = *(const GAS v4u*)(Vg + (size_t)d * vstr_g + ch * 8); } }
    else for (int id = tid; id < nkeys * 8; id += NWAVES * 64) { const int key = id >> 3, ch = id & 7; const v4u w = *(const GAS v4u*)(Vg + (size_t)key * vstr_g + ch * 8);
        LAS unsigned char* p = Vl + (8 * ch) * vstr + key * 2;
        *(LAS bf16*)(p) = (bf16)(w.x & 0xffffu); *(LAS bf16*)(p + vstr) = (bf16)(w.x >> 16); *(LAS bf16*)(p + 2 * vstr) = (bf16)(w.y & 0xffffu); *(LAS bf16*)(p + 3 * vstr) = (bf16)(w.y >> 16);
        *(LAS bf16*)(p + 4 * vstr) = (bf16)(w.z & 0xffffu); *(LAS bf16*)(p + 5 * vstr) = (bf16)(w.z >> 16); *(LAS bf16*)(p + 6 * vstr) = (bf16)(w.w & 0xffffu); *(LAS bf16*)(p + 7 * vstr) = (bf16)(w.w >> 16); }
}
__device__ __forceinline__ void memattn_prompt_unit(Frame& F, int layer, int unit) {
    int lane_ = F.lane; asm volatile("" : "+v"(lane_)); const int lane = lane_, r32 = lane & 31, hh = lane >> 5;
    const int b = unit >> 7, hm = (unit >> 5) & 3, qblk = unit & 31; const int row = b * T + qblk * 256 + F.wave * 32 + r32;
    LAS unsigned char* Kl = F.lds; LAS unsigned char* Vl = F.lds + 256 * KL_STR; constexpr int VSTR = 256 * 2 + 16;
    __syncthreads();
    stage_kv<true>(Kl, Vl, VSTR, (const bf16*)(F.ws + WS_MK) + (size_t)((layer * 2 + b) * 4 + hm) * 256 * 64, 64, (const bf16*)(F.ws + WS_MVT) + (size_t)((layer * 2 + b) * 4 + hm) * 64 * 256, 256, 256, F.wave * 64 + lane);
    bf16x8 qf[4];
    if (layer == 0) { const bf16* qp = (const bf16*)(F.ws + WS_PROJ) + (size_t)row * NCOLA + RWKV_COLS + hm * 64; const float* gn = F.in[I_MQN];
        float x[4][8]; float ss = 0.f;
#pragma unroll
        for (int ks = 0; ks < 4; ++ks) { const v4u w = *(const GAS v4u*)(qp + 16 * ks + 8 * hh); const unsigned ww[4] = {w.x, w.y, w.z, w.w};
#pragma unroll
            for (int i = 0; i < 4; ++i) { x[ks][2 * i] = bflo(ww[i]); x[ks][2 * i + 1] = bfhi(ww[i]); ss += x[ks][2 * i] * x[ks][2 * i] + x[ks][2 * i + 1] * x[ks][2 * i + 1]; } }
        ss = add_x32(ss); const float rs = rsqrtf(ss * (1.0f / 64.0f) + 1e-6f) * C2Q;
#pragma unroll
        for (int ks = 0; ks < 4; ++ks) {
#pragma unroll
            for (int i = 0; i < 8; ++i) x[ks][i] *= rs * gn[16 * ks + 8 * hh + i];
            qf[ks] = pack_frag(x[ks]); }
    } else { const bf16* qp = (const bf16*)(F.ws + WS_Q1) + (size_t)row * DM + 768 + hm * 64;
#pragma unroll
        for (int ks = 0; ks < 4; ++ks) qf[ks] = *(const GAS bf16x8*)(qp + 16 * ks + 8 * hh); }
    __syncthreads();
    f32x16 o0, o1; float ls;
    flash32_lds<false>(qf, Kl, Vl, VSTR, 0, 8, 0, 0, -1e30f, 0.f, o0, o1, ls, lane);
    flash_store((bf16*)(F.ws + WS_MIX) + (size_t)(b * T + qblk * 256 + F.wave * 32) * DM + 768 + hm * 64, DM, o0, o1, ls, lane);
}
__device__ __forceinline__ void swa_prompt_unit(Frame& F, int unit) {
    int lane_ = F.lane; asm volatile("" : "+v"(lane_)); const int lane = lane_, r32 = lane & 31, hh = lane >> 5;
    const int b = unit >> 7, kvh = (unit >> 5) & 3, qblk = unit & 31, q0 = qblk * 256, kb0 = q0 >= 128 ? q0 - 128 : 0, nkeys = q0 + 256 - kb0;
    LAS unsigned char* Kl = F.lds; LAS unsigned char* Vl = F.lds + 384 * KL_STR; constexpr int VSTR = 384 * 2 + 16;
    __syncthreads();
    stage_kv<false>(Kl, Vl, VSTR, (const bf16*)(F.ws + WS_K1) + (size_t)(b * T + kb0) * 256 + kvh * 64, 256, (const bf16*)(F.ws + WS_V1) + (size_t)(b * T + kb0) * 256 + kvh * 64, 256, nkeys, F.wave * 64 + lane);
    const int tq = q0 + F.wave * 32, row = b * T + tq + r32;
    bf16x8 qf[3][4];
#pragma unroll
    for (int gq = 0; gq < 3; ++gq) { const bf16* qp = (const bf16*)(F.ws + WS_Q1) + (size_t)row * DM + (kvh * 3 + gq) * 64;
#pragma unroll
        for (int ks = 0; ks < 4; ++ks) qf[gq][ks] = *(const GAS bf16x8*)(qp + 16 * ks + 8 * hh); }
    __syncthreads();
    const int kp_lo = tq >= 128 ? tq - 128 : 0, nblk = (tq - kp_lo) / 32 + 1;
#pragma unroll
    for (int gq = 0; gq < 3; ++gq) { const int hq = kvh * 3 + gq; const float sink = F.in[I_SINKS][hq] * LOG2E;
        f32x16 o0, o1; float ls;
        flash32_lds<true>(qf[gq], Kl, Vl, VSTR, kp_lo - kb0, nblk, kp_lo, tq + r32, sink, 1.0f, o0, o1, ls, lane);
        flash_store((bf16*)(F.ws + WS_MIX) + (size_t)(b * T + tq) * DM + hq * 64, DM, o0, o1, ls, lane); }
}
template <int NQ, bool WINDOW>
__device__ __forceinline__ void small_attn(const LAS float* ql, LAS float* sc, int NKP, const float* k1, const float* v1, int kst1, int nk1, const bf16* k2, const bf16* v2, int kst2, int nk2,
                                           const float* sinkg  , bf16* out0, int ostride_q, int lane) {
    const int sub = lane >> 4, dq = lane & 15, nk = nk1 + nk2;
    f32x4 qv[NQ];
#pragma unroll
    for (int qi = 0; qi < NQ; ++qi) qv[qi] = *(const LAS f32x4*)(ql + qi * 64 + 4 * dq);
    constexpr int KBAT = NQ > 4 ? 4 : 8;
    for (int kg0 = 0; kg0 < nk1; kg0 += 4 * KBAT) { f32x4 kv[KBAT];
#pragma unroll
        for (int u = 0; u < KBAT; ++u) kv[u] = *(const GAS f32x4*)(k1 + (size_t)(kg0 + 4 * u + sub) * kst1 + 4 * dq);
        __builtin_amdgcn_sched_barrier(0);
#pragma unroll
        for (int u = 0; u < KBAT; ++u) { const int key = kg0 + 4 * u + sub;
#pragma unroll
            for (int qi = 0; qi < NQ; ++qi) { const f32x4 p = qv[qi] * kv[u]; const float s = sum16((p[0] + p[1]) + (p[2] + p[3])); if (dq == 0) sc[qi * NKP + key] = s; } } }
    for (int kg = nk1; kg < nk; kg += 4) { const int key = kg + sub; const f32x4 kv = unpack4(*(const GAS v2u*)(k2 + (size_t)(key - nk1) * kst2 + 4 * dq));
#pragma unroll
        for (int qi = 0; qi < NQ; ++qi) { const f32x4 p = qv[qi] * kv; const float s = sum16((p[0] + p[1]) + (p[2] + p[3])); if (dq == 0) sc[qi * NKP + key] = s; } }
    LDS_WAIT(); asm volatile("" ::: "memory");
#pragma unroll
    for (int qi = 0; qi < NQ; ++qi) { float sv[5]; const float sk_ = sinkg ? sinkg[qi >> 2] * LOG2E : -1e30f; float mx = sk_;
#pragma unroll
        for (int t = 0; t < 5; ++t) { const int key = lane + 64 * t; float s = -1e30f; if (key < nk) { s = sc[qi * NKP + key]; if (WINDOW) { const int i = qi & 3; if (key < i + 1 || key > 128 + i) s = -1e30f; } } sv[t] = s; mx = fmaxf(mx, s); }
        mx = wave_max(mx); float sum = 0.f;
#pragma unroll
        for (int t = 0; t < 5; ++t) { sv[t] = __builtin_amdgcn_exp2f(sv[t] - mx); sum += sv[t]; }
        sum = wave_sum(sum) + (sinkg ? __builtin_amdgcn_exp2f(sk_ - mx) : 0.f); const float inv = 1.0f / sum;
#pragma unroll
        for (int t = 0; t < 5; ++t) { const int key = lane + 64 * t; if (key < nk) sc[qi * NKP + key] = sv[t] * inv; } }
    LDS_WAIT(); asm volatile("" ::: "memory");
    f32x4 acc[NQ];
#pragma unroll
    for (int qi = 0; qi < NQ; ++qi) acc[qi] = (f32x4){0.f, 0.f, 0.f, 0.f};
    for (int kg0 = 0; kg0 < nk1; kg0 += 4 * KBAT) { f32x4 vv[KBAT];
#pragma unroll
        for (int u = 0; u < KBAT; ++u) vv[u] = *(const GAS f32x4*)(v1 + (size_t)(kg0 + 4 * u + sub) * kst1 + 4 * dq);
        __builtin_amdgcn_sched_barrier(0);
#pragma unroll
        for (int u = 0; u < KBAT; ++u) { const int key = kg0 + 4 * u + sub;
#pragma unroll
            for (int qi = 0; qi < NQ; ++qi) acc[qi] += vv[u] * sc[qi * NKP + key]; } }
    for (int kg = nk1; kg < nk; kg += 4) { const int key = kg + sub; const f32x4 vv = unpack4(*(const GAS v2u*)(v2 + (size_t)(key - nk1) * kst2 + 4 * dq));
#pragma unroll
        for (int qi = 0; qi < NQ; ++qi) acc[qi] += vv * sc[qi * NKP + key]; }
#pragma unroll
    for (int qi = 0; qi < NQ; ++qi) { f32x4 a = acc[qi];
#pragma unroll
        for (int e = 0; e < 4; ++e) { a[e] = add_x16(a[e]); a[e] = add_x32(a[e]); }
        if (sub == 0) *(GAS v2u*)(out0 + (size_t)(qi & 3) * ostride_q + (qi >> 2) * 64 + 4 * dq) = pack4(a); }
    LDS_WAIT(); asm volatile("" ::: "memory");
}
__device__ __forceinline__ void memattn_sample_task(Frame& F, int layer, int task, LAS float* wl  ) {
    int lane_ = F.lane; asm volatile("" : "+v"(lane_)); const int lane = lane_, b = task >> 2, hm = task & 3; LAS float* ql = wl; LAS float* sc = wl + 12 * 64;
#pragma unroll
    for (int i = 0; i < 4; ++i) { const int row = RP + b * ST + i; float x;
        if (layer == 0) { x = bf2f(((const bf16*)(F.ws + WS_PROJ))[(size_t)row * NCOLA + RWKV_COLS + hm * 64 + lane]); const float ss = wave_sum(x * x); x *= rsqrtf(ss * (1.0f / 64.0f) + 1e-6f) * C2Q * F.in[I_MQN][lane]; }
        else x = bf2f(((const bf16*)(F.ws + WS_Q1))[(size_t)row * DM + 768 + hm * 64 + lane]);
        ql[i * 64 + lane] = x; }
    LDS_WAIT(); asm volatile("" ::: "memory");
    const float* k1 = F.in[I_CMK] + (((size_t)layer * SB + b) * NMEM * 4 + hm) * 64; const float* v1 = F.in[I_CMV] + (((size_t)layer * SB + b) * NMEM * 4 + hm) * 64;
    small_attn<4, false>(ql, sc, 264, k1, v1, 256, 256, nullptr, nullptr, 0, 0, nullptr, (bf16*)(F.ws + WS_MIX) + (size_t)(RP + b * ST) * DM + 768 + hm * 64, DM, lane);
}
__device__ __forceinline__ void swa_sample_task(Frame& F, int task, LAS float* wl) {
    int lane_ = F.lane; asm volatile("" : "+v"(lane_)); const int lane = lane_, b = task >> 2, kvh = task & 3; LAS float* ql = wl; LAS float* sc = wl + 12 * 64;
#pragma unroll
    for (int qi = 0; qi < 12; ++qi) { const int i = qi & 3, gq = qi >> 2, hq = kvh * 3 + gq; const int row = RP + b * ST + i;
        ql[qi * 64 + lane] = bf2f(((const bf16*)(F.ws + WS_Q1))[(size_t)row * DM + hq * 64 + lane]); }
    LDS_WAIT(); asm volatile("" ::: "memory");
    const float* k1 = F.in[I_CSK] + ((size_t)b * 128 * 4 + kvh) * 64; const float* v1 = F.in[I_CSV] + ((size_t)b * 128 * 4 + kvh) * 64;
    const bf16* k2 = (const bf16*)(F.ws + WS_K1) + (size_t)(RP + b * ST) * 256 + kvh * 64; const bf16* v2 = (const bf16*)(F.ws + WS_V1) + (size_t)(RP + b * ST) * 256 + kvh * 64;
    small_attn<12, true>(ql, sc, 136, k1, v1, 256, 128, k2, v2, 256, 4, F.in[I_SINKS] + kvh * 3, (bf16*)(F.ws + WS_MIX) + (size_t)(RP + b * ST) * DM + kvh * 3 * 64, DM, lane);
}

constexpr int N_PHASES = 13;
template <int PM> __global__ void __launch_bounds__(NWAVES * 64, 2) yoco_fwd(Args args) {
    extern __shared__ __attribute__((aligned(16))) unsigned char lds[];
    Frame F;
    F.lds = (LAS unsigned char*)lds; F.lds_g = lds;
    F.wave = __builtin_amdgcn_readfirstlane((int)threadIdx.x >> 6); F.lane = mk_lane(); F.tid = F.wave * 64 + F.lane;
    F.G = gridDim.x; { const int bx = blockIdx.x; F.vcu = (F.G % 8 == 0) ? (bx % 8) * (F.G / 8) + bx / 8 : bx; }
    F.in = args.in; F.out = args.out; F.ws = args.ws; F.ctl = (gu32*)(args.ws + WS_CTL);
    for (int u = F.tid; u < (LDS_BYTES - LDSCTL_OFF) / 4; u += NWAVES * 64) ((LAS unsigned*)(F.lds + LDSCTL_OFF))[u] = 0u;
    __syncthreads();
    const int lo = args.ph_lo, hi = args.ph_hi;
    XcdBarrier bar; bar.wave0 = F.wave == 0; bar.bar = (unsigned*)(F.ctl + CW_BAR); bar.x = 0; bar.st = nullptr;
    bar = xcd_barrier_post((unsigned*)(F.ctl + CW_BAR), (volatile LAS unsigned*)(F.lds + MISC_OFF) + 8, F.wave == 0);
#define IN(k) (((PM >> (k)) & 1) && lo <= (k) && (k) < hi)
#ifndef MK_DUP
#define MK_DUP -1
#endif
#define PH_REP(k) ((MK_DUP == (k)) ? 2 : 1)
#ifndef MK_TIME
#define MK_TIME -1
#endif
#define STAMP(k) do { if (MK_TIME >= 0 && blockIdx.x == 0 && F.wave == 0 && mk_lane() == 0) ((volatile LAS unsigned long long*)(F.lds + LDSCTL_OFF + 512))[(k)] = __builtin_amdgcn_s_memrealtime(); } while (0)
#define SEAM(k) do { if (IN(k) && IN((k) + 1)) xcd_barrier(bar); STAMP((k) + 1); } while (0)
    const int gw = F.vcu * NWAVES + F.wave, NGW = F.G * NWAVES;
    STAMP(0);
#define SSQ ((float*)(F.ws + WS_SSQ))
#define HB ((bf16*)(F.ws + WS_HB))
#define MIX ((bf16*)(F.ws + WS_MIX))
#define HH ((bf16*)(F.ws + WS_H))
#define PHASE_BEGIN() do { int z_ = 0; unsigned char* ws_ = args.ws; float* out_ = args.out; asm volatile("" : "+s"(z_), "+s"(ws_), "+s"(out_)); F.in = args.in + z_; F.ws = ws_; F.out = out_; \
                           F.lane = mk_lane(); F.tid = F.wave * 64 + F.lane; } while (0)

    if (IN(0)) for (int rep_ = 0; rep_ < PH_REP(0); ++rep_) { PHASE_BEGIN(); p0_prologue(F); } SEAM(0);

    if (IN(1)) for (int rep_ = 0; rep_ < PH_REP(1); ++rep_) { PHASE_BEGIN();
        { pg8::Gemm g{HB, (const bf16*)(F.ws + WS_WA), R, NCOLA, DM}; pg8::StaticOrder S; S.init(R, NCOLA, F.G, (int)blockIdx.x, DM);
          pg8::EpiScaleBf16<0> E{(bf16*)(F.ws + WS_PROJ), NCOLA, SSQ};
          pg8::gemm_phase<pg8::EpiScaleBf16<0>, pg8::StaticOrder, true, true>(F.lds + RING_OFF, g, S, E, F.wave, F.lane); }
#ifndef NO_MEMKV
        { pg8::Gemm g{(const bf16*)(F.ws + WS_MB), (const bf16*)(F.ws + WS_WM), 512, 1024, DM}; pg8::StaticOrder S; S.init(512, 1024, F.G, (int)blockIdx.x, DM);
          pg8::EpiMemKV E{F.ws, F.out, F.in[I_MKN]};
          pg8::gemm_phase<pg8::EpiMemKV, pg8::StaticOrder, true, true>(F.lds + RING_OFF, g, S, E, F.wave, F.lane); }
#endif
    } SEAM(1);

    if (IN(2)) for (int rep_ = 0; rep_ < ((MK_DUP == 2 || (MK_DUP >= 20 && MK_DUP < 30)) ? 2 : 1); ++rep_) { PHASE_BEGIN();
        const int half = F.wave >> 2; const int gw = F.vcu * NWAVES + F.wave, NGW = F.G * NWAVES;
        LAS unsigned char* hb = F.lds + half * PREP_HALF; LAS float* wtot = (LAS float*)(F.lds + WTOT_OFF + half * 1024);
        const int slim = (rep_ == 1 && MK_DUP == 21) ? 3 : (rep_ == 1 && MK_DUP == 22) ? 5 : 99;
        if (!(rep_ == 1 && MK_DUP == 20)) { LAS unsigned char* prow = F.lds + WTOT_OFF + 2048 + half * 512; PrepPf pf; if (F.vcu < NUNIT / 2) prep_issue(F, 2 * F.vcu + half, pf);
            for (int pi = F.vcu; pi < NUNIT / 2; pi += F.G) rwkv_prep_unit(F, 2 * pi + half, hb, wtot, prow, pf, pi + F.G < NUNIT / 2, 2 * (pi + F.G) + half, slim); }
        STAMP(14);
        if (!(rep_ == 1 && (MK_DUP == 21 || MK_DUP == 22))) for (int t = gw; t < SB * NH + 2; t += NGW) {
            if (t < SB * NH) rwkv_sample_task(F, t);
            else { const int b = t - SB * NH; const bf16* lr = (const bf16*)(F.ws + WS_PROJ) + (size_t)(b * T + T - 1) * NCOLA; float* o = F.out + O_PSHIFT + (size_t)b * RWKV_COLS;
                for (int q = F.lane; q < RWKV_COLS; q += 64) o[q] = bf2f(lr[q]); } }
        { const int nsw = (SB * NH + 2 + NWAVES - 1) / NWAVES;
          if (rep_ == 0 && F.vcu >= nsw && F.G > nsw) { __syncthreads(); p0_weights(F, 1, (F.vcu - nsw) * NWAVES + F.wave, (F.G - nsw) * NWAVES, (LAS float*)(F.lds + F.wave * 16384)); }
          else if (rep_ == 0 && F.G <= nsw) { __syncthreads(); p0_weights(F, 1, gw, NGW, (LAS float*)(F.lds + F.wave * 16384)); } }
    } SEAM(2);

    if (IN(3)) for (int rep_ = 0; rep_ < ((MK_DUP == 30 || MK_DUP == 31) ? 2 : 1); ++rep_) { PHASE_BEGIN();
        const int nscan = NB * NH * 4;
        const int nconv = (F.G - nscan) * NWAVES + nscan * 7;
        if (F.vcu < nscan) { if (F.wave == 0) { if (rep_ == 0 || MK_DUP == 31) rwkv_scan_chain(F, F.vcu >> 2, F.vcu & 3); }
                             else if (rep_ == 0) { copy_window_cache(F, (F.vcu * 7 + F.wave - 1) * 64 + F.lane, nscan * 7 * 64);
                                                   } }
        else if (rep_ == 0 || MK_DUP == 30) { LAS float* wl = (LAS float*)(F.lds + F.wave * 12288);
            for (int u = F.vcu - nscan; u < 256; u += F.G - nscan) memattn_prompt_unit(F, 0, u);
            __syncthreads();
            const int ow = (F.vcu - nscan) * NWAVES + F.wave, NOW = (F.G - nscan) * NWAVES;
            for (int t = ow; t < 512; t += NOW) memattn_sample_task(F, 0, t, wl);
            }
    } SEAM(3);

    if (IN(4)) for (int rep_ = 0; rep_ < PH_REP(4); ++rep_) { PHASE_BEGIN(); _Pragma("unroll 2") for (int it = gw; it < NUNIT * 4; it += NGW) rwkv_yout_item(F, it); } SEAM(4); if (MK_DUP == 40) for (int i_ = 0; i_ < 10; ++i_) xcd_barrier(bar);

    if (IN(5)) for (int rep_ = 0; rep_ < PH_REP(5); ++rep_) { PHASE_BEGIN(); pg8::Gemm g{MIX, (const bf16*)(F.ws + WS_WOUT), R, DM, DM}; pg8::TailOrder S; S.init(F.G, (int)blockIdx.x, DM, S_K1);
        pg8::EpiResid E{F.in[I_XP], F.in[I_XS], RP, nullptr, HB, SSQ, (float*)(F.ws + WS_SLAB), S_K1};
        pg8::gemm_phase<pg8::EpiResid, pg8::TailOrder, true, true>(F.lds + RING_OFF, g, S, E, F.wave, F.lane); } SEAM(5);
    if (IN(6)) for (int rep_ = 0; rep_ < PH_REP(6); ++rep_) { PHASE_BEGIN(); finalize_sample(F, F.in[I_XS], S_K1, false); xcd_barrier(bar);
        pg8::Gemm g{HB, (const bf16*)(F.ws + WS_WUP), R, FF, DM}; pg8::StaticOrder S; S.init(R, FF, F.G, (int)blockIdx.x, DM);
        pg8::EpiScaleBf16<1> E{HH, FF, SSQ};
        pg8::gemm_phase<pg8::EpiScaleBf16<1>, pg8::StaticOrder, true, true>(F.lds + RING_OFF, g, S, E, F.wave, F.lane); } SEAM(6);
    if (IN(7)) { PHASE_BEGIN(); pg8::Gemm g{HH, (const bf16*)(F.ws + WS_WDN), R, DM, FF}; pg8::TailOrder S; S.init(F.G, (int)blockIdx.x, FF, S_K4);
        pg8::EpiResid E{nullptr, nullptr, RP, nullptr, HB, SSQ, (float*)(F.ws + WS_SLAB), S_K4, HB};
        pg8::gemm_phase<pg8::EpiResid, pg8::TailOrder, true, true>(F.lds + RING_OFF, g, S, E, F.wave, F.lane); } SEAM(7);

    if (IN(8)) for (int rep_ = 0; rep_ < PH_REP(8); ++rep_) { PHASE_BEGIN(); finalize_sample(F, nullptr, S_K4, false); xcd_barrier(bar);
        pg8::Gemm g{HB, (const bf16*)(F.ws + WS_WB), R, NCOLB, DM}; pg8::StaticOrder S; S.init(R, NCOLB, F.G, (int)blockIdx.x, DM);
        pg8::EpiL1 E{F.ws, F.out, F.in[I_QN], F.in[I_MQN] + 64, F.in[I_KN]};
        pg8::gemm_phase<pg8::EpiL1, pg8::StaticOrder, true, true>(F.lds + RING_OFF, g, S, E, F.wave, F.lane); } SEAM(8);

    if (IN(9)) for (int rep_ = 0; rep_ < PH_REP(9); ++rep_) { PHASE_BEGIN(); LAS float* wl = (LAS float*)(F.lds + F.wave * 12288); const int gw = F.vcu * NWAVES + F.wave, NGW = F.G * NWAVES;
        for (int u = F.vcu; u < 256; u += F.G) swa_prompt_unit(F, u);
        for (int u = F.vcu; u < 256; u += F.G) memattn_prompt_unit(F, 1, u);
        __syncthreads();
        for (int t = gw; t < 512 + 512; t += NGW) { if (t < 512) swa_sample_task(F, t, wl); else memattn_sample_task(F, 1, t - 512, wl); }
    } SEAM(9);

    if (IN(10)) for (int rep_ = 0; rep_ < PH_REP(10); ++rep_) { PHASE_BEGIN(); pg8::Gemm g{MIX, (const bf16*)(F.ws + WS_WOUT) + (size_t)DM * DM, R, DM, DM}; pg8::TailOrder S; S.init(F.G, (int)blockIdx.x, DM, S_K1);
        pg8::EpiResid E{nullptr, nullptr, RP, nullptr, HB, SSQ, (float*)(F.ws + WS_SLAB), S_K1, HB};
        pg8::gemm_phase<pg8::EpiResid, pg8::TailOrder, true, true>(F.lds + RING_OFF, g, S, E, F.wave, F.lane); } SEAM(10);
    if (IN(11)) for (int rep_ = 0; rep_ < PH_REP(11); ++rep_) { PHASE_BEGIN(); finalize_sample(F, nullptr, S_K1, false); xcd_barrier(bar);
        pg8::Gemm g{HB, (const bf16*)(F.ws + WS_WUP) + (size_t)DM * FF, R, FF, DM}; pg8::StaticOrder S; S.init(R, FF, F.G, (int)blockIdx.x, DM);
        pg8::EpiScaleBf16<1> E{HH, FF, SSQ};
        pg8::gemm_phase<pg8::EpiScaleBf16<1>, pg8::StaticOrder, true, true>(F.lds + RING_OFF, g, S, E, F.wave, F.lane); } SEAM(11);
    if (IN(12)) for (int rep_ = 0; rep_ < PH_REP(12); ++rep_) { PHASE_BEGIN(); pg8::Gemm g{HH, (const bf16*)(F.ws + WS_WDN) + (size_t)DM * FF, R, DM, FF}; pg8::TailOrder S; S.init(F.G, (int)blockIdx.x, FF, S_K4);
        pg8::EpiResid E{nullptr, nullptr, RP, F.out + O_Y, nullptr, nullptr, (float*)(F.ws + WS_SLAB), S_K4, HB};
        pg8::gemm_phase<pg8::EpiResid, pg8::TailOrder, true, true>(F.lds + RING_OFF, g, S, E, F.wave, F.lane);
        xcd_barrier(bar); finalize_sample(F, nullptr, S_K4, true); }
    STAMP(13);
    if (MK_TIME >= 0 && blockIdx.x == 0 && F.wave == 0 && mk_lane() == 0) {
        volatile LAS unsigned long long* ts = (volatile LAS unsigned long long*)(F.lds + LDSCTL_OFF + 512); const unsigned long long d = MK_TIME == 20 ? ts[14] - ts[2] : MK_TIME == 21 ? ts[3] - ts[14] : MK_TIME == 22 ? ts[15] - ts[14] : MK_TIME == 23 ? ts[16] - ts[15] : ts[MK_TIME + 1] - ts[MK_TIME], t0 = __builtin_amdgcn_s_memrealtime();
        while (__builtin_amdgcn_s_memrealtime() - t0 < d) __builtin_amdgcn_s_sleep(8); }
#undef IN
#undef SEAM
#undef SSQ
#undef HB
#undef MIX
#undef HH
#undef PHASE_BEGIN
}

template <int PM> static void launch_pm(int grid, hipStream_t stream, const Args& a) { hipLaunchKernelGGL(yoco_fwd<PM>, dim3(grid), dim3(NWAVES * 64), LDS_BYTES, stream, a); }
template <int PM> static bool set_lds() { return hipFuncSetAttribute((const void*)yoco_fwd<PM>, hipFuncAttributeMaxDynamicSharedMemorySize, LDS_BYTES) == hipSuccess; }
extern "C" void kernel_launch(void* const* d_in, const int* in_sizes, int n_in, void* d_out, int out_size, void* d_ws, size_t ws_size, hipStream_t stream) {
    static int grid = 0;
    if (grid == 0) {
        if (n_in != N_IN || (size_t)out_size != O_END || ws_size < WS_END) { fprintf(stderr, "kernel_launch: unexpected shapes (n_in %d, out %d, ws %zu < %zu)\n", n_in, out_size, ws_size, (size_t)WS_END); grid = -1; return; }
        int dev = 0, cus = 0;
        if (hipGetDevice(&dev) != hipSuccess || hipDeviceGetAttribute(&cus, hipDeviceAttributeMultiprocessorCount, dev) != hipSuccess) { grid = -1; return; }
        bool ok = true;
#if MK_ONE_LAUNCH
        ok = set_lds<0x1fff>();
#else
        ok = set_lds<1>() && set_lds<2>() && set_lds<4>() && set_lds<8>() && set_lds<16>() && set_lds<32>() && set_lds<64>() && set_lds<128>() && set_lds<256>() && set_lds<512>() && set_lds<1024>() && set_lds<2048>() && set_lds<4096>();
#endif
        if (!ok) { grid = -1; return; }
        (void)hipGetLastError();
        grid = cus;
    }
    if (grid < 0) return;
    (void)hipMemsetAsync((char*)d_ws + WS_CTL, 0, CTL_ZERO_BYTES, stream);
    Args a{};
    for (int i = 0; i < N_IN; ++i) a.in[i] = (const float*)d_in[i];
    a.out = (float*)d_out; a.ws = (unsigned char*)d_ws;
#if MK_ONE_LAUNCH
    a.ph_lo = 0; a.ph_hi = N_PHASES; launch_pm<0x1fff>(grid, stream, a);
#else
#define LP(p) a.ph_lo = (p); a.ph_hi = (p) + 1; launch_pm<(1 << (p))>(grid, stream, a);
    LP(0) LP(1) LP(2) LP(3) LP(4) LP(5) LP(6) LP(7) LP(8) LP(9) LP(10) LP(11) LP(12)
#undef LP
#endif
}
```

```cpp
#include <hip/hip_runtime.h>
#include <cstdio>
#include <cstdint>
namespace pg8 {
#define PG8_LAS __attribute__((address_space(3)))
typedef unsigned short bf16_t;
typedef short bf16x8 __attribute__((ext_vector_type(8)));
typedef float f32x4 __attribute__((ext_vector_type(4)));
typedef unsigned u32x4 __attribute__((ext_vector_type(4)));
constexpr int BM = 256, BK = 64, HALF = 128, HTB = HALF * BK * 2  , STAGE_BYTES = 8 * HTB, NXCD = 8, WGM = 8;

__host__ __device__ __forceinline__ int lds_byte(int r, int c) { const int st = (r >> 4) * 2 + (c >> 5), rr = r & 15, cc = c & 31, ob = rr * 64 + cc * 2; return st * 1024 + (ob ^ (((ob >> 9) & 1) << 5)); }
__host__ __device__ __forceinline__ void stage_rc(int b, int& R, int& C) { const int st = b / 1024, sb = b % 1024, swz = sb ^ (((sb >> 9) & 1) << 5); R = (st >> 1) * 16 + swz / 64; C = (st & 1) * 32 + (swz % 64) / 2; }
__host__ __device__ __forceinline__ int perm32(int rho) { const int n = rho >> 4, i = rho & 15; return 8 * (i >> 2) + 4 * n + (i & 3); }

struct Unit { int pm, pn, kt0, nt; };
struct Gemm { const bf16_t* A; const bf16_t* Bt; int M, N, K; };

struct StaticOrder {
    int nM, nN, nwg, G, c, ntf;
    __host__ __device__ void init(int M, int N, int G_, int c_, int K_) { nM = M / BM; nN = N / BM; nwg = nM * nN; G = G_; c = c_; ntf = K_ / BK; }
    __host__ __device__ bool next(int i, Unit& u) const {
        const long L = (long)i * G + c; if (L >= nwg) return false;
        int wgid = (int)L; { const int q = nwg / NXCD, r = nwg % NXCD, xcd = wgid % NXCD, off = wgid / NXCD; wgid = (xcd < r ? xcd * (q + 1) : r * (q + 1) + (xcd - r) * q) + off; }
        const int nig = WGM * nN, gid = wgid / nig, fm = gid * WGM, gsz = (nM - fm) < WGM ? (nM - fm) : WGM;
        u.pm = fm + ((wgid % nig) % gsz); u.pn = (wgid % nig) / gsz; u.kt0 = 0; u.nt = ntf; return true;
    }
    __device__ __forceinline__ void a_ready(const Unit&) const {}
    __device__ __forceinline__ void done(const Unit&) const {}
};
struct TailOrder {
    StaticOrder P; int S, ntf;
    __host__ __device__ void init(int G_, int c_, int K_, int S_) { P.init(64 * BM, 4 * BM, G_, c_, K_); S = S_; ntf = K_ / BK; }
    __host__ __device__ bool next(int i, Unit& u) const {
        const long L = (long)i * P.G + P.c; if (L >= 256 + 8 * S) return false;
        const int Li = (int)L; const bool prm = Li < 256;
        const int w0 = prm ? Li : 0, wg = (w0 % NXCD) * (256 / NXCD) + w0 / NXCD, nig = WGM * 4, gid = wg / nig, fm = gid * WGM;
        const int pmP = fm + ((wg % nig) % WGM), pnP = (wg % nig) / WGM;
        const int Ls = prm ? 0 : Li - 256, tile = Ls / S, sl = Ls % S, nts = ntf / S;
        u.pm = prm ? pmP : 64 + (tile >> 2); u.pn = prm ? pnP : (tile & 3); u.nt = prm ? ntf : nts; u.kt0 = prm ? 0 : sl * nts; return true;
    }
    __device__ __forceinline__ void a_ready(const Unit&) const {}
    __device__ __forceinline__ void done(const Unit&) const {}
};


typedef float f32x2_t __attribute__((ext_vector_type(2))); typedef __bf16 bf16x2_t __attribute__((ext_vector_type(2)));
__device__ __forceinline__ unsigned cvt_pk_bf16(float lo, float hi) { f32x2_t v = {lo, hi}; bf16x2_t b = __builtin_convertvector(v, bf16x2_t); return __builtin_bit_cast(unsigned, b); }
__device__ __forceinline__ u32x4 pack8(f32x4 v0, f32x4 v1) { u32x4 w; w.x = cvt_pk_bf16(v0[0], v0[1]); w.y = cvt_pk_bf16(v0[2], v0[3]); w.z = cvt_pk_bf16(v1[0], v1[1]); w.w = cvt_pk_bf16(v1[2], v1[3]); return w; }

template <int M> __device__ __forceinline__ float swz_xor(float v) { return __int_as_float(__builtin_amdgcn_ds_swizzle(__float_as_int(v), (M << 10) | 0x1f)); }
__device__ __forceinline__ float add_x32(float v) { auto r = __builtin_amdgcn_permlane32_swap(__float_as_uint(v), __float_as_uint(v), false, false); return __uint_as_float(r[0]) + __uint_as_float(r[1]); }
__device__ __forceinline__ float max_x32(float v) { auto r = __builtin_amdgcn_permlane32_swap(__float_as_uint(v), __float_as_uint(v), false, false); return fmaxf(__uint_as_float(r[0]), __uint_as_float(r[1])); }
__device__ __forceinline__ float add_x16(float v) { return v + swz_xor<16>(v); }
template <int CTRL> __device__ __forceinline__ float dpp_mov(float v) { return __int_as_float(__builtin_amdgcn_update_dpp(0, __float_as_int(v), CTRL, 0xf, 0xf, false)); }
__device__ __forceinline__ float sum16_dpp(float v) { v += dpp_mov<0xB1>(v); v += dpp_mov<0x4E>(v); v += dpp_mov<0x141>(v); v += dpp_mov<0x140>(v); return v; }
__device__ __forceinline__ float max16_dpp(float v) { v = fmaxf(v, dpp_mov<0xB1>(v)); v = fmaxf(v, dpp_mov<0x4E>(v)); v = fmaxf(v, dpp_mov<0x141>(v)); v = fmaxf(v, dpp_mov<0x140>(v)); return v; }
__device__ __forceinline__ float sum4_dpp(float v) { v += dpp_mov<0xB1>(v); v += dpp_mov<0x4E>(v); return v; }
__device__ __forceinline__ float hsum4(f32x4 a) { return (a[0] + a[1]) + (a[2] + a[3]); }
__device__ __forceinline__ float row_rstd(const float* ssq, int row) {
    const f32x4* p = (const f32x4*)(ssq + (size_t)row * 16);
    const f32x4 a = p[0], b = p[1], c = p[2], d = p[3];
    const float s = (hsum4(a) + hsum4(b)) + (hsum4(c) + hsum4(d));
    return rsqrtf(s * (1.0f / 1024.0f) + 1e-6f);
}
template <int ACT> struct EpiScaleBf16 {
    static constexpr bool PERM = true, AFTER_DRAIN = false;
    bf16_t* O; int ldc; const float* ssq;
    __device__ __forceinline__ void operator()(const f32x4 (&acc)[2][2][4][2], const Unit& u, int wr, int wc, int fr_, int fq_) const {
        int fr = fr_, fq = fq_; asm volatile("" : "+v"(fr), "+v"(fq));
        const int row0 = u.pm * BM + wr * 64 + fr, col0 = u.pn * BM + wc * 32 + 8 * fq;
#pragma unroll
        for (int ai = 0; ai < 2; ++ai)
#pragma unroll
            for (int m = 0; m < 4; ++m) { const int row = row0 + ai * HALF + m * 16; const float rs = row_rstd(ssq, row); bf16_t* rowp = O + (size_t)row * ldc + col0;
#pragma unroll
                for (int bj = 0; bj < 2; ++bj) { f32x4 v0 = acc[ai][bj][m][0] * rs, v1 = acc[ai][bj][m][1] * rs;
                    if (ACT == 1) {
#pragma unroll
                        for (int e = 0; e < 4; ++e) { const float a = fmaxf(v0[e], 0.f), b = fmaxf(v1[e], 0.f); v0[e] = a * a; v1[e] = b * b; } }
                    *(u32x4*)(rowp + bj * HALF) = pack8(v0, v1); } }
    }
};
struct EpiResid {
    static constexpr bool PERM = true, AFTER_DRAIN = false;
    const float* base; const float* base2; int split; float* out; bf16_t* hb; float* ssq_out; float* slab; int S; const bf16_t* hbase = nullptr; int omask = -1;
    __device__ __forceinline__ void operator()(const f32x4 (&acc)[2][2][4][2], const Unit& u, int wr, int wc, int fr_, int fq_) const {
        int fr = fr_, fq = fq_; asm volatile("" : "+v"(fr), "+v"(fq));
        if (slab && u.pm >= 64) {
            float* sp = slab + ((size_t)((((u.pm - 64) << 2) + u.pn) * S + u.kt0 / u.nt) << 16) + (size_t)(wr * 64 + fr) * 256 + wc * 32 + 8 * fq;
#pragma unroll
            for (int ai = 0; ai < 2; ++ai)
#pragma unroll
                for (int m = 0; m < 4; ++m)
#pragma unroll
                    for (int bj = 0; bj < 2; ++bj) { float* p = sp + (size_t)(ai * HALF + m * 16) * 256 + bj * HALF; *(f32x4*)p = acc[ai][bj][m][0]; *(f32x4*)(p + 4) = acc[ai][bj][m][1]; }
            return;
        }
        const int row0 = u.pm * BM + wr * 64 + fr, col0 = u.pn * BM + wc * 32 + 8 * fq;
#pragma unroll
        for (int ai = 0; ai < 2; ++ai)
#pragma unroll
            for (int m = 0; m < 4; ++m) { const int row = row0 + ai * HALF + m * 16;
                const float* bp = (row < split ? base + (size_t)row * 1024 : base2 + (size_t)(row - split) * 1024) + col0;
                float ss = 0.f;
#pragma unroll
                for (int bj = 0; bj < 2; ++bj) { f32x4 b0, b1;
                    if (hbase) { const u32x4 w = *(const u32x4*)(hbase + (size_t)row * 1024 + col0 + bj * HALF);
                        b0 = (f32x4){__uint_as_float(w.x << 16), __uint_as_float(w.x & 0xffff0000u), __uint_as_float(w.y << 16), __uint_as_float(w.y & 0xffff0000u)};
                        b1 = (f32x4){__uint_as_float(w.z << 16), __uint_as_float(w.z & 0xffff0000u), __uint_as_float(w.w << 16), __uint_as_float(w.w & 0xffff0000u)}; }
                    else { b0 = *(const f32x4*)(bp + bj * HALF); b1 = *(const f32x4*)(bp + bj * HALF + 4); }
                    const f32x4 h0 = b0 + acc[ai][bj][m][0], h1 = b1 + acc[ai][bj][m][1];
                    if (out) { float* op = out + (size_t)(row & omask) * 1024 + col0; *(f32x4*)(op + bj * HALF) = h0; *(f32x4*)(op + bj * HALF + 4) = h1; }
                    if (hb) *(u32x4*)(hb + (size_t)row * 1024 + col0 + bj * HALF) = pack8(h0, h1);
                    ss += hsum4(h0 * h0) + hsum4(h1 * h1); }
                if (ssq_out) { ss = add_x16(ss); ss = add_x32(ss); if (fq == 0) ssq_out[(size_t)row * 16 + u.pn * 4 + wc] = ss; }
                if (m == 3) asm volatile("" ::: "memory"); }
    }
};
template <class Epi, class Sched, bool ALIGN_EPI = false, bool SP2 = false>
__device__ __forceinline__ void gemm_phase(PG8_LAS unsigned char* lds, const Gemm g, const Sched& S, const Epi& E, int wid_in, int lane_in) {
    const int wid = wid_in, lane = lane_in, tid = wid * 64 + lane, wr = wid >> 2, wc = wid & 3, fr = lane & 15, fq = lane >> 4;
    const int K = g.K;
    unsigned voffA[2], voffB[2];
#pragma unroll
    for (int i = 0; i < 2; ++i) { int R, C; stage_rc(tid * 16 + i * 8192, R, C); const int Rb = Epi::PERM ? ((R & ~31) + perm32(R & 31)) : R;
        voffA[i] = (unsigned)(R * K + C) * 2u; voffB[i] = (unsigned)(Rb * K + C) * 2u; }
    const size_t kstep = (size_t)(BK * 2);
    const size_t hstep = (size_t)HALF * K * 2;
    const size_t tstep = 2 * hstep;
    const unsigned ldsw = (unsigned)wid * 1024u;
    const int aoff = lds_byte(wr * 64 + fr, fq * 8), boff = lds_byte(wc * 32 + fr, fq * 8);
#define PG8_SA(b, h) (((b) * 2 + (h)) * HTB)
#define PG8_SB(b, h) ((4 + (b) * 2 + (h)) * HTB)
#define PG8_STAGE(bufoff, gbase, voff) do { _Pragma("unroll") for (int _i = 0; _i < 2; ++_i) \
        __builtin_amdgcn_global_load_lds((const unsigned*)((const char*)(gbase) + (voff)[_i]), (PG8_LAS unsigned*)(lds + (bufoff) + ldsw + _i * 8192), 16, 0, 0); } while (0)
#define PG8_LDA(dst, b, h) do { _Pragma("unroll") for (int m = 0; m < 4; ++m) _Pragma("unroll") for (int k = 0; k < 2; ++k) dst[m][k] = *(const PG8_LAS bf16x8*)(lds + PG8_SA(b, h) + aoff + m * 2048 + k * 1024); } while (0)
#define PG8_LDB(dst, b, h) do { _Pragma("unroll") for (int n = 0; n < 2; ++n) _Pragma("unroll") for (int k = 0; k < 2; ++k) dst[n][k] = *(const PG8_LAS bf16x8*)(lds + PG8_SB(b, h) + boff + n * 2048 + k * 1024); } while (0)
#define PG8_MMA(ai, bj, At, Bt) do { __builtin_amdgcn_s_setprio(1); _Pragma("unroll") for (int m = 0; m < 4; ++m) _Pragma("unroll") for (int n = 0; n < 2; ++n) _Pragma("unroll") for (int k = 0; k < 2; ++k) \
        acc[ai][bj][m][n] = __builtin_amdgcn_mfma_f32_16x16x32_bf16(Bt[n][k], At[m][k], acc[ai][bj][m][n], 0, 0, 0); __builtin_amdgcn_s_setprio(0); } while (0)
#define PG8_WAIT_V(n) asm volatile("s_waitcnt vmcnt(" #n ")" ::: "memory")
#define PG8_WAIT_L(n) asm volatile("s_waitcnt lgkmcnt(" #n ")" ::: "memory")
#define PG8_BAR __builtin_amdgcn_s_barrier()
#define PG8_SCHED __builtin_amdgcn_sched_barrier(0)
    Unit cur, nxt; int ui = 0;
    if (!S.next(0, cur)) return;
    f32x4 acc[2][2][4][2];
#pragma unroll
    for (int a = 0; a < 2; ++a)
#pragma unroll
        for (int b = 0; b < 2; ++b)
#pragma unroll
            for (int m = 0; m < 4; ++m)
#pragma unroll
                for (int n = 0; n < 2; ++n) acc[a][b][m][n] = (f32x4){0.f, 0.f, 0.f, 0.f};
    bf16x8 At[4][2], B0[2][2], B1[2][2];
    const char* cA = (const char*)g.A + (size_t)cur.pm * tstep + (size_t)cur.kt0 * kstep; const char* cB = (const char*)g.Bt + (size_t)cur.pn * tstep + (size_t)cur.kt0 * kstep;
    S.a_ready(cur);
    if constexpr (SP2) {
        PG8_STAGE(PG8_SB(0, 0), cB, voffB); PG8_STAGE(PG8_SB(0, 1), cB + hstep, voffB); PG8_STAGE(PG8_SA(0, 0), cA, voffA); PG8_STAGE(PG8_SA(0, 1), cA + hstep, voffA);
        if (wr == 1) PG8_BAR;
        PG8_WAIT_V(2); PG8_BAR;
        PG8_STAGE(PG8_SB(1, 0), cB + kstep, voffB); PG8_STAGE(PG8_SA(1, 0), cA + kstep, voffA); PG8_STAGE(PG8_SB(1, 1), cB + hstep + kstep, voffB);
        PG8_WAIT_V(6); PG8_BAR;
    } else {
        PG8_STAGE(PG8_SB(0, 0), cB, voffB); PG8_STAGE(PG8_SA(0, 0), cA, voffA); PG8_STAGE(PG8_SB(0, 1), cB + hstep, voffB); PG8_STAGE(PG8_SA(0, 1), cA + hstep, voffA);
        if (wr == 1) PG8_BAR;
        PG8_WAIT_V(4); PG8_BAR;
        PG8_STAGE(PG8_SB(1, 0), cB + kstep, voffB); PG8_STAGE(PG8_SA(1, 0), cA + kstep, voffA); PG8_STAGE(PG8_SB(1, 1), cB + hstep + kstep, voffB);
        PG8_WAIT_V(6); PG8_BAR;
    }
    for (;;) {
        const bool has_next = S.next(ui + 1, nxt);
        const char* nA = has_next ? (const char*)g.A + (size_t)nxt.pm * tstep + (size_t)nxt.kt0 * kstep : cA; const char* nB = has_next ? (const char*)g.Bt + (size_t)nxt.pn * tstep + (size_t)nxt.kt0 * kstep : cB;
        const int nt = cur.nt;
        for (int t = 0; t < nt; t += 2) {
            const bool last = (t == nt - 2);
            const char* a1 = cA + (size_t)(t + 1) * kstep;
            const char* a2 = last ? nA : cA + (size_t)(t + 2) * kstep; const char* b2 = last ? nB : cB + (size_t)(t + 2) * kstep;
            const char* a3 = a2 + kstep; const char* b3 = b2 + kstep;
            if (last && has_next) S.a_ready(nxt);
            if constexpr (SP2) {
            PG8_LDB(B0, 0, 0); PG8_LDB(B1, 0, 1); PG8_SCHED; PG8_LDA(At, 0, 0); PG8_STAGE(PG8_SA(1, 1), a1 + hstep, voffA);
            PG8_WAIT_V(8); PG8_WAIT_L(0); PG8_BAR; PG8_MMA(0, 0, At, B0); PG8_MMA(0, 1, At, B1); PG8_BAR; PG8_SCHED;
            PG8_LDA(At, 0, 1); PG8_STAGE(PG8_SB(0, 0), b2, voffB); PG8_STAGE(PG8_SB(0, 1), b2 + hstep, voffB); PG8_STAGE(PG8_SA(0, 0), a2, voffA);
            PG8_WAIT_V(8); PG8_WAIT_L(0); PG8_BAR; PG8_MMA(1, 0, At, B0); PG8_MMA(1, 1, At, B1); PG8_BAR; PG8_SCHED;
            PG8_LDB(B0, 1, 0); PG8_LDB(B1, 1, 1); PG8_SCHED; PG8_LDA(At, 1, 0); PG8_STAGE(PG8_SA(0, 1), a2 + hstep, voffA);
            PG8_WAIT_V(8); PG8_WAIT_L(0); PG8_BAR; PG8_MMA(0, 0, At, B0); PG8_MMA(0, 1, At, B1); PG8_BAR; PG8_SCHED;
            PG8_LDA(At, 1, 1); PG8_STAGE(PG8_SB(1, 0), b3, voffB); PG8_STAGE(PG8_SB(1, 1), b3 + hstep, voffB); PG8_STAGE(PG8_SA(1, 0), a3, voffA);
            PG8_WAIT_V(8); PG8_WAIT_L(0); PG8_BAR; PG8_MMA(1, 0, At, B0); PG8_MMA(1, 1, At, B1); PG8_BAR; PG8_SCHED;
            } else {
            PG8_LDB(B0, 0, 0); PG8_SCHED; PG8_LDA(At, 0, 0); PG8_STAGE(PG8_SA(1, 1), a1 + hstep, voffA);
            PG8_WAIT_L(8); PG8_BAR; PG8_WAIT_L(0); PG8_MMA(0, 0, At, B0); PG8_BAR; PG8_SCHED;
            PG8_LDB(B1, 0, 1); PG8_STAGE(PG8_SB(0, 0), b2, voffB);
            PG8_BAR; PG8_WAIT_L(0); PG8_MMA(0, 1, At, B1); PG8_BAR;
            PG8_LDA(At, 0, 1); PG8_STAGE(PG8_SA(0, 0), a2, voffA);
            PG8_BAR; PG8_WAIT_L(0); PG8_MMA(1, 0, At, B0); PG8_BAR; PG8_SCHED;
            PG8_STAGE(PG8_SB(0, 1), b2 + hstep, voffB);
            PG8_WAIT_V(6); PG8_BAR; PG8_MMA(1, 1, At, B1); PG8_BAR;
            PG8_LDB(B0, 1, 0); PG8_SCHED; PG8_LDA(At, 1, 0); PG8_STAGE(PG8_SA(0, 1), a2 + hstep, voffA);
            PG8_WAIT_L(8); PG8_BAR; PG8_WAIT_L(0); PG8_MMA(0, 0, At, B0); PG8_BAR; PG8_SCHED;
            PG8_LDB(B1, 1, 1); PG8_STAGE(PG8_SB(1, 0), b3, voffB);
            PG8_BAR; PG8_WAIT_L(0); PG8_MMA(0, 1, At, B1); PG8_BAR;
            PG8_LDA(At, 1, 1); PG8_STAGE(PG8_SA(1, 0), a3, voffA);
            PG8_BAR; PG8_WAIT_L(0); PG8_MMA(1, 0, At, B0); PG8_BAR; PG8_SCHED;
            PG8_STAGE(PG8_SB(1, 1), b3 + hstep, voffB);
            PG8_WAIT_V(6); PG8_BAR; PG8_MMA(1, 1, At, B1); PG8_BAR;
            }
        }
        if constexpr (ALIGN_EPI) { if (wr == 0) PG8_BAR; }
        if constexpr (!Epi::AFTER_DRAIN) { E(acc, cur, wr, wc, fr, fq); S.done(cur); }
        if (!has_next) break;
#pragma unroll
        for (int a = 0; a < 2; ++a)
#pragma unroll
            for (int b = 0; b < 2; ++b)
#pragma unroll
                for (int m = 0; m < 4; ++m)
#pragma unroll
                    for (int n = 0; n < 2; ++n) acc[a][b][m][n] = (f32x4){0.f, 0.f, 0.f, 0.f};
        cur = nxt; cA = nA; cB = nB; ++ui;
        if constexpr (ALIGN_EPI) { if (wr == 1) PG8_BAR; }
    }
    PG8_WAIT_V(0);
    if constexpr (!ALIGN_EPI) { if (wr == 0) PG8_BAR; }
    PG8_BAR;
    if constexpr (Epi::AFTER_DRAIN) { E.fused(acc, cur, wr, wc, fr, fq, lds, wid, lane); S.done(cur); }
#undef PG8_SA
#undef PG8_SB
#undef PG8_STAGE
#undef PG8_LDA
#undef PG8_LDB
#undef PG8_MMA
#undef PG8_WAIT_V
#undef PG8_WAIT_L
#undef PG8_BAR
#undef PG8_SCHED
}
}

constexpr int NWAVES = 8;
#ifndef MK_ONE_LAUNCH
#define MK_ONE_LAUNCH 1
#endif
constexpr int DM = 1024, RP = 16384  , RS = 512  , R = RP + RS, T = 8192, NB = 2, SB = 128, ST = 4;
constexpr int NCOLA = 2816, RWKV_COLS = 2560, NH = 12, HD = 64, FF = 4096, NCOLB = 1536, NMEM = 256;
constexpr int NCHUNK = RP / 64  , NUNIT = NCHUNK * NH  ;
constexpr float C2Q = 0.125f * 1.4426950408889634f;
constexpr float LOG2E = 1.4426950408889634f;
enum { I_XP = 0, I_XS, I_SSHIFT, I_SWKV, I_CSK, I_CSV, I_CMK, I_CMV, I_MEMP, I_NMIX, I_NMLP, I_WOUT, I_WUP, I_WDN, I_MNORM, I_WMKV, I_MQN, I_MKN,
       I_WINA, I_MU, I_WW2, I_W0, I_WA2, I_A0, I_WG2, I_KK, I_KA, I_RK, I_LNW, I_LNB, I_WINB, I_QN, I_SINKS, I_KVN, I_WKV, I_KN, N_IN };
constexpr size_t O_Y = 0, O_PSHIFT = (size_t)R * DM, O_PWKV = O_PSHIFT + 2 * RWKV_COLS, O_PSK = O_PWKV + 2 * 12 * 4096, O_PSV = O_PSK + 2 * 128 * 256,
                 O_PMK = O_PSV + 2 * 128 * 256, O_PMV = O_PMK + 2 * 2 * 256 * 256, O_SSHIFT = O_PMV + 2 * 2 * 256 * 256, O_SWKV = O_SSHIFT + (size_t)SB * RWKV_COLS,
                 O_SSK = O_SWKV + (size_t)SB * 12 * 4096, O_SSV = O_SSK + (size_t)SB * 128 * 256, O_END = O_SSV + (size_t)SB * 128 * 256;
constexpr size_t al256(size_t x) { return (x + 255) & ~(size_t)255; }
constexpr size_t WS_CTL = 0, CTL_ZERO_BYTES = 1u << 15;
constexpr size_t WS_WA = 1u << 20;
constexpr size_t WS_WOUT = WS_WA + (size_t)NCOLA * DM * 2;
constexpr size_t WS_WUP = WS_WOUT + (size_t)2 * DM * DM * 2;
constexpr size_t WS_WDN = WS_WUP + (size_t)2 * FF * DM * 2;
constexpr size_t WS_WB = WS_WDN + (size_t)2 * FF * DM * 2;
constexpr size_t WS_WM = WS_WB + (size_t)NCOLB * DM * 2;
constexpr size_t WS_WW2 = WS_WM + (size_t)DM * DM * 2;
constexpr size_t WS_WA2 = WS_WW2 + (size_t)768 * 64 * 2;
constexpr size_t WS_WG2 = WS_WA2 + (size_t)768 * 64 * 2;
constexpr size_t WS_ROPE = WS_WG2 + (size_t)768 * 128 * 2;
constexpr size_t WS_SSQ = al256(WS_ROPE + (size_t)8196 * 64 * 4);
constexpr size_t WS_SSQM = WS_SSQ + (size_t)R * 16 * 4;
constexpr size_t WS_MB = WS_SSQM + (size_t)512 * 16 * 4;
constexpr size_t WS_MK = WS_MB + (size_t)512 * DM * 2;
constexpr size_t WS_MVT = WS_MK + (size_t)2 * 2 * 4 * 256 * 64 * 2;
constexpr size_t WS_HB = WS_MVT + (size_t)2 * 2 * 4 * 256 * 64 * 2;
constexpr size_t WS_MIX = WS_HB + (size_t)R * DM * 2;
constexpr size_t WS_BIG = WS_MIX + (size_t)R * DM * 2;
constexpr size_t WS_PROJ = WS_BIG;
constexpr size_t WS_REC = WS_PROJ + (size_t)R * NCOLA * 2;
constexpr size_t REC_BYTES = 5 * 8192;
constexpr size_t WS_END0 = WS_REC + (size_t)NUNIT * REC_BYTES;
constexpr size_t WS_H = WS_BIG;
constexpr size_t WS_END1 = WS_H + (size_t)R * FF * 2;
constexpr size_t WS_SLAB = WS_BIG + ((size_t)160 << 20);
constexpr int S_K1 = 4, S_K4 = 16;
constexpr size_t WS_Q1 = WS_BIG;
constexpr size_t WS_K1 = WS_Q1 + (size_t)R * DM * 2;
constexpr size_t WS_V1 = WS_K1 + (size_t)R * 256 * 2;
constexpr size_t WS_VT1 = WS_V1 + (size_t)R * 256 * 2;
constexpr size_t WS_END = WS_END0 > WS_END1 ? WS_END0 : WS_END1;
static_assert(WS_VT1 + (size_t)2 * 4 * 64 * 8192 * 2 <= WS_END && WS_END1 <= WS_SLAB && WS_SLAB + ((size_t)32 << 20) <= WS_END, "ws map");
constexpr int CW_BAR = 4096;
constexpr int RING_OFF = 0, RING_BYTES = 131072, PREP_HALF = 73728, LDSCTL_OFF = 147456, MISC_OFF = LDSCTL_OFF + 320, WTOT_OFF = LDSCTL_OFF + 1024, LDS_BYTES = LDSCTL_OFF + 4096;

#define GAS __attribute__((address_space(1)))
#define LAS __attribute__((address_space(3)))
typedef unsigned short bf16;
typedef unsigned v4u __attribute__((ext_vector_type(4)));
typedef unsigned v2u __attribute__((ext_vector_type(2)));
typedef float f32x4 __attribute__((ext_vector_type(4)));
typedef float f32x16 __attribute__((ext_vector_type(16)));
typedef short bf16x8 __attribute__((ext_vector_type(8)));
typedef short bf16x4 __attribute__((ext_vector_type(4)));
typedef GAS unsigned gu32;
#define RLX_AGENT __ATOMIC_RELAXED, __HIP_MEMORY_SCOPE_AGENT
#define LDS_WAIT() asm volatile("s_waitcnt lgkmcnt(0)" ::: "memory")
#define VM_WAIT() asm volatile("s_waitcnt vmcnt(0)" ::: "memory")
using pg8::cvt_pk_bf16;
__device__ __forceinline__ int mk_lane() { int l; asm volatile("v_mbcnt_lo_u32_b32 %0, -1, 0\n\tv_mbcnt_hi_u32_b32 %0, -1, %0" : "=v"(l)); return l; }
__device__ __forceinline__ float bf2f(unsigned v) { return __uint_as_float(v << 16); }
__device__ __forceinline__ float bflo(unsigned w) { return __uint_as_float(w << 16); }
__device__ __forceinline__ float bfhi(unsigned w) { return __uint_as_float(w & 0xffff0000u); }
__device__ __forceinline__ bf16 f2bf(float f) { return (bf16)(cvt_pk_bf16(f, 0.f) & 0xffffu); }
__device__ __forceinline__ v2u pack4(f32x4 v) { v2u w; w.x = cvt_pk_bf16(v[0], v[1]); w.y = cvt_pk_bf16(v[2], v[3]); return w; }
__device__ __forceinline__ f32x4 unpack4(v2u w) { return (f32x4){bflo(w.x), bfhi(w.x), bflo(w.y), bfhi(w.y)}; }
__device__ __forceinline__ f32x4 mfma16(bf16x8 a, bf16x8 b, f32x4 c) { return __builtin_amdgcn_mfma_f32_16x16x32_bf16(a, b, c, 0, 0, 0); }
__device__ __forceinline__ f32x16 mfma32(bf16x8 a, bf16x8 b, f32x16 c) { return __builtin_amdgcn_mfma_f32_32x32x16_bf16(a, b, c, 0, 0, 0); }
using pg8::swz_xor; using pg8::add_x32; using pg8::max_x32; using pg8::add_x16; using pg8::sum16_dpp; using pg8::max16_dpp; using pg8::sum4_dpp;
__device__ __forceinline__ float sum16(float v) { return sum16_dpp(v); }
__device__ __forceinline__ float wave_sum(float v) { v = sum16_dpp(v); v = add_x16(v); return add_x32(v); }
__device__ __forceinline__ float wave_max(float v) { v = max16_dpp(v); v = fmaxf(v, swz_xor<16>(v)); return max_x32(v); }
__device__ __forceinline__ float fsigmoid(float x) { return __builtin_amdgcn_rcpf(1.0f + __expf(-x)); }
__device__ __forceinline__ float ftanh(float x) { const float e = __expf(2.0f * x); return 1.0f - 2.0f * __builtin_amdgcn_rcpf(e + 1.0f); }
namespace pg8 {
__device__ __forceinline__ void head_norm(f32x4 (&x)[2][2], const float* gain, int fq) {
    float ss = 0.f;
#pragma unroll
    for (int bj = 0; bj < 2; ++bj)
#pragma unroll
        for (int n = 0; n < 2; ++n) ss += hsum4(x[bj][n] * x[bj][n]);
    ss = add_x16(ss); ss = add_x32(ss);
    const float rs = rsqrtf(ss * (1.0f / 64.0f) + 1e-6f);
#pragma unroll
    for (int bj = 0; bj < 2; ++bj)
#pragma unroll
        for (int n = 0; n < 2; ++n) { const f32x4 g = *(const f32x4*)(gain + 32 * bj + 8 * fq + 4 * n); x[bj][n] = x[bj][n] * rs * g; }
}
__device__ __forceinline__ void head_rope(f32x4 (&x)[2][2], const float* cs  , int fq) {
#pragma unroll
    for (int n = 0; n < 2; ++n) { const f32x4 t0 = *(const f32x4*)(cs + 2 * (8 * fq + 4 * n)), t1 = *(const f32x4*)(cs + 2 * (8 * fq + 4 * n) + 4);
        const f32x4 cc = {t0[0], t0[2], t1[0], t1[2]}, sn = {t0[1], t0[3], t1[1], t1[3]};
        const f32x4 x1 = x[0][n], x2 = x[1][n]; x[0][n] = x1 * cc - x2 * sn; x[1][n] = x2 * cc + x1 * sn; }
}
struct EpiL1 {
    static constexpr bool PERM = true, AFTER_DRAIN = false;
    unsigned char* ws; float* outp; const float* g_q; const float* g_mq; const float* g_k;
    __device__ __forceinline__ void operator()(const f32x4 (&acc)[2][2][4][2], const Unit& u, int wr, int wc, int fr_, int fq_) const {
        int fr = fr_, fq = fq_; asm volatile("" : "+v"(fr), "+v"(fq));
        const float* ssq = (const float*)(ws + WS_SSQ); const float* rope = (const float*)(ws + WS_ROPE); const float c2 = C2Q;
        bf16_t* Q1 = (bf16_t*)(ws + WS_Q1); bf16_t* K1 = (bf16_t*)(ws + WS_K1); bf16_t* V1 = (bf16_t*)(ws + WS_V1);
        float* p_k = outp + O_PSK; float* p_v = outp + O_PSV; float* s_k = outp + O_SSK; float* s_v = outp + O_SSV;
        const int H = u.pn * 4 + wc, row0 = u.pm * BM + wr * 64 + fr;
#pragma unroll
        for (int ai = 0; ai < 2; ++ai)
#pragma unroll
            for (int m = 0; m < 4; ++m) { const int row = row0 + ai * HALF + m * 16; const float rs = row_rstd(ssq, row);
                const int pidx = row < 16384 ? (row & 8191) : 8192 + ((row - 16384) & 3);
                f32x4 x[2][2];
#pragma unroll
                for (int bj = 0; bj < 2; ++bj)
#pragma unroll
                    for (int n = 0; n < 2; ++n) x[bj][n] = acc[ai][bj][m][n] * rs;
                if (H < 16) {
                    head_norm(x, H < 12 ? g_q : g_mq, fq);
                    if (H < 12) head_rope(x, rope + (size_t)pidx * 64, fq);
#pragma unroll
                    for (int bj = 0; bj < 2; ++bj) *(u32x4*)(Q1 + (size_t)row * 1024 + H * 64 + 32 * bj + 8 * fq) = pack8(x[bj][0] * c2, x[bj][1] * c2);
                } else {
                    const int kh = (H - 16) & 3; const bool isk = H < 20;
                    if (isk) { head_norm(x, g_k, fq); head_rope(x, rope + (size_t)pidx * 64, fq); }
                    bf16_t* dst = isk ? K1 : V1;
#pragma unroll
                    for (int bj = 0; bj < 2; ++bj) *(u32x4*)(dst + (size_t)row * 256 + kh * 64 + 32 * bj + 8 * fq) = pack8(x[bj][0], x[bj][1]);
                    float* o = nullptr;
                    if (row < 16384) { const int b = row >> 13, t = row & 8191; if (t >= 8064) o = (isk ? p_k : p_v) + ((size_t)(b * 128 + (t - 8064)) * 4 + kh) * 64; }
                    else { const int b = (row - 16384) >> 2, i = (row - 16384) & 3; o = (isk ? s_k : s_v) + ((size_t)(b * 128 + 124 + i) * 4 + kh) * 64; }
                    if (o) {
#pragma unroll
                        for (int bj = 0; bj < 2; ++bj) { *(f32x4*)(o + 32 * bj + 8 * fq) = x[bj][0]; *(f32x4*)(o + 32 * bj + 8 * fq + 4) = x[bj][1]; } }
                }
                if (m == 3) asm volatile("" ::: "memory");
            }
    }
};
struct EpiMemKV {
    static constexpr bool PERM = true, AFTER_DRAIN = false;
    unsigned char* ws; float* outp; const float* g_k  ;
    __device__ __forceinline__ void operator()(const f32x4 (&acc)[2][2][4][2], const Unit& u, int wr, int wc, int fr_, int fq_) const {
        int fr = fr_, fq = fq_; asm volatile("" : "+v"(fr), "+v"(fq));
        const float* ssq = (const float*)(ws + WS_SSQM); float* p_k = outp + O_PMK; float* p_v = outp + O_PMV; bf16_t* MK = (bf16_t*)(ws + WS_MK)  ; bf16_t* MVT = (bf16_t*)(ws + WS_MVT)  ;
        const int H = u.pn * 4 + wc, l = H >> 3, isv = (H >> 2) & 1, hh = H & 3, row0 = u.pm * BM + wr * 64 + fr;
#pragma unroll
        for (int ai = 0; ai < 2; ++ai)
#pragma unroll
            for (int m = 0; m < 4; ++m) { const int row = row0 + ai * HALF + m * 16; const float rs = row_rstd(ssq, row); const int b = row >> 8, mm = row & 255;
                f32x4 x[2][2];
#pragma unroll
                for (int bj = 0; bj < 2; ++bj)
#pragma unroll
                    for (int n = 0; n < 2; ++n) x[bj][n] = acc[ai][bj][m][n] * rs;
                if (!isv) head_norm(x, g_k + l * 64, fq);
                float* o = (isv ? p_v : p_k) + ((((size_t)l * 2 + b) * 256 + mm) * 4 + hh) * 64;
#pragma unroll
                for (int bj = 0; bj < 2; ++bj) { *(f32x4*)(o + 32 * bj + 8 * fq) = x[bj][0]; *(f32x4*)(o + 32 * bj + 8 * fq + 4) = x[bj][1]; }
                if (!isv) {
#pragma unroll
                    for (int bj = 0; bj < 2; ++bj) *(u32x4*)(MK + ((((size_t)l * 2 + b) * 4 + hh) * 256 + mm) * 64 + 32 * bj + 8 * fq) = pack8(x[bj][0], x[bj][1]);
                } else {
#pragma unroll
                    for (int bj = 0; bj < 2; ++bj)
#pragma unroll
                        for (int n = 0; n < 2; ++n)
#pragma unroll
                            for (int e = 0; e < 4; ++e) { const int d = 32 * bj + 8 * fq + 4 * n + e; MVT[((((size_t)l * 2 + b) * 4 + hh) * 64 + d) * 256 + mm] = (bf16_t)(cvt_pk_bf16(x[bj][n][e], 0.f) & 0xffffu); }
                }
                asm volatile("" ::: "memory");
            }
    }
};
}
#define XB_TMO      128
#define XB_XCNT(j)  (256  + 64 * (j))
#define XB_XSUB(j)  (1280 + 64 * (j))
#define XB_XGEN(j)  (2304 + 64 * (j))
#define XB_TOP      3328
#define XB_TOPGEN   3392
#define XCD_BAR_WORDS 3456
#define XB_SPIN_CAP (1u << 18)

__device__ __forceinline__ unsigned xb_ld(unsigned* p)              { return __hip_atomic_load(p, __ATOMIC_RELAXED, __HIP_MEMORY_SCOPE_AGENT); }
__device__ __forceinline__ unsigned xb_add(unsigned* p, unsigned v) { return __hip_atomic_fetch_add(p, v, __ATOMIC_RELAXED, __HIP_MEMORY_SCOPE_AGENT); }
__device__ __forceinline__ unsigned xb_xcc_id() { return (unsigned)__builtin_amdgcn_s_getreg((3 << 11) | 20) & 0xFu; }
#define XB_SPIN(cond, bar) do { unsigned _sp = 0; while (cond) { __builtin_amdgcn_s_sleep(1); \
    if ((++_sp & 255u) == 0u) { if (xb_ld(&(bar)[XB_TMO])) break; if (_sp > XB_SPIN_CAP) { atomicAdd(&(bar)[XB_TMO], 1u); break; } } } } while (0)

struct XcdBarrier {
    bool wave0;
    unsigned* bar; unsigned x;
    volatile LAS unsigned* st;
};

__device__ __forceinline__ XcdBarrier xcd_barrier_post(unsigned* bar, volatile LAS unsigned* st, bool wave0) {
    XcdBarrier b; b.wave0 = wave0; b.bar = bar; b.x = xb_xcc_id(); b.st = st;
    if (wave0 && mk_lane() == 0) (void)xb_add(&bar[XB_XCNT(b.x)], 1u);
    return b;
}
__device__ __forceinline__ void xcd_barrier_complete(unsigned* bar, unsigned x, unsigned& nloc, unsigned& nx) {
    const unsigned G = gridDim.x * gridDim.y * gridDim.z;
    unsigned sum, cnt, mine, sp = 0u;
    for (;;) {
        sum = 0u; cnt = 0u; mine = 0u;
#pragma unroll
        for (unsigned j = 0; j < 16; ++j) { const unsigned c = xb_ld(&bar[XB_XCNT(j)]); sum += c; cnt += (c > 0u) ? 1u : 0u; mine = (j == x) ? c : mine; }
        if (sum == G) break;
        __builtin_amdgcn_s_sleep(1);
        if ((++sp & 255u) == 0u) { if (xb_ld(&bar[XB_TMO])) break; if (sp > XB_SPIN_CAP) { atomicAdd(&bar[XB_TMO], 1u); break; } }
    }
    nloc = mine > 0u ? mine : 1u; nx = cnt > 0u ? cnt : 1u;
}

__device__ __forceinline__ void xcd_barrier(const XcdBarrier& b) {
    asm volatile("s_waitcnt vmcnt(0)" ::: "memory");
    __syncthreads();
    if (b.wave0 && mk_lane() == 0) {
        unsigned* bar = b.bar;
        __builtin_amdgcn_s_waitcnt(0);
        unsigned nloc = b.st[0], nx = b.st[1];
        if (nloc == 0u) { xcd_barrier_complete(bar, b.x, nloc, nx); b.st[0] = nloc; b.st[1] = nx; }
        const unsigned old = xb_add(&bar[XB_XSUB(b.x)], 1u);
        const unsigned gen = old / nloc;
        if (old + 1u == (gen + 1u) * nloc) {
            __builtin_amdgcn_fence(__ATOMIC_RELEASE, "agent");
            asm volatile("s_waitcnt vmcnt(0)" ::: "memory");
            const unsigned og = xb_add(&bar[XB_TOP], 1u);
            const unsigned tg = og / nx;
            if (og + 1u == (tg + 1u) * nx) xb_add(&bar[XB_TOPGEN], 1u);
            else XB_SPIN(xb_ld(&bar[XB_TOPGEN]) == tg, bar);
            __builtin_amdgcn_fence(__ATOMIC_ACQUIRE, "agent");
            xb_add(&bar[XB_XGEN(b.x)], 1u);
            asm volatile("s_waitcnt vmcnt(0)" ::: "memory");
        } else {
            XB_SPIN(xb_ld(&bar[XB_XGEN(b.x)]) == gen, bar);
            __builtin_amdgcn_fence(__ATOMIC_ACQUIRE, "agent");
            asm volatile("s_waitcnt vmcnt(0)" ::: "memory");
        }
    }
    __syncthreads();
}

struct Args { const float* in[N_IN]; float* out; unsigned char* ws; int ph_lo, ph_hi; };
struct Frame {
    LAS unsigned char* lds; unsigned char* lds_g;
    gu32* ctl;
    int tid, lane, wave, vcu, G;
    const float* const* in; float* out; unsigned char* ws;
};
__host__ __device__ __forceinline__ int wsig_inv(int nl) { return 128 * ((nl >> 5) & 1) + 32 * (nl >> 6) + (nl & 31); }

__device__ __forceinline__ void p0_transpose_item(const float* W, int K, int N, bf16* WT, int row_off, bool sig, const float* gain, LAS float* scr, int item, int lane) {
    const int nblk = N / 32, kb = item / nblk, nb = item % nblk, k0 = 64 * kb, n0 = 32 * nb;
    float tv[32];
#pragma unroll
    for (int i = 0; i < 32; ++i) { const int kk = 2 * i + (lane >> 5); tv[i] = W[(size_t)(k0 + kk) * N + n0 + (lane & 31)]; }
    __builtin_amdgcn_sched_barrier(0);
    if (gain) {
#pragma unroll
        for (int i = 0; i < 32; ++i) tv[i] *= gain[k0 + 2 * i + (lane >> 5)]; }
#pragma unroll
    for (int i = 0; i < 32; ++i) scr[(2 * i + (lane >> 5)) * 33 + (lane & 31)] = tv[i];
    LDS_WAIT(); asm volatile("" ::: "memory");
    const int c = lane & 7;
    int nbase = row_off + n0; if (sig) { const int ng = row_off + n0; nbase = (ng & ~255) + wsig_inv(ng & 255); }
#pragma unroll
    for (int j = 0; j < 4; ++j) { const int n = (lane >> 3) + 8 * j; const LAS float* s = scr + (8 * c) * 33 + n;
        v4u o; o.x = cvt_pk_bf16(s[0 * 33], s[1 * 33]); o.y = cvt_pk_bf16(s[2 * 33], s[3 * 33]); o.z = cvt_pk_bf16(s[4 * 33], s[5 * 33]); o.w = cvt_pk_bf16(s[6 * 33], s[7 * 33]);
        *(GAS v4u*)(WT + (size_t)(nbase + n) * K + k0 + 8 * c) = o; }
    LDS_WAIT(); asm volatile("" ::: "memory");
}
__device__ __forceinline__ void row_to_bf16_ssq(const float* xrow, bf16* orow, float* ssqrow, int lane) {
    const GAS f32x4* xr = (const GAS f32x4*)xrow + lane;
    f32x4 v[4]; float s = 0.f;
#pragma unroll
    for (int j = 0; j < 4; ++j) { v[j] = xr[64 * j]; s += (v[j].x * v[j].x + v[j].y * v[j].y) + (v[j].z * v[j].z + v[j].w * v[j].w); }
    s = wave_sum(s);
    GAS v2u* o8 = (GAS v2u*)orow + lane;
#pragma unroll
    for (int j = 0; j < 4; ++j) o8[64 * j] = pack4(v[j]);
    if (lane < 16) ssqrow[lane] = lane == 0 ? s : 0.f;
}
__device__ __forceinline__ void p0_weights(Frame& F, int part, int gw, int NGW, LAS float* scr) {
    unsigned char* ws = F.ws;
    int it = gw;
#define P0_JOB(Wp, K_, N_, WTp, roff, sg, gn) { const int ni = ((K_) / 64) * ((N_) / 32); for (; it < ni; it += NGW) p0_transpose_item((Wp), (K_), (N_), (WTp), (roff), (sg), (gn), scr, it, F.lane); it -= ni; }
    if (part == 0) {
    P0_JOB(F.in[I_WINA], DM, NCOLA, (bf16*)(ws + WS_WA), 0, false, F.in[I_NMIX]);
    P0_JOB(F.in[I_WMKV], DM, 512, (bf16*)(ws + WS_WM), 0, true, F.in[I_MNORM]);
    P0_JOB(F.in[I_WMKV] + (size_t)DM * 512, DM, 512, (bf16*)(ws + WS_WM), 512, true, F.in[I_MNORM] + DM);
    P0_JOB(F.in[I_WW2], 64, 768, (bf16*)(ws + WS_WW2), 0, false, nullptr);
    P0_JOB(F.in[I_WA2], 64, 768, (bf16*)(ws + WS_WA2), 0, false, nullptr);
    P0_JOB(F.in[I_WG2], 128, 768, (bf16*)(ws + WS_WG2), 0, false, nullptr);
    } else {
    P0_JOB(F.in[I_WOUT], DM, DM, (bf16*)(ws + WS_WOUT), 0, false, nullptr);
    P0_JOB(F.in[I_WUP], DM, FF, (bf16*)(ws + WS_WUP), 0, false, F.in[I_NMLP]);
    P0_JOB(F.in[I_WDN], FF, DM, (bf16*)(ws + WS_WDN), 0, false, nullptr);
    P0_JOB(F.in[I_WINB], DM, DM, (bf16*)(ws + WS_WB), 0, true, F.in[I_NMIX] + DM);
    P0_JOB(F.in[I_WKV], DM, 512, (bf16*)(ws + WS_WB), 1024, true, F.in[I_KVN]);
    P0_JOB(F.in[I_WOUT] + (size_t)DM * DM, DM, DM, (bf16*)(ws + WS_WOUT) + (size_t)DM * DM, 0, false, nullptr);
    P0_JOB(F.in[I_WUP] + (size_t)DM * FF, DM, FF, (bf16*)(ws + WS_WUP) + (size_t)DM * FF, 0, false, F.in[I_NMLP] + DM);
    P0_JOB(F.in[I_WDN] + (size_t)DM * FF, FF, DM, (bf16*)(ws + WS_WDN) + (size_t)DM * FF, 0, false, nullptr);
    }
#undef P0_JOB
}
__device__ __forceinline__ void p0_prologue(Frame& F) {
    LAS float* scr = (LAS float*)(F.lds + RING_OFF + F.wave * 16384);
    const int gw = F.vcu * NWAVES + F.wave, NGW = F.G * NWAVES;
    unsigned char* ws = F.ws;
    p0_weights(F, 0, gw, NGW, scr);
    for (int m = gw; m < R; m += NGW) { const float* xr = m < RP ? F.in[I_XP] + (size_t)m * DM : F.in[I_XS] + (size_t)(m - RP) * DM;
        row_to_bf16_ssq(xr, (bf16*)(ws + WS_HB) + (size_t)m * DM, (float*)(ws + WS_SSQ) + (size_t)m * 16, F.lane); }
    for (int m = gw; m < 512; m += NGW) row_to_bf16_ssq(F.in[I_MEMP] + (size_t)m * DM, (bf16*)(ws + WS_MB) + (size_t)m * DM, (float*)(ws + WS_SSQM) + (size_t)m * 16, F.lane);
    { const int gt = F.vcu * NWAVES * 64 + F.tid, NGT = F.G * NWAVES * 64; float* rt = (float*)(ws + WS_ROPE);
      for (int i = gt; i < 8196 * 32; i += NGT) { const int p = i >> 5, f = i & 31; const float pos = (float)(p < 8192 ? p : 16384 + (p - 8192));
          double fq_ = 1.0; for (int k = 0; k < f; ++k) fq_ *= 0.74989420933245582730; const float ang = pos * (float)fq_; const double rev = (double)ang * 0.15915494309189535; const float fr = (float)(rev - floor(rev));
          rt[2 * i] = __builtin_amdgcn_cosf(fr); rt[2 * i + 1] = __builtin_amdgcn_sinf(fr); } }
}

__device__ __forceinline__ void finalize_sample(Frame& F, const float* fbase  , int S, bool last) {
    const int gw = F.vcu * NWAVES + F.wave, NGW = F.G * NWAVES; const float* slab = (const float*)(F.ws + WS_SLAB);
    for (int rs = gw; rs < RS; rs += NGW) { const int row = RP + rs, tile0 = (rs >> 8) << 2, r = rs & 255; float ss = 0.f;
#pragma unroll
        for (int pn = 0; pn < 4; ++pn) { f32x4 h;
            if (fbase) h = *(const GAS f32x4*)(fbase + (size_t)rs * DM + pn * 256 + 4 * F.lane);
            else h = unpack4(*(const GAS v2u*)((const bf16*)(F.ws + WS_HB) + (size_t)row * DM + pn * 256 + 4 * F.lane));
            for (int s0 = 0; s0 < S; s0 += 4) { f32x4 pv[4];
#pragma unroll
                for (int s = 0; s < 4; ++s) pv[s] = *(const GAS f32x4*)(slab + ((size_t)((tile0 + pn) * S + s0 + s) << 16) + r * 256 + 4 * F.lane);
                __builtin_amdgcn_sched_barrier(0);
                h += (pv[0] + pv[1]) + (pv[2] + pv[3]); }
            if (last) *(GAS f32x4*)(F.out + O_Y + (size_t)row * DM + pn * 256 + 4 * F.lane) = h;
            else *(GAS v2u*)((bf16*)(F.ws + WS_HB) + (size_t)row * DM + pn * 256 + 4 * F.lane) = pack4(h);
            ss += (h[0] * h[0] + h[1] * h[1]) + (h[2] * h[2] + h[3] * h[3]); }
        if (!last) { ss = wave_sum(ss); if (F.lane < 16) ((float*)(F.ws + WS_SSQ))[(size_t)row * 16 + F.lane] = F.lane == 0 ? ss : 0.f; } }
}

__device__ __forceinline__ void copy_window_cache(Frame& F, int gt, int NGT) {
    const int per = 124 * 256 / 4;
    for (int i = gt; i < SB * per; i += NGT) { const int b = i / per, r = i % per;
        ((GAS f32x4*)(F.out + O_SSK + (size_t)b * 128 * 256))[r] = ((const GAS f32x4*)(F.in[I_CSK] + (size_t)b * 128 * 256 + 4 * 256))[r];
        ((GAS f32x4*)(F.out + O_SSV + (size_t)b * 128 * 256))[r] = ((const GAS f32x4*)(F.in[I_CSV] + (size_t)b * 128 * 256 + 4 * 256))[r]; }
}

constexpr int LSTR = 144, SLOT = 64 * LSTR;
__device__ __forceinline__ int rec_index(int chunk, int h) { return ((chunk >> 7) * NH + h) * 128 + (chunk & 127); }
constexpr int REC_PT = 0, REC_QS = 8192, REC_RY = 16384, REC_YL = 24576, REC_BV = 32768;
__device__ __forceinline__ bf16x8 lfrag(const LAS unsigned char* m, int row, int k) { return *(const LAS bf16x8*)(m + row * LSTR + k * 2); }
__device__ __forceinline__ void mm_strip(f32x4 (&acc)[4], const LAS unsigned char* X, const LAS unsigned char* Y, int w, int c, int g) {
#pragma unroll
    for (int ks = 0; ks < 2; ++ks) { const bf16x8 a = lfrag(X, 16 * w + c, 32 * ks + 8 * g);
#pragma unroll
        for (int n = 0; n < 4; ++n) acc[n] = mfma16(a, lfrag(Y, 16 * n + c, 32 * ks + 8 * g), acc[n]); }
}
__device__ __forceinline__ void mm_strip2(f32x4 (&acc0)[4], f32x4 (&acc1)[4], const LAS unsigned char* X, const LAS unsigned char* Y0, const LAS unsigned char* Y1, int w, int c, int g) {
#pragma unroll
    for (int ks = 0; ks < 2; ++ks) { const bf16x8 a = lfrag(X, 16 * w + c, 32 * ks + 8 * g);
#pragma unroll
        for (int n = 0; n < 4; ++n) { acc0[n] = mfma16(a, lfrag(Y0, 16 * n + c, 32 * ks + 8 * g), acc0[n]); acc1[n] = mfma16(a, lfrag(Y1, 16 * n + c, 32 * ks + 8 * g), acc1[n]); } }
}
__device__ __forceinline__ void zero4(f32x4 (&a)[4]) {
#pragma unroll
    for (int n = 0; n < 4; ++n) a[n] = (f32x4){0.f, 0.f, 0.f, 0.f};
}
__device__ __forceinline__ void st_T(LAS unsigned char* dest, const f32x4 (&acc)[4], int w, int c, int g) {
#pragma unroll
    for (int n = 0; n < 4; ++n) *(LAS v2u*)(dest + (16 * n + c) * LSTR + (16 * w + 4 * g) * 2) = pack4(acc[n]);
}
__device__ __forceinline__ void st_T_global(unsigned char* dest  , const f32x4 (&acc)[4], int w, int c, int g) {
#pragma unroll
    for (int n = 0; n < 4; ++n) *(GAS v2u*)(dest + (16 * n + c) * 128 + (16 * w + 4 * g) * 2) = pack4(acc[n]);
}
__device__ __forceinline__ void load_shift8(const bf16* cur, const bf16* prv, const float* mu, float (&o)[8]) {
    const v4u cw = *(const GAS v4u*)cur; v4u pw = {0u, 0u, 0u, 0u}; if (prv) pw = *(const GAS v4u*)prv;
    const f32x4 m0 = *(const GAS f32x4*)mu, m1 = *(const GAS f32x4*)(mu + 4);
    const float cf[8] = {bflo(cw.x), bfhi(cw.x), bflo(cw.y), bfhi(cw.y), bflo(cw.z), bfhi(cw.z), bflo(cw.w), bfhi(cw.w)};
    const float pf[8] = {bflo(pw.x), bfhi(pw.x), bflo(pw.y), bfhi(pw.y), bflo(pw.z), bfhi(pw.z), bflo(pw.w), bfhi(pw.w)};
    const float mf[8] = {m0[0], m0[1], m0[2], m0[3], m1[0], m1[1], m1[2], m1[3]};
#pragma unroll
    for (int i = 0; i < 8; ++i) o[i] = cf[i] + (pf[i] - cf[i]) * mf[i];
}
__device__ __forceinline__ bf16x8 pack_frag(const float (&v)[8]) {
    v4u w; w.x = cvt_pk_bf16(v[0], v[1]); w.y = cvt_pk_bf16(v[2], v[3]); w.z = cvt_pk_bf16(v[4], v[5]); w.w = cvt_pk_bf16(v[6], v[7]); return __builtin_bit_cast(bf16x8, w);
}

struct PrepPf { v4u raw[3][2]; v4u prv; };
__device__ __forceinline__ void prep_issue(Frame& F, int unit, PrepPf& pf) {
    const int th = (F.wave & 3) * 64 + F.lane; const int chunk = unit / NH, h = unit % NH, row0 = chunk * 64; const bool first = (chunk & 127) == 0;
    const bf16* proj = (const bf16*)(F.ws + WS_PROJ);
#pragma unroll
    for (int a = 0; a < 3; ++a)
#pragma unroll
        for (int i = 0; i < 2; ++i) { const int id = th + 256 * i; pf.raw[a][i] = *(const GAS v4u*)(proj + (size_t)(row0 + (id >> 3)) * NCOLA + a * 768 + h * 64 + (id & 7) * 8); }
    pf.prv = (v4u){0u, 0u, 0u, 0u};
    if (th < 24 && !first) pf.prv = *(const GAS v4u*)(proj + (size_t)(row0 - 1) * NCOLA + (th >> 3) * 768 + h * 64 + (th & 7) * 8);
}
__device__ __forceinline__ void shift8(v4u cw, v4u pw, const float* mu, float (&o)[8]) {
    const f32x4 m0 = *(const GAS f32x4*)mu, m1 = *(const GAS f32x4*)(mu + 4);
    const float cf[8] = {bflo(cw.x), bfhi(cw.x), bflo(cw.y), bfhi(cw.y), bflo(cw.z), bfhi(cw.z), bflo(cw.w), bfhi(cw.w)};
    const float pf_[8] = {bflo(pw.x), bfhi(pw.x), bflo(pw.y), bfhi(pw.y), bflo(pw.z), bfhi(pw.z), bflo(pw.w), bfhi(pw.w)};
    const float mf[8] = {m0[0], m0[1], m0[2], m0[3], m1[0], m1[1], m1[2], m1[3]};
#pragma unroll
    for (int i = 0; i < 8; ++i) o[i] = cf[i] + (pf_[i] - cf[i]) * mf[i];
}
#ifndef MK_TIME
#define MK_TIME -1
#endif
#define STAMP3(k) do { if (MK_TIME >= 0 && unit == 0 && w_ == 0 && lane_ == 0) ((volatile LAS unsigned long long*)(F.lds + LDSCTL_OFF + 512))[(k)] = __builtin_amdgcn_s_memrealtime(); } while (0)
#define HBAR() do { asm volatile("s_waitcnt lgkmcnt(0)" ::: "memory"); __builtin_amdgcn_s_barrier(); asm volatile("" ::: "memory"); } while (0)
__device__ __forceinline__ void rwkv_prep_unit(Frame& F, int unit, LAS unsigned char* hb, LAS float* wtot, LAS unsigned char* prow, PrepPf& pf, bool has_next, int next_unit, int stage_limit = 99) {
    int w_ = F.wave & 3, lane_ = F.lane; asm volatile("" : "+s"(w_), "+v"(lane_));
    const int w = w_, lane = lane_, g = lane >> 4, c = lane & 15;
    STAMP3(17);
    const int chunk = unit / NH, h = unit % NH, row0 = chunk * 64; const bool first = (chunk & 127) == 0;
    const bf16* proj = (const bf16*)(F.ws + WS_PROJ);
    unsigned char* rec = F.ws + WS_REC + (size_t)rec_index(chunk, h) * REC_BYTES;
    LAS unsigned char* const s0 = hb, * const s1 = hb + SLOT, * const s2 = hb + 2 * SLOT, * const s3 = hb + 3 * SLOT, * const s4 = hb + 4 * SLOT, * const s5 = hb + 5 * SLOT, * const s6 = hb + 6 * SLOT, * const s7 = hb + 7 * SLOT;
    float mur[4], muk[4], muv[4], w0[4], a0[4], kkc[4], kac[4], rkc[4];
#pragma unroll
    for (int n = 0; n < 4; ++n) { const int col = h * 64 + 16 * n + c; mur[n] = F.in[I_MU][col]; muk[n] = F.in[I_MU][768 + col]; muv[n] = F.in[I_MU][1536 + col];
        w0[n] = F.in[I_W0][col]; a0[n] = F.in[I_A0][col]; kkc[n] = F.in[I_KK][col]; kac[n] = F.in[I_KA][col]; rkc[n] = F.in[I_RK][col]; }
    f32x4 dw[4], da[4]; zero4(dw); zero4(da);
    { const int th = w * 64 + lane;
#pragma unroll
      for (int a = 0; a < 3; ++a)
#pragma unroll
          for (int i = 0; i < 2; ++i) { const int id = th + 256 * i; *(LAS v4u*)(hb + a * SLOT + (id >> 3) * LSTR + (id & 7) * 16) = pf.raw[a][i]; }
      if (th < 24) *(LAS v4u*)(prow + (th >> 3) * 128 + (th & 7) * 16) = pf.prv; }
    {
        const bf16* Ww2 = (const bf16*)(F.ws + WS_WW2); const bf16* Wa2 = (const bf16*)(F.ws + WS_WA2);
        const int tl = 16 * w + c; const bf16* crl = proj + (size_t)(row0 + tl) * NCOLA; const bool hpl = !(first && tl == 0);
        v4u lc[2][2], lp[2][2];
#pragma unroll
        for (int a = 0; a < 2; ++a)
#pragma unroll
            for (int ks = 0; ks < 2; ++ks) { const int col = 2304 + 64 * a + 32 * ks + 8 * g; lc[a][ks] = *(const GAS v4u*)(crl + col); lp[a][ks] = (v4u){0u, 0u, 0u, 0u}; if (hpl) lp[a][ks] = *(const GAS v4u*)(crl - NCOLA + col); }
#pragma unroll
        for (int ks = 0; ks < 2; ++ks) { const int l0 = 32 * ks + 8 * g; float x[8];
            shift8(lc[0][ks], lp[0][ks], F.in[I_MU] + 2304 + l0, x);
#pragma unroll
            for (int i = 0; i < 8; ++i) x[i] = ftanh(x[i]);
            const bf16x8 aw = pack_frag(x);
            shift8(lc[1][ks], lp[1][ks], F.in[I_MU] + 2368 + l0, x);
            const bf16x8 aa = pack_frag(x);
#pragma unroll
            for (int n = 0; n < 4; ++n) { const size_t wo = (size_t)(h * 64 + 16 * n + c) * 64 + l0;
                dw[n] = mfma16(aw, *(const GAS bf16x8*)(Ww2 + wo), dw[n]); da[n] = mfma16(aa, *(const GAS bf16x8*)(Wa2 + wo), da[n]); } }
    }
    STAMP3(18);
    HBAR();
    if (has_next) prep_issue(F, next_unit, pf);
    f32x4 rt[4], kh[4], lw[4], at_[4], bt_[4], kt_[4], bh_[4], vv[4]; float gam[4]; float bon[4] = {0.f, 0.f, 0.f, 0.f}; float ssk[4] = {0.f, 0.f, 0.f, 0.f};
    f32x4 kkr[4], aa_[4], kp[4], rr[4];
    {

        const LAS unsigned char* pbase = (w == 0 && g == 0) ? prow + c * 2 : hb + (16 * w + 4 * g - 1) * LSTR + c * 2; const int pstr = (w == 0 && g == 0) ? 128 : SLOT;
        float rp[4], kpv[4], vp[4];
#pragma unroll
        for (int n = 0; n < 4; ++n) { rp[n] = bf2f(*(const LAS bf16*)(pbase + 32 * n)); kpv[n] = bf2f(*(const LAS bf16*)(pbase + pstr + 32 * n)); vp[n] = bf2f(*(const LAS bf16*)(pbase + 2 * pstr + 32 * n)); }
#pragma unroll
        for (int reg = 0; reg < 4; ++reg) { const int t = 16 * w + 4 * g + reg; const LAS unsigned char* cr = hb + t * LSTR + c * 2;
#pragma unroll
            for (int n = 0; n < 4; ++n) {
                const float r0 = bf2f(*(const LAS bf16*)(cr + 32 * n)), k0 = bf2f(*(const LAS bf16*)(cr + SLOT + 32 * n)), v0 = bf2f(*(const LAS bf16*)(cr + 2 * SLOT + 32 * n));
                const float r1 = rp[n], k1 = kpv[n], v1 = vp[n]; rp[n] = r0; kpv[n] = k0; vp[n] = v0;
                const float r = r0 + (r1 - r0) * mur[n], k = k0 + (k1 - k0) * muk[n], v = v0 + (v1 - v0) * muv[n];
                const float y = -(w0[n] + dw[n][reg]);
                const float sp = fmaxf(y, 0.f) + __logf(1.0f + __expf(-fabsf(y)));
                lw[n][reg] = -__expf(-sp - 0.5f);
                const float a = fsigmoid(a0[n] + da[n][reg]);
                aa_[n][reg] = a; kkr[n][reg] = k * kkc[n]; kp[n][reg] = k * (1.0f + (a - 1.0f) * kac[n]); rr[n][reg] = r; vv[n][reg] = v;
                ssk[reg] += kkr[n][reg] * kkr[n][reg]; bon[reg] += r * kp[n][reg] * rkc[n]; } }
    }
#pragma unroll
    for (int reg = 0; reg < 4; ++reg) { ssk[reg] = sum16(ssk[reg]); bon[reg] = sum16(bon[reg]); ssk[reg] = __builtin_amdgcn_rsqf(fmaxf(ssk[reg], 1e-24f)); }
    STAMP3(19);
    f32x4 Lc[4];
#pragma unroll
    for (int n = 0; n < 4; ++n) { f32x4 inc; inc[0] = lw[n][0]; inc[1] = inc[0] + lw[n][1]; inc[2] = inc[1] + lw[n][2]; inc[3] = inc[2] + lw[n][3];
        const float tot = inc[3]; const float t1 = __shfl(tot, (lane - 16) & 63), t2 = __shfl(tot, (lane - 32) & 63), t3 = __shfl(tot, (lane - 48) & 63);
        const float pre = (g >= 1 ? t1 : 0.f) + (g >= 2 ? t2 : 0.f) + (g >= 3 ? t3 : 0.f);
        Lc[n] = inc + pre; if (g == 3) wtot[w * 64 + 16 * n + c] = pre + tot; }
    HBAR();
#pragma unroll
    for (int n = 0; n < 4; ++n) { const int j = 16 * n + c; const float t0 = wtot[j], t1 = wtot[64 + j], t2 = wtot[128 + j], t3 = wtot[192 + j];
        const float base = (w >= 1 ? t0 : 0.f) + (w >= 2 ? t1 : 0.f) + (w >= 3 ? t2 : 0.f); const float LC = (t0 + t1) + (t2 + t3);
        gam[n] = __expf(LC);
#pragma unroll
        for (int reg = 0; reg < 4; ++reg) { const float L = Lc[n][reg] + base; const float eL = __expf(L), eLi = __builtin_amdgcn_rcpf(eL), eP = __expf(L - lw[n][reg]), eC = gam[n] * eLi;
            const float kk = kkr[n][reg] * ssk[reg], bsc = kk * aa_[n][reg];
            at_[n][reg] = -kk * eP; rt[n][reg] = rr[n][reg] * eL; bt_[n][reg] = bsc * eLi; kt_[n][reg] = kp[n][reg] * eLi; bh_[n][reg] = bsc * eC; kh[n][reg] = kp[n][reg] * eC;
            const int t = 16 * w + 4 * g + reg;
            *(LAS bf16*)(s0 + t * LSTR + j * 2) = f2bf(at_[n][reg]); *(LAS bf16*)(s1 + t * LSTR + j * 2) = f2bf(bt_[n][reg]);
            *(LAS bf16*)(s2 + t * LSTR + j * 2) = f2bf(kt_[n][reg]); *(LAS bf16*)(s3 + t * LSTR + j * 2) = f2bf(rt[n][reg]); }
        *(LAS v2u*)(s4 + j * LSTR + (16 * w + 4 * g) * 2) = pack4(at_[n]); *(LAS v2u*)(s5 + j * LSTR + (16 * w + 4 * g) * 2) = pack4(bh_[n]); *(LAS v2u*)(s6 + j * LSTR + (16 * w + 4 * g) * 2) = pack4(vv[n]);
        f32x4 bv;
#pragma unroll
        for (int reg = 0; reg < 4; ++reg) bv[reg] = bon[reg] * vv[n][reg];
        *(GAS v2u*)(rec + REC_BV + ((w * 64 + lane) * 4 + n) * 8) = pack4(bv); }
    HBAR();
    STAMP3(20);
    if (stage_limit <= 3) return;
    f32x4 aN[4], aMk[4], aMbr[4], aMkr[4]; zero4(aN); zero4(aMk); zero4(aMbr); zero4(aMkr);
    mm_strip2(aN, aMk, s0, s1, s2, w, c, g);
    mm_strip(aMbr, s1, s3, w, c, g); mm_strip(aMkr, s2, s3, w, c, g);
#pragma unroll
    for (int n = 0; n < 4; ++n)
#pragma unroll
        for (int reg = 0; reg < 4; ++reg) { const int row = 16 * w + 4 * g + reg, col = 16 * n + c;
            if (!(col < row)) { aN[n][reg] = 0.f; aMk[n][reg] = 0.f; } if (!(row <= col)) { aMbr[n][reg] = 0.f; aMkr[n][reg] = 0.f; } }
    HBAR();
    LAS float* Nf = (LAS float*)s0;
#pragma unroll
    for (int n = 0; n < 4; ++n)
#pragma unroll
        for (int reg = 0; reg < 4; ++reg) Nf[(16 * w + 4 * g + reg) * 64 + (c & 3) * 16 + 4 * n + (c >> 2)] = aN[n][reg];
    st_T(s2, aMk, w, c, g);
    st_T(s3, aMbr, w, c, g);
    HBAR();
    {
        const int q = lane & 3, sl = lane >> 2; float cq[16];
#pragma unroll
        for (int k = 0; k < 16; ++k) cq[k] = 0.f;
        for (int t = 0; t < 16 * w; ++t) if (q == 0) *(LAS bf16*)(s7 + t * LSTR + (16 * w + sl) * 2) = (bf16)0;
#pragma unroll
        for (int t = 0; t < 64; ++t) if (t >= 16 * w) {
            float part = 0.f;
#pragma unroll
            for (int k4 = 0; k4 < (t + 15) / 16; ++k4) { const f32x4 nv = *(const LAS f32x4*)(Nf + t * 64 + q * 16 + 4 * k4);
#pragma unroll
                for (int e = 0; e < 4; ++e) if (4 * (4 * k4 + e) < t) part = fmaf(nv[e], cq[4 * k4 + e], part); }
            part = sum4_dpp(part);
            const float val = part + ((t == 16 * w + sl) ? 1.0f : 0.0f);
            cq[t >> 2] = (q == (t & 3)) ? val : cq[t >> 2];
            if (q == 0) *(LAS bf16*)(s7 + t * LSTR + (16 * w + sl) * 2) = f2bf(val);
        }
    }
    HBAR();
    STAMP3(21);
    if (stage_limit <= 5) return;
    { f32x4 aW[4], aNk[4]; zero4(aW); zero4(aNk); mm_strip2(aW, aNk, s7, s4, s2, w, c, g); st_T(s0, aW, w, c, g); st_T(s1, aNk, w, c, g); }
    HBAR();
    { f32x4 aP[4]; zero4(aP); mm_strip(aP, s0, s5, w, c, g);
#pragma unroll
      for (int n = 0; n < 4; ++n)
#pragma unroll
          for (int reg = 0; reg < 4; ++reg) if (n == w && c == 4 * g + reg) aP[n][reg] += gam[n];
#pragma unroll
      for (int n = 0; n < 4; ++n) *(GAS v2u*)(rec + REC_PT + ((n * 2 + (w >> 1)) * 64 + lane) * 16 + 8 * (w & 1)) = pack4(aP[n]); }
    { f32x4 aZq[4], aZy[4]; zero4(aZq); zero4(aZy); mm_strip2(aZq, aZy, s1, s5, s3, w, c, g);
#pragma unroll
      for (int n = 0; n < 4; ++n) { aZq[n] += kh[n]; aZy[n] += aMkr[n]; }
      f32x4 aRy[4]; zero4(aRy); mm_strip(aRy, s3, s0, w, c, g);
#pragma unroll
      for (int n = 0; n < 4; ++n)
#pragma unroll
          for (int reg = 0; reg < 4; ++reg) *(GAS bf16*)(rec + REC_RY + ((w * 2 + (n >> 1)) * 64 + 16 * (2 * (n & 1) + (c >> 3)) + 4 * g + reg) * 16 + 2 * (c & 7)) = f2bf(aRy[n][reg] + rt[n][reg]);
      st_T(s4, aZq, w, c, g);
      st_T(s7, aZy, w, c, g); }
    HBAR();
    { f32x4 aQ[4], aY[4]; zero4(aQ); zero4(aY); mm_strip(aQ, s4, s6, w, c, g); mm_strip(aY, s7, s6, w, c, g);
#pragma unroll
      for (int n = 0; n < 4; ++n) { *(GAS v2u*)(rec + REC_QS + ((n * 64 + lane) * 4 + w) * 8) = pack4(aQ[n]);
                                    *(GAS v2u*)(rec + REC_YL + ((w * 64 + lane) * 4 + n) * 8) = pack4(aY[n]); } }
    STAMP3(22);
}

__device__ __forceinline__ float rdlane(float v, int l) { return __int_as_float(__builtin_amdgcn_readlane(__float_as_int(v), l)); }
#ifndef MK_TIME
#define MK_TIME -1
#endif
#define STAMP2(k) do { if (MK_TIME >= 0 && blockIdx.x == 0 && F.wave == 0 && lane == 0) ((volatile LAS unsigned long long*)(F.lds + LDSCTL_OFF + 512))[(k)] = __builtin_amdgcn_s_memrealtime(); } while (0)
__device__ __forceinline__ void rwkv_sample_task(Frame& F, int task) {
    int lane_ = F.lane; asm volatile("" : "+v"(lane_)); const int lane = lane_;
    const int b = task / NH, h = task % NH, col = h * 64 + lane;
    const bf16* proj = (const bf16*)(F.ws + WS_PROJ);
    const float* sh = F.in[I_SSHIFT] + (size_t)b * RWKV_COLS;
    const float* mu = F.in[I_MU];
    float S[64];
    { const GAS f32x4* sp = (const GAS f32x4*)(F.in[I_SWKV] + (((size_t)b * NH + h) * 64 + lane) * 64);
#pragma unroll
      for (int q = 0; q < 16; ++q) { const f32x4 v = sp[q]; S[4 * q] = v[0]; S[4 * q + 1] = v[1]; S[4 * q + 2] = v[2]; S[4 * q + 3] = v[3]; } }
    const float w0 = F.in[I_W0][col], a0 = F.in[I_A0][col], kkc = F.in[I_KK][col], kac = F.in[I_KA][col], rkc = F.in[I_RK][col], lnw = F.in[I_LNW][col], lnb = F.in[I_LNB][col];
    float rr[ST], kq[ST], vq[ST], twd[ST], adv[ST], gd0[ST], gd1[ST];
#pragma unroll
    for (int i = 0; i < ST; ++i) { const int row = RP + b * ST + i; const bf16* cr = proj + (size_t)row * NCOLA;
#define SHIFTED(cc) ({ const float p_ = bf2f(cr[(cc)]); const float q_ = (i == 0) ? sh[(cc)] : bf2f(cr[(cc) - NCOLA]); p_ + (q_ - p_) * mu[(cc)]; })
        rr[i] = SHIFTED(col); kq[i] = SHIFTED(768 + col); vq[i] = SHIFTED(1536 + col);
        twd[i] = ftanh(SHIFTED(2304 + lane)); adv[i] = SHIFTED(2368 + lane); gd0[i] = fsigmoid(SHIFTED(2432 + lane)); gd1[i] = fsigmoid(SHIFTED(2496 + lane));
#undef SHIFTED
    }
    float dwv[ST] = {0.f, 0.f, 0.f, 0.f}, dav[ST] = {0.f, 0.f, 0.f, 0.f}, ggv[ST] = {0.f, 0.f, 0.f, 0.f};
    { const GAS float* W2 = (const GAS float*)(F.in[I_WW2] + col); const GAS float* A2 = (const GAS float*)(F.in[I_WA2] + col); const GAS float* G2 = (const GAS float*)(F.in[I_WG2] + col);
      for (int l0 = 0; l0 < 64; l0 += 16) {
          float w2[16], a2[16], ga[16], gb[16];
#pragma unroll
          for (int u = 0; u < 16; ++u) { w2[u] = W2[(size_t)u * 768]; a2[u] = A2[(size_t)u * 768]; ga[u] = G2[(size_t)u * 768]; gb[u] = G2[(size_t)(64 + u) * 768]; }
          W2 += 16 * 768; A2 += 16 * 768; G2 += 16 * 768;
          __builtin_amdgcn_sched_barrier(0);
#pragma unroll
          for (int u = 0; u < 16; ++u) { const int l = l0 + u;
#pragma unroll
              for (int i = 0; i < ST; ++i) { dwv[i] = fmaf(rdlane(twd[i], l), w2[u], dwv[i]); dav[i] = fmaf(rdlane(adv[i], l), a2[u], dav[i]); ggv[i] = fmaf(rdlane(gd0[i], l), ga[u], ggv[i]); ggv[i] = fmaf(rdlane(gd1[i], l), gb[u], ggv[i]); } } } }
    STAMP2(15);
#pragma unroll
    for (int i = 0; i < ST; ++i) {
        const int row = RP + b * ST + i;
        const float r = rr[i], k = kq[i], v = vq[i], dw = dwv[i], da = dav[i], gg = ggv[i];
        const float y0 = -(w0 + dw); const float sp = fmaxf(y0, 0.f) + __logf(1.0f + __expf(-fabsf(y0)));
        const float wdec = __expf(-__expf(-sp - 0.5f));
        const float a = fsigmoid(a0 + da);
        const float kkr = k * kkc; const float nrm = fmaxf(sqrtf(wave_sum(kkr * kkr)), 1e-12f); const float kk = kkr / nrm;
        const float kp = k * (1.0f + (a - 1.0f) * kac);
        const float asc = -kk, bsc = kk * a;
        const float bonus = wave_sum(r * kp * rkc);
        float sa = 0.f;
#pragma unroll
        for (int j = 0; j < 64; ++j) sa = fmaf(S[j], rdlane(asc, j), sa);
        const float vi = v;
        float y = 0.f;
#pragma unroll
        for (int j = 0; j < 64; ++j) { const float wj = rdlane(wdec, j), bj = rdlane(bsc, j), kj = rdlane(kp, j), rj = rdlane(r, j);
            S[j] = fmaf(S[j], wj, fmaf(sa, bj, vi * kj)); y = fmaf(S[j], rj, y); }
        const float mean = wave_sum(y) * (1.0f / 64.0f); const float dy = y - mean; const float var = wave_sum(dy * dy) * (1.0f / 64.0f);
        const float o = (dy * rsqrtf(var + 6.4e-4f) * lnw + lnb + bonus * vi) * gg;
        ((bf16*)(F.ws + WS_MIX))[(size_t)row * DM + col] = f2bf(o);
        asm volatile("" ::: "memory");
    }
    STAMP2(16);
    { GAS f32x4* sp = (GAS f32x4*)(F.out + O_SWKV + (((size_t)b * NH + h) * 64 + lane) * 64);
#pragma unroll
      for (int q = 0; q < 16; ++q) sp[q] = (f32x4){S[4 * q], S[4 * q + 1], S[4 * q + 2], S[4 * q + 3]}; }
    if (h == 0) { const bf16* lr = proj + (size_t)(RP + b * ST + ST - 1) * NCOLA; float* o = F.out + O_SSHIFT + (size_t)b * RWKV_COLS;
        for (int q = lane; q < RWKV_COLS; q += 64) o[q] = bf2f(lr[q]); }
}

__device__ __forceinline__ void rwkv_scan_chain(Frame& F, int bh, int w) {
    int lane_ = F.lane; asm volatile("" : "+v"(lane_)); const int lane = lane_, g = lane >> 4, c = lane & 15; const int b = bh / NH, h = bh % NH;
    constexpr int DPF = 12, NSL = 14, SLB = 10240;
    LAS unsigned char* ring = F.lds;
    auto recp = [&](int cc) -> const unsigned char* { return F.ws + WS_REC + (size_t)((b * NH + h) * 128 + cc) * REC_BYTES; };
    const int vrow = 16 * w + c;
    if (F.wave >= 4) {
        const int L = F.wave - 4, npc = L < 2 ? 3 : 2;
#define SCAN_DMA(cc_) do { const unsigned char* rp_ = recp(cc_); LAS unsigned char* sl_ = ring + ((cc_) % NSL) * SLB; \
            _Pragma("unroll") for (int q = 0; q < 3; ++q) { const int p = L + 4 * q; if (p < 8) __builtin_amdgcn_global_load_lds((const unsigned*)(rp_ + REC_PT + p * 1024 + lane * 16), (LAS unsigned*)(sl_ + p * 1024), 16, 0, 0); \
                else if (p < 10) __builtin_amdgcn_global_load_lds((const unsigned*)(rp_ + REC_QS + (w * 64 + lane) * 32 + (p - 8) * 16), (LAS unsigned*)(sl_ + p * 1024), 16, 0, 0); } } while (0)
        for (int d = 0; d < DPF; ++d) SCAN_DMA(d);
        for (int cc = 0; cc < 128; ++cc) {
            const int younger = (cc + DPF <= 128 ? DPF - 1 : 127 - cc) * npc;
            if (younger >= 33) asm volatile("s_waitcnt vmcnt(33)" ::: "memory"); else if (younger >= 22) asm volatile("s_waitcnt vmcnt(22)" ::: "memory");
            else if (younger >= 11) asm volatile("s_waitcnt vmcnt(11)" ::: "memory"); else asm volatile("s_waitcnt vmcnt(0)" ::: "memory");
            __builtin_amdgcn_s_barrier();
            if (cc + DPF < 128) SCAN_DMA(cc + DPF);
        }
#undef SCAN_DMA
        asm volatile("s_waitcnt vmcnt(0)" ::: "memory");
        return;
    }
    if (F.wave != 0) { for (int cc = 0; cc < 128; ++cc) __builtin_amdgcn_s_barrier(); return; }
    f32x4 acc[4]; zero4(acc);
    for (int cc = 0; cc < 128; ++cc) {
        __builtin_amdgcn_s_barrier(); asm volatile("" ::: "memory");
        const LAS unsigned char* sl = ring + (cc % NSL) * SLB;
        bf16x8 pa[4][2];
#pragma unroll
        for (int mt = 0; mt < 4; ++mt)
#pragma unroll
            for (int ks = 0; ks < 2; ++ks) pa[mt][ks] = *(const LAS bf16x8*)(sl + (mt * 2 + ks) * 1024 + lane * 16);
        const v4u q0 = *(const LAS v4u*)(sl + 8192 + lane * 16), q1 = *(const LAS v4u*)(sl + 9216 + lane * 16);
        unsigned char* sp_ = F.ws + WS_HB + (size_t)((b * NH + h) * 128 + cc) * 8192;
        v2u sb[4]; f32x4 nacc[4];
#pragma unroll
        for (int mt = 0; mt < 4; ++mt) sb[mt] = pack4(acc[mt]);
        nacc[0] = unpack4((v2u){q0.x, q0.y}); nacc[1] = unpack4((v2u){q0.z, q0.w}); nacc[2] = unpack4((v2u){q1.x, q1.y}); nacc[3] = unpack4((v2u){q1.z, q1.w});
#pragma unroll
        for (int mt = 0; mt < 4; ++mt) *(GAS v2u*)(sp_ + ((w * 2 + (mt >> 1)) * 64 + 16 * (2 * (mt & 1) + (g >> 1)) + c) * 16 + 8 * (g & 1)) = sb[mt];
        bf16x8 bf[2];
#pragma unroll
        for (int ks = 0; ks < 2; ++ks) { v4u t; t.x = sb[2 * ks].x; t.y = sb[2 * ks].y; t.z = sb[2 * ks + 1].x; t.w = sb[2 * ks + 1].y; bf[ks] = __builtin_bit_cast(bf16x8, t); }
#pragma unroll
        for (int mt = 0; mt < 4; ++mt) { nacc[mt] = mfma16(pa[mt][0], bf[0], nacc[mt]); nacc[mt] = mfma16(pa[mt][1], bf[1], nacc[mt]); acc[mt] = nacc[mt]; }
        asm volatile("s_waitcnt lgkmcnt(0)" ::: "memory");
    }
    float* o = F.out + O_PWKV + (((size_t)b * NH + h) * 64 + vrow) * 64;
#pragma unroll
    for (int mt = 0; mt < 4; ++mt) *(GAS f32x4*)(o + 16 * mt + 4 * g) = acc[mt];
}

__device__ __forceinline__ void rwkv_yout_item(Frame& F, int item) {
    int lane_ = F.lane; asm volatile("" : "+v"(lane_)); const int lane = lane_, g = lane >> 4, c = lane & 15; const int unit = item >> 2, w = item & 3;
    const int chunk = unit / NH, h = unit % NH, row0 = chunk * 64; const bool first = (chunk & 127) == 0;
    const unsigned char* rec = F.ws + WS_REC + (size_t)rec_index(chunk, h) * REC_BYTES; const unsigned char* srec = F.ws + WS_HB + (size_t)rec_index(chunk, h) * 8192;
    const bf16* proj = (const bf16*)(F.ws + WS_PROJ);
    f32x4 y[4], gt[4]; zero4(gt);
    { const v4u y01 = *(const GAS v4u*)(rec + REC_YL + (w * 64 + lane) * 32), y23 = *(const GAS v4u*)(rec + REC_YL + (w * 64 + lane) * 32 + 16);
      y[0] = unpack4((v2u){y01.x, y01.y}); y[1] = unpack4((v2u){y01.z, y01.w}); y[2] = unpack4((v2u){y23.x, y23.y}); y[3] = unpack4((v2u){y23.z, y23.w}); }
    { bf16x8 ar[2], sf[4][2]; v4u gc[4], gp[4]; v2u bvv[4];
      const int tg = 16 * w + c; const bf16* crg = proj + (size_t)(row0 + tg) * NCOLA; const bool hpg = !(first && tg == 0);
#pragma unroll
      for (int ks = 0; ks < 2; ++ks) { ar[ks] = *(const GAS bf16x8*)(rec + REC_RY + ((w * 2 + ks) * 64 + lane) * 16);
#pragma unroll
          for (int n = 0; n < 4; ++n) sf[n][ks] = *(const GAS bf16x8*)(srec + ((n * 2 + ks) * 64 + lane) * 16); }
      __builtin_amdgcn_sched_barrier(0);
#pragma unroll
      for (int ks = 0; ks < 2; ++ks)
#pragma unroll
          for (int n = 0; n < 4; ++n) y[n] = mfma16(ar[ks], sf[n][ks], y[n]); }
    { const int t = 16 * w + c; const bf16* cr = proj + (size_t)(row0 + t) * NCOLA; const bf16* pr = (first && t == 0) ? nullptr : cr - NCOLA; const bf16* Wg2 = (const bf16*)(F.ws + WS_WG2);
#pragma unroll
      for (int ks = 0; ks < 4; ++ks) { const int l0 = 32 * ks + 8 * g; float x[8]; load_shift8(cr + 2432 + l0, pr ? pr + 2432 + l0 : nullptr, F.in[I_MU] + 2432 + l0, x);
#pragma unroll
          for (int i = 0; i < 8; ++i) x[i] = fsigmoid(x[i]);
          const bf16x8 ag = pack_frag(x);
#pragma unroll
          for (int n = 0; n < 4; ++n) gt[n] = mfma16(ag, *(const GAS bf16x8*)(Wg2 + (size_t)(h * 64 + 16 * n + c) * 128 + l0), gt[n]); } }
    float mean[4], rstd[4];
#pragma unroll
    for (int reg = 0; reg < 4; ++reg) { float s = (y[0][reg] + y[1][reg]) + (y[2][reg] + y[3][reg]); s = sum16(s); mean[reg] = s * (1.0f / 64.0f);
        float q = 0.f;
#pragma unroll
        for (int n = 0; n < 4; ++n) { const float d = y[n][reg] - mean[reg]; q += d * d; }
        q = sum16(q); rstd[reg] = rsqrtf(q * (1.0f / 64.0f) + 6.4e-4f); }
    bf16* mix = (bf16*)(F.ws + WS_MIX);
#pragma unroll
    for (int n = 0; n < 4; ++n) { const int col = h * 64 + 16 * n + c; const float lnw = F.in[I_LNW][col], lnb = F.in[I_LNB][col];
        const f32x4 bv = unpack4(*(const GAS v2u*)(rec + REC_BV + ((w * 64 + lane) * 4 + n) * 8));
#pragma unroll
        for (int reg = 0; reg < 4; ++reg) { const float o = ((y[n][reg] - mean[reg]) * rstd[reg] * lnw + lnb + bv[reg]) * gt[n][reg];
            mix[(size_t)(row0 + 16 * w + 4 * g + reg) * DM + col] = f2bf(o); } }
}

__device__ __forceinline__ int crow32(int r, int hi) { return (r & 3) + 8 * (r >> 2) + 4 * hi; }
template <bool MASKED, int GB>
__device__ __forceinline__ void flash32(const bf16x8 (&qf)[4], const bf16* Kp, int kstr, const bf16* VTp, int vstr, int kb_lo, int nblk, int qpos, float m0, float l0,
                                        f32x16& o0, f32x16& o1, float& lsum, int lane) {
    const int r32 = lane & 31, hh = lane >> 5;
    float m = m0, l = hh == 0 ? l0 : 0.f;
#pragma unroll
    for (int r = 0; r < 16; ++r) { o0[r] = 0.f; o1[r] = 0.f; }
    for (int b0 = 0; b0 < nblk; b0 += GB) {
        bf16x8 kf[GB][4]; v2u vf[GB][2][2][2];
#pragma unroll
        for (int i = 0; i < GB; ++i) if (b0 + i < nblk) { const int kb = kb_lo + 32 * (b0 + i);
#pragma unroll
            for (int ks = 0; ks < 4; ++ks) kf[i][ks] = *(const GAS bf16x8*)(Kp + (size_t)(kb + r32) * kstr + 16 * ks + 8 * hh);
#pragma unroll
            for (int s2 = 0; s2 < 2; ++s2)
#pragma unroll
                for (int dt = 0; dt < 2; ++dt) { const bf16* vp = VTp + (size_t)(32 * dt + r32) * vstr + kb + 16 * s2 + 4 * hh; vf[i][s2][dt][0] = *(const GAS v2u*)vp; vf[i][s2][dt][1] = *(const GAS v2u*)(vp + 8); } }
#pragma unroll
        for (int i = 0; i < GB; ++i) if (b0 + i < nblk) { const int kb = kb_lo + 32 * (b0 + i);
            f32x16 s;
#pragma unroll
            for (int r = 0; r < 16; ++r) s[r] = 0.f;
#pragma unroll
            for (int ks = 0; ks < 4; ++ks) s = mfma32(kf[i][ks], qf[ks], s);
            if (MASKED) {
#pragma unroll
                for (int r = 0; r < 16; ++r) { const int rel = qpos - (kb + crow32(r, hh)); if (rel < 0 || rel >= 128) s[r] = -1e30f; } }
            float bm = s[0];
#pragma unroll
            for (int r = 1; r < 16; ++r) bm = fmaxf(bm, s[r]);
            bm = max_x32(bm);
            const float mn = fmaxf(m, bm), alpha = __builtin_amdgcn_exp2f(m - mn); m = mn;
            float ps = 0.f;
#pragma unroll
            for (int r = 0; r < 16; ++r) { s[r] = __builtin_amdgcn_exp2f(s[r] - mn); ps += s[r]; }
            l = l * alpha + ps;
#pragma unroll
            for (int r = 0; r < 16; ++r) { o0[r] *= alpha; o1[r] *= alpha; }
#pragma unroll
            for (int s2 = 0; s2 < 2; ++s2) {
                v4u pw; pw.x = cvt_pk_bf16(s[8 * s2], s[8 * s2 + 1]); pw.y = cvt_pk_bf16(s[8 * s2 + 2], s[8 * s2 + 3]); pw.z = cvt_pk_bf16(s[8 * s2 + 4], s[8 * s2 + 5]); pw.w = cvt_pk_bf16(s[8 * s2 + 6], s[8 * s2 + 7]);
                const bf16x8 pb = __builtin_bit_cast(bf16x8, pw);
                { v4u aw; aw.x = vf[i][s2][0][0].x; aw.y = vf[i][s2][0][0].y; aw.z = vf[i][s2][0][1].x; aw.w = vf[i][s2][0][1].y; o0 = mfma32(__builtin_bit_cast(bf16x8, aw), pb, o0); }
                { v4u aw; aw.x = vf[i][s2][1][0].x; aw.y = vf[i][s2][1][0].y; aw.z = vf[i][s2][1][1].x; aw.w = vf[i][s2][1][1].y; o1 = mfma32(__builtin_bit_cast(bf16x8, aw), pb, o1); } }
        }
    }
    lsum = add_x32(l);
}
__device__ __forceinline__ void flash_store(bf16* dst  , int rstride, const f32x16& o0, const f32x16& o1, float lsum, int lane) {
    const int r32 = lane & 31, hh = lane >> 5; const float inv = 1.0f / lsum; bf16* p = dst + (size_t)r32 * rstride + 4 * hh;
#pragma unroll
    for (int k = 0; k < 4; ++k) { *(GAS v2u*)(p + 8 * k) = pack4((f32x4){o0[4 * k] * inv, o0[4 * k + 1] * inv, o0[4 * k + 2] * inv, o0[4 * k + 3] * inv});
        *(GAS v2u*)(p + 32 + 8 * k) = pack4((f32x4){o1[4 * k] * inv, o1[4 * k + 1] * inv, o1[4 * k + 2] * inv, o1[4 * k + 3] * inv}); }
}
constexpr int KL_STR = 144;
template <bool MASKED>
__device__ __forceinline__ void flash32_lds(const bf16x8 (&qf)[4], const LAS unsigned char* Kl, const LAS unsigned char* Vl, int vstr, int lk_lo, int nblk, int kpos_lo, int qpos, float m0, float l0,
                                            f32x16& o0, f32x16& o1, float& lsum, int lane) {
    const int r32 = lane & 31, hh = lane >> 5;
    float m = m0, l = hh == 0 ? l0 : 0.f;
#pragma unroll
    for (int r = 0; r < 16; ++r) { o0[r] = 0.f; o1[r] = 0.f; }
    for (int blk = 0; blk < nblk; ++blk) { const int lk = lk_lo + 32 * blk;
        f32x16 s;
#pragma unroll
        for (int r = 0; r < 16; ++r) s[r] = 0.f;
#pragma unroll
        for (int ks = 0; ks < 4; ++ks) s = mfma32(*(const LAS bf16x8*)(Kl + (lk + r32) * KL_STR + (16 * ks + 8 * hh) * 2), qf[ks], s);
        if (MASKED && (blk == 0 || blk == nblk - 1)) {
#pragma unroll
            for (int r = 0; r < 16; ++r) { const int rel = qpos - (kpos_lo + 32 * blk + crow32(r, hh)); if (rel < 0 || rel >= 128) s[r] = -1e30f; } }
        float bm = s[0];
#pragma unroll
        for (int r = 1; r < 16; ++r) bm = fmaxf(bm, s[r]);
        bm = max_x32(bm);
        const float mn = fmaxf(m, bm), alpha = __builtin_amdgcn_exp2f(m - mn); m = mn;
        float ps = 0.f;
#pragma unroll
        for (int r = 0; r < 16; ++r) { s[r] = __builtin_amdgcn_exp2f(s[r] - mn); ps += s[r]; }
        l = l * alpha + ps;
#pragma unroll
        for (int r = 0; r < 16; ++r) { o0[r] *= alpha; o1[r] *= alpha; }
#pragma unroll
        for (int s2 = 0; s2 < 2; ++s2) {
            v4u pw; pw.x = cvt_pk_bf16(s[8 * s2], s[8 * s2 + 1]); pw.y = cvt_pk_bf16(s[8 * s2 + 2], s[8 * s2 + 3]); pw.z = cvt_pk_bf16(s[8 * s2 + 4], s[8 * s2 + 5]); pw.w = cvt_pk_bf16(s[8 * s2 + 6], s[8 * s2 + 7]);
            const bf16x8 pb = __builtin_bit_cast(bf16x8, pw);
#pragma unroll
            for (int dt = 0; dt < 2; ++dt) { const LAS unsigned char* vp = Vl + (32 * dt + r32) * vstr + (lk + 16 * s2 + 4 * hh) * 2;
                const v2u a0 = *(const LAS v2u*)vp, a1 = *(const LAS v2u*)(vp + 16); v4u aw; aw.x = a0.x; aw.y = a0.y; aw.z = a1.x; aw.w = a1.y;
                if (dt == 0) o0 = mfma32(__builtin_bit_cast(bf16x8, aw), pb, o0); else o1 = mfma32(__builtin_bit_cast(bf16x8, aw), pb, o1); } }
    }
    lsum = add_x32(l);
}
template <bool VT>
__device__ __forceinline__ void stage_kv(LAS unsigned char* Kl, LAS unsigned char* Vl, int vstr, const bf16* Kg, int kstr, const bf16* Vg, int vstr_g, int nkeys, int tid) {
    for (int id = tid; id < nkeys * 8; id += NWAVES * 64) { const int key = id >> 3, ch = id & 7; *(LAS v4u*)(Kl + key * KL_STR + ch * 16) = *(const GAS v4u*)(Kg + (size_t)key * kstr + ch * 8); }
    if (VT) { const int cpr = nkeys >> 3;
        for (int id = tid; id < 64 * cpr; id += NWAVES * 64) { const int d = id / cpr, ch = id % cpr; *(LAS v4u*)(Vl + d * vstr + ch * 16) = *(const GAS v4u*)(Vg + (size_t)d * vstr_g + ch * 8); } }
    else for (int id = tid; id < nkeys * 8; id += NWAVES * 64) { const int key = id >> 3, ch = id & 7; const v4u w = *(const GAS v4u*)(Vg + (size_t)key * vstr_g + ch * 8);
        LAS unsigned char* p = Vl + (8 * ch) * vstr + key * 2;
        *(LAS bf16*)(p) = (bf16)(w.x & 0xffffu); *(LAS bf16*)(p + vstr) = (bf16)(w.x >> 16); *(LAS bf16*)(p + 2 * vstr) = (bf16)(w.y & 0xffffu); *(LAS bf16*)(p + 3 * vstr) = (bf16)(w.y >> 16);
        *(LAS bf16*)(p + 4 * vstr) = (bf16)(w.z & 0xffffu); *(LAS bf16*)(p + 5 * vstr) = (bf16)(w.z >> 16); *(LAS bf16*)(p + 6 * vstr) = (bf16)(w.w & 0xffffu); *(LAS bf16*)(p + 7 * vstr) = (bf16)(w.w >> 16); }
}
__device__ __forceinline__ void memattn_prompt_unit(Frame& F, int layer, int unit) {
    int lane_ = F.lane; asm volatile("" : "+v"(lane_)); const int lane = lane_, r32 = lane & 31, hh = lane >> 5;
    const int b = unit >> 7, hm = (unit >> 5) & 3, qblk = unit & 31; const int row = b * T + qblk * 256 + F.wave * 32 + r32;
    LAS unsigned char* Kl = F.lds; LAS unsigned char* Vl = F.lds + 256 * KL_STR; constexpr int VSTR = 256 * 2 + 16;
    __syncthreads();
    stage_kv<true>(Kl, Vl, VSTR, (const bf16*)(F.ws + WS_MK) + (size_t)((layer * 2 + b) * 4 + hm) * 256 * 64, 64, (const bf16*)(F.ws + WS_MVT) + (size_t)((layer * 2 + b) * 4 + hm) * 64 * 256, 256, 256, F.wave * 64 + lane);
    bf16x8 qf[4];
    if (layer == 0) { const bf16* qp = (const bf16*)(F.ws + WS_PROJ) + (size_t)row * NCOLA + RWKV_COLS + hm * 64; const float* gn = F.in[I_MQN];
        float x[4][8]; float ss = 0.f;
#pragma unroll
        for (int ks = 0; ks < 4; ++ks) { const v4u w = *(const GAS v4u*)(qp + 16 * ks + 8 * hh); const unsigned ww[4] = {w.x, w.y, w.z, w.w};
#pragma unroll
            for (int i = 0; i < 4; ++i) { x[ks][2 * i] = bflo(ww[i]); x[ks][2 * i + 1] = bfhi(ww[i]); ss += x[ks][2 * i] * x[ks][2 * i] + x[ks][2 * i + 1] * x[ks][2 * i + 1]; } }
        ss = add_x32(ss); const float rs = rsqrtf(ss * (1.0f / 64.0f) + 1e-6f) * C2Q;
#pragma unroll
        for (int ks = 0; ks < 4; ++ks) {
#pragma unroll
            for (int i = 0; i < 8; ++i) x[ks][i] *= rs * gn[16 * ks + 8 * hh + i];
            qf[ks] = pack_frag(x[ks]); }
    } else { const bf16* qp = (const bf16*)(F.ws + WS_Q1) + (size_t)row * DM + 768 + hm * 64;
#pragma unroll
        for (int ks = 0; ks < 4; ++ks) qf[ks] = *(const GAS bf16x8*)(qp + 16 * ks + 8 * hh); }
    __syncthreads();
    f32x16 o0, o1; float ls;
    flash32_lds<false>(qf, Kl, Vl, VSTR, 0, 8, 0, 0, -1e30f, 0.f, o0, o1, ls, lane);
    flash_store((bf16*)(F.ws + WS_MIX) + (size_t)(b * T + qblk * 256 + F.wave * 32) * DM + 768 + hm * 64, DM, o0, o1, ls, lane);
}
__device__ __forceinline__ void swa_prompt_unit(Frame& F, int unit) {
    int lane_ = F.lane; asm volatile("" : "+v"(lane_)); const int lane = lane_, r32 = lane & 31, hh = lane >> 5;
    const int b = unit >> 7, kvh = (unit >> 5) & 3, qblk = unit & 31, q0 = qblk * 256, kb0 = q0 >= 128 ? q0 - 128 : 0, nkeys = q0 + 256 - kb0;
    LAS unsigned char* Kl = F.lds; LAS unsigned char* Vl = F.lds + 384 * KL_STR; constexpr int VSTR = 384 * 2 + 16;
    __syncthreads();
    stage_kv<false>(Kl, Vl, VSTR, (const bf16*)(F.ws + WS_K1) + (size_t)(b * T + kb0) * 256 + kvh * 64, 256, (const bf16*)(F.ws + WS_V1) + (size_t)(b * T + kb0) * 256 + kvh * 64, 256, nkeys, F.wave * 64 + lane);
    const int tq = q0 + F.wave * 32, row = b * T + tq + r32;
    bf16x8 qf[3][4];
#pragma unroll
    for (int gq = 0; gq < 3; ++gq) { const bf16* qp = (const bf16*)(F.ws + WS_Q1) + (size_t)row * DM + (kvh * 3 + gq) * 64;
#pragma unroll
        for (int ks = 0; ks < 4; ++ks) qf[gq][ks] = *(const GAS bf16x8*)(qp + 16 * ks + 8 * hh); }
    __syncthreads();
    const int kp_lo = tq >= 128 ? tq - 128 : 0, nblk = (tq - kp_lo) / 32 + 1;
#pragma unroll
    for (int gq = 0; gq < 3; ++gq) { const int hq = kvh * 3 + gq; const float sink = F.in[I_SINKS][hq] * LOG2E;
        f32x16 o0, o1; float ls;
        flash32_lds<true>(qf[gq], Kl, Vl, VSTR, kp_lo - kb0, nblk, kp_lo, tq + r32, sink, 1.0f, o0, o1, ls, lane);
        flash_store((bf16*)(F.ws + WS_MIX) + (size_t)(b * T + tq) * DM + hq * 64, DM, o0, o1, ls, lane); }
}
template <int NQ, bool WINDOW>
__device__ __forceinline__ void small_attn(const LAS float* ql, LAS float* sc, int NKP, const float* k1, const float* v1, int kst1, int nk1, const bf16* k2, const bf16* v2, int kst2, int nk2,
                                           const float* sinkg  , bf16* out0, int ostride_q, int lane) {
    const int sub = lane >> 4, dq = lane & 15, nk = nk1 + nk2;
    f32x4 qv[NQ];
#pragma unroll
    for (int qi = 0; qi < NQ; ++qi) qv[qi] = *(const LAS f32x4*)(ql + qi * 64 + 4 * dq);
    constexpr int KBAT = NQ > 4 ? 4 : 8;
    for (int kg0 = 0; kg0 < nk1; kg0 += 4 * KBAT) { f32x4 kv[KBAT];
#pragma unroll
        for (int u = 0; u < KBAT; ++u) kv[u] = *(const GAS f32x4*)(k1 + (size_t)(kg0 + 4 * u + sub) * kst1 + 4 * dq);
        __builtin_amdgcn_sched_barrier(0);
#pragma unroll
        for (int u = 0; u < KBAT; ++u) { const int key = kg0 + 4 * u + sub;
#pragma unroll
            for (int qi = 0; qi < NQ; ++qi) { const f32x4 p = qv[qi] * kv[u]; const float s = sum16((p[0] + p[1]) + (p[2] + p[3])); if (dq == 0) sc[qi * NKP + key] = s; } } }
    for (int kg = nk1; kg < nk; kg += 4) { const int key = kg + sub; const f32x4 kv = unpack4(*(const GAS v2u*)(k2 + (size_t)(key - nk1) * kst2 + 4 * dq));
#pragma unroll
        for (int qi = 0; qi < NQ; ++qi) { const f32x4 p = qv[qi] * kv; const float s = sum16((p[0] + p[1]) + (p[2] + p[3])); if (dq == 0) sc[qi * NKP + key] = s; } }
    LDS_WAIT(); asm volatile("" ::: "memory");
#pragma unroll
    for (int qi = 0; qi < NQ; ++qi) { float sv[5]; const float sk_ = sinkg ? sinkg[qi >> 2] * LOG2E : -1e30f; float mx = sk_;
#pragma unroll
        for (int t = 0; t < 5; ++t) { const int key = lane + 64 * t; float s = -1e30f; if (key < nk) { s = sc[qi * NKP + key]; if (WINDOW) { const int i = qi & 3; if (key < i + 1 || key > 128 + i) s = -1e30f; } } sv[t] = s; mx = fmaxf(mx, s); }
        mx = wave_max(mx); float sum = 0.f;
#pragma unroll
        for (int t = 0; t < 5; ++t) { sv[t] = __builtin_amdgcn_exp2f(sv[t] - mx); sum += sv[t]; }
        sum = wave_sum(sum) + (sinkg ? __builtin_amdgcn_exp2f(sk_ - mx) : 0.f); const float inv = 1.0f / sum;
#pragma unroll
        for (int t = 0; t < 5; ++t) { const int key = lane + 64 * t; if (key < nk) sc[qi * NKP + key] = sv[t] * inv; } }
    LDS_WAIT(); asm volatile("" ::: "memory");
    f32x4 acc[NQ];
#pragma unroll
    for (int qi = 0; qi < NQ; ++qi) acc[qi] = (f32x4){0.f, 0.f, 0.f, 0.f};
    for (int kg0 = 0; kg0 < nk1; kg0 += 4 * KBAT) { f32x4 vv[KBAT];
#pragma unroll
        for (int u = 0; u < KBAT; ++u) vv[u] = *(const GAS f32x4*)(v1 + (size_t)(kg0 + 4 * u + sub) * kst1 + 4 * dq);
        __builtin_amdgcn_sched_barrier(0);
#pragma unroll
        for (int u = 0; u < KBAT; ++u) { const int key = kg0 + 4 * u + sub;
#pragma unroll
            for (int qi = 0; qi < NQ; ++qi) acc[qi] += vv[u] * sc[qi * NKP + key]; } }
    for (int kg = nk1; kg < nk; kg += 4) { const int key = kg + sub; const f32x4 vv = unpack4(*(const GAS v2u*)(v2 + (size_t)(key - nk1) * kst2 + 4 * dq));
#pragma unroll
        for (int qi = 0; qi < NQ; ++qi) acc[qi] += vv * sc[qi * NKP + key]; }
#pragma unroll
    for (int qi = 0; qi < NQ; ++qi) { f32x4 a = acc[qi];
#pragma unroll
        for (int e = 0; e < 4; ++e) { a[e] = add_x16(a[e]); a[e] = add_x32(a[e]); }
        if (sub == 0) *(GAS v2u*)(out0 + (size_t)(qi & 3) * ostride_q + (qi >> 2) * 64 + 4 * dq) = pack4(a); }
    LDS_WAIT(); asm volatile("" ::: "memory");
}
__device__ __forceinline__ void memattn_sample_task(Frame& F, int layer, int task, LAS float* wl  ) {
    int lane_ = F.lane; asm volatile("" : "+v"(lane_)); const int lane = lane_, b = task >> 2, hm = task & 3; LAS float* ql = wl; LAS float* sc = wl + 12 * 64;
#pragma unroll
    for (int i = 0; i < 4; ++i) { const int row = RP + b * ST + i; float x;
        if (layer == 0) { x = bf2f(((const bf16*)(F.ws + WS_PROJ))[(size_t)row * NCOLA + RWKV_COLS + hm * 64 + lane]); const float ss = wave_sum(x * x); x *= rsqrtf(ss * (1.0f / 64.0f) + 1e-6f) * C2Q * F.in[I_MQN][lane]; }
        else x = bf2f(((const bf16*)(F.ws + WS_Q1))[(size_t)row * DM + 768 + hm * 64 + lane]);
        ql[i * 64 + lane] = x; }
    LDS_WAIT(); asm volatile("" ::: "memory");
    const float* k1 = F.in[I_CMK] + (((size_t)layer * SB + b) * NMEM * 4 + hm) * 64; const float* v1 = F.in[I_CMV] + (((size_t)layer * SB + b) * NMEM * 4 + hm) * 64;
    small_attn<4, false>(ql, sc, 264, k1, v1, 256, 256, nullptr, nullptr, 0, 0, nullptr, (bf16*)(F.ws + WS_MIX) + (size_t)(RP + b * ST) * DM + 768 + hm * 64, DM, lane);
}
__device__ __forceinline__ void swa_sample_task(Frame& F, int task, LAS float* wl) {
    int lane_ = F.lane; asm volatile("" : "+v"(lane_)); const int lane = lane_, b = task >> 2, kvh = task & 3; LAS float* ql = wl; LAS float* sc = wl + 12 * 64;
#pragma unroll
    for (int qi = 0; qi < 12; ++qi) { const int i = qi & 3, gq = qi >> 2, hq = kvh * 3 + gq; const int row = RP + b * ST + i;
        ql[qi * 64 + lane] = bf2f(((const bf16*)(F.ws + WS_Q1))[(size_t)row * DM + hq * 64 + lane]); }
    LDS_WAIT(); asm volatile("" ::: "memory");
    const float* k1 = F.in[I_CSK] + ((size_t)b * 128 * 4 + kvh) * 64; const float* v1 = F.in[I_CSV] + ((size_t)b * 128 * 4 + kvh) * 64;
    const bf16* k2 = (const bf16*)(F.ws + WS_K1) + (size_t)(RP + b * ST) * 256 + kvh * 64; const bf16* v2 = (const bf16*)(F.ws + WS_V1) + (size_t)(RP + b * ST) * 256 + kvh * 64;
    small_attn<12, true>(ql, sc, 136, k1, v1, 256, 128, k2, v2, 256, 4, F.in[I_SINKS] + kvh * 3, (bf16*)(F.ws + WS_MIX) + (size_t)(RP + b * ST) * DM + kvh * 3 * 64, DM, lane);
}

constexpr int N_PHASES = 13;
template <int PM> __global__ void __launch_bounds__(NWAVES * 64, 2) yoco_fwd(Args args) {
    extern __shared__ __attribute__((aligned(16))) unsigned char lds[];
    Frame F;
    F.lds = (LAS unsigned char*)lds; F.lds_g = lds;
    F.wave = __builtin_amdgcn_readfirstlane((int)threadIdx.x >> 6); F.lane = mk_lane(); F.tid = F.wave * 64 + F.lane;
    F.G = gridDim.x; { const int bx = blockIdx.x; F.vcu = (F.G % 8 == 0) ? (bx % 8) * (F.G / 8) + bx / 8 : bx; }
    F.in = args.in; F.out = args.out; F.ws = args.ws; F.ctl = (gu32*)(args.ws + WS_CTL);
    for (int u = F.tid; u < (LDS_BYTES - LDSCTL_OFF) / 4; u += NWAVES * 64) ((LAS unsigned*)(F.lds + LDSCTL_OFF))[u] = 0u;
    __syncthreads();
    const int lo = args.ph_lo, hi = args.ph_hi;
    XcdBarrier bar; bar.wave0 = F.wave == 0; bar.bar = (unsigned*)(F.ctl + CW_BAR); bar.x = 0; bar.st = nullptr;
    bar = xcd_barrier_post((unsigned*)(F.ctl + CW_BAR), (volatile LAS unsigned*)(F.lds + MISC_OFF) + 8, F.wave == 0);
#define IN(k) (((PM >> (k)) & 1) && lo <= (k) && (k) < hi)
#ifndef MK_DUP
#define MK_DUP -1
#endif
#define PH_REP(k) ((MK_DUP == (k)) ? 2 : 1)
#ifndef MK_TIME
#define MK_TIME -1
#endif
#define STAMP(k) do { if (MK_TIME >= 0 && blockIdx.x == 0 && F.wave == 0 && mk_lane() == 0) ((volatile LAS unsigned long long*)(F.lds + LDSCTL_OFF + 512))[(k)] = __builtin_amdgcn_s_memrealtime(); } while (0)
#define SEAM(k) do { if (IN(k) && IN((k) + 1)) xcd_barrier(bar); STAMP((k) + 1); } while (0)
    const int gw = F.vcu * NWAVES + F.wave, NGW = F.G * NWAVES;
    STAMP(0);
#define SSQ ((float*)(F.ws + WS_SSQ))
#define HB ((bf16*)(F.ws + WS_HB))
#define MIX ((bf16*)(F.ws + WS_MIX))
#define HH ((bf16*)(F.ws + WS_H))
#define PHASE_BEGIN() do { int z_ = 0; unsigned char* ws_ = args.ws; float* out_ = args.out; asm volatile("" : "+s"(z_), "+s"(ws_), "+s"(out_)); F.in = args.in + z_; F.ws = ws_; F.out = out_; \
                           F.lane = mk_lane(); F.tid = F.wave * 64 + F.lane; } while (0)

    if (IN(0)) for (int rep_ = 0; rep_ < PH_REP(0); ++rep_) { PHASE_BEGIN(); p0_prologue(F); } SEAM(0);

    if (IN(1)) for (int rep_ = 0; rep_ < PH_REP(1); ++rep_) { PHASE_BEGIN();
#ifndef NO_MEMKV
        { pg8::Gemm g{(const bf16*)(F.ws + WS_MB), (const bf16*)(F.ws + WS_WM), 512, 1024, DM}; pg8::StaticOrder S; S.init(512, 1024, F.G, (int)((blockIdx.x + 8) % F.G), DM);
          pg8::EpiMemKV E{F.ws, F.out, F.in[I_MKN]};
          pg8::gemm_phase<pg8::EpiMemKV, pg8::StaticOrder, true, true>(F.lds + RING_OFF, g, S, E, F.wave, F.lane); }
#endif
        { pg8::Gemm g{HB, (const bf16*)(F.ws + WS_WA), R, NCOLA, DM}; pg8::StaticOrder S; S.init(R, NCOLA, F.G, (int)blockIdx.x, DM);
          pg8::EpiScaleBf16<0> E{(bf16*)(F.ws + WS_PROJ), NCOLA, SSQ};
          pg8::gemm_phase<pg8::EpiScaleBf16<0>, pg8::StaticOrder, true, true>(F.lds + RING_OFF, g, S, E, F.wave, F.lane); }
    } SEAM(1);

    if (IN(2)) for (int rep_ = 0; rep_ < ((MK_DUP == 2 || (MK_DUP >= 20 && MK_DUP < 30)) ? 2 : 1); ++rep_) { PHASE_BEGIN();
        const int half = F.wave >> 2; const int gw = F.vcu * NWAVES + F.wave, NGW = F.G * NWAVES;
        LAS unsigned char* hb = F.lds + half * PREP_HALF; LAS float* wtot = (LAS float*)(F.lds + WTOT_OFF + half * 1024);
        const int slim = (rep_ == 1 && MK_DUP == 21) ? 3 : (rep_ == 1 && MK_DUP == 22) ? 5 : 99;
        if (!(rep_ == 1 && MK_DUP == 20)) { LAS unsigned char* prow = F.lds + WTOT_OFF + 2048 + half * 512; PrepPf pf; if (F.vcu < NUNIT / 2) prep_issue(F, 2 * F.vcu + half, pf);
            for (int pi = F.vcu; pi < NUNIT / 2; pi += F.G) rwkv_prep_unit(F, 2 * pi + half, hb, wtot, prow, pf, pi + F.G < NUNIT / 2, 2 * (pi + F.G) + half, slim); }
        STAMP(14);
        if (!(rep_ == 1 && (MK_DUP == 21 || MK_DUP == 22))) for (int t = gw; t < SB * NH + 2; t += NGW) {
            if (t < SB * NH) rwkv_sample_task(F, t);
            else { const int b = t - SB * NH; const bf16* lr = (const bf16*)(F.ws + WS_PROJ) + (size_t)(b * T + T - 1) * NCOLA; float* o = F.out + O_PSHIFT + (size_t)b * RWKV_COLS;
                for (int q = F.lane; q < RWKV_COLS; q += 64) o[q] = bf2f(lr[q]); } }
        { const int nsw = (SB * NH + 2 + NWAVES - 1) / NWAVES;
          if (rep_ == 0 && F.vcu >= nsw && F.G > nsw) { __syncthreads(); p0_weights(F, 1, (F.vcu - nsw) * NWAVES + F.wave, (F.G - nsw) * NWAVES, (LAS float*)(F.lds + F.wave * 16384)); }
          else if (rep_ == 0 && F.G <= nsw) { __syncthreads(); p0_weights(F, 1, gw, NGW, (LAS float*)(F.lds + F.wave * 16384)); } }
    } SEAM(2);

    if (IN(3)) for (int rep_ = 0; rep_ < ((MK_DUP == 30 || MK_DUP == 31) ? 2 : 1); ++rep_) { PHASE_BEGIN();
        const int nscan = NB * NH * 4;
        const int nconv = (F.G - nscan) * NWAVES + nscan * 7;
        if (F.vcu < nscan) { if (rep_ == 0 || MK_DUP == 31) { rwkv_scan_chain(F, F.vcu >> 2, F.vcu & 3); if (F.wave == 0) STAMP(23); } }
        else if (rep_ == 0 || MK_DUP == 30) { LAS float* wl = (LAS float*)(F.lds + F.wave * 12288);
            for (int u = F.vcu - nscan; u < 256; u += F.G - nscan) memattn_prompt_unit(F, 0, u);
            __syncthreads();
            const int ow = (F.vcu - nscan) * NWAVES + F.wave, NOW = (F.G - nscan) * NWAVES;
            for (int t = ow; t < 512; t += NOW) memattn_sample_task(F, 0, t, wl);
            }
    } SEAM(3);

    if (IN(4)) for (int rep_ = 0; rep_ < PH_REP(4); ++rep_) { PHASE_BEGIN(); if (rep_ == 0) copy_window_cache(F, gw * 64 + F.lane, NGW * 64);
        _Pragma("unroll 2") for (int it = gw; it < NUNIT * 4; it += NGW) rwkv_yout_item(F, it); } SEAM(4); if (MK_DUP == 40) for (int i_ = 0; i_ < 10; ++i_) xcd_barrier(bar);

    if (IN(5)) for (int rep_ = 0; rep_ < PH_REP(5); ++rep_) { PHASE_BEGIN(); pg8::Gemm g{MIX, (const bf16*)(F.ws + WS_WOUT), R, DM, DM}; pg8::TailOrder S; S.init(F.G, (int)blockIdx.x, DM, S_K1);
        pg8::EpiResid E{F.in[I_XP], F.in[I_XS], RP, nullptr, HB, SSQ, (float*)(F.ws + WS_SLAB), S_K1};
        pg8::gemm_phase<pg8::EpiResid, pg8::TailOrder, true, true>(F.lds + RING_OFF, g, S, E, F.wave, F.lane); } SEAM(5);
    if (IN(6)) for (int rep_ = 0; rep_ < PH_REP(6); ++rep_) { PHASE_BEGIN(); finalize_sample(F, F.in[I_XS], S_K1, false); xcd_barrier(bar);
        pg8::Gemm g{HB, (const bf16*)(F.ws + WS_WUP), R, FF, DM}; pg8::StaticOrder S; S.init(R, FF, F.G, (int)blockIdx.x, DM);
        pg8::EpiScaleBf16<1> E{HH, FF, SSQ};
        pg8::gemm_phase<pg8::EpiScaleBf16<1>, pg8::StaticOrder, true, true>(F.lds + RING_OFF, g, S, E, F.wave, F.lane); } SEAM(6);
    if (IN(7)) { PHASE_BEGIN(); pg8::Gemm g{HH, (const bf16*)(F.ws + WS_WDN), R, DM, FF}; pg8::TailOrder S; S.init(F.G, (int)blockIdx.x, FF, S_K4);
        pg8::EpiResid E{nullptr, nullptr, RP, nullptr, HB, SSQ, (float*)(F.ws + WS_SLAB), S_K4, HB};
        pg8::gemm_phase<pg8::EpiResid, pg8::TailOrder, true, true>(F.lds + RING_OFF, g, S, E, F.wave, F.lane); } SEAM(7);

    if (IN(8)) for (int rep_ = 0; rep_ < PH_REP(8); ++rep_) { PHASE_BEGIN(); finalize_sample(F, nullptr, S_K4, false); xcd_barrier(bar);
        pg8::Gemm g{HB, (const bf16*)(F.ws + WS_WB), R, NCOLB, DM}; pg8::StaticOrder S; S.init(R, NCOLB, F.G, (int)blockIdx.x, DM);
        pg8::EpiL1 E{F.ws, F.out, F.in[I_QN], F.in[I_MQN] + 64, F.in[I_KN]};
        pg8::gemm_phase<pg8::EpiL1, pg8::StaticOrder, true, true>(F.lds + RING_OFF, g, S, E, F.wave, F.lane); } SEAM(8);

    if (IN(9)) for (int rep_ = 0; rep_ < PH_REP(9); ++rep_) { PHASE_BEGIN(); LAS float* wl = (LAS float*)(F.lds + F.wave * 12288); const int gw = F.vcu * NWAVES + F.wave, NGW = F.G * NWAVES;
        for (int u = F.vcu; u < 256; u += F.G) swa_prompt_unit(F, u);
        for (int u = F.vcu; u < 256; u += F.G) memattn_prompt_unit(F, 1, u);
        __syncthreads();
        for (int t = gw; t < 512 + 512; t += NGW) { if (t < 512) swa_sample_task(F, t, wl); else memattn_sample_task(F, 1, t - 512, wl); }
    } SEAM(9);

    if (IN(10)) for (int rep_ = 0; rep_ < PH_REP(10); ++rep_) { PHASE_BEGIN(); pg8::Gemm g{MIX, (const bf16*)(F.ws + WS_WOUT) + (size_t)DM * DM, R, DM, DM}; pg8::TailOrder S; S.init(F.G, (int)blockIdx.x, DM, S_K1);
        pg8::EpiResid E{nullptr, nullptr, RP, nullptr, HB, SSQ, (float*)(F.ws + WS_SLAB), S_K1, HB};
        pg8::gemm_phase<pg8::EpiResid, pg8::TailOrder, true, true>(F.lds + RING_OFF, g, S, E, F.wave, F.lane); } SEAM(10);
    if (IN(11)) for (int rep_ = 0; rep_ < PH_REP(11); ++rep_) { PHASE_BEGIN(); finalize_sample(F, nullptr, S_K1, false); xcd_barrier(bar);
        pg8::Gemm g{HB, (const bf16*)(F.ws + WS_WUP) + (size_t)DM * FF, R, FF, DM}; pg8::StaticOrder S; S.init(R, FF, F.G, (int)blockIdx.x, DM);
        pg8::EpiScaleBf16<1> E{HH, FF, SSQ};
        pg8::gemm_phase<pg8::EpiScaleBf16<1>, pg8::StaticOrder, true, true>(F.lds + RING_OFF, g, S, E, F.wave, F.lane); } SEAM(11);
    if (IN(12)) for (int rep_ = 0; rep_ < PH_REP(12); ++rep_) { PHASE_BEGIN(); pg8::Gemm g{HH, (const bf16*)(F.ws + WS_WDN) + (size_t)DM * FF, R, DM, FF}; pg8::TailOrder S; S.init(F.G, (int)blockIdx.x, FF, S_K4);
        pg8::EpiResid E{nullptr, nullptr, RP, F.out + O_Y, nullptr, nullptr, (float*)(F.ws + WS_SLAB), S_K4, HB};
        pg8::gemm_phase<pg8::EpiResid, pg8::TailOrder, true, true>(F.lds + RING_OFF, g, S, E, F.wave, F.lane);
        xcd_barrier(bar); finalize_sample(F, nullptr, S_K4, true); }
    STAMP(13);
    if (MK_TIME >= 0 && blockIdx.x == 0 && F.wave == 0 && mk_lane() == 0) {
        volatile LAS unsigned long long* ts = (volatile LAS unsigned long long*)(F.lds + LDSCTL_OFF + 512); const unsigned long long d = MK_TIME == 20 ? ts[14] - ts[2] : MK_TIME == 21 ? ts[3] - ts[14] : MK_TIME == 22 ? ts[15] - ts[14] : MK_TIME == 36 ? ts[23] - ts[3] : (MK_TIME >= 30 && MK_TIME < 36) ? ts[MK_TIME - 30 + 18] - ts[MK_TIME - 30 + 17] : MK_TIME == 23 ? ts[16] - ts[15] : ts[MK_TIME + 1] - ts[MK_TIME], t0 = __builtin_amdgcn_s_memrealtime();
        while (__builtin_amdgcn_s_memrealtime() - t0 < d) __builtin_amdgcn_s_sleep(8); }
#undef IN
#undef SEAM
#undef SSQ
#undef HB
#undef MIX
#undef HH
#undef PHASE_BEGIN
}

template <int PM> static void launch_pm(int grid, hipStream_t stream, const Args& a) { hipLaunchKernelGGL(yoco_fwd<PM>, dim3(grid), dim3(NWAVES * 64), LDS_BYTES, stream, a); }
template <int PM> static bool set_lds() { return hipFuncSetAttribute((const void*)yoco_fwd<PM>, hipFuncAttributeMaxDynamicSharedMemorySize, LDS_BYTES) == hipSuccess; }
extern "C" void kernel_launch(void* const* d_in, const int* in_sizes, int n_in, void* d_out, int out_size, void* d_ws, size_t ws_size, hipStream_t stream) {
    static int grid = 0;
    if (grid == 0) {
        if (n_in != N_IN || (size_t)out_size != O_END || ws_size < WS_END) { fprintf(stderr, "kernel_launch: unexpected shapes (n_in %d, out %d, ws %zu < %zu)\n", n_in, out_size, ws_size, (size_t)WS_END); grid = -1; return; }
        int dev = 0, cus = 0;
        if (hipGetDevice(&dev) != hipSuccess || hipDeviceGetAttribute(&cus, hipDeviceAttributeMultiprocessorCount, dev) != hipSuccess) { grid = -1; return; }
        bool ok = true;
#if MK_ONE_LAUNCH
        ok = set_lds<0x1fff>();
#else
        ok = set_lds<1>() && set_lds<2>() && set_lds<4>() && set_lds<8>() && set_lds<16>() && set_lds<32>() && set_lds<64>() && set_lds<128>() && set_lds<256>() && set_lds<512>() && set_lds<1024>() && set_lds<2048>() && set_lds<4096>();
#endif
        if (!ok) { grid = -1; return; }
        (void)hipGetLastError();
        grid = cus;
    }
    if (grid < 0) return;
    (void)hipMemsetAsync((char*)d_ws + WS_CTL, 0, CTL_ZERO_BYTES, stream);
    Args a{};
    for (int i = 0; i < N_IN; ++i) a.in[i] = (const float*)d_in[i];
    a.out = (float*)d_out; a.ws = (unsigned char*)d_ws;
#if MK_ONE_LAUNCH
    a.ph_lo = 0; a.ph_hi = N_PHASES; launch_pm<0x1fff>(grid, stream, a);
#else
#define LP(p) a.ph_lo = (p); a.ph_hi = (p) + 1; launch_pm<(1 << (p))>(grid, stream, a);
    LP(0) LP(1) LP(2) LP(3) LP(4) LP(5) LP(6) LP(7) LP(8) LP(9) LP(10) LP(11) LP(12)
#undef LP
#endif
}
```

```cpp
#include <hip/hip_runtime.h>
#include <cstdio>
#include <cstdint>
namespace pg8 {
#define PG8_LAS __attribute__((address_space(3)))
typedef unsigned short bf16_t;
typedef short bf16x8 __attribute__((ext_vector_type(8)));
typedef float f32x4 __attribute__((ext_vector_type(4)));
typedef unsigned u32x4 __attribute__((ext_vector_type(4)));
constexpr int BM = 256, BK = 64, HALF = 128, HTB = HALF * BK * 2  , STAGE_BYTES = 8 * HTB, NXCD = 8, WGM = 8;

__host__ __device__ __forceinline__ int lds_byte(int r, int c) { const int st = (r >> 4) * 2 + (c >> 5), rr = r & 15, cc = c & 31, ob = rr * 64 + cc * 2; return st * 1024 + (ob ^ (((ob >> 9) & 1) << 5)); }
__host__ __device__ __forceinline__ void stage_rc(int b, int& R, int& C) { const int st = b / 1024, sb = b % 1024, swz = sb ^ (((sb >> 9) & 1) << 5); R = (st >> 1) * 16 + swz / 64; C = (st & 1) * 32 + (swz % 64) / 2; }
__host__ __device__ __forceinline__ int perm32(int rho) { const int n = rho >> 4, i = rho & 15; return 8 * (i >> 2) + 4 * n + (i & 3); }

struct Unit { int pm, pn, kt0, nt; };
struct Gemm { const bf16_t* A; const bf16_t* Bt; int M, N, K; };

struct StaticOrder {
    int nM, nN, nwg, G, c, ntf;
    __host__ __device__ void init(int M, int N, int G_, int c_, int K_) { nM = M / BM; nN = N / BM; nwg = nM * nN; G = G_; c = c_; ntf = K_ / BK; }
    __host__ __device__ bool next(int i, Unit& u) const {
        const long L = (long)i * G + c; if (L >= nwg) return false;
        int wgid = (int)L; { const int q = nwg / NXCD, r = nwg % NXCD, xcd = wgid % NXCD, off = wgid / NXCD; wgid = (xcd < r ? xcd * (q + 1) : r * (q + 1) + (xcd - r) * q) + off; }
        const int nig = WGM * nN, gid = wgid / nig, fm = gid * WGM, gsz = (nM - fm) < WGM ? (nM - fm) : WGM;
        u.pm = fm + ((wgid % nig) % gsz); u.pn = (wgid % nig) / gsz; u.kt0 = 0; u.nt = ntf; return true;
    }
    __device__ __forceinline__ void a_ready(const Unit&) const {}
    __device__ __forceinline__ void done(const Unit&) const {}
};
struct TailOrder {
    StaticOrder P; int S, ntf;
    __host__ __device__ void init(int G_, int c_, int K_, int S_) { P.init(64 * BM, 4 * BM, G_, c_, K_); S = S_; ntf = K_ / BK; }
    __host__ __device__ bool next(int i, Unit& u) const {
        const long L = (long)i * P.G + P.c; if (L >= 256 + 8 * S) return false;
        const int Li = (int)L; const bool prm = Li < 256;
        const int w0 = prm ? Li : 0, wg = (w0 % NXCD) * (256 / NXCD) + w0 / NXCD, nig = WGM * 4, gid = wg / nig, fm = gid * WGM;
        const int pmP = fm + ((wg % nig) % WGM), pnP = (wg % nig) / WGM;
        const int Ls = prm ? 0 : Li - 256, tile = Ls / S, sl = Ls % S, nts = ntf / S;
        u.pm = prm ? pmP : 64 + (tile >> 2); u.pn = prm ? pnP : (tile & 3); u.nt = prm ? ntf : nts; u.kt0 = prm ? 0 : sl * nts; return true;
    }
    __device__ __forceinline__ void a_ready(const Unit&) const {}
    __device__ __forceinline__ void done(const Unit&) const {}
};


typedef float f32x2_t __attribute__((ext_vector_type(2))); typedef __bf16 bf16x2_t __attribute__((ext_vector_type(2)));
__device__ __forceinline__ unsigned cvt_pk_bf16(float lo, float hi) { f32x2_t v = {lo, hi}; bf16x2_t b = __builtin_convertvector(v, bf16x2_t); return __builtin_bit_cast(unsigned, b); }
__device__ __forceinline__ u32x4 pack8(f32x4 v0, f32x4 v1) { u32x4 w; w.x = cvt_pk_bf16(v0[0], v0[1]); w.y = cvt_pk_bf16(v0[2], v0[3]); w.z = cvt_pk_bf16(v1[0], v1[1]); w.w = cvt_pk_bf16(v1[2], v1[3]); return w; }

template <int M> __device__ __forceinline__ float swz_xor(float v) { return __int_as_float(__builtin_amdgcn_ds_swizzle(__float_as_int(v), (M << 10) | 0x1f)); }
__device__ __forceinline__ float add_x32(float v) { auto r = __builtin_amdgcn_permlane32_swap(__float_as_uint(v), __float_as_uint(v), false, false); return __uint_as_float(r[0]) + __uint_as_float(r[1]); }
__device__ __forceinline__ float max_x32(float v) { auto r = __builtin_amdgcn_permlane32_swap(__float_as_uint(v), __float_as_uint(v), false, false); return fmaxf(__uint_as_float(r[0]), __uint_as_float(r[1])); }
__device__ __forceinline__ float add_x16(float v) { return v + swz_xor<16>(v); }
template <int CTRL> __device__ __forceinline__ float dpp_mov(float v) { return __int_as_float(__builtin_amdgcn_update_dpp(0, __float_as_int(v), CTRL, 0xf, 0xf, false)); }
__device__ __forceinline__ float sum16_dpp(float v) { v += dpp_mov<0xB1>(v); v += dpp_mov<0x4E>(v); v += dpp_mov<0x141>(v); v += dpp_mov<0x140>(v); return v; }
__device__ __forceinline__ float max16_dpp(float v) { v = fmaxf(v, dpp_mov<0xB1>(v)); v = fmaxf(v, dpp_mov<0x4E>(v)); v = fmaxf(v, dpp_mov<0x141>(v)); v = fmaxf(v, dpp_mov<0x140>(v)); return v; }
__device__ __forceinline__ float sum4_dpp(float v) { v += dpp_mov<0xB1>(v); v += dpp_mov<0x4E>(v); return v; }
__device__ __forceinline__ float hsum4(f32x4 a) { return (a[0] + a[1]) + (a[2] + a[3]); }
__device__ __forceinline__ float row_rstd(const float* ssq, int row) {
    const f32x4* p = (const f32x4*)(ssq + (size_t)row * 16);
    const f32x4 a = p[0], b = p[1], c = p[2], d = p[3];
    const float s = (hsum4(a) + hsum4(b)) + (hsum4(c) + hsum4(d));
    return rsqrtf(s * (1.0f / 1024.0f) + 1e-6f);
}
template <int ACT> struct EpiScaleBf16 {
    static constexpr bool PERM = true, AFTER_DRAIN = false;
    bf16_t* O; int ldc; const float* ssq;
    __device__ __forceinline__ void operator()(const f32x4 (&acc)[2][2][4][2], const Unit& u, int wr, int wc, int fr_, int fq_) const {
        int fr = fr_, fq = fq_; asm volatile("" : "+v"(fr), "+v"(fq));
        const int row0 = u.pm * BM + wr * 64 + fr, col0 = u.pn * BM + wc * 32 + 8 * fq;
#pragma unroll
        for (int ai = 0; ai < 2; ++ai)
#pragma unroll
            for (int m = 0; m < 4; ++m) { const int row = row0 + ai * HALF + m * 16; const float rs = row_rstd(ssq, row); bf16_t* rowp = O + (size_t)row * ldc + col0;
#pragma unroll
                for (int bj = 0; bj < 2; ++bj) { f32x4 v0 = acc[ai][bj][m][0] * rs, v1 = acc[ai][bj][m][1] * rs;
                    if (ACT == 1) {
#pragma unroll
                        for (int e = 0; e < 4; ++e) { const float a = fmaxf(v0[e], 0.f), b = fmaxf(v1[e], 0.f); v0[e] = a * a; v1[e] = b * b; } }
                    *(u32x4*)(rowp + bj * HALF) = pack8(v0, v1); } }
    }
};
struct EpiResid {
    static constexpr bool PERM = true, AFTER_DRAIN = false;
    const float* base; const float* base2; int split; float* out; bf16_t* hb; float* ssq_out; float* slab; int S; const bf16_t* hbase = nullptr; int omask = -1;
    __device__ __forceinline__ void operator()(const f32x4 (&acc)[2][2][4][2], const Unit& u, int wr, int wc, int fr_, int fq_) const {
        int fr = fr_, fq = fq_; asm volatile("" : "+v"(fr), "+v"(fq));
        if (slab && u.pm >= 64) {
            float* sp = slab + ((size_t)((((u.pm - 64) << 2) + u.pn) * S + u.kt0 / u.nt) << 16) + (size_t)(wr * 64 + fr) * 256 + wc * 32 + 8 * fq;
#pragma unroll
            for (int ai = 0; ai < 2; ++ai)
#pragma unroll
                for (int m = 0; m < 4; ++m)
#pragma unroll
                    for (int bj = 0; bj < 2; ++bj) { float* p = sp + (size_t)(ai * HALF + m * 16) * 256 + bj * HALF; *(f32x4*)p = acc[ai][bj][m][0]; *(f32x4*)(p + 4) = acc[ai][bj][m][1]; }
            return;
        }
        const int row0 = u.pm * BM + wr * 64 + fr, col0 = u.pn * BM + wc * 32 + 8 * fq;
#pragma unroll
        for (int ai = 0; ai < 2; ++ai)
#pragma unroll
            for (int m = 0; m < 4; ++m) { const int row = row0 + ai * HALF + m * 16;
                const float* bp = (row < split ? base + (size_t)row * 1024 : base2 + (size_t)(row - split) * 1024) + col0;
                float ss = 0.f;
#pragma unroll
                for (int bj = 0; bj < 2; ++bj) { f32x4 b0, b1;
                    if (hbase) { const u32x4 w = *(const u32x4*)(hbase + (size_t)row * 1024 + col0 + bj * HALF);
                        b0 = (f32x4){__uint_as_float(w.x << 16), __uint_as_float(w.x & 0xffff0000u), __uint_as_float(w.y << 16), __uint_as_float(w.y & 0xffff0000u)};
                        b1 = (f32x4){__uint_as_float(w.z << 16), __uint_as_float(w.z & 0xffff0000u), __uint_as_float(w.w << 16), __uint_as_float(w.w & 0xffff0000u)}; }
                    else { b0 = *(const f32x4*)(bp + bj * HALF); b1 = *(const f32x4*)(bp + bj * HALF + 4); }
                    const f32x4 h0 = b0 + acc[ai][bj][m][0], h1 = b1 + acc[ai][bj][m][1];
                    if (out) { float* op = out + (size_t)(row & omask) * 1024 + col0; *(f32x4*)(op + bj * HALF) = h0; *(f32x4*)(op + bj * HALF + 4) = h1; }
                    if (hb) *(u32x4*)(hb + (size_t)row * 1024 + col0 + bj * HALF) = pack8(h0, h1);
                    ss += hsum4(h0 * h0) + hsum4(h1 * h1); }
                if (ssq_out) { ss = add_x16(ss); ss = add_x32(ss); if (fq == 0) ssq_out[(size_t)row * 16 + u.pn * 4 + wc] = ss; }
                if (m == 3) asm volatile("" ::: "memory"); }
    }
};
template <class Epi, class Sched, bool ALIGN_EPI = false, bool SP2 = false>
__device__ __forceinline__ void gemm_phase(PG8_LAS unsigned char* lds, const Gemm g, const Sched& S, const Epi& E, int wid_in, int lane_in) {
    const int wid = wid_in, lane = lane_in, tid = wid * 64 + lane, wr = wid >> 2, wc = wid & 3, fr = lane & 15, fq = lane >> 4;
    const int K = g.K;
    unsigned voffA[2], voffB[2];
#pragma unroll
    for (int i = 0; i < 2; ++i) { int R, C; stage_rc(tid * 16 + i * 8192, R, C); const int Rb = Epi::PERM ? ((R & ~31) + perm32(R & 31)) : R;
        voffA[i] = (unsigned)(R * K + C) * 2u; voffB[i] = (unsigned)(Rb * K + C) * 2u; }
    const size_t kstep = (size_t)(BK * 2);
    const size_t hstep = (size_t)HALF * K * 2;
    const size_t tstep = 2 * hstep;
    const unsigned ldsw = (unsigned)wid * 1024u;
    const int aoff = lds_byte(wr * 64 + fr, fq * 8), boff = lds_byte(wc * 32 + fr, fq * 8);
#define PG8_SA(b, h) (((b) * 2 + (h)) * HTB)
#define PG8_SB(b, h) ((4 + (b) * 2 + (h)) * HTB)
#define PG8_STAGE(bufoff, gbase, voff) do { _Pragma("unroll") for (int _i = 0; _i < 2; ++_i) \
        __builtin_amdgcn_global_load_lds((const unsigned*)((const char*)(gbase) + (voff)[_i]), (PG8_LAS unsigned*)(lds + (bufoff) + ldsw + _i * 8192), 16, 0, 0); } while (0)
#define PG8_LDA(dst, b, h) do { _Pragma("unroll") for (int m = 0; m < 4; ++m) _Pragma("unroll") for (int k = 0; k < 2; ++k) dst[m][k] = *(const PG8_LAS bf16x8*)(lds + PG8_SA(b, h) + aoff + m * 2048 + k * 1024); } while (0)
#define PG8_LDB(dst, b, h) do { _Pragma("unroll") for (int n = 0; n < 2; ++n) _Pragma("unroll") for (int k = 0; k < 2; ++k) dst[n][k] = *(const PG8_LAS bf16x8*)(lds + PG8_SB(b, h) + boff + n * 2048 + k * 1024); } while (0)
#define PG8_MMA(ai, bj, At, Bt) do { __builtin_amdgcn_s_setprio(1); _Pragma("unroll") for (int m = 0; m < 4; ++m) _Pragma("unroll") for (int n = 0; n < 2; ++n) _Pragma("unroll") for (int k = 0; k < 2; ++k) \
        acc[ai][bj][m][n] = __builtin_amdgcn_mfma_f32_16x16x32_bf16(Bt[n][k], At[m][k], acc[ai][bj][m][n], 0, 0, 0); __builtin_amdgcn_s_setprio(0); } while (0)
#define PG8_WAIT_V(n) asm volatile("s_waitcnt vmcnt(" #n ")" ::: "memory")
#define PG8_WAIT_L(n) asm volatile("s_waitcnt lgkmcnt(" #n ")" ::: "memory")
#define PG8_BAR __builtin_amdgcn_s_barrier()
#define PG8_SCHED __builtin_amdgcn_sched_barrier(0)
    Unit cur, nxt; int ui = 0;
    if (!S.next(0, cur)) return;
    f32x4 acc[2][2][4][2];
#pragma unroll
    for (int a = 0; a < 2; ++a)
#pragma unroll
        for (int b = 0; b < 2; ++b)
#pragma unroll
            for (int m = 0; m < 4; ++m)
#pragma unroll
                for (int n = 0; n < 2; ++n) acc[a][b][m][n] = (f32x4){0.f, 0.f, 0.f, 0.f};
    bf16x8 At[4][2], B0[2][2], B1[2][2];
    const char* cA = (const char*)g.A + (size_t)cur.pm * tstep + (size_t)cur.kt0 * kstep; const char* cB = (const char*)g.Bt + (size_t)cur.pn * tstep + (size_t)cur.kt0 * kstep;
    S.a_ready(cur);
    if constexpr (SP2) {
        PG8_STAGE(PG8_SB(0, 0), cB, voffB); PG8_STAGE(PG8_SB(0, 1), cB + hstep, voffB); PG8_STAGE(PG8_SA(0, 0), cA, voffA); PG8_STAGE(PG8_SA(0, 1), cA + hstep, voffA);
        if (wr == 1) PG8_BAR;
        PG8_WAIT_V(2); PG8_BAR;
        PG8_STAGE(PG8_SB(1, 0), cB + kstep, voffB); PG8_STAGE(PG8_SA(1, 0), cA + kstep, voffA); PG8_STAGE(PG8_SB(1, 1), cB + hstep + kstep, voffB);
        PG8_WAIT_V(6); PG8_BAR;
    } else {
        PG8_STAGE(PG8_SB(0, 0), cB, voffB); PG8_STAGE(PG8_SA(0, 0), cA, voffA); PG8_STAGE(PG8_SB(0, 1), cB + hstep, voffB); PG8_STAGE(PG8_SA(0, 1), cA + hstep, voffA);
        if (wr == 1) PG8_BAR;
        PG8_WAIT_V(4); PG8_BAR;
        PG8_STAGE(PG8_SB(1, 0), cB + kstep, voffB); PG8_STAGE(PG8_SA(1, 0), cA + kstep, voffA); PG8_STAGE(PG8_SB(1, 1), cB + hstep + kstep, voffB);
        PG8_WAIT_V(6); PG8_BAR;
    }
    for (;;) {
        const bool has_next = S.next(ui + 1, nxt);
        const char* nA = has_next ? (const char*)g.A + (size_t)nxt.pm * tstep + (size_t)nxt.kt0 * kstep : cA; const char* nB = has_next ? (const char*)g.Bt + (size_t)nxt.pn * tstep + (size_t)nxt.kt0 * kstep : cB;
        const int nt = cur.nt;
        for (int t = 0; t < nt; t += 2) {
            const bool last = (t == nt - 2);
            const char* a1 = cA + (size_t)(t + 1) * kstep;
            const char* a2 = last ? nA : cA + (size_t)(t + 2) * kstep; const char* b2 = last ? nB : cB + (size_t)(t + 2) * kstep;
            const char* a3 = a2 + kstep; const char* b3 = b2 + kstep;
            if (last && has_next) S.a_ready(nxt);
            if constexpr (SP2) {
            PG8_LDB(B0, 0, 0); PG8_LDB(B1, 0, 1); PG8_SCHED; PG8_LDA(At, 0, 0); PG8_STAGE(PG8_SA(1, 1), a1 + hstep, voffA);
            PG8_WAIT_V(8); PG8_WAIT_L(0); PG8_BAR; PG8_MMA(0, 0, At, B0); PG8_MMA(0, 1, At, B1); PG8_BAR; PG8_SCHED;
            PG8_LDA(At, 0, 1); PG8_STAGE(PG8_SB(0, 0), b2, voffB); PG8_STAGE(PG8_SB(0, 1), b2 + hstep, voffB); PG8_STAGE(PG8_SA(0, 0), a2, voffA);
            PG8_WAIT_V(8); PG8_WAIT_L(0); PG8_BAR; PG8_MMA(1, 0, At, B0); PG8_MMA(1, 1, At, B1); PG8_BAR; PG8_SCHED;
            PG8_LDB(B0, 1, 0); PG8_LDB(B1, 1, 1); PG8_SCHED; PG8_LDA(At, 1, 0); PG8_STAGE(PG8_SA(0, 1), a2 + hstep, voffA);
            PG8_WAIT_V(8); PG8_WAIT_L(0); PG8_BAR; PG8_MMA(0, 0, At, B0); PG8_MMA(0, 1, At, B1); PG8_BAR; PG8_SCHED;
            PG8_LDA(At, 1, 1); PG8_STAGE(PG8_SB(1, 0), b3, voffB); PG8_STAGE(PG8_SB(1, 1), b3 + hstep, voffB); PG8_STAGE(PG8_SA(1, 0), a3, voffA);
            PG8_WAIT_V(8); PG8_WAIT_L(0); PG8_BAR; PG8_MMA(1, 0, At, B0); PG8_MMA(1, 1, At, B1); PG8_BAR; PG8_SCHED;
            } else {
            PG8_LDB(B0, 0, 0); PG8_SCHED; PG8_LDA(At, 0, 0); PG8_STAGE(PG8_SA(1, 1), a1 + hstep, voffA);
            PG8_WAIT_L(8); PG8_BAR; PG8_WAIT_L(0); PG8_MMA(0, 0, At, B0); PG8_BAR; PG8_SCHED;
            PG8_LDB(B1, 0, 1); PG8_STAGE(PG8_SB(0, 0), b2, voffB);
            PG8_BAR; PG8_WAIT_L(0); PG8_MMA(0, 1, At, B1); PG8_BAR;
            PG8_LDA(At, 0, 1); PG8_STAGE(PG8_SA(0, 0), a2, voffA);
            PG8_BAR; PG8_WAIT_L(0); PG8_MMA(1, 0, At, B0); PG8_BAR; PG8_SCHED;
            PG8_STAGE(PG8_SB(0, 1), b2 + hstep, voffB);
            PG8_WAIT_V(6); PG8_BAR; PG8_MMA(1, 1, At, B1); PG8_BAR;
            PG8_LDB(B0, 1, 0); PG8_SCHED; PG8_LDA(At, 1, 0); PG8_STAGE(PG8_SA(0, 1), a2 + hstep, voffA);
            PG8_WAIT_L(8); PG8_BAR; PG8_WAIT_L(0); PG8_MMA(0, 0, At, B0); PG8_BAR; PG8_SCHED;
            PG8_LDB(B1, 1, 1); PG8_STAGE(PG8_SB(1, 0), b3, voffB);
            PG8_BAR; PG8_WAIT_L(0); PG8_MMA(0, 1, At, B1); PG8_BAR;
            PG8_LDA(At, 1, 1); PG8_STAGE(PG8_SA(1, 0), a3, voffA);
            PG8_BAR; PG8_WAIT_L(0); PG8_MMA(1, 0, At, B0); PG8_BAR; PG8_SCHED;
            PG8_STAGE(PG8_SB(1, 1), b3 + hstep, voffB);
            PG8_WAIT_V(6); PG8_BAR; PG8_MMA(1, 1, At, B1); PG8_BAR;
            }
        }
        if constexpr (ALIGN_EPI) { if (wr == 0) PG8_BAR; }
        if constexpr (!Epi::AFTER_DRAIN) { E(acc, cur, wr, wc, fr, fq); S.done(cur); }
        if (!has_next) break;
#pragma unroll
        for (int a = 0; a < 2; ++a)
#pragma unroll
            for (int b = 0; b < 2; ++b)
#pragma unroll
                for (int m = 0; m < 4; ++m)
#pragma unroll
                    for (int n = 0; n < 2; ++n) acc[a][b][m][n] = (f32x4){0.f, 0.f, 0.f, 0.f};
        cur = nxt; cA = nA; cB = nB; ++ui;
        if constexpr (ALIGN_EPI) { if (wr == 1) PG8_BAR; }
    }
    PG8_WAIT_V(0);
    if constexpr (!ALIGN_EPI) { if (wr == 0) PG8_BAR; }
    PG8_BAR;
    if constexpr (Epi::AFTER_DRAIN) { E.fused(acc, cur, wr, wc, fr, fq, lds, wid, lane); S.done(cur); }
#undef PG8_SA
#undef PG8_SB
#undef PG8_STAGE
#undef PG8_LDA
#undef PG8_LDB
#undef PG8_MMA
#undef PG8_WAIT_V
#undef PG8_WAIT_L
#undef PG8_BAR
#undef PG8_SCHED
}
}

constexpr int NWAVES = 8;
#ifndef MK_ONE_LAUNCH
#define MK_ONE_LAUNCH 1
#endif
constexpr int DM = 1024, RP = 16384  , RS = 512  , R = RP + RS, T = 8192, NB = 2, SB = 128, ST = 4;
constexpr int NCOLA = 2816, RWKV_COLS = 2560, NH = 12, HD = 64, FF = 4096, NCOLB = 1536, NMEM = 256;
constexpr int NCHUNK = RP / 64  , NUNIT = NCHUNK * NH  ;
constexpr float C2Q = 0.125f * 1.4426950408889634f;
constexpr float LOG2E = 1.4426950408889634f;
enum { I_XP = 0, I_XS, I_SSHIFT, I_SWKV, I_CSK, I_CSV, I_CMK, I_CMV, I_MEMP, I_NMIX, I_NMLP, I_WOUT, I_WUP, I_WDN, I_MNORM, I_WMKV, I_MQN, I_MKN,
       I_WINA, I_MU, I_WW2, I_W0, I_WA2, I_A0, I_WG2, I_KK, I_KA, I_RK, I_LNW, I_LNB, I_WINB, I_QN, I_SINKS, I_KVN, I_WKV, I_KN, N_IN };
constexpr size_t O_Y = 0, O_PSHIFT = (size_t)R * DM, O_PWKV = O_PSHIFT + 2 * RWKV_COLS, O_PSK = O_PWKV + 2 * 12 * 4096, O_PSV = O_PSK + 2 * 128 * 256,
                 O_PMK = O_PSV + 2 * 128 * 256, O_PMV = O_PMK + 2 * 2 * 256 * 256, O_SSHIFT = O_PMV + 2 * 2 * 256 * 256, O_SWKV = O_SSHIFT + (size_t)SB * RWKV_COLS,
                 O_SSK = O_SWKV + (size_t)SB * 12 * 4096, O_SSV = O_SSK + (size_t)SB * 128 * 256, O_END = O_SSV + (size_t)SB * 128 * 256;
constexpr size_t al256(size_t x) { return (x + 255) & ~(size_t)255; }
constexpr size_t WS_CTL = 0, CTL_ZERO_BYTES = 1u << 15;
constexpr size_t WS_WA = 1u << 20;
constexpr size_t WS_WOUT = WS_WA + (size_t)NCOLA * DM * 2;
constexpr size_t WS_WUP = WS_WOUT + (size_t)2 * DM * DM * 2;
constexpr size_t WS_WDN = WS_WUP + (size_t)2 * FF * DM * 2;
constexpr size_t WS_WB = WS_WDN + (size_t)2 * FF * DM * 2;
constexpr size_t WS_WM = WS_WB + (size_t)NCOLB * DM * 2;
constexpr size_t WS_WW2 = WS_WM + (size_t)DM * DM * 2;
constexpr size_t WS_WA2 = WS_WW2 + (size_t)768 * 64 * 2;
constexpr size_t WS_WG2 = WS_WA2 + (size_t)768 * 64 * 2;
constexpr size_t WS_ROPE = WS_WG2 + (size_t)768 * 128 * 2;
constexpr size_t WS_SSQ = al256(WS_ROPE + (size_t)8196 * 64 * 4);
constexpr size_t WS_SSQM = WS_SSQ + (size_t)R * 16 * 4;
constexpr size_t WS_MB = WS_SSQM + (size_t)512 * 16 * 4;
constexpr size_t WS_MK = WS_MB + (size_t)512 * DM * 2;
constexpr size_t WS_MVT = WS_MK + (size_t)2 * 2 * 4 * 256 * 64 * 2;
constexpr size_t WS_HB = WS_MVT + (size_t)2 * 2 * 4 * 256 * 64 * 2;
constexpr size_t WS_MIX = WS_HB + (size_t)R * DM * 2;
constexpr size_t WS_BIG = WS_MIX + (size_t)R * DM * 2;
constexpr size_t WS_PROJ = WS_BIG;
constexpr size_t WS_REC = WS_PROJ + (size_t)R * NCOLA * 2;
constexpr size_t REC_BYTES = 5 * 8192;
constexpr size_t WS_END0 = WS_REC + (size_t)NUNIT * REC_BYTES;
constexpr size_t WS_H = WS_BIG;
constexpr size_t WS_END1 = WS_H + (size_t)R * FF * 2;
constexpr size_t WS_SLAB = WS_BIG + ((size_t)160 << 20);
constexpr int S_K1 = 4, S_K4 = 16;
constexpr size_t WS_Q1 = WS_BIG;
constexpr size_t WS_K1 = WS_Q1 + (size_t)R * DM * 2;
constexpr size_t WS_V1 = WS_K1 + (size_t)R * 256 * 2;
constexpr size_t WS_VT1 = WS_V1 + (size_t)R * 256 * 2;
constexpr size_t WS_END = WS_END0 > WS_END1 ? WS_END0 : WS_END1;
static_assert(WS_VT1 + (size_t)2 * 4 * 64 * 8192 * 2 <= WS_END && WS_END1 <= WS_SLAB && WS_SLAB + ((size_t)32 << 20) <= WS_END, "ws map");
constexpr int CW_BAR = 4096;
constexpr int RING_OFF = 0, RING_BYTES = 131072, PREP_HALF = 73728, LDSCTL_OFF = 147456, MISC_OFF = LDSCTL_OFF + 320, WTOT_OFF = LDSCTL_OFF + 1024, LDS_BYTES = LDSCTL_OFF + 4096;

#define GAS __attribute__((address_space(1)))
#define LAS __attribute__((address_space(3)))
typedef unsigned short bf16;
typedef unsigned v4u __attribute__((ext_vector_type(4)));
typedef unsigned v2u __attribute__((ext_vector_type(2)));
typedef float f32x4 __attribute__((ext_vector_type(4)));
typedef float f32x16 __attribute__((ext_vector_type(16)));
typedef short bf16x8 __attribute__((ext_vector_type(8)));
typedef short bf16x4 __attribute__((ext_vector_type(4)));
typedef GAS unsigned gu32;
#define RLX_AGENT __ATOMIC_RELAXED, __HIP_MEMORY_SCOPE_AGENT
#define LDS_WAIT() asm volatile("s_waitcnt lgkmcnt(0)" ::: "memory")
#define VM_WAIT() asm volatile("s_waitcnt vmcnt(0)" ::: "memory")
using pg8::cvt_pk_bf16;
__device__ __forceinline__ int mk_lane() { int l; asm volatile("v_mbcnt_lo_u32_b32 %0, -1, 0\n\tv_mbcnt_hi_u32_b32 %0, -1, %0" : "=v"(l)); return l; }
__device__ __forceinline__ float bf2f(unsigned v) { return __uint_as_float(v << 16); }
__device__ __forceinline__ float bflo(unsigned w) { return __uint_as_float(w << 16); }
__device__ __forceinline__ float bfhi(unsigned w) { return __uint_as_float(w & 0xffff0000u); }
__device__ __forceinline__ bf16 f2bf(float f) { return (bf16)(cvt_pk_bf16(f, 0.f) & 0xffffu); }
__device__ __forceinline__ v2u pack4(f32x4 v) { v2u w; w.x = cvt_pk_bf16(v[0], v[1]); w.y = cvt_pk_bf16(v[2], v[3]); return w; }
__device__ __forceinline__ f32x4 unpack4(v2u w) { return (f32x4){bflo(w.x), bfhi(w.x), bflo(w.y), bfhi(w.y)}; }
__device__ __forceinline__ f32x4 mfma16(bf16x8 a, bf16x8 b, f32x4 c) { return __builtin_amdgcn_mfma_f32_16x16x32_bf16(a, b, c, 0, 0, 0); }
__device__ __forceinline__ f32x16 mfma32(bf16x8 a, bf16x8 b, f32x16 c) { return __builtin_amdgcn_mfma_f32_32x32x16_bf16(a, b, c, 0, 0, 0); }
using pg8::swz_xor; using pg8::add_x32; using pg8::max_x32; using pg8::add_x16; using pg8::sum16_dpp; using pg8::max16_dpp; using pg8::sum4_dpp;
__device__ __forceinline__ float sum16(float v) { return sum16_dpp(v); }
__device__ __forceinline__ float wave_sum(float v) { v = sum16_dpp(v); v = add_x16(v); return add_x32(v); }
__device__ __forceinline__ float wave_max(float v) { v = max16_dpp(v); v = fmaxf(v, swz_xor<16>(v)); return max_x32(v); }
__device__ __forceinline__ float fsigmoid(float x) { return __builtin_amdgcn_rcpf(1.0f + __expf(-x)); }
__device__ __forceinline__ float ftanh(float x) { const float e = __expf(2.0f * x); return 1.0f - 2.0f * __builtin_amdgcn_rcpf(e + 1.0f); }
namespace pg8 {
__device__ __forceinline__ void head_norm(f32x4 (&x)[2][2], const float* gain, int fq) {
    float ss = 0.f;
#pragma unroll
    for (int bj = 0; bj < 2; ++bj)
#pragma unroll
        for (int n = 0; n < 2; ++n) ss += hsum4(x[bj][n] * x[bj][n]);
    ss = add_x16(ss); ss = add_x32(ss);
    const float rs = rsqrtf(ss * (1.0f / 64.0f) + 1e-6f);
#pragma unroll
    for (int bj = 0; bj < 2; ++bj)
#pragma unroll
        for (int n = 0; n < 2; ++n) { const f32x4 g = *(const f32x4*)(gain + 32 * bj + 8 * fq + 4 * n); x[bj][n] = x[bj][n] * rs * g; }
}
__device__ __forceinline__ void head_rope(f32x4 (&x)[2][2], const float* cs  , int fq) {
#pragma unroll
    for (int n = 0; n < 2; ++n) { const f32x4 t0 = *(const f32x4*)(cs + 2 * (8 * fq + 4 * n)), t1 = *(const f32x4*)(cs + 2 * (8 * fq + 4 * n) + 4);
        const f32x4 cc = {t0[0], t0[2], t1[0], t1[2]}, sn = {t0[1], t0[3], t1[1], t1[3]};
        const f32x4 x1 = x[0][n], x2 = x[1][n]; x[0][n] = x1 * cc - x2 * sn; x[1][n] = x2 * cc + x1 * sn; }
}
struct EpiL1 {
    static constexpr bool PERM = true, AFTER_DRAIN = false;
    unsigned char* ws; float* outp; const float* g_q; const float* g_mq; const float* g_k;
    __device__ __forceinline__ void operator()(const f32x4 (&acc)[2][2][4][2], const Unit& u, int wr, int wc, int fr_, int fq_) const {
        int fr = fr_, fq = fq_; asm volatile("" : "+v"(fr), "+v"(fq));
        const float* ssq = (const float*)(ws + WS_SSQ); const float* rope = (const float*)(ws + WS_ROPE); const float c2 = C2Q;
        bf16_t* Q1 = (bf16_t*)(ws + WS_Q1); bf16_t* K1 = (bf16_t*)(ws + WS_K1); bf16_t* V1 = (bf16_t*)(ws + WS_V1);
        float* p_k = outp + O_PSK; float* p_v = outp + O_PSV; float* s_k = outp + O_SSK; float* s_v = outp + O_SSV;
        const int H = u.pn * 4 + wc, row0 = u.pm * BM + wr * 64 + fr;
#pragma unroll
        for (int ai = 0; ai < 2; ++ai)
#pragma unroll
            for (int m = 0; m < 4; ++m) { const int row = row0 + ai * HALF + m * 16; const float rs = row_rstd(ssq, row);
                const int pidx = row < 16384 ? (row & 8191) : 8192 + ((row - 16384) & 3);
                f32x4 x[2][2];
#pragma unroll
                for (int bj = 0; bj < 2; ++bj)
#pragma unroll
                    for (int n = 0; n < 2; ++n) x[bj][n] = acc[ai][bj][m][n] * rs;
                if (H < 16) {
                    head_norm(x, H < 12 ? g_q : g_mq, fq);
                    if (H < 12) head_rope(x, rope + (size_t)pidx * 64, fq);
#pragma unroll
                    for (int bj = 0; bj < 2; ++bj) *(u32x4*)(Q1 + (size_t)row * 1024 + H * 64 + 32 * bj + 8 * fq) = pack8(x[bj][0] * c2, x[bj][1] * c2);
                } else {
                    const int kh = (H - 16) & 3; const bool isk = H < 20;
                    if (isk) { head_norm(x, g_k, fq); head_rope(x, rope + (size_t)pidx * 64, fq); }
                    bf16_t* dst = isk ? K1 : V1;
#pragma unroll
                    for (int bj = 0; bj < 2; ++bj) *(u32x4*)(dst + (size_t)row * 256 + kh * 64 + 32 * bj + 8 * fq) = pack8(x[bj][0], x[bj][1]);
                    float* o = nullptr;
                    if (row < 16384) { const int b = row >> 13, t = row & 8191; if (t >= 8064) o = (isk ? p_k : p_v) + ((size_t)(b * 128 + (t - 8064)) * 4 + kh) * 64; }
                    else { const int b = (row - 16384) >> 2, i = (row - 16384) & 3; o = (isk ? s_k : s_v) + ((size_t)(b * 128 + 124 + i) * 4 + kh) * 64; }
                    if (o) {
#pragma unroll
                        for (int bj = 0; bj < 2; ++bj) { *(f32x4*)(o + 32 * bj + 8 * fq) = x[bj][0]; *(f32x4*)(o + 32 * bj + 8 * fq + 4) = x[bj][1]; } }
                }
                if (m == 3) asm volatile("" ::: "memory");
            }
    }
};
struct EpiMemKV {
    static constexpr bool PERM = true, AFTER_DRAIN = false;
    unsigned char* ws; float* outp; const float* g_k  ;
    __device__ __forceinline__ void operator()(const f32x4 (&acc)[2][2][4][2], const Unit& u, int wr, int wc, int fr_, int fq_) const {
        int fr = fr_, fq = fq_; asm volatile("" : "+v"(fr), "+v"(fq));
        const float* ssq = (const float*)(ws + WS_SSQM); float* p_k = outp + O_PMK; float* p_v = outp + O_PMV; bf16_t* MK = (bf16_t*)(ws + WS_MK)  ; bf16_t* MVT = (bf16_t*)(ws + WS_MVT)  ;
        const int H = u.pn * 4 + wc, l = H >> 3, isv = (H >> 2) & 1, hh = H & 3, row0 = u.pm * BM + wr * 64 + fr;
#pragma unroll
        for (int ai = 0; ai < 2; ++ai)
#pragma unroll
            for (int m = 0; m < 4; ++m) { const int row = row0 + ai * HALF + m * 16; const float rs = row_rstd(ssq, row); const int b = row >> 8, mm = row & 255;
                f32x4 x[2][2];
#pragma unroll
                for (int bj = 0; bj < 2; ++bj)
#pragma unroll
                    for (int n = 0; n < 2; ++n) x[bj][n] = acc[ai][bj][m][n] * rs;
                if (!isv) head_norm(x, g_k + l * 64, fq);
                float* o = (isv ? p_v : p_k) + ((((size_t)l * 2 + b) * 256 + mm) * 4 + hh) * 64;
#pragma unroll
                for (int bj = 0; bj < 2; ++bj) { *(f32x4*)(o + 32 * bj + 8 * fq) = x[bj][0]; *(f32x4*)(o + 32 * bj + 8 * fq + 4) = x[bj][1]; }
                if (!isv) {
#pragma unroll
                    for (int bj = 0; bj < 2; ++bj) *(u32x4*)(MK + ((((size_t)l * 2 + b) * 4 + hh) * 256 + mm) * 64 + 32 * bj + 8 * fq) = pack8(x[bj][0], x[bj][1]);
                } else {
#pragma unroll
                    for (int bj = 0; bj < 2; ++bj)
#pragma unroll
                        for (int n = 0; n < 2; ++n)
#pragma unroll
                            for (int e = 0; e < 4; ++e) { const int d = 32 * bj + 8 * fq + 4 * n + e; MVT[((((size_t)l * 2 + b) * 4 + hh) * 64 + d) * 256 + mm] = (bf16_t)(cvt_pk_bf16(x[bj][n][e], 0.f) & 0xffffu); }
                }
                asm volatile("" ::: "memory");
            }
    }
};
}
#define XB_TMO      128
#define XB_XCNT(j)  (256  + 64 * (j))
#define XB_XSUB(j)  (1280 + 64 * (j))
#define XB_XGEN(j)  (2304 + 64 * (j))
#define XB_TOP      3328
#define XB_TOPGEN   3392
#define XCD_BAR_WORDS 3456
#define XB_SPIN_CAP (1u << 18)

__device__ __forceinline__ unsigned xb_ld(unsigned* p)              { return __hip_atomic_load(p, __ATOMIC_RELAXED, __HIP_MEMORY_SCOPE_AGENT); }
__device__ __forceinline__ unsigned xb_add(unsigned* p, unsigned v) { return __hip_atomic_fetch_add(p, v, __ATOMIC_RELAXED, __HIP_MEMORY_SCOPE_AGENT); }
__device__ __forceinline__ unsigned xb_xcc_id() { return (unsigned)__builtin_amdgcn_s_getreg((3 << 11) | 20) & 0xFu; }
#define XB_SPIN(cond, bar) do { unsigned _sp = 0; while (cond) { __builtin_amdgcn_s_sleep(1); \
    if ((++_sp & 255u) == 0u) { if (xb_ld(&(bar)[XB_TMO])) break; if (_sp > XB_SPIN_CAP) { atomicAdd(&(bar)[XB_TMO], 1u); break; } } } } while (0)

struct XcdBarrier {
    bool wave0;
    unsigned* bar; unsigned x;
    volatile LAS unsigned* st;
};

__device__ __forceinline__ XcdBarrier xcd_barrier_post(unsigned* bar, volatile LAS unsigned* st, bool wave0) {
    XcdBarrier b; b.wave0 = wave0; b.bar = bar; b.x = xb_xcc_id(); b.st = st;
    if (wave0 && mk_lane() == 0) (void)xb_add(&bar[XB_XCNT(b.x)], 1u);
    return b;
}
__device__ __forceinline__ void xcd_barrier_complete(unsigned* bar, unsigned x, unsigned& nloc, unsigned& nx) {
    const unsigned G = gridDim.x * gridDim.y * gridDim.z;
    unsigned sum, cnt, mine, sp = 0u;
    for (;;) {
        sum = 0u; cnt = 0u; mine = 0u;
#pragma unroll
        for (unsigned j = 0; j < 16; ++j) { const unsigned c = xb_ld(&bar[XB_XCNT(j)]); sum += c; cnt += (c > 0u) ? 1u : 0u; mine = (j == x) ? c : mine; }
        if (sum == G) break;
        __builtin_amdgcn_s_sleep(1);
        if ((++sp & 255u) == 0u) { if (xb_ld(&bar[XB_TMO])) break; if (sp > XB_SPIN_CAP) { atomicAdd(&bar[XB_TMO], 1u); break; } }
    }
    nloc = mine > 0u ? mine : 1u; nx = cnt > 0u ? cnt : 1u;
}

__device__ __forceinline__ void xcd_barrier(const XcdBarrier& b) {
    asm volatile("s_waitcnt vmcnt(0)" ::: "memory");
    __syncthreads();
    if (b.wave0 && mk_lane() == 0) {
        unsigned* bar = b.bar;
        __builtin_amdgcn_s_waitcnt(0);
        unsigned nloc = b.st[0], nx = b.st[1];
        if (nloc == 0u) { xcd_barrier_complete(bar, b.x, nloc, nx); b.st[0] = nloc; b.st[1] = nx; }
        const unsigned old = xb_add(&bar[XB_XSUB(b.x)], 1u);
        const unsigned gen = old / nloc;
        if (old + 1u == (gen + 1u) * nloc) {
            __builtin_amdgcn_fence(__ATOMIC_RELEASE, "agent");
            asm volatile("s_waitcnt vmcnt(0)" ::: "memory");
            const unsigned og = xb_add(&bar[XB_TOP], 1u);
            const unsigned tg = og / nx;
            if (og + 1u == (tg + 1u) * nx) xb_add(&bar[XB_TOPGEN], 1u);
            else XB_SPIN(xb_ld(&bar[XB_TOPGEN]) == tg, bar);
            __builtin_amdgcn_fence(__ATOMIC_ACQUIRE, "agent");
            xb_add(&bar[XB_XGEN(b.x)], 1u);
            asm volatile("s_waitcnt vmcnt(0)" ::: "memory");
        } else {
            XB_SPIN(xb_ld(&bar[XB_XGEN(b.x)]) == gen, bar);
            __builtin_amdgcn_fence(__ATOMIC_ACQUIRE, "agent");
            asm volatile("s_waitcnt vmcnt(0)" ::: "memory");
        }
    }
    __syncthreads();
}

struct Args { const float* in[N_IN]; float* out; unsigned char* ws; int ph_lo, ph_hi; };
struct Frame {
    LAS unsigned char* lds; unsigned char* lds_g;
    gu32* ctl;
    int tid, lane, wave, vcu, G;
    const float* const* in; float* out; unsigned char* ws;
};
__host__ __device__ __forceinline__ int wsig_inv(int nl) { return 128 * ((nl >> 5) & 1) + 32 * (nl >> 6) + (nl & 31); }

__device__ __forceinline__ void p0_transpose_item(const float* W, int K, int N, bf16* WT, int row_off, bool sig, const float* gain, LAS float* scr, int item, int lane) {
    const int nblk = N / 32, kb = item / nblk, nb = item % nblk, k0 = 64 * kb, n0 = 32 * nb;
    float tv[32];
#pragma unroll
    for (int i = 0; i < 32; ++i) { const int kk = 2 * i + (lane >> 5); tv[i] = W[(size_t)(k0 + kk) * N + n0 + (lane & 31)]; }
    __builtin_amdgcn_sched_barrier(0);
    if (gain) {
#pragma unroll
        for (int i = 0; i < 32; ++i) tv[i] *= gain[k0 + 2 * i + (lane >> 5)]; }
#pragma unroll
    for (int i = 0; i < 32; ++i) scr[(2 * i + (lane >> 5)) * 33 + (lane & 31)] = tv[i];
    LDS_WAIT(); asm volatile("" ::: "memory");
    const int c = lane & 7;
    int nbase = row_off + n0; if (sig) { const int ng = row_off + n0; nbase = (ng & ~255) + wsig_inv(ng & 255); }
#pragma unroll
    for (int j = 0; j < 4; ++j) { const int n = (lane >> 3) + 8 * j; const LAS float* s = scr + (8 * c) * 33 + n;
        v4u o; o.x = cvt_pk_bf16(s[0 * 33], s[1 * 33]); o.y = cvt_pk_bf16(s[2 * 33], s[3 * 33]); o.z = cvt_pk_bf16(s[4 * 33], s[5 * 33]); o.w = cvt_pk_bf16(s[6 * 33], s[7 * 33]);
        *(GAS v4u*)(WT + (size_t)(nbase + n) * K + k0 + 8 * c) = o; }
    LDS_WAIT(); asm volatile("" ::: "memory");
}
__device__ __forceinline__ void row_to_bf16_ssq(const float* xrow, bf16* orow, float* ssqrow, int lane) {
    const GAS f32x4* xr = (const GAS f32x4*)xrow + lane;
    f32x4 v[4]; float s = 0.f;
#pragma unroll
    for (int j = 0; j < 4; ++j) { v[j] = xr[64 * j]; s += (v[j].x * v[j].x + v[j].y * v[j].y) + (v[j].z * v[j].z + v[j].w * v[j].w); }
    s = wave_sum(s);
    GAS v2u* o8 = (GAS v2u*)orow + lane;
#pragma unroll
    for (int j = 0; j < 4; ++j) o8[64 * j] = pack4(v[j]);
    if (lane < 16) ssqrow[lane] = lane == 0 ? s : 0.f;
}
__device__ __forceinline__ void p0_weights(Frame& F, int part, int gw, int NGW, LAS float* scr) {
    unsigned char* ws = F.ws;
    int it = gw;
#define P0_JOB(Wp, K_, N_, WTp, roff, sg, gn) { const int ni = ((K_) / 64) * ((N_) / 32); for (; it < ni; it += NGW) p0_transpose_item((Wp), (K_), (N_), (WTp), (roff), (sg), (gn), scr, it, F.lane); it -= ni; }
    if (part == 0) {
    P0_JOB(F.in[I_WINA], DM, NCOLA, (bf16*)(ws + WS_WA), 0, false, F.in[I_NMIX]);
    P0_JOB(F.in[I_WMKV], DM, 512, (bf16*)(ws + WS_WM), 0, true, F.in[I_MNORM]);
    P0_JOB(F.in[I_WMKV] + (size_t)DM * 512, DM, 512, (bf16*)(ws + WS_WM), 512, true, F.in[I_MNORM] + DM);
    P0_JOB(F.in[I_WW2], 64, 768, (bf16*)(ws + WS_WW2), 0, false, nullptr);
    P0_JOB(F.in[I_WA2], 64, 768, (bf16*)(ws + WS_WA2), 0, false, nullptr);
    P0_JOB(F.in[I_WG2], 128, 768, (bf16*)(ws + WS_WG2), 0, false, nullptr);
    } else {
    P0_JOB(F.in[I_WOUT], DM, DM, (bf16*)(ws + WS_WOUT), 0, false, nullptr);
    P0_JOB(F.in[I_WUP], DM, FF, (bf16*)(ws + WS_WUP), 0, false, F.in[I_NMLP]);
    P0_JOB(F.in[I_WDN], FF, DM, (bf16*)(ws + WS_WDN), 0, false, nullptr);
    P0_JOB(F.in[I_WINB], DM, DM, (bf16*)(ws + WS_WB), 0, true, F.in[I_NMIX] + DM);
    P0_JOB(F.in[I_WKV], DM, 512, (bf16*)(ws + WS_WB), 1024, true, F.in[I_KVN]);
    P0_JOB(F.in[I_WOUT] + (size_t)DM * DM, DM, DM, (bf16*)(ws + WS_WOUT) + (size_t)DM * DM, 0, false, nullptr);
    P0_JOB(F.in[I_WUP] + (size_t)DM * FF, DM, FF, (bf16*)(ws + WS_WUP) + (size_t)DM * FF, 0, false, F.in[I_NMLP] + DM);
    P0_JOB(F.in[I_WDN] + (size_t)DM * FF, FF, DM, (bf16*)(ws + WS_WDN) + (size_t)DM * FF, 0, false, nullptr);
    }
#undef P0_JOB
}
__device__ __forceinline__ void p0_prologue(Frame& F) {
    LAS float* scr = (LAS float*)(F.lds + RING_OFF + F.wave * 16384);
    const int gw = F.vcu * NWAVES + F.wave, NGW = F.G * NWAVES;
    unsigned char* ws = F.ws;
    p0_weights(F, 0, gw, NGW, scr);
    for (int m = gw; m < R; m += NGW) { const float* xr = m < RP ? F.in[I_XP] + (size_t)m * DM : F.in[I_XS] + (size_t)(m - RP) * DM;
        row_to_bf16_ssq(xr, (bf16*)(ws + WS_HB) + (size_t)m * DM, (float*)(ws + WS_SSQ) + (size_t)m * 16, F.lane); }
    for (int m = gw; m < 512; m += NGW) row_to_bf16_ssq(F.in[I_MEMP] + (size_t)m * DM, (bf16*)(ws + WS_MB) + (size_t)m * DM, (float*)(ws + WS_SSQM) + (size_t)m * 16, F.lane);
    { const int gt = F.vcu * NWAVES * 64 + F.tid, NGT = F.G * NWAVES * 64; float* rt = (float*)(ws + WS_ROPE);
      for (int i = gt; i < 8196 * 32; i += NGT) { const int p = i >> 5, f = i & 31; const float pos = (float)(p < 8192 ? p : 16384 + (p - 8192));
          double fq_ = 1.0; for (int k = 0; k < f; ++k) fq_ *= 0.74989420933245582730; const float ang = pos * (float)fq_; const double rev = (double)ang * 0.15915494309189535; const float fr = (float)(rev - floor(rev));
          rt[2 * i] = __builtin_amdgcn_cosf(fr); rt[2 * i + 1] = __builtin_amdgcn_sinf(fr); } }
}

__device__ __forceinline__ void finalize_sample(Frame& F, const float* fbase  , int S, bool last) {
    const int gw = F.vcu * NWAVES + F.wave, NGW = F.G * NWAVES; const float* slab = (const float*)(F.ws + WS_SLAB);
    for (int rs = gw; rs < RS; rs += NGW) { const int row = RP + rs, tile0 = (rs >> 8) << 2, r = rs & 255; float ss = 0.f;
#pragma unroll
        for (int pn = 0; pn < 4; ++pn) { f32x4 h;
            if (fbase) h = *(const GAS f32x4*)(fbase + (size_t)rs * DM + pn * 256 + 4 * F.lane);
            else h = unpack4(*(const GAS v2u*)((const bf16*)(F.ws + WS_HB) + (size_t)row * DM + pn * 256 + 4 * F.lane));
            for (int s0 = 0; s0 < S; s0 += 4) { f32x4 pv[4];
#pragma unroll
                for (int s = 0; s < 4; ++s) pv[s] = *(const GAS f32x4*)(slab + ((size_t)((tile0 + pn) * S + s0 + s) << 16) + r * 256 + 4 * F.lane);
                __builtin_amdgcn_sched_barrier(0);
                h += (pv[0] + pv[1]) + (pv[2] + pv[3]); }
            if (last) *(GAS f32x4*)(F.out + O_Y + (size_t)row * DM + pn * 256 + 4 * F.lane) = h;
            else *(GAS v2u*)((bf16*)(F.ws + WS_HB) + (size_t)row * DM + pn * 256 + 4 * F.lane) = pack4(h);
            ss += (h[0] * h[0] + h[1] * h[1]) + (h[2] * h[2] + h[3] * h[3]); }
        if (!last) { ss = wave_sum(ss); if (F.lane < 16) ((float*)(F.ws + WS_SSQ))[(size_t)row * 16 + F.lane] = F.lane == 0 ? ss : 0.f; } }
}

__device__ __forceinline__ void copy_window_cache(Frame& F, int gt, int NGT) {
    const int per = 124 * 256 / 4;
    for (int i = gt; i < SB * per; i += NGT) { const int b = i / per, r = i % per;
        ((GAS f32x4*)(F.out + O_SSK + (size_t)b * 128 * 256))[r] = ((const GAS f32x4*)(F.in[I_CSK] + (size_t)b * 128 * 256 + 4 * 256))[r];
        ((GAS f32x4*)(F.out + O_SSV + (size_t)b * 128 * 256))[r] = ((const GAS f32x4*)(F.in[I_CSV] + (size_t)b * 128 * 256 + 4 * 256))[r]; }
}

constexpr int LSTR = 144, SLOT = 64 * LSTR;
__device__ __forceinline__ int rec_index(int chunk, int h) { return ((chunk >> 7) * NH + h) * 128 + (chunk & 127); }
constexpr int REC_PT = 0, REC_QS = 8192, REC_RY = 16384, REC_YL = 24576, REC_BV = 32768;
__device__ __forceinline__ bf16x8 lfrag(const LAS unsigned char* m, int row, int k) { return *(const LAS bf16x8*)(m + row * LSTR + k * 2); }
__device__ __forceinline__ void mm_strip(f32x4 (&acc)[4], const LAS unsigned char* X, const LAS unsigned char* Y, int w, int c, int g) {
#pragma unroll
    for (int ks = 0; ks < 2; ++ks) { const bf16x8 a = lfrag(X, 16 * w + c, 32 * ks + 8 * g);
#pragma unroll
        for (int n = 0; n < 4; ++n) acc[n] = mfma16(a, lfrag(Y, 16 * n + c, 32 * ks + 8 * g), acc[n]); }
}
__device__ __forceinline__ void mm_strip2(f32x4 (&acc0)[4], f32x4 (&acc1)[4], const LAS unsigned char* X, const LAS unsigned char* Y0, const LAS unsigned char* Y1, int w, int c, int g) {
#pragma unroll
    for (int ks = 0; ks < 2; ++ks) { const bf16x8 a = lfrag(X, 16 * w + c, 32 * ks + 8 * g);
#pragma unroll
        for (int n = 0; n < 4; ++n) { acc0[n] = mfma16(a, lfrag(Y0, 16 * n + c, 32 * ks + 8 * g), acc0[n]); acc1[n] = mfma16(a, lfrag(Y1, 16 * n + c, 32 * ks + 8 * g), acc1[n]); } }
}
__device__ __forceinline__ void zero4(f32x4 (&a)[4]) {
#pragma unroll
    for (int n = 0; n < 4; ++n) a[n] = (f32x4){0.f, 0.f, 0.f, 0.f};
}
__device__ __forceinline__ void st_T(LAS unsigned char* dest, const f32x4 (&acc)[4], int w, int c, int g) {
#pragma unroll
    for (int n = 0; n < 4; ++n) *(LAS v2u*)(dest + (16 * n + c) * LSTR + (16 * w + 4 * g) * 2) = pack4(acc[n]);
}
__device__ __forceinline__ void st_T_global(unsigned char* dest  , const f32x4 (&acc)[4], int w, int c, int g) {
#pragma unroll
    for (int n = 0; n < 4; ++n) *(GAS v2u*)(dest + (16 * n + c) * 128 + (16 * w + 4 * g) * 2) = pack4(acc[n]);
}
__device__ __forceinline__ void load_shift8(const bf16* cur, const bf16* prv, const float* mu, float (&o)[8]) {
    const v4u cw = *(const GAS v4u*)cur; v4u pw = {0u, 0u, 0u, 0u}; if (prv) pw = *(const GAS v4u*)prv;
    const f32x4 m0 = *(const GAS f32x4*)mu, m1 = *(const GAS f32x4*)(mu + 4);
    const float cf[8] = {bflo(cw.x), bfhi(cw.x), bflo(cw.y), bfhi(cw.y), bflo(cw.z), bfhi(cw.z), bflo(cw.w), bfhi(cw.w)};
    const float pf[8] = {bflo(pw.x), bfhi(pw.x), bflo(pw.y), bfhi(pw.y), bflo(pw.z), bfhi(pw.z), bflo(pw.w), bfhi(pw.w)};
    const float mf[8] = {m0[0], m0[1], m0[2], m0[3], m1[0], m1[1], m1[2], m1[3]};
#pragma unroll
    for (int i = 0; i < 8; ++i) o[i] = cf[i] + (pf[i] - cf[i]) * mf[i];
}
__device__ __forceinline__ bf16x8 pack_frag(const float (&v)[8]) {
    v4u w; w.x = cvt_pk_bf16(v[0], v[1]); w.y = cvt_pk_bf16(v[2], v[3]); w.z = cvt_pk_bf16(v[4], v[5]); w.w = cvt_pk_bf16(v[6], v[7]); return __builtin_bit_cast(bf16x8, w);
}

struct PrepPf { v4u raw[3][2]; v4u prv; };
__device__ __forceinline__ void prep_issue(Frame& F, int unit, PrepPf& pf) {
    const int th = (F.wave & 3) * 64 + F.lane; const int chunk = unit / NH, h = unit % NH, row0 = chunk * 64; const bool first = (chunk & 127) == 0;
    const bf16* proj = (const bf16*)(F.ws + WS_PROJ);
#pragma unroll
    for (int a = 0; a < 3; ++a)
#pragma unroll
        for (int i = 0; i < 2; ++i) { const int id = th + 256 * i; pf.raw[a][i] = *(const GAS v4u*)(proj + (size_t)(row0 + (id >> 3)) * NCOLA + a * 768 + h * 64 + (id & 7) * 8); }
    pf.prv = (v4u){0u, 0u, 0u, 0u};
    if (th < 24 && !first) pf.prv = *(const GAS v4u*)(proj + (size_t)(row0 - 1) * NCOLA + (th >> 3) * 768 + h * 64 + (th & 7) * 8);
}
__device__ __forceinline__ void shift8(v4u cw, v4u pw, const float* mu, float (&o)[8]) {
    const f32x4 m0 = *(const GAS f32x4*)mu, m1 = *(const GAS f32x4*)(mu + 4);
    const float cf[8] = {bflo(cw.x), bfhi(cw.x), bflo(cw.y), bfhi(cw.y), bflo(cw.z), bfhi(cw.z), bflo(cw.w), bfhi(cw.w)};
    const float pf_[8] = {bflo(pw.x), bfhi(pw.x), bflo(pw.y), bfhi(pw.y), bflo(pw.z), bfhi(pw.z), bflo(pw.w), bfhi(pw.w)};
    const float mf[8] = {m0[0], m0[1], m0[2], m0[3], m1[0], m1[1], m1[2], m1[3]};
#pragma unroll
    for (int i = 0; i < 8; ++i) o[i] = cf[i] + (pf_[i] - cf[i]) * mf[i];
}
#ifndef MK_TIME
#define MK_TIME -1
#endif
#define STAMP3(k) do { if (MK_TIME >= 0 && unit == 0 && w_ == 0 && lane_ == 0) ((volatile LAS unsigned long long*)(F.lds + LDSCTL_OFF + 512))[(k)] = __builtin_amdgcn_s_memrealtime(); } while (0)
#define HBAR() do { asm volatile("s_waitcnt lgkmcnt(0)" ::: "memory"); __builtin_amdgcn_s_barrier(); asm volatile("" ::: "memory"); } while (0)
__device__ __forceinline__ void rwkv_prep_unit(Frame& F, int unit, LAS unsigned char* hb, LAS float* wtot, LAS unsigned char* prow, PrepPf& pf, bool has_next, int next_unit, int stage_limit = 99) {
    int w_ = F.wave & 3, lane_ = F.lane; asm volatile("" : "+s"(w_), "+v"(lane_));
    const int w = w_, lane = lane_, g = lane >> 4, c = lane & 15;
    STAMP3(17);
    const int chunk = unit / NH, h = unit % NH, row0 = chunk * 64; const bool first = (chunk & 127) == 0;
    const bf16* proj = (const bf16*)(F.ws + WS_PROJ);
    unsigned char* rec = F.ws + WS_REC + (size_t)rec_index(chunk, h) * REC_BYTES;
    LAS unsigned char* const s0 = hb, * const s1 = hb + SLOT, * const s2 = hb + 2 * SLOT, * const s3 = hb + 3 * SLOT, * const s4 = hb + 4 * SLOT, * const s5 = hb + 5 * SLOT, * const s6 = hb + 6 * SLOT, * const s7 = hb + 7 * SLOT;
    float mur[4], muk[4], muv[4], w0[4], a0[4], kkc[4], kac[4], rkc[4];
#pragma unroll
    for (int n = 0; n < 4; ++n) { const int col = h * 64 + 16 * n + c; mur[n] = F.in[I_MU][col]; muk[n] = F.in[I_MU][768 + col]; muv[n] = F.in[I_MU][1536 + col];
        w0[n] = F.in[I_W0][col]; a0[n] = F.in[I_A0][col]; kkc[n] = F.in[I_KK][col]; kac[n] = F.in[I_KA][col]; rkc[n] = F.in[I_RK][col]; }
    f32x4 dw[4], da[4]; zero4(dw); zero4(da);
    { const int th = w * 64 + lane;
#pragma unroll
      for (int a = 0; a < 3; ++a)
#pragma unroll
          for (int i = 0; i < 2; ++i) { const int id = th + 256 * i; *(LAS v4u*)(hb + a * SLOT + (id >> 3) * LSTR + (id & 7) * 16) = pf.raw[a][i]; }
      if (th < 24) *(LAS v4u*)(prow + (th >> 3) * 128 + (th & 7) * 16) = pf.prv; }
    {
        const bf16* Ww2 = (const bf16*)(F.ws + WS_WW2); const bf16* Wa2 = (const bf16*)(F.ws + WS_WA2);
        const int tl = 16 * w + c; const bf16* crl = proj + (size_t)(row0 + tl) * NCOLA; const bool hpl = !(first && tl == 0);
        v4u lc[2][2], lp[2][2];
#pragma unroll
        for (int a = 0; a < 2; ++a)
#pragma unroll
            for (int ks = 0; ks < 2; ++ks) { const int col = 2304 + 64 * a + 32 * ks + 8 * g; lc[a][ks] = *(const GAS v4u*)(crl + col); lp[a][ks] = (v4u){0u, 0u, 0u, 0u}; if (hpl) lp[a][ks] = *(const GAS v4u*)(crl - NCOLA + col); }
#pragma unroll
        for (int ks = 0; ks < 2; ++ks) { const int l0 = 32 * ks + 8 * g; float x[8];
            shift8(lc[0][ks], lp[0][ks], F.in[I_MU] + 2304 + l0, x);
#pragma unroll
            for (int i = 0; i < 8; ++i) x[i] = ftanh(x[i]);
            const bf16x8 aw = pack_frag(x);
            shift8(lc[1][ks], lp[1][ks], F.in[I_MU] + 2368 + l0, x);
            const bf16x8 aa = pack_frag(x);
#pragma unroll
            for (int n = 0; n < 4; ++n) { const size_t wo = (size_t)(h * 64 + 16 * n + c) * 64 + l0;
                dw[n] = mfma16(aw, *(const GAS bf16x8*)(Ww2 + wo), dw[n]); da[n] = mfma16(aa, *(const GAS bf16x8*)(Wa2 + wo), da[n]); } }
    }
    STAMP3(18);
    HBAR();
    if (has_next) prep_issue(F, next_unit, pf);
    f32x4 rt[4], kh[4], lw[4], at_[4], bt_[4], kt_[4], bh_[4], vv[4]; float gam[4]; float bon[4] = {0.f, 0.f, 0.f, 0.f}; float ssk[4] = {0.f, 0.f, 0.f, 0.f};
    f32x4 kkr[4], aa_[4], kp[4], rr[4];
    {

        const LAS unsigned char* pbase = (w == 0 && g == 0) ? prow + c * 2 : hb + (16 * w + 4 * g - 1) * LSTR + c * 2; const int pstr = (w == 0 && g == 0) ? 128 : SLOT;
        float rp[4], kpv[4], vp[4];
#pragma unroll
        for (int n = 0; n < 4; ++n) { rp[n] = bf2f(*(const LAS bf16*)(pbase + 32 * n)); kpv[n] = bf2f(*(const LAS bf16*)(pbase + pstr + 32 * n)); vp[n] = bf2f(*(const LAS bf16*)(pbase + 2 * pstr + 32 * n)); }
#pragma unroll
        for (int reg = 0; reg < 4; ++reg) { const int t = 16 * w + 4 * g + reg; const LAS unsigned char* cr = hb + t * LSTR + c * 2;
#pragma unroll
            for (int n = 0; n < 4; ++n) {
                const float r0 = bf2f(*(const LAS bf16*)(cr + 32 * n)), k0 = bf2f(*(const LAS bf16*)(cr + SLOT + 32 * n)), v0 = bf2f(*(const LAS bf16*)(cr + 2 * SLOT + 32 * n));
                const float r1 = rp[n], k1 = kpv[n], v1 = vp[n]; rp[n] = r0; kpv[n] = k0; vp[n] = v0;
                const float r = r0 + (r1 - r0) * mur[n], k = k0 + (k1 - k0) * muk[n], v = v0 + (v1 - v0) * muv[n];
                const float y = -(w0[n] + dw[n][reg]);
                const float sp = fmaxf(y, 0.f) + __logf(1.0f + __expf(-fabsf(y)));
                lw[n][reg] = -__expf(-sp - 0.5f);
                const float a = fsigmoid(a0[n] + da[n][reg]);
                aa_[n][reg] = a; kkr[n][reg] = k * kkc[n]; kp[n][reg] = k * (1.0f + (a - 1.0f) * kac[n]); rr[n][reg] = r; vv[n][reg] = v;
                ssk[reg] += kkr[n][reg] * kkr[n][reg]; bon[reg] += r * kp[n][reg] * rkc[n]; } }
    }
#pragma unroll
    for (int reg = 0; reg < 4; ++reg) { ssk[reg] = sum16(ssk[reg]); bon[reg] = sum16(bon[reg]); ssk[reg] = __builtin_amdgcn_rsqf(fmaxf(ssk[reg], 1e-24f)); }
    STAMP3(19);
    f32x4 Lc[4];
#pragma unroll
    for (int n = 0; n < 4; ++n) { f32x4 inc; inc[0] = lw[n][0]; inc[1] = inc[0] + lw[n][1]; inc[2] = inc[1] + lw[n][2]; inc[3] = inc[2] + lw[n][3];
        const float tot = inc[3]; const float t1 = __shfl(tot, (lane - 16) & 63), t2 = __shfl(tot, (lane - 32) & 63), t3 = __shfl(tot, (lane - 48) & 63);
        const float pre = (g >= 1 ? t1 : 0.f) + (g >= 2 ? t2 : 0.f) + (g >= 3 ? t3 : 0.f);
        Lc[n] = inc + pre; if (g == 3) wtot[w * 64 + 16 * n + c] = pre + tot; }
    HBAR();
#pragma unroll
    for (int n = 0; n < 4; ++n) { const int j = 16 * n + c; const float t0 = wtot[j], t1 = wtot[64 + j], t2 = wtot[128 + j], t3 = wtot[192 + j];
        const float base = (w >= 1 ? t0 : 0.f) + (w >= 2 ? t1 : 0.f) + (w >= 3 ? t2 : 0.f); const float LC = (t0 + t1) + (t2 + t3);
        gam[n] = __expf(LC);
#pragma unroll
        for (int reg = 0; reg < 4; ++reg) { const float L = Lc[n][reg] + base; const float eL = __expf(L), eLi = __builtin_amdgcn_rcpf(eL), eP = __expf(L - lw[n][reg]), eC = gam[n] * eLi;
            const float kk = kkr[n][reg] * ssk[reg], bsc = kk * aa_[n][reg];
            at_[n][reg] = -kk * eP; rt[n][reg] = rr[n][reg] * eL; bt_[n][reg] = bsc * eLi; kt_[n][reg] = kp[n][reg] * eLi; bh_[n][reg] = bsc * eC; kh[n][reg] = kp[n][reg] * eC;
            const int t = 16 * w + 4 * g + reg;
            *(LAS bf16*)(s0 + t * LSTR + j * 2) = f2bf(at_[n][reg]); *(LAS bf16*)(s1 + t * LSTR + j * 2) = f2bf(bt_[n][reg]);
            *(LAS bf16*)(s2 + t * LSTR + j * 2) = f2bf(kt_[n][reg]); *(LAS bf16*)(s3 + t * LSTR + j * 2) = f2bf(rt[n][reg]); }
        *(LAS v2u*)(s4 + j * LSTR + (16 * w + 4 * g) * 2) = pack4(at_[n]); *(LAS v2u*)(s5 + j * LSTR + (16 * w + 4 * g) * 2) = pack4(bh_[n]); *(LAS v2u*)(s6 + j * LSTR + (16 * w + 4 * g) * 2) = pack4(vv[n]);
        f32x4 bv;
#pragma unroll
        for (int reg = 0; reg < 4; ++reg) bv[reg] = bon[reg] * vv[n][reg];
        *(GAS v2u*)(rec + REC_BV + ((w * 64 + lane) * 4 + n) * 8) = pack4(bv); }
    HBAR();
    STAMP3(20);
    if (stage_limit <= 3) return;
    f32x4 aN[4], aMk[4], aMbr[4], aMkr[4]; zero4(aN); zero4(aMk); zero4(aMbr); zero4(aMkr);
    mm_strip2(aN, aMk, s0, s1, s2, w, c, g);
    mm_strip(aMbr, s1, s3, w, c, g); mm_strip(aMkr, s2, s3, w, c, g);
#pragma unroll
    for (int n = 0; n < 4; ++n)
#pragma unroll
        for (int reg = 0; reg < 4; ++reg) { const int row = 16 * w + 4 * g + reg, col = 16 * n + c;
            if (!(col < row)) { aN[n][reg] = 0.f; aMk[n][reg] = 0.f; } if (!(row <= col)) { aMbr[n][reg] = 0.f; aMkr[n][reg] = 0.f; } }
    HBAR();
    LAS float* Nf = (LAS float*)s0;
#pragma unroll
    for (int n = 0; n < 4; ++n)
#pragma unroll
        for (int reg = 0; reg < 4; ++reg) Nf[(16 * w + 4 * g + reg) * 64 + (c & 3) * 16 + 4 * n + (c >> 2)] = aN[n][reg];
    st_T(s2, aMk, w, c, g);
    st_T(s3, aMbr, w, c, g);
    HBAR();
    {
        const int q = lane & 3, sl = lane >> 2; float cq[16];
#pragma unroll
        for (int k = 0; k < 16; ++k) cq[k] = 0.f;
        for (int t = 0; t < 16 * w; ++t) if (q == 0) *(LAS bf16*)(s7 + t * LSTR + (16 * w + sl) * 2) = (bf16)0;
#pragma unroll
        for (int t = 0; t < 64; ++t) if (t >= 16 * w) {
            float part = 0.f;
#pragma unroll
            for (int k4 = 0; k4 < (t + 15) / 16; ++k4) { const f32x4 nv = *(const LAS f32x4*)(Nf + t * 64 + q * 16 + 4 * k4);
#pragma unroll
                for (int e = 0; e < 4; ++e) if (4 * (4 * k4 + e) < t) part = fmaf(nv[e], cq[4 * k4 + e], part); }
            part = sum4_dpp(part);
            const float val = part + ((t == 16 * w + sl) ? 1.0f : 0.0f);
            cq[t >> 2] = (q == (t & 3)) ? val : cq[t >> 2];
            if (q == 0) *(LAS bf16*)(s7 + t * LSTR + (16 * w + sl) * 2) = f2bf(val);
        }
    }
    HBAR();
    STAMP3(21);
    if (stage_limit <= 5) return;
    { f32x4 aW[4], aNk[4]; zero4(aW); zero4(aNk); mm_strip2(aW, aNk, s7, s4, s2, w, c, g); st_T(s0, aW, w, c, g); st_T(s1, aNk, w, c, g); }
    HBAR();
    { f32x4 aP[4]; zero4(aP); mm_strip(aP, s0, s5, w, c, g);
#pragma unroll
      for (int n = 0; n < 4; ++n)
#pragma unroll
          for (int reg = 0; reg < 4; ++reg) if (n == w && c == 4 * g + reg) aP[n][reg] += gam[n];
#pragma unroll
      for (int n = 0; n < 4; ++n) *(GAS v2u*)(rec + REC_PT + ((n * 2 + (w >> 1)) * 64 + lane) * 16 + 8 * (w & 1)) = pack4(aP[n]); }
    { f32x4 aZq[4], aZy[4]; zero4(aZq); zero4(aZy); mm_strip2(aZq, aZy, s1, s5, s3, w, c, g);
#pragma unroll
      for (int n = 0; n < 4; ++n) { aZq[n] += kh[n]; aZy[n] += aMkr[n]; }
      f32x4 aRy[4]; zero4(aRy); mm_strip(aRy, s3, s0, w, c, g);
#pragma unroll
      for (int n = 0; n < 4; ++n)
#pragma unroll
          for (int reg = 0; reg < 4; ++reg) *(GAS bf16*)(rec + REC_RY + ((w * 2 + (n >> 1)) * 64 + 16 * (2 * (n & 1) + (c >> 3)) + 4 * g + reg) * 16 + 2 * (c & 7)) = f2bf(aRy[n][reg] + rt[n][reg]);
      st_T(s4, aZq, w, c, g);
      st_T(s7, aZy, w, c, g); }
    HBAR();
    { f32x4 aQ[4], aY[4]; zero4(aQ); zero4(aY); mm_strip(aQ, s4, s6, w, c, g); mm_strip(aY, s7, s6, w, c, g);
#pragma unroll
      for (int n = 0; n < 4; ++n) { *(GAS v2u*)(rec + REC_QS + ((n * 64 + lane) * 4 + w) * 8) = pack4(aQ[n]);
                                    *(GAS v2u*)(rec + REC_YL + ((w * 64 + lane) * 4 + n) * 8) = pack4(aY[n]); } }
    STAMP3(22);
}

__device__ __forceinline__ float rdlane(float v, int l) { return __int_as_float(__builtin_amdgcn_readlane(__float_as_int(v), l)); }
#ifndef MK_TIME
#define MK_TIME -1
#endif
#define STAMP2(k) do { if (MK_TIME >= 0 && blockIdx.x == 0 && F.wave == 0 && lane == 0) ((volatile LAS unsigned long long*)(F.lds + LDSCTL_OFF + 512))[(k)] = __builtin_amdgcn_s_memrealtime(); } while (0)
__device__ __forceinline__ void rwkv_sample_task(Frame& F, int task) {
    int lane_ = F.lane; asm volatile("" : "+v"(lane_)); const int lane = lane_;
    const int b = task / NH, h = task % NH, col = h * 64 + lane;
    const bf16* proj = (const bf16*)(F.ws + WS_PROJ);
    const float* sh = F.in[I_SSHIFT] + (size_t)b * RWKV_COLS;
    const float* mu = F.in[I_MU];
    float S[64];
    { const GAS f32x4* sp = (const GAS f32x4*)(F.in[I_SWKV] + (((size_t)b * NH + h) * 64 + lane) * 64);
#pragma unroll
      for (int q = 0; q < 16; ++q) { const f32x4 v = sp[q]; S[4 * q] = v[0]; S[4 * q + 1] = v[1]; S[4 * q + 2] = v[2]; S[4 * q + 3] = v[3]; } }
    const float w0 = F.in[I_W0][col], a0 = F.in[I_A0][col], kkc = F.in[I_KK][col], kac = F.in[I_KA][col], rkc = F.in[I_RK][col], lnw = F.in[I_LNW][col], lnb = F.in[I_LNB][col];
    float rr[ST], kq[ST], vq[ST], twd[ST], adv[ST], gd0[ST], gd1[ST];
#pragma unroll
    for (int i = 0; i < ST; ++i) { const int row = RP + b * ST + i; const bf16* cr = proj + (size_t)row * NCOLA;
#define SHIFTED(cc) ({ const float p_ = bf2f(cr[(cc)]); const float q_ = (i == 0) ? sh[(cc)] : bf2f(cr[(cc) - NCOLA]); p_ + (q_ - p_) * mu[(cc)]; })
        rr[i] = SHIFTED(col); kq[i] = SHIFTED(768 + col); vq[i] = SHIFTED(1536 + col);
        twd[i] = ftanh(SHIFTED(2304 + lane)); adv[i] = SHIFTED(2368 + lane); gd0[i] = fsigmoid(SHIFTED(2432 + lane)); gd1[i] = fsigmoid(SHIFTED(2496 + lane));
#undef SHIFTED
    }
    float dwv[ST] = {0.f, 0.f, 0.f, 0.f}, dav[ST] = {0.f, 0.f, 0.f, 0.f}, ggv[ST] = {0.f, 0.f, 0.f, 0.f};
    { const GAS float* W2 = (const GAS float*)(F.in[I_WW2] + col); const GAS float* A2 = (const GAS float*)(F.in[I_WA2] + col); const GAS float* G2 = (const GAS float*)(F.in[I_WG2] + col);
      for (int l0 = 0; l0 < 64; l0 += 16) {
          float w2[16], a2[16], ga[16], gb[16];
#pragma unroll
          for (int u = 0; u < 16; ++u) { w2[u] = W2[(size_t)u * 768]; a2[u] = A2[(size_t)u * 768]; ga[u] = G2[(size_t)u * 768]; gb[u] = G2[(size_t)(64 + u) * 768]; }
          W2 += 16 * 768; A2 += 16 * 768; G2 += 16 * 768;
          __builtin_amdgcn_sched_barrier(0);
#pragma unroll
          for (int u = 0; u < 16; ++u) { const int l = l0 + u;
#pragma unroll
              for (int i = 0; i < ST; ++i) { dwv[i] = fmaf(rdlane(twd[i], l), w2[u], dwv[i]); dav[i] = fmaf(rdlane(adv[i], l), a2[u], dav[i]); ggv[i] = fmaf(rdlane(gd0[i], l), ga[u], ggv[i]); ggv[i] = fmaf(rdlane(gd1[i], l), gb[u], ggv[i]); } } } }
    STAMP2(15);
#pragma unroll
    for (int i = 0; i < ST; ++i) {
        const int row = RP + b * ST + i;
        const float r = rr[i], k = kq[i], v = vq[i], dw = dwv[i], da = dav[i], gg = ggv[i];
        const float y0 = -(w0 + dw); const float sp = fmaxf(y0, 0.f) + __logf(1.0f + __expf(-fabsf(y0)));
        const float wdec = __expf(-__expf(-sp - 0.5f));
        const float a = fsigmoid(a0 + da);
        const float kkr = k * kkc; const float nrm = fmaxf(sqrtf(wave_sum(kkr * kkr)), 1e-12f); const float kk = kkr / nrm;
        const float kp = k * (1.0f + (a - 1.0f) * kac);
        const float asc = -kk, bsc = kk * a;
        const float bonus = wave_sum(r * kp * rkc);
        float sa = 0.f;
#pragma unroll
        for (int j = 0; j < 64; ++j) sa = fmaf(S[j], rdlane(asc, j), sa);
        const float vi = v;
        float y = 0.f;
#pragma unroll
        for (int j = 0; j < 64; ++j) { const float wj = rdlane(wdec, j), bj = rdlane(bsc, j), kj = rdlane(kp, j), rj = rdlane(r, j);
            S[j] = fmaf(S[j], wj, fmaf(sa, bj, vi * kj)); y = fmaf(S[j], rj, y); }
        const float mean = wave_sum(y) * (1.0f / 64.0f); const float dy = y - mean; const float var = wave_sum(dy * dy) * (1.0f / 64.0f);
        const float o = (dy * rsqrtf(var + 6.4e-4f) * lnw + lnb + bonus * vi) * gg;
        ((bf16*)(F.ws + WS_MIX))[(size_t)row * DM + col] = f2bf(o);
        asm volatile("" ::: "memory");
    }
    STAMP2(16);
    { GAS f32x4* sp = (GAS f32x4*)(F.out + O_SWKV + (((size_t)b * NH + h) * 64 + lane) * 64);
#pragma unroll
      for (int q = 0; q < 16; ++q) sp[q] = (f32x4){S[4 * q], S[4 * q + 1], S[4 * q + 2], S[4 * q + 3]}; }
    if (h == 0) { const bf16* lr = proj + (size_t)(RP + b * ST + ST - 1) * NCOLA; float* o = F.out + O_SSHIFT + (size_t)b * RWKV_COLS;
        for (int q = lane; q < RWKV_COLS; q += 64) o[q] = bf2f(lr[q]); }
}

__device__ __forceinline__ void rwkv_scan_chain(Frame& F, int bh, int w) {
    int lane_ = F.lane; asm volatile("" : "+v"(lane_)); const int lane = lane_, g = lane >> 4, c = lane & 15; const int b = bh / NH, h = bh % NH;
    constexpr int DPF = 12, NSL = 14, SLB = 10240;
    LAS unsigned char* ring = F.lds;
    auto recp = [&](int cc) -> const unsigned char* { return F.ws + WS_REC + (size_t)((b * NH + h) * 128 + cc) * REC_BYTES; };
    const int vrow = 16 * w + c;
    if (F.wave >= 4) {
        const int L = F.wave - 4, npc = L < 2 ? 3 : 2;
#define SCAN_DMA(cc_) do { const unsigned char* rp_ = recp(cc_); LAS unsigned char* sl_ = ring + ((cc_) % NSL) * SLB; \
            _Pragma("unroll") for (int q = 0; q < 3; ++q) { const int p = L + 4 * q; if (p < 8) __builtin_amdgcn_global_load_lds((const unsigned*)(rp_ + REC_PT + p * 1024 + lane * 16), (LAS unsigned*)(sl_ + p * 1024), 16, 0, 0); \
                else if (p < 10) __builtin_amdgcn_global_load_lds((const unsigned*)(rp_ + REC_QS + (w * 64 + lane) * 32 + (p - 8) * 16), (LAS unsigned*)(sl_ + p * 1024), 16, 0, 0); } } while (0)
        for (int d = 0; d < DPF; ++d) SCAN_DMA(d);
        for (int cc = 0; cc < 128; ++cc) {
            const int younger = (cc + DPF <= 128 ? DPF - 1 : 127 - cc) * npc;
            if (younger >= 33) asm volatile("s_waitcnt vmcnt(33)" ::: "memory"); else if (younger >= 22) asm volatile("s_waitcnt vmcnt(22)" ::: "memory");
            else if (younger >= 11) asm volatile("s_waitcnt vmcnt(11)" ::: "memory"); else asm volatile("s_waitcnt vmcnt(0)" ::: "memory");
            __builtin_amdgcn_s_barrier();
            if (cc + DPF < 128) SCAN_DMA(cc + DPF);
        }
#undef SCAN_DMA
        asm volatile("s_waitcnt vmcnt(0)" ::: "memory");
        return;
    }
    if (F.wave != 0) { for (int cc = 0; cc < 128; ++cc) __builtin_amdgcn_s_barrier(); return; }
    f32x4 acc[4]; zero4(acc);
    for (int cc = 0; cc < 128; ++cc) {
        __builtin_amdgcn_s_barrier(); asm volatile("" ::: "memory");
        const LAS unsigned char* sl = ring + (cc % NSL) * SLB;
        bf16x8 pa[4][2];
#pragma unroll
        for (int mt = 0; mt < 4; ++mt)
#pragma unroll
            for (int ks = 0; ks < 2; ++ks) pa[mt][ks] = *(const LAS bf16x8*)(sl + (mt * 2 + ks) * 1024 + lane * 16);
        const v4u q0 = *(const LAS v4u*)(sl + 8192 + lane * 16), q1 = *(const LAS v4u*)(sl + 9216 + lane * 16);
        unsigned char* sp_ = F.ws + WS_HB + (size_t)((b * NH + h) * 128 + cc) * 8192;
        v2u sb[4]; f32x4 nacc[4];
#pragma unroll
        for (int mt = 0; mt < 4; ++mt) sb[mt] = pack4(acc[mt]);
        nacc[0] = unpack4((v2u){q0.x, q0.y}); nacc[1] = unpack4((v2u){q0.z, q0.w}); nacc[2] = unpack4((v2u){q1.x, q1.y}); nacc[3] = unpack4((v2u){q1.z, q1.w});
#pragma unroll
        for (int mt = 0; mt < 4; ++mt) *(GAS v2u*)(sp_ + ((w * 2 + (mt >> 1)) * 64 + 16 * (2 * (mt & 1) + (g >> 1)) + c) * 16 + 8 * (g & 1)) = sb[mt];
        bf16x8 bf[2];
#pragma unroll
        for (int ks = 0; ks < 2; ++ks) { v4u t; t.x = sb[2 * ks].x; t.y = sb[2 * ks].y; t.z = sb[2 * ks + 1].x; t.w = sb[2 * ks + 1].y; bf[ks] = __builtin_bit_cast(bf16x8, t); }
#pragma unroll
        for (int mt = 0; mt < 4; ++mt) { nacc[mt] = mfma16(pa[mt][0], bf[0], nacc[mt]); nacc[mt] = mfma16(pa[mt][1], bf[1], nacc[mt]); acc[mt] = nacc[mt]; }
        asm volatile("s_waitcnt lgkmcnt(0)" ::: "memory");
    }
    float* o = F.out + O_PWKV + (((size_t)b * NH + h) * 64 + vrow) * 64;
#pragma unroll
    for (int mt = 0; mt < 4; ++mt) *(GAS f32x4*)(o + 16 * mt + 4 * g) = acc[mt];
}

__device__ __forceinline__ void rwkv_yout_item(Frame& F, int item) {
    int lane_ = F.lane; asm volatile("" : "+v"(lane_)); const int lane = lane_, g = lane >> 4, c = lane & 15; const int unit = item >> 2, w = item & 3;
    const int chunk = unit / NH, h = unit % NH, row0 = chunk * 64; const bool first = (chunk & 127) == 0;
    const unsigned char* rec = F.ws + WS_REC + (size_t)rec_index(chunk, h) * REC_BYTES; const unsigned char* srec = F.ws + WS_HB + (size_t)rec_index(chunk, h) * 8192;
    const bf16* proj = (const bf16*)(F.ws + WS_PROJ);
    f32x4 y[4], gt[4]; zero4(gt);
    { const v4u y01 = *(const GAS v4u*)(rec + REC_YL + (w * 64 + lane) * 32), y23 = *(const GAS v4u*)(rec + REC_YL + (w * 64 + lane) * 32 + 16);
      y[0] = unpack4((v2u){y01.x, y01.y}); y[1] = unpack4((v2u){y01.z, y01.w}); y[2] = unpack4((v2u){y23.x, y23.y}); y[3] = unpack4((v2u){y23.z, y23.w}); }
    { bf16x8 ar[2], sf[4][2]; v4u gc[4], gp[4]; v2u bvv[4];
      const int tg = 16 * w + c; const bf16* crg = proj + (size_t)(row0 + tg) * NCOLA; const bool hpg = !(first && tg == 0);
#pragma unroll
      for (int ks = 0; ks < 2; ++ks) { ar[ks] = *(const GAS bf16x8*)(rec + REC_RY + ((w * 2 + ks) * 64 + lane) * 16);
#pragma unroll
          for (int n = 0; n < 4; ++n) sf[n][ks] = *(const GAS bf16x8*)(srec + ((n * 2 + ks) * 64 + lane) * 16); }
      __builtin_amdgcn_sched_barrier(0);
#pragma unroll
      for (int ks = 0; ks < 2; ++ks)
#pragma unroll
          for (int n = 0; n < 4; ++n) y[n] = mfma16(ar[ks], sf[n][ks], y[n]); }
    { const int t = 16 * w + c; const bf16* cr = proj + (size_t)(row0 + t) * NCOLA; const bf16* pr = (first && t == 0) ? nullptr : cr - NCOLA; const bf16* Wg2 = (const bf16*)(F.ws + WS_WG2);
#pragma unroll
      for (int ks = 0; ks < 4; ++ks) { const int l0 = 32 * ks + 8 * g; float x[8]; load_shift8(cr + 2432 + l0, pr ? pr + 2432 + l0 : nullptr, F.in[I_MU] + 2432 + l0, x);
#pragma unroll
          for (int i = 0; i < 8; ++i) x[i] = fsigmoid(x[i]);
          const bf16x8 ag = pack_frag(x);
#pragma unroll
          for (int n = 0; n < 4; ++n) gt[n] = mfma16(ag, *(const GAS bf16x8*)(Wg2 + (size_t)(h * 64 + 16 * n + c) * 128 + l0), gt[n]); } }
    float mean[4], rstd[4];
#pragma unroll
    for (int reg = 0; reg < 4; ++reg) { float s = (y[0][reg] + y[1][reg]) + (y[2][reg] + y[3][reg]); s = sum16(s); mean[reg] = s * (1.0f / 64.0f);
        float q = 0.f;
#pragma unroll
        for (int n = 0; n < 4; ++n) { const float d = y[n][reg] - mean[reg]; q += d * d; }
        q = sum16(q); rstd[reg] = rsqrtf(q * (1.0f / 64.0f) + 6.4e-4f); }
    bf16* mix = (bf16*)(F.ws + WS_MIX);
#pragma unroll
    for (int n = 0; n < 4; ++n) { const int col = h * 64 + 16 * n + c; const float lnw = F.in[I_LNW][col], lnb = F.in[I_LNB][col];
        const f32x4 bv = unpack4(*(const GAS v2u*)(rec + REC_BV + ((w * 64 + lane) * 4 + n) * 8));
#pragma unroll
        for (int reg = 0; reg < 4; ++reg) { const float o = ((y[n][reg] - mean[reg]) * rstd[reg] * lnw + lnb + bv[reg]) * gt[n][reg];
            mix[(size_t)(row0 + 16 * w + 4 * g + reg) * DM + col] = f2bf(o); } }
}

__device__ __forceinline__ int crow32(int r, int hi) { return (r & 3) + 8 * (r >> 2) + 4 * hi; }
template <bool MASKED, int GB>
__device__ __forceinline__ void flash32(const bf16x8 (&qf)[4], const bf16* Kp, int kstr, const bf16* VTp, int vstr, int kb_lo, int nblk, int qpos, float m0, float l0,
                                        f32x16& o0, f32x16& o1, float& lsum, int lane) {
    const int r32 = lane & 31, hh = lane >> 5;
    float m = m0, l = hh == 0 ? l0 : 0.f;
#pragma unroll
    for (int r = 0; r < 16; ++r) { o0[r] = 0.f; o1[r] = 0.f; }
    for (int b0 = 0; b0 < nblk; b0 += GB) {
        bf16x8 kf[GB][4]; v2u vf[GB][2][2][2];
#pragma unroll
        for (int i = 0; i < GB; ++i) if (b0 + i < nblk) { const int kb = kb_lo + 32 * (b0 + i);
#pragma unroll
            for (int ks = 0; ks < 4; ++ks) kf[i][ks] = *(const GAS bf16x8*)(Kp + (size_t)(kb + r32) * kstr + 16 * ks + 8 * hh);
#pragma unroll
            for (int s2 = 0; s2 < 2; ++s2)
#pragma unroll
                for (int dt = 0; dt < 2; ++dt) { const bf16* vp = VTp + (size_t)(32 * dt + r32) * vstr + kb + 16 * s2 + 4 * hh; vf[i][s2][dt][0] = *(const GAS v2u*)vp; vf[i][s2][dt][1] = *(const GAS v2u*)(vp + 8); } }
#pragma unroll
        for (int i = 0; i < GB; ++i) if (b0 + i < nblk) { const int kb = kb_lo + 32 * (b0 + i);
            f32x16 s;
#pragma unroll
            for (int r = 0; r < 16; ++r) s[r] = 0.f;
#pragma unroll
            for (int ks = 0; ks < 4; ++ks) s = mfma32(kf[i][ks], qf[ks], s);
            if (MASKED) {
#pragma unroll
                for (int r = 0; r < 16; ++r) { const int rel = qpos - (kb + crow32(r, hh)); if (rel < 0 || rel >= 128) s[r] = -1e30f; } }
            float bm = s[0];
#pragma unroll
            for (int r = 1; r < 16; ++r) bm = fmaxf(bm, s[r]);
            bm = max_x32(bm);
            const float mn = fmaxf(m, bm), alpha = __builtin_amdgcn_exp2f(m - mn); m = mn;
            float ps = 0.f;
#pragma unroll
            for (int r = 0; r < 16; ++r) { s[r] = __builtin_amdgcn_exp2f(s[r] - mn); ps += s[r]; }
            l = l * alpha + ps;
#pragma unroll
            for (int r = 0; r < 16; ++r) { o0[r] *= alpha; o1[r] *= alpha; }
#pragma unroll
            for (int s2 = 0; s2 < 2; ++s2) {
                v4u pw; pw.x = cvt_pk_bf16(s[8 * s2], s[8 * s2 + 1]); pw.y = cvt_pk_bf16(s[8 * s2 + 2], s[8 * s2 + 3]); pw.z = cvt_pk_bf16(s[8 * s2 + 4], s[8 * s2 + 5]); pw.w = cvt_pk_bf16(s[8 * s2 + 6], s[8 * s2 + 7]);
                const bf16x8 pb = __builtin_bit_cast(bf16x8, pw);
                { v4u aw; aw.x = vf[i][s2][0][0].x; aw.y = vf[i][s2][0][0].y; aw.z = vf[i][s2][0][1].x; aw.w = vf[i][s2][0][1].y; o0 = mfma32(__builtin_bit_cast(bf16x8, aw), pb, o0); }
                { v4u aw; aw.x = vf[i][s2][1][0].x; aw.y = vf[i][s2][1][0].y; aw.z = vf[i][s2][1][1].x; aw.w = vf[i][s2][1][1].y; o1 = mfma32(__builtin_bit_cast(bf16x8, aw), pb, o1); } }
        }
    }
    lsum = add_x32(l);
}
__device__ __forceinline__ void flash_store(bf16* dst  , int rstride, const f32x16& o0, const f32x16& o1, float lsum, int lane) {
    const int r32 = lane & 31, hh = lane >> 5; const float inv = 1.0f / lsum; bf16* p = dst + (size_t)r32 * rstride + 4 * hh;
#pragma unroll
    for (int k = 0; k < 4; ++k) { *(GAS v2u*)(p + 8 * k) = pack4((f32x4){o0[4 * k] * inv, o0[4 * k + 1] * inv, o0[4 * k + 2] * inv, o0[4 * k + 3] * inv});
        *(GAS v2u*)(p + 32 + 8 * k) = pack4((f32x4){o1[4 * k] * inv, o1[4 * k + 1] * inv, o1[4 * k + 2] * inv, o1[4 * k + 3] * inv}); }
}
constexpr int KL_STR = 144;
template <bool MASKED>
__device__ __forceinline__ void flash32_lds(const bf16x8 (&qf)[4], const LAS unsigned char* Kl, const LAS unsigned char* Vl, int vstr, int lk_lo, int nblk, int kpos_lo, int qpos, float m0, float l0,
                                            f32x16& o0, f32x16& o1, float& lsum, int lane) {
    const int r32 = lane & 31, hh = lane >> 5;
    float m = m0, l = hh == 0 ? l0 : 0.f;
#pragma unroll
    for (int r = 0; r < 16; ++r) { o0[r] = 0.f; o1[r] = 0.f; }
    for (int blk = 0; blk < nblk; ++blk) { const int lk = lk_lo + 32 * blk;
        f32x16 s;
#pragma unroll
        for (int r = 0; r < 16; ++r) s[r] = 0.f;
#pragma unroll
        for (int ks = 0; ks < 4; ++ks) s = mfma32(*(const LAS bf16x8*)(Kl + (lk + r32) * KL_STR + (16 * ks + 8 * hh) * 2), qf[ks], s);
        if (MASKED && (blk == 0 || blk == nblk - 1)) {
#pragma unroll
            for (int r = 0; r < 16; ++r) { const int rel = qpos - (kpos_lo + 32 * blk + crow32(r, hh)); if (rel < 0 || rel >= 128) s[r] = -1e30f; } }
        float bm = s[0];
#pragma unroll
        for (int r = 1; r < 16; ++r) bm = fmaxf(bm, s[r]);
        bm = max_x32(bm);
        const float mn = fmaxf(m, bm), alpha = __builtin_amdgcn_exp2f(m - mn); m = mn;
        float ps = 0.f;
#pragma unroll
        for (int r = 0; r < 16; ++r) { s[r] = __builtin_amdgcn_exp2f(s[r] - mn); ps += s[r]; }
        l = l * alpha + ps;
#pragma unroll
        for (int r = 0; r < 16; ++r) { o0[r] *= alpha; o1[r] *= alpha; }
#pragma unroll
        for (int s2 = 0; s2 < 2; ++s2) {
            v4u pw; pw.x = cvt_pk_bf16(s[8 * s2], s[8 * s2 + 1]); pw.y = cvt_pk_bf16(s[8 * s2 + 2], s[8 * s2 + 3]); pw.z = cvt_pk_bf16(s[8 * s2 + 4], s[8 * s2 + 5]); pw.w = cvt_pk_bf16(s[8 * s2 + 6], s[8 * s2 + 7]);
            const bf16x8 pb = __builtin_bit_cast(bf16x8, pw);
#pragma unroll
            for (int dt = 0; dt < 2; ++dt) { const LAS unsigned char* vp = Vl + (32 * dt + r32) * vstr + (lk + 16 * s2 + 4 * hh) * 2;
                const v2u a0 = *(const LAS v2u*)vp, a1 = *(const LAS v2u*)(vp + 16); v4u aw; aw.x = a0.x; aw.y = a0.y; aw.z = a1.x; aw.w = a1.y;
                if (dt == 0) o0 = mfma32(__builtin_bit_cast(bf16x8, aw), pb, o0); else o1 = mfma32(__builtin_bit_cast(bf16x8, aw), pb, o1); } }
    }
    lsum = add_x32(l);
}
template <bool VT>
__device__ __forceinline__ void stage_kv(LAS unsigned char* Kl, LAS unsigned char* Vl, int vstr, const bf16* Kg, int kstr, const bf16* Vg, int vstr_g, int nkeys, int tid) {
    for (int id = tid; id < nkeys * 8; id += NWAVES * 64) { const int key = id >> 3, ch = id & 7; *(LAS v4u*)(Kl + key * KL_STR + ch * 16) = *(const GAS v4u*)(Kg + (size_t)key * kstr + ch * 8); }
    if (VT) { const int cpr = nkeys >> 3;
        for (int id = tid; id < 64 * cpr; id += NWAVES * 64) { const int d = id / cpr, ch = id % cpr; *(LAS v4u*)(Vl + d * vstr + ch * 16) = *(const GAS v4u*)(Vg + (size_t)d * vstr_g + ch * 8); } }
    else for (int id = tid; id < nkeys * 8; id += NWAVES * 64) { const int key = id >> 3, ch = id & 7; const v4u w = *(const GAS v4u*)(Vg + (size_t)key * vstr_g + ch * 8);
        LAS unsigned char* p = Vl + (8 * ch) * vstr + key * 2;
        *(LAS bf16*)(p) = (bf16)(w.x & 0xffffu); *(LAS bf16*)(p + vstr) = (bf16)(w.x >> 16); *(LAS bf16*)(p + 2 * vstr) = (bf16)(w.y & 0xffffu); *(LAS bf16*)(p + 3 * vstr) = (bf16)(w.y >> 16);
        *(LAS bf16*)(p + 4 * vstr) = (bf16)(w.z & 0xffffu); *(LAS bf16*)(p + 5 * vstr) = (bf16)(w.z >> 16); *(LAS bf16*)(p + 6 * vstr) = (bf16)(w.w & 0xffffu); *(LAS bf16*)(p + 7 * vstr) = (bf16)(w.w >> 16); }
}
__device__ __forceinline__ void memattn_prompt_unit(Frame& F, int layer, int unit) {
    int lane_ = F.lane; asm volatile("" : "+v"(lane_)); const int lane = lane_, r32 = lane & 31, hh = lane >> 5;
    const int b = unit >> 7, hm = (unit >> 5) & 3, qblk = unit & 31; const int row = b * T + qblk * 256 + F.wave * 32 + r32;
    LAS unsigned char* Kl = F.lds; LAS unsigned char* Vl = F.lds + 256 * KL_STR; constexpr int VSTR = 256 * 2 + 16;
    __syncthreads();
    stage_kv<true>(Kl, Vl, VSTR, (const bf16*)(F.ws + WS_MK) + (size_t)((layer * 2 + b) * 4 + hm) * 256 * 64, 64, (const bf16*)(F.ws + WS_MVT) + (size_t)((layer * 2 + b) * 4 + hm) * 64 * 256, 256, 256, F.wave * 64 + lane);
    bf16x8 qf[4];
    if (layer == 0) { const bf16* qp = (const bf16*)(F.ws + WS_PROJ) + (size_t)row * NCOLA + RWKV_COLS + hm * 64; const float* gn = F.in[I_MQN];
        float x[4][8]; float ss = 0.f;
#pragma unroll
        for (int ks = 0; ks < 4; ++ks) { const v4u w = *(const GAS v4u*)(qp + 16 * ks + 8 * hh); const unsigned ww[4] = {w.x, w.y, w.z, w.w};
#pragma unroll
            for (int i = 0; i < 4; ++i) { x[ks][2 * i] = bflo(ww[i]); x[ks][2 * i + 1] = bfhi(ww[i]); ss += x[ks][2 * i] * x[ks][2 * i] + x[ks][2 * i + 1] * x[ks][2 * i + 1]; } }
        ss = add_x32(ss); const float rs = rsqrtf(ss * (1.0f / 64.0f) + 1e-6f) * C2Q;
#pragma unroll
        for (int ks = 0; ks < 4; ++ks) {
#pragma unroll
            for (int i = 0; i < 8; ++i) x[ks][i] *= rs * gn[16 * ks + 8 * hh + i];
            qf[ks] = pack_frag(x[ks]); }
    } else { const bf16* qp = (const bf16*)(F.ws + WS_Q1) + (size_t)row * DM + 768 + hm * 64;
#pragma unroll
        for (int ks = 0; ks < 4; ++ks) qf[ks] = *(const GAS bf16x8*)(qp + 16 * ks + 8 * hh); }
    __syncthreads();
    f32x16 o0, o1; float ls;
    flash32_lds<false>(qf, Kl, Vl, VSTR, 0, 8, 0, 0, -1e30f, 0.f, o0, o1, ls, lane);
    flash_store((bf16*)(F.ws + WS_MIX) + (size_t)(b * T + qblk * 256 + F.wave * 32) * DM + 768 + hm * 64, DM, o0, o1, ls, lane);
}
__device__ __forceinline__ void swa_prompt_unit(Frame& F, int unit) {
    int lane_ = F.lane; asm volatile("" : "+v"(lane_)); const int lane = lane_, r32 = lane & 31, hh = lane >> 5;
    const int b = unit >> 7, kvh = (unit >> 5) & 3, qblk = unit & 31, q0 = qblk * 256, kb0 = q0 >= 128 ? q0 - 128 : 0, nkeys = q0 + 256 - kb0;
    LAS unsigned char* Kl = F.lds; LAS unsigned char* Vl = F.lds + 384 * KL_STR; constexpr int VSTR = 384 * 2 + 16;
    __syncthreads();
    stage_kv<false>(Kl, Vl, VSTR, (const bf16*)(F.ws + WS_K1) + (size_t)(b * T + kb0) * 256 + kvh * 64, 256, (const bf16*)(F.ws + WS_V1) + (size_t)(b * T + kb0) * 256 + kvh * 64, 256, nkeys, F.wave * 64 + lane);
    const int tq = q0 + F.wave * 32, row = b * T + tq + r32;
    bf16x8 qf[3][4];
#pragma unroll
    for (int gq = 0; gq < 3; ++gq) { const bf16* qp = (const bf16*)(F.ws + WS_Q1) + (size_t)row * DM + (kvh * 3 + gq) * 64;
#pragma unroll
        for (int ks = 0; ks < 4; ++ks) qf[gq][ks] = *(const GAS bf16x8*)(qp + 16 * ks + 8 * hh); }
    __syncthreads();
    const int kp_lo = tq >= 128 ? tq - 128 : 0, nblk = (tq - kp_lo) / 32 + 1;
#pragma unroll
    for (int gq = 0; gq < 3; ++gq) { const int hq = kvh * 3 + gq; const float sink = F.in[I_SINKS][hq] * LOG2E;
        f32x16 o0, o1; float ls;
        flash32_lds<true>(qf[gq], Kl, Vl, VSTR, kp_lo - kb0, nblk, kp_lo, tq + r32, sink, 1.0f, o0, o1, ls, lane);
        flash_store((bf16*)(F.ws + WS_MIX) + (size_t)(b * T + tq) * DM + hq * 64, DM, o0, o1, ls, lane); }
}
template <int NQ, bool WINDOW>
__device__ __forceinline__ void small_attn(const LAS float* ql, LAS float* sc, int NKP, const float* k1, const float* v1, int kst1, int nk1, const bf16* k2, const bf16* v2, int kst2, int nk2,
                                           const float* sinkg  , bf16* out0, int ostride_q, int lane) {
    const int sub = lane >> 4, dq = lane & 15, nk = nk1 + nk2;
    f32x4 qv[NQ];
#pragma unroll
    for (int qi = 0; qi < NQ; ++qi) qv[qi] = *(const LAS f32x4*)(ql + qi * 64 + 4 * dq);
    constexpr int KBAT = NQ > 4 ? 4 : 8;
    for (int kg0 = 0; kg0 < nk1; kg0 += 4 * KBAT) { f32x4 kv[KBAT];
#pragma unroll
        for (int u = 0; u < KBAT; ++u) kv[u] = *(const GAS f32x4*)(k1 + (size_t)(kg0 + 4 * u + sub) * kst1 + 4 * dq);
        __builtin_amdgcn_sched_barrier(0);
#pragma unroll
        for (int u = 0; u < KBAT; ++u) { const int key = kg0 + 4 * u + sub;
#pragma unroll
            for (int qi = 0; qi < NQ; ++qi) { const f32x4 p = qv[qi] * kv[u]; const float s = sum16((p[0] + p[1]) + (p[2] + p[3])); if (dq == 0) sc[qi * NKP + key] = s; } } }
    for (int kg = nk1; kg < nk; kg += 4) { const int key = kg + sub; const f32x4 kv = unpack4(*(const GAS v2u*)(k2 + (size_t)(key - nk1) * kst2 + 4 * dq));
#pragma unroll
        for (int qi = 0; qi < NQ; ++qi) { const f32x4 p = qv[qi] * kv; const float s = sum16((p[0] + p[1]) + (p[2] + p[3])); if (dq == 0) sc[qi * NKP + key] = s; } }
    LDS_WAIT(); asm volatile("" ::: "memory");
#pragma unroll
    for (int qi = 0; qi < NQ; ++qi) { float sv[5]; const float sk_ = sinkg ? sinkg[qi >> 2] * LOG2E : -1e30f; float mx = sk_;
#pragma unroll
        for (int t = 0; t < 5; ++t) { const int key = lane + 64 * t; float s = -1e30f; if (key < nk) { s = sc[qi * NKP + key]; if (WINDOW) { const int i = qi & 3; if (key < i + 1 || key > 128 + i) s = -1e30f; } } sv[t] = s; mx = fmaxf(mx, s); }
        mx = wave_max(mx); float sum = 0.f;
#pragma unroll
        for (int t = 0; t < 5; ++t) { sv[t] = __builtin_amdgcn_exp2f(sv[t] - mx); sum += sv[t]; }
        sum = wave_sum(sum) + (sinkg ? __builtin_amdgcn_exp2f(sk_ - mx) : 0.f); const float inv = 1.0f / sum;
#pragma unroll
        for (int t = 0; t < 5; ++t) { const int key = lane + 64 * t; if (key < nk) sc[qi * NKP + key] = sv[t] * inv; } }
    LDS_WAIT(); asm volatile("" ::: "memory");
    f32x4 acc[NQ];
#pragma unroll
    for (int qi = 0; qi < NQ; ++qi) acc[qi] = (f32x4){0.f, 0.f, 0.f, 0.f};
    for (int kg0 = 0; kg0 < nk1; kg0 += 4 * KBAT) { f32x4 vv[KBAT];
#pragma unroll
        for (int u = 0; u < KBAT; ++u) vv[u] = *(const GAS f32x4*)(v1 + (size_t)(kg0 + 4 * u + sub) * kst1 + 4 * dq);
        __builtin_amdgcn_sched_barrier(0);
#pragma unroll
        for (int u = 0; u < KBAT; ++u) { const int key = kg0 + 4 * u + sub;
#pragma unroll
            for (int qi = 0; qi < NQ; ++qi) acc[qi] += vv[u] * sc[qi * NKP + key]; } }
    for (int kg = nk1; kg < nk; kg += 4) { const int key = kg + sub; const f32x4 vv = unpack4(*(const GAS v2u*)(v2 + (size_t)(key - nk1) * kst2 + 4 * dq));
#pragma unroll
        for (int qi = 0; qi < NQ; ++qi) acc[qi] += vv * sc[qi * NKP + key]; }
#pragma unroll
    for (int qi = 0; qi < NQ; ++qi) { f32x4 a = acc[qi];
#pragma unroll
        for (int e = 0; e < 4; ++e) { a[e] = add_x16(a[e]); a[e] = add_x32(a[e]); }
        if (sub == 0) *(GAS v2u*)(out0 + (size_t)(qi & 3) * ostride_q + (qi >> 2) * 64 + 4 * dq) = pack4(a); }
    LDS_WAIT(); asm volatile("" ::: "memory");
}
template <int NQ, bool WINDOW>
__device__ __forceinline__ void small_attn2(bool valid, int half, const LAS float* ql, LAS float* sc, LAS float* xch, int NKP, const float* k1, const float* v1, int kst1, int nk1,
                                            const bf16* k2, const bf16* v2, int kst2, int nk2, const float* sinkg, bf16* out0, int ostride_q, int lane) {
    const int sub = lane >> 4, dq = lane & 15, nk = nk1 + nk2, klo = half ? nk1 / 2 : 0, khi = half ? nk1 : nk1 / 2, kend = half ? nk : khi;
    constexpr int KBAT = 4;
    f32x4 qv[NQ]; float mloc[NQ];
    if (valid) {
#pragma unroll
        for (int qi = 0; qi < NQ; ++qi) qv[qi] = *(const LAS f32x4*)(ql + qi * 64 + 4 * dq);
        for (int kg0 = klo; kg0 < khi; kg0 += 4 * KBAT) { f32x4 kv[KBAT];
#pragma unroll
            for (int u = 0; u < KBAT; ++u) kv[u] = *(const GAS f32x4*)(k1 + (size_t)(kg0 + 4 * u + sub) * kst1 + 4 * dq);
            __builtin_amdgcn_sched_barrier(0);
#pragma unroll
            for (int u = 0; u < KBAT; ++u) { const int key = kg0 + 4 * u + sub;
#pragma unroll
                for (int qi = 0; qi < NQ; ++qi) { const f32x4 p = qv[qi] * kv[u]; const float s = sum16((p[0] + p[1]) + (p[2] + p[3])); if (dq == 0) sc[qi * NKP + key] = s; } } }
        if (half) for (int kg = nk1; kg < nk; kg += 4) { const int key = kg + sub; const f32x4 kv = unpack4(*(const GAS v2u*)(k2 + (size_t)(key - nk1) * kst2 + 4 * dq));
#pragma unroll
            for (int qi = 0; qi < NQ; ++qi) { const f32x4 p = qv[qi] * kv; const float s = sum16((p[0] + p[1]) + (p[2] + p[3])); if (dq == 0) sc[qi * NKP + key] = s; } }
        LDS_WAIT(); asm volatile("" ::: "memory");
#pragma unroll
        for (int qi = 0; qi < NQ; ++qi) { float mx = -1e30f;
#pragma unroll
            for (int t = 0; t < 3; ++t) { const int key = klo + lane + 64 * t; if (key < kend) { float s = sc[qi * NKP + key]; if (WINDOW) { const int i = qi & 3; if (key < i + 1 || key > 128 + i) s = -1e30f; } mx = fmaxf(mx, s); } }
            mloc[qi] = wave_max(mx); if (lane == 0) xch[half * NQ + qi] = mloc[qi]; }
    }
    __syncthreads();
    if (valid) {
#pragma unroll
        for (int qi = 0; qi < NQ; ++qi) { const float sk_ = sinkg ? sinkg[qi >> 2] * LOG2E : -1e30f; const float m = fmaxf(fmaxf(xch[qi], xch[NQ + qi]), sk_); float sum = 0.f;
#pragma unroll
            for (int t = 0; t < 3; ++t) { const int key = klo + lane + 64 * t; if (key < kend) { float s = sc[qi * NKP + key]; if (WINDOW) { const int i = qi & 3; if (key < i + 1 || key > 128 + i) s = -1e30f; }
                    const float p = __builtin_amdgcn_exp2f(s - m); sc[qi * NKP + key] = p; sum += p; } }
            sum = wave_sum(sum); if (half == 0 && sinkg) sum += __builtin_amdgcn_exp2f(sk_ - m);
            if (lane == 0) xch[2 * NQ + half * NQ + qi] = sum; }
        LDS_WAIT(); asm volatile("" ::: "memory");
    }
    __syncthreads();
    if (valid) {
        f32x4 acc[NQ];
#pragma unroll
        for (int qi = 0; qi < NQ; ++qi) acc[qi] = (f32x4){0.f, 0.f, 0.f, 0.f};
        for (int kg0 = klo; kg0 < khi; kg0 += 4 * KBAT) { f32x4 vv[KBAT];
#pragma unroll
            for (int u = 0; u < KBAT; ++u) vv[u] = *(const GAS f32x4*)(v1 + (size_t)(kg0 + 4 * u + sub) * kst1 + 4 * dq);
            __builtin_amdgcn_sched_barrier(0);
#pragma unroll
            for (int u = 0; u < KBAT; ++u) { const int key = kg0 + 4 * u + sub;
#pragma unroll
                for (int qi = 0; qi < NQ; ++qi) acc[qi] += vv[u] * sc[qi * NKP + key]; } }
        if (half) for (int kg = nk1; kg < nk; kg += 4) { const int key = kg + sub; const f32x4 vv = unpack4(*(const GAS v2u*)(v2 + (size_t)(key - nk1) * kst2 + 4 * dq));
#pragma unroll
            for (int qi = 0; qi < NQ; ++qi) acc[qi] += vv * sc[qi * NKP + key]; }
#pragma unroll
        for (int qi = 0; qi < NQ; ++qi) { f32x4 a = acc[qi]; const float inv = 1.0f / (xch[2 * NQ + qi] + xch[3 * NQ + qi]);
#pragma unroll
            for (int e = 0; e < 4; ++e) { a[e] = add_x16(a[e]); a[e] = add_x32(a[e]); a[e] *= inv; }
            acc[qi] = a;
            if (half == 1 && sub == 0) *(LAS f32x4*)(xch + 4 * NQ + qi * 64 + 4 * dq) = a; }
        LDS_WAIT(); asm volatile("" ::: "memory");
        __syncthreads();
        if (half == 0 && sub == 0) {
#pragma unroll
            for (int qi = 0; qi < NQ; ++qi) { const f32x4 o = acc[qi] + *(const LAS f32x4*)(xch + 4 * NQ + qi * 64 + 4 * dq); *(GAS v2u*)(out0 + (size_t)(qi & 3) * ostride_q + (qi >> 2) * 64 + 4 * dq) = pack4(o); } }
    } else __syncthreads();
    LDS_WAIT(); asm volatile("" ::: "memory");
}
__device__ __forceinline__ void memattn_sample_task(Frame& F, int layer, int task, bool valid, LAS float* wl, LAS float* xch) {
    int lane_ = F.lane; asm volatile("" : "+v"(lane_)); const int lane = lane_, b = task >> 2, hm = task & 3; LAS float* ql = wl; LAS float* sc = wl + 12 * 64;
    if (valid) {
#pragma unroll
        for (int i = 0; i < 4; ++i) { const int row = RP + b * ST + i; float x;
            if (layer == 0) { x = bf2f(((const bf16*)(F.ws + WS_PROJ))[(size_t)row * NCOLA + RWKV_COLS + hm * 64 + lane]); const float ss = wave_sum(x * x); x *= rsqrtf(ss * (1.0f / 64.0f) + 1e-6f) * C2Q * F.in[I_MQN][lane]; }
            else x = bf2f(((const bf16*)(F.ws + WS_Q1))[(size_t)row * DM + 768 + hm * 64 + lane]);
            ql[i * 64 + lane] = x; }
        LDS_WAIT(); asm volatile("" ::: "memory"); }
    const float* k1 = F.in[I_CMK] + (((size_t)layer * SB + b) * NMEM * 4 + hm) * 64; const float* v1 = F.in[I_CMV] + (((size_t)layer * SB + b) * NMEM * 4 + hm) * 64;
    small_attn2<4, false>(valid, F.wave & 1, ql, sc, xch, 264, k1, v1, 256, 256, nullptr, nullptr, 0, 0, nullptr, (bf16*)(F.ws + WS_MIX) + (size_t)(RP + b * ST) * DM + 768 + hm * 64, DM, lane);
}
__device__ __forceinline__ void swa_sample_task(Frame& F, int task, bool valid, LAS float* wl, LAS float* xch) {
    int lane_ = F.lane; asm volatile("" : "+v"(lane_)); const int lane = lane_, b = task >> 2, kvh = task & 3; LAS float* ql = wl; LAS float* sc = wl + 12 * 64;
    if (valid) {
#pragma unroll
        for (int qi = 0; qi < 12; ++qi) { const int i = qi & 3, gq = qi >> 2, hq = kvh * 3 + gq; const int row = RP + b * ST + i;
            ql[qi * 64 + lane] = bf2f(((const bf16*)(F.ws + WS_Q1))[(size_t)row * DM + hq * 64 + lane]); }
        LDS_WAIT(); asm volatile("" ::: "memory"); }
    const float* k1 = F.in[I_CSK] + ((size_t)b * 128 * 4 + kvh) * 64; const float* v1 = F.in[I_CSV] + ((size_t)b * 128 * 4 + kvh) * 64;
    const bf16* k2 = (const bf16*)(F.ws + WS_K1) + (size_t)(RP + b * ST) * 256 + kvh * 64; const bf16* v2 = (const bf16*)(F.ws + WS_V1) + (size_t)(RP + b * ST) * 256 + kvh * 64;
    small_attn2<12, true>(valid, F.wave & 1, ql, sc, xch, 136, k1, v1, 256, 128, k2, v2, 256, 4, F.in[I_SINKS] + kvh * 3, (bf16*)(F.ws + WS_MIX) + (size_t)(RP + b * ST) * DM + kvh * 3 * 64, DM, lane);
}

constexpr int N_PHASES = 13;
template <int PM> __global__ void __launch_bounds__(NWAVES * 64, 2) yoco_fwd(Args args) {
    extern __shared__ __attribute__((aligned(16))) unsigned char lds[];
    Frame F;
    F.lds = (LAS unsigned char*)lds; F.lds_g = lds;
    F.wave = __builtin_amdgcn_readfirstlane((int)threadIdx.x >> 6); F.lane = mk_lane(); F.tid = F.wave * 64 + F.lane;
    F.G = gridDim.x; { const int bx = blockIdx.x; F.vcu = (F.G % 8 == 0) ? (bx % 8) * (F.G / 8) + bx / 8 : bx; }
    F.in = args.in; F.out = args.out; F.ws = args.ws; F.ctl = (gu32*)(args.ws + WS_CTL);
    for (int u = F.tid; u < (LDS_BYTES - LDSCTL_OFF) / 4; u += NWAVES * 64) ((LAS unsigned*)(F.lds + LDSCTL_OFF))[u] = 0u;
    __syncthreads();
    const int lo = args.ph_lo, hi = args.ph_hi;
    XcdBarrier bar; bar.wave0 = F.wave == 0; bar.bar = (unsigned*)(F.ctl + CW_BAR); bar.x = 0; bar.st = nullptr;
    bar = xcd_barrier_post((unsigned*)(F.ctl + CW_BAR), (volatile LAS unsigned*)(F.lds + MISC_OFF) + 8, F.wave == 0);
#define IN(k) (((PM >> (k)) & 1) && lo <= (k) && (k) < hi)
#ifndef MK_DUP
#define MK_DUP -1
#endif
#define PH_REP(k) ((MK_DUP == (k)) ? 2 : 1)
#ifndef MK_TIME
#define MK_TIME -1
#endif
#define STAMP(k) do { if (MK_TIME >= 0 && blockIdx.x == 0 && F.wave == 0 && mk_lane() == 0) ((volatile LAS unsigned long long*)(F.lds + LDSCTL_OFF + 512))[(k)] = __builtin_amdgcn_s_memrealtime(); } while (0)
#define SEAM(k) do { if (IN(k) && IN((k) + 1)) xcd_barrier(bar); STAMP((k) + 1); } while (0)
    const int gw = F.vcu * NWAVES + F.wave, NGW = F.G * NWAVES;
    STAMP(0);
#define SSQ ((float*)(F.ws + WS_SSQ))
#define HB ((bf16*)(F.ws + WS_HB))
#define MIX ((bf16*)(F.ws + WS_MIX))
#define HH ((bf16*)(F.ws + WS_H))
#define PHASE_BEGIN() do { int z_ = 0; unsigned char* ws_ = args.ws; float* out_ = args.out; asm volatile("" : "+s"(z_), "+s"(ws_), "+s"(out_)); F.in = args.in + z_; F.ws = ws_; F.out = out_; \
                           F.lane = mk_lane(); F.tid = F.wave * 64 + F.lane; } while (0)

    if (IN(0)) for (int rep_ = 0; rep_ < PH_REP(0); ++rep_) { PHASE_BEGIN(); p0_prologue(F); } SEAM(0);

    if (IN(1)) for (int rep_ = 0; rep_ < PH_REP(1); ++rep_) { PHASE_BEGIN();
#ifndef NO_MEMKV
        { pg8::Gemm g{(const bf16*)(F.ws + WS_MB), (const bf16*)(F.ws + WS_WM), 512, 1024, DM}; pg8::StaticOrder S; S.init(512, 1024, F.G, (int)((blockIdx.x + 8) % F.G), DM);
          pg8::EpiMemKV E{F.ws, F.out, F.in[I_MKN]};
          pg8::gemm_phase<pg8::EpiMemKV, pg8::StaticOrder, true, true>(F.lds + RING_OFF, g, S, E, F.wave, F.lane); }
#endif
        { pg8::Gemm g{HB, (const bf16*)(F.ws + WS_WA), R, NCOLA, DM}; pg8::StaticOrder S; S.init(R, NCOLA, F.G, (int)blockIdx.x, DM);
          pg8::EpiScaleBf16<0> E{(bf16*)(F.ws + WS_PROJ), NCOLA, SSQ};
          pg8::gemm_phase<pg8::EpiScaleBf16<0>, pg8::StaticOrder, true, true>(F.lds + RING_OFF, g, S, E, F.wave, F.lane); }
    } SEAM(1);

    if (IN(2)) for (int rep_ = 0; rep_ < ((MK_DUP == 2 || (MK_DUP >= 20 && MK_DUP < 30)) ? 2 : 1); ++rep_) { PHASE_BEGIN();
        const int half = F.wave >> 2; const int gw = F.vcu * NWAVES + F.wave, NGW = F.G * NWAVES;
        LAS unsigned char* hb = F.lds + half * PREP_HALF; LAS float* wtot = (LAS float*)(F.lds + WTOT_OFF + half * 1024);
        const int slim = (rep_ == 1 && MK_DUP == 21) ? 3 : (rep_ == 1 && MK_DUP == 22) ? 5 : 99;
        if (!(rep_ == 1 && MK_DUP == 20)) { LAS unsigned char* prow = F.lds + WTOT_OFF + 2048 + half * 512; PrepPf pf; if (F.vcu < NUNIT / 2) prep_issue(F, 2 * F.vcu + half, pf);
            for (int pi = F.vcu; pi < NUNIT / 2; pi += F.G) rwkv_prep_unit(F, 2 * pi + half, hb, wtot, prow, pf, pi + F.G < NUNIT / 2, 2 * (pi + F.G) + half, slim); }
        STAMP(14);
        if (!(rep_ == 1 && (MK_DUP == 21 || MK_DUP == 22))) for (int t = gw; t < SB * NH + 2; t += NGW) {
            if (t < SB * NH) rwkv_sample_task(F, t);
            else { const int b = t - SB * NH; const bf16* lr = (const bf16*)(F.ws + WS_PROJ) + (size_t)(b * T + T - 1) * NCOLA; float* o = F.out + O_PSHIFT + (size_t)b * RWKV_COLS;
                for (int q = F.lane; q < RWKV_COLS; q += 64) o[q] = bf2f(lr[q]); } }
        { const int nsw = (SB * NH + 2 + NWAVES - 1) / NWAVES;
          if (rep_ == 0 && F.vcu >= nsw && F.G > nsw) { __syncthreads(); p0_weights(F, 1, (F.vcu - nsw) * NWAVES + F.wave, (F.G - nsw) * NWAVES, (LAS float*)(F.lds + F.wave * 16384)); }
          else if (rep_ == 0 && F.G <= nsw) { __syncthreads(); p0_weights(F, 1, gw, NGW, (LAS float*)(F.lds + F.wave * 16384)); } }
    } SEAM(2);

    if (IN(3)) for (int rep_ = 0; rep_ < ((MK_DUP == 30 || MK_DUP == 31) ? 2 : 1); ++rep_) { PHASE_BEGIN();
        const int nscan = NB * NH * 4;
        const int nconv = (F.G - nscan) * NWAVES + nscan * 7;
        if (F.vcu < nscan) { if (rep_ == 0 || MK_DUP == 31) { rwkv_scan_chain(F, F.vcu >> 2, F.vcu & 3); if (F.wave == 0) STAMP(23); } }
        else if (rep_ == 0 || MK_DUP == 30) { LAS float* wl = (LAS float*)(F.lds + F.wave * 12288);
            for (int u = F.vcu - nscan; u < 256; u += F.G - nscan) memattn_prompt_unit(F, 0, u);
            __syncthreads();
            { LAS float* xch = (LAS float*)(F.lds + 8 * 12288) + (F.wave >> 1) * 1024; const int nwg = F.G - nscan, wgi = F.vcu - nscan;
              for (int it = 0; it * nwg * 4 < 512; ++it) { const int t = (it * nwg + wgi) * 4 + (F.wave >> 1); memattn_sample_task(F, 0, t, t < 512, wl, xch); } }
            }
    } SEAM(3);

    if (IN(4)) for (int rep_ = 0; rep_ < PH_REP(4); ++rep_) { PHASE_BEGIN(); if (rep_ == 0) copy_window_cache(F, gw * 64 + F.lane, NGW * 64);
        _Pragma("unroll 2") for (int it = gw; it < NUNIT * 4; it += NGW) rwkv_yout_item(F, it); } SEAM(4); if (MK_DUP == 40) for (int i_ = 0; i_ < 10; ++i_) xcd_barrier(bar);

    if (IN(5)) for (int rep_ = 0; rep_ < PH_REP(5); ++rep_) { PHASE_BEGIN(); pg8::Gemm g{MIX, (const bf16*)(F.ws + WS_WOUT), R, DM, DM}; pg8::TailOrder S; S.init(F.G, (int)blockIdx.x, DM, S_K1);
        pg8::EpiResid E{F.in[I_XP], F.in[I_XS], RP, nullptr, HB, SSQ, (float*)(F.ws + WS_SLAB), S_K1};
        pg8::gemm_phase<pg8::EpiResid, pg8::TailOrder, true, true>(F.lds + RING_OFF, g, S, E, F.wave, F.lane); } SEAM(5);
    if (IN(6)) for (int rep_ = 0; rep_ < PH_REP(6); ++rep_) { PHASE_BEGIN(); finalize_sample(F, F.in[I_XS], S_K1, false); xcd_barrier(bar);
        pg8::Gemm g{HB, (const bf16*)(F.ws + WS_WUP), R, FF, DM}; pg8::StaticOrder S; S.init(R, FF, F.G, (int)blockIdx.x, DM);
        pg8::EpiScaleBf16<1> E{HH, FF, SSQ};
        pg8::gemm_phase<pg8::EpiScaleBf16<1>, pg8::StaticOrder, true, true>(F.lds + RING_OFF, g, S, E, F.wave, F.lane); } SEAM(6);
    if (IN(7)) { PHASE_BEGIN(); pg8::Gemm g{HH, (const bf16*)(F.ws + WS_WDN), R, DM, FF}; pg8::TailOrder S; S.init(F.G, (int)blockIdx.x, FF, S_K4);
        pg8::EpiResid E{nullptr, nullptr, RP, nullptr, HB, SSQ, (float*)(F.ws + WS_SLAB), S_K4, HB};
        pg8::gemm_phase<pg8::EpiResid, pg8::TailOrder, true, true>(F.lds + RING_OFF, g, S, E, F.wave, F.lane); } SEAM(7);

    if (IN(8)) for (int rep_ = 0; rep_ < PH_REP(8); ++rep_) { PHASE_BEGIN(); finalize_sample(F, nullptr, S_K4, false); xcd_barrier(bar);
        pg8::Gemm g{HB, (const bf16*)(F.ws + WS_WB), R, NCOLB, DM}; pg8::StaticOrder S; S.init(R, NCOLB, F.G, (int)blockIdx.x, DM);
        pg8::EpiL1 E{F.ws, F.out, F.in[I_QN], F.in[I_MQN] + 64, F.in[I_KN]};
        pg8::gemm_phase<pg8::EpiL1, pg8::StaticOrder, true, true>(F.lds + RING_OFF, g, S, E, F.wave, F.lane); } SEAM(8);

    if (IN(9)) for (int rep_ = 0; rep_ < PH_REP(9); ++rep_) { PHASE_BEGIN(); LAS float* wl = (LAS float*)(F.lds + F.wave * 12288); const int gw = F.vcu * NWAVES + F.wave, NGW = F.G * NWAVES;
        for (int u = F.vcu; u < 256; u += F.G) swa_prompt_unit(F, u);
        for (int u = F.vcu; u < 256; u += F.G) memattn_prompt_unit(F, 1, u);
        __syncthreads();
        { LAS float* xch = (LAS float*)(F.lds + 8 * 12288) + (F.wave >> 1) * 1024;
          for (int it = 0; it * F.G * 4 < 1024; ++it) { const int t = (it * F.G + F.vcu) * 4 + (F.wave >> 1);
              if (it * F.G * 4 < 512) { if (t < 512) swa_sample_task(F, t, true, wl, xch); else memattn_sample_task(F, 1, t - 512, t < 1024, wl, xch); }
              else memattn_sample_task(F, 1, t - 512, t < 1024, wl, xch); } }
    } SEAM(9);

    if (IN(10)) for (int rep_ = 0; rep_ < PH_REP(10); ++rep_) { PHASE_BEGIN(); pg8::Gemm g{MIX, (const bf16*)(F.ws + WS_WOUT) + (size_t)DM * DM, R, DM, DM}; pg8::TailOrder S; S.init(F.G, (int)blockIdx.x, DM, S_K1);
        pg8::EpiResid E{nullptr, nullptr, RP, nullptr, HB, SSQ, (float*)(F.ws + WS_SLAB), S_K1, HB};
        pg8::gemm_phase<pg8::EpiResid, pg8::TailOrder, true, true>(F.lds + RING_OFF, g, S, E, F.wave, F.lane); } SEAM(10);
    if (IN(11)) for (int rep_ = 0; rep_ < PH_REP(11); ++rep_) { PHASE_BEGIN(); finalize_sample(F, nullptr, S_K1, false); xcd_barrier(bar);
        pg8::Gemm g{HB, (const bf16*)(F.ws + WS_WUP) + (size_t)DM * FF, R, FF, DM}; pg8::StaticOrder S; S.init(R, FF, F.G, (int)blockIdx.x, DM);
        pg8::EpiScaleBf16<1> E{HH, FF, SSQ};
        pg8::gemm_phase<pg8::EpiScaleBf16<1>, pg8::StaticOrder, true, true>(F.lds + RING_OFF, g, S, E, F.wave, F.lane); } SEAM(11);
    if (IN(12)) for (int rep_ = 0; rep_ < PH_REP(12); ++rep_) { PHASE_BEGIN(); pg8::Gemm g{HH, (const bf16*)(F.ws + WS_WDN) + (size_t)DM * FF, R, DM, FF}; pg8::TailOrder S; S.init(F.G, (int)blockIdx.x, FF, S_K4);
        pg8::EpiResid E{nullptr, nullptr, RP, F.out + O_Y, nullptr, nullptr, (float*)(F.ws + WS_SLAB), S_K4, HB};
        pg8::gemm_phase<pg8::EpiResid, pg8::TailOrder, true, true>(F.lds + RING_OFF, g, S, E, F.wave, F.lane);
        xcd_barrier(bar); finalize_sample(F, nullptr, S_K4, true); }
    STAMP(13);
    if (MK_TIME >= 0 && blockIdx.x == 0 && F.wave == 0 && mk_lane() == 0) {
        volatile LAS unsigned long long* ts = (volatile LAS unsigned long long*)(F.lds + LDSCTL_OFF + 512); const unsigned long long d = MK_TIME == 20 ? ts[14] - ts[2] : MK_TIME == 21 ? ts[3] - ts[14] : MK_TIME == 22 ? ts[15] - ts[14] : MK_TIME == 36 ? ts[23] - ts[3] : (MK_TIME >= 30 && MK_TIME < 36) ? ts[MK_TIME - 30 + 18] - ts[MK_TIME - 30 + 17] : MK_TIME == 23 ? ts[16] - ts[15] : ts[MK_TIME + 1] - ts[MK_TIME], t0 = __builtin_amdgcn_s_memrealtime();
        while (__builtin_amdgcn_s_memrealtime() - t0 < d) __builtin_amdgcn_s_sleep(8); }
#undef IN
#undef SEAM
#undef SSQ
#undef HB
#undef MIX
#undef HH
#undef PHASE_BEGIN
}

template <int PM> static void launch_pm(int grid, hipStream_t stream, const Args& a) { hipLaunchKernelGGL(yoco_fwd<PM>, dim3(grid), dim3(NWAVES * 64), LDS_BYTES, stream, a); }
template <int PM> static bool set_lds() { return hipFuncSetAttribute((const void*)yoco_fwd<PM>, hipFuncAttributeMaxDynamicSharedMemorySize, LDS_BYTES) == hipSuccess; }
extern "C" void kernel_launch(void* const* d_in, const int* in_sizes, int n_in, void* d_out, int out_size, void* d_ws, size_t ws_size, hipStream_t stream) {
    static int grid = 0;
    if (grid == 0) {
        if (n_in != N_IN || (size_t)out_size != O_END || ws_size < WS_END) { fprintf(stderr, "kernel_launch: unexpected shapes (n_in %d, out %d, ws %zu < %zu)\n", n_in, out_size, ws_size, (size_t)WS_END); grid = -1; return; }
        int dev = 0, cus = 0;
        if (hipGetDevice(&dev) != hipSuccess || hipDeviceGetAttribute(&cus, hipDeviceAttributeMultiprocessorCount, dev) != hipSuccess) { grid = -1; return; }
        bool ok = true;
#if MK_ONE_LAUNCH
        ok = set_lds<0x1fff>();
#else
        ok = set_lds<1>() && set_lds<2>() && set_lds<4>() && set_lds<8>() && set_lds<16>() && set_lds<32>() && set_lds<64>() && set_lds<128>() && set_lds<256>() && set_lds<512>() && set_lds<1024>() && set_lds<2048>() && set_lds<4096>();
#endif
        if (!ok) { grid = -1; return; }
        (void)hipGetLastError();
        grid = cus;
    }
    if (grid < 0) return;
    (void)hipMemsetAsync((char*)d_ws + WS_CTL, 0, CTL_ZERO_BYTES, stream);
    Args a{};
    for (int i = 0; i < N_IN; ++i) a.in[i] = (const float*)d_in[i];
    a.out = (float*)d_out; a.ws = (unsigned char*)d_ws;
#if MK_ONE_LAUNCH
    a.ph_lo = 0; a.ph_hi = N_PHASES; launch_pm<0x1fff>(grid, stream, a);
#else
#define LP(p) a.ph_lo = (p); a.ph_hi = (p) + 1; launch_pm<(1 << (p))>(grid, stream, a);
    LP(0) LP(1) LP(2) LP(3) LP(4) LP(5) LP(6) LP(7) LP(8) LP(9) LP(10) LP(11) LP(12)
#undef LP
#endif
}
```

```cpp
#include <hip/hip_runtime.h>
#include <cstdio>
#include <cstdint>
namespace pg8 {
#define PG8_LAS __attribute__((address_space(3)))
typedef unsigned short bf16_t;
typedef short bf16x8 __attribute__((ext_vector_type(8)));
typedef float f32x4 __attribute__((ext_vector_type(4)));
typedef unsigned u32x4 __attribute__((ext_vector_type(4)));
constexpr int BM = 256, BK = 64, HALF = 128, HTB = HALF * BK * 2  , STAGE_BYTES = 8 * HTB, NXCD = 8, WGM = 8;

__host__ __device__ __forceinline__ int lds_byte(int r, int c) { const int st = (r >> 4) * 2 + (c >> 5), rr = r & 15, cc = c & 31, ob = rr * 64 + cc * 2; return st * 1024 + (ob ^ (((ob >> 9) & 1) << 5)); }
__host__ __device__ __forceinline__ void stage_rc(int b, int& R, int& C) { const int st = b / 1024, sb = b % 1024, swz = sb ^ (((sb >> 9) & 1) << 5); R = (st >> 1) * 16 + swz / 64; C = (st & 1) * 32 + (swz % 64) / 2; }
__host__ __device__ __forceinline__ int perm32(int rho) { const int n = rho >> 4, i = rho & 15; return 8 * (i >> 2) + 4 * n + (i & 3); }

struct Unit { int pm, pn, kt0, nt; };
struct Gemm { const bf16_t* A; const bf16_t* Bt; int M, N, K; };

struct StaticOrder {
    int nM, nN, nwg, G, c, ntf;
    __host__ __device__ void init(int M, int N, int G_, int c_, int K_) { nM = M / BM; nN = N / BM; nwg = nM * nN; G = G_; c = c_; ntf = K_ / BK; }
    __host__ __device__ bool next(int i, Unit& u) const {
        const long L = (long)i * G + c; if (L >= nwg) return false;
        int wgid = (int)L; { const int q = nwg / NXCD, r = nwg % NXCD, xcd = wgid % NXCD, off = wgid / NXCD; wgid = (xcd < r ? xcd * (q + 1) : r * (q + 1) + (xcd - r) * q) + off; }
        const int nig = WGM * nN, gid = wgid / nig, fm = gid * WGM, gsz = (nM - fm) < WGM ? (nM - fm) : WGM;
        u.pm = fm + ((wgid % nig) % gsz); u.pn = (wgid % nig) / gsz; u.kt0 = 0; u.nt = ntf; return true;
    }
    __device__ __forceinline__ void a_ready(const Unit&) const {}
    __device__ __forceinline__ void done(const Unit&) const {}
};
struct TailOrder {
    StaticOrder P; int S, ntf;
    __host__ __device__ void init(int G_, int c_, int K_, int S_) { P.init(64 * BM, 4 * BM, G_, c_, K_); S = S_; ntf = K_ / BK; }
    __host__ __device__ bool next(int i, Unit& u) const {
        const long L = (long)i * P.G + P.c; if (L >= 256 + 8 * S) return false;
        const int Li = (int)L; const bool prm = Li < 256;
        const int w0 = prm ? Li : 0, wg = (w0 % NXCD) * (256 / NXCD) + w0 / NXCD, nig = WGM * 4, gid = wg / nig, fm = gid * WGM;
        const int pmP = fm + ((wg % nig) % WGM), pnP = (wg % nig) / WGM;
        const int Ls = prm ? 0 : Li - 256, tile = Ls / S, sl = Ls % S, nts = ntf / S;
        u.pm = prm ? pmP : 64 + (tile >> 2); u.pn = prm ? pnP : (tile & 3); u.nt = prm ? ntf : nts; u.kt0 = prm ? 0 : sl * nts; return true;
    }
    __device__ __forceinline__ void a_ready(const Unit&) const {}
    __device__ __forceinline__ void done(const Unit&) const {}
};


typedef float f32x2_t __attribute__((ext_vector_type(2))); typedef __bf16 bf16x2_t __attribute__((ext_vector_type(2)));
__device__ __forceinline__ unsigned cvt_pk_bf16(float lo, float hi) { f32x2_t v = {lo, hi}; bf16x2_t b = __builtin_convertvector(v, bf16x2_t); return __builtin_bit_cast(unsigned, b); }
__device__ __forceinline__ u32x4 pack8(f32x4 v0, f32x4 v1) { u32x4 w; w.x = cvt_pk_bf16(v0[0], v0[1]); w.y = cvt_pk_bf16(v0[2], v0[3]); w.z = cvt_pk_bf16(v1[0], v1[1]); w.w = cvt_pk_bf16(v1[2], v1[3]); return w; }

template <int M> __device__ __forceinline__ float swz_xor(float v) { return __int_as_float(__builtin_amdgcn_ds_swizzle(__float_as_int(v), (M << 10) | 0x1f)); }
__device__ __forceinline__ float add_x32(float v) { auto r = __builtin_amdgcn_permlane32_swap(__float_as_uint(v), __float_as_uint(v), false, false); return __uint_as_float(r[0]) + __uint_as_float(r[1]); }
__device__ __forceinline__ float max_x32(float v) { auto r = __builtin_amdgcn_permlane32_swap(__float_as_uint(v), __float_as_uint(v), false, false); return fmaxf(__uint_as_float(r[0]), __uint_as_float(r[1])); }
__device__ __forceinline__ float add_x16(float v) { return v + swz_xor<16>(v); }
template <int CTRL> __device__ __forceinline__ float dpp_mov(float v) { return __int_as_float(__builtin_amdgcn_update_dpp(0, __float_as_int(v), CTRL, 0xf, 0xf, false)); }
__device__ __forceinline__ float sum16_dpp(float v) { v += dpp_mov<0xB1>(v); v += dpp_mov<0x4E>(v); v += dpp_mov<0x141>(v); v += dpp_mov<0x140>(v); return v; }
__device__ __forceinline__ float max16_dpp(float v) { v = fmaxf(v, dpp_mov<0xB1>(v)); v = fmaxf(v, dpp_mov<0x4E>(v)); v = fmaxf(v, dpp_mov<0x141>(v)); v = fmaxf(v, dpp_mov<0x140>(v)); return v; }
__device__ __forceinline__ float sum4_dpp(float v) { v += dpp_mov<0xB1>(v); v += dpp_mov<0x4E>(v); return v; }
__device__ __forceinline__ float hsum4(f32x4 a) { return (a[0] + a[1]) + (a[2] + a[3]); }
__device__ __forceinline__ float row_rstd(const float* ssq, int row) {
    const f32x4* p = (const f32x4*)(ssq + (size_t)row * 16);
    const f32x4 a = p[0], b = p[1], c = p[2], d = p[3];
    const float s = (hsum4(a) + hsum4(b)) + (hsum4(c) + hsum4(d));
    return rsqrtf(s * (1.0f / 1024.0f) + 1e-6f);
}
template <int ACT> struct EpiScaleBf16 {
    static constexpr bool PERM = true, AFTER_DRAIN = false;
    bf16_t* O; int ldc; const float* ssq; const float* ck = nullptr; const float* cv = nullptr; float* ok = nullptr; float* ov = nullptr; int cpy_units = 0;
    __device__ __forceinline__ void operator()(const f32x4 (&acc)[2][2][4][2], const Unit& u, int wr, int wc, int fr_, int fq_) const {
        int fr = fr_, fq = fq_; asm volatile("" : "+v"(fr), "+v"(fq));
        constexpr int per = 124 * 256 / 4, tot = 128 * per;
        f32x4 c0[2], c1[2]; int ci[2] = {-1, -1};
        if (cpy_units > 0) { const int idx = u.pm * (ldc >> 8) + u.pn, lo = (int)((long)tot * idx / cpy_units), hi = (int)((long)tot * (idx + 1) / cpy_units), th = (wr * 4 + wc) * 64 + fq * 16 + fr;
#pragma unroll
            for (int q = 0; q < 2; ++q) { const int i = lo + th + 512 * q; if (i < hi) { ci[q] = i; const int b = i / per, r = i % per;
                c0[q] = ((const f32x4*)(ck + (size_t)b * 128 * 256 + 4 * 256))[r]; c1[q] = ((const f32x4*)(cv + (size_t)b * 128 * 256 + 4 * 256))[r]; } } }
        const int row0 = u.pm * BM + wr * 64 + fr, col0 = u.pn * BM + wc * 32 + 8 * fq;
#pragma unroll
        for (int ai = 0; ai < 2; ++ai)
#pragma unroll
            for (int m = 0; m < 4; ++m) { const int row = row0 + ai * HALF + m * 16; const float rs = row_rstd(ssq, row); bf16_t* rowp = O + (size_t)row * ldc + col0;
#pragma unroll
                for (int bj = 0; bj < 2; ++bj) { f32x4 v0 = acc[ai][bj][m][0] * rs, v1 = acc[ai][bj][m][1] * rs;
                    if (ACT == 1) {
#pragma unroll
                        for (int e = 0; e < 4; ++e) { const float a = fmaxf(v0[e], 0.f), b = fmaxf(v1[e], 0.f); v0[e] = a * a; v1[e] = b * b; } }
                    *(u32x4*)(rowp + bj * HALF) = pack8(v0, v1); } }
        if (cpy_units > 0) {
#pragma unroll
            for (int q = 0; q < 2; ++q) if (ci[q] >= 0) { const int b = ci[q] / per, r = ci[q] % per; ((f32x4*)(ok + (size_t)b * 128 * 256))[r] = c0[q]; ((f32x4*)(ov + (size_t)b * 128 * 256))[r] = c1[q]; } }
    }
};
struct EpiResid {
    static constexpr bool PERM = true, AFTER_DRAIN = false;
    const float* base; const float* base2; int split; float* out; bf16_t* hb; float* ssq_out; float* slab; int S; const bf16_t* hbase = nullptr; int omask = -1;
    __device__ __forceinline__ void operator()(const f32x4 (&acc)[2][2][4][2], const Unit& u, int wr, int wc, int fr_, int fq_) const {
        int fr = fr_, fq = fq_; asm volatile("" : "+v"(fr), "+v"(fq));
        if (slab && u.pm >= 64) {
            float* sp = slab + ((size_t)((((u.pm - 64) << 2) + u.pn) * S + u.kt0 / u.nt) << 16) + (size_t)(wr * 64 + fr) * 256 + wc * 32 + 8 * fq;
#pragma unroll
            for (int ai = 0; ai < 2; ++ai)
#pragma unroll
                for (int m = 0; m < 4; ++m)
#pragma unroll
                    for (int bj = 0; bj < 2; ++bj) { float* p = sp + (size_t)(ai * HALF + m * 16) * 256 + bj * HALF; *(f32x4*)p = acc[ai][bj][m][0]; *(f32x4*)(p + 4) = acc[ai][bj][m][1]; }
            return;
        }
        const int row0 = u.pm * BM + wr * 64 + fr, col0 = u.pn * BM + wc * 32 + 8 * fq;
#pragma unroll
        for (int ai = 0; ai < 2; ++ai)
#pragma unroll
            for (int m = 0; m < 4; ++m) { const int row = row0 + ai * HALF + m * 16;
                const float* bp = (row < split ? base + (size_t)row * 1024 : base2 + (size_t)(row - split) * 1024) + col0;
                float ss = 0.f;
#pragma unroll
                for (int bj = 0; bj < 2; ++bj) { f32x4 b0, b1;
                    if (hbase) { const u32x4 w = *(const u32x4*)(hbase + (size_t)row * 1024 + col0 + bj * HALF);
                        b0 = (f32x4){__uint_as_float(w.x << 16), __uint_as_float(w.x & 0xffff0000u), __uint_as_float(w.y << 16), __uint_as_float(w.y & 0xffff0000u)};
                        b1 = (f32x4){__uint_as_float(w.z << 16), __uint_as_float(w.z & 0xffff0000u), __uint_as_float(w.w << 16), __uint_as_float(w.w & 0xffff0000u)}; }
                    else { b0 = *(const f32x4*)(bp + bj * HALF); b1 = *(const f32x4*)(bp + bj * HALF + 4); }
                    const f32x4 h0 = b0 + acc[ai][bj][m][0], h1 = b1 + acc[ai][bj][m][1];
                    if (out) { float* op = out + (size_t)(row & omask) * 1024 + col0; *(f32x4*)(op + bj * HALF) = h0; *(f32x4*)(op + bj * HALF + 4) = h1; }
                    if (hb) *(u32x4*)(hb + (size_t)row * 1024 + col0 + bj * HALF) = pack8(h0, h1);
                    ss += hsum4(h0 * h0) + hsum4(h1 * h1); }
                if (ssq_out) { ss = add_x16(ss); ss = add_x32(ss); if (fq == 0) ssq_out[(size_t)row * 16 + u.pn * 4 + wc] = ss; }
                if (m == 3) asm volatile("" ::: "memory"); }
    }
};
template <class Epi, class Sched, bool ALIGN_EPI = false, bool SP2 = false>
__device__ __forceinline__ void gemm_phase(PG8_LAS unsigned char* lds, const Gemm g, const Sched& S, const Epi& E, int wid_in, int lane_in) {
    const int wid = wid_in, lane = lane_in, tid = wid * 64 + lane, wr = wid >> 2, wc = wid & 3, fr = lane & 15, fq = lane >> 4;
    const int K = g.K;
    unsigned voffA[2], voffB[2];
#pragma unroll
    for (int i = 0; i < 2; ++i) { int R, C; stage_rc(tid * 16 + i * 8192, R, C); const int Rb = Epi::PERM ? ((R & ~31) + perm32(R & 31)) : R;
        voffA[i] = (unsigned)(R * K + C) * 2u; voffB[i] = (unsigned)(Rb * K + C) * 2u; }
    const size_t kstep = (size_t)(BK * 2);
    const size_t hstep = (size_t)HALF * K * 2;
    const size_t tstep = 2 * hstep;
    const unsigned ldsw = (unsigned)wid * 1024u;
    const int aoff = lds_byte(wr * 64 + fr, fq * 8), boff = lds_byte(wc * 32 + fr, fq * 8);
#define PG8_SA(b, h) (((b) * 2 + (h)) * HTB)
#define PG8_SB(b, h) ((4 + (b) * 2 + (h)) * HTB)
#define PG8_STAGE(bufoff, gbase, voff) do { _Pragma("unroll") for (int _i = 0; _i < 2; ++_i) \
        __builtin_amdgcn_global_load_lds((const unsigned*)((const char*)(gbase) + (voff)[_i]), (PG8_LAS unsigned*)(lds + (bufoff) + ldsw + _i * 8192), 16, 0, 0); } while (0)
#define PG8_LDA(dst, b, h) do { _Pragma("unroll") for (int m = 0; m < 4; ++m) _Pragma("unroll") for (int k = 0; k < 2; ++k) dst[m][k] = *(const PG8_LAS bf16x8*)(lds + PG8_SA(b, h) + aoff + m * 2048 + k * 1024); } while (0)
#define PG8_LDB(dst, b, h) do { _Pragma("unroll") for (int n = 0; n < 2; ++n) _Pragma("unroll") for (int k = 0; k < 2; ++k) dst[n][k] = *(const PG8_LAS bf16x8*)(lds + PG8_SB(b, h) + boff + n * 2048 + k * 1024); } while (0)
#define PG8_MMA(ai, bj, At, Bt) do { __builtin_amdgcn_s_setprio(1); _Pragma("unroll") for (int m = 0; m < 4; ++m) _Pragma("unroll") for (int n = 0; n < 2; ++n) _Pragma("unroll") for (int k = 0; k < 2; ++k) \
        acc[ai][bj][m][n] = __builtin_amdgcn_mfma_f32_16x16x32_bf16(Bt[n][k], At[m][k], acc[ai][bj][m][n], 0, 0, 0); __builtin_amdgcn_s_setprio(0); } while (0)
#define PG8_WAIT_V(n) asm volatile("s_waitcnt vmcnt(" #n ")" ::: "memory")
#define PG8_WAIT_L(n) asm volatile("s_waitcnt lgkmcnt(" #n ")" ::: "memory")
#define PG8_BAR __builtin_amdgcn_s_barrier()
#define PG8_SCHED __builtin_amdgcn_sched_barrier(0)
    Unit cur, nxt; int ui = 0;
    if (!S.next(0, cur)) return;
    f32x4 acc[2][2][4][2];
#pragma unroll
    for (int a = 0; a < 2; ++a)
#pragma unroll
        for (int b = 0; b < 2; ++b)
#pragma unroll
            for (int m = 0; m < 4; ++m)
#pragma unroll
                for (int n = 0; n < 2; ++n) acc[a][b][m][n] = (f32x4){0.f, 0.f, 0.f, 0.f};
    bf16x8 At[4][2], B0[2][2], B1[2][2];
    const char* cA = (const char*)g.A + (size_t)cur.pm * tstep + (size_t)cur.kt0 * kstep; const char* cB = (const char*)g.Bt + (size_t)cur.pn * tstep + (size_t)cur.kt0 * kstep;
    S.a_ready(cur);
    if constexpr (SP2) {
        PG8_STAGE(PG8_SB(0, 0), cB, voffB); PG8_STAGE(PG8_SB(0, 1), cB + hstep, voffB); PG8_STAGE(PG8_SA(0, 0), cA, voffA); PG8_STAGE(PG8_SA(0, 1), cA + hstep, voffA);
        if (wr == 1) PG8_BAR;
        PG8_WAIT_V(2); PG8_BAR;
        PG8_STAGE(PG8_SB(1, 0), cB + kstep, voffB); PG8_STAGE(PG8_SA(1, 0), cA + kstep, voffA); PG8_STAGE(PG8_SB(1, 1), cB + hstep + kstep, voffB);
        PG8_WAIT_V(6); PG8_BAR;
    } else {
        PG8_STAGE(PG8_SB(0, 0), cB, voffB); PG8_STAGE(PG8_SA(0, 0), cA, voffA); PG8_STAGE(PG8_SB(0, 1), cB + hstep, voffB); PG8_STAGE(PG8_SA(0, 1), cA + hstep, voffA);
        if (wr == 1) PG8_BAR;
        PG8_WAIT_V(4); PG8_BAR;
        PG8_STAGE(PG8_SB(1, 0), cB + kstep, voffB); PG8_STAGE(PG8_SA(1, 0), cA + kstep, voffA); PG8_STAGE(PG8_SB(1, 1), cB + hstep + kstep, voffB);
        PG8_WAIT_V(6); PG8_BAR;
    }
    for (;;) {
        const bool has_next = S.next(ui + 1, nxt);
        const char* nA = has_next ? (const char*)g.A + (size_t)nxt.pm * tstep + (size_t)nxt.kt0 * kstep : cA; const char* nB = has_next ? (const char*)g.Bt + (size_t)nxt.pn * tstep + (size_t)nxt.kt0 * kstep : cB;
        const int nt = cur.nt;
        for (int t = 0; t < nt; t += 2) {
            const bool last = (t == nt - 2);
            const char* a1 = cA + (size_t)(t + 1) * kstep;
            const char* a2 = last ? nA : cA + (size_t)(t + 2) * kstep; const char* b2 = last ? nB : cB + (size_t)(t + 2) * kstep;
            const char* a3 = a2 + kstep; const char* b3 = b2 + kstep;
            if (last && has_next) S.a_ready(nxt);
            if constexpr (SP2) {
            PG8_LDB(B0, 0, 0); PG8_LDB(B1, 0, 1); PG8_SCHED; PG8_LDA(At, 0, 0); PG8_STAGE(PG8_SA(1, 1), a1 + hstep, voffA);
            PG8_WAIT_V(8); PG8_WAIT_L(0); PG8_BAR; PG8_MMA(0, 0, At, B0); PG8_MMA(0, 1, At, B1); PG8_BAR; PG8_SCHED;
            PG8_LDA(At, 0, 1); PG8_STAGE(PG8_SB(0, 0), b2, voffB); PG8_STAGE(PG8_SB(0, 1), b2 + hstep, voffB); PG8_STAGE(PG8_SA(0, 0), a2, voffA);
            PG8_WAIT_V(8); PG8_WAIT_L(0); PG8_BAR; PG8_MMA(1, 0, At, B0); PG8_MMA(1, 1, At, B1); PG8_BAR; PG8_SCHED;
            PG8_LDB(B0, 1, 0); PG8_LDB(B1, 1, 1); PG8_SCHED; PG8_LDA(At, 1, 0); PG8_STAGE(PG8_SA(0, 1), a2 + hstep, voffA);
            PG8_WAIT_V(8); PG8_WAIT_L(0); PG8_BAR; PG8_MMA(0, 0, At, B0); PG8_MMA(0, 1, At, B1); PG8_BAR; PG8_SCHED;
            PG8_LDA(At, 1, 1); PG8_STAGE(PG8_SB(1, 0), b3, voffB); PG8_STAGE(PG8_SB(1, 1), b3 + hstep, voffB); PG8_STAGE(PG8_SA(1, 0), a3, voffA);
            PG8_WAIT_V(8); PG8_WAIT_L(0); PG8_BAR; PG8_MMA(1, 0, At, B0); PG8_MMA(1, 1, At, B1); PG8_BAR; PG8_SCHED;
            } else {
            PG8_LDB(B0, 0, 0); PG8_SCHED; PG8_LDA(At, 0, 0); PG8_STAGE(PG8_SA(1, 1), a1 + hstep, voffA);
            PG8_WAIT_L(8); PG8_BAR; PG8_WAIT_L(0); PG8_MMA(0, 0, At, B0); PG8_BAR; PG8_SCHED;
            PG8_LDB(B1, 0, 1); PG8_STAGE(PG8_SB(0, 0), b2, voffB);
            PG8_BAR; PG8_WAIT_L(0); PG8_MMA(0, 1, At, B1); PG8_BAR;
            PG8_LDA(At, 0, 1); PG8_STAGE(PG8_SA(0, 0), a2, voffA);
            PG8_BAR; PG8_WAIT_L(0); PG8_MMA(1, 0, At, B0); PG8_BAR; PG8_SCHED;
            PG8_STAGE(PG8_SB(0, 1), b2 + hstep, voffB);
            PG8_WAIT_V(6); PG8_BAR; PG8_MMA(1, 1, At, B1); PG8_BAR;
            PG8_LDB(B0, 1, 0); PG8_SCHED; PG8_LDA(At, 1, 0); PG8_STAGE(PG8_SA(0, 1), a2 + hstep, voffA);
            PG8_WAIT_L(8); PG8_BAR; PG8_WAIT_L(0); PG8_MMA(0, 0, At, B0); PG8_BAR; PG8_SCHED;
            PG8_LDB(B1, 1, 1); PG8_STAGE(PG8_SB(1, 0), b3, voffB);
            PG8_BAR; PG8_WAIT_L(0); PG8_MMA(0, 1, At, B1); PG8_BAR;
            PG8_LDA(At, 1, 1); PG8_STAGE(PG8_SA(1, 0), a3, voffA);
            PG8_BAR; PG8_WAIT_L(0); PG8_MMA(1, 0, At, B0); PG8_BAR; PG8_SCHED;
            PG8_STAGE(PG8_SB(1, 1), b3 + hstep, voffB);
            PG8_WAIT_V(6); PG8_BAR; PG8_MMA(1, 1, At, B1); PG8_BAR;
            }
        }
        if constexpr (ALIGN_EPI) { if (wr == 0) PG8_BAR; }
        if constexpr (!Epi::AFTER_DRAIN) { E(acc, cur, wr, wc, fr, fq); S.done(cur); }
        if (!has_next) break;
#pragma unroll
        for (int a = 0; a < 2; ++a)
#pragma unroll
            for (int b = 0; b < 2; ++b)
#pragma unroll
                for (int m = 0; m < 4; ++m)
#pragma unroll
                    for (int n = 0; n < 2; ++n) acc[a][b][m][n] = (f32x4){0.f, 0.f, 0.f, 0.f};
        cur = nxt; cA = nA; cB = nB; ++ui;
        if constexpr (ALIGN_EPI) { if (wr == 1) PG8_BAR; }
    }
    PG8_WAIT_V(0);
    if constexpr (!ALIGN_EPI) { if (wr == 0) PG8_BAR; }
    PG8_BAR;
    if constexpr (Epi::AFTER_DRAIN) { E.fused(acc, cur, wr, wc, fr, fq, lds, wid, lane); S.done(cur); }
#undef PG8_SA
#undef PG8_SB
#undef PG8_STAGE
#undef PG8_LDA
#undef PG8_LDB
#undef PG8_MMA
#undef PG8_WAIT_V
#undef PG8_WAIT_L
#undef PG8_BAR
#undef PG8_SCHED
}
}

constexpr int NWAVES = 8;
#ifndef MK_ONE_LAUNCH
#define MK_ONE_LAUNCH 1
#endif
constexpr int DM = 1024, RP = 16384  , RS = 512  , R = RP + RS, T = 8192, NB = 2, SB = 128, ST = 4;
constexpr int NCOLA = 2816, RWKV_COLS = 2560, NH = 12, HD = 64, FF = 4096, NCOLB = 1536, NMEM = 256;
constexpr int NCHUNK = RP / 64  , NUNIT = NCHUNK * NH  ;
constexpr float C2Q = 0.125f * 1.4426950408889634f;
constexpr float LOG2E = 1.4426950408889634f;
enum { I_XP = 0, I_XS, I_SSHIFT, I_SWKV, I_CSK, I_CSV, I_CMK, I_CMV, I_MEMP, I_NMIX, I_NMLP, I_WOUT, I_WUP, I_WDN, I_MNORM, I_WMKV, I_MQN, I_MKN,
       I_WINA, I_MU, I_WW2, I_W0, I_WA2, I_A0, I_WG2, I_KK, I_KA, I_RK, I_LNW, I_LNB, I_WINB, I_QN, I_SINKS, I_KVN, I_WKV, I_KN, N_IN };
constexpr size_t O_Y = 0, O_PSHIFT = (size_t)R * DM, O_PWKV = O_PSHIFT + 2 * RWKV_COLS, O_PSK = O_PWKV + 2 * 12 * 4096, O_PSV = O_PSK + 2 * 128 * 256,
                 O_PMK = O_PSV + 2 * 128 * 256, O_PMV = O_PMK + 2 * 2 * 256 * 256, O_SSHIFT = O_PMV + 2 * 2 * 256 * 256, O_SWKV = O_SSHIFT + (size_t)SB * RWKV_COLS,
                 O_SSK = O_SWKV + (size_t)SB * 12 * 4096, O_SSV = O_SSK + (size_t)SB * 128 * 256, O_END = O_SSV + (size_t)SB * 128 * 256;
constexpr size_t al256(size_t x) { return (x + 255) & ~(size_t)255; }
constexpr size_t WS_CTL = 0, CTL_ZERO_BYTES = 1u << 15;
constexpr size_t WS_WA = 1u << 20;
constexpr size_t WS_WOUT = WS_WA + (size_t)NCOLA * DM * 2;
constexpr size_t WS_WUP = WS_WOUT + (size_t)2 * DM * DM * 2;
constexpr size_t WS_WDN = WS_WUP + (size_t)2 * FF * DM * 2;
constexpr size_t WS_WB = WS_WDN + (size_t)2 * FF * DM * 2;
constexpr size_t WS_WM = WS_WB + (size_t)NCOLB * DM * 2;
constexpr size_t WS_WW2 = WS_WM + (size_t)DM * DM * 2;
constexpr size_t WS_WA2 = WS_WW2 + (size_t)768 * 64 * 2;
constexpr size_t WS_WG2 = WS_WA2 + (size_t)768 * 64 * 2;
constexpr size_t WS_ROPE = WS_WG2 + (size_t)768 * 128 * 2;
constexpr size_t WS_SSQ = al256(WS_ROPE + (size_t)8196 * 64 * 4);
constexpr size_t WS_SSQM = WS_SSQ + (size_t)R * 16 * 4;
constexpr size_t WS_MB = WS_SSQM + (size_t)512 * 16 * 4;
constexpr size_t WS_MK = WS_MB + (size_t)512 * DM * 2;
constexpr size_t WS_MVT = WS_MK + (size_t)2 * 2 * 4 * 256 * 64 * 2;
constexpr size_t WS_HB = WS_MVT + (size_t)2 * 2 * 4 * 256 * 64 * 2;
constexpr size_t WS_MIX = WS_HB + (size_t)R * DM * 2;
constexpr size_t WS_BIG = WS_MIX + (size_t)R * DM * 2;
constexpr size_t WS_PROJ = WS_BIG;
constexpr size_t WS_REC = WS_PROJ + (size_t)R * NCOLA * 2;
constexpr size_t REC_BYTES = 5 * 8192;
constexpr size_t WS_END0 = WS_REC + (size_t)NUNIT * REC_BYTES;
constexpr size_t WS_H = WS_BIG;
constexpr size_t WS_END1 = WS_H + (size_t)R * FF * 2;
constexpr size_t WS_SLAB = WS_BIG + ((size_t)160 << 20);
constexpr int S_K1 = 4, S_K4 = 16;
constexpr size_t WS_Q1 = WS_BIG;
constexpr size_t WS_K1 = WS_Q1 + (size_t)R * DM * 2;
constexpr size_t WS_V1 = WS_K1 + (size_t)R * 256 * 2;
constexpr size_t WS_VT1 = WS_V1 + (size_t)R * 256 * 2;
constexpr size_t WS_END = WS_END0 > WS_END1 ? WS_END0 : WS_END1;
static_assert(WS_VT1 + (size_t)2 * 4 * 64 * 8192 * 2 <= WS_END && WS_END1 <= WS_SLAB && WS_SLAB + ((size_t)32 << 20) <= WS_END, "ws map");
constexpr int CW_BAR = 4096;
constexpr int RING_OFF = 0, RING_BYTES = 131072, PREP_HALF = 73728, LDSCTL_OFF = 147456, MISC_OFF = LDSCTL_OFF + 320, WTOT_OFF = LDSCTL_OFF + 1024, LDS_BYTES = LDSCTL_OFF + 4096;

#define GAS __attribute__((address_space(1)))
#define LAS __attribute__((address_space(3)))
typedef unsigned short bf16;
typedef unsigned v4u __attribute__((ext_vector_type(4)));
typedef unsigned v2u __attribute__((ext_vector_type(2)));
typedef float f32x4 __attribute__((ext_vector_type(4)));
typedef float f32x16 __attribute__((ext_vector_type(16)));
typedef short bf16x8 __attribute__((ext_vector_type(8)));
typedef short bf16x4 __attribute__((ext_vector_type(4)));
typedef GAS unsigned gu32;
#define RLX_AGENT __ATOMIC_RELAXED, __HIP_MEMORY_SCOPE_AGENT
#define LDS_WAIT() asm volatile("s_waitcnt lgkmcnt(0)" ::: "memory")
#define VM_WAIT() asm volatile("s_waitcnt vmcnt(0)" ::: "memory")
using pg8::cvt_pk_bf16;
__device__ __forceinline__ int mk_lane() { int l; asm volatile("v_mbcnt_lo_u32_b32 %0, -1, 0\n\tv_mbcnt_hi_u32_b32 %0, -1, %0" : "=v"(l)); return l; }
__device__ __forceinline__ float bf2f(unsigned v) { return __uint_as_float(v << 16); }
__device__ __forceinline__ float bflo(unsigned w) { return __uint_as_float(w << 16); }
__device__ __forceinline__ float bfhi(unsigned w) { return __uint_as_float(w & 0xffff0000u); }
__device__ __forceinline__ bf16 f2bf(float f) { return (bf16)(cvt_pk_bf16(f, 0.f) & 0xffffu); }
__device__ __forceinline__ v2u pack4(f32x4 v) { v2u w; w.x = cvt_pk_bf16(v[0], v[1]); w.y = cvt_pk_bf16(v[2], v[3]); return w; }
__device__ __forceinline__ f32x4 unpack4(v2u w) { return (f32x4){bflo(w.x), bfhi(w.x), bflo(w.y), bfhi(w.y)}; }
__device__ __forceinline__ f32x4 mfma16(bf16x8 a, bf16x8 b, f32x4 c) { return __builtin_amdgcn_mfma_f32_16x16x32_bf16(a, b, c, 0, 0, 0); }
__device__ __forceinline__ f32x16 mfma32(bf16x8 a, bf16x8 b, f32x16 c) { return __builtin_amdgcn_mfma_f32_32x32x16_bf16(a, b, c, 0, 0, 0); }
using pg8::swz_xor; using pg8::add_x32; using pg8::max_x32; using pg8::add_x16; using pg8::sum16_dpp; using pg8::max16_dpp; using pg8::sum4_dpp;
__device__ __forceinline__ float sum16(float v) { return sum16_dpp(v); }
__device__ __forceinline__ float wave_sum(float v) { v = sum16_dpp(v); v = add_x16(v); return add_x32(v); }
__device__ __forceinline__ float wave_max(float v) { v = max16_dpp(v); v = fmaxf(v, swz_xor<16>(v)); return max_x32(v); }
__device__ __forceinline__ float fsigmoid(float x) { return __builtin_amdgcn_rcpf(1.0f + __expf(-x)); }
__device__ __forceinline__ float ftanh(float x) { const float e = __expf(2.0f * x); return 1.0f - 2.0f * __builtin_amdgcn_rcpf(e + 1.0f); }
namespace pg8 {
__device__ __forceinline__ void head_norm(f32x4 (&x)[2][2], const float* gain, int fq) {
    float ss = 0.f;
#pragma unroll
    for (int bj = 0; bj < 2; ++bj)
#pragma unroll
        for (int n = 0; n < 2; ++n) ss += hsum4(x[bj][n] * x[bj][n]);
    ss = add_x16(ss); ss = add_x32(ss);
    const float rs = rsqrtf(ss * (1.0f / 64.0f) + 1e-6f);
#pragma unroll
    for (int bj = 0; bj < 2; ++bj)
#pragma unroll
        for (int n = 0; n < 2; ++n) { const f32x4 g = *(const f32x4*)(gain + 32 * bj + 8 * fq + 4 * n); x[bj][n] = x[bj][n] * rs * g; }
}
__device__ __forceinline__ void head_rope(f32x4 (&x)[2][2], const float* cs  , int fq) {
#pragma unroll
    for (int n = 0; n < 2; ++n) { const f32x4 t0 = *(const f32x4*)(cs + 2 * (8 * fq + 4 * n)), t1 = *(const f32x4*)(cs + 2 * (8 * fq + 4 * n) + 4);
        const f32x4 cc = {t0[0], t0[2], t1[0], t1[2]}, sn = {t0[1], t0[3], t1[1], t1[3]};
        const f32x4 x1 = x[0][n], x2 = x[1][n]; x[0][n] = x1 * cc - x2 * sn; x[1][n] = x2 * cc + x1 * sn; }
}
struct EpiL1 {
    static constexpr bool PERM = true, AFTER_DRAIN = false;
    unsigned char* ws; float* outp; const float* g_q; const float* g_mq; const float* g_k;
    __device__ __forceinline__ void operator()(const f32x4 (&acc)[2][2][4][2], const Unit& u, int wr, int wc, int fr_, int fq_) const {
        int fr = fr_, fq = fq_; asm volatile("" : "+v"(fr), "+v"(fq));
        const float* ssq = (const float*)(ws + WS_SSQ); const float* rope = (const float*)(ws + WS_ROPE); const float c2 = C2Q;
        bf16_t* Q1 = (bf16_t*)(ws + WS_Q1); bf16_t* K1 = (bf16_t*)(ws + WS_K1); bf16_t* V1 = (bf16_t*)(ws + WS_V1);
        float* p_k = outp + O_PSK; float* p_v = outp + O_PSV; float* s_k = outp + O_SSK; float* s_v = outp + O_SSV;
        const int H = u.pn * 4 + wc, row0 = u.pm * BM + wr * 64 + fr;
#pragma unroll
        for (int ai = 0; ai < 2; ++ai)
#pragma unroll
            for (int m = 0; m < 4; ++m) { const int row = row0 + ai * HALF + m * 16; const float rs = row_rstd(ssq, row);
                const int pidx = row < 16384 ? (row & 8191) : 8192 + ((row - 16384) & 3);
                f32x4 x[2][2];
#pragma unroll
                for (int bj = 0; bj < 2; ++bj)
#pragma unroll
                    for (int n = 0; n < 2; ++n) x[bj][n] = acc[ai][bj][m][n] * rs;
                if (H < 16) {
                    head_norm(x, H < 12 ? g_q : g_mq, fq);
                    if (H < 12) head_rope(x, rope + (size_t)pidx * 64, fq);
#pragma unroll
                    for (int bj = 0; bj < 2; ++bj) *(u32x4*)(Q1 + (size_t)row * 1024 + H * 64 + 32 * bj + 8 * fq) = pack8(x[bj][0] * c2, x[bj][1] * c2);
                } else {
                    const int kh = (H - 16) & 3; const bool isk = H < 20;
                    if (isk) { head_norm(x, g_k, fq); head_rope(x, rope + (size_t)pidx * 64, fq); }
                    bf16_t* dst = isk ? K1 : V1;
#pragma unroll
                    for (int bj = 0; bj < 2; ++bj) *(u32x4*)(dst + (size_t)row * 256 + kh * 64 + 32 * bj + 8 * fq) = pack8(x[bj][0], x[bj][1]);
                    float* o = nullptr;
                    if (row < 16384) { const int b = row >> 13, t = row & 8191; if (t >= 8064) o = (isk ? p_k : p_v) + ((size_t)(b * 128 + (t - 8064)) * 4 + kh) * 64; }
                    else { const int b = (row - 16384) >> 2, i = (row - 16384) & 3; o = (isk ? s_k : s_v) + ((size_t)(b * 128 + 124 + i) * 4 + kh) * 64; }
                    if (o) {
#pragma unroll
                        for (int bj = 0; bj < 2; ++bj) { *(f32x4*)(o + 32 * bj + 8 * fq) = x[bj][0]; *(f32x4*)(o + 32 * bj + 8 * fq + 4) = x[bj][1]; } }
                }
                if (m == 3) asm volatile("" ::: "memory");
            }
    }
};
struct EpiMemKV {
    static constexpr bool PERM = true, AFTER_DRAIN = false;
    unsigned char* ws; float* outp; const float* g_k  ;
    __device__ __forceinline__ void operator()(const f32x4 (&acc)[2][2][4][2], const Unit& u, int wr, int wc, int fr_, int fq_) const {
        int fr = fr_, fq = fq_; asm volatile("" : "+v"(fr), "+v"(fq));
        const float* ssq = (const float*)(ws + WS_SSQM); float* p_k = outp + O_PMK; float* p_v = outp + O_PMV; bf16_t* MK = (bf16_t*)(ws + WS_MK)  ; bf16_t* MVT = (bf16_t*)(ws + WS_MVT)  ;
        const int H = u.pn * 4 + wc, l = H >> 3, isv = (H >> 2) & 1, hh = H & 3, row0 = u.pm * BM + wr * 64 + fr;
#pragma unroll
        for (int ai = 0; ai < 2; ++ai)
#pragma unroll
            for (int m = 0; m < 4; ++m) { const int row = row0 + ai * HALF + m * 16; const float rs = row_rstd(ssq, row); const int b = row >> 8, mm = row & 255;
                f32x4 x[2][2];
#pragma unroll
                for (int bj = 0; bj < 2; ++bj)
#pragma unroll
                    for (int n = 0; n < 2; ++n) x[bj][n] = acc[ai][bj][m][n] * rs;
                if (!isv) head_norm(x, g_k + l * 64, fq);
                float* o = (isv ? p_v : p_k) + ((((size_t)l * 2 + b) * 256 + mm) * 4 + hh) * 64;
#pragma unroll
                for (int bj = 0; bj < 2; ++bj) { *(f32x4*)(o + 32 * bj + 8 * fq) = x[bj][0]; *(f32x4*)(o + 32 * bj + 8 * fq + 4) = x[bj][1]; }
                if (!isv) {
#pragma unroll
                    for (int bj = 0; bj < 2; ++bj) *(u32x4*)(MK + ((((size_t)l * 2 + b) * 4 + hh) * 256 + mm) * 64 + 32 * bj + 8 * fq) = pack8(x[bj][0], x[bj][1]);
                } else {
#pragma unroll
                    for (int bj = 0; bj < 2; ++bj)
#pragma unroll
                        for (int n = 0; n < 2; ++n)
#pragma unroll
                            for (int e = 0; e < 4; ++e) { const int d = 32 * bj + 8 * fq + 4 * n + e; MVT[((((size_t)l * 2 + b) * 4 + hh) * 64 + d) * 256 + mm] = (bf16_t)(cvt_pk_bf16(x[bj][n][e], 0.f) & 0xffffu); }
                }
                asm volatile("" ::: "memory");
            }
    }
};
}
#define XB_TMO      128
#define XB_XCNT(j)  (256  + 64 * (j))
#define XB_XSUB(j)  (1280 + 64 * (j))
#define XB_XGEN(j)  (2304 + 64 * (j))
#define XB_TOP      3328
#define XB_TOPGEN   3392
#define XCD_BAR_WORDS 3456
#define XB_SPIN_CAP (1u << 18)

__device__ __forceinline__ unsigned xb_ld(unsigned* p)              { return __hip_atomic_load(p, __ATOMIC_RELAXED, __HIP_MEMORY_SCOPE_AGENT); }
__device__ __forceinline__ unsigned xb_add(unsigned* p, unsigned v) { return __hip_atomic_fetch_add(p, v, __ATOMIC_RELAXED, __HIP_MEMORY_SCOPE_AGENT); }
__device__ __forceinline__ unsigned xb_xcc_id() { return (unsigned)__builtin_amdgcn_s_getreg((3 << 11) | 20) & 0xFu; }
#define XB_SPIN(cond, bar) do { unsigned _sp = 0; while (cond) { __builtin_amdgcn_s_sleep(1); \
    if ((++_sp & 255u) == 0u) { if (xb_ld(&(bar)[XB_TMO])) break; if (_sp > XB_SPIN_CAP) { atomicAdd(&(bar)[XB_TMO], 1u); break; } } } } while (0)

struct XcdBarrier {
    bool wave0;
    unsigned* bar; unsigned x;
    volatile LAS unsigned* st;
};

__device__ __forceinline__ XcdBarrier xcd_barrier_post(unsigned* bar, volatile LAS unsigned* st, bool wave0) {
    XcdBarrier b; b.wave0 = wave0; b.bar = bar; b.x = xb_xcc_id(); b.st = st;
    if (wave0 && mk_lane() == 0) (void)xb_add(&bar[XB_XCNT(b.x)], 1u);
    return b;
}
__device__ __forceinline__ void xcd_barrier_complete(unsigned* bar, unsigned x, unsigned& nloc, unsigned& nx) {
    const unsigned G = gridDim.x * gridDim.y * gridDim.z;
    unsigned sum, cnt, mine, sp = 0u;
    for (;;) {
        sum = 0u; cnt = 0u; mine = 0u;
#pragma unroll
        for (unsigned j = 0; j < 16; ++j) { const unsigned c = xb_ld(&bar[XB_XCNT(j)]); sum += c; cnt += (c > 0u) ? 1u : 0u; mine = (j == x) ? c : mine; }
        if (sum == G) break;
        __builtin_amdgcn_s_sleep(1);
        if ((++sp & 255u) == 0u) { if (xb_ld(&bar[XB_TMO])) break; if (sp > XB_SPIN_CAP) { atomicAdd(&bar[XB_TMO], 1u); break; } }
    }
    nloc = mine > 0u ? mine : 1u; nx = cnt > 0u ? cnt : 1u;
}

__device__ __forceinline__ void xcd_barrier(const XcdBarrier& b) {
    asm volatile("s_waitcnt vmcnt(0)" ::: "memory");
    __syncthreads();
    if (b.wave0 && mk_lane() == 0) {
        unsigned* bar = b.bar;
        __builtin_amdgcn_s_waitcnt(0);
        unsigned nloc = b.st[0], nx = b.st[1];
        if (nloc == 0u) { xcd_barrier_complete(bar, b.x, nloc, nx); b.st[0] = nloc; b.st[1] = nx; }
        const unsigned old = xb_add(&bar[XB_XSUB(b.x)], 1u);
        const unsigned gen = old / nloc;
        if (old + 1u == (gen + 1u) * nloc) {
            __builtin_amdgcn_fence(__ATOMIC_RELEASE, "agent");
            asm volatile("s_waitcnt vmcnt(0)" ::: "memory");
            const unsigned og = xb_add(&bar[XB_TOP], 1u);
            const unsigned tg = og / nx;
            if (og + 1u == (tg + 1u) * nx) xb_add(&bar[XB_TOPGEN], 1u);
            else XB_SPIN(xb_ld(&bar[XB_TOPGEN]) == tg, bar);
            __builtin_amdgcn_fence(__ATOMIC_ACQUIRE, "agent");
            xb_add(&bar[XB_XGEN(b.x)], 1u);
            asm volatile("s_waitcnt vmcnt(0)" ::: "memory");
        } else {
            XB_SPIN(xb_ld(&bar[XB_XGEN(b.x)]) == gen, bar);
            __builtin_amdgcn_fence(__ATOMIC_ACQUIRE, "agent");
            asm volatile("s_waitcnt vmcnt(0)" ::: "memory");
        }
    }
    __syncthreads();
}

struct Args { const float* in[N_IN]; float* out; unsigned char* ws; int ph_lo, ph_hi; };
struct Frame {
    LAS unsigned char* lds; unsigned char* lds_g;
    gu32* ctl;
    int tid, lane, wave, vcu, G;
    const float* const* in; float* out; unsigned char* ws;
};
__host__ __device__ __forceinline__ int wsig_inv(int nl) { return 128 * ((nl >> 5) & 1) + 32 * (nl >> 6) + (nl & 31); }

__device__ __forceinline__ void p0_item_load(const float* W, int N, const float* gain, int item, int lane, float (&tv)[32], float (&gv)[32]) {
    const int nblk = N / 32, kb = item / nblk, nb = item % nblk, k0 = 64 * kb, n0 = 32 * nb;
#pragma unroll
    for (int i = 0; i < 32; ++i) { const int kk = 2 * i + (lane >> 5); tv[i] = W[(size_t)(k0 + kk) * N + n0 + (lane & 31)]; gv[i] = gain ? gain[k0 + kk] : 1.0f; }
}
__device__ __forceinline__ void p0_item_finish(int K, int N, bf16* WT, int row_off, bool sig, LAS float* scr, int item, int lane, const float (&tv)[32], const float (&gv)[32]) {
    const int nblk = N / 32, kb = item / nblk, nb = item % nblk, k0 = 64 * kb, n0 = 32 * nb;
#pragma unroll
    for (int i = 0; i < 32; ++i) scr[(2 * i + (lane >> 5)) * 33 + (lane & 31)] = tv[i] * gv[i];
    LDS_WAIT(); asm volatile("" ::: "memory");
    const int c = lane & 7;
    int nbase = row_off + n0; if (sig) { const int ng = row_off + n0; nbase = (ng & ~255) + wsig_inv(ng & 255); }
#pragma unroll
    for (int j = 0; j < 4; ++j) { const int n = (lane >> 3) + 8 * j; const LAS float* s = scr + (8 * c) * 33 + n;
        v4u o; o.x = cvt_pk_bf16(s[0 * 33], s[1 * 33]); o.y = cvt_pk_bf16(s[2 * 33], s[3 * 33]); o.z = cvt_pk_bf16(s[4 * 33], s[5 * 33]); o.w = cvt_pk_bf16(s[6 * 33], s[7 * 33]);
        *(GAS v4u*)(WT + (size_t)(nbase + n) * K + k0 + 8 * c) = o; }
    LDS_WAIT(); asm volatile("" ::: "memory");
}
__device__ __forceinline__ int p0_job(const float* W, int K, int N, bf16* WT, int row_off, bool sig, const float* gain, LAS float* scr, int it, int NGW, int lane) {
    const int ni = (K / 64) * (N / 32);
    while (it < ni) { const int n1 = it + NGW; float ta[32], ga[32], tb[32], gb[32];
        p0_item_load(W, N, gain, it, lane, ta, ga); if (n1 < ni) p0_item_load(W, N, gain, n1, lane, tb, gb);
        __builtin_amdgcn_sched_barrier(0);
        p0_item_finish(K, N, WT, row_off, sig, scr, it, lane, ta, ga);
        if (n1 >= ni) { it = n1; break; }
        p0_item_finish(K, N, WT, row_off, sig, scr, n1, lane, tb, gb); it = n1 + NGW; }
    return it - ni;
}
__device__ __forceinline__ void row_to_bf16_ssq(const float* xrow, bf16* orow, float* ssqrow, int lane) {
    const GAS f32x4* xr = (const GAS f32x4*)xrow + lane;
    f32x4 v[4]; float s = 0.f;
#pragma unroll
    for (int j = 0; j < 4; ++j) { v[j] = xr[64 * j]; s += (v[j].x * v[j].x + v[j].y * v[j].y) + (v[j].z * v[j].z + v[j].w * v[j].w); }
    s = wave_sum(s);
    GAS v2u* o8 = (GAS v2u*)orow + lane;
#pragma unroll
    for (int j = 0; j < 4; ++j) o8[64 * j] = pack4(v[j]);
    if (lane < 16) ssqrow[lane] = lane == 0 ? s : 0.f;
}
__device__ __forceinline__ void p0_weights(Frame& F, int part, int gw, int NGW, LAS float* scr) {
    unsigned char* ws = F.ws;
    int it = gw;
#define P0_JOB(Wp, K_, N_, WTp, roff, sg, gn) { it = p0_job((Wp), (K_), (N_), (WTp), (roff), (sg), (gn), scr, it, NGW, F.lane); }
    if (part == 0) {
    P0_JOB(F.in[I_WINA], DM, NCOLA, (bf16*)(ws + WS_WA), 0, false, F.in[I_NMIX]);
    P0_JOB(F.in[I_WMKV], DM, 512, (bf16*)(ws + WS_WM), 0, true, F.in[I_MNORM]);
    P0_JOB(F.in[I_WMKV] + (size_t)DM * 512, DM, 512, (bf16*)(ws + WS_WM), 512, true, F.in[I_MNORM] + DM);
    P0_JOB(F.in[I_WW2], 64, 768, (bf16*)(ws + WS_WW2), 0, false, nullptr);
    P0_JOB(F.in[I_WA2], 64, 768, (bf16*)(ws + WS_WA2), 0, false, nullptr);
    P0_JOB(F.in[I_WG2], 128, 768, (bf16*)(ws + WS_WG2), 0, false, nullptr);
    } else {
    P0_JOB(F.in[I_WOUT], DM, DM, (bf16*)(ws + WS_WOUT), 0, false, nullptr);
    P0_JOB(F.in[I_WUP], DM, FF, (bf16*)(ws + WS_WUP), 0, false, F.in[I_NMLP]);
    P0_JOB(F.in[I_WDN], FF, DM, (bf16*)(ws + WS_WDN), 0, false, nullptr);
    P0_JOB(F.in[I_WINB], DM, DM, (bf16*)(ws + WS_WB), 0, true, F.in[I_NMIX] + DM);
    P0_JOB(F.in[I_WKV], DM, 512, (bf16*)(ws + WS_WB), 1024, true, F.in[I_KVN]);
    P0_JOB(F.in[I_WOUT] + (size_t)DM * DM, DM, DM, (bf16*)(ws + WS_WOUT) + (size_t)DM * DM, 0, false, nullptr);
    P0_JOB(F.in[I_WUP] + (size_t)DM * FF, DM, FF, (bf16*)(ws + WS_WUP) + (size_t)DM * FF, 0, false, F.in[I_NMLP] + DM);
    P0_JOB(F.in[I_WDN] + (size_t)DM * FF, FF, DM, (bf16*)(ws + WS_WDN) + (size_t)DM * FF, 0, false, nullptr);
    }
#undef P0_JOB
}
__device__ __forceinline__ void p0_prologue(Frame& F) {
    LAS float* scr = (LAS float*)(F.lds + RING_OFF + F.wave * 16384);
    const int gw = F.vcu * NWAVES + F.wave, NGW = F.G * NWAVES;
    unsigned char* ws = F.ws;
    p0_weights(F, 0, gw, NGW, scr);
    for (int m = gw; m < R; m += NGW) { const float* xr = m < RP ? F.in[I_XP] + (size_t)m * DM : F.in[I_XS] + (size_t)(m - RP) * DM;
        row_to_bf16_ssq(xr, (bf16*)(ws + WS_HB) + (size_t)m * DM, (float*)(ws + WS_SSQ) + (size_t)m * 16, F.lane); }
    for (int m = gw; m < 512; m += NGW) row_to_bf16_ssq(F.in[I_MEMP] + (size_t)m * DM, (bf16*)(ws + WS_MB) + (size_t)m * DM, (float*)(ws + WS_SSQM) + (size_t)m * 16, F.lane);
    { const int gt = F.vcu * NWAVES * 64 + F.tid, NGT = F.G * NWAVES * 64; float* rt = (float*)(ws + WS_ROPE);
      for (int i = gt; i < 8196 * 32; i += NGT) { const int p = i >> 5, f = i & 31; const float pos = (float)(p < 8192 ? p : 16384 + (p - 8192));
          double fq_ = 1.0; for (int k = 0; k < f; ++k) fq_ *= 0.74989420933245582730; const float ang = pos * (float)fq_; const double rev = (double)ang * 0.15915494309189535; const float fr = (float)(rev - floor(rev));
          rt[2 * i] = __builtin_amdgcn_cosf(fr); rt[2 * i + 1] = __builtin_amdgcn_sinf(fr); } }
}

__device__ __forceinline__ void finalize_sample(Frame& F, const float* fbase  , int S, bool last) {
    const int gw = F.vcu * NWAVES + F.wave, NGW = F.G * NWAVES; const float* slab = (const float*)(F.ws + WS_SLAB);
    for (int rs = gw; rs < RS; rs += NGW) { const int row = RP + rs, tile0 = (rs >> 8) << 2, r = rs & 255; float ss = 0.f;
#pragma unroll
        for (int pn = 0; pn < 4; ++pn) { f32x4 h;
            if (fbase) h = *(const GAS f32x4*)(fbase + (size_t)rs * DM + pn * 256 + 4 * F.lane);
            else h = unpack4(*(const GAS v2u*)((const bf16*)(F.ws + WS_HB) + (size_t)row * DM + pn * 256 + 4 * F.lane));
            for (int s0 = 0; s0 < S; s0 += 4) { f32x4 pv[4];
#pragma unroll
                for (int s = 0; s < 4; ++s) pv[s] = *(const GAS f32x4*)(slab + ((size_t)((tile0 + pn) * S + s0 + s) << 16) + r * 256 + 4 * F.lane);
                __builtin_amdgcn_sched_barrier(0);
                h += (pv[0] + pv[1]) + (pv[2] + pv[3]); }
            if (last) *(GAS f32x4*)(F.out + O_Y + (size_t)row * DM + pn * 256 + 4 * F.lane) = h;
            else *(GAS v2u*)((bf16*)(F.ws + WS_HB) + (size_t)row * DM + pn * 256 + 4 * F.lane) = pack4(h);
            ss += (h[0] * h[0] + h[1] * h[1]) + (h[2] * h[2] + h[3] * h[3]); }
        if (!last) { ss = wave_sum(ss); if (F.lane < 16) ((float*)(F.ws + WS_SSQ))[(size_t)row * 16 + F.lane] = F.lane == 0 ? ss : 0.f; } }
}

__device__ __forceinline__ void copy_window_cache(Frame& F, int gt, int NGT, int part, int nparts) {
    const int per = 124 * 256 / 4, tot = SB * per, lo = (int)((long)tot * part / nparts), hi = (int)((long)tot * (part + 1) / nparts);
    for (int i0 = lo + gt; i0 < hi; i0 += 4 * NGT) { f32x4 kv[4], vv[4];
#pragma unroll
        for (int u = 0; u < 4; ++u) { const int i = i0 + u * NGT; if (i < hi) { const int b = i / per, r = i % per;
            kv[u] = ((const GAS f32x4*)(F.in[I_CSK] + (size_t)b * 128 * 256 + 4 * 256))[r]; vv[u] = ((const GAS f32x4*)(F.in[I_CSV] + (size_t)b * 128 * 256 + 4 * 256))[r]; } }
        __builtin_amdgcn_sched_barrier(0);
#pragma unroll
        for (int u = 0; u < 4; ++u) { const int i = i0 + u * NGT; if (i < hi) { const int b = i / per, r = i % per;
            ((GAS f32x4*)(F.out + O_SSK + (size_t)b * 128 * 256))[r] = kv[u]; ((GAS f32x4*)(F.out + O_SSV + (size_t)b * 128 * 256))[r] = vv[u]; } } }
}

constexpr int LSTR = 144, SLOT = 64 * LSTR;
__device__ __forceinline__ int rec_index(int chunk, int h) { return ((chunk >> 7) * NH + h) * 128 + (chunk & 127); }
constexpr int REC_PT = 0, REC_QS = 8192, REC_RY = 16384, REC_YL = 24576, REC_BV = 32768;
__device__ __forceinline__ bf16x8 lfrag(const LAS unsigned char* m, int row, int k) { return *(const LAS bf16x8*)(m + row * LSTR + k * 2); }
__device__ __forceinline__ void mm_strip(f32x4 (&acc)[4], const LAS unsigned char* X, const LAS unsigned char* Y, int w, int c, int g) {
#pragma unroll
    for (int ks = 0; ks < 2; ++ks) { const bf16x8 a = lfrag(X, 16 * w + c, 32 * ks + 8 * g);
#pragma unroll
        for (int n = 0; n < 4; ++n) acc[n] = mfma16(a, lfrag(Y, 16 * n + c, 32 * ks + 8 * g), acc[n]); }
}
__device__ __forceinline__ void mm_strip2(f32x4 (&acc0)[4], f32x4 (&acc1)[4], const LAS unsigned char* X, const LAS unsigned char* Y0, const LAS unsigned char* Y1, int w, int c, int g) {
#pragma unroll
    for (int ks = 0; ks < 2; ++ks) { const bf16x8 a = lfrag(X, 16 * w + c, 32 * ks + 8 * g);
#pragma unroll
        for (int n = 0; n < 4; ++n) { acc0[n] = mfma16(a, lfrag(Y0, 16 * n + c, 32 * ks + 8 * g), acc0[n]); acc1[n] = mfma16(a, lfrag(Y1, 16 * n + c, 32 * ks + 8 * g), acc1[n]); } }
}
__device__ __forceinline__ void zero4(f32x4 (&a)[4]) {
#pragma unroll
    for (int n = 0; n < 4; ++n) a[n] = (f32x4){0.f, 0.f, 0.f, 0.f};
}
__device__ __forceinline__ void st_T(LAS unsigned char* dest, const f32x4 (&acc)[4], int w, int c, int g) {
#pragma unroll
    for (int n = 0; n < 4; ++n) *(LAS v2u*)(dest + (16 * n + c) * LSTR + (16 * w + 4 * g) * 2) = pack4(acc[n]);
}
__device__ __forceinline__ void st_T_global(unsigned char* dest  , const f32x4 (&acc)[4], int w, int c, int g) {
#pragma unroll
    for (int n = 0; n < 4; ++n) *(GAS v2u*)(dest + (16 * n + c) * 128 + (16 * w + 4 * g) * 2) = pack4(acc[n]);
}
__device__ __forceinline__ void load_shift8(const bf16* cur, const bf16* prv, const float* mu, float (&o)[8]) {
    const v4u cw = *(const GAS v4u*)cur; v4u pw = {0u, 0u, 0u, 0u}; if (prv) pw = *(const GAS v4u*)prv;
    const f32x4 m0 = *(const GAS f32x4*)mu, m1 = *(const GAS f32x4*)(mu + 4);
    const float cf[8] = {bflo(cw.x), bfhi(cw.x), bflo(cw.y), bfhi(cw.y), bflo(cw.z), bfhi(cw.z), bflo(cw.w), bfhi(cw.w)};
    const float pf[8] = {bflo(pw.x), bfhi(pw.x), bflo(pw.y), bfhi(pw.y), bflo(pw.z), bfhi(pw.z), bflo(pw.w), bfhi(pw.w)};
    const float mf[8] = {m0[0], m0[1], m0[2], m0[3], m1[0], m1[1], m1[2], m1[3]};
#pragma unroll
    for (int i = 0; i < 8; ++i) o[i] = cf[i] + (pf[i] - cf[i]) * mf[i];
}
__device__ __forceinline__ bf16x8 pack_frag(const float (&v)[8]) {
    v4u w; w.x = cvt_pk_bf16(v[0], v[1]); w.y = cvt_pk_bf16(v[2], v[3]); w.z = cvt_pk_bf16(v[4], v[5]); w.w = cvt_pk_bf16(v[6], v[7]); return __builtin_bit_cast(bf16x8, w);
}

struct PrepPf { v4u raw[3][2]; v4u prv; };
__device__ __forceinline__ void prep_issue(Frame& F, int unit, PrepPf& pf) {
    const int th = (F.wave & 3) * 64 + F.lane; const int chunk = unit / NH, h = unit % NH, row0 = chunk * 64; const bool first = (chunk & 127) == 0;
    const bf16* proj = (const bf16*)(F.ws + WS_PROJ);
#pragma unroll
    for (int a = 0; a < 3; ++a)
#pragma unroll
        for (int i = 0; i < 2; ++i) { const int id = th + 256 * i; pf.raw[a][i] = *(const GAS v4u*)(proj + (size_t)(row0 + (id >> 3)) * NCOLA + a * 768 + h * 64 + (id & 7) * 8); }
    pf.prv = (v4u){0u, 0u, 0u, 0u};
    if (th < 24 && !first) pf.prv = *(const GAS v4u*)(proj + (size_t)(row0 - 1) * NCOLA + (th >> 3) * 768 + h * 64 + (th & 7) * 8);
}
__device__ __forceinline__ void shift8(v4u cw, v4u pw, const float* mu, float (&o)[8]) {
    const f32x4 m0 = *(const GAS f32x4*)mu, m1 = *(const GAS f32x4*)(mu + 4);
    const float cf[8] = {bflo(cw.x), bfhi(cw.x), bflo(cw.y), bfhi(cw.y), bflo(cw.z), bfhi(cw.z), bflo(cw.w), bfhi(cw.w)};
    const float pf_[8] = {bflo(pw.x), bfhi(pw.x), bflo(pw.y), bfhi(pw.y), bflo(pw.z), bfhi(pw.z), bflo(pw.w), bfhi(pw.w)};
    const float mf[8] = {m0[0], m0[1], m0[2], m0[3], m1[0], m1[1], m1[2], m1[3]};
#pragma unroll
    for (int i = 0; i < 8; ++i) o[i] = cf[i] + (pf_[i] - cf[i]) * mf[i];
}
#ifndef MK_TIME
#define MK_TIME -1
#endif
#define STAMP3(k) do { if (MK_TIME >= 0 && unit == 0 && w_ == 0 && lane_ == 0) ((volatile LAS unsigned long long*)(F.lds + LDSCTL_OFF + 512))[(k)] = __builtin_amdgcn_s_memrealtime(); } while (0)
#define HBAR() do { asm volatile("s_waitcnt lgkmcnt(0)" ::: "memory"); __builtin_amdgcn_s_barrier(); asm volatile("" ::: "memory"); } while (0)
__device__ __forceinline__ void rwkv_prep_unit(Frame& F, int unit, LAS unsigned char* hb, LAS float* wtot, LAS unsigned char* prow, PrepPf& pf, bool has_next, int next_unit, int stage_limit = 99) {
    int w_ = F.wave & 3, lane_ = F.lane; asm volatile("" : "+s"(w_), "+v"(lane_));
    const int w = w_, lane = lane_, g = lane >> 4, c = lane & 15;
    STAMP3(17);
    const int chunk = unit / NH, h = unit % NH, row0 = chunk * 64; const bool first = (chunk & 127) == 0;
    const bf16* proj = (const bf16*)(F.ws + WS_PROJ);
    unsigned char* rec = F.ws + WS_REC + (size_t)rec_index(chunk, h) * REC_BYTES;
    LAS unsigned char* const s0 = hb, * const s1 = hb + SLOT, * const s2 = hb + 2 * SLOT, * const s3 = hb + 3 * SLOT, * const s4 = hb + 4 * SLOT, * const s5 = hb + 5 * SLOT, * const s6 = hb + 6 * SLOT, * const s7 = hb + 7 * SLOT;
    float mur[4], muk[4], muv[4], w0[4], a0[4], kkc[4], kac[4], rkc[4];
#pragma unroll
    for (int n = 0; n < 4; ++n) { const int col = h * 64 + 16 * n + c; mur[n] = F.in[I_MU][col]; muk[n] = F.in[I_MU][768 + col]; muv[n] = F.in[I_MU][1536 + col];
        w0[n] = F.in[I_W0][col]; a0[n] = F.in[I_A0][col]; kkc[n] = F.in[I_KK][col]; kac[n] = F.in[I_KA][col]; rkc[n] = F.in[I_RK][col]; }
    f32x4 dw[4], da[4]; zero4(dw); zero4(da);
    { const int th = w * 64 + lane;
#pragma unroll
      for (int a = 0; a < 3; ++a)
#pragma unroll
          for (int i = 0; i < 2; ++i) { const int id = th + 256 * i; *(LAS v4u*)(hb + a * SLOT + (id >> 3) * LSTR + (id & 7) * 16) = pf.raw[a][i]; }
      if (th < 24) *(LAS v4u*)(prow + (th >> 3) * 128 + (th & 7) * 16) = pf.prv; }
    {
        const bf16* Ww2 = (const bf16*)(F.ws + WS_WW2); const bf16* Wa2 = (const bf16*)(F.ws + WS_WA2);
        const int tl = 16 * w + c; const bf16* crl = proj + (size_t)(row0 + tl) * NCOLA; const bool hpl = !(first && tl == 0);
        v4u lc[2][2], lp[2][2];
#pragma unroll
        for (int a = 0; a < 2; ++a)
#pragma unroll
            for (int ks = 0; ks < 2; ++ks) { const int col = 2304 + 64 * a + 32 * ks + 8 * g; lc[a][ks] = *(const GAS v4u*)(crl + col); lp[a][ks] = (v4u){0u, 0u, 0u, 0u}; if (hpl) lp[a][ks] = *(const GAS v4u*)(crl - NCOLA + col); }
#pragma unroll
        for (int ks = 0; ks < 2; ++ks) { const int l0 = 32 * ks + 8 * g; float x[8];
            shift8(lc[0][ks], lp[0][ks], F.in[I_MU] + 2304 + l0, x);
#pragma unroll
            for (int i = 0; i < 8; ++i) x[i] = ftanh(x[i]);
            const bf16x8 aw = pack_frag(x);
            shift8(lc[1][ks], lp[1][ks], F.in[I_MU] + 2368 + l0, x);
            const bf16x8 aa = pack_frag(x);
#pragma unroll
            for (int n = 0; n < 4; ++n) { const size_t wo = (size_t)(h * 64 + 16 * n + c) * 64 + l0;
                dw[n] = mfma16(aw, *(const GAS bf16x8*)(Ww2 + wo), dw[n]); da[n] = mfma16(aa, *(const GAS bf16x8*)(Wa2 + wo), da[n]); } }
    }
    STAMP3(18);
    HBAR();
    if (has_next) prep_issue(F, next_unit, pf);
    f32x4 rt[4], kh[4], lw[4], at_[4], bt_[4], kt_[4], bh_[4], vv[4]; float gam[4]; float bon[4] = {0.f, 0.f, 0.f, 0.f}; float ssk[4] = {0.f, 0.f, 0.f, 0.f};
    f32x4 kkr[4], aa_[4], kp[4], rr[4];
    {

        const LAS unsigned char* pbase = (w == 0 && g == 0) ? prow + c * 2 : hb + (16 * w + 4 * g - 1) * LSTR + c * 2; const int pstr = (w == 0 && g == 0) ? 128 : SLOT;
        float rp[4], kpv[4], vp[4];
#pragma unroll
        for (int n = 0; n < 4; ++n) { rp[n] = bf2f(*(const LAS bf16*)(pbase + 32 * n)); kpv[n] = bf2f(*(const LAS bf16*)(pbase + pstr + 32 * n)); vp[n] = bf2f(*(const LAS bf16*)(pbase + 2 * pstr + 32 * n)); }
#pragma unroll
        for (int reg = 0; reg < 4; ++reg) { const int t = 16 * w + 4 * g + reg; const LAS unsigned char* cr = hb + t * LSTR + c * 2;
#pragma unroll
            for (int n = 0; n < 4; ++n) {
                const float r0 = bf2f(*(const LAS bf16*)(cr + 32 * n)), k0 = bf2f(*(const LAS bf16*)(cr + SLOT + 32 * n)), v0 = bf2f(*(const LAS bf16*)(cr + 2 * SLOT + 32 * n));
                const float r1 = rp[n], k1 = kpv[n], v1 = vp[n]; rp[n] = r0; kpv[n] = k0; vp[n] = v0;
                const float r = r0 + (r1 - r0) * mur[n], k = k0 + (k1 - k0) * muk[n], v = v0 + (v1 - v0) * muv[n];
                const float y = -(w0[n] + dw[n][reg]);
                const float sp = fmaxf(y, 0.f) + __logf(1.0f + __expf(-fabsf(y)));
                lw[n][reg] = -__expf(-sp - 0.5f);
                const float a = fsigmoid(a0[n] + da[n][reg]);
                aa_[n][reg] = a; kkr[n][reg] = k * kkc[n]; kp[n][reg] = k * (1.0f + (a - 1.0f) * kac[n]); rr[n][reg] = r; vv[n][reg] = v;
                ssk[reg] += kkr[n][reg] * kkr[n][reg]; bon[reg] += r * kp[n][reg] * rkc[n]; } }
    }
#pragma unroll
    for (int reg = 0; reg < 4; ++reg) { ssk[reg] = sum16(ssk[reg]); bon[reg] = sum16(bon[reg]); ssk[reg] = __builtin_amdgcn_rsqf(fmaxf(ssk[reg], 1e-24f)); }
    STAMP3(19);
    f32x4 Lc[4];
#pragma unroll
    for (int n = 0; n < 4; ++n) { f32x4 inc; inc[0] = lw[n][0]; inc[1] = inc[0] + lw[n][1]; inc[2] = inc[1] + lw[n][2]; inc[3] = inc[2] + lw[n][3];
        const float tot = inc[3]; const float t1 = __shfl(tot, (lane - 16) & 63), t2 = __shfl(tot, (lane - 32) & 63), t3 = __shfl(tot, (lane - 48) & 63);
        const float pre = (g >= 1 ? t1 : 0.f) + (g >= 2 ? t2 : 0.f) + (g >= 3 ? t3 : 0.f);
        Lc[n] = inc + pre; if (g == 3) wtot[w * 64 + 16 * n + c] = pre + tot; }
    HBAR();
#pragma unroll
    for (int n = 0; n < 4; ++n) { const int j = 16 * n + c; const float t0 = wtot[j], t1 = wtot[64 + j], t2 = wtot[128 + j], t3 = wtot[192 + j];
        const float base = (w >= 1 ? t0 : 0.f) + (w >= 2 ? t1 : 0.f) + (w >= 3 ? t2 : 0.f); const float LC = (t0 + t1) + (t2 + t3);
        gam[n] = __expf(LC);
#pragma unroll
        for (int reg = 0; reg < 4; ++reg) { const float L = Lc[n][reg] + base; const float eL = __expf(L), eLi = __builtin_amdgcn_rcpf(eL), eP = __expf(L - lw[n][reg]), eC = gam[n] * eLi;
            const float kk = kkr[n][reg] * ssk[reg], bsc = kk * aa_[n][reg];
            at_[n][reg] = -kk * eP; rt[n][reg] = rr[n][reg] * eL; bt_[n][reg] = bsc * eLi; kt_[n][reg] = kp[n][reg] * eLi; bh_[n][reg] = bsc * eC; kh[n][reg] = kp[n][reg] * eC;
            const int t = 16 * w + 4 * g + reg;
            *(LAS bf16*)(s0 + t * LSTR + j * 2) = f2bf(at_[n][reg]); *(LAS bf16*)(s1 + t * LSTR + j * 2) = f2bf(bt_[n][reg]);
            *(LAS bf16*)(s2 + t * LSTR + j * 2) = f2bf(kt_[n][reg]); *(LAS bf16*)(s3 + t * LSTR + j * 2) = f2bf(rt[n][reg]); }
        *(LAS v2u*)(s4 + j * LSTR + (16 * w + 4 * g) * 2) = pack4(at_[n]); *(LAS v2u*)(s5 + j * LSTR + (16 * w + 4 * g) * 2) = pack4(bh_[n]); *(LAS v2u*)(s6 + j * LSTR + (16 * w + 4 * g) * 2) = pack4(vv[n]);
        f32x4 bv;
#pragma unroll
        for (int reg = 0; reg < 4; ++reg) bv[reg] = bon[reg] * vv[n][reg];
        *(GAS v2u*)(rec + REC_BV + ((w * 64 + lane) * 4 + n) * 8) = pack4(bv); }
    HBAR();
    STAMP3(20);
    if (stage_limit <= 3) return;
    f32x4 aN[4], aMk[4], aMbr[4], aMkr[4]; zero4(aN); zero4(aMk); zero4(aMbr); zero4(aMkr);
    mm_strip2(aN, aMk, s0, s1, s2, w, c, g);
    mm_strip(aMbr, s1, s3, w, c, g); mm_strip(aMkr, s2, s3, w, c, g);
#pragma unroll
    for (int n = 0; n < 4; ++n)
#pragma unroll
        for (int reg = 0; reg < 4; ++reg) { const int row = 16 * w + 4 * g + reg, col = 16 * n + c;
            if (!(col < row)) { aN[n][reg] = 0.f; aMk[n][reg] = 0.f; } if (!(row <= col)) { aMbr[n][reg] = 0.f; aMkr[n][reg] = 0.f; } }
    HBAR();
    LAS float* Nf = (LAS float*)s0;
#pragma unroll
    for (int n = 0; n < 4; ++n)
#pragma unroll
        for (int reg = 0; reg < 4; ++reg) Nf[(16 * w + 4 * g + reg) * 64 + (c & 3) * 16 + 4 * n + (c >> 2)] = aN[n][reg];
    st_T(s2, aMk, w, c, g);
    st_T(s3, aMbr, w, c, g);
    HBAR();
    {
        const int q = lane & 3, sl = lane >> 2; float cq[16];
#pragma unroll
        for (int k = 0; k < 16; ++k) cq[k] = 0.f;
        for (int t = 0; t < 16 * w; ++t) if (q == 0) *(LAS bf16*)(s7 + t * LSTR + (16 * w + sl) * 2) = (bf16)0;
#pragma unroll
        for (int t = 0; t < 64; ++t) if (t >= 16 * w) {
            float part = 0.f;
#pragma unroll
            for (int k4 = 0; k4 < (t + 15) / 16; ++k4) { const f32x4 nv = *(const LAS f32x4*)(Nf + t * 64 + q * 16 + 4 * k4);
#pragma unroll
                for (int e = 0; e < 4; ++e) if (4 * (4 * k4 + e) < t) part = fmaf(nv[e], cq[4 * k4 + e], part); }
            part = sum4_dpp(part);
            const float val = part + ((t == 16 * w + sl) ? 1.0f : 0.0f);
            cq[t >> 2] = (q == (t & 3)) ? val : cq[t >> 2];
            if (q == 0) *(LAS bf16*)(s7 + t * LSTR + (16 * w + sl) * 2) = f2bf(val);
        }
    }
    HBAR();
    STAMP3(21);
    if (stage_limit <= 5) return;
    { f32x4 aW[4], aNk[4]; zero4(aW); zero4(aNk); mm_strip2(aW, aNk, s7, s4, s2, w, c, g); st_T(s0, aW, w, c, g); st_T(s1, aNk, w, c, g); }
    HBAR();
    { f32x4 aP[4]; zero4(aP); mm_strip(aP, s0, s5, w, c, g);
#pragma unroll
      for (int n = 0; n < 4; ++n)
#pragma unroll
          for (int reg = 0; reg < 4; ++reg) if (n == w && c == 4 * g + reg) aP[n][reg] += gam[n];
#pragma unroll
      for (int n = 0; n < 4; ++n) *(GAS v2u*)(rec + REC_PT + ((n * 2 + (w >> 1)) * 64 + lane) * 16 + 8 * (w & 1)) = pack4(aP[n]); }
    { f32x4 aZq[4], aZy[4]; zero4(aZq); zero4(aZy); mm_strip2(aZq, aZy, s1, s5, s3, w, c, g);
#pragma unroll
      for (int n = 0; n < 4; ++n) { aZq[n] += kh[n]; aZy[n] += aMkr[n]; }
      f32x4 aRy[4]; zero4(aRy); mm_strip(aRy, s3, s0, w, c, g);
#pragma unroll
      for (int n = 0; n < 4; ++n)
#pragma unroll
          for (int reg = 0; reg < 4; ++reg) *(GAS bf16*)(rec + REC_RY + ((w * 2 + (n >> 1)) * 64 + 16 * (2 * (n & 1) + (c >> 3)) + 4 * g + reg) * 16 + 2 * (c & 7)) = f2bf(aRy[n][reg] + rt[n][reg]);
      st_T(s4, aZq, w, c, g);
      st_T(s7, aZy, w, c, g); }
    HBAR();
    { f32x4 aQ[4], aY[4]; zero4(aQ); zero4(aY); mm_strip(aQ, s4, s6, w, c, g); mm_strip(aY, s7, s6, w, c, g);
#pragma unroll
      for (int n = 0; n < 4; ++n) { *(GAS v2u*)(rec + REC_QS + ((n * 64 + lane) * 4 + w) * 8) = pack4(aQ[n]);
                                    *(GAS v2u*)(rec + REC_YL + ((w * 64 + lane) * 4 + n) * 8) = pack4(aY[n]); } }
    STAMP3(22);
}

__device__ __forceinline__ float rdlane(float v, int l) { return __int_as_float(__builtin_amdgcn_readlane(__float_as_int(v), l)); }
#ifndef MK_TIME
#define MK_TIME -1
#endif
#define STAMP2(k) do { if (MK_TIME >= 0 && blockIdx.x == 0 && F.wave == 0 && lane == 0) ((volatile LAS unsigned long long*)(F.lds + LDSCTL_OFF + 512))[(k)] = __builtin_amdgcn_s_memrealtime(); } while (0)
__device__ __forceinline__ void rwkv_sample_task(Frame& F, int task) {
    int lane_ = F.lane; asm volatile("" : "+v"(lane_)); const int lane = lane_;
    const int b = task / NH, h = task % NH, col = h * 64 + lane;
    const bf16* proj = (const bf16*)(F.ws + WS_PROJ);
    const float* sh = F.in[I_SSHIFT] + (size_t)b * RWKV_COLS;
    const float* mu = F.in[I_MU];
    float S[64];
    { const GAS f32x4* sp = (const GAS f32x4*)(F.in[I_SWKV] + (((size_t)b * NH + h) * 64 + lane) * 64);
#pragma unroll
      for (int q = 0; q < 16; ++q) { const f32x4 v = sp[q]; S[4 * q] = v[0]; S[4 * q + 1] = v[1]; S[4 * q + 2] = v[2]; S[4 * q + 3] = v[3]; } }
    const float w0 = F.in[I_W0][col], a0 = F.in[I_A0][col], kkc = F.in[I_KK][col], kac = F.in[I_KA][col], rkc = F.in[I_RK][col], lnw = F.in[I_LNW][col], lnb = F.in[I_LNB][col];
    float rr[ST], kq[ST], vq[ST], twd[ST], adv[ST], gd0[ST], gd1[ST];
    {
      const int cols[7] = {col, 768 + col, 1536 + col, 2304 + lane, 2368 + lane, 2432 + lane, 2496 + lane};
      float raw[ST + 1][7], muv[7];
#pragma unroll
      for (int q = 0; q < 7; ++q) { muv[q] = mu[cols[q]]; raw[0][q] = sh[cols[q]];
#pragma unroll
          for (int i = 0; i < ST; ++i) raw[i + 1][q] = bf2f(proj[(size_t)(RP + b * ST + i) * NCOLA + cols[q]]); }
      __builtin_amdgcn_sched_barrier(0);
#pragma unroll
      for (int i = 0; i < ST; ++i) {
#define SHV(q) (raw[i + 1][q] + (raw[i][q] - raw[i + 1][q]) * muv[q])
          rr[i] = SHV(0); kq[i] = SHV(1); vq[i] = SHV(2); twd[i] = ftanh(SHV(3)); adv[i] = SHV(4); gd0[i] = fsigmoid(SHV(5)); gd1[i] = fsigmoid(SHV(6));
#undef SHV
      } }
    float dwv[ST] = {0.f, 0.f, 0.f, 0.f}, dav[ST] = {0.f, 0.f, 0.f, 0.f}, ggv[ST] = {0.f, 0.f, 0.f, 0.f};
    { const GAS float* W2 = (const GAS float*)(F.in[I_WW2] + col); const GAS float* A2 = (const GAS float*)(F.in[I_WA2] + col); const GAS float* G2 = (const GAS float*)(F.in[I_WG2] + col);
      for (int l0 = 0; l0 < 64; l0 += 16) {
          float w2[16], a2[16], ga[16], gb[16];
#pragma unroll
          for (int u = 0; u < 16; ++u) { w2[u] = W2[(size_t)u * 768]; a2[u] = A2[(size_t)u * 768]; ga[u] = G2[(size_t)u * 768]; gb[u] = G2[(size_t)(64 + u) * 768]; }
          W2 += 16 * 768; A2 += 16 * 768; G2 += 16 * 768;
          __builtin_amdgcn_sched_barrier(0);
#pragma unroll
          for (int u = 0; u < 16; ++u) { const int l = l0 + u;
#pragma unroll
              for (int i = 0; i < ST; ++i) { dwv[i] = fmaf(rdlane(twd[i], l), w2[u], dwv[i]); dav[i] = fmaf(rdlane(adv[i], l), a2[u], dav[i]); ggv[i] = fmaf(rdlane(gd0[i], l), ga[u], ggv[i]); ggv[i] = fmaf(rdlane(gd1[i], l), gb[u], ggv[i]); } } } }
    STAMP2(15);
#pragma unroll
    for (int i = 0; i < ST; ++i) {
        const int row = RP + b * ST + i;
        const float r = rr[i], k = kq[i], v = vq[i], dw = dwv[i], da = dav[i], gg = ggv[i];
        const float y0 = -(w0 + dw); const float sp = fmaxf(y0, 0.f) + __logf(1.0f + __expf(-fabsf(y0)));
        const float wdec = __expf(-__expf(-sp - 0.5f));
        const float a = fsigmoid(a0 + da);
        const float kkr = k * kkc; const float nrm = fmaxf(sqrtf(wave_sum(kkr * kkr)), 1e-12f); const float kk = kkr / nrm;
        const float kp = k * (1.0f + (a - 1.0f) * kac);
        const float asc = -kk, bsc = kk * a;
        const float bonus = wave_sum(r * kp * rkc);
        float sa = 0.f;
#pragma unroll
        for (int j = 0; j < 64; ++j) sa = fmaf(S[j], rdlane(asc, j), sa);
        const float vi = v;
        float y = 0.f;
#pragma unroll
        for (int j = 0; j < 64; ++j) { const float wj = rdlane(wdec, j), bj = rdlane(bsc, j), kj = rdlane(kp, j), rj = rdlane(r, j);
            S[j] = fmaf(S[j], wj, fmaf(sa, bj, vi * kj)); y = fmaf(S[j], rj, y); }
        const float mean = wave_sum(y) * (1.0f / 64.0f); const float dy = y - mean; const float var = wave_sum(dy * dy) * (1.0f / 64.0f);
        const float o = (dy * rsqrtf(var + 6.4e-4f) * lnw + lnb + bonus * vi) * gg;
        ((bf16*)(F.ws + WS_MIX))[(size_t)row * DM + col] = f2bf(o);
        asm volatile("" ::: "memory");
    }
    STAMP2(16);
    { GAS f32x4* sp = (GAS f32x4*)(F.out + O_SWKV + (((size_t)b * NH + h) * 64 + lane) * 64);
#pragma unroll
      for (int q = 0; q < 16; ++q) sp[q] = (f32x4){S[4 * q], S[4 * q + 1], S[4 * q + 2], S[4 * q + 3]}; }
    if (h == 0) { const bf16* lr = proj + (size_t)(RP + b * ST + ST - 1) * NCOLA; float* o = F.out + O_SSHIFT + (size_t)b * RWKV_COLS;
        for (int q = lane; q < RWKV_COLS; q += 64) o[q] = bf2f(lr[q]); }
}

__device__ __forceinline__ void rwkv_scan_chain(Frame& F, int bh, int w) {
    int lane_ = F.lane; asm volatile("" : "+v"(lane_)); const int lane = lane_, g = lane >> 4, c = lane & 15; const int b = bh / NH, h = bh % NH;
    constexpr int DPF = 12, NSL = 14, SLB = 10240;
    LAS unsigned char* ring = F.lds;
    auto recp = [&](int cc) -> const unsigned char* { return F.ws + WS_REC + (size_t)((b * NH + h) * 128 + cc) * REC_BYTES; };
    const int vrow = 16 * w + c;
    if (F.wave >= 4) {
        const int L = F.wave - 4, npc = L < 2 ? 3 : 2;
#define SCAN_DMA(cc_) do { const unsigned char* rp_ = recp(cc_); LAS unsigned char* sl_ = ring + ((cc_) % NSL) * SLB; \
            _Pragma("unroll") for (int q = 0; q < 3; ++q) { const int p = L + 4 * q; if (p < 8) __builtin_amdgcn_global_load_lds((const unsigned*)(rp_ + REC_PT + p * 1024 + lane * 16), (LAS unsigned*)(sl_ + p * 1024), 16, 0, 0); \
                else if (p < 10) __builtin_amdgcn_global_load_lds((const unsigned*)(rp_ + REC_QS + (w * 64 + lane) * 32 + (p - 8) * 16), (LAS unsigned*)(sl_ + p * 1024), 16, 0, 0); } } while (0)
        for (int d = 0; d < DPF; ++d) SCAN_DMA(d);
        for (int cc = 0; cc < 128; ++cc) {
            const int younger = (cc + DPF <= 128 ? DPF - 1 : 127 - cc) * npc;
            if (younger >= 33) asm volatile("s_waitcnt vmcnt(33)" ::: "memory"); else if (younger >= 22) asm volatile("s_waitcnt vmcnt(22)" ::: "memory");
            else if (younger >= 11) asm volatile("s_waitcnt vmcnt(11)" ::: "memory"); else asm volatile("s_waitcnt vmcnt(0)" ::: "memory");
            __builtin_amdgcn_s_barrier();
            if (cc + DPF < 128) SCAN_DMA(cc + DPF);
        }
#undef SCAN_DMA
        asm volatile("s_waitcnt vmcnt(0)" ::: "memory");
        return;
    }
    if (F.wave != 0) { for (int cc = 0; cc < 128; ++cc) __builtin_amdgcn_s_barrier(); return; }
    f32x4 acc[4]; zero4(acc);
    for (int cc = 0; cc < 128; ++cc) {
        __builtin_amdgcn_s_barrier(); asm volatile("" ::: "memory");
        const LAS unsigned char* sl = ring + (cc % NSL) * SLB;
        bf16x8 pa[4][2];
#pragma unroll
        for (int mt = 0; mt < 4; ++mt)
#pragma unroll
            for (int ks = 0; ks < 2; ++ks) pa[mt][ks] = *(const LAS bf16x8*)(sl + (mt * 2 + ks) * 1024 + lane * 16);
        const v4u q0 = *(const LAS v4u*)(sl + 8192 + lane * 16), q1 = *(const LAS v4u*)(sl + 9216 + lane * 16);
        unsigned char* sp_ = F.ws + WS_HB + (size_t)((b * NH + h) * 128 + cc) * 8192;
        v2u sb[4]; f32x4 nacc[4];
#pragma unroll
        for (int mt = 0; mt < 4; ++mt) sb[mt] = pack4(acc[mt]);
        nacc[0] = unpack4((v2u){q0.x, q0.y}); nacc[1] = unpack4((v2u){q0.z, q0.w}); nacc[2] = unpack4((v2u){q1.x, q1.y}); nacc[3] = unpack4((v2u){q1.z, q1.w});
#pragma unroll
        for (int mt = 0; mt < 4; ++mt) *(GAS v2u*)(sp_ + ((w * 2 + (mt >> 1)) * 64 + 16 * (2 * (mt & 1) + (g >> 1)) + c) * 16 + 8 * (g & 1)) = sb[mt];
        bf16x8 bf[2];
#pragma unroll
        for (int ks = 0; ks < 2; ++ks) { v4u t; t.x = sb[2 * ks].x; t.y = sb[2 * ks].y; t.z = sb[2 * ks + 1].x; t.w = sb[2 * ks + 1].y; bf[ks] = __builtin_bit_cast(bf16x8, t); }
#pragma unroll
        for (int mt = 0; mt < 4; ++mt) { nacc[mt] = mfma16(pa[mt][0], bf[0], nacc[mt]); nacc[mt] = mfma16(pa[mt][1], bf[1], nacc[mt]); acc[mt] = nacc[mt]; }
        asm volatile("s_waitcnt lgkmcnt(0)" ::: "memory");
    }
    float* o = F.out + O_PWKV + (((size_t)b * NH + h) * 64 + vrow) * 64;
#pragma unroll
    for (int mt = 0; mt < 4; ++mt) *(GAS f32x4*)(o + 16 * mt + 4 * g) = acc[mt];
}

__device__ __forceinline__ void rwkv_yout_item(Frame& F, int item) {
    int lane_ = F.lane; asm volatile("" : "+v"(lane_)); const int lane = lane_, g = lane >> 4, c = lane & 15; const int unit = item >> 2, w = item & 3;
    const int chunk = unit / NH, h = unit % NH, row0 = chunk * 64; const bool first = (chunk & 127) == 0;
    const unsigned char* rec = F.ws + WS_REC + (size_t)rec_index(chunk, h) * REC_BYTES; const unsigned char* srec = F.ws + WS_HB + (size_t)rec_index(chunk, h) * 8192;
    const bf16* proj = (const bf16*)(F.ws + WS_PROJ);
    f32x4 y[4], gt[4]; zero4(gt);
    { const v4u y01 = *(const GAS v4u*)(rec + REC_YL + (w * 64 + lane) * 32), y23 = *(const GAS v4u*)(rec + REC_YL + (w * 64 + lane) * 32 + 16);
      y[0] = unpack4((v2u){y01.x, y01.y}); y[1] = unpack4((v2u){y01.z, y01.w}); y[2] = unpack4((v2u){y23.x, y23.y}); y[3] = unpack4((v2u){y23.z, y23.w}); }
    { bf16x8 ar[2], sf[4][2]; v4u gc[4], gp[4]; v2u bvv[4];
      const int tg = 16 * w + c; const bf16* crg = proj + (size_t)(row0 + tg) * NCOLA; const bool hpg = !(first && tg == 0);
#pragma unroll
      for (int ks = 0; ks < 2; ++ks) { ar[ks] = *(const GAS bf16x8*)(rec + REC_RY + ((w * 2 + ks) * 64 + lane) * 16);
#pragma unroll
          for (int n = 0; n < 4; ++n) sf[n][ks] = *(const GAS bf16x8*)(srec + ((n * 2 + ks) * 64 + lane) * 16); }
      __builtin_amdgcn_sched_barrier(0);
#pragma unroll
      for (int ks = 0; ks < 2; ++ks)
#pragma unroll
          for (int n = 0; n < 4; ++n) y[n] = mfma16(ar[ks], sf[n][ks], y[n]); }
    { const int t = 16 * w + c; const bf16* cr = proj + (size_t)(row0 + t) * NCOLA; const bf16* pr = (first && t == 0) ? nullptr : cr - NCOLA; const bf16* Wg2 = (const bf16*)(F.ws + WS_WG2);
#pragma unroll
      for (int ks = 0; ks < 4; ++ks) { const int l0 = 32 * ks + 8 * g; float x[8]; load_shift8(cr + 2432 + l0, pr ? pr + 2432 + l0 : nullptr, F.in[I_MU] + 2432 + l0, x);
#pragma unroll
          for (int i = 0; i < 8; ++i) x[i] = fsigmoid(x[i]);
          const bf16x8 ag = pack_frag(x);
#pragma unroll
          for (int n = 0; n < 4; ++n) gt[n] = mfma16(ag, *(const GAS bf16x8*)(Wg2 + (size_t)(h * 64 + 16 * n + c) * 128 + l0), gt[n]); } }
    float mean[4], rstd[4];
#pragma unroll
    for (int reg = 0; reg < 4; ++reg) { float s = (y[0][reg] + y[1][reg]) + (y[2][reg] + y[3][reg]); s = sum16(s); mean[reg] = s * (1.0f / 64.0f);
        float q = 0.f;
#pragma unroll
        for (int n = 0; n < 4; ++n) { const float d = y[n][reg] - mean[reg]; q += d * d; }
        q = sum16(q); rstd[reg] = rsqrtf(q * (1.0f / 64.0f) + 6.4e-4f); }
    bf16* mix = (bf16*)(F.ws + WS_MIX);
#pragma unroll
    for (int n = 0; n < 4; ++n) { const int col = h * 64 + 16 * n + c; const float lnw = F.in[I_LNW][col], lnb = F.in[I_LNB][col];
        const f32x4 bv = unpack4(*(const GAS v2u*)(rec + REC_BV + ((w * 64 + lane) * 4 + n) * 8));
#pragma unroll
        for (int reg = 0; reg < 4; ++reg) { const float o = ((y[n][reg] - mean[reg]) * rstd[reg] * lnw + lnb + bv[reg]) * gt[n][reg];
            mix[(size_t)(row0 + 16 * w + 4 * g + reg) * DM + col] = f2bf(o); } }
}

__device__ __forceinline__ int crow32(int r, int hi) { return (r & 3) + 8 * (r >> 2) + 4 * hi; }
template <bool MASKED, int GB>
__device__ __forceinline__ void flash32(const bf16x8 (&qf)[4], const bf16* Kp, int kstr, const bf16* VTp, int vstr, int kb_lo, int nblk, int qpos, float m0, float l0,
                                        f32x16& o0, f32x16& o1, float& lsum, int lane) {
    const int r32 = lane & 31, hh = lane >> 5;
    float m = m0, l = hh == 0 ? l0 : 0.f;
#pragma unroll
    for (int r = 0; r < 16; ++r) { o0[r] = 0.f; o1[r] = 0.f; }
    for (int b0 = 0; b0 < nblk; b0 += GB) {
        bf16x8 kf[GB][4]; v2u vf[GB][2][2][2];
#pragma unroll
        for (int i = 0; i < GB; ++i) if (b0 + i < nblk) { const int kb = kb_lo + 32 * (b0 + i);
#pragma unroll
            for (int ks = 0; ks < 4; ++ks) kf[i][ks] = *(const GAS bf16x8*)(Kp + (size_t)(kb + r32) * kstr + 16 * ks + 8 * hh);
#pragma unroll
            for (int s2 = 0; s2 < 2; ++s2)
#pragma unroll
                for (int dt = 0; dt < 2; ++dt) { const bf16* vp = VTp + (size_t)(32 * dt + r32) * vstr + kb + 16 * s2 + 4 * hh; vf[i][s2][dt][0] = *(const GAS v2u*)vp; vf[i][s2][dt][1] = *(const GAS v2u*)(vp + 8); } }
#pragma unroll
        for (int i = 0; i < GB; ++i) if (b0 + i < nblk) { const int kb = kb_lo + 32 * (b0 + i);
            f32x16 s;
#pragma unroll
            for (int r = 0; r < 16; ++r) s[r] = 0.f;
#pragma unroll
            for (int ks = 0; ks < 4; ++ks) s = mfma32(kf[i][ks], qf[ks], s);
            if (MASKED) {
#pragma unroll
                for (int r = 0; r < 16; ++r) { const int rel = qpos - (kb + crow32(r, hh)); if (rel < 0 || rel >= 128) s[r] = -1e30f; } }
            float bm = s[0];
#pragma unroll
            for (int r = 1; r < 16; ++r) bm = fmaxf(bm, s[r]);
            bm = max_x32(bm);
            const float mn = fmaxf(m, bm), alpha = __builtin_amdgcn_exp2f(m - mn); m = mn;
            float ps = 0.f;
#pragma unroll
            for (int r = 0; r < 16; ++r) { s[r] = __builtin_amdgcn_exp2f(s[r] - mn); ps += s[r]; }
            l = l * alpha + ps;
#pragma unroll
            for (int r = 0; r < 16; ++r) { o0[r] *= alpha; o1[r] *= alpha; }
#pragma unroll
            for (int s2 = 0; s2 < 2; ++s2) {
                v4u pw; pw.x = cvt_pk_bf16(s[8 * s2], s[8 * s2 + 1]); pw.y = cvt_pk_bf16(s[8 * s2 + 2], s[8 * s2 + 3]); pw.z = cvt_pk_bf16(s[8 * s2 + 4], s[8 * s2 + 5]); pw.w = cvt_pk_bf16(s[8 * s2 + 6], s[8 * s2 + 7]);
                const bf16x8 pb = __builtin_bit_cast(bf16x8, pw);
                { v4u aw; aw.x = vf[i][s2][0][0].x; aw.y = vf[i][s2][0][0].y; aw.z = vf[i][s2][0][1].x; aw.w = vf[i][s2][0][1].y; o0 = mfma32(__builtin_bit_cast(bf16x8, aw), pb, o0); }
                { v4u aw; aw.x = vf[i][s2][1][0].x; aw.y = vf[i][s2][1][0].y; aw.z = vf[i][s2][1][1].x; aw.w = vf[i][s2][1][1].y; o1 = mfma32(__builtin_bit_cast(bf16x8, aw), pb, o1); } }
        }
    }
    lsum = add_x32(l);
}
__device__ __forceinline__ void flash_store(bf16* dst  , int rstride, const f32x16& o0, const f32x16& o1, float lsum, int lane) {
    const int r32 = lane & 31, hh = lane >> 5; const float inv = 1.0f / lsum; bf16* p = dst + (size_t)r32 * rstride + 4 * hh;
#pragma unroll
    for (int k = 0; k < 4; ++k) { *(GAS v2u*)(p + 8 * k) = pack4((f32x4){o0[4 * k] * inv, o0[4 * k + 1] * inv, o0[4 * k + 2] * inv, o0[4 * k + 3] * inv});
        *(GAS v2u*)(p + 32 + 8 * k) = pack4((f32x4){o1[4 * k] * inv, o1[4 * k + 1] * inv, o1[4 * k + 2] * inv, o1[4 * k + 3] * inv}); }
}
constexpr int KL_STR = 144;
template <bool MASKED>
__device__ __forceinline__ void flash32_lds(const bf16x8 (&qf)[4], const LAS unsigned char* Kl, const LAS unsigned char* Vl, int vstr, int lk_lo, int nblk, int kpos_lo, int qpos, float m0, float l0,
                                            f32x16& o0, f32x16& o1, float& lsum, int lane) {
    const int r32 = lane & 31, hh = lane >> 5;
    float m = m0, l = hh == 0 ? l0 : 0.f;
#pragma unroll
    for (int r = 0; r < 16; ++r) { o0[r] = 0.f; o1[r] = 0.f; }
    for (int blk = 0; blk < nblk; ++blk) { const int lk = lk_lo + 32 * blk;
        f32x16 s;
#pragma unroll
        for (int r = 0; r < 16; ++r) s[r] = 0.f;
#pragma unroll
        for (int ks = 0; ks < 4; ++ks) s = mfma32(*(const LAS bf16x8*)(Kl + (lk + r32) * KL_STR + (16 * ks + 8 * hh) * 2), qf[ks], s);
        if (MASKED && (blk == 0 || blk == nblk - 1)) {
#pragma unroll
            for (int r = 0; r < 16; ++r) { const int rel = qpos - (kpos_lo + 32 * blk + crow32(r, hh)); if (rel < 0 || rel >= 128) s[r] = -1e30f; } }
        float bm = s[0];
#pragma unroll
        for (int r = 1; r < 16; ++r) bm = fmaxf(bm, s[r]);
        bm = max_x32(bm);
        const float mn = fmaxf(m, bm), alpha = __builtin_amdgcn_exp2f(m - mn); m = mn;
        float ps = 0.f;
#pragma unroll
        for (int r = 0; r < 16; ++r) { s[r] = __builtin_amdgcn_exp2f(s[r] - mn); ps += s[r]; }
        l = l * alpha + ps;
#pragma unroll
        for (int r = 0; r < 16; ++r) { o0[r] *= alpha; o1[r] *= alpha; }
#pragma unroll
        for (int s2 = 0; s2 < 2; ++s2) {
            v4u pw; pw.x = cvt_pk_bf16(s[8 * s2], s[8 * s2 + 1]); pw.y = cvt_pk_bf16(s[8 * s2 + 2], s[8 * s2 + 3]); pw.z = cvt_pk_bf16(s[8 * s2 + 4], s[8 * s2 + 5]); pw.w = cvt_pk_bf16(s[8 * s2 + 6], s[8 * s2 + 7]);
            const bf16x8 pb = __builtin_bit_cast(bf16x8, pw);
#pragma unroll
            for (int dt = 0; dt < 2; ++dt) { const LAS unsigned char* vp = Vl + (32 * dt + r32) * vstr + (lk + 16 * s2 + 4 * hh) * 2;
                const v2u a0 = *(const LAS v2u*)vp, a1 = *(const LAS v2u*)(vp + 16); v4u aw; aw.x = a0.x; aw.y = a0.y; aw.z = a1.x; aw.w = a1.y;
                if (dt == 0) o0 = mfma32(__builtin_bit_cast(bf16x8, aw), pb, o0); else o1 = mfma32(__builtin_bit_cast(bf16x8, aw), pb, o1); } }
    }
    lsum = add_x32(l);
}
template <bool VT>
__device__ __forceinline__ void stage_kv(LAS unsigned char* Kl, LAS unsigned char* Vl, int vstr, const bf16* Kg, int kstr, const bf16* Vg, int vstr_g, int nkeys, int tid) {
    for (int id = tid; id < nkeys * 8; id += NWAVES * 64) { const int key = id >> 3, ch = id & 7; *(LAS v4u*)(Kl + key * KL_STR + ch * 16) = *(const GAS v4u*)(Kg + (size_t)key * kstr + ch * 8); }
    if (VT) { const int cpr = nkeys >> 3;
        for (int id = tid; id < 64 * cpr; id += NWAVES * 64) { const int d = id / cpr, ch = id % cpr; *(LAS v4u*)(Vl + d * vstr + ch * 16) = *(const GAS v4u*)(Vg + (size_t)d * vstr_g + ch * 8); } }
    else for (int id = tid; id < nkeys * 8; id += NWAVES * 64) { const int key = id >> 3, ch = id & 7; const v4u w = *(const GAS v4u*)(Vg + (size_t)key * vstr_g + ch * 8);
        LAS unsigned char* p = Vl + (8 * ch) * vstr + key * 2;
        *(LAS bf16*)(p) = (bf16)(w.x & 0xffffu); *(LAS bf16*)(p + vstr) = (bf16)(w.x >> 16); *(LAS bf16*)(p + 2 * vstr) = (bf16)(w.y & 0xffffu); *(LAS bf16*)(p + 3 * vstr) = (bf16)(w.y >> 16);
        *(LAS bf16*)(p + 4 * vstr) = (bf16)(w.z & 0xffffu); *(LAS bf16*)(p + 5 * vstr) = (bf16)(w.z >> 16); *(LAS bf16*)(p + 6 * vstr) = (bf16)(w.w & 0xffffu); *(LAS bf16*)(p + 7 * vstr) = (bf16)(w.w >> 16); }
}
__device__ __forceinline__ void memattn_prompt_unit(Frame& F, int layer, int unit) {
    int lane_ = F.lane; asm volatile("" : "+v"(lane_)); const int lane = lane_, r32 = lane & 31, hh = lane >> 5;
    const int b = unit >> 7, hm = (unit >> 5) & 3, qblk = unit & 31; const int row = b * T + qblk * 256 + F.wave * 32 + r32;
    LAS unsigned char* Kl = F.lds; LAS unsigned char* Vl = F.lds + 256 * KL_STR; constexpr int VSTR = 256 * 2 + 16;
    __syncthreads();
    stage_kv<true>(Kl, Vl, VSTR, (const bf16*)(F.ws + WS_MK) + (size_t)((layer * 2 + b) * 4 + hm) * 256 * 64, 64, (const bf16*)(F.ws + WS_MVT) + (size_t)((layer * 2 + b) * 4 + hm) * 64 * 256, 256, 256, F.wave * 64 + lane);
    bf16x8 qf[4];
    if (layer == 0) { const bf16* qp = (const bf16*)(F.ws + WS_PROJ) + (size_t)row * NCOLA + RWKV_COLS + hm * 64; const float* gn = F.in[I_MQN];
        float x[4][8]; float ss = 0.f;
#pragma unroll
        for (int ks = 0; ks < 4; ++ks) { const v4u w = *(const GAS v4u*)(qp + 16 * ks + 8 * hh); const unsigned ww[4] = {w.x, w.y, w.z, w.w};
#pragma unroll
            for (int i = 0; i < 4; ++i) { x[ks][2 * i] = bflo(ww[i]); x[ks][2 * i + 1] = bfhi(ww[i]); ss += x[ks][2 * i] * x[ks][2 * i] + x[ks][2 * i + 1] * x[ks][2 * i + 1]; } }
        ss = add_x32(ss); const float rs = rsqrtf(ss * (1.0f / 64.0f) + 1e-6f) * C2Q;
#pragma unroll
        for (int ks = 0; ks < 4; ++ks) {
#pragma unroll
            for (int i = 0; i < 8; ++i) x[ks][i] *= rs * gn[16 * ks + 8 * hh + i];
            qf[ks] = pack_frag(x[ks]); }
    } else { const bf16* qp = (const bf16*)(F.ws + WS_Q1) + (size_t)row * DM + 768 + hm * 64;
#pragma unroll
        for (int ks = 0; ks < 4; ++ks) qf[ks] = *(const GAS bf16x8*)(qp + 16 * ks + 8 * hh); }
    __syncthreads();
    f32x16 o0, o1; float ls;
    flash32_lds<false>(qf, Kl, Vl, VSTR, 0, 8, 0, 0, -1e30f, 0.f, o0, o1, ls, lane);
    flash_store((bf16*)(F.ws + WS_MIX) + (size_t)(b * T + qblk * 256 + F.wave * 32) * DM + 768 + hm * 64, DM, o0, o1, ls, lane);
}
__device__ __forceinline__ void swa_prompt_unit(Frame& F, int unit) {
    int lane_ = F.lane; asm volatile("" : "+v"(lane_)); const int lane = lane_, r32 = lane & 31, hh = lane >> 5;
    const int b = unit >> 7, kvh = (unit >> 5) & 3, qblk = unit & 31, q0 = qblk * 256, kb0 = q0 >= 128 ? q0 - 128 : 0, nkeys = q0 + 256 - kb0;
    LAS unsigned char* Kl = F.lds; LAS unsigned char* Vl = F.lds + 384 * KL_STR; constexpr int VSTR = 384 * 2 + 16;
    __syncthreads();
    stage_kv<false>(Kl, Vl, VSTR, (const bf16*)(F.ws + WS_K1) + (size_t)(b * T + kb0) * 256 + kvh * 64, 256, (const bf16*)(F.ws + WS_V1) + (size_t)(b * T + kb0) * 256 + kvh * 64, 256, nkeys, F.wave * 64 + lane);
    const int tq = q0 + F.wave * 32, row = b * T + tq + r32;
    bf16x8 qf[3][4];
#pragma unroll
    for (int gq = 0; gq < 3; ++gq) { const bf16* qp = (const bf16*)(F.ws + WS_Q1) + (size_t)row * DM + (kvh * 3 + gq) * 64;
#pragma unroll
        for (int ks = 0; ks < 4; ++ks) qf[gq][ks] = *(const GAS bf16x8*)(qp + 16 * ks + 8 * hh); }
    __syncthreads();
    const int kp_lo = tq >= 128 ? tq - 128 : 0, nblk = (tq - kp_lo) / 32 + 1;
#pragma unroll
    for (int gq = 0; gq < 3; ++gq) { const int hq = kvh * 3 + gq; const float sink = F.in[I_SINKS][hq] * LOG2E;
        f32x16 o0, o1; float ls;
        flash32_lds<true>(qf[gq], Kl, Vl, VSTR, kp_lo - kb0, nblk, kp_lo, tq + r32, sink, 1.0f, o0, o1, ls, lane);
        flash_store((bf16*)(F.ws + WS_MIX) + (size_t)(b * T + tq) * DM + hq * 64, DM, o0, o1, ls, lane); }
}
template <int NQ, bool WINDOW>
__device__ __forceinline__ void small_attn(const LAS float* ql, LAS float* sc, int NKP, const float* k1, const float* v1, int kst1, int nk1, const bf16* k2, const bf16* v2, int kst2, int nk2,
                                           const float* sinkg  , bf16* out0, int ostride_q, int lane) {
    const int sub = lane >> 4, dq = lane & 15, nk = nk1 + nk2;
    f32x4 qv[NQ];
#pragma unroll
    for (int qi = 0; qi < NQ; ++qi) qv[qi] = *(const LAS f32x4*)(ql + qi * 64 + 4 * dq);
    constexpr int KBAT = NQ > 4 ? 4 : 8;
    for (int kg0 = 0; kg0 < nk1; kg0 += 4 * KBAT) { f32x4 kv[KBAT];
#pragma unroll
        for (int u = 0; u < KBAT; ++u) kv[u] = *(const GAS f32x4*)(k1 + (size_t)(kg0 + 4 * u + sub) * kst1 + 4 * dq);
        __builtin_amdgcn_sched_barrier(0);
#pragma unroll
        for (int u = 0; u < KBAT; ++u) { const int key = kg0 + 4 * u + sub;
#pragma unroll
            for (int qi = 0; qi < NQ; ++qi) { const f32x4 p = qv[qi] * kv[u]; const float s = sum16((p[0] + p[1]) + (p[2] + p[3])); if (dq == 0) sc[qi * NKP + key] = s; } } }
    for (int kg = nk1; kg < nk; kg += 4) { const int key = kg + sub; const f32x4 kv = unpack4(*(const GAS v2u*)(k2 + (size_t)(key - nk1) * kst2 + 4 * dq));
#pragma unroll
        for (int qi = 0; qi < NQ; ++qi) { const f32x4 p = qv[qi] * kv; const float s = sum16((p[0] + p[1]) + (p[2] + p[3])); if (dq == 0) sc[qi * NKP + key] = s; } }
    LDS_WAIT(); asm volatile("" ::: "memory");
#pragma unroll
    for (int qi = 0; qi < NQ; ++qi) { float sv[5]; const float sk_ = sinkg ? sinkg[qi >> 2] * LOG2E : -1e30f; float mx = sk_;
#pragma unroll
        for (int t = 0; t < 5; ++t) { const int key = lane + 64 * t; float s = -1e30f; if (key < nk) { s = sc[qi * NKP + key]; if (WINDOW) { const int i = qi & 3; if (key < i + 1 || key > 128 + i) s = -1e30f; } } sv[t] = s; mx = fmaxf(mx, s); }
        mx = wave_max(mx); float sum = 0.f;
#pragma unroll
        for (int t = 0; t < 5; ++t) { sv[t] = __builtin_amdgcn_exp2f(sv[t] - mx); sum += sv[t]; }
        sum = wave_sum(sum) + (sinkg ? __builtin_amdgcn_exp2f(sk_ - mx) : 0.f); const float inv = 1.0f / sum;
#pragma unroll
        for (int t = 0; t < 5; ++t) { const int key = lane + 64 * t; if (key < nk) sc[qi * NKP + key] = sv[t] * inv; } }
    LDS_WAIT(); asm volatile("" ::: "memory");
    f32x4 acc[NQ];
#pragma unroll
    for (int qi = 0; qi < NQ; ++qi) acc[qi] = (f32x4){0.f, 0.f, 0.f, 0.f};
    for (int kg0 = 0; kg0 < nk1; kg0 += 4 * KBAT) { f32x4 vv[KBAT];
#pragma unroll
        for (int u = 0; u < KBAT; ++u) vv[u] = *(const GAS f32x4*)(v1 + (size_t)(kg0 + 4 * u + sub) * kst1 + 4 * dq);
        __builtin_amdgcn_sched_barrier(0);
#pragma unroll
        for (int u = 0; u < KBAT; ++u) { const int key = kg0 + 4 * u + sub;
#pragma unroll
            for (int qi = 0; qi < NQ; ++qi) acc[qi] += vv[u] * sc[qi * NKP + key]; } }
    for (int kg = nk1; kg < nk; kg += 4) { const int key = kg + sub; const f32x4 vv = unpack4(*(const GAS v2u*)(v2 + (size_t)(key - nk1) * kst2 + 4 * dq));
#pragma unroll
        for (int qi = 0; qi < NQ; ++qi) acc[qi] += vv * sc[qi * NKP + key]; }
#pragma unroll
    for (int qi = 0; qi < NQ; ++qi) { f32x4 a = acc[qi];
#pragma unroll
        for (int e = 0; e < 4; ++e) { a[e] = add_x16(a[e]); a[e] = add_x32(a[e]); }
        if (sub == 0) *(GAS v2u*)(out0 + (size_t)(qi & 3) * ostride_q + (qi >> 2) * 64 + 4 * dq) = pack4(a); }
    LDS_WAIT(); asm volatile("" ::: "memory");
}
template <int NQ, bool WINDOW>
__device__ __forceinline__ void small_attn2(bool valid, int half, const LAS float* ql, LAS float* sc, LAS float* xch, int NKP, const float* k1, const float* v1, int kst1, int nk1,
                                            const bf16* k2, const bf16* v2, int kst2, int nk2, const float* sinkg, bf16* out0, int ostride_q, int lane) {
    const int sub = lane >> 4, dq = lane & 15, nk = nk1 + nk2, klo = half ? nk1 / 2 : 0, khi = half ? nk1 : nk1 / 2, kend = half ? nk : khi;
    constexpr int KBAT = 4;
    f32x4 qv[NQ]; float mloc[NQ];
    if (valid) {
#pragma unroll
        for (int qi = 0; qi < NQ; ++qi) qv[qi] = *(const LAS f32x4*)(ql + qi * 64 + 4 * dq);
        for (int kg0 = klo; kg0 < khi; kg0 += 4 * KBAT) { f32x4 kv[KBAT];
#pragma unroll
            for (int u = 0; u < KBAT; ++u) kv[u] = *(const GAS f32x4*)(k1 + (size_t)(kg0 + 4 * u + sub) * kst1 + 4 * dq);
            __builtin_amdgcn_sched_barrier(0);
#pragma unroll
            for (int u = 0; u < KBAT; ++u) { const int key = kg0 + 4 * u + sub;
#pragma unroll
                for (int qi = 0; qi < NQ; ++qi) { const f32x4 p = qv[qi] * kv[u]; const float s = sum16((p[0] + p[1]) + (p[2] + p[3])); if (dq == 0) sc[qi * NKP + key] = s; } } }
        if (half) for (int kg = nk1; kg < nk; kg += 4) { const int key = kg + sub; const f32x4 kv = unpack4(*(const GAS v2u*)(k2 + (size_t)(key - nk1) * kst2 + 4 * dq));
#pragma unroll
            for (int qi = 0; qi < NQ; ++qi) { const f32x4 p = qv[qi] * kv; const float s = sum16((p[0] + p[1]) + (p[2] + p[3])); if (dq == 0) sc[qi * NKP + key] = s; } }
        LDS_WAIT(); asm volatile("" ::: "memory");
#pragma unroll
        for (int qi = 0; qi < NQ; ++qi) { float mx = -1e30f;
#pragma unroll
            for (int t = 0; t < 3; ++t) { const int key = klo + lane + 64 * t; if (key < kend) { float s = sc[qi * NKP + key]; if (WINDOW) { const int i = qi & 3; if (key < i + 1 || key > 128 + i) s = -1e30f; } mx = fmaxf(mx, s); } }
            mloc[qi] = wave_max(mx); if (lane == 0) xch[half * NQ + qi] = mloc[qi]; }
    }
    __syncthreads();
    if (valid) {
#pragma unroll
        for (int qi = 0; qi < NQ; ++qi) { const float sk_ = sinkg ? sinkg[qi >> 2] * LOG2E : -1e30f; const float m = fmaxf(fmaxf(xch[qi], xch[NQ + qi]), sk_); float sum = 0.f;
#pragma unroll
            for (int t = 0; t < 3; ++t) { const int key = klo + lane + 64 * t; if (key < kend) { float s = sc[qi * NKP + key]; if (WINDOW) { const int i = qi & 3; if (key < i + 1 || key > 128 + i) s = -1e30f; }
                    const float p = __builtin_amdgcn_exp2f(s - m); sc[qi * NKP + key] = p; sum += p; } }
            sum = wave_sum(sum); if (half == 0 && sinkg) sum += __builtin_amdgcn_exp2f(sk_ - m);
            if (lane == 0) xch[2 * NQ + half * NQ + qi] = sum; }
        LDS_WAIT(); asm volatile("" ::: "memory");
    }
    __syncthreads();
    if (valid) {
        f32x4 acc[NQ];
#pragma unroll
        for (int qi = 0; qi < NQ; ++qi) acc[qi] = (f32x4){0.f, 0.f, 0.f, 0.f};
        for (int kg0 = klo; kg0 < khi; kg0 += 4 * KBAT) { f32x4 vv[KBAT];
#pragma unroll
            for (int u = 0; u < KBAT; ++u) vv[u] = *(const GAS f32x4*)(v1 + (size_t)(kg0 + 4 * u + sub) * kst1 + 4 * dq);
            __builtin_amdgcn_sched_barrier(0);
#pragma unroll
            for (int u = 0; u < KBAT; ++u) { const int key = kg0 + 4 * u + sub;
#pragma unroll
                for (int qi = 0; qi < NQ; ++qi) acc[qi] += vv[u] * sc[qi * NKP + key]; } }
        if (half) for (int kg = nk1; kg < nk; kg += 4) { const int key = kg + sub; const f32x4 vv = unpack4(*(const GAS v2u*)(v2 + (size_t)(key - nk1) * kst2 + 4 * dq));
#pragma unroll
            for (int qi = 0; qi < NQ; ++qi) acc[qi] += vv * sc[qi * NKP + key]; }
#pragma unroll
        for (int qi = 0; qi < NQ; ++qi) { f32x4 a = acc[qi]; const float inv = 1.0f / (xch[2 * NQ + qi] + xch[3 * NQ + qi]);
#pragma unroll
            for (int e = 0; e < 4; ++e) { a[e] = add_x16(a[e]); a[e] = add_x32(a[e]); a[e] *= inv; }
            acc[qi] = a;
            if (half == 1 && sub == 0) *(LAS f32x4*)(xch + 4 * NQ + qi * 64 + 4 * dq) = a; }
        LDS_WAIT(); asm volatile("" ::: "memory");
        __syncthreads();
        if (half == 0 && sub == 0) {
#pragma unroll
            for (int qi = 0; qi < NQ; ++qi) { const f32x4 o = acc[qi] + *(const LAS f32x4*)(xch + 4 * NQ + qi * 64 + 4 * dq); *(GAS v2u*)(out0 + (size_t)(qi & 3) * ostride_q + (qi >> 2) * 64 + 4 * dq) = pack4(o); } }
    } else __syncthreads();
    LDS_WAIT(); asm volatile("" ::: "memory");
}
__device__ __forceinline__ void memattn_sample_task(Frame& F, int layer, int task, bool valid, LAS float* wl, LAS float* xch) {
    int lane_ = F.lane; asm volatile("" : "+v"(lane_)); const int lane = lane_, b = task >> 2, hm = task & 3; LAS float* ql = wl; LAS float* sc = wl + 12 * 64;
    if (valid) {
#pragma unroll
        for (int i = 0; i < 4; ++i) { const int row = RP + b * ST + i; float x;
            if (layer == 0) { x = bf2f(((const bf16*)(F.ws + WS_PROJ))[(size_t)row * NCOLA + RWKV_COLS + hm * 64 + lane]); const float ss = wave_sum(x * x); x *= rsqrtf(ss * (1.0f / 64.0f) + 1e-6f) * C2Q * F.in[I_MQN][lane]; }
            else x = bf2f(((const bf16*)(F.ws + WS_Q1))[(size_t)row * DM + 768 + hm * 64 + lane]);
            ql[i * 64 + lane] = x; }
        LDS_WAIT(); asm volatile("" ::: "memory"); }
    const float* k1 = F.in[I_CMK] + (((size_t)layer * SB + b) * NMEM * 4 + hm) * 64; const float* v1 = F.in[I_CMV] + (((size_t)layer * SB + b) * NMEM * 4 + hm) * 64;
    small_attn2<4, false>(valid, F.wave & 1, ql, sc, xch, 264, k1, v1, 256, 256, nullptr, nullptr, 0, 0, nullptr, (bf16*)(F.ws + WS_MIX) + (size_t)(RP + b * ST) * DM + 768 + hm * 64, DM, lane);
}
__device__ __forceinline__ void swa_sample_task(Frame& F, int task, bool valid, LAS float* wl, LAS float* xch) {
    int lane_ = F.lane; asm volatile("" : "+v"(lane_)); const int lane = lane_, b = task >> 2, kvh = task & 3; LAS float* ql = wl; LAS float* sc = wl + 12 * 64;
    if (valid) {
#pragma unroll
        for (int qi = 0; qi < 12; ++qi) { const int i = qi & 3, gq = qi >> 2, hq = kvh * 3 + gq; const int row = RP + b * ST + i;
            ql[qi * 64 + lane] = bf2f(((const bf16*)(F.ws + WS_Q1))[(size_t)row * DM + hq * 64 + lane]); }
        LDS_WAIT(); asm volatile("" ::: "memory"); }
    const float* k1 = F.in[I_CSK] + ((size_t)b * 128 * 4 + kvh) * 64; const float* v1 = F.in[I_CSV] + ((size_t)b * 128 * 4 + kvh) * 64;
    const bf16* k2 = (const bf16*)(F.ws + WS_K1) + (size_t)(RP + b * ST) * 256 + kvh * 64; const bf16* v2 = (const bf16*)(F.ws + WS_V1) + (size_t)(RP + b * ST) * 256 + kvh * 64;
    small_attn2<12, true>(valid, F.wave & 1, ql, sc, xch, 136, k1, v1, 256, 128, k2, v2, 256, 4, F.in[I_SINKS] + kvh * 3, (bf16*)(F.ws + WS_MIX) + (size_t)(RP + b * ST) * DM + kvh * 3 * 64, DM, lane);
}

constexpr int N_PHASES = 13;
template <int PM> __global__ void __launch_bounds__(NWAVES * 64, 2) yoco_fwd(Args args) {
    extern __shared__ __attribute__((aligned(16))) unsigned char lds[];
    Frame F;
    F.lds = (LAS unsigned char*)lds; F.lds_g = lds;
    F.wave = __builtin_amdgcn_readfirstlane((int)threadIdx.x >> 6); F.lane = mk_lane(); F.tid = F.wave * 64 + F.lane;
    F.G = gridDim.x; { const int bx = blockIdx.x; F.vcu = (F.G % 8 == 0) ? (bx % 8) * (F.G / 8) + bx / 8 : bx; }
    F.in = args.in; F.out = args.out; F.ws = args.ws; F.ctl = (gu32*)(args.ws + WS_CTL);
    for (int u = F.tid; u < (LDS_BYTES - LDSCTL_OFF) / 4; u += NWAVES * 64) ((LAS unsigned*)(F.lds + LDSCTL_OFF))[u] = 0u;
    __syncthreads();
    const int lo = args.ph_lo, hi = args.ph_hi;
    XcdBarrier bar; bar.wave0 = F.wave == 0; bar.bar = (unsigned*)(F.ctl + CW_BAR); bar.x = 0; bar.st = nullptr;
    bar = xcd_barrier_post((unsigned*)(F.ctl + CW_BAR), (volatile LAS unsigned*)(F.lds + MISC_OFF) + 8, F.wave == 0);
#define IN(k) (((PM >> (k)) & 1) && lo <= (k) && (k) < hi)
#ifndef MK_DUP
#define MK_DUP -1
#endif
#define PH_REP(k) ((MK_DUP == (k)) ? 2 : 1)
#ifndef MK_TIME
#define MK_TIME -1
#endif
#define STAMP(k) do { if (MK_TIME >= 0 && blockIdx.x == 0 && F.wave == 0 && mk_lane() == 0) ((volatile LAS unsigned long long*)(F.lds + LDSCTL_OFF + 512))[(k)] = __builtin_amdgcn_s_memrealtime(); } while (0)
#define SEAM(k) do { if (IN(k) && IN((k) + 1)) xcd_barrier(bar); STAMP((k) + 1); } while (0)
    const int gw = F.vcu * NWAVES + F.wave, NGW = F.G * NWAVES;
    STAMP(0);
#define SSQ ((float*)(F.ws + WS_SSQ))
#define HB ((bf16*)(F.ws + WS_HB))
#define MIX ((bf16*)(F.ws + WS_MIX))
#define HH ((bf16*)(F.ws + WS_H))
#define PHASE_BEGIN() do { int z_ = 0; unsigned char* ws_ = args.ws; float* out_ = args.out; asm volatile("" : "+s"(z_), "+s"(ws_), "+s"(out_)); F.in = args.in + z_; F.ws = ws_; F.out = out_; \
                           F.lane = mk_lane(); F.tid = F.wave * 64 + F.lane; } while (0)

    if (IN(0)) for (int rep_ = 0; rep_ < PH_REP(0); ++rep_) { PHASE_BEGIN(); p0_prologue(F); } SEAM(0);

    if (IN(1)) for (int rep_ = 0; rep_ < PH_REP(1); ++rep_) { PHASE_BEGIN();
#ifndef NO_MEMKV
        { pg8::Gemm g{(const bf16*)(F.ws + WS_MB), (const bf16*)(F.ws + WS_WM), 512, 1024, DM}; pg8::StaticOrder S; S.init(512, 1024, F.G, (int)((blockIdx.x + 8) % F.G), DM);
          pg8::EpiMemKV E{F.ws, F.out, F.in[I_MKN]};
          pg8::gemm_phase<pg8::EpiMemKV, pg8::StaticOrder, true, true>(F.lds + RING_OFF, g, S, E, F.wave, F.lane); }
#endif
        { pg8::Gemm g{HB, (const bf16*)(F.ws + WS_WA), R, NCOLA, DM}; pg8::StaticOrder S; S.init(R, NCOLA, F.G, (int)blockIdx.x, DM);
          pg8::EpiScaleBf16<0> E{(bf16*)(F.ws + WS_PROJ), NCOLA, SSQ};
          pg8::gemm_phase<pg8::EpiScaleBf16<0>, pg8::StaticOrder, true, true>(F.lds + RING_OFF, g, S, E, F.wave, F.lane); }
    } SEAM(1);

    if (IN(2)) for (int rep_ = 0; rep_ < ((MK_DUP == 2 || (MK_DUP >= 20 && MK_DUP < 30)) ? 2 : 1); ++rep_) { PHASE_BEGIN();
        const int half = F.wave >> 2; const int gw = F.vcu * NWAVES + F.wave, NGW = F.G * NWAVES;
        LAS unsigned char* hb = F.lds + half * PREP_HALF; LAS float* wtot = (LAS float*)(F.lds + WTOT_OFF + half * 1024);
        const int slim = (rep_ == 1 && MK_DUP == 21) ? 3 : (rep_ == 1 && MK_DUP == 22) ? 5 : 99;
        if (!(rep_ == 1 && MK_DUP == 20)) { LAS unsigned char* prow = F.lds + WTOT_OFF + 2048 + half * 512; PrepPf pf; if (F.vcu < NUNIT / 2) prep_issue(F, 2 * F.vcu + half, pf);
            for (int pi = F.vcu; pi < NUNIT / 2; pi += F.G) rwkv_prep_unit(F, 2 * pi + half, hb, wtot, prow, pf, pi + F.G < NUNIT / 2, 2 * (pi + F.G) + half, slim); }
        STAMP(14);
        if (!(rep_ == 1 && (MK_DUP == 21 || MK_DUP == 22))) for (int t = gw; t < SB * NH + 2; t += NGW) {
            if (t < SB * NH) rwkv_sample_task(F, t);
            else { const int b = t - SB * NH; const bf16* lr = (const bf16*)(F.ws + WS_PROJ) + (size_t)(b * T + T - 1) * NCOLA; float* o = F.out + O_PSHIFT + (size_t)b * RWKV_COLS;
                for (int q = F.lane; q < RWKV_COLS; q += 64) o[q] = bf2f(lr[q]); } }
        { const int nsw = (SB * NH + 2 + NWAVES - 1) / NWAVES;
          if (rep_ == 0 && F.vcu >= nsw && F.G > nsw) { __syncthreads(); p0_weights(F, 1, (F.vcu - nsw) * NWAVES + F.wave, (F.G - nsw) * NWAVES, (LAS float*)(F.lds + F.wave * 16384)); }
          else if (rep_ == 0 && F.G <= nsw) { __syncthreads(); p0_weights(F, 1, gw, NGW, (LAS float*)(F.lds + F.wave * 16384)); } }
    } SEAM(2);

    if (IN(3)) for (int rep_ = 0; rep_ < ((MK_DUP == 30 || MK_DUP == 31) ? 2 : 1); ++rep_) { PHASE_BEGIN();
        const int nscan = NB * NH * 4;
        const int nconv = (F.G - nscan) * NWAVES + nscan * 7;
        if (F.vcu < nscan) { if (rep_ == 0 || MK_DUP == 31) { rwkv_scan_chain(F, F.vcu >> 2, F.vcu & 3); if (F.wave == 0) STAMP(23); } }
        else if (rep_ == 0 || MK_DUP == 30) { LAS float* wl = (LAS float*)(F.lds + F.wave * 12288);
            for (int u = F.vcu - nscan; u < 256; u += F.G - nscan) memattn_prompt_unit(F, 0, u);
            __syncthreads();
            { LAS float* xch = (LAS float*)(F.lds + 8 * 12288) + (F.wave >> 1) * 1024; const int nwg = F.G - nscan, wgi = F.vcu - nscan;
              for (int it = 0; it * nwg * 4 < 512; ++it) { const int t = (it * nwg + wgi) * 4 + (F.wave >> 1); memattn_sample_task(F, 0, t, t < 512, wl, xch); } }
            }
    } SEAM(3);

    if (IN(4)) for (int rep_ = 0; rep_ < PH_REP(4); ++rep_) { PHASE_BEGIN(); _Pragma("unroll 2") for (int it = gw; it < NUNIT * 4; it += NGW) rwkv_yout_item(F, it); } SEAM(4); if (MK_DUP == 40) for (int i_ = 0; i_ < 10; ++i_) xcd_barrier(bar);

    if (IN(5)) for (int rep_ = 0; rep_ < PH_REP(5); ++rep_) { PHASE_BEGIN(); pg8::Gemm g{MIX, (const bf16*)(F.ws + WS_WOUT), R, DM, DM}; pg8::TailOrder S; S.init(F.G, (int)blockIdx.x, DM, S_K1);
        pg8::EpiResid E{F.in[I_XP], F.in[I_XS], RP, nullptr, HB, SSQ, (float*)(F.ws + WS_SLAB), S_K1};
        pg8::gemm_phase<pg8::EpiResid, pg8::TailOrder, true, true>(F.lds + RING_OFF, g, S, E, F.wave, F.lane); } SEAM(5);
    if (IN(6)) for (int rep_ = 0; rep_ < PH_REP(6); ++rep_) { PHASE_BEGIN(); finalize_sample(F, F.in[I_XS], S_K1, false); xcd_barrier(bar);
        pg8::Gemm g{HB, (const bf16*)(F.ws + WS_WUP), R, FF, DM}; pg8::StaticOrder S; S.init(R, FF, F.G, (int)blockIdx.x, DM);
        pg8::EpiScaleBf16<1> E{HH, FF, SSQ, F.in[I_CSK], F.in[I_CSV], F.out + O_SSK, F.out + O_SSV, rep_ == 0 ? (R / 256) * (FF / 256) : 0};
        pg8::gemm_phase<pg8::EpiScaleBf16<1>, pg8::StaticOrder, true, true>(F.lds + RING_OFF, g, S, E, F.wave, F.lane); } SEAM(6);
    if (IN(7)) { PHASE_BEGIN(); pg8::Gemm g{HH, (const bf16*)(F.ws + WS_WDN), R, DM, FF}; pg8::TailOrder S; S.init(F.G, (int)blockIdx.x, FF, S_K4);
        pg8::EpiResid E{nullptr, nullptr, RP, nullptr, HB, SSQ, (float*)(F.ws + WS_SLAB), S_K4, HB};
        pg8::gemm_phase<pg8::EpiResid, pg8::TailOrder, true, true>(F.lds + RING_OFF, g, S, E, F.wave, F.lane); } SEAM(7);

    if (IN(8)) for (int rep_ = 0; rep_ < PH_REP(8); ++rep_) { PHASE_BEGIN(); finalize_sample(F, nullptr, S_K4, false); xcd_barrier(bar);
        pg8::Gemm g{HB, (const bf16*)(F.ws + WS_WB), R, NCOLB, DM}; pg8::StaticOrder S; S.init(R, NCOLB, F.G, (int)blockIdx.x, DM);
        pg8::EpiL1 E{F.ws, F.out, F.in[I_QN], F.in[I_MQN] + 64, F.in[I_KN]};
        pg8::gemm_phase<pg8::EpiL1, pg8::StaticOrder, true, true>(F.lds + RING_OFF, g, S, E, F.wave, F.lane); } SEAM(8);

    if (IN(9)) for (int rep_ = 0; rep_ < PH_REP(9); ++rep_) { PHASE_BEGIN(); LAS float* wl = (LAS float*)(F.lds + F.wave * 12288); const int gw = F.vcu * NWAVES + F.wave, NGW = F.G * NWAVES;
        for (int u = F.vcu; u < 256; u += F.G) swa_prompt_unit(F, u);
        for (int u = F.vcu; u < 256; u += F.G) memattn_prompt_unit(F, 1, u);
        __syncthreads();
        { LAS float* xch = (LAS float*)(F.lds + 8 * 12288) + (F.wave >> 1) * 1024;
          for (int it = 0; it * F.G * 4 < 1024; ++it) { const int t = (it * F.G + F.vcu) * 4 + (F.wave >> 1);
              if (it * F.G * 4 < 512) { if (t < 512) swa_sample_task(F, t, true, wl, xch); else memattn_sample_task(F, 1, t - 512, t < 1024, wl, xch); }
              else memattn_sample_task(F, 1, t - 512, t < 1024, wl, xch); } }
    } SEAM(9);

    if (IN(10)) for (int rep_ = 0; rep_ < PH_REP(10); ++rep_) { PHASE_BEGIN(); pg8::Gemm g{MIX, (const bf16*)(F.ws + WS_WOUT) + (size_t)DM * DM, R, DM, DM}; pg8::TailOrder S; S.init(F.G, (int)blockIdx.x, DM, S_K1);
        pg8::EpiResid E{nullptr, nullptr, RP, nullptr, HB, SSQ, (float*)(F.ws + WS_SLAB), S_K1, HB};
        pg8::gemm_phase<pg8::EpiResid, pg8::TailOrder, true, true>(F.lds + RING_OFF, g, S, E, F.wave, F.lane); } SEAM(10);
    if (IN(11)) for (int rep_ = 0; rep_ < PH_REP(11); ++rep_) { PHASE_BEGIN(); finalize_sample(F, nullptr, S_K1, false); xcd_barrier(bar);
        pg8::Gemm g{HB, (const bf16*)(F.ws + WS_WUP) + (size_t)DM * FF, R, FF, DM}; pg8::StaticOrder S; S.init(R, FF, F.G, (int)blockIdx.x, DM);
        pg8::EpiScaleBf16<1> E{HH, FF, SSQ};
        pg8::gemm_phase<pg8::EpiScaleBf16<1>, pg8::StaticOrder, true, true>(F.lds + RING_OFF, g, S, E, F.wave, F.lane); } SEAM(11);
    if (IN(12)) for (int rep_ = 0; rep_ < PH_REP(12); ++rep_) { PHASE_BEGIN(); pg8::Gemm g{HH, (const bf16*)(F.ws + WS_WDN) + (size_t)DM * FF, R, DM, FF}; pg8::TailOrder S; S.init(F.G, (int)blockIdx.x, FF, S_K4);
        pg8::EpiResid E{nullptr, nullptr, RP, F.out + O_Y, nullptr, nullptr, (float*)(F.ws + WS_SLAB), S_K4, HB};
        pg8::gemm_phase<pg8::EpiResid, pg8::TailOrder, true, true>(F.lds + RING_OFF, g, S, E, F.wave, F.lane);
        xcd_barrier(bar); finalize_sample(F, nullptr, S_K4, true); }
    STAMP(13);
    if (MK_TIME >= 0 && blockIdx.x == 0 && F.wave == 0 && mk_lane() == 0) {
        volatile LAS unsigned long long* ts = (volatile LAS unsigned long long*)(F.lds + LDSCTL_OFF + 512); const unsigned long long d = MK_TIME == 20 ? ts[14] - ts[2] : MK_TIME == 21 ? ts[3] - ts[14] : MK_TIME == 22 ? ts[15] - ts[14] : MK_TIME == 36 ? ts[23] - ts[3] : (MK_TIME >= 30 && MK_TIME < 36) ? ts[MK_TIME - 30 + 18] - ts[MK_TIME - 30 + 17] : MK_TIME == 23 ? ts[16] - ts[15] : ts[MK_TIME + 1] - ts[MK_TIME], t0 = __builtin_amdgcn_s_memrealtime();
        while (__builtin_amdgcn_s_memrealtime() - t0 < d) __builtin_amdgcn_s_sleep(8); }
#undef IN
#undef SEAM
#undef SSQ
#undef HB
#undef MIX
#undef HH
#undef PHASE_BEGIN
}

template <int PM> static void launch_pm(int grid, hipStream_t stream, const Args& a) { hipLaunchKernelGGL(yoco_fwd<PM>, dim3(grid), dim3(NWAVES * 64), LDS_BYTES, stream, a); }
template <int PM> static bool set_lds() { return hipFuncSetAttribute((const void*)yoco_fwd<PM>, hipFuncAttributeMaxDynamicSharedMemorySize, LDS_BYTES) == hipSuccess; }
extern "C" void kernel_launch(void* const* d_in, const int* in_sizes, int n_in, void* d_out, int out_size, void* d_ws, size_t ws_size, hipStream_t stream) {
    static int grid = 0;
    if (grid == 0) {
        if (n_in != N_IN || (size_t)out_size != O_END || ws_size < WS_END) { fprintf(stderr, "kernel_launch: unexpected shapes (n_in %d, out %d, ws %zu < %zu)\n", n_in, out_size, ws_size, (size_t)WS_END); grid = -1; return; }
        int dev = 0, cus = 0;
        if (hipGetDevice(&dev) != hipSuccess || hipDeviceGetAttribute(&cus, hipDeviceAttributeMultiprocessorCount, dev) != hipSuccess) { grid = -1; return; }
        bool ok = true;
#if MK_ONE_LAUNCH
        ok = set_lds<0x1fff>();
#else
        ok = set_lds<1>() && set_lds<2>() && set_lds<4>() && set_lds<8>() && set_lds<16>() && set_lds<32>() && set_lds<64>() && set_lds<128>() && set_lds<256>() && set_lds<512>() && set_lds<1024>() && set_lds<2048>() && set_lds<4096>();
#endif
        if (!ok) { grid = -1; return; }
        (void)hipGetLastError();
        grid = cus;
    }
    if (grid < 0) return;
    (void)hipMemsetAsync((char*)d_ws + WS_CTL, 0, CTL_ZERO_BYTES, stream);
    Args a{};
    for (int i = 0; i < N_IN; ++i) a.in[i] = (const float*)d_in[i];
    a.out = (float*)d_out; a.ws = (unsigned char*)d_ws;
#if MK_ONE_LAUNCH
    a.ph_lo = 0; a.ph_hi = N_PHASES; launch_pm<0x1fff>(grid, stream, a);
#else
#define LP(p) a.ph_lo = (p); a.ph_hi = (p) + 1; launch_pm<(1 << (p))>(grid, stream, a);
    LP(0) LP(1) LP(2) LP(3) LP(4) LP(5) LP(6) LP(7) LP(8) LP(9) LP(10) LP(11) LP(12)
#undef LP
#endif
}
```

```cpp
#include <hip/hip_runtime.h>
#include <cstdio>
#include <cstdint>
namespace pg8 {
#define PG8_LAS __attribute__((address_space(3)))
typedef unsigned short bf16_t;
typedef short bf16x8 __attribute__((ext_vector_type(8)));
typedef float f32x4 __attribute__((ext_vector_type(4)));
typedef unsigned u32x4 __attribute__((ext_vector_type(4)));
constexpr int BM = 256, BK = 64, HALF = 128, HTB = HALF * BK * 2  , STAGE_BYTES = 8 * HTB, NXCD = 8, WGM = 8;

__host__ __device__ __forceinline__ int lds_byte(int r, int c) { const int st = (r >> 4) * 2 + (c >> 5), rr = r & 15, cc = c & 31, ob = rr * 64 + cc * 2; return st * 1024 + (ob ^ (((ob >> 9) & 1) << 5)); }
__host__ __device__ __forceinline__ void stage_rc(int b, int& R, int& C) { const int st = b / 1024, sb = b % 1024, swz = sb ^ (((sb >> 9) & 1) << 5); R = (st >> 1) * 16 + swz / 64; C = (st & 1) * 32 + (swz % 64) / 2; }
__host__ __device__ __forceinline__ int perm32(int rho) { const int n = rho >> 4, i = rho & 15; return 8 * (i >> 2) + 4 * n + (i & 3); }

struct Unit { int pm, pn, kt0, nt; };
struct Gemm { const bf16_t* A; const bf16_t* Bt; int M, N, K; };

struct StaticOrder {
    int nM, nN, nwg, G, c, ntf;
    __host__ __device__ void init(int M, int N, int G_, int c_, int K_) { nM = M / BM; nN = N / BM; nwg = nM * nN; G = G_; c = c_; ntf = K_ / BK; }
    __host__ __device__ bool next(int i, Unit& u) const {
        const long L = (long)i * G + c; if (L >= nwg) return false;
        int wgid = (int)L; { const int q = nwg / NXCD, r = nwg % NXCD, xcd = wgid % NXCD, off = wgid / NXCD; wgid = (xcd < r ? xcd * (q + 1) : r * (q + 1) + (xcd - r) * q) + off; }
        const int nig = WGM * nN, gid = wgid / nig, fm = gid * WGM, gsz = (nM - fm) < WGM ? (nM - fm) : WGM;
        u.pm = fm + ((wgid % nig) % gsz); u.pn = (wgid % nig) / gsz; u.kt0 = 0; u.nt = ntf; return true;
    }
    __device__ __forceinline__ void a_ready(const Unit&) const {}
    __device__ __forceinline__ void done(const Unit&) const {}
};
struct TailOrder {
    StaticOrder P; int S, ntf;
    __host__ __device__ void init(int G_, int c_, int K_, int S_) { P.init(64 * BM, 4 * BM, G_, c_, K_); S = S_; ntf = K_ / BK; }
    __host__ __device__ bool next(int i, Unit& u) const {
        const long L = (long)i * P.G + P.c; if (L >= 256 + 8 * S) return false;
        const int Li = (int)L; const bool prm = Li < 256;
        const int w0 = prm ? Li : 0, wg = (w0 % NXCD) * (256 / NXCD) + w0 / NXCD, nig = WGM * 4, gid = wg / nig, fm = gid * WGM;
        const int pmP = fm + ((wg % nig) % WGM), pnP = (wg % nig) / WGM;
        const int Ls = prm ? 0 : Li - 256, tile = Ls / S, sl = Ls % S, nts = ntf / S;
        u.pm = prm ? pmP : 64 + (tile >> 2); u.pn = prm ? pnP : (tile & 3); u.nt = prm ? ntf : nts; u.kt0 = prm ? 0 : sl * nts; return true;
    }
    __device__ __forceinline__ void a_ready(const Unit&) const {}
    __device__ __forceinline__ void done(const Unit&) const {}
};


typedef float f32x2_t __attribute__((ext_vector_type(2))); typedef __bf16 bf16x2_t __attribute__((ext_vector_type(2)));
__device__ __forceinline__ unsigned cvt_pk_bf16(float lo, float hi) { f32x2_t v = {lo, hi}; bf16x2_t b = __builtin_convertvector(v, bf16x2_t); return __builtin_bit_cast(unsigned, b); }
__device__ __forceinline__ u32x4 pack8(f32x4 v0, f32x4 v1) { u32x4 w; w.x = cvt_pk_bf16(v0[0], v0[1]); w.y = cvt_pk_bf16(v0[2], v0[3]); w.z = cvt_pk_bf16(v1[0], v1[1]); w.w = cvt_pk_bf16(v1[2], v1[3]); return w; }

template <int M> __device__ __forceinline__ float swz_xor(float v) { return __int_as_float(__builtin_amdgcn_ds_swizzle(__float_as_int(v), (M << 10) | 0x1f)); }
__device__ __forceinline__ float add_x32(float v) { auto r = __builtin_amdgcn_permlane32_swap(__float_as_uint(v), __float_as_uint(v), false, false); return __uint_as_float(r[0]) + __uint_as_float(r[1]); }
__device__ __forceinline__ float max_x32(float v) { auto r = __builtin_amdgcn_permlane32_swap(__float_as_uint(v), __float_as_uint(v), false, false); return fmaxf(__uint_as_float(r[0]), __uint_as_float(r[1])); }
__device__ __forceinline__ float add_x16(float v) { return v + swz_xor<16>(v); }
template <int CTRL> __device__ __forceinline__ float dpp_mov(float v) { return __int_as_float(__builtin_amdgcn_update_dpp(0, __float_as_int(v), CTRL, 0xf, 0xf, false)); }
__device__ __forceinline__ float sum16_dpp(float v) { v += dpp_mov<0xB1>(v); v += dpp_mov<0x4E>(v); v += dpp_mov<0x141>(v); v += dpp_mov<0x140>(v); return v; }
__device__ __forceinline__ float max16_dpp(float v) { v = fmaxf(v, dpp_mov<0xB1>(v)); v = fmaxf(v, dpp_mov<0x4E>(v)); v = fmaxf(v, dpp_mov<0x141>(v)); v = fmaxf(v, dpp_mov<0x140>(v)); return v; }
__device__ __forceinline__ float sum4_dpp(float v) { v += dpp_mov<0xB1>(v); v += dpp_mov<0x4E>(v); return v; }
__device__ __forceinline__ float hsum4(f32x4 a) { return (a[0] + a[1]) + (a[2] + a[3]); }
__device__ __forceinline__ float row_rstd(const float* ssq, int row) {
    const f32x4* p = (const f32x4*)(ssq + (size_t)row * 16);
    const f32x4 a = p[0], b = p[1], c = p[2], d = p[3];
    const float s = (hsum4(a) + hsum4(b)) + (hsum4(c) + hsum4(d));
    return rsqrtf(s * (1.0f / 1024.0f) + 1e-6f);
}
template <int ACT> struct EpiScaleBf16 {
    static constexpr bool PERM = true, AFTER_DRAIN = false;
    bf16_t* O; int ldc; const float* ssq; const float* ck = nullptr; const float* cv = nullptr; float* ok = nullptr; float* ov = nullptr; int cpy_units = 0;
    __device__ __forceinline__ void operator()(const f32x4 (&acc)[2][2][4][2], const Unit& u, int wr, int wc, int fr_, int fq_) const {
        int fr = fr_, fq = fq_; asm volatile("" : "+v"(fr), "+v"(fq));
        constexpr int per = 124 * 256 / 4, tot = 128 * per;
        f32x4 c0[2], c1[2]; int ci[2] = {-1, -1};
        if (cpy_units > 0) { const int idx = u.pm * (ldc >> 8) + u.pn, lo = (int)((long)tot * idx / cpy_units), hi = (int)((long)tot * (idx + 1) / cpy_units), th = (wr * 4 + wc) * 64 + fq * 16 + fr;
#pragma unroll
            for (int q = 0; q < 2; ++q) { const int i = lo + th + 512 * q; if (i < hi) { ci[q] = i; const int b = i / per, r = i % per;
                c0[q] = ((const f32x4*)(ck + (size_t)b * 128 * 256 + 4 * 256))[r]; c1[q] = ((const f32x4*)(cv + (size_t)b * 128 * 256 + 4 * 256))[r]; } } }
        const int row0 = u.pm * BM + wr * 64 + fr, col0 = u.pn * BM + wc * 32 + 8 * fq;
#pragma unroll
        for (int ai = 0; ai < 2; ++ai)
#pragma unroll
            for (int m = 0; m < 4; ++m) { const int row = row0 + ai * HALF + m * 16; const float rs = row_rstd(ssq, row); bf16_t* rowp = O + (size_t)row * ldc + col0;
#pragma unroll
                for (int bj = 0; bj < 2; ++bj) { f32x4 v0 = acc[ai][bj][m][0] * rs, v1 = acc[ai][bj][m][1] * rs;
                    if (ACT == 1) {
#pragma unroll
                        for (int e = 0; e < 4; ++e) { const float a = fmaxf(v0[e], 0.f), b = fmaxf(v1[e], 0.f); v0[e] = a * a; v1[e] = b * b; } }
                    *(u32x4*)(rowp + bj * HALF) = pack8(v0, v1); } }
        if (cpy_units > 0) {
#pragma unroll
            for (int q = 0; q < 2; ++q) if (ci[q] >= 0) { const int b = ci[q] / per, r = ci[q] % per; ((f32x4*)(ok + (size_t)b * 128 * 256))[r] = c0[q]; ((f32x4*)(ov + (size_t)b * 128 * 256))[r] = c1[q]; } }
    }
};
struct EpiResid {
    static constexpr bool PERM = true, AFTER_DRAIN = false;
    const float* base; const float* base2; int split; float* out; bf16_t* hb; float* ssq_out; float* slab; int S; const bf16_t* hbase = nullptr; int omask = -1;
    __device__ __forceinline__ void operator()(const f32x4 (&acc)[2][2][4][2], const Unit& u, int wr, int wc, int fr_, int fq_) const {
        int fr = fr_, fq = fq_; asm volatile("" : "+v"(fr), "+v"(fq));
        if (slab && u.pm >= 64) {
            float* sp = slab + ((size_t)((((u.pm - 64) << 2) + u.pn) * S + u.kt0 / u.nt) << 16) + (size_t)(wr * 64 + fr) * 256 + wc * 32 + 8 * fq;
#pragma unroll
            for (int ai = 0; ai < 2; ++ai)
#pragma unroll
                for (int m = 0; m < 4; ++m)
#pragma unroll
                    for (int bj = 0; bj < 2; ++bj) { float* p = sp + (size_t)(ai * HALF + m * 16) * 256 + bj * HALF; *(f32x4*)p = acc[ai][bj][m][0]; *(f32x4*)(p + 4) = acc[ai][bj][m][1]; }
            return;
        }
        const int row0 = u.pm * BM + wr * 64 + fr, col0 = u.pn * BM + wc * 32 + 8 * fq;
#pragma unroll
        for (int ai = 0; ai < 2; ++ai)
#pragma unroll
            for (int m = 0; m < 4; ++m) { const int row = row0 + ai * HALF + m * 16;
                const float* bp = (row < split ? base + (size_t)row * 1024 : base2 + (size_t)(row - split) * 1024) + col0;
                float ss = 0.f;
#pragma unroll
                for (int bj = 0; bj < 2; ++bj) { f32x4 b0, b1;
                    if (hbase) { const u32x4 w = *(const u32x4*)(hbase + (size_t)row * 1024 + col0 + bj * HALF);
                        b0 = (f32x4){__uint_as_float(w.x << 16), __uint_as_float(w.x & 0xffff0000u), __uint_as_float(w.y << 16), __uint_as_float(w.y & 0xffff0000u)};
                        b1 = (f32x4){__uint_as_float(w.z << 16), __uint_as_float(w.z & 0xffff0000u), __uint_as_float(w.w << 16), __uint_as_float(w.w & 0xffff0000u)}; }
                    else { b0 = *(const f32x4*)(bp + bj * HALF); b1 = *(const f32x4*)(bp + bj * HALF + 4); }
                    const f32x4 h0 = b0 + acc[ai][bj][m][0], h1 = b1 + acc[ai][bj][m][1];
                    if (out) { float* op = out + (size_t)(row & omask) * 1024 + col0; *(f32x4*)(op + bj * HALF) = h0; *(f32x4*)(op + bj * HALF + 4) = h1; }
                    if (hb) *(u32x4*)(hb + (size_t)row * 1024 + col0 + bj * HALF) = pack8(h0, h1);
                    ss += hsum4(h0 * h0) + hsum4(h1 * h1); }
                if (ssq_out) { ss = add_x16(ss); ss = add_x32(ss); if (fq == 0) ssq_out[(size_t)row * 16 + u.pn * 4 + wc] = ss; }
                if (m == 3) asm volatile("" ::: "memory"); }
    }
};
template <class Epi, class Sched, bool ALIGN_EPI = false, bool SP2 = false>
__device__ __forceinline__ void gemm_phase(PG8_LAS unsigned char* lds, const Gemm g, const Sched& S, const Epi& E, int wid_in, int lane_in) {
    const int wid = wid_in, lane = lane_in, tid = wid * 64 + lane, wr = wid >> 2, wc = wid & 3, fr = lane & 15, fq = lane >> 4;
    const int K = g.K;
    unsigned voffA[2], voffB[2];
#pragma unroll
    for (int i = 0; i < 2; ++i) { int R, C; stage_rc(tid * 16 + i * 8192, R, C); const int Rb = Epi::PERM ? ((R & ~31) + perm32(R & 31)) : R;
        voffA[i] = (unsigned)(R * K + C) * 2u; voffB[i] = (unsigned)(Rb * K + C) * 2u; }
    const size_t kstep = (size_t)(BK * 2);
    const size_t hstep = (size_t)HALF * K * 2;
    const size_t tstep = 2 * hstep;
    const unsigned ldsw = (unsigned)wid * 1024u;
    const int aoff = lds_byte(wr * 64 + fr, fq * 8), boff = lds_byte(wc * 32 + fr, fq * 8);
#define PG8_SA(b, h) (((b) * 2 + (h)) * HTB)
#define PG8_SB(b, h) ((4 + (b) * 2 + (h)) * HTB)
#define PG8_STAGE(bufoff, gbase, voff) do { _Pragma("unroll") for (int _i = 0; _i < 2; ++_i) \
        __builtin_amdgcn_global_load_lds((const unsigned*)((const char*)(gbase) + (voff)[_i]), (PG8_LAS unsigned*)(lds + (bufoff) + ldsw + _i * 8192), 16, 0, 0); } while (0)
#define PG8_LDA(dst, b, h) do { _Pragma("unroll") for (int m = 0; m < 4; ++m) _Pragma("unroll") for (int k = 0; k < 2; ++k) dst[m][k] = *(const PG8_LAS bf16x8*)(lds + PG8_SA(b, h) + aoff + m * 2048 + k * 1024); } while (0)
#define PG8_LDB(dst, b, h) do { _Pragma("unroll") for (int n = 0; n < 2; ++n) _Pragma("unroll") for (int k = 0; k < 2; ++k) dst[n][k] = *(const PG8_LAS bf16x8*)(lds + PG8_SB(b, h) + boff + n * 2048 + k * 1024); } while (0)
#define PG8_MMA(ai, bj, At, Bt) do { __builtin_amdgcn_s_setprio(1); _Pragma("unroll") for (int m = 0; m < 4; ++m) _Pragma("unroll") for (int n = 0; n < 2; ++n) _Pragma("unroll") for (int k = 0; k < 2; ++k) \
        acc[ai][bj][m][n] = __builtin_amdgcn_mfma_f32_16x16x32_bf16(Bt[n][k], At[m][k], acc[ai][bj][m][n], 0, 0, 0); __builtin_amdgcn_s_setprio(0); } while (0)
#define PG8_WAIT_V(n) asm volatile("s_waitcnt vmcnt(" #n ")" ::: "memory")
#define PG8_WAIT_L(n) asm volatile("s_waitcnt lgkmcnt(" #n ")" ::: "memory")
#define PG8_BAR __builtin_amdgcn_s_barrier()
#define PG8_SCHED __builtin_amdgcn_sched_barrier(0)
    Unit cur, nxt; int ui = 0;
    if (!S.next(0, cur)) return;
    f32x4 acc[2][2][4][2];
#pragma unroll
    for (int a = 0; a < 2; ++a)
#pragma unroll
        for (int b = 0; b < 2; ++b)
#pragma unroll
            for (int m = 0; m < 4; ++m)
#pragma unroll
                for (int n = 0; n < 2; ++n) acc[a][b][m][n] = (f32x4){0.f, 0.f, 0.f, 0.f};
    bf16x8 At[4][2], B0[2][2], B1[2][2];
    const char* cA = (const char*)g.A + (size_t)cur.pm * tstep + (size_t)cur.kt0 * kstep; const char* cB = (const char*)g.Bt + (size_t)cur.pn * tstep + (size_t)cur.kt0 * kstep;
    S.a_ready(cur);
    if constexpr (SP2) {
        PG8_STAGE(PG8_SB(0, 0), cB, voffB); PG8_STAGE(PG8_SB(0, 1), cB + hstep, voffB); PG8_STAGE(PG8_SA(0, 0), cA, voffA); PG8_STAGE(PG8_SA(0, 1), cA + hstep, voffA);
        if (wr == 1) PG8_BAR;
        PG8_WAIT_V(2); PG8_BAR;
        PG8_STAGE(PG8_SB(1, 0), cB + kstep, voffB); PG8_STAGE(PG8_SA(1, 0), cA + kstep, voffA); PG8_STAGE(PG8_SB(1, 1), cB + hstep + kstep, voffB);
        PG8_WAIT_V(6); PG8_BAR;
    } else {
        PG8_STAGE(PG8_SB(0, 0), cB, voffB); PG8_STAGE(PG8_SA(0, 0), cA, voffA); PG8_STAGE(PG8_SB(0, 1), cB + hstep, voffB); PG8_STAGE(PG8_SA(0, 1), cA + hstep, voffA);
        if (wr == 1) PG8_BAR;
        PG8_WAIT_V(4); PG8_BAR;
        PG8_STAGE(PG8_SB(1, 0), cB + kstep, voffB); PG8_STAGE(PG8_SA(1, 0), cA + kstep, voffA); PG8_STAGE(PG8_SB(1, 1), cB + hstep + kstep, voffB);
        PG8_WAIT_V(6); PG8_BAR;
    }
    for (;;) {
        const bool has_next = S.next(ui + 1, nxt);
        const char* nA = has_next ? (const char*)g.A + (size_t)nxt.pm * tstep + (size_t)nxt.kt0 * kstep : cA; const char* nB = has_next ? (const char*)g.Bt + (size_t)nxt.pn * tstep + (size_t)nxt.kt0 * kstep : cB;
        const int nt = cur.nt;
        for (int t = 0; t < nt; t += 2) {
            const bool last = (t == nt - 2);
            const char* a1 = cA + (size_t)(t + 1) * kstep;
            const char* a2 = last ? nA : cA + (size_t)(t + 2) * kstep; const char* b2 = last ? nB : cB + (size_t)(t + 2) * kstep;
            const char* a3 = a2 + kstep; const char* b3 = b2 + kstep;
            if (last && has_next) S.a_ready(nxt);
            if constexpr (SP2) {
            PG8_LDB(B0, 0, 0); PG8_LDB(B1, 0, 1); PG8_SCHED; PG8_LDA(At, 0, 0); PG8_STAGE(PG8_SA(1, 1), a1 + hstep, voffA);
            PG8_WAIT_V(8); PG8_WAIT_L(0); PG8_BAR; PG8_MMA(0, 0, At, B0); PG8_MMA(0, 1, At, B1); PG8_BAR; PG8_SCHED;
            PG8_LDA(At, 0, 1); PG8_STAGE(PG8_SB(0, 0), b2, voffB); PG8_STAGE(PG8_SB(0, 1), b2 + hstep, voffB); PG8_STAGE(PG8_SA(0, 0), a2, voffA);
            PG8_WAIT_V(8); PG8_WAIT_L(0); PG8_BAR; PG8_MMA(1, 0, At, B0); PG8_MMA(1, 1, At, B1); PG8_BAR; PG8_SCHED;
            PG8_LDB(B0, 1, 0); PG8_LDB(B1, 1, 1); PG8_SCHED; PG8_LDA(At, 1, 0); PG8_STAGE(PG8_SA(0, 1), a2 + hstep, voffA);
            PG8_WAIT_V(8); PG8_WAIT_L(0); PG8_BAR; PG8_MMA(0, 0, At, B0); PG8_MMA(0, 1, At, B1); PG8_BAR; PG8_SCHED;
            PG8_LDA(At, 1, 1); PG8_STAGE(PG8_SB(1, 0), b3, voffB); PG8_STAGE(PG8_SB(1, 1), b3 + hstep, voffB); PG8_STAGE(PG8_SA(1, 0), a3, voffA);
            PG8_WAIT_V(8); PG8_WAIT_L(0); PG8_BAR; PG8_MMA(1, 0, At, B0); PG8_MMA(1, 1, At, B1); PG8_BAR; PG8_SCHED;
            } else {
            PG8_LDB(B0, 0, 0); PG8_SCHED; PG8_LDA(At, 0, 0); PG8_STAGE(PG8_SA(1, 1), a1 + hstep, voffA);
            PG8_WAIT_L(8); PG8_BAR; PG8_WAIT_L(0); PG8_MMA(0, 0, At, B0); PG8_BAR; PG8_SCHED;
            PG8_LDB(B1, 0, 1); PG8_STAGE(PG8_SB(0, 0), b2, voffB);
            PG8_BAR; PG8_WAIT_L(0); PG8_MMA(0, 1, At, B1); PG8_BAR;
            PG8_LDA(At, 0, 1); PG8_STAGE(PG8_SA(0, 0), a2, voffA);
            PG8_BAR; PG8_WAIT_L(0); PG8_MMA(1, 0, At, B0); PG8_BAR; PG8_SCHED;
            PG8_STAGE(PG8_SB(0, 1), b2 + hstep, voffB);
            PG8_WAIT_V(6); PG8_BAR; PG8_MMA(1, 1, At, B1); PG8_BAR;
            PG8_LDB(B0, 1, 0); PG8_SCHED; PG8_LDA(At, 1, 0); PG8_STAGE(PG8_SA(0, 1), a2 + hstep, voffA);
            PG8_WAIT_L(8); PG8_BAR; PG8_WAIT_L(0); PG8_MMA(0, 0, At, B0); PG8_BAR; PG8_SCHED;
            PG8_LDB(B1, 1, 1); PG8_STAGE(PG8_SB(1, 0), b3, voffB);
            PG8_BAR; PG8_WAIT_L(0); PG8_MMA(0, 1, At, B1); PG8_BAR;
            PG8_LDA(At, 1, 1); PG8_STAGE(PG8_SA(1, 0), a3, voffA);
            PG8_BAR; PG8_WAIT_L(0); PG8_MMA(1, 0, At, B0); PG8_BAR; PG8_SCHED;
            PG8_STAGE(PG8_SB(1, 1), b3 + hstep, voffB);
            PG8_WAIT_V(6); PG8_BAR; PG8_MMA(1, 1, At, B1); PG8_BAR;
            }
        }
        if constexpr (ALIGN_EPI) { if (wr == 0) PG8_BAR; }
        if constexpr (!Epi::AFTER_DRAIN) { E(acc, cur, wr, wc, fr, fq); S.done(cur); }
        if (!has_next) break;
#pragma unroll
        for (int a = 0; a < 2; ++a)
#pragma unroll
            for (int b = 0; b < 2; ++b)
#pragma unroll
                for (int m = 0; m < 4; ++m)
#pragma unroll
                    for (int n = 0; n < 2; ++n) acc[a][b][m][n] = (f32x4){0.f, 0.f, 0.f, 0.f};
        cur = nxt; cA = nA; cB = nB; ++ui;
        if constexpr (ALIGN_EPI) { if (wr == 1) PG8_BAR; }
    }
    PG8_WAIT_V(0);
    if constexpr (!ALIGN_EPI) { if (wr == 0) PG8_BAR; }
    PG8_BAR;
    if constexpr (Epi::AFTER_DRAIN) { E.fused(acc, cur, wr, wc, fr, fq, lds, wid, lane); S.done(cur); }
#undef PG8_SA
#undef PG8_SB
#undef PG8_STAGE
#undef PG8_LDA
#undef PG8_LDB
#undef PG8_MMA
#undef PG8_WAIT_V
#undef PG8_WAIT_L
#undef PG8_BAR
#undef PG8_SCHED
}
}

constexpr int NWAVES = 8;
#ifndef MK_ONE_LAUNCH
#define MK_ONE_LAUNCH 1
#endif
constexpr int DM = 1024, RP = 16384  , RS = 512  , R = RP + RS, T = 8192, NB = 2, SB = 128, ST = 4;
constexpr int NCOLA = 2816, RWKV_COLS = 2560, NH = 12, HD = 64, FF = 4096, NCOLB = 1536, NMEM = 256;
constexpr int NCHUNK = RP / 64  , NUNIT = NCHUNK * NH  ;
constexpr float C2Q = 0.125f * 1.4426950408889634f;
constexpr float LOG2E = 1.4426950408889634f;
enum { I_XP = 0, I_XS, I_SSHIFT, I_SWKV, I_CSK, I_CSV, I_CMK, I_CMV, I_MEMP, I_NMIX, I_NMLP, I_WOUT, I_WUP, I_WDN, I_MNORM, I_WMKV, I_MQN, I_MKN,
       I_WINA, I_MU, I_WW2, I_W0, I_WA2, I_A0, I_WG2, I_KK, I_KA, I_RK, I_LNW, I_LNB, I_WINB, I_QN, I_SINKS, I_KVN, I_WKV, I_KN, N_IN };
constexpr size_t O_Y = 0, O_PSHIFT = (size_t)R * DM, O_PWKV = O_PSHIFT + 2 * RWKV_COLS, O_PSK = O_PWKV + 2 * 12 * 4096, O_PSV = O_PSK + 2 * 128 * 256,
                 O_PMK = O_PSV + 2 * 128 * 256, O_PMV = O_PMK + 2 * 2 * 256 * 256, O_SSHIFT = O_PMV + 2 * 2 * 256 * 256, O_SWKV = O_SSHIFT + (size_t)SB * RWKV_COLS,
                 O_SSK = O_SWKV + (size_t)SB * 12 * 4096, O_SSV = O_SSK + (size_t)SB * 128 * 256, O_END = O_SSV + (size_t)SB * 128 * 256;
constexpr size_t al256(size_t x) { return (x + 255) & ~(size_t)255; }
constexpr size_t WS_CTL = 0, CTL_ZERO_BYTES = 1u << 15;
constexpr size_t WS_WA = 1u << 20;
constexpr size_t WS_WOUT = WS_WA + (size_t)NCOLA * DM * 2;
constexpr size_t WS_WUP = WS_WOUT + (size_t)2 * DM * DM * 2;
constexpr size_t WS_WDN = WS_WUP + (size_t)2 * FF * DM * 2;
constexpr size_t WS_WB = WS_WDN + (size_t)2 * FF * DM * 2;
constexpr size_t WS_WM = WS_WB + (size_t)NCOLB * DM * 2;
constexpr size_t WS_WW2 = WS_WM + (size_t)DM * DM * 2;
constexpr size_t WS_WA2 = WS_WW2 + (size_t)768 * 64 * 2;
constexpr size_t WS_WG2 = WS_WA2 + (size_t)768 * 64 * 2;
constexpr size_t WS_ROPE = WS_WG2 + (size_t)768 * 128 * 2;
constexpr size_t WS_SSQ = al256(WS_ROPE + (size_t)8196 * 64 * 4);
constexpr size_t WS_SSQM = WS_SSQ + (size_t)R * 16 * 4;
constexpr size_t WS_MB = WS_SSQM + (size_t)512 * 16 * 4;
constexpr size_t WS_MK = WS_MB + (size_t)512 * DM * 2;
constexpr size_t WS_MVT = WS_MK + (size_t)2 * 2 * 4 * 256 * 64 * 2;
constexpr size_t WS_HB = WS_MVT + (size_t)2 * 2 * 4 * 256 * 64 * 2;
constexpr size_t WS_MIX = WS_HB + (size_t)R * DM * 2;
constexpr size_t WS_BIG = WS_MIX + (size_t)R * DM * 2;
constexpr size_t WS_PROJ = WS_BIG;
constexpr size_t WS_REC = WS_PROJ + (size_t)R * NCOLA * 2;
constexpr size_t REC_BYTES = 5 * 8192;
constexpr size_t WS_END0 = WS_REC + (size_t)NUNIT * REC_BYTES;
constexpr size_t WS_H = WS_BIG;
constexpr size_t WS_END1 = WS_H + (size_t)R * FF * 2;
constexpr size_t WS_SLAB = WS_BIG + ((size_t)160 << 20);
constexpr int S_K1 = 4, S_K4 = 8;
constexpr size_t WS_Q1 = WS_BIG;
constexpr size_t WS_K1 = WS_Q1 + (size_t)R * DM * 2;
constexpr size_t WS_V1 = WS_K1 + (size_t)R * 256 * 2;
constexpr size_t WS_VT1 = WS_V1 + (size_t)R * 256 * 2;
constexpr size_t WS_END = WS_END0 > WS_END1 ? WS_END0 : WS_END1;
static_assert(WS_VT1 + (size_t)2 * 4 * 64 * 8192 * 2 <= WS_END && WS_END1 <= WS_SLAB && WS_SLAB + ((size_t)32 << 20) <= WS_END, "ws map");
constexpr int CW_BAR = 4096;
constexpr int RING_OFF = 0, RING_BYTES = 131072, PREP_HALF = 73728, LDSCTL_OFF = 147456, MISC_OFF = LDSCTL_OFF + 320, WTOT_OFF = LDSCTL_OFF + 1024, LDS_BYTES = LDSCTL_OFF + 4096;

#define GAS __attribute__((address_space(1)))
#define LAS __attribute__((address_space(3)))
typedef unsigned short bf16;
typedef unsigned v4u __attribute__((ext_vector_type(4)));
typedef unsigned v2u __attribute__((ext_vector_type(2)));
typedef float f32x4 __attribute__((ext_vector_type(4)));
typedef float f32x16 __attribute__((ext_vector_type(16)));
typedef short bf16x8 __attribute__((ext_vector_type(8)));
typedef short bf16x4 __attribute__((ext_vector_type(4)));
typedef GAS unsigned gu32;
#define RLX_AGENT __ATOMIC_RELAXED, __HIP_MEMORY_SCOPE_AGENT
#define LDS_WAIT() asm volatile("s_waitcnt lgkmcnt(0)" ::: "memory")
#define VM_WAIT() asm volatile("s_waitcnt vmcnt(0)" ::: "memory")
using pg8::cvt_pk_bf16;
__device__ __forceinline__ int mk_lane() { int l; asm volatile("v_mbcnt_lo_u32_b32 %0, -1, 0\n\tv_mbcnt_hi_u32_b32 %0, -1, %0" : "=v"(l)); return l; }
__device__ __forceinline__ float bf2f(unsigned v) { return __uint_as_float(v << 16); }
__device__ __forceinline__ float bflo(unsigned w) { return __uint_as_float(w << 16); }
__device__ __forceinline__ float bfhi(unsigned w) { return __uint_as_float(w & 0xffff0000u); }
__device__ __forceinline__ bf16 f2bf(float f) { return (bf16)(cvt_pk_bf16(f, 0.f) & 0xffffu); }
__device__ __forceinline__ v2u pack4(f32x4 v) { v2u w; w.x = cvt_pk_bf16(v[0], v[1]); w.y = cvt_pk_bf16(v[2], v[3]); return w; }
__device__ __forceinline__ f32x4 unpack4(v2u w) { return (f32x4){bflo(w.x), bfhi(w.x), bflo(w.y), bfhi(w.y)}; }
__device__ __forceinline__ f32x4 mfma16(bf16x8 a, bf16x8 b, f32x4 c) { return __builtin_amdgcn_mfma_f32_16x16x32_bf16(a, b, c, 0, 0, 0); }
__device__ __forceinline__ f32x16 mfma32(bf16x8 a, bf16x8 b, f32x16 c) { return __builtin_amdgcn_mfma_f32_32x32x16_bf16(a, b, c, 0, 0, 0); }
using pg8::swz_xor; using pg8::add_x32; using pg8::max_x32; using pg8::add_x16; using pg8::sum16_dpp; using pg8::max16_dpp; using pg8::sum4_dpp;
__device__ __forceinline__ float sum16(float v) { return sum16_dpp(v); }
__device__ __forceinline__ float wave_sum(float v) { v = sum16_dpp(v); v = add_x16(v); return add_x32(v); }
__device__ __forceinline__ float wave_max(float v) { v = max16_dpp(v); v = fmaxf(v, swz_xor<16>(v)); return max_x32(v); }
__device__ __forceinline__ float fsigmoid(float x) { return __builtin_amdgcn_rcpf(1.0f + __expf(-x)); }
__device__ __forceinline__ float ftanh(float x) { const float e = __expf(2.0f * x); return 1.0f - 2.0f * __builtin_amdgcn_rcpf(e + 1.0f); }
namespace pg8 {
__device__ __forceinline__ void head_norm(f32x4 (&x)[2][2], const float* gain, int fq) {
    float ss = 0.f;
#pragma unroll
    for (int bj = 0; bj < 2; ++bj)
#pragma unroll
        for (int n = 0; n < 2; ++n) ss += hsum4(x[bj][n] * x[bj][n]);
    ss = add_x16(ss); ss = add_x32(ss);
    const float rs = rsqrtf(ss * (1.0f / 64.0f) + 1e-6f);
#pragma unroll
    for (int bj = 0; bj < 2; ++bj)
#pragma unroll
        for (int n = 0; n < 2; ++n) { const f32x4 g = *(const f32x4*)(gain + 32 * bj + 8 * fq + 4 * n); x[bj][n] = x[bj][n] * rs * g; }
}
__device__ __forceinline__ void head_rope(f32x4 (&x)[2][2], const float* cs  , int fq) {
#pragma unroll
    for (int n = 0; n < 2; ++n) { const f32x4 t0 = *(const f32x4*)(cs + 2 * (8 * fq + 4 * n)), t1 = *(const f32x4*)(cs + 2 * (8 * fq + 4 * n) + 4);
        const f32x4 cc = {t0[0], t0[2], t1[0], t1[2]}, sn = {t0[1], t0[3], t1[1], t1[3]};
        const f32x4 x1 = x[0][n], x2 = x[1][n]; x[0][n] = x1 * cc - x2 * sn; x[1][n] = x2 * cc + x1 * sn; }
}
struct EpiL1 {
    static constexpr bool PERM = true, AFTER_DRAIN = false;
    unsigned char* ws; float* outp; const float* g_q; const float* g_mq; const float* g_k;
    __device__ __forceinline__ void operator()(const f32x4 (&acc)[2][2][4][2], const Unit& u, int wr, int wc, int fr_, int fq_) const {
        int fr = fr_, fq = fq_; asm volatile("" : "+v"(fr), "+v"(fq));
        const float* ssq = (const float*)(ws + WS_SSQ); const float* rope = (const float*)(ws + WS_ROPE); const float c2 = C2Q;
        bf16_t* Q1 = (bf16_t*)(ws + WS_Q1); bf16_t* K1 = (bf16_t*)(ws + WS_K1); bf16_t* V1 = (bf16_t*)(ws + WS_V1);
        float* p_k = outp + O_PSK; float* p_v = outp + O_PSV; float* s_k = outp + O_SSK; float* s_v = outp + O_SSV;
        const int H = u.pn * 4 + wc, row0 = u.pm * BM + wr * 64 + fr;
#pragma unroll
        for (int ai = 0; ai < 2; ++ai)
#pragma unroll
            for (int m = 0; m < 4; ++m) { const int row = row0 + ai * HALF + m * 16; const float rs = row_rstd(ssq, row);
                const int pidx = row < 16384 ? (row & 8191) : 8192 + ((row - 16384) & 3);
                f32x4 x[2][2];
#pragma unroll
                for (int bj = 0; bj < 2; ++bj)
#pragma unroll
                    for (int n = 0; n < 2; ++n) x[bj][n] = acc[ai][bj][m][n] * rs;
                if (H < 16) {
                    head_norm(x, H < 12 ? g_q : g_mq, fq);
                    if (H < 12) head_rope(x, rope + (size_t)pidx * 64, fq);
#pragma unroll
                    for (int bj = 0; bj < 2; ++bj) *(u32x4*)(Q1 + (size_t)row * 1024 + H * 64 + 32 * bj + 8 * fq) = pack8(x[bj][0] * c2, x[bj][1] * c2);
                } else {
                    const int kh = (H - 16) & 3; const bool isk = H < 20;
                    if (isk) { head_norm(x, g_k, fq); head_rope(x, rope + (size_t)pidx * 64, fq); }
                    bf16_t* dst = isk ? K1 : V1;
#pragma unroll
                    for (int bj = 0; bj < 2; ++bj) *(u32x4*)(dst + (size_t)row * 256 + kh * 64 + 32 * bj + 8 * fq) = pack8(x[bj][0], x[bj][1]);
                    float* o = nullptr;
                    if (row < 16384) { const int b = row >> 13, t = row & 8191; if (t >= 8064) o = (isk ? p_k : p_v) + ((size_t)(b * 128 + (t - 8064)) * 4 + kh) * 64; }
                    else { const int b = (row - 16384) >> 2, i = (row - 16384) & 3; o = (isk ? s_k : s_v) + ((size_t)(b * 128 + 124 + i) * 4 + kh) * 64; }
                    if (o) {
#pragma unroll
                        for (int bj = 0; bj < 2; ++bj) { *(f32x4*)(o + 32 * bj + 8 * fq) = x[bj][0]; *(f32x4*)(o + 32 * bj + 8 * fq + 4) = x[bj][1]; } }
                }
                if (m == 3) asm volatile("" ::: "memory");
            }
    }
};
struct EpiMemKV {
    static constexpr bool PERM = true, AFTER_DRAIN = false;
    unsigned char* ws; float* outp; const float* g_k  ;
    __device__ __forceinline__ void operator()(const f32x4 (&acc)[2][2][4][2], const Unit& u, int wr, int wc, int fr_, int fq_) const {
        int fr = fr_, fq = fq_; asm volatile("" : "+v"(fr), "+v"(fq));
        const float* ssq = (const float*)(ws + WS_SSQM); float* p_k = outp + O_PMK; float* p_v = outp + O_PMV; bf16_t* MK = (bf16_t*)(ws + WS_MK)  ; bf16_t* MVT = (bf16_t*)(ws + WS_MVT)  ;
        const int H = u.pn * 4 + wc, l = H >> 3, isv = (H >> 2) & 1, hh = H & 3, row0 = u.pm * BM + wr * 64 + fr;
#pragma unroll
        for (int ai = 0; ai < 2; ++ai)
#pragma unroll
            for (int m = 0; m < 4; ++m) { const int row = row0 + ai * HALF + m * 16; const float rs = row_rstd(ssq, row); const int b = row >> 8, mm = row & 255;
                f32x4 x[2][2];
#pragma unroll
                for (int bj = 0; bj < 2; ++bj)
#pragma unroll
                    for (int n = 0; n < 2; ++n) x[bj][n] = acc[ai][bj][m][n] * rs;
                if (!isv) head_norm(x, g_k + l * 64, fq);
                float* o = (isv ? p_v : p_k) + ((((size_t)l * 2 + b) * 256 + mm) * 4 + hh) * 64;
#pragma unroll
                for (int bj = 0; bj < 2; ++bj) { *(f32x4*)(o + 32 * bj + 8 * fq) = x[bj][0]; *(f32x4*)(o + 32 * bj + 8 * fq + 4) = x[bj][1]; }
                if (!isv) {
#pragma unroll
                    for (int bj = 0; bj < 2; ++bj) *(u32x4*)(MK + ((((size_t)l * 2 + b) * 4 + hh) * 256 + mm) * 64 + 32 * bj + 8 * fq) = pack8(x[bj][0], x[bj][1]);
                } else {
#pragma unroll
                    for (int bj = 0; bj < 2; ++bj)
#pragma unroll
                        for (int n = 0; n < 2; ++n)
#pragma unroll
                            for (int e = 0; e < 4; ++e) { const int d = 32 * bj + 8 * fq + 4 * n + e; MVT[((((size_t)l * 2 + b) * 4 + hh) * 64 + d) * 256 + mm] = (bf16_t)(cvt_pk_bf16(x[bj][n][e], 0.f) & 0xffffu); }
                }
                asm volatile("" ::: "memory");
            }
    }
};
}
#define XB_TMO      128
#define XB_XCNT(j)  (256  + 64 * (j))
#define XB_XSUB(j)  (1280 + 64 * (j))
#define XB_XGEN(j)  (2304 + 64 * (j))
#define XB_TOP      3328
#define XB_TOPGEN   3392
#define XCD_BAR_WORDS 3456
#define XB_SPIN_CAP (1u << 18)

__device__ __forceinline__ unsigned xb_ld(unsigned* p)              { return __hip_atomic_load(p, __ATOMIC_RELAXED, __HIP_MEMORY_SCOPE_AGENT); }
__device__ __forceinline__ unsigned xb_add(unsigned* p, unsigned v) { return __hip_atomic_fetch_add(p, v, __ATOMIC_RELAXED, __HIP_MEMORY_SCOPE_AGENT); }
__device__ __forceinline__ unsigned xb_xcc_id() { return (unsigned)__builtin_amdgcn_s_getreg((3 << 11) | 20) & 0xFu; }
#define XB_SPIN(cond, bar) do { unsigned _sp = 0; while (cond) { __builtin_amdgcn_s_sleep(1); \
    if ((++_sp & 255u) == 0u) { if (xb_ld(&(bar)[XB_TMO])) break; if (_sp > XB_SPIN_CAP) { atomicAdd(&(bar)[XB_TMO], 1u); break; } } } } while (0)

struct XcdBarrier {
    bool wave0;
    unsigned* bar; unsigned x;
    volatile LAS unsigned* st;
};

__device__ __forceinline__ XcdBarrier xcd_barrier_post(unsigned* bar, volatile LAS unsigned* st, bool wave0) {
    XcdBarrier b; b.wave0 = wave0; b.bar = bar; b.x = xb_xcc_id(); b.st = st;
    if (wave0 && mk_lane() == 0) (void)xb_add(&bar[XB_XCNT(b.x)], 1u);
    return b;
}
__device__ __forceinline__ void xcd_barrier_complete(unsigned* bar, unsigned x, unsigned& nloc, unsigned& nx) {
    const unsigned G = gridDim.x * gridDim.y * gridDim.z;
    unsigned sum, cnt, mine, sp = 0u;
    for (;;) {
        sum = 0u; cnt = 0u; mine = 0u;
#pragma unroll
        for (unsigned j = 0; j < 16; ++j) { const unsigned c = xb_ld(&bar[XB_XCNT(j)]); sum += c; cnt += (c > 0u) ? 1u : 0u; mine = (j == x) ? c : mine; }
        if (sum == G) break;
        __builtin_amdgcn_s_sleep(1);
        if ((++sp & 255u) == 0u) { if (xb_ld(&bar[XB_TMO])) break; if (sp > XB_SPIN_CAP) { atomicAdd(&bar[XB_TMO], 1u); break; } }
    }
    nloc = mine > 0u ? mine : 1u; nx = cnt > 0u ? cnt : 1u;
}

__device__ __forceinline__ void xcd_barrier(const XcdBarrier& b) {
    asm volatile("s_waitcnt vmcnt(0)" ::: "memory");
    __syncthreads();
    if (b.wave0 && mk_lane() == 0) {
        unsigned* bar = b.bar;
        __builtin_amdgcn_s_waitcnt(0);
        unsigned nloc = b.st[0], nx = b.st[1];
        if (nloc == 0u) { xcd_barrier_complete(bar, b.x, nloc, nx); b.st[0] = nloc; b.st[1] = nx; }
        asm volatile("buffer_inv sc1" ::: "memory");
        const unsigned old = xb_add(&bar[XB_XSUB(b.x)], 1u);
        const unsigned gen = old / nloc;
        if (old + 1u == (gen + 1u) * nloc) {
            __builtin_amdgcn_fence(__ATOMIC_RELEASE, "agent");
            asm volatile("s_waitcnt vmcnt(0)" ::: "memory");
            const unsigned og = xb_add(&bar[XB_TOP], 1u);
            const unsigned target = (og / nx + 1u) * nx;
            if (og + 1u != target) XB_SPIN(xb_ld(&bar[XB_TOP]) < target, bar);
            xb_add(&bar[XB_XGEN(b.x)], 1u);
        } else {
            XB_SPIN(xb_ld(&bar[XB_XGEN(b.x)]) == gen, bar);
        }
        asm volatile("s_waitcnt vmcnt(0)" ::: "memory");
    }
    __syncthreads();
}

__device__ __forceinline__ void xcd_barrier_arrive(const XcdBarrier& b) {
    asm volatile("s_waitcnt vmcnt(0)" ::: "memory");
    __syncthreads();
    if (b.wave0 && mk_lane() == 0) {
        unsigned* bar = b.bar;
        __builtin_amdgcn_s_waitcnt(0);
        unsigned nloc = b.st[0], nx = b.st[1];
        if (nloc == 0u) { xcd_barrier_complete(bar, b.x, nloc, nx); b.st[0] = nloc; b.st[1] = nx; }
        const unsigned old = xb_add(&bar[XB_XSUB(b.x)], 1u);
        const unsigned gen = old / nloc;
        if (old + 1u == (gen + 1u) * nloc) {
            xb_add(&bar[XB_XGEN(b.x)], 1u);
            __builtin_amdgcn_fence(__ATOMIC_RELEASE, "agent");
            asm volatile("s_waitcnt vmcnt(0)" ::: "memory");
            xb_add(&bar[XB_TOP], 1u);
        }
        b.st[2] = (gen + 1u) * nx;
    }
}
__device__ __forceinline__ void xcd_barrier_wait(const XcdBarrier& b) {
    __syncthreads();
    if (b.wave0 && mk_lane() == 0) {
        unsigned* bar = b.bar; const unsigned target = b.st[2];
        asm volatile("buffer_inv sc1" ::: "memory");
        XB_SPIN(xb_ld(&bar[XB_TOP]) < target, bar);
        asm volatile("s_waitcnt vmcnt(0)" ::: "memory");
    }
    __syncthreads();
}

struct Args { const float* in[N_IN]; float* out; unsigned char* ws; int ph_lo, ph_hi; };
struct Frame {
    LAS unsigned char* lds; unsigned char* lds_g;
    gu32* ctl;
    int tid, lane, wave, vcu, G;
    const float* const* in; float* out; unsigned char* ws;
};
__host__ __device__ __forceinline__ int wsig_inv(int nl) { return 128 * ((nl >> 5) & 1) + 32 * (nl >> 6) + (nl & 31); }

__device__ __forceinline__ void p0_item_load(const float* W, int N, const float* gain, int item, int lane, float (&tv)[32], float (&gv)[32]) {
    const int nblk = N / 32, kb = item / nblk, nb = item % nblk, k0 = 64 * kb, n0 = 32 * nb;
#pragma unroll
    for (int i = 0; i < 32; ++i) { const int kk = 2 * i + (lane >> 5); tv[i] = W[(size_t)(k0 + kk) * N + n0 + (lane & 31)]; gv[i] = gain ? gain[k0 + kk] : 1.0f; }
}
__device__ __forceinline__ void p0_item_finish(int K, int N, bf16* WT, int row_off, bool sig, LAS float* scr, int item, int lane, const float (&tv)[32], const float (&gv)[32]) {
    const int nblk = N / 32, kb = item / nblk, nb = item % nblk, k0 = 64 * kb, n0 = 32 * nb;
#pragma unroll
    for (int i = 0; i < 32; ++i) scr[(2 * i + (lane >> 5)) * 33 + (lane & 31)] = tv[i] * gv[i];
    LDS_WAIT(); asm volatile("" ::: "memory");
    const int c = lane & 7;
    int nbase = row_off + n0; if (sig) { const int ng = row_off + n0; nbase = (ng & ~255) + wsig_inv(ng & 255); }
#pragma unroll
    for (int j = 0; j < 4; ++j) { const int n = (lane >> 3) + 8 * j; const LAS float* s = scr + (8 * c) * 33 + n;
        v4u o; o.x = cvt_pk_bf16(s[0 * 33], s[1 * 33]); o.y = cvt_pk_bf16(s[2 * 33], s[3 * 33]); o.z = cvt_pk_bf16(s[4 * 33], s[5 * 33]); o.w = cvt_pk_bf16(s[6 * 33], s[7 * 33]);
        *(GAS v4u*)(WT + (size_t)(nbase + n) * K + k0 + 8 * c) = o; }
    LDS_WAIT(); asm volatile("" ::: "memory");
}
__device__ __forceinline__ int p0_job(const float* W, int K, int N, bf16* WT, int row_off, bool sig, const float* gain, LAS float* scr, int it, int NGW, int lane) {
    const int ni = (K / 64) * (N / 32);
    while (it < ni) { const int n1 = it + NGW; float ta[32], ga[32], tb[32], gb[32];
        p0_item_load(W, N, gain, it, lane, ta, ga); if (n1 < ni) p0_item_load(W, N, gain, n1, lane, tb, gb);
        __builtin_amdgcn_sched_barrier(0);
        p0_item_finish(K, N, WT, row_off, sig, scr, it, lane, ta, ga);
        if (n1 >= ni) { it = n1; break; }
        p0_item_finish(K, N, WT, row_off, sig, scr, n1, lane, tb, gb); it = n1 + NGW; }
    return it - ni;
}
__device__ __forceinline__ void row_to_bf16_ssq(const float* xrow, bf16* orow, float* ssqrow, int lane) {
    const GAS f32x4* xr = (const GAS f32x4*)xrow + lane;
    f32x4 v[4]; float s = 0.f;
#pragma unroll
    for (int j = 0; j < 4; ++j) { v[j] = xr[64 * j]; s += (v[j].x * v[j].x + v[j].y * v[j].y) + (v[j].z * v[j].z + v[j].w * v[j].w); }
    s = wave_sum(s);
    GAS v2u* o8 = (GAS v2u*)orow + lane;
#pragma unroll
    for (int j = 0; j < 4; ++j) o8[64 * j] = pack4(v[j]);
    if (lane < 16) ssqrow[lane] = lane == 0 ? s : 0.f;
}
__device__ __forceinline__ void p0_weights(Frame& F, int part, int gw, int NGW, LAS float* scr) {
    unsigned char* ws = F.ws;
    int it = gw;
#define P0_JOB(Wp, K_, N_, WTp, roff, sg, gn) { it = p0_job((Wp), (K_), (N_), (WTp), (roff), (sg), (gn), scr, it, NGW, F.lane); }
    if (part == 0) {
    P0_JOB(F.in[I_WINA], DM, NCOLA, (bf16*)(ws + WS_WA), 0, false, F.in[I_NMIX]);
    P0_JOB(F.in[I_WMKV], DM, 512, (bf16*)(ws + WS_WM), 0, true, F.in[I_MNORM]);
    P0_JOB(F.in[I_WMKV] + (size_t)DM * 512, DM, 512, (bf16*)(ws + WS_WM), 512, true, F.in[I_MNORM] + DM);
    P0_JOB(F.in[I_WW2], 64, 768, (bf16*)(ws + WS_WW2), 0, false, nullptr);
    P0_JOB(F.in[I_WA2], 64, 768, (bf16*)(ws + WS_WA2), 0, false, nullptr);
    P0_JOB(F.in[I_WG2], 128, 768, (bf16*)(ws + WS_WG2), 0, false, nullptr);
    } else if (part == 1) {
    P0_JOB(F.in[I_WOUT], DM, DM, (bf16*)(ws + WS_WOUT), 0, false, nullptr);
    P0_JOB(F.in[I_WUP], DM, FF, (bf16*)(ws + WS_WUP), 0, false, F.in[I_NMLP]);
    P0_JOB(F.in[I_WDN], FF, DM, (bf16*)(ws + WS_WDN), 0, false, nullptr);
    P0_JOB(F.in[I_WINB], DM, DM, (bf16*)(ws + WS_WB), 0, true, F.in[I_NMIX] + DM);
    P0_JOB(F.in[I_WKV], DM, 512, (bf16*)(ws + WS_WB), 1024, true, F.in[I_KVN]);
    } else {
    P0_JOB(F.in[I_WOUT] + (size_t)DM * DM, DM, DM, (bf16*)(ws + WS_WOUT) + (size_t)DM * DM, 0, false, nullptr);
    P0_JOB(F.in[I_WUP] + (size_t)DM * FF, DM, FF, (bf16*)(ws + WS_WUP) + (size_t)DM * FF, 0, false, F.in[I_NMLP] + DM);
    P0_JOB(F.in[I_WDN] + (size_t)DM * FF, FF, DM, (bf16*)(ws + WS_WDN) + (size_t)DM * FF, 0, false, nullptr);
    }
#undef P0_JOB
}
__device__ __forceinline__ void p0_prologue(Frame& F) {
    LAS float* scr = (LAS float*)(F.lds + RING_OFF + F.wave * 16384);
    const int gw = F.vcu * NWAVES + F.wave, NGW = F.G * NWAVES;
    unsigned char* ws = F.ws;
    p0_weights(F, 0, gw, NGW, scr);
    for (int m = gw; m < R; m += NGW) { const float* xr = m < RP ? F.in[I_XP] + (size_t)m * DM : F.in[I_XS] + (size_t)(m - RP) * DM;
        row_to_bf16_ssq(xr, (bf16*)(ws + WS_HB) + (size_t)m * DM, (float*)(ws + WS_SSQ) + (size_t)m * 16, F.lane); }
    for (int m = gw; m < 512; m += NGW) row_to_bf16_ssq(F.in[I_MEMP] + (size_t)m * DM, (bf16*)(ws + WS_MB) + (size_t)m * DM, (float*)(ws + WS_SSQM) + (size_t)m * 16, F.lane);
}
__device__ __forceinline__ void p0_rope(Frame& F) {
    unsigned char* ws = F.ws;
    { const int gt = F.vcu * NWAVES * 64 + F.tid, NGT = F.G * NWAVES * 64; float* rt = (float*)(ws + WS_ROPE);
      for (int i = gt; i < 8196 * 32; i += NGT) { const int p = i >> 5, f = i & 31; const float pos = (float)(p < 8192 ? p : 16384 + (p - 8192));
          double fq_ = 1.0; for (int k = 0; k < f; ++k) fq_ *= 0.74989420933245582730; const float ang = pos * (float)fq_; const double rev = (double)ang * 0.15915494309189535; const float fr = (float)(rev - floor(rev));
          rt[2 * i] = __builtin_amdgcn_cosf(fr); rt[2 * i + 1] = __builtin_amdgcn_sinf(fr); } }
}

__device__ __forceinline__ void finalize_sample(Frame& F, const float* fbase  , int S, bool last) {
    const int gw = F.vcu * NWAVES + F.wave, NGW = F.G * NWAVES; const float* slab = (const float*)(F.ws + WS_SLAB);
    for (int tk = gw; tk < RS * 4; tk += NGW) { const int rs = tk >> 2, pn = tk & 3, row = RP + rs, tile0 = (rs >> 8) << 2, r = rs & 255;
        f32x4 h, pv[8];
        if (fbase) h = *(const GAS f32x4*)(fbase + (size_t)rs * DM + pn * 256 + 4 * F.lane);
        else h = unpack4(*(const GAS v2u*)((const bf16*)(F.ws + WS_HB) + (size_t)row * DM + pn * 256 + 4 * F.lane));
#pragma unroll
        for (int s = 0; s < 8; ++s) if (s < S) pv[s] = *(const GAS f32x4*)(slab + ((size_t)((tile0 + pn) * S + s) << 16) + r * 256 + 4 * F.lane);
        __builtin_amdgcn_sched_barrier(0);
        h += (pv[0] + pv[1]) + (pv[2] + pv[3]); if (S > 4) h += (pv[4] + pv[5]) + (pv[6] + pv[7]);
        if (last) *(GAS f32x4*)(F.out + O_Y + (size_t)row * DM + pn * 256 + 4 * F.lane) = h;
        else { *(GAS v2u*)((bf16*)(F.ws + WS_HB) + (size_t)row * DM + pn * 256 + 4 * F.lane) = pack4(h);
            const float ss = wave_sum((h[0] * h[0] + h[1] * h[1]) + (h[2] * h[2] + h[3] * h[3]));
            if (F.lane < 4) ((float*)(F.ws + WS_SSQ))[(size_t)row * 16 + 4 * pn + F.lane] = F.lane == 0 ? ss : 0.f; } }
}

__device__ __forceinline__ void copy_window_cache(Frame& F, int gt, int NGT, int part, int nparts) {
    const int per = 124 * 256 / 4, tot = SB * per, lo = (int)((long)tot * part / nparts), hi = (int)((long)tot * (part + 1) / nparts);
    for (int i0 = lo + gt; i0 < hi; i0 += 4 * NGT) { f32x4 kv[4], vv[4];
#pragma unroll
        for (int u = 0; u < 4; ++u) { const int i = i0 + u * NGT; if (i < hi) { const int b = i / per, r = i % per;
            kv[u] = ((const GAS f32x4*)(F.in[I_CSK] + (size_t)b * 128 * 256 + 4 * 256))[r]; vv[u] = ((const GAS f32x4*)(F.in[I_CSV] + (size_t)b * 128 * 256 + 4 * 256))[r]; } }
        __builtin_amdgcn_sched_barrier(0);
#pragma unroll
        for (int u = 0; u < 4; ++u) { const int i = i0 + u * NGT; if (i < hi) { const int b = i / per, r = i % per;
            ((GAS f32x4*)(F.out + O_SSK + (size_t)b * 128 * 256))[r] = kv[u]; ((GAS f32x4*)(F.out + O_SSV + (size_t)b * 128 * 256))[r] = vv[u]; } } }
}

constexpr int LSTR = 144, SLOT = 64 * LSTR;
__device__ __forceinline__ int rec_index(int chunk, int h) { return ((chunk >> 7) * NH + h) * 128 + (chunk & 127); }
constexpr int REC_PT = 0, REC_QS = 8192, REC_RY = 16384, REC_YL = 24576, REC_BV = 32768;
__device__ __forceinline__ bf16x8 lfrag(const LAS unsigned char* m, int row, int k) { return *(const LAS bf16x8*)(m + row * LSTR + k * 2); }
__device__ __forceinline__ void mm_strip(f32x4 (&acc)[4], const LAS unsigned char* X, const LAS unsigned char* Y, int w, int c, int g) {
#pragma unroll
    for (int ks = 0; ks < 2; ++ks) { const bf16x8 a = lfrag(X, 16 * w + c, 32 * ks + 8 * g);
#pragma unroll
        for (int n = 0; n < 4; ++n) acc[n] = mfma16(a, lfrag(Y, 16 * n + c, 32 * ks + 8 * g), acc[n]); }
}
__device__ __forceinline__ void mm_strip2(f32x4 (&acc0)[4], f32x4 (&acc1)[4], const LAS unsigned char* X, const LAS unsigned char* Y0, const LAS unsigned char* Y1, int w, int c, int g) {
#pragma unroll
    for (int ks = 0; ks < 2; ++ks) { const bf16x8 a = lfrag(X, 16 * w + c, 32 * ks + 8 * g);
#pragma unroll
        for (int n = 0; n < 4; ++n) { acc0[n] = mfma16(a, lfrag(Y0, 16 * n + c, 32 * ks + 8 * g), acc0[n]); acc1[n] = mfma16(a, lfrag(Y1, 16 * n + c, 32 * ks + 8 * g), acc1[n]); } }
}
__device__ __forceinline__ void zero4(f32x4 (&a)[4]) {
#pragma unroll
    for (int n = 0; n < 4; ++n) a[n] = (f32x4){0.f, 0.f, 0.f, 0.f};
}
__device__ __forceinline__ void st_T(LAS unsigned char* dest, const f32x4 (&acc)[4], int w, int c, int g) {
#pragma unroll
    for (int n = 0; n < 4; ++n) *(LAS v2u*)(dest + (16 * n + c) * LSTR + (16 * w + 4 * g) * 2) = pack4(acc[n]);
}
__device__ __forceinline__ void st_T_global(unsigned char* dest  , const f32x4 (&acc)[4], int w, int c, int g) {
#pragma unroll
    for (int n = 0; n < 4; ++n) *(GAS v2u*)(dest + (16 * n + c) * 128 + (16 * w + 4 * g) * 2) = pack4(acc[n]);
}
__device__ __forceinline__ void load_shift8(const bf16* cur, const bf16* prv, const float* mu, float (&o)[8]) {
    const v4u cw = *(const GAS v4u*)cur; v4u pw = {0u, 0u, 0u, 0u}; if (prv) pw = *(const GAS v4u*)prv;
    const f32x4 m0 = *(const GAS f32x4*)mu, m1 = *(const GAS f32x4*)(mu + 4);
    const float cf[8] = {bflo(cw.x), bfhi(cw.x), bflo(cw.y), bfhi(cw.y), bflo(cw.z), bfhi(cw.z), bflo(cw.w), bfhi(cw.w)};
    const float pf[8] = {bflo(pw.x), bfhi(pw.x), bflo(pw.y), bfhi(pw.y), bflo(pw.z), bfhi(pw.z), bflo(pw.w), bfhi(pw.w)};
    const float mf[8] = {m0[0], m0[1], m0[2], m0[3], m1[0], m1[1], m1[2], m1[3]};
#pragma unroll
    for (int i = 0; i < 8; ++i) o[i] = cf[i] + (pf[i] - cf[i]) * mf[i];
}
__device__ __forceinline__ bf16x8 pack_frag(const float (&v)[8]) {
    v4u w; w.x = cvt_pk_bf16(v[0], v[1]); w.y = cvt_pk_bf16(v[2], v[3]); w.z = cvt_pk_bf16(v[4], v[5]); w.w = cvt_pk_bf16(v[6], v[7]); return __builtin_bit_cast(bf16x8, w);
}

struct PrepPf { v4u raw[3][2]; v4u prv; };
__device__ __forceinline__ void prep_issue(Frame& F, int unit, PrepPf& pf) {
    const int th = (F.wave & 3) * 64 + F.lane; const int chunk = unit / NH, h = unit % NH, row0 = chunk * 64; const bool first = (chunk & 127) == 0;
    const bf16* proj = (const bf16*)(F.ws + WS_PROJ);
#pragma unroll
    for (int a = 0; a < 3; ++a)
#pragma unroll
        for (int i = 0; i < 2; ++i) { const int id = th + 256 * i; pf.raw[a][i] = *(const GAS v4u*)(proj + (size_t)(row0 + (id >> 3)) * NCOLA + a * 768 + h * 64 + (id & 7) * 8); }
    pf.prv = (v4u){0u, 0u, 0u, 0u};
    if (th < 24 && !first) pf.prv = *(const GAS v4u*)(proj + (size_t)(row0 - 1) * NCOLA + (th >> 3) * 768 + h * 64 + (th & 7) * 8);
}
__device__ __forceinline__ void shift8(v4u cw, v4u pw, const float* mu, float (&o)[8]) {
    const f32x4 m0 = *(const GAS f32x4*)mu, m1 = *(const GAS f32x4*)(mu + 4);
    const float cf[8] = {bflo(cw.x), bfhi(cw.x), bflo(cw.y), bfhi(cw.y), bflo(cw.z), bfhi(cw.z), bflo(cw.w), bfhi(cw.w)};
    const float pf_[8] = {bflo(pw.x), bfhi(pw.x), bflo(pw.y), bfhi(pw.y), bflo(pw.z), bfhi(pw.z), bflo(pw.w), bfhi(pw.w)};
    const float mf[8] = {m0[0], m0[1], m0[2], m0[3], m1[0], m1[1], m1[2], m1[3]};
#pragma unroll
    for (int i = 0; i < 8; ++i) o[i] = cf[i] + (pf_[i] - cf[i]) * mf[i];
}
#ifndef MK_TIME
#define MK_TIME -1
#endif
#define STAMP3(k) do { if (MK_TIME >= 0 && unit == 0 && w_ == 0 && lane_ == 0) ((volatile LAS unsigned long long*)(F.lds + LDSCTL_OFF + 512))[(k)] = __builtin_amdgcn_s_memrealtime(); } while (0)
#define HBAR() do { asm volatile("s_waitcnt lgkmcnt(0)" ::: "memory"); __builtin_amdgcn_s_barrier(); asm volatile("" ::: "memory"); } while (0)
__device__ __forceinline__ void rwkv_prep_unit(Frame& F, int unit, LAS unsigned char* hb, LAS float* wtot, LAS unsigned char* prow, PrepPf& pf, bool has_next, int next_unit, int stage_limit = 99) {
    int w_ = F.wave & 3, lane_ = F.lane; asm volatile("" : "+s"(w_), "+v"(lane_));
    const int w = w_, lane = lane_, g = lane >> 4, c = lane & 15;
    STAMP3(17);
    const int chunk = unit / NH, h = unit % NH, row0 = chunk * 64; const bool first = (chunk & 127) == 0;
    const bf16* proj = (const bf16*)(F.ws + WS_PROJ);
    unsigned char* rec = F.ws + WS_REC + (size_t)rec_index(chunk, h) * REC_BYTES;
    LAS unsigned char* const s0 = hb, * const s1 = hb + SLOT, * const s2 = hb + 2 * SLOT, * const s3 = hb + 3 * SLOT, * const s4 = hb + 4 * SLOT, * const s5 = hb + 5 * SLOT, * const s6 = hb + 6 * SLOT, * const s7 = hb + 7 * SLOT;
    float mur[4], muk[4], muv[4], w0[4], a0[4], kkc[4], kac[4], rkc[4];
#pragma unroll
    for (int n = 0; n < 4; ++n) { const int col = h * 64 + 16 * n + c; mur[n] = F.in[I_MU][col]; muk[n] = F.in[I_MU][768 + col]; muv[n] = F.in[I_MU][1536 + col];
        w0[n] = F.in[I_W0][col]; a0[n] = F.in[I_A0][col]; kkc[n] = F.in[I_KK][col]; kac[n] = F.in[I_KA][col]; rkc[n] = F.in[I_RK][col]; }
    f32x4 dw[4], da[4]; zero4(dw); zero4(da);
    { const int th = w * 64 + lane;
#pragma unroll
      for (int a = 0; a < 3; ++a)
#pragma unroll
          for (int i = 0; i < 2; ++i) { const int id = th + 256 * i; *(LAS v4u*)(hb + a * SLOT + (id >> 3) * LSTR + (id & 7) * 16) = pf.raw[a][i]; }
      if (th < 24) *(LAS v4u*)(prow + (th >> 3) * 128 + (th & 7) * 16) = pf.prv; }
    {
        const bf16* Ww2 = (const bf16*)(F.ws + WS_WW2); const bf16* Wa2 = (const bf16*)(F.ws + WS_WA2);
        const int tl = 16 * w + c; const bf16* crl = proj + (size_t)(row0 + tl) * NCOLA; const bool hpl = !(first && tl == 0);
        v4u lc[2][2], lp[2][2];
#pragma unroll
        for (int a = 0; a < 2; ++a)
#pragma unroll
            for (int ks = 0; ks < 2; ++ks) { const int col = 2304 + 64 * a + 32 * ks + 8 * g; lc[a][ks] = *(const GAS v4u*)(crl + col); lp[a][ks] = (v4u){0u, 0u, 0u, 0u}; if (hpl) lp[a][ks] = *(const GAS v4u*)(crl - NCOLA + col); }
#pragma unroll
        for (int ks = 0; ks < 2; ++ks) { const int l0 = 32 * ks + 8 * g; float x[8];
            shift8(lc[0][ks], lp[0][ks], F.in[I_MU] + 2304 + l0, x);
#pragma unroll
            for (int i = 0; i < 8; ++i) x[i] = ftanh(x[i]);
            const bf16x8 aw = pack_frag(x);
            shift8(lc[1][ks], lp[1][ks], F.in[I_MU] + 2368 + l0, x);
            const bf16x8 aa = pack_frag(x);
#pragma unroll
            for (int n = 0; n < 4; ++n) { const size_t wo = (size_t)(h * 64 + 16 * n + c) * 64 + l0;
                dw[n] = mfma16(aw, *(const GAS bf16x8*)(Ww2 + wo), dw[n]); da[n] = mfma16(aa, *(const GAS bf16x8*)(Wa2 + wo), da[n]); } }
    }
    STAMP3(18);
    HBAR();
    if (has_next) prep_issue(F, next_unit, pf);
    f32x4 rt[4], kh[4], lw[4], at_[4], bt_[4], kt_[4], bh_[4], vv[4]; float gam[4]; float bon[4] = {0.f, 0.f, 0.f, 0.f}; float ssk[4] = {0.f, 0.f, 0.f, 0.f};
    f32x4 kkr[4], aa_[4], kp[4], rr[4];
    {

        const LAS unsigned char* pbase = (w == 0 && g == 0) ? prow + c * 2 : hb + (16 * w + 4 * g - 1) * LSTR + c * 2; const int pstr = (w == 0 && g == 0) ? 128 : SLOT;
        float rp[4], kpv[4], vp[4];
#pragma unroll
        for (int n = 0; n < 4; ++n) { rp[n] = bf2f(*(const LAS bf16*)(pbase + 32 * n)); kpv[n] = bf2f(*(const LAS bf16*)(pbase + pstr + 32 * n)); vp[n] = bf2f(*(const LAS bf16*)(pbase + 2 * pstr + 32 * n)); }
#pragma unroll
        for (int reg = 0; reg < 4; ++reg) { const int t = 16 * w + 4 * g + reg; const LAS unsigned char* cr = hb + t * LSTR + c * 2;
#pragma unroll
            for (int n = 0; n < 4; ++n) {
                const float r0 = bf2f(*(const LAS bf16*)(cr + 32 * n)), k0 = bf2f(*(const LAS bf16*)(cr + SLOT + 32 * n)), v0 = bf2f(*(const LAS bf16*)(cr + 2 * SLOT + 32 * n));
                const float r1 = rp[n], k1 = kpv[n], v1 = vp[n]; rp[n] = r0; kpv[n] = k0; vp[n] = v0;
                const float r = r0 + (r1 - r0) * mur[n], k = k0 + (k1 - k0) * muk[n], v = v0 + (v1 - v0) * muv[n];
                const float y = -(w0[n] + dw[n][reg]);
                const float sp = fmaxf(y, 0.f) + __logf(1.0f + __expf(-fabsf(y)));
                lw[n][reg] = -__expf(-sp - 0.5f);
                const float a = fsigmoid(a0[n] + da[n][reg]);
                aa_[n][reg] = a; kkr[n][reg] = k * kkc[n]; kp[n][reg] = k * (1.0f + (a - 1.0f) * kac[n]); rr[n][reg] = r; vv[n][reg] = v;
                ssk[reg] += kkr[n][reg] * kkr[n][reg]; bon[reg] += r * kp[n][reg] * rkc[n]; } }
    }
#pragma unroll
    for (int reg = 0; reg < 4; ++reg) { ssk[reg] = sum16(ssk[reg]); bon[reg] = sum16(bon[reg]); ssk[reg] = __builtin_amdgcn_rsqf(fmaxf(ssk[reg], 1e-24f)); }
    STAMP3(19);
    f32x4 Lc[4];
#pragma unroll
    for (int n = 0; n < 4; ++n) { f32x4 inc; inc[0] = lw[n][0]; inc[1] = inc[0] + lw[n][1]; inc[2] = inc[1] + lw[n][2]; inc[3] = inc[2] + lw[n][3];
        const float tot = inc[3]; const float t1 = __shfl(tot, (lane - 16) & 63), t2 = __shfl(tot, (lane - 32) & 63), t3 = __shfl(tot, (lane - 48) & 63);
        const float pre = (g >= 1 ? t1 : 0.f) + (g >= 2 ? t2 : 0.f) + (g >= 3 ? t3 : 0.f);
        Lc[n] = inc + pre; if (g == 3) wtot[w * 64 + 16 * n + c] = pre + tot; }
    HBAR();
#pragma unroll
    for (int n = 0; n < 4; ++n) { const int j = 16 * n + c; const float t0 = wtot[j], t1 = wtot[64 + j], t2 = wtot[128 + j], t3 = wtot[192 + j];
        const float base = (w >= 1 ? t0 : 0.f) + (w >= 2 ? t1 : 0.f) + (w >= 3 ? t2 : 0.f); const float LC = (t0 + t1) + (t2 + t3);
        gam[n] = __expf(LC);
#pragma unroll
        for (int reg = 0; reg < 4; ++reg) { const float L = Lc[n][reg] + base; const float eL = __expf(L), eLi = __builtin_amdgcn_rcpf(eL), eP = __expf(L - lw[n][reg]), eC = gam[n] * eLi;
            const float kk = kkr[n][reg] * ssk[reg], bsc = kk * aa_[n][reg];
            at_[n][reg] = -kk * eP; rt[n][reg] = rr[n][reg] * eL; bt_[n][reg] = bsc * eLi; kt_[n][reg] = kp[n][reg] * eLi; bh_[n][reg] = bsc * eC; kh[n][reg] = kp[n][reg] * eC;
            const int t = 16 * w + 4 * g + reg;
            *(LAS bf16*)(s0 + t * LSTR + j * 2) = f2bf(at_[n][reg]); *(LAS bf16*)(s1 + t * LSTR + j * 2) = f2bf(bt_[n][reg]);
            *(LAS bf16*)(s2 + t * LSTR + j * 2) = f2bf(kt_[n][reg]); *(LAS bf16*)(s3 + t * LSTR + j * 2) = f2bf(rt[n][reg]); }
        *(LAS v2u*)(s4 + j * LSTR + (16 * w + 4 * g) * 2) = pack4(at_[n]); *(LAS v2u*)(s5 + j * LSTR + (16 * w + 4 * g) * 2) = pack4(bh_[n]); *(LAS v2u*)(s6 + j * LSTR + (16 * w + 4 * g) * 2) = pack4(vv[n]);
        f32x4 bv;
#pragma unroll
        for (int reg = 0; reg < 4; ++reg) bv[reg] = bon[reg] * vv[n][reg];
        *(GAS v2u*)(rec + REC_BV + ((w * 64 + lane) * 4 + n) * 8) = pack4(bv); }
    HBAR();
    STAMP3(20);
    if (stage_limit <= 3) return;
    f32x4 aN[4], aMk[4], aMbr[4], aMkr[4]; zero4(aN); zero4(aMk); zero4(aMbr); zero4(aMkr);
    mm_strip2(aN, aMk, s0, s1, s2, w, c, g);
    mm_strip(aMbr, s1, s3, w, c, g); mm_strip(aMkr, s2, s3, w, c, g);
#pragma unroll
    for (int n = 0; n < 4; ++n)
#pragma unroll
        for (int reg = 0; reg < 4; ++reg) { const int row = 16 * w + 4 * g + reg, col = 16 * n + c;
            if (!(col < row)) { aN[n][reg] = 0.f; aMk[n][reg] = 0.f; } if (!(row <= col)) { aMbr[n][reg] = 0.f; aMkr[n][reg] = 0.f; } }
    HBAR();
    LAS float* Nf = (LAS float*)s0;
#pragma unroll
    for (int n = 0; n < 4; ++n)
#pragma unroll
        for (int reg = 0; reg < 4; ++reg) Nf[(16 * w + 4 * g + reg) * 64 + (c & 3) * 16 + 4 * n + (c >> 2)] = aN[n][reg];
    st_T(s2, aMk, w, c, g);
    st_T(s3, aMbr, w, c, g);
    HBAR();
    {
        const int q = lane & 3, sl = lane >> 2; float cq[16];
#pragma unroll
        for (int k = 0; k < 16; ++k) cq[k] = 0.f;
        for (int t = 0; t < 16 * w; ++t) if (q == 0) *(LAS bf16*)(s7 + t * LSTR + (16 * w + sl) * 2) = (bf16)0;
#pragma unroll
        for (int t = 0; t < 64; ++t) if (t >= 16 * w) {
            float part = 0.f;
#pragma unroll
            for (int k4 = 0; k4 < (t + 15) / 16; ++k4) { const f32x4 nv = *(const LAS f32x4*)(Nf + t * 64 + q * 16 + 4 * k4);
#pragma unroll
                for (int e = 0; e < 4; ++e) if (4 * (4 * k4 + e) < t) part = fmaf(nv[e], cq[4 * k4 + e], part); }
            part = sum4_dpp(part);
            const float val = part + ((t == 16 * w + sl) ? 1.0f : 0.0f);
            cq[t >> 2] = (q == (t & 3)) ? val : cq[t >> 2];
            if (q == 0) *(LAS bf16*)(s7 + t * LSTR + (16 * w + sl) * 2) = f2bf(val);
        }
    }
    HBAR();
    STAMP3(21);
    if (stage_limit <= 5) return;
    { f32x4 aW[4], aNk[4]; zero4(aW); zero4(aNk); mm_strip2(aW, aNk, s7, s4, s2, w, c, g); st_T(s0, aW, w, c, g); st_T(s1, aNk, w, c, g); }
    HBAR();
    { f32x4 aP[4]; zero4(aP); mm_strip(aP, s0, s5, w, c, g);
#pragma unroll
      for (int n = 0; n < 4; ++n)
#pragma unroll
          for (int reg = 0; reg < 4; ++reg) if (n == w && c == 4 * g + reg) aP[n][reg] += gam[n];
#pragma unroll
      for (int n = 0; n < 4; ++n) *(GAS v2u*)(rec + REC_PT + ((n * 2 + (w >> 1)) * 64 + lane) * 16 + 8 * (w & 1)) = pack4(aP[n]); }
    { f32x4 aZq[4], aZy[4]; zero4(aZq); zero4(aZy); mm_strip2(aZq, aZy, s1, s5, s3, w, c, g);
#pragma unroll
      for (int n = 0; n < 4; ++n) { aZq[n] += kh[n]; aZy[n] += aMkr[n]; }
      f32x4 aRy[4]; zero4(aRy); mm_strip(aRy, s3, s0, w, c, g);
#pragma unroll
      for (int n = 0; n < 4; ++n)
#pragma unroll
          for (int reg = 0; reg < 4; ++reg) *(GAS bf16*)(rec + REC_RY + ((w * 2 + (n >> 1)) * 64 + 16 * (2 * (n & 1) + (c >> 3)) + 4 * g + reg) * 16 + 2 * (c & 7)) = f2bf(aRy[n][reg] + rt[n][reg]);
      st_T(s4, aZq, w, c, g);
      st_T(s7, aZy, w, c, g); }
    HBAR();
    { f32x4 aQ[4], aY[4]; zero4(aQ); zero4(aY); mm_strip(aQ, s4, s6, w, c, g); mm_strip(aY, s7, s6, w, c, g);
#pragma unroll
      for (int n = 0; n < 4; ++n) { *(GAS v2u*)(rec + REC_QS + ((n * 64 + lane) * 4 + w) * 8) = pack4(aQ[n]);
                                    *(GAS v2u*)(rec + REC_YL + ((w * 64 + lane) * 4 + n) * 8) = pack4(aY[n]); } }
    STAMP3(22);
}

__device__ __forceinline__ float rdlane(float v, int l) { return __int_as_float(__builtin_amdgcn_readlane(__float_as_int(v), l)); }
#ifndef MK_TIME
#define MK_TIME -1
#endif
#define STAMP2(k) do { if (MK_TIME >= 0 && blockIdx.x == 0 && F.wave == 0 && lane == 0) ((volatile LAS unsigned long long*)(F.lds + LDSCTL_OFF + 512))[(k)] = __builtin_amdgcn_s_memrealtime(); } while (0)
__device__ __forceinline__ void rwkv_sample_task(Frame& F, int task, LAS float* wl) {
    int lane_ = F.lane; asm volatile("" : "+v"(lane_)); const int lane = lane_;
    const int b = task / NH, h = task % NH, col = h * 64 + lane;
    const bf16* proj = (const bf16*)(F.ws + WS_PROJ);
    const float* sh = F.in[I_SSHIFT] + (size_t)b * RWKV_COLS;
    const float* mu = F.in[I_MU];
    f32x4 sraw[16];
    { const GAS f32x4* sp = (const GAS f32x4*)(F.in[I_SWKV] + ((size_t)b * NH + h) * 4096) + lane;
#pragma unroll
      for (int q = 0; q < 16; ++q) sraw[q] = sp[64 * q]; }
    const float w0 = F.in[I_W0][col], a0 = F.in[I_A0][col], kkc = F.in[I_KK][col], kac = F.in[I_KA][col], rkc = F.in[I_RK][col], lnw = F.in[I_LNW][col], lnb = F.in[I_LNB][col];
    float rr[ST], kq[ST], vq[ST], twd[ST], adv[ST], gd0[ST], gd1[ST];
    {
      const int cols[7] = {col, 768 + col, 1536 + col, 2304 + lane, 2368 + lane, 2432 + lane, 2496 + lane};
      float raw[ST + 1][7], muv[7];
#pragma unroll
      for (int q = 0; q < 7; ++q) { muv[q] = mu[cols[q]]; raw[0][q] = sh[cols[q]];
#pragma unroll
          for (int i = 0; i < ST; ++i) raw[i + 1][q] = bf2f(proj[(size_t)(RP + b * ST + i) * NCOLA + cols[q]]); }
      __builtin_amdgcn_sched_barrier(0);
#pragma unroll
      for (int i = 0; i < ST; ++i) {
#define SHV(q) (raw[i + 1][q] + (raw[i][q] - raw[i + 1][q]) * muv[q])
          rr[i] = SHV(0); kq[i] = SHV(1); vq[i] = SHV(2); twd[i] = ftanh(SHV(3)); adv[i] = SHV(4); gd0[i] = fsigmoid(SHV(5)); gd1[i] = fsigmoid(SHV(6));
#undef SHV
      } }
    float dwv[ST], dav[ST], ggv[ST];
    { LAS float* xs = wl;
#pragma unroll
      for (int i = 0; i < ST; ++i) { xs[(0 * 4 + i) * 64 + lane] = twd[i]; xs[(1 * 4 + i) * 64 + lane] = adv[i]; xs[(2 * 4 + i) * 64 + lane] = gd0[i]; xs[(3 * 4 + i) * 64 + lane] = gd1[i]; }
      LDS_WAIT(); asm volatile("" ::: "memory");
      const int g = lane >> 4, c = lane & 15, tr = c & 3;
      const bf16* Ww2 = (const bf16*)(F.ws + WS_WW2); const bf16* Wa2 = (const bf16*)(F.ws + WS_WA2); const bf16* Wg2 = (const bf16*)(F.ws + WS_WG2);
      bf16x8 aw[2], aa[2], ag[4];
#pragma unroll
      for (int ks = 0; ks < 4; ++ks) { float x[8];
          if (ks < 2) {
#pragma unroll
              for (int jj = 0; jj < 8; ++jj) x[jj] = c < 4 ? xs[(0 * 4 + tr) * 64 + 32 * ks + 8 * g + jj] : 0.f;
              aw[ks] = pack_frag(x);
#pragma unroll
              for (int jj = 0; jj < 8; ++jj) x[jj] = c < 4 ? xs[(1 * 4 + tr) * 64 + 32 * ks + 8 * g + jj] : 0.f;
              aa[ks] = pack_frag(x); }
#pragma unroll
          for (int jj = 0; jj < 8; ++jj) x[jj] = c < 4 ? xs[((2 + (ks >> 1)) * 4 + tr) * 64 + 32 * (ks & 1) + 8 * g + jj] : 0.f;
          ag[ks] = pack_frag(x); }
      f32x4 dW[4], dA[4], dG[4]; zero4(dW); zero4(dA); zero4(dG);
#pragma unroll
      for (int n = 0; n < 4; ++n) { bf16x8 bw[2], ba[2], bg[4];
          const size_t wr_ = (size_t)(h * 64 + 16 * n + c);
#pragma unroll
          for (int ks = 0; ks < 2; ++ks) { bw[ks] = *(const GAS bf16x8*)(Ww2 + wr_ * 64 + 32 * ks + 8 * g); ba[ks] = *(const GAS bf16x8*)(Wa2 + wr_ * 64 + 32 * ks + 8 * g); }
#pragma unroll
          for (int ks = 0; ks < 4; ++ks) bg[ks] = *(const GAS bf16x8*)(Wg2 + wr_ * 128 + 32 * ks + 8 * g);
#pragma unroll
          for (int ks = 0; ks < 2; ++ks) { dW[n] = mfma16(aw[ks], bw[ks], dW[n]); dA[n] = mfma16(aa[ks], ba[ks], dA[n]); }
#pragma unroll
          for (int ks = 0; ks < 4; ++ks) dG[n] = mfma16(ag[ks], bg[ks], dG[n]); }
      LDS_WAIT(); asm volatile("" ::: "memory");
      if (g == 0) {
#pragma unroll
          for (int n = 0; n < 4; ++n)
#pragma unroll
              for (int i = 0; i < ST; ++i) { xs[(0 * 4 + i) * 64 + 16 * n + c] = dW[n][i]; xs[(1 * 4 + i) * 64 + 16 * n + c] = dA[n][i]; xs[(2 * 4 + i) * 64 + 16 * n + c] = dG[n][i]; } }
      LDS_WAIT(); asm volatile("" ::: "memory");
#pragma unroll
      for (int i = 0; i < ST; ++i) { dwv[i] = xs[(0 * 4 + i) * 64 + lane]; dav[i] = xs[(1 * 4 + i) * 64 + lane]; ggv[i] = xs[(2 * 4 + i) * 64 + lane]; }
      LDS_WAIT(); asm volatile("" ::: "memory"); }
    float S[64];
    { const int rr_ = lane >> 4, qq_ = lane & 15;
#pragma unroll
      for (int q = 0; q < 16; ++q)
#pragma unroll
          for (int e = 0; e < 4; ++e) wl[(4 * q + rr_) * 65 + 4 * qq_ + e] = sraw[q][e];
      LDS_WAIT(); asm volatile("" ::: "memory");
#pragma unroll
      for (int j = 0; j < 64; ++j) S[j] = wl[lane * 65 + j];
      LDS_WAIT(); asm volatile("" ::: "memory"); }
    STAMP2(15);
#pragma unroll
    for (int i = 0; i < ST; ++i) {
        const int row = RP + b * ST + i;
        const float r = rr[i], k = kq[i], v = vq[i], dw = dwv[i], da = dav[i], gg = ggv[i];
        const float y0 = -(w0 + dw); const float sp = fmaxf(y0, 0.f) + __logf(1.0f + __expf(-fabsf(y0)));
        const float wdec = __expf(-__expf(-sp - 0.5f));
        const float a = fsigmoid(a0 + da);
        const float kkr = k * kkc; const float nrm = fmaxf(sqrtf(wave_sum(kkr * kkr)), 1e-12f); const float kk = kkr / nrm;
        const float kp = k * (1.0f + (a - 1.0f) * kac);
        const float asc = -kk, bsc = kk * a;
        const float bonus = wave_sum(r * kp * rkc);
        float sa = 0.f;
#pragma unroll
        for (int j = 0; j < 64; ++j) sa = fmaf(S[j], rdlane(asc, j), sa);
        const float vi = v;
        float y = 0.f;
#pragma unroll
        for (int j = 0; j < 64; ++j) { const float wj = rdlane(wdec, j), bj = rdlane(bsc, j), kj = rdlane(kp, j), rj = rdlane(r, j);
            S[j] = fmaf(S[j], wj, fmaf(sa, bj, vi * kj)); y = fmaf(S[j], rj, y); }
        const float mean = wave_sum(y) * (1.0f / 64.0f); const float dy = y - mean; const float var = wave_sum(dy * dy) * (1.0f / 64.0f);
        const float o = (dy * rsqrtf(var + 6.4e-4f) * lnw + lnb + bonus * vi) * gg;
        ((bf16*)(F.ws + WS_MIX))[(size_t)row * DM + col] = f2bf(o);
        asm volatile("" ::: "memory");
    }
    STAMP2(16);
    { const int rr_ = lane >> 4, qq_ = lane & 15;
#pragma unroll
      for (int j = 0; j < 64; ++j) wl[lane * 65 + j] = S[j];
      LDS_WAIT(); asm volatile("" ::: "memory");
      GAS f32x4* sp = (GAS f32x4*)(F.out + O_SWKV + ((size_t)b * NH + h) * 4096) + lane;
#pragma unroll
      for (int q = 0; q < 16; ++q) { f32x4 v;
#pragma unroll
          for (int e = 0; e < 4; ++e) v[e] = wl[(4 * q + rr_) * 65 + 4 * qq_ + e];
          sp[64 * q] = v; }
      LDS_WAIT(); asm volatile("" ::: "memory"); }
    if (h == 0) { const bf16* lr = proj + (size_t)(RP + b * ST + ST - 1) * NCOLA; float* o = F.out + O_SSHIFT + (size_t)b * RWKV_COLS;
        for (int q = lane; q < RWKV_COLS; q += 64) o[q] = bf2f(lr[q]); }
}

__device__ __forceinline__ void rwkv_scan_chain(Frame& F, int bh, int w) {
    int lane_ = F.lane; asm volatile("" : "+v"(lane_)); const int lane = lane_, g = lane >> 4, c = lane & 15; const int b = bh / NH, h = bh % NH;
    constexpr int DPF = 12, NSL = 14, SLB = 10240;
    LAS unsigned char* ring = F.lds;
    auto recp = [&](int cc) -> const unsigned char* { return F.ws + WS_REC + (size_t)((b * NH + h) * 128 + cc) * REC_BYTES; };
    const int vrow = 16 * w + c;
    if (F.wave >= 4) {
        const int L = F.wave - 4, npc = L < 2 ? 3 : 2;
#define SCAN_DMA(cc_) do { const unsigned char* rp_ = recp(cc_); LAS unsigned char* sl_ = ring + ((cc_) % NSL) * SLB; \
            _Pragma("unroll") for (int q = 0; q < 3; ++q) { const int p = L + 4 * q; if (p < 8) __builtin_amdgcn_global_load_lds((const unsigned*)(rp_ + REC_PT + p * 1024 + lane * 16), (LAS unsigned*)(sl_ + p * 1024), 16, 0, 0); \
                else if (p < 10) __builtin_amdgcn_global_load_lds((const unsigned*)(rp_ + REC_QS + (w * 64 + lane) * 32 + (p - 8) * 16), (LAS unsigned*)(sl_ + p * 1024), 16, 0, 0); } } while (0)
        for (int d = 0; d < DPF; ++d) SCAN_DMA(d);
        for (int cc = 0; cc < 128; ++cc) {
            const int younger = (cc + DPF <= 128 ? DPF - 1 : 127 - cc) * npc;
            if (younger >= 33) asm volatile("s_waitcnt vmcnt(33)" ::: "memory"); else if (younger >= 22) asm volatile("s_waitcnt vmcnt(22)" ::: "memory");
            else if (younger >= 11) asm volatile("s_waitcnt vmcnt(11)" ::: "memory"); else asm volatile("s_waitcnt vmcnt(0)" ::: "memory");
            __builtin_amdgcn_s_barrier();
            if (cc + DPF < 128) SCAN_DMA(cc + DPF);
        }
#undef SCAN_DMA
        asm volatile("s_waitcnt vmcnt(0)" ::: "memory");
        return;
    }
    if (F.wave != 0) { for (int cc = 0; cc < 128; ++cc) __builtin_amdgcn_s_barrier(); return; }
    f32x4 acc[4]; zero4(acc);
    for (int cc = 0; cc < 128; ++cc) {
        __builtin_amdgcn_s_barrier(); asm volatile("" ::: "memory");
        const LAS unsigned char* sl = ring + (cc % NSL) * SLB;
        bf16x8 pa[4][2];
#pragma unroll
        for (int mt = 0; mt < 4; ++mt)
#pragma unroll
            for (int ks = 0; ks < 2; ++ks) pa[mt][ks] = *(const LAS bf16x8*)(sl + (mt * 2 + ks) * 1024 + lane * 16);
        const v4u q0 = *(const LAS v4u*)(sl + 8192 + lane * 16), q1 = *(const LAS v4u*)(sl + 9216 + lane * 16);
        unsigned char* sp_ = (unsigned char*)(F.out + O_Y) + (size_t)((b * NH + h) * 128 + cc) * 8192;
        v2u sb[4]; f32x4 nacc[4];
#pragma unroll
        for (int mt = 0; mt < 4; ++mt) sb[mt] = pack4(acc[mt]);
        nacc[0] = unpack4((v2u){q0.x, q0.y}); nacc[1] = unpack4((v2u){q0.z, q0.w}); nacc[2] = unpack4((v2u){q1.x, q1.y}); nacc[3] = unpack4((v2u){q1.z, q1.w});
#pragma unroll
        for (int mt = 0; mt < 4; ++mt) *(GAS v2u*)(sp_ + ((w * 2 + (mt >> 1)) * 64 + 16 * (2 * (mt & 1) + (g >> 1)) + c) * 16 + 8 * (g & 1)) = sb[mt];
        bf16x8 bf[2];
#pragma unroll
        for (int ks = 0; ks < 2; ++ks) { v4u t; t.x = sb[2 * ks].x; t.y = sb[2 * ks].y; t.z = sb[2 * ks + 1].x; t.w = sb[2 * ks + 1].y; bf[ks] = __builtin_bit_cast(bf16x8, t); }
#pragma unroll
        for (int mt = 0; mt < 4; ++mt) { nacc[mt] = mfma16(pa[mt][0], bf[0], nacc[mt]); nacc[mt] = mfma16(pa[mt][1], bf[1], nacc[mt]); acc[mt] = nacc[mt]; }
        asm volatile("s_waitcnt lgkmcnt(0)" ::: "memory");
    }
    float* o = F.out + O_PWKV + (((size_t)b * NH + h) * 64 + vrow) * 64;
#pragma unroll
    for (int mt = 0; mt < 4; ++mt) *(GAS f32x4*)(o + 16 * mt + 4 * g) = acc[mt];
}

struct YoutKeep { bf16x8 wg[4][4]; f32x4 m0[4], m1[4]; float lnw[4], lnb[4]; bf16x8 sf[4][2]; int chunk; };
__device__ __forceinline__ void rwkv_yout_setup(Frame& F, int h, int lane, YoutKeep& K) {
    const int g = lane >> 4, c = lane & 15; const bf16* Wg2 = (const bf16*)(F.ws + WS_WG2);
#pragma unroll
    for (int ks = 0; ks < 4; ++ks) { const int l0 = 32 * ks + 8 * g; K.m0[ks] = *(const GAS f32x4*)(F.in[I_MU] + 2432 + l0); K.m1[ks] = *(const GAS f32x4*)(F.in[I_MU] + 2432 + l0 + 4);
#pragma unroll
        for (int n = 0; n < 4; ++n) K.wg[n][ks] = *(const GAS bf16x8*)(Wg2 + (size_t)(h * 64 + 16 * n + c) * 128 + l0); }
#pragma unroll
    for (int n = 0; n < 4; ++n) { const int col = h * 64 + 16 * n + c; K.lnw[n] = F.in[I_LNW][col]; K.lnb[n] = F.in[I_LNB][col]; }
    K.chunk = -1;
}
__device__ __forceinline__ void rwkv_yout_item(Frame& F, int chunk, int w, int h, int lane, YoutKeep& K) {
    const int g = lane >> 4, c = lane & 15; const int row0 = chunk * 64; const bool first = (chunk & 127) == 0;
    const unsigned char* rec = F.ws + WS_REC + (size_t)rec_index(chunk, h) * REC_BYTES; const unsigned char* srec = (const unsigned char*)(F.out + O_Y) + (size_t)rec_index(chunk, h) * 8192;
    const bf16* proj = (const bf16*)(F.ws + WS_PROJ);
    const v4u y01 = *(const GAS v4u*)(rec + REC_YL + (w * 64 + lane) * 32), y23 = *(const GAS v4u*)(rec + REC_YL + (w * 64 + lane) * 32 + 16);
    bf16x8 ar[2]; v4u gc[4], gp[4]; v2u bvv[4];
    const int tg = 16 * w + c; const bf16* crg = proj + (size_t)(row0 + tg) * NCOLA + 2432; const bool hpg = !(first && tg == 0);
#pragma unroll
    for (int ks = 0; ks < 2; ++ks) ar[ks] = *(const GAS bf16x8*)(rec + REC_RY + ((w * 2 + ks) * 64 + lane) * 16);
    if (chunk != K.chunk) { K.chunk = chunk;
#pragma unroll
        for (int ks = 0; ks < 2; ++ks)
#pragma unroll
            for (int n = 0; n < 4; ++n) K.sf[n][ks] = *(const GAS bf16x8*)(srec + ((n * 2 + ks) * 64 + lane) * 16); }
#pragma unroll
    for (int ks = 0; ks < 4; ++ks) { const int l0 = 32 * ks + 8 * g; gc[ks] = *(const GAS v4u*)(crg + l0); gp[ks] = (v4u){0u, 0u, 0u, 0u}; if (hpg) gp[ks] = *(const GAS v4u*)(crg - NCOLA + l0); }
#pragma unroll
    for (int n = 0; n < 4; ++n) bvv[n] = *(const GAS v2u*)(rec + REC_BV + ((w * 64 + lane) * 4 + n) * 8);
    __builtin_amdgcn_sched_barrier(0);
    f32x4 y[4], gt[4]; zero4(gt);
    y[0] = unpack4((v2u){y01.x, y01.y}); y[1] = unpack4((v2u){y01.z, y01.w}); y[2] = unpack4((v2u){y23.x, y23.y}); y[3] = unpack4((v2u){y23.z, y23.w});
#pragma unroll
    for (int ks = 0; ks < 2; ++ks)
#pragma unroll
        for (int n = 0; n < 4; ++n) y[n] = mfma16(ar[ks], K.sf[n][ks], y[n]);
#pragma unroll
    for (int ks = 0; ks < 4; ++ks) { const v4u cw = gc[ks], pw = gp[ks];
        const float cf[8] = {bflo(cw.x), bfhi(cw.x), bflo(cw.y), bfhi(cw.y), bflo(cw.z), bfhi(cw.z), bflo(cw.w), bfhi(cw.w)};
        const float pf[8] = {bflo(pw.x), bfhi(pw.x), bflo(pw.y), bfhi(pw.y), bflo(pw.z), bfhi(pw.z), bflo(pw.w), bfhi(pw.w)};
        const float mf[8] = {K.m0[ks][0], K.m0[ks][1], K.m0[ks][2], K.m0[ks][3], K.m1[ks][0], K.m1[ks][1], K.m1[ks][2], K.m1[ks][3]};
        float x[8];
#pragma unroll
        for (int i = 0; i < 8; ++i) x[i] = fsigmoid(cf[i] + (pf[i] - cf[i]) * mf[i]);
        const bf16x8 ag = pack_frag(x);
#pragma unroll
        for (int n = 0; n < 4; ++n) gt[n] = mfma16(ag, K.wg[n][ks], gt[n]); }
    float mean[4], rstd[4];
#pragma unroll
    for (int reg = 0; reg < 4; ++reg) { float s = (y[0][reg] + y[1][reg]) + (y[2][reg] + y[3][reg]); s = sum16(s); mean[reg] = s * (1.0f / 64.0f);
        float q = 0.f;
#pragma unroll
        for (int n = 0; n < 4; ++n) { const float d = y[n][reg] - mean[reg]; q += d * d; }
        q = sum16(q); rstd[reg] = rsqrtf(q * (1.0f / 64.0f) + 6.4e-4f); }
    bf16* mix = (bf16*)(F.ws + WS_MIX);
#pragma unroll
    for (int n = 0; n < 4; ++n) { const int col = h * 64 + 16 * n + c; const f32x4 bv = unpack4(bvv[n]);
#pragma unroll
        for (int reg = 0; reg < 4; ++reg) { const float o = ((y[n][reg] - mean[reg]) * rstd[reg] * K.lnw[n] + K.lnb[n] + bv[reg]) * gt[n][reg];
            mix[(size_t)(row0 + 16 * w + 4 * g + reg) * DM + col] = f2bf(o); } }
}

__device__ __forceinline__ int crow32(int r, int hi) { return (r & 3) + 8 * (r >> 2) + 4 * hi; }
template <bool MASKED, int GB>
__device__ __forceinline__ void flash32(const bf16x8 (&qf)[4], const bf16* Kp, int kstr, const bf16* VTp, int vstr, int kb_lo, int nblk, int qpos, float m0, float l0,
                                        f32x16& o0, f32x16& o1, float& lsum, int lane) {
    const int r32 = lane & 31, hh = lane >> 5;
    float m = m0, l = hh == 0 ? l0 : 0.f;
#pragma unroll
    for (int r = 0; r < 16; ++r) { o0[r] = 0.f; o1[r] = 0.f; }
    for (int b0 = 0; b0 < nblk; b0 += GB) {
        bf16x8 kf[GB][4]; v2u vf[GB][2][2][2];
#pragma unroll
        for (int i = 0; i < GB; ++i) if (b0 + i < nblk) { const int kb = kb_lo + 32 * (b0 + i);
#pragma unroll
            for (int ks = 0; ks < 4; ++ks) kf[i][ks] = *(const GAS bf16x8*)(Kp + (size_t)(kb + r32) * kstr + 16 * ks + 8 * hh);
#pragma unroll
            for (int s2 = 0; s2 < 2; ++s2)
#pragma unroll
                for (int dt = 0; dt < 2; ++dt) { const bf16* vp = VTp + (size_t)(32 * dt + r32) * vstr + kb + 16 * s2 + 4 * hh; vf[i][s2][dt][0] = *(const GAS v2u*)vp; vf[i][s2][dt][1] = *(const GAS v2u*)(vp + 8); } }
#pragma unroll
        for (int i = 0; i < GB; ++i) if (b0 + i < nblk) { const int kb = kb_lo + 32 * (b0 + i);
            f32x16 s;
#pragma unroll
            for (int r = 0; r < 16; ++r) s[r] = 0.f;
#pragma unroll
            for (int ks = 0; ks < 4; ++ks) s = mfma32(kf[i][ks], qf[ks], s);
            if (MASKED) {
#pragma unroll
                for (int r = 0; r < 16; ++r) { const int rel = qpos - (kb + crow32(r, hh)); if (rel < 0 || rel >= 128) s[r] = -1e30f; } }
            float bm = s[0];
#pragma unroll
            for (int r = 1; r < 16; ++r) bm = fmaxf(bm, s[r]);
            bm = max_x32(bm);
            const float mn = fmaxf(m, bm), alpha = __builtin_amdgcn_exp2f(m - mn); m = mn;
            float ps = 0.f;
#pragma unroll
            for (int r = 0; r < 16; ++r) { s[r] = __builtin_amdgcn_exp2f(s[r] - mn); ps += s[r]; }
            l = l * alpha + ps;
#pragma unroll
            for (int r = 0; r < 16; ++r) { o0[r] *= alpha; o1[r] *= alpha; }
#pragma unroll
            for (int s2 = 0; s2 < 2; ++s2) {
                v4u pw; pw.x = cvt_pk_bf16(s[8 * s2], s[8 * s2 + 1]); pw.y = cvt_pk_bf16(s[8 * s2 + 2], s[8 * s2 + 3]); pw.z = cvt_pk_bf16(s[8 * s2 + 4], s[8 * s2 + 5]); pw.w = cvt_pk_bf16(s[8 * s2 + 6], s[8 * s2 + 7]);
                const bf16x8 pb = __builtin_bit_cast(bf16x8, pw);
                { v4u aw; aw.x = vf[i][s2][0][0].x; aw.y = vf[i][s2][0][0].y; aw.z = vf[i][s2][0][1].x; aw.w = vf[i][s2][0][1].y; o0 = mfma32(__builtin_bit_cast(bf16x8, aw), pb, o0); }
                { v4u aw; aw.x = vf[i][s2][1][0].x; aw.y = vf[i][s2][1][0].y; aw.z = vf[i][s2][1][1].x; aw.w = vf[i][s2][1][1].y; o1 = mfma32(__builtin_bit_cast(bf16x8, aw), pb, o1); } }
        }
    }
    lsum = add_x32(l);
}
__device__ __forceinline__ void flash_store(bf16* dst  , int rstride, const f32x16& o0, const f32x16& o1, float lsum, int lane) {
    const int r32 = lane & 31, hh = lane >> 5; const float inv = 1.0f / lsum; bf16* p = dst + (size_t)r32 * rstride + 4 * hh;
#pragma unroll
    for (int k = 0; k < 4; ++k) { *(GAS v2u*)(p + 8 * k) = pack4((f32x4){o0[4 * k] * inv, o0[4 * k + 1] * inv, o0[4 * k + 2] * inv, o0[4 * k + 3] * inv});
        *(GAS v2u*)(p + 32 + 8 * k) = pack4((f32x4){o1[4 * k] * inv, o1[4 * k + 1] * inv, o1[4 * k + 2] * inv, o1[4 * k + 3] * inv}); }
}
constexpr int KL_STR = 144;
template <bool MASKED>
__device__ __forceinline__ void flash32_lds(const bf16x8 (&qf)[4], const LAS unsigned char* Kl, const LAS unsigned char* Vl, int vstr, int lk_lo, int nblk, int kpos_lo, int qpos, float m0, float l0,
                                            f32x16& o0, f32x16& o1, float& lsum, int lane) {
    const int r32 = lane & 31, hh = lane >> 5;
    float m = m0, l = hh == 0 ? l0 : 0.f;
#pragma unroll
    for (int r = 0; r < 16; ++r) { o0[r] = 0.f; o1[r] = 0.f; }
    for (int blk = 0; blk < nblk; ++blk) { const int lk = lk_lo + 32 * blk;
        f32x16 s;
#pragma unroll
        for (int r = 0; r < 16; ++r) s[r] = 0.f;
#pragma unroll
        for (int ks = 0; ks < 4; ++ks) s = mfma32(*(const LAS bf16x8*)(Kl + (lk + r32) * KL_STR + (16 * ks + 8 * hh) * 2), qf[ks], s);
        if (MASKED && (blk == 0 || blk == nblk - 1)) {
#pragma unroll
            for (int r = 0; r < 16; ++r) { const int rel = qpos - (kpos_lo + 32 * blk + crow32(r, hh)); if (rel < 0 || rel >= 128) s[r] = -1e30f; } }
        float bm = s[0];
#pragma unroll
        for (int r = 1; r < 16; ++r) bm = fmaxf(bm, s[r]);
        bm = max_x32(bm);
        const float mn = fmaxf(m, bm), alpha = __builtin_amdgcn_exp2f(m - mn); m = mn;
        float ps = 0.f;
#pragma unroll
        for (int r = 0; r < 16; ++r) { s[r] = __builtin_amdgcn_exp2f(s[r] - mn); ps += s[r]; }
        l = l * alpha + ps;
#pragma unroll
        for (int r = 0; r < 16; ++r) { o0[r] *= alpha; o1[r] *= alpha; }
#pragma unroll
        for (int s2 = 0; s2 < 2; ++s2) {
            v4u pw; pw.x = cvt_pk_bf16(s[8 * s2], s[8 * s2 + 1]); pw.y = cvt_pk_bf16(s[8 * s2 + 2], s[8 * s2 + 3]); pw.z = cvt_pk_bf16(s[8 * s2 + 4], s[8 * s2 + 5]); pw.w = cvt_pk_bf16(s[8 * s2 + 6], s[8 * s2 + 7]);
            const bf16x8 pb = __builtin_bit_cast(bf16x8, pw);
#pragma unroll
            for (int dt = 0; dt < 2; ++dt) { const LAS unsigned char* vp = Vl + (32 * dt + r32) * vstr + (lk + 16 * s2 + 4 * hh) * 2;
                const v2u a0 = *(const LAS v2u*)vp, a1 = *(const LAS v2u*)(vp + 16); v4u aw; aw.x = a0.x; aw.y = a0.y; aw.z = a1.x; aw.w = a1.y;
                if (dt == 0) o0 = mfma32(__builtin_bit_cast(bf16x8, aw), pb, o0); else o1 = mfma32(__builtin_bit_cast(bf16x8, aw), pb, o1); } }
    }
    lsum = add_x32(l);
}
template <bool VT>
__device__ __forceinline__ void stage_kv(LAS unsigned char* Kl, LAS unsigned char* Vl, int vstr, const bf16* Kg, int kstr, const bf16* Vg, int vstr_g, int nkeys, int tid) {
    for (int id = tid; id < nkeys * 8; id += NWAVES * 64) { const int key = id >> 3, ch = id & 7; *(LAS v4u*)(Kl + key * KL_STR + ch * 16) = *(const GAS v4u*)(Kg + (size_t)key * kstr + ch * 8); }
    if (VT) { const int cpr = nkeys >> 3;
        for (int id = tid; id < 64 * cpr; id += NWAVES * 64) { const int d = id / cpr, ch = id % cpr; *(LAS v4u*)(Vl + d * vstr + ch * 16) = *(const GAS v4u*)(Vg + (size_t)d * vstr_g + ch * 8); } }
    else for (int id = tid; id < nkeys * 8; id += NWAVES * 64) { const int key = id >> 3, ch = id & 7; const v4u w = *(const GAS v4u*)(Vg + (size_t)key * vstr_g + ch * 8);
        LAS unsigned char* p = Vl + (8 * ch) * vstr + key * 2;
        *(LAS bf16*)(p) = (bf16)(w.x & 0xffffu); *(LAS bf16*)(p + vstr) = (bf16)(w.x >> 16); *(LAS bf16*)(p + 2 * vstr) = (bf16)(w.y & 0xffffu); *(LAS bf16*)(p + 3 * vstr) = (bf16)(w.y >> 16);
        *(LAS bf16*)(p + 4 * vstr) = (bf16)(w.z & 0xffffu); *(LAS bf16*)(p + 5 * vstr) = (bf16)(w.z >> 16); *(LAS bf16*)(p + 6 * vstr) = (bf16)(w.w & 0xffffu); *(LAS bf16*)(p + 7 * vstr) = (bf16)(w.w >> 16); }
}
__device__ __forceinline__ void memattn_prompt_unit(Frame& F, int layer, int unit) {
    int lane_ = F.lane; asm volatile("" : "+v"(lane_)); const int lane = lane_, r32 = lane & 31, hh = lane >> 5;
    const int b = unit >> 7, hm = (unit >> 5) & 3, qblk = unit & 31; const int row = b * T + qblk * 256 + F.wave * 32 + r32;
    LAS unsigned char* Kl = F.lds; LAS unsigned char* Vl = F.lds + 256 * KL_STR; constexpr int VSTR = 256 * 2 + 16;
    __syncthreads();
    stage_kv<true>(Kl, Vl, VSTR, (const bf16*)(F.ws + WS_MK) + (size_t)((layer * 2 + b) * 4 + hm) * 256 * 64, 64, (const bf16*)(F.ws + WS_MVT) + (size_t)((layer * 2 + b) * 4 + hm) * 64 * 256, 256, 256, F.wave * 64 + lane);
    bf16x8 qf[4];
    if (layer == 0) { const bf16* qp = (const bf16*)(F.ws + WS_PROJ) + (size_t)row * NCOLA + RWKV_COLS + hm * 64; const float* gn = F.in[I_MQN];
        float x[4][8]; float ss = 0.f;
#pragma unroll
        for (int ks = 0; ks < 4; ++ks) { const v4u w = *(const GAS v4u*)(qp + 16 * ks + 8 * hh); const unsigned ww[4] = {w.x, w.y, w.z, w.w};
#pragma unroll
            for (int i = 0; i < 4; ++i) { x[ks][2 * i] = bflo(ww[i]); x[ks][2 * i + 1] = bfhi(ww[i]); ss += x[ks][2 * i] * x[ks][2 * i] + x[ks][2 * i + 1] * x[ks][2 * i + 1]; } }
        ss = add_x32(ss); const float rs = rsqrtf(ss * (1.0f / 64.0f) + 1e-6f) * C2Q;
#pragma unroll
        for (int ks = 0; ks < 4; ++ks) {
#pragma unroll
            for (int i = 0; i < 8; ++i) x[ks][i] *= rs * gn[16 * ks + 8 * hh + i];
            qf[ks] = pack_frag(x[ks]); }
    } else { const bf16* qp = (const bf16*)(F.ws + WS_Q1) + (size_t)row * DM + 768 + hm * 64;
#pragma unroll
        for (int ks = 0; ks < 4; ++ks) qf[ks] = *(const GAS bf16x8*)(qp + 16 * ks + 8 * hh); }
    __syncthreads();
    f32x16 o0, o1; float ls;
    flash32_lds<false>(qf, Kl, Vl, VSTR, 0, 8, 0, 0, -1e30f, 0.f, o0, o1, ls, lane);
    flash_store((bf16*)(F.ws + WS_MIX) + (size_t)(b * T + qblk * 256 + F.wave * 32) * DM + 768 + hm * 64, DM, o0, o1, ls, lane);
}
__device__ __forceinline__ void swa_prompt_unit(Frame& F, int unit) {
    int lane_ = F.lane; asm volatile("" : "+v"(lane_)); const int lane = lane_, r32 = lane & 31, hh = lane >> 5;
    const int b = unit >> 7, kvh = (unit >> 5) & 3, qblk = unit & 31, q0 = qblk * 256, kb0 = q0 >= 128 ? q0 - 128 : 0, nkeys = q0 + 256 - kb0;
    LAS unsigned char* Kl = F.lds; LAS unsigned char* Vl = F.lds + 384 * KL_STR; constexpr int VSTR = 384 * 2 + 16;
    __syncthreads();
    stage_kv<false>(Kl, Vl, VSTR, (const bf16*)(F.ws + WS_K1) + (size_t)(b * T + kb0) * 256 + kvh * 64, 256, (const bf16*)(F.ws + WS_V1) + (size_t)(b * T + kb0) * 256 + kvh * 64, 256, nkeys, F.wave * 64 + lane);
    const int tq = q0 + F.wave * 32, row = b * T + tq + r32;
    bf16x8 qf[3][4];
#pragma unroll
    for (int gq = 0; gq < 3; ++gq) { const bf16* qp = (const bf16*)(F.ws + WS_Q1) + (size_t)row * DM + (kvh * 3 + gq) * 64;
#pragma unroll
        for (int ks = 0; ks < 4; ++ks) qf[gq][ks] = *(const GAS bf16x8*)(qp + 16 * ks + 8 * hh); }
    __syncthreads();
    const int kp_lo = tq >= 128 ? tq - 128 : 0, nblk = (tq - kp_lo) / 32 + 1;
#pragma unroll
    for (int gq = 0; gq < 3; ++gq) { const int hq = kvh * 3 + gq; const float sink = F.in[I_SINKS][hq] * LOG2E;
        f32x16 o0, o1; float ls;
        flash32_lds<true>(qf[gq], Kl, Vl, VSTR, kp_lo - kb0, nblk, kp_lo, tq + r32, sink, 1.0f, o0, o1, ls, lane);
        flash_store((bf16*)(F.ws + WS_MIX) + (size_t)(b * T + tq) * DM + hq * 64, DM, o0, o1, ls, lane); }
}
template <int NQ, bool WINDOW>
__device__ __forceinline__ void small_attn(const LAS float* ql, LAS float* sc, int NKP, const float* k1, const float* v1, int kst1, int nk1, const bf16* k2, const bf16* v2, int kst2, int nk2,
                                           const float* sinkg  , bf16* out0, int ostride_q, int lane) {
    const int sub = lane >> 4, dq = lane & 15, nk = nk1 + nk2;
    f32x4 qv[NQ];
#pragma unroll
    for (int qi = 0; qi < NQ; ++qi) qv[qi] = *(const LAS f32x4*)(ql + qi * 64 + 4 * dq);
    constexpr int KBAT = NQ > 4 ? 4 : 8;
    for (int kg0 = 0; kg0 < nk1; kg0 += 4 * KBAT) { f32x4 kv[KBAT];
#pragma unroll
        for (int u = 0; u < KBAT; ++u) kv[u] = *(const GAS f32x4*)(k1 + (size_t)(kg0 + 4 * u + sub) * kst1 + 4 * dq);
        __builtin_amdgcn_sched_barrier(0);
#pragma unroll
        for (int u = 0; u < KBAT; ++u) { const int key = kg0 + 4 * u + sub;
#pragma unroll
            for (int qi = 0; qi < NQ; ++qi) { const f32x4 p = qv[qi] * kv[u]; const float s = sum16((p[0] + p[1]) + (p[2] + p[3])); if (dq == 0) sc[qi * NKP + key] = s; } } }
    for (int kg = nk1; kg < nk; kg += 4) { const int key = kg + sub; const f32x4 kv = unpack4(*(const GAS v2u*)(k2 + (size_t)(key - nk1) * kst2 + 4 * dq));
#pragma unroll
        for (int qi = 0; qi < NQ; ++qi) { const f32x4 p = qv[qi] * kv; const float s = sum16((p[0] + p[1]) + (p[2] + p[3])); if (dq == 0) sc[qi * NKP + key] = s; } }
    LDS_WAIT(); asm volatile("" ::: "memory");
#pragma unroll
    for (int qi = 0; qi < NQ; ++qi) { float sv[5]; const float sk_ = sinkg ? sinkg[qi >> 2] * LOG2E : -1e30f; float mx = sk_;
#pragma unroll
        for (int t = 0; t < 5; ++t) { const int key = lane + 64 * t; float s = -1e30f; if (key < nk) { s = sc[qi * NKP + key]; if (WINDOW) { const int i = qi & 3; if (key < i + 1 || key > 128 + i) s = -1e30f; } } sv[t] = s; mx = fmaxf(mx, s); }
        mx = wave_max(mx); float sum = 0.f;
#pragma unroll
        for (int t = 0; t < 5; ++t) { sv[t] = __builtin_amdgcn_exp2f(sv[t] - mx); sum += sv[t]; }
        sum = wave_sum(sum) + (sinkg ? __builtin_amdgcn_exp2f(sk_ - mx) : 0.f); const float inv = 1.0f / sum;
#pragma unroll
        for (int t = 0; t < 5; ++t) { const int key = lane + 64 * t; if (key < nk) sc[qi * NKP + key] = sv[t] * inv; } }
    LDS_WAIT(); asm volatile("" ::: "memory");
    f32x4 acc[NQ];
#pragma unroll
    for (int qi = 0; qi < NQ; ++qi) acc[qi] = (f32x4){0.f, 0.f, 0.f, 0.f};
    for (int kg0 = 0; kg0 < nk1; kg0 += 4 * KBAT) { f32x4 vv[KBAT];
#pragma unroll
        for (int u = 0; u < KBAT; ++u) vv[u] = *(const GAS f32x4*)(v1 + (size_t)(kg0 + 4 * u + sub) * kst1 + 4 * dq);
        __builtin_amdgcn_sched_barrier(0);
#pragma unroll
        for (int u = 0; u < KBAT; ++u) { const int key = kg0 + 4 * u + sub;
#pragma unroll
            for (int qi = 0; qi < NQ; ++qi) acc[qi] += vv[u] * sc[qi * NKP + key]; } }
    for (int kg = nk1; kg < nk; kg += 4) { const int key = kg + sub; const f32x4 vv = unpack4(*(const GAS v2u*)(v2 + (size_t)(key - nk1) * kst2 + 4 * dq));
#pragma unroll
        for (int qi = 0; qi < NQ; ++qi) acc[qi] += vv * sc[qi * NKP + key]; }
#pragma unroll
    for (int qi = 0; qi < NQ; ++qi) { f32x4 a = acc[qi];
#pragma unroll
        for (int e = 0; e < 4; ++e) { a[e] = add_x16(a[e]); a[e] = add_x32(a[e]); }
        if (sub == 0) *(GAS v2u*)(out0 + (size_t)(qi & 3) * ostride_q + (qi >> 2) * 64 + 4 * dq) = pack4(a); }
    LDS_WAIT(); asm volatile("" ::: "memory");
}
template <int NQ, bool WINDOW>
__device__ __forceinline__ void small_attn2(bool valid, int half, const LAS float* ql, LAS float* sc, LAS float* xch, int NKP, const float* k1, const float* v1, int kst1, int nk1,
                                            const bf16* k2, const bf16* v2, int kst2, int nk2, const float* sinkg, bf16* out0, int ostride_q, int lane) {
    const int sub = lane >> 4, dq = lane & 15, nk = nk1 + nk2, klo = half ? nk1 / 2 : 0, khi = half ? nk1 : nk1 / 2, kend = half ? nk : khi;
    constexpr int KBAT = 4;
    f32x4 qv[NQ]; float mloc[NQ];
    if (valid) {
#pragma unroll
        for (int qi = 0; qi < NQ; ++qi) qv[qi] = *(const LAS f32x4*)(ql + qi * 64 + 4 * dq);
        for (int kg0 = klo; kg0 < khi; kg0 += 4 * KBAT) { f32x4 kv[KBAT];
#pragma unroll
            for (int u = 0; u < KBAT; ++u) kv[u] = *(const GAS f32x4*)(k1 + (size_t)(kg0 + 4 * u + sub) * kst1 + 4 * dq);
            __builtin_amdgcn_sched_barrier(0);
#pragma unroll
            for (int u = 0; u < KBAT; ++u) { const int key = kg0 + 4 * u + sub;
#pragma unroll
                for (int qi = 0; qi < NQ; ++qi) { const f32x4 p = qv[qi] * kv[u]; const float s = sum16((p[0] + p[1]) + (p[2] + p[3])); if (dq == 0) sc[qi * NKP + key] = s; } } }
        if (half) for (int kg = nk1; kg < nk; kg += 4) { const int key = kg + sub; const f32x4 kv = unpack4(*(const GAS v2u*)(k2 + (size_t)(key - nk1) * kst2 + 4 * dq));
#pragma unroll
            for (int qi = 0; qi < NQ; ++qi) { const f32x4 p = qv[qi] * kv; const float s = sum16((p[0] + p[1]) + (p[2] + p[3])); if (dq == 0) sc[qi * NKP + key] = s; } }
        LDS_WAIT(); asm volatile("" ::: "memory");
#pragma unroll
        for (int qi = 0; qi < NQ; ++qi) { float mx = -1e30f;
#pragma unroll
            for (int t = 0; t < 3; ++t) { const int key = klo + lane + 64 * t; if (key < kend) { float s = sc[qi * NKP + key]; if (WINDOW) { const int i = qi & 3; if (key < i + 1 || key > 128 + i) s = -1e30f; } mx = fmaxf(mx, s); } }
            mloc[qi] = wave_max(mx); if (lane == 0) xch[half * NQ + qi] = mloc[qi]; }
    }
    __syncthreads();
    if (valid) {
#pragma unroll
        for (int qi = 0; qi < NQ; ++qi) { const float sk_ = sinkg ? sinkg[qi >> 2] * LOG2E : -1e30f; const float m = fmaxf(fmaxf(xch[qi], xch[NQ + qi]), sk_); float sum = 0.f;
#pragma unroll
            for (int t = 0; t < 3; ++t) { const int key = klo + lane + 64 * t; if (key < kend) { float s = sc[qi * NKP + key]; if (WINDOW) { const int i = qi & 3; if (key < i + 1 || key > 128 + i) s = -1e30f; }
                    const float p = __builtin_amdgcn_exp2f(s - m); sc[qi * NKP + key] = p; sum += p; } }
            sum = wave_sum(sum); if (half == 0 && sinkg) sum += __builtin_amdgcn_exp2f(sk_ - m);
            if (lane == 0) xch[2 * NQ + half * NQ + qi] = sum; }
        LDS_WAIT(); asm volatile("" ::: "memory");
    }
    __syncthreads();
    if (valid) {
        f32x4 acc[NQ];
#pragma unroll
        for (int qi = 0; qi < NQ; ++qi) acc[qi] = (f32x4){0.f, 0.f, 0.f, 0.f};
        for (int kg0 = klo; kg0 < khi; kg0 += 4 * KBAT) { f32x4 vv[KBAT];
#pragma unroll
            for (int u = 0; u < KBAT; ++u) vv[u] = *(const GAS f32x4*)(v1 + (size_t)(kg0 + 4 * u + sub) * kst1 + 4 * dq);
            __builtin_amdgcn_sched_barrier(0);
#pragma unroll
            for (int u = 0; u < KBAT; ++u) { const int key = kg0 + 4 * u + sub;
#pragma unroll
                for (int qi = 0; qi < NQ; ++qi) acc[qi] += vv[u] * sc[qi * NKP + key]; } }
        if (half) for (int kg = nk1; kg < nk; kg += 4) { const int key = kg + sub; const f32x4 vv = unpack4(*(const GAS v2u*)(v2 + (size_t)(key - nk1) * kst2 + 4 * dq));
#pragma unroll
            for (int qi = 0; qi < NQ; ++qi) acc[qi] += vv * sc[qi * NKP + key]; }
#pragma unroll
        for (int qi = 0; qi < NQ; ++qi) { f32x4 a = acc[qi]; const float inv = 1.0f / (xch[2 * NQ + qi] + xch[3 * NQ + qi]);
#pragma unroll
            for (int e = 0; e < 4; ++e) { a[e] = add_x16(a[e]); a[e] = add_x32(a[e]); a[e] *= inv; }
            acc[qi] = a;
            if (half == 1 && sub == 0) *(LAS f32x4*)(xch + 4 * NQ + qi * 64 + 4 * dq) = a; }
        LDS_WAIT(); asm volatile("" ::: "memory");
        __syncthreads();
        if (half == 0 && sub == 0) {
#pragma unroll
            for (int qi = 0; qi < NQ; ++qi) { const f32x4 o = acc[qi] + *(const LAS f32x4*)(xch + 4 * NQ + qi * 64 + 4 * dq); *(GAS v2u*)(out0 + (size_t)(qi & 3) * ostride_q + (qi >> 2) * 64 + 4 * dq) = pack4(o); } }
    } else __syncthreads();
    LDS_WAIT(); asm volatile("" ::: "memory");
}
__device__ __forceinline__ void memattn_sample_task(Frame& F, int layer, int task, bool valid, LAS float* wl, LAS float* xch) {
    int lane_ = F.lane; asm volatile("" : "+v"(lane_)); const int lane = lane_, b = task >> 2, hm = task & 3; LAS float* ql = wl; LAS float* sc = wl + 12 * 64;
    if (valid) {
#pragma unroll
        for (int i = 0; i < 4; ++i) { const int row = RP + b * ST + i; float x;
            if (layer == 0) { x = bf2f(((const bf16*)(F.ws + WS_PROJ))[(size_t)row * NCOLA + RWKV_COLS + hm * 64 + lane]); const float ss = wave_sum(x * x); x *= rsqrtf(ss * (1.0f / 64.0f) + 1e-6f) * C2Q * F.in[I_MQN][lane]; }
            else x = bf2f(((const bf16*)(F.ws + WS_Q1))[(size_t)row * DM + 768 + hm * 64 + lane]);
            ql[i * 64 + lane] = x; }
        LDS_WAIT(); asm volatile("" ::: "memory"); }
    const float* k1 = F.in[I_CMK] + (((size_t)layer * SB + b) * NMEM * 4 + hm) * 64; const float* v1 = F.in[I_CMV] + (((size_t)layer * SB + b) * NMEM * 4 + hm) * 64;
    small_attn2<4, false>(valid, F.wave & 1, ql, sc, xch, 264, k1, v1, 256, 256, nullptr, nullptr, 0, 0, nullptr, (bf16*)(F.ws + WS_MIX) + (size_t)(RP + b * ST) * DM + 768 + hm * 64, DM, lane);
}
__device__ __forceinline__ void swa_sample_task(Frame& F, int task, bool valid, LAS float* wl, LAS float* xch) {
    int lane_ = F.lane; asm volatile("" : "+v"(lane_)); const int lane = lane_, b = task >> 2, kvh = task & 3; LAS float* ql = wl; LAS float* sc = wl + 12 * 64;
    if (valid) {
#pragma unroll
        for (int qi = 0; qi < 12; ++qi) { const int i = qi & 3, gq = qi >> 2, hq = kvh * 3 + gq; const int row = RP + b * ST + i;
            ql[qi * 64 + lane] = bf2f(((const bf16*)(F.ws + WS_Q1))[(size_t)row * DM + hq * 64 + lane]); }
        LDS_WAIT(); asm volatile("" ::: "memory"); }
    const float* k1 = F.in[I_CSK] + ((size_t)b * 128 * 4 + kvh) * 64; const float* v1 = F.in[I_CSV] + ((size_t)b * 128 * 4 + kvh) * 64;
    const bf16* k2 = (const bf16*)(F.ws + WS_K1) + (size_t)(RP + b * ST) * 256 + kvh * 64; const bf16* v2 = (const bf16*)(F.ws + WS_V1) + (size_t)(RP + b * ST) * 256 + kvh * 64;
    small_attn2<12, true>(valid, F.wave & 1, ql, sc, xch, 136, k1, v1, 256, 128, k2, v2, 256, 4, F.in[I_SINKS] + kvh * 3, (bf16*)(F.ws + WS_MIX) + (size_t)(RP + b * ST) * DM + kvh * 3 * 64, DM, lane);
}

constexpr int N_PHASES = 13;
template <int PM> __global__ void __launch_bounds__(NWAVES * 64, 2) yoco_fwd(Args args) {
    extern __shared__ __attribute__((aligned(16))) unsigned char lds[];
    Frame F;
    F.lds = (LAS unsigned char*)lds; F.lds_g = lds;
    F.wave = __builtin_amdgcn_readfirstlane((int)threadIdx.x >> 6); F.lane = mk_lane(); F.tid = F.wave * 64 + F.lane;
    F.G = gridDim.x; { const int bx = blockIdx.x; F.vcu = (F.G % 8 == 0) ? (bx % 8) * (F.G / 8) + bx / 8 : bx; }
    F.in = args.in; F.out = args.out; F.ws = args.ws; F.ctl = (gu32*)(args.ws + WS_CTL);
    for (int u = F.tid; u < (LDS_BYTES - LDSCTL_OFF) / 4; u += NWAVES * 64) ((LAS unsigned*)(F.lds + LDSCTL_OFF))[u] = 0u;
    __syncthreads();
    const int lo = args.ph_lo, hi = args.ph_hi;
    XcdBarrier bar; bar.wave0 = F.wave == 0; bar.bar = (unsigned*)(F.ctl + CW_BAR); bar.x = 0; bar.st = nullptr;
    bar = xcd_barrier_post((unsigned*)(F.ctl + CW_BAR), (volatile LAS unsigned*)(F.lds + MISC_OFF) + 8, F.wave == 0);
#define IN(k) (((PM >> (k)) & 1) && lo <= (k) && (k) < hi)
#ifndef MK_DUP
#define MK_DUP -1
#endif
#define PH_REP(k) ((MK_DUP == (k)) ? 2 : 1)
#ifndef MK_TIME
#define MK_TIME -1
#endif
#define STAMP(k) do { if (MK_TIME >= 0 && blockIdx.x == 0 && F.wave == 0 && mk_lane() == 0) ((volatile LAS unsigned long long*)(F.lds + LDSCTL_OFF + 512))[(k)] = __builtin_amdgcn_s_memrealtime(); } while (0)
#define SEAM(k) do { if (IN(k) && IN((k) + 1)) xcd_barrier(bar); STAMP((k) + 1); } while (0)
    const int gw = F.vcu * NWAVES + F.wave, NGW = F.G * NWAVES;
    STAMP(0);
#define SSQ ((float*)(F.ws + WS_SSQ))
#define HB ((bf16*)(F.ws + WS_HB))
#define MIX ((bf16*)(F.ws + WS_MIX))
#define HH ((bf16*)(F.ws + WS_H))
#define PHASE_BEGIN() do { int z_ = 0; unsigned char* ws_ = args.ws; float* out_ = args.out; asm volatile("" : "+s"(z_), "+s"(ws_), "+s"(out_)); F.in = args.in + z_; F.ws = ws_; F.out = out_; \
                           F.lane = mk_lane(); F.tid = F.wave * 64 + F.lane; } while (0)

    if (IN(0)) for (int rep_ = 0; rep_ < PH_REP(0); ++rep_) { PHASE_BEGIN(); p0_prologue(F); if (IN(1)) xcd_barrier_arrive(bar); p0_rope(F); } if (IN(0) && IN(1)) xcd_barrier_wait(bar); STAMP(1);

    if (IN(1)) for (int rep_ = 0; rep_ < PH_REP(1); ++rep_) { PHASE_BEGIN();
#ifndef NO_MEMKV
        { pg8::Gemm g{(const bf16*)(F.ws + WS_MB), (const bf16*)(F.ws + WS_WM), 512, 1024, DM}; pg8::StaticOrder S; S.init(512, 1024, F.G, (int)((blockIdx.x + 8) % F.G), DM);
          pg8::EpiMemKV E{F.ws, F.out, F.in[I_MKN]};
          pg8::gemm_phase<pg8::EpiMemKV, pg8::StaticOrder, true, true>(F.lds + RING_OFF, g, S, E, F.wave, F.lane); }
#endif
        { pg8::Gemm g{HB, (const bf16*)(F.ws + WS_WA), R, NCOLA, DM}; pg8::StaticOrder S; S.init(R, NCOLA, F.G, (int)blockIdx.x, DM);
          pg8::EpiScaleBf16<0> E{(bf16*)(F.ws + WS_PROJ), NCOLA, SSQ};
          pg8::gemm_phase<pg8::EpiScaleBf16<0>, pg8::StaticOrder, true, true>(F.lds + RING_OFF, g, S, E, F.wave, F.lane); }
    } SEAM(1);

    if (IN(2)) for (int rep_ = 0; rep_ < ((MK_DUP == 2 || (MK_DUP >= 20 && MK_DUP < 30)) ? 2 : 1); ++rep_) { PHASE_BEGIN();
        const int half = F.wave >> 2; const int gw = F.vcu * NWAVES + F.wave, NGW = F.G * NWAVES;
        LAS unsigned char* hb = F.lds + half * PREP_HALF; LAS float* wtot = (LAS float*)(F.lds + WTOT_OFF + half * 1024);
        const int slim = (rep_ == 1 && MK_DUP == 21) ? 3 : (rep_ == 1 && MK_DUP == 22) ? 5 : 99;
        if (!(rep_ == 1 && MK_DUP == 20)) { LAS unsigned char* prow = F.lds + WTOT_OFF + 2048 + half * 512; PrepPf pf; if (F.vcu < NUNIT / 2) prep_issue(F, 2 * F.vcu + half, pf);
            for (int pi = F.vcu; pi < NUNIT / 2; pi += F.G) rwkv_prep_unit(F, 2 * pi + half, hb, wtot, prow, pf, pi + F.G < NUNIT / 2, 2 * (pi + F.G) + half, slim); }
        STAMP(14);
        if (IN(3)) xcd_barrier_arrive(bar); else __syncthreads();
        if (!(rep_ == 1 && (MK_DUP == 21 || MK_DUP == 22))) for (int t = gw; t < SB * NH + 2; t += NGW) {
            if (t < SB * NH) rwkv_sample_task(F, t, (LAS float*)(F.lds + F.wave * 18432));
            else { const int b = t - SB * NH; const bf16* lr = (const bf16*)(F.ws + WS_PROJ) + (size_t)(b * T + T - 1) * NCOLA; float* o = F.out + O_PSHIFT + (size_t)b * RWKV_COLS;
                for (int q = F.lane; q < RWKV_COLS; q += 64) o[q] = bf2f(lr[q]); } }
        { const int nsw = (SB * NH + 2 + NWAVES - 1) / NWAVES;
          if (rep_ == 0 && F.vcu >= nsw && F.G > nsw) { __syncthreads(); p0_weights(F, 1, (F.vcu - nsw) * NWAVES + F.wave, (F.G - nsw) * NWAVES, (LAS float*)(F.lds + F.wave * 16384)); }
          else if (rep_ == 0 && F.G <= nsw) { __syncthreads(); p0_weights(F, 1, gw, NGW, (LAS float*)(F.lds + F.wave * 16384)); } }
    } if (IN(2) && IN(3)) xcd_barrier_wait(bar); STAMP(3);

    if (IN(3)) for (int rep_ = 0; rep_ < ((MK_DUP == 30 || MK_DUP == 31) ? 2 : 1); ++rep_) { PHASE_BEGIN();
        const int nscan = NB * NH * 4;
        const int nconv = (F.G - nscan) * NWAVES + nscan * 7;
        if (F.vcu < nscan) { if (rep_ == 0 || MK_DUP == 31) { rwkv_scan_chain(F, F.vcu >> 2, F.vcu & 3); if (F.wave == 0) STAMP(23); } }
        else if (rep_ == 0 || MK_DUP == 30) { LAS float* wl = (LAS float*)(F.lds + F.wave * 12288);
            const int nwg = F.G - nscan, wgi = F.vcu - nscan; const bool bal = nwg == 160;
            if (bal) { if (wgi >= 128) { for (int q = 0; q < 4; ++q) memattn_prompt_unit(F, 0, 128 + (wgi - 128) * 4 + q); } else memattn_prompt_unit(F, 0, wgi); }
            else for (int u = wgi; u < 256; u += nwg) memattn_prompt_unit(F, 0, u);
            __syncthreads();
            { LAS float* xch = (LAS float*)(F.lds + 8 * 12288) + (F.wave >> 1) * 1024;
              if (bal) { if (wgi < 128) { const int t = wgi * 4 + (F.wave >> 1); memattn_sample_task(F, 0, t, true, wl, xch); } }
              else for (int it = 0; it * nwg * 4 < 512; ++it) { const int t = (it * nwg + wgi) * 4 + (F.wave >> 1); memattn_sample_task(F, 0, t, t < 512, wl, xch); } }
            }
    } SEAM(3);

    if (IN(4)) for (int rep_ = 0; rep_ < PH_REP(4); ++rep_) { PHASE_BEGIN(); { int lane_ = F.lane; asm volatile("" : "+v"(lane_)); const int hh = gw % NH, idx0 = gw / NH, nwh = (NGW - hh + NH - 1) / NH, per = (NCHUNK * 4 + nwh - 1) / nwh;
          YoutKeep K; rwkv_yout_setup(F, hh, lane_, K);
          const int jend = (idx0 + 1) * per < NCHUNK * 4 ? (idx0 + 1) * per : NCHUNK * 4;
          for (int j = idx0 * per; j < jend; ++j) rwkv_yout_item(F, j >> 2, j & 3, hh, lane_, K); } } SEAM(4); if (MK_DUP == 40) for (int i_ = 0; i_ < 10; ++i_) xcd_barrier(bar);

    if (IN(5)) for (int rep_ = 0; rep_ < PH_REP(5); ++rep_) { PHASE_BEGIN(); pg8::Gemm g{MIX, (const bf16*)(F.ws + WS_WOUT), R, DM, DM}; pg8::TailOrder S; S.init(F.G, (int)blockIdx.x, DM, S_K1);
        pg8::EpiResid E{nullptr, nullptr, RP, nullptr, HB, SSQ, (float*)(F.ws + WS_SLAB), S_K1, HB};
        pg8::gemm_phase<pg8::EpiResid, pg8::TailOrder, true, true>(F.lds + RING_OFF, g, S, E, F.wave, F.lane); } SEAM(5);
    if (IN(6)) for (int rep_ = 0; rep_ < PH_REP(6); ++rep_) { PHASE_BEGIN(); finalize_sample(F, F.in[I_XS], S_K1, false); xcd_barrier(bar);
        pg8::Gemm g{HB, (const bf16*)(F.ws + WS_WUP), R, FF, DM}; pg8::StaticOrder S; S.init(R, FF, F.G, (int)blockIdx.x, DM);
        pg8::EpiScaleBf16<1> E{HH, FF, SSQ, F.in[I_CSK], F.in[I_CSV], F.out + O_SSK, F.out + O_SSV, rep_ == 0 ? (R / 256) * (FF / 256) : 0};
        pg8::gemm_phase<pg8::EpiScaleBf16<1>, pg8::StaticOrder, true, true>(F.lds + RING_OFF, g, S, E, F.wave, F.lane); } SEAM(6);
    if (IN(7)) { PHASE_BEGIN(); pg8::Gemm g{HH, (const bf16*)(F.ws + WS_WDN), R, DM, FF}; pg8::TailOrder S; S.init(F.G, (int)blockIdx.x, FF, S_K4);
        pg8::EpiResid E{nullptr, nullptr, RP, nullptr, HB, SSQ, (float*)(F.ws + WS_SLAB), S_K4, HB};
        pg8::gemm_phase<pg8::EpiResid, pg8::TailOrder, true, true>(F.lds + RING_OFF, g, S, E, F.wave, F.lane); } SEAM(7);

    if (IN(8)) for (int rep_ = 0; rep_ < PH_REP(8); ++rep_) { PHASE_BEGIN(); finalize_sample(F, nullptr, S_K4, false); xcd_barrier(bar);
        pg8::Gemm g{HB, (const bf16*)(F.ws + WS_WB), R, NCOLB, DM}; pg8::StaticOrder S; S.init(R, NCOLB, F.G, (int)blockIdx.x, DM);
        pg8::EpiL1 E{F.ws, F.out, F.in[I_QN], F.in[I_MQN] + 64, F.in[I_KN]};
        pg8::gemm_phase<pg8::EpiL1, pg8::StaticOrder, true, true>(F.lds + RING_OFF, g, S, E, F.wave, F.lane);
        { const int nbusy = (R / 256) * (NCOLB / 256) - (int)F.G;
          if (rep_ == 0 && nbusy >= 0 && (int)blockIdx.x >= nbusy && (int)F.G > nbusy) p0_weights(F, 2, ((int)blockIdx.x - nbusy) * NWAVES + F.wave, ((int)F.G - nbusy) * NWAVES, (LAS float*)(F.lds + F.wave * 16384));
          else if (rep_ == 0 && (nbusy < 0 || (int)F.G <= nbusy)) p0_weights(F, 2, F.vcu * NWAVES + F.wave, F.G * NWAVES, (LAS float*)(F.lds + F.wave * 16384)); } } SEAM(8);

    if (IN(9)) for (int rep_ = 0; rep_ < PH_REP(9); ++rep_) { PHASE_BEGIN(); LAS float* wl = (LAS float*)(F.lds + F.wave * 12288); const int gw = F.vcu * NWAVES + F.wave, NGW = F.G * NWAVES;
        for (int u = F.vcu; u < 256; u += F.G) swa_prompt_unit(F, u);
        for (int u = F.vcu; u < 256; u += F.G) memattn_prompt_unit(F, 1, u);
        __syncthreads();
        { LAS float* xch = (LAS float*)(F.lds + 8 * 12288) + (F.wave >> 1) * 1024;
          for (int it = 0; it * F.G * 4 < 1024; ++it) { const int t = (it * F.G + F.vcu) * 4 + (F.wave >> 1);
              if (it * F.G * 4 < 512) { if (t < 512) swa_sample_task(F, t, true, wl, xch); else memattn_sample_task(F, 1, t - 512, t < 1024, wl, xch); }
              else memattn_sample_task(F, 1, t - 512, t < 1024, wl, xch); } }
    } SEAM(9);

    if (IN(10)) for (int rep_ = 0; rep_ < PH_REP(10); ++rep_) { PHASE_BEGIN(); pg8::Gemm g{MIX, (const bf16*)(F.ws + WS_WOUT) + (size_t)DM * DM, R, DM, DM}; pg8::TailOrder S; S.init(F.G, (int)blockIdx.x, DM, S_K1);
        pg8::EpiResid E{nullptr, nullptr, RP, nullptr, HB, SSQ, (float*)(F.ws + WS_SLAB), S_K1, HB};
        pg8::gemm_phase<pg8::EpiResid, pg8::TailOrder, true, true>(F.lds + RING_OFF, g, S, E, F.wave, F.lane); } SEAM(10);
    if (IN(11)) for (int rep_ = 0; rep_ < PH_REP(11); ++rep_) { PHASE_BEGIN(); finalize_sample(F, nullptr, S_K1, false); xcd_barrier(bar);
        pg8::Gemm g{HB, (const bf16*)(F.ws + WS_WUP) + (size_t)DM * FF, R, FF, DM}; pg8::StaticOrder S; S.init(R, FF, F.G, (int)blockIdx.x, DM);
        pg8::EpiScaleBf16<1> E{HH, FF, SSQ};
        pg8::gemm_phase<pg8::EpiScaleBf16<1>, pg8::StaticOrder, true, true>(F.lds + RING_OFF, g, S, E, F.wave, F.lane); } SEAM(11);
    if (IN(12)) for (int rep_ = 0; rep_ < PH_REP(12); ++rep_) { PHASE_BEGIN(); pg8::Gemm g{HH, (const bf16*)(F.ws + WS_WDN) + (size_t)DM * FF, R, DM, FF}; pg8::TailOrder S; S.init(F.G, (int)blockIdx.x, FF, S_K4);
        pg8::EpiResid E{nullptr, nullptr, RP, F.out + O_Y, nullptr, nullptr, (float*)(F.ws + WS_SLAB), S_K4, HB};
        pg8::gemm_phase<pg8::EpiResid, pg8::TailOrder, true, true>(F.lds + RING_OFF, g, S, E, F.wave, F.lane);
        xcd_barrier(bar); finalize_sample(F, nullptr, S_K4, true); }
    STAMP(13);
    if (MK_TIME >= 0 && blockIdx.x == 0 && F.wave == 0 && mk_lane() == 0) {
        volatile LAS unsigned long long* ts = (volatile LAS unsigned long long*)(F.lds + LDSCTL_OFF + 512); const unsigned long long d = MK_TIME == 20 ? ts[14] - ts[2] : MK_TIME == 21 ? ts[3] - ts[14] : MK_TIME == 22 ? ts[15] - ts[14] : MK_TIME == 36 ? ts[23] - ts[3] : (MK_TIME >= 30 && MK_TIME < 36) ? ts[MK_TIME - 30 + 18] - ts[MK_TIME - 30 + 17] : MK_TIME == 23 ? ts[16] - ts[15] : ts[MK_TIME + 1] - ts[MK_TIME], t0 = __builtin_amdgcn_s_memrealtime();
        while (__builtin_amdgcn_s_memrealtime() - t0 < d) __builtin_amdgcn_s_sleep(8); }
#undef IN
#undef SEAM
#undef SSQ
#undef HB
#undef MIX
#undef HH
#undef PHASE_BEGIN
}

template <int PM> static void launch_pm(int grid, hipStream_t stream, const Args& a) {
    Args aa = a; void* kargs[] = {(void*)&aa};
    if (hipLaunchCooperativeKernel((const void*)yoco_fwd<PM>, dim3(grid), dim3(NWAVES * 64), kargs, LDS_BYTES, stream) != hipSuccess) fprintf(stderr, "kernel_launch: cooperative launch failed (grid %d)\n", grid);
}
template <int PM> static bool set_lds() { return hipFuncSetAttribute((const void*)yoco_fwd<PM>, hipFuncAttributeMaxDynamicSharedMemorySize, LDS_BYTES) == hipSuccess; }
extern "C" void kernel_launch(void* const* d_in, const int* in_sizes, int n_in, void* d_out, int out_size, void* d_ws, size_t ws_size, hipStream_t stream) {
    static int grid = 0;
    if (grid == 0) {
        if (n_in != N_IN || (size_t)out_size != O_END || ws_size < WS_END) { fprintf(stderr, "kernel_launch: unexpected shapes (n_in %d, out %d, ws %zu < %zu)\n", n_in, out_size, ws_size, (size_t)WS_END); grid = -1; return; }
        int dev = 0, cus = 0;
        if (hipGetDevice(&dev) != hipSuccess || hipDeviceGetAttribute(&cus, hipDeviceAttributeMultiprocessorCount, dev) != hipSuccess) { grid = -1; return; }
        bool ok = true;
#if MK_ONE_LAUNCH
        ok = set_lds<0x1fff>();
#else
        ok = set_lds<1>() && set_lds<2>() && set_lds<4>() && set_lds<8>() && set_lds<16>() && set_lds<32>() && set_lds<64>() && set_lds<128>() && set_lds<256>() && set_lds<512>() && set_lds<1024>() && set_lds<2048>() && set_lds<4096>();
#endif
        if (!ok) { grid = -1; return; }
        int per_cu = 0;
#if MK_ONE_LAUNCH
        if (hipOccupancyMaxActiveBlocksPerMultiprocessor(&per_cu, yoco_fwd<0x1fff>, NWAVES * 64, LDS_BYTES) != hipSuccess || per_cu < 1) { fprintf(stderr, "kernel_launch: occupancy query reports %d workgroups per CU\n", per_cu); grid = -1; return; }
#endif
        (void)hipGetLastError();
        grid = cus;
    }
    if (grid < 0) return;
    (void)hipMemsetAsync((char*)d_ws + WS_CTL, 0, CTL_ZERO_BYTES, stream);
    Args a{};
    for (int i = 0; i < N_IN; ++i) a.in[i] = (const float*)d_in[i];
    a.out = (float*)d_out; a.ws = (unsigned char*)d_ws;
#if MK_ONE_LAUNCH
    a.ph_lo = 0; a.ph_hi = N_PHASES; launch_pm<0x1fff>(grid, stream, a);
#else
#define LP(p) a.ph_lo = (p); a.ph_hi = (p) + 1; launch_pm<(1 << (p))>(grid, stream, a);
    LP(0) LP(1) LP(2) LP(3) LP(4) LP(5) LP(6) LP(7) LP(8) LP(9) LP(10) LP(11) LP(12)
#undef LP
#endif
}
```
